# Optimizing an MI355X kernel written in HIP

```python
import jax, jax.numpy as jnp
from jax import lax
import numpy as np

D_MODEL = 1024
BATCH = 2
SEQ = 8192
DEPTH = 1

N_ATTN_HEADS = 8
ATTN_HEAD_DIM = 64
KV_LATENT = 256
N_IDX_HEADS = 8
IDX_HEAD_DIM = 32
TOPK_MAX = 256
Q_BLOCK = 128
N_RWKV_HEADS = 8
RWKV_HEAD_DIM = 64
DECAY_LORA = 64
AAA_LORA = 64
GATE_LORA = 160
N_GROUPS = 4
EXPERTS_PER_GROUP = 8
N_EXPERTS = N_GROUPS * EXPERTS_PER_GROUP
D_EXPERT = 512
TOP_K_EXPERTS = 2
NORM_EPS = 1e-6
GN_EPS = 64e-5
ATTN_W = N_ATTN_HEADS * ATTN_HEAD_DIM
RWKV_W = N_RWKV_HEADS * RWKV_HEAD_DIM
IDX_Q_W = N_IDX_HEADS * IDX_HEAD_DIM
SHIFT_W = 3 * RWKV_W + DECAY_LORA + AAA_LORA + GATE_LORA
IN_SPLITS = (ATTN_W, KV_LATENT, IDX_Q_W, IDX_HEAD_DIM, N_IDX_HEADS, SHIFT_W, D_MODEL, D_MODEL)
IN_W = ATTN_W + KV_LATENT + IDX_Q_W + IDX_HEAD_DIM + N_IDX_HEADS + SHIFT_W + 2 * D_MODEL

kernel_name = "hybrid_dsa_rwkv7_hmoe_block"


def _split(x, sizes):
    idx = np.cumsum(sizes)[:-1].tolist()
    return jnp.split(x, idx, axis=-1)


def _rmsnorm(x, g):
    xf = x.astype(jnp.float32)
    y = xf * lax.rsqrt(jnp.mean(xf * xf, axis=-1, keepdims=True) + NORM_EPS)
    return (y * g.astype(jnp.float32)).astype(x.dtype)


def _dsa_attention(q, k, v, q_idx, k_idx, w_idx):
    B, S = q.shape[0], q.shape[1]
    top_k = min(TOPK_MAX, S // 4)
    nb = S // Q_BLOCK
    f32 = jnp.float32
    slopes = 2.0 ** (-8.0 * jnp.arange(1, N_ATTN_HEADS + 1, dtype=f32) / N_ATTN_HEADS)
    key_pos = jnp.arange(S)
    k_idx_f = k_idx.astype(f32)
    idx_scale = (IDX_HEAD_DIM ** -0.5) * (N_IDX_HEADS ** -0.5)

    def blocks(a):
        return jnp.moveaxis(a.reshape((B, nb, Q_BLOCK) + a.shape[2:]), 1, 0)

    def one_block(args):
        qb, qib, wib, start = args
        t = start + jnp.arange(Q_BLOCK)
        dots = jnp.einsum('bthd,bsd->bths', qib.astype(f32), k_idx_f)
        score = jnp.einsum('bths,bth->bts', jax.nn.relu(dots), wib.astype(f32)) * idx_scale
        causal = key_pos[None, :] <= t[:, None]
        score = jnp.where(causal[None], score, -jnp.inf)
        _, sel = lax.top_k(score, top_k)
        k_sel = jax.vmap(lambda kb, ib: kb[ib])(k, sel)
        v_sel = jax.vmap(lambda vb, ib: vb[ib])(v, sel)
        logits = jnp.einsum('bthd,btkhd->bthk', qb.astype(f32), k_sel.astype(f32)) * (ATTN_HEAD_DIM ** -0.5)
        dist = (t[None, :, None] - sel).astype(f32)
        logits = logits - slopes[None, None, :, None] * dist[:, :, None, :]
        valid = sel <= t[None, :, None]
        logits = jnp.where(valid[:, :, None, :], logits, -jnp.inf)
        p = jax.nn.softmax(logits, axis=-1)
        o = jnp.einsum('bthk,btkhd->bthd', p, v_sel.astype(f32))
        return o.astype(q.dtype)

    starts = jnp.arange(nb) * Q_BLOCK
    out = lax.map(one_block, (blocks(q), blocks(q_idx), blocks(w_idx), starts))
    return jnp.moveaxis(out, 0, 1).reshape(B, S, ATTN_W)


def _rwkv7_time_mix(p_shift, mu, w0, w2, a0, a2, g2, k_k, k_a, r_k, ln_w, ln_b):
    B, S = p_shift.shape[0], p_shift.shape[1]
    H, N = N_RWKV_HEADS, RWKV_HEAD_DIM
    f32 = jnp.float32
    prev = jnp.pad(p_shift[:, :-1], ((0, 0), (1, 0), (0, 0)))
    mixed = p_shift + (prev - p_shift) * mu
    r, k, v, wl, al, gl = _split(mixed, (RWKV_W, RWKV_W, RWKV_W, DECAY_LORA, AAA_LORA, GATE_LORA))
    w = -jax.nn.softplus(-(w0 + jnp.tanh(wl) @ w2)) - 0.5
    decay = jnp.exp(-jnp.exp(w.astype(f32)))
    a = jax.nn.sigmoid(a0 + al @ a2)
    g = jax.nn.sigmoid(gl) @ g2
    heads = lambda z: z.reshape(B, S, H, N).astype(f32)
    kk = heads(k * k_k)
    kk = kk / jnp.maximum(jnp.sqrt(jnp.sum(kk * kk, axis=-1, keepdims=True)), 1e-12)
    k = k * (1.0 + (a - 1.0) * k_a)
    r_h, k_h, v_h, a_h, d_h = heads(r), heads(k), heads(v), heads(a), heads(decay)

    def step(state, inp):
        r_t, d_t, k_t, v_t, kk_t, b_t = inp
        sa = jnp.einsum('bhij,bhj->bhi', state, -kk_t)
        state = state * d_t[:, :, None, :] + sa[..., None] * b_t[:, :, None, :] + v_t[..., None] * k_t[:, :, None, :]
        y = jnp.einsum('bhij,bhj->bhi', state, r_t)
        return state, y

    xs = tuple(jnp.moveaxis(z, 1, 0) for z in (r_h, d_h, k_h, v_h, kk, kk * a_h))
    _, y = lax.scan(step, jnp.zeros((B, H, N, N), f32), xs)
    y = jnp.moveaxis(y, 0, 1)
    mean = jnp.mean(y, axis=-1, keepdims=True)
    var = jnp.mean(jnp.square(y - mean), axis=-1, keepdims=True)
    y = ((y - mean) * lax.rsqrt(var + GN_EPS)).reshape(B, S, RWKV_W) * ln_w + ln_b
    bonus = (jnp.sum(r_h * k_h * r_k, axis=-1, keepdims=True) * v_h).reshape(B, S, RWKV_W)
    return ((y + bonus) * g).astype(p_shift.dtype)


def _hier_moe(xt, wg_router, we_router, e_bias, w_gate, w_up, w_down):
    T, D = xt.shape
    f32 = jnp.float32
    p_group = jax.nn.softmax((xt @ wg_router).astype(f32), axis=-1)
    g_sel = jnp.argmax(p_group, axis=-1)
    p_gsel = jnp.max(p_group, axis=-1)
    e_logits = (xt @ we_router).astype(f32).reshape(T, N_GROUPS, EXPERTS_PER_GROUP) + e_bias.astype(f32).reshape(N_GROUPS, EXPERTS_PER_GROUP)
    e_in = jnp.take_along_axis(e_logits, g_sel[:, None, None], axis=1)[:, 0]
    top_v, top_i = lax.top_k(e_in, TOP_K_EXPERTS)
    w_top = jax.nn.softmax(top_v, axis=-1) * p_gsel[:, None]
    expert_id = g_sel[:, None] * EXPERTS_PER_GROUP + top_i
    combine = jnp.sum(jax.nn.one_hot(expert_id, N_EXPERTS, dtype=f32) * w_top[..., None], axis=1)

    def body(acc, ew):
        wg, wu, wd, cw = ew
        hdn = jax.nn.silu(xt @ wg) * (xt @ wu)
        return acc + cw[:, None] * (hdn @ wd).astype(f32), None

    acc, _ = lax.scan(body, jnp.zeros((T, D), f32), (w_gate, w_up, w_down, combine.T))
    return acc.astype(xt.dtype)


def setup_inputs(seed: int = 0) -> dict:
    key = jax.random.key(seed)
    ks = iter(jax.random.split(key, 40))
    nrm = lambda shape, scale: jax.random.normal(next(ks), shape, jnp.float32) * scale
    L = DEPTH
    return {
        "x": nrm((BATCH, SEQ, D_MODEL), 1.0),
        "c": nrm((BATCH, D_MODEL), 1.0),
        "ada_w": nrm((L, D_MODEL, 6 * D_MODEL), 0.5 * D_MODEL ** -0.5),
        "ada_b": nrm((L, 6 * D_MODEL), 0.02),
        "mix_norm_g": 1.0 + nrm((L, D_MODEL), 0.02),
        "w_in": nrm((L, D_MODEL, IN_W), D_MODEL ** -0.5),
        "kv_norm_g": 1.0 + nrm((L, KV_LATENT), 0.02),
        "w_kv_up": nrm((L, KV_LATENT, 2 * ATTN_W), KV_LATENT ** -0.5),
        "q_norm_g": 1.0 + nrm((L, ATTN_HEAD_DIM), 0.02),
        "k_norm_g": 1.0 + nrm((L, ATTN_HEAD_DIM), 0.02),
        "rwkv_mu": jax.random.uniform(next(ks), (L, SHIFT_W), jnp.float32, 0.2, 0.8),
        "rwkv_w0": -1.0 + nrm((L, RWKV_W), 0.5),
        "rwkv_w2": nrm((L, DECAY_LORA, RWKV_W), 0.5 * DECAY_LORA ** -0.5),
        "rwkv_a0": nrm((L, RWKV_W), 0.1),
        "rwkv_a2": nrm((L, AAA_LORA, RWKV_W), 0.5 * AAA_LORA ** -0.5),
        "rwkv_g2": nrm((L, GATE_LORA, RWKV_W), GATE_LORA ** -0.5),
        "rwkv_k_k": 0.85 + nrm((L, RWKV_W), 0.02),
        "rwkv_k_a": 1.0 + nrm((L, RWKV_W), 0.02),
        "rwkv_r_k": nrm((L, N_RWKV_HEADS, RWKV_HEAD_DIM), 0.1),
        "rwkv_ln_w": 1.0 + nrm((L, RWKV_W), 0.02),
        "rwkv_ln_b": nrm((L, RWKV_W), 0.02),
        "w_branch_attn": nrm((L, ATTN_W, D_MODEL), ATTN_W ** -0.5),
        "w_branch_rwkv": nrm((L, RWKV_W, D_MODEL), RWKV_W ** -0.5),
        "w_out": nrm((L, D_MODEL, D_MODEL), D_MODEL ** -0.5),
        "moe_norm_g": 1.0 + nrm((L, D_MODEL), 0.02),
        "router_group_w": nrm((L, D_MODEL, N_GROUPS), D_MODEL ** -0.5),
        "router_expert_w": nrm((L, D_MODEL, N_EXPERTS), D_MODEL ** -0.5),
        "router_expert_bias": nrm((L, N_EXPERTS), 0.01),
        "expert_w_gate": nrm((L, N_EXPERTS, D_MODEL, D_EXPERT), D_MODEL ** -0.5),
        "expert_w_up": nrm((L, N_EXPERTS, D_MODEL, D_EXPERT), D_MODEL ** -0.5),
        "expert_w_down": nrm((L, N_EXPERTS, D_EXPERT, D_MODEL), D_EXPERT ** -0.5),
    }


def reference(x, c, ada_w, ada_b, mix_norm_g, w_in, kv_norm_g, w_kv_up, q_norm_g, k_norm_g,
              rwkv_mu, rwkv_w0, rwkv_w2, rwkv_a0, rwkv_a2, rwkv_g2, rwkv_k_k, rwkv_k_a, rwkv_r_k,
              rwkv_ln_w, rwkv_ln_b, w_branch_attn, w_branch_rwkv, w_out, moe_norm_g,
              router_group_w, router_expert_w, router_expert_bias, expert_w_gate, expert_w_up,
              expert_w_down):
    B, S, D = x.shape
    h = x
    for l in range(DEPTH):
        mod = jax.nn.silu(c) @ ada_w[l] + ada_b[l]
        sh1, sc1, gt1, sh2, sc2, gt2 = jnp.split(mod[:, None, :], 6, axis=-1)

        xn = _rmsnorm(h, mix_norm_g[l]) * (1.0 + sc1) + sh1
        proj = xn @ w_in[l]
        q_a, kv_lat, q_i, k_i, w_i, p_shift, gate_a, gate_r = _split(proj, IN_SPLITS)
        q = _rmsnorm(q_a.reshape(B, S, N_ATTN_HEADS, ATTN_HEAD_DIM), q_norm_g[l])
        kv = _rmsnorm(kv_lat, kv_norm_g[l]) @ w_kv_up[l]
        k_lin, v_lin = jnp.split(kv, 2, axis=-1)
        k = _rmsnorm(k_lin.reshape(B, S, N_ATTN_HEADS, ATTN_HEAD_DIM), k_norm_g[l])
        v = v_lin.reshape(B, S, N_ATTN_HEADS, ATTN_HEAD_DIM)
        o_attn = _dsa_attention(q, k, v, q_i.reshape(B, S, N_IDX_HEADS, IDX_HEAD_DIM), k_i, w_i)
        o_rwkv = _rwkv7_time_mix(p_shift, rwkv_mu[l], rwkv_w0[l], rwkv_w2[l], rwkv_a0[l], rwkv_a2[l],
                                 rwkv_g2[l], rwkv_k_k[l], rwkv_k_a[l], rwkv_r_k[l], rwkv_ln_w[l], rwkv_ln_b[l])
        merged = jax.nn.sigmoid(gate_a) * (o_attn @ w_branch_attn[l]) + jax.nn.sigmoid(gate_r) * (o_rwkv @ w_branch_rwkv[l])
        h = h + gt1 * (merged @ w_out[l])

        xn2 = _rmsnorm(h, moe_norm_g[l]) * (1.0 + sc2) + sh2
        moe = _hier_moe(xn2.reshape(B * S, D), router_group_w[l], router_expert_w[l], router_expert_bias[l],
                        expert_w_gate[l], expert_w_up[l], expert_w_down[l])
        h = h + gt2 * moe.reshape(B, S, D)
    return h
```

```cpp
#include <hip/hip_runtime.h>
#include <cstdio>
#include <cstdint>

namespace {
constexpr int NB = 2, SEQ = 8192, DM = 1024, NT = NB * SEQ;
constexpr int AW = 512, KVL = 256, NIH = 8, IDD = 32, SHW = 1824, INW = 4936;
constexpr int C_KV = 512, C_QI = 768, C_PS = 1064, C_GA = 2888, C_GR = 3912;
constexpr int IDXW = 296;
constexpr int RW = 512, NE = 32, DE = 512;
constexpr int TOPK = 256;
constexpr float NORM_EPS = 1e-6f, GN_EPS = 64e-5f;
constexpr int NTHR = 512;

typedef unsigned short bf16_t;
__device__ __forceinline__ float bf2f(bf16_t v) { return __uint_as_float(((unsigned)v) << 16); }
__device__ __forceinline__ bf16_t f2bf(float f) { unsigned u = __float_as_uint(f); return (bf16_t)((u + 0x7fffu + ((u >> 16) & 1u)) >> 16); }

constexpr size_t MiB = 1u << 20;
constexpr size_t WS_CTL = 0;
constexpr size_t WS_MOD = 1 * MiB;
constexpr size_t WS_XN = 2 * MiB;
constexpr size_t WS_ORW = 2 * MiB;
constexpr size_t WS_G = 18 * MiB;
constexpr size_t WS_Q = 34 * MiB;
constexpr size_t WS_KVN = 50 * MiB;
constexpr size_t WS_K = 58 * MiB;
constexpr size_t WS_V = 74 * MiB;
constexpr size_t WS_IDX = 90 * MiB;
constexpr size_t WS_PS = 109 * MiB;
constexpr size_t WS_YS = 109 * MiB;
constexpr size_t WS_OATT = 166 * MiB;
constexpr size_t WS_R = 182 * MiB, WS_K2 = 198 * MiB, WS_VV = 214 * MiB, WS_KK = 230 * MiB, WS_BB = 246 * MiB;
constexpr size_t WS_DD = 262 * MiB;
constexpr size_t WS_MERGED = 34 * MiB;
constexpr size_t WS_XN2 = 66 * MiB;
constexpr size_t WS_ROUTE = 98 * MiB;
constexpr size_t WS_LTOK = 99 * MiB;
constexpr size_t WS_LW = 100 * MiB;
constexpr size_t WS_HID = 109 * MiB;
constexpr size_t WS_END = 294 * MiB;
constexpr int HID_ROWS = 36864;
constexpr int CT_CNT = 0, CT_OFF = 64, CT_CUR = 128;

struct P {
    const float* in[31];
    float* out;
    unsigned char* ws;
};

__device__ __forceinline__ float dpp_row_shr(float v, int n) {
    int iv = __builtin_bit_cast(int, v), r;
    switch (n) { case 1: r = __builtin_amdgcn_update_dpp(0, iv, 0x111, 0xf, 0xf, true); break; case 2: r = __builtin_amdgcn_update_dpp(0, iv, 0x112, 0xf, 0xf, true); break;
                 case 4: r = __builtin_amdgcn_update_dpp(0, iv, 0x114, 0xf, 0xf, true); break; default: r = __builtin_amdgcn_update_dpp(0, iv, 0x118, 0xf, 0xf, true); break; }
    return __builtin_bit_cast(float, r);
}
__device__ __forceinline__ float wave_sum(float v) {
    v += dpp_row_shr(v, 1); v += dpp_row_shr(v, 2); v += dpp_row_shr(v, 4); v += dpp_row_shr(v, 8);
    v += __builtin_bit_cast(float, __builtin_amdgcn_update_dpp(0, __builtin_bit_cast(int, v), 0x142, 0xa, 0xf, false));
    v += __builtin_bit_cast(float, __builtin_amdgcn_update_dpp(0, __builtin_bit_cast(int, v), 0x143, 0xc, 0xf, false));
    return __builtin_bit_cast(float, __builtin_amdgcn_readlane(__builtin_bit_cast(int, v), 63));
}
__device__ __forceinline__ float wave_max(float v) {
#pragma unroll
    for (int o = 32; o > 0; o >>= 1) v = fmaxf(v, __shfl_xor(v, o));
    return v;
}
__device__ __forceinline__ float sigmoidf_(float x) { return 1.f / (1.f + __expf(-x)); }

__device__ void ph_mod(const P& p, float* lds) {
    const float* c = p.in[1]; const float* W = p.in[2]; const float* bia = p.in[3];
    float* mod = (float*)(p.ws + WS_MOD);
    for (int i = threadIdx.x; i < NB * DM; i += NTHR) { float v = c[i]; lds[i] = v / (1.f + __expf(-v)); }
    __syncthreads();
    const int gt = blockIdx.x * NTHR + threadIdx.x, gs = gridDim.x * NTHR;
    for (int j = gt; j < 6 * DM; j += gs) {
        float a0 = 0.f, a1 = 0.f;
#pragma unroll 8
        for (int k = 0; k < DM; ++k) { float w = W[(size_t)k * (6 * DM) + j]; a0 += lds[k] * w; a1 += lds[DM + k] * w; }
        mod[j] = a0 + bia[j]; mod[6 * DM + j] = a1 + bia[j];
    }
}

template <bool ROUTE>
__device__ void ph_norm(const P& p, const float* src, const float* g, int which, bf16_t* dst) {
    const float* mod = (const float*)(p.ws + WS_MOD);
    const int lane = threadIdx.x & 63, wv = threadIdx.x >> 6;
    const int gw = blockIdx.x * (NTHR / 64) + wv, nw = gridDim.x * (NTHR / 64);
    for (int m = gw; m < NT; m += nw) {
        const int b = m / SEQ;
        const float* sh = mod + b * 6 * DM + (which ? 3 * DM : 0);
        const float* sc = sh + DM;
        const float4* xr = (const float4*)(src + (size_t)m * DM);
        float4 v[4]; float ss = 0.f;
#pragma unroll
        for (int j = 0; j < 4; ++j) { v[j] = xr[lane + 64 * j]; ss += v[j].x * v[j].x + v[j].y * v[j].y + v[j].z * v[j].z + v[j].w * v[j].w; }
        ss = wave_sum(ss);
        const float rstd = rsqrtf(ss * (1.f / DM) + NORM_EPS);
        float o[16];
#pragma unroll
        for (int j = 0; j < 4; ++j) {
            const int c0 = 4 * (lane + 64 * j);
            const float4 gg = *(const float4*)(g + c0), s1 = *(const float4*)(sc + c0), s0 = *(const float4*)(sh + c0);
            o[4 * j + 0] = v[j].x * rstd * gg.x * (1.f + s1.x) + s0.x; o[4 * j + 1] = v[j].y * rstd * gg.y * (1.f + s1.y) + s0.y;
            o[4 * j + 2] = v[j].z * rstd * gg.z * (1.f + s1.z) + s0.z; o[4 * j + 3] = v[j].w * rstd * gg.w * (1.f + s1.w) + s0.w;
            uint2 pk; pk.x = (unsigned)f2bf(o[4 * j]) | ((unsigned)f2bf(o[4 * j + 1]) << 16); pk.y = (unsigned)f2bf(o[4 * j + 2]) | ((unsigned)f2bf(o[4 * j + 3]) << 16);
            *(uint2*)(dst + (size_t)m * DM + c0) = pk;
        }
        if constexpr (ROUTE) {
            const float* wgr = p.in[25]; const float* wer = p.in[26]; const float* eb = p.in[27];
            float lg[4], le[32];
#pragma unroll
            for (int q = 0; q < 4; ++q) lg[q] = 0.f;
#pragma unroll
            for (int q = 0; q < 32; ++q) le[q] = 0.f;
#pragma unroll
            for (int j = 0; j < 4; ++j)
#pragma unroll
                for (int e = 0; e < 4; ++e) {
                    const int i = 4 * (lane + 64 * j) + e; const float xv = o[4 * j + e];
                    const float4 wg4 = *(const float4*)(wgr + (size_t)i * 4);
                    lg[0] += xv * wg4.x; lg[1] += xv * wg4.y; lg[2] += xv * wg4.z; lg[3] += xv * wg4.w;
                    const float4* we4 = (const float4*)(wer + (size_t)i * 32);
#pragma unroll
                    for (int q = 0; q < 8; ++q) { float4 w = we4[q]; le[4 * q] += xv * w.x; le[4 * q + 1] += xv * w.y; le[4 * q + 2] += xv * w.z; le[4 * q + 3] += xv * w.w; }
                }
#pragma unroll
            for (int q = 0; q < 4; ++q) lg[q] = wave_sum(lg[q]);
#pragma unroll
            for (int q = 0; q < 32; ++q) le[q] = wave_sum(le[q]);
            if (lane == 0) {
                int gs = 0; float mx = lg[0];
#pragma unroll
                for (int q = 1; q < 4; ++q) if (lg[q] > mx) { mx = lg[q]; gs = q; }
                float den = 0.f;
#pragma unroll
                for (int q = 0; q < 4; ++q) den += __expf(lg[q] - mx);
                const float pg = 1.f / den;
                float ev[8];
#pragma unroll
                for (int q = 0; q < 8; ++q) { float a = 0.f;
#pragma unroll
                    for (int gq = 0; gq < 4; ++gq) a = (gs == gq) ? le[gq * 8 + q] : a;
                    ev[q] = a + eb[gs * 8 + q]; }
                int i0 = 0; float v0 = ev[0];
#pragma unroll
                for (int q = 1; q < 8; ++q) if (ev[q] > v0) { v0 = ev[q]; i0 = q; }
                int i1 = -1; float v1 = -INFINITY;
#pragma unroll
                for (int q = 0; q < 8; ++q) if (q != i0 && ev[q] > v1) { v1 = ev[q]; i1 = q; }
                const float e1 = __expf(v1 - v0), w0 = pg / (1.f + e1), w1 = pg * e1 / (1.f + e1);
                int* route = (int*)(p.ws + WS_ROUTE) + (size_t)m * 4;
                route[0] = gs * 8 + i0; route[1] = gs * 8 + i1; route[2] = __float_as_int(w0); route[3] = __float_as_int(w1);
                int* ctl = (int*)(p.ws + WS_CTL);
                atomicAdd(ctl + CT_CNT + gs * 8 + i0, 1); atomicAdd(ctl + CT_CNT + gs * 8 + i1, 1);
            }
        }
    }
}

struct GemmArgs {
    const bf16_t* A1; const bf16_t* A2; int lda;
    const int* rowidx; int rows_valid;
    const float* B1; const float* B2; int ldb;
    int K, N;
};
template <bool DUAL, bool SEPA, class Epi>
__device__ void gemm_tile(const GemmArgs& g, int m0, int n0, float* lds, const Epi& epi) {
    float* As1 = lds; float* As2 = lds + 16 * 132; float* Bs1 = lds + 2 * 16 * 132; float* Bs2 = lds + 3 * 16 * 132;
    const int tid = threadIdx.x, tx = tid & 31, ty = tid >> 5;
    float acc1[8][4], acc2[8][4];
#pragma unroll
    for (int i = 0; i < 8; ++i)
#pragma unroll
        for (int j = 0; j < 4; ++j) { acc1[i][j] = 0.f; acc2[i][j] = 0.f; }
    const int ar = tid >> 2, akq = (tid & 3) * 4;
    long arow;
    { const int rr = m0 + ar; if (g.rowidx) { arow = (rr < g.rows_valid) ? (long)g.rowidx[rr] : -1; } else arow = rr; }
    const int bk = tid >> 5, bn = n0 + (tid & 31) * 4;
    const bool bok = bn < g.N;
    for (int k0 = 0; k0 < g.K; k0 += 16) {
        uint2 a1 = make_uint2(0, 0), a2 = make_uint2(0, 0);
        if (arow >= 0) { a1 = *(const uint2*)(g.A1 + (size_t)arow * g.lda + k0 + akq); if (SEPA) a2 = *(const uint2*)(g.A2 + (size_t)arow * g.lda + k0 + akq); }
        float4 b1 = make_float4(0, 0, 0, 0), b2 = make_float4(0, 0, 0, 0);
        if (bok) { b1 = *(const float4*)(g.B1 + (size_t)(k0 + bk) * g.ldb + bn); if (DUAL) b2 = *(const float4*)(g.B2 + (size_t)(k0 + bk) * g.ldb + bn); }
        __syncthreads();
        As1[(akq + 0) * 132 + ar] = bf2f((bf16_t)(a1.x & 0xffff)); As1[(akq + 1) * 132 + ar] = bf2f((bf16_t)(a1.x >> 16));
        As1[(akq + 2) * 132 + ar] = bf2f((bf16_t)(a1.y & 0xffff)); As1[(akq + 3) * 132 + ar] = bf2f((bf16_t)(a1.y >> 16));
        *(float4*)(Bs1 + bk * 132 + (tid & 31) * 4) = b1;
        if (DUAL) {
            if (SEPA) {
                As2[(akq + 0) * 132 + ar] = bf2f((bf16_t)(a2.x & 0xffff)); As2[(akq + 1) * 132 + ar] = bf2f((bf16_t)(a2.x >> 16));
                As2[(akq + 2) * 132 + ar] = bf2f((bf16_t)(a2.y & 0xffff)); As2[(akq + 3) * 132 + ar] = bf2f((bf16_t)(a2.y >> 16));
            }
            *(float4*)(Bs2 + bk * 132 + (tid & 31) * 4) = b2;
        }
        __syncthreads();
        const float* Asec = SEPA ? As2 : As1;
#pragma unroll 4
        for (int k = 0; k < 16; ++k) {
            const float4 x0 = *(const float4*)(As1 + k * 132 + ty * 8), x1 = *(const float4*)(As1 + k * 132 + ty * 8 + 4);
            const float4 bb = *(const float4*)(Bs1 + k * 132 + tx * 4);
            const float a[8] = {x0.x, x0.y, x0.z, x0.w, x1.x, x1.y, x1.z, x1.w};
            const float bv[4] = {bb.x, bb.y, bb.z, bb.w};
#pragma unroll
            for (int i = 0; i < 8; ++i)
#pragma unroll
                for (int j = 0; j < 4; ++j) acc1[i][j] += a[i] * bv[j];
            if (DUAL) {
                const float4 y0 = *(const float4*)(Asec + k * 132 + ty * 8), y1 = *(const float4*)(Asec + k * 132 + ty * 8 + 4);
                const float4 cc = *(const float4*)(Bs2 + k * 132 + tx * 4);
                const float a2v[8] = {y0.x, y0.y, y0.z, y0.w, y1.x, y1.y, y1.z, y1.w};
                const float cv[4] = {cc.x, cc.y, cc.z, cc.w};
#pragma unroll
                for (int i = 0; i < 8; ++i)
#pragma unroll
                    for (int j = 0; j < 4; ++j) acc2[i][j] += a2v[i] * cv[j];
            }
        }
    }
    __syncthreads();
#pragma unroll
    for (int i = 0; i < 8; ++i)
#pragma unroll
        for (int j = 0; j < 4; ++j) { const int n = n0 + tx * 4 + j; if (n < g.N) epi(m0 + ty * 8 + i, n, acc1[i][j], acc2[i][j]); }
}

struct EpiInproj {
    unsigned char* ws; float* gates;
    __device__ __forceinline__ void operator()(int m, int n, float v, float) const {
        if (n < C_KV) ((bf16_t*)(ws + WS_Q))[(size_t)m * AW + n] = f2bf(v);
        else if (n < C_QI) ((bf16_t*)(ws + WS_KVN))[(size_t)m * KVL + (n - C_KV)] = f2bf(v);
        else if (n < C_PS) ((float*)(ws + WS_IDX))[(size_t)m * IDXW + (n - C_QI)] = v;
        else if (n < C_GA) ((bf16_t*)(ws + WS_PS))[(size_t)m * SHW + (n - C_PS)] = f2bf(v);
        else if (n < C_GR) ((bf16_t*)gates)[(size_t)m * DM + (n - C_GA)] = f2bf(sigmoidf_(v));
        else ((bf16_t*)gates)[(size_t)NT * DM + (size_t)m * DM + (n - C_GR)] = f2bf(sigmoidf_(v));
    }
};
struct EpiKV {
    unsigned char* ws;
    __device__ __forceinline__ void operator()(int m, int n, float v, float) const {
        if (n < AW) ((bf16_t*)(ws + WS_K))[(size_t)m * AW + n] = f2bf(v);
        else ((bf16_t*)(ws + WS_V))[(size_t)m * AW + (n - AW)] = f2bf(v);
    }
};
struct EpiMerge {
    unsigned char* ws; const float* gates;
    __device__ __forceinline__ void operator()(int m, int n, float va, float vr) const {
        const float ga = bf2f(((const bf16_t*)gates)[(size_t)m * DM + n]), gr = bf2f(((const bf16_t*)gates)[(size_t)NT * DM + (size_t)m * DM + n]);
        ((bf16_t*)(ws + WS_MERGED))[(size_t)m * DM + n] = f2bf(ga * va + gr * vr);
    }
};
struct EpiOut {
    const float* x; const float* mod; float* out;
    __device__ __forceinline__ void operator()(int m, int n, float v, float) const {
        const int b = m / SEQ; out[(size_t)m * DM + n] = x[(size_t)m * DM + n] + mod[b * 6 * DM + 2 * DM + n] * v;
    }
};
struct EpiMoe1 {
    bf16_t* hid; const float* lw; int rowbase, cnt;
    __device__ __forceinline__ void operator()(int m, int n, float g, float u) const {
        if (m < cnt) { const float w = lw[rowbase + m]; hid[(size_t)(rowbase + m) * DE + n] = f2bf(w * (g / (1.f + __expf(-g))) * u); }
    }
};
struct EpiMoe2 {
    const int* ltok; const float* mod; float* out; int rowbase, cnt;
    __device__ __forceinline__ void operator()(int m, int n, float v, float) const {
        if (m < cnt) { const int tok = ltok[rowbase + m]; const int b = tok / SEQ; atomicAdd(out + (size_t)tok * DM + n, mod[b * 6 * DM + 5 * DM + n] * v); }
    }
};

template <class Epi>
__device__ void ph_gemm_plain(const GemmArgs& g, int M, float* lds, const Epi& epi) {
    const int nmt = M / 128, nnt = (g.N + 127) / 128;
    for (int t = blockIdx.x; t < nmt * nnt; t += gridDim.x) { const int mt = t % nmt, nt = t / nmt; gemm_tile<false, false>(g, mt * 128, nt * 128, lds, epi); }
}

__device__ void ph_headnorm(bf16_t* X, const float* g) {
    const int lane = threadIdx.x & 63, wv = threadIdx.x >> 6;
    const int gw = blockIdx.x * (NTHR / 64) + wv, nw = gridDim.x * (NTHR / 64);
    for (int m = gw; m < NT; m += nw) {
        uint4 raw = *(const uint4*)(X + (size_t)m * AW + lane * 8);
        float v[8] = {bf2f(raw.x & 0xffff), bf2f(raw.x >> 16), bf2f(raw.y & 0xffff), bf2f(raw.y >> 16), bf2f(raw.z & 0xffff), bf2f(raw.z >> 16), bf2f(raw.w & 0xffff), bf2f(raw.w >> 16)};
        float ss = 0.f;
#pragma unroll
        for (int i = 0; i < 8; ++i) ss += v[i] * v[i];
        ss += __shfl_xor(ss, 1); ss += __shfl_xor(ss, 2); ss += __shfl_xor(ss, 4);
        const float rstd = rsqrtf(ss * (1.f / 64.f) + NORM_EPS);
        const int d0 = (lane & 7) * 8;
        unsigned o[4];
#pragma unroll
        for (int i = 0; i < 4; ++i) o[i] = (unsigned)f2bf(v[2 * i] * rstd * g[d0 + 2 * i]) | ((unsigned)f2bf(v[2 * i + 1] * rstd * g[d0 + 2 * i + 1]) << 16);
        *(uint4*)(X + (size_t)m * AW + lane * 8) = make_uint4(o[0], o[1], o[2], o[3]);
    }
}
__device__ void ph_kvnorm(bf16_t* X, const float* g) {
    const int lane = threadIdx.x & 63, wv = threadIdx.x >> 6;
    const int gw = blockIdx.x * (NTHR / 64) + wv, nw = gridDim.x * (NTHR / 64);
    for (int m = gw; m < NT; m += nw) {
        uint2 raw = *(const uint2*)(X + (size_t)m * KVL + lane * 4);
        float v[4] = {bf2f(raw.x & 0xffff), bf2f(raw.x >> 16), bf2f(raw.y & 0xffff), bf2f(raw.y >> 16)};
        float ss = wave_sum(v[0] * v[0] + v[1] * v[1] + v[2] * v[2] + v[3] * v[3]);
        const float rstd = rsqrtf(ss * (1.f / 256.f) + NORM_EPS);
        uint2 o; o.x = (unsigned)f2bf(v[0] * rstd * g[lane * 4]) | ((unsigned)f2bf(v[1] * rstd * g[lane * 4 + 1]) << 16);
        o.y = (unsigned)f2bf(v[2] * rstd * g[lane * 4 + 2]) | ((unsigned)f2bf(v[3] * rstd * g[lane * 4 + 3]) << 16);
        *(uint2*)(X + (size_t)m * KVL + lane * 4) = o;
    }
}

__device__ __forceinline__ unsigned f2key(float f) { unsigned u = __float_as_uint(f); return (u & 0x80000000u) ? ~u : (u | 0x80000000u); }
__device__ void ph_dsa(const P& p, float* lds) {
    const float* IDX = (const float*)(p.ws + WS_IDX);
    const bf16_t* Q = (const bf16_t*)(p.ws + WS_Q); const bf16_t* Kb = (const bf16_t*)(p.ws + WS_K); const bf16_t* Vb = (const bf16_t*)(p.ws + WS_V);
    bf16_t* O = (bf16_t*)(p.ws + WS_OATT);
    unsigned* s_key = (unsigned*)lds;
    float* s_qi = lds + 8192;
    float* s_w = s_qi + 256;
    float* s_q = s_w + 8;
    int* s_sel = (int*)(s_q + 512);
    float* s_lg = (float*)(s_sel + 256);
    unsigned* s_hist = (unsigned*)(s_lg + 2048);
    int* s_misc = (int*)(s_hist + 256);
    float* s_inv = (float*)(s_misc + 16);
    const int tid = threadIdx.x, lane = tid & 63, wv = tid >> 6;
    const float idx_scale = 0.17677669529663687f * 0.35355339059327373f;
    for (int tq = blockIdx.x; tq < NT; tq += gridDim.x) {
        const int b = tq / SEQ, t = tq % SEQ, n = t + 1;
        __syncthreads();
        const float* ir = IDX + (size_t)tq * IDXW;
        if (tid < 256) s_qi[tid] = ir[tid];
        if (tid < 8) s_w[tid] = ir[288 + tid] * idx_scale;
        s_q[tid] = bf2f(Q[(size_t)tq * AW + tid]);
        __syncthreads();
        int nsel;
        if (n <= TOPK) { if (tid < n) s_sel[tid] = tid; nsel = n; __syncthreads(); }
        else {
            for (int s = tid; s < n; s += NTHR) {
                const float4* kp = (const float4*)(IDX + (size_t)(b * SEQ + s) * IDXW + 256);
                float kv[32];
#pragma unroll
                for (int i = 0; i < 8; ++i) { float4 v4 = kp[i]; kv[4 * i] = v4.x; kv[4 * i + 1] = v4.y; kv[4 * i + 2] = v4.z; kv[4 * i + 3] = v4.w; }
                float sc = 0.f;
#pragma unroll 1
                for (int h = 0; h < 8; ++h) { float d = 0.f;
#pragma unroll
                    for (int i = 0; i < 32; ++i) d += s_qi[h * 32 + i] * kv[i];
                    sc += s_w[h] * fmaxf(d, 0.f); }
                s_key[s] = f2key(sc);
            }
            unsigned prefix = 0; int remaining = TOPK; int cnt_eq = 0;
            for (int pass = 0; pass < 4; ++pass) {
                const int shift = 24 - 8 * pass;
                if (tid < 256) s_hist[tid] = 0;
                __syncthreads();
                for (int s = tid; s < n; s += NTHR) { const unsigned k = s_key[s]; if (pass == 0 || (k >> (shift + 8)) == (prefix >> (shift + 8))) atomicAdd(&s_hist[(k >> shift) & 255u], 1u); }
                __syncthreads();
                unsigned hv = 0, suf = 0;
                if (tid < 256) { hv = s_hist[tid]; suf = hv;
#pragma unroll
                    for (int o = 1; o < 64; o <<= 1) { unsigned oth = __shfl_down(suf, o); if (lane + o < 64) suf += oth; }
                    if (lane == 0) s_misc[4 + wv] = (int)suf; }
                __syncthreads();
                if (tid < 256) { for (int w2 = wv + 1; w2 < 4; ++w2) suf += (unsigned)s_misc[4 + w2];
                    const unsigned above = suf - hv;
                    if ((int)above < remaining && remaining <= (int)(above + hv)) { s_misc[0] = tid; s_misc[1] = remaining - (int)above; s_misc[2] = (int)hv; } }
                __syncthreads();
                prefix |= ((unsigned)s_misc[0]) << shift; remaining = s_misc[1]; cnt_eq = s_misc[2];
                __syncthreads();
            }
            if (tid == 0) s_misc[3] = 0;
            __syncthreads();
            for (int s = tid; s < n; s += NTHR) { const unsigned k = s_key[s]; if (k > prefix || (k == prefix && cnt_eq == remaining)) { int pos = atomicAdd(&s_misc[3], 1); s_sel[pos] = s; } }
            __syncthreads();
            if (cnt_eq != remaining && wv == 0) {
                int base = s_misc[3], taken = 0;
                for (int s0 = 0; s0 < n && taken < remaining; s0 += 64) { const int s = s0 + lane; const bool f = (s < n) && (s_key[s] == prefix);
                    const unsigned long long mk = __ballot(f); const int pre = __popcll(mk & ((1ull << lane) - 1ull));
                    if (f && taken + pre < remaining) s_sel[base + taken + pre] = s;
                    taken += __popcll(mk); }
            }
            nsel = TOPK;
            __syncthreads();
        }
        {
            const int j = tid & 255, hh = tid >> 8;
            float lg4[4] = {-INFINITY, -INFINITY, -INFINITY, -INFINITY};
            if (j < nsel) {
                const int s = s_sel[j];
                const uint4* kr = (const uint4*)(Kb + (size_t)(b * SEQ + s) * AW + hh * 256);
#pragma unroll
                for (int h4 = 0; h4 < 4; ++h4) { float d = 0.f; const float* qv = s_q + (hh * 4 + h4) * 64;
#pragma unroll
                    for (int c = 0; c < 8; ++c) { uint4 r = kr[h4 * 8 + c];
                        d += qv[c * 8 + 0] * bf2f(r.x & 0xffff) + qv[c * 8 + 1] * bf2f(r.x >> 16) + qv[c * 8 + 2] * bf2f(r.y & 0xffff) + qv[c * 8 + 3] * bf2f(r.y >> 16)
                           + qv[c * 8 + 4] * bf2f(r.z & 0xffff) + qv[c * 8 + 5] * bf2f(r.z >> 16) + qv[c * 8 + 6] * bf2f(r.w & 0xffff) + qv[c * 8 + 7] * bf2f(r.w >> 16); }
                    const int h = hh * 4 + h4; const float slope = exp2f(-(float)(h + 1));
                    lg4[h4] = d * 0.125f - slope * (float)(t - s); }
            }
#pragma unroll
            for (int h4 = 0; h4 < 4; ++h4) s_lg[(hh * 4 + h4) * 256 + j] = lg4[h4];
        }
        __syncthreads();
        {
            float v[4]; float mx = -INFINITY;
#pragma unroll
            for (int i = 0; i < 4; ++i) { v[i] = s_lg[wv * 256 + lane + 64 * i]; mx = fmaxf(mx, v[i]); }
            mx = wave_max(mx); float sm = 0.f;
#pragma unroll
            for (int i = 0; i < 4; ++i) { v[i] = __expf(v[i] - mx); sm += v[i]; s_lg[wv * 256 + lane + 64 * i] = v[i]; }
            sm = wave_sum(sm);
            if (lane == 0) s_inv[wv] = 1.f / sm;
        }
        __syncthreads();
        {
            float acc = 0.f; const float* pr = s_lg + wv * 256;
            const bf16_t* vb = Vb + (size_t)b * SEQ * AW + tid;
#pragma unroll 8
            for (int j = 0; j < nsel; ++j) acc += pr[j] * bf2f(vb[(size_t)s_sel[j] * AW]);
            O[(size_t)tq * AW + tid] = f2bf(acc * s_inv[wv]);
        }
    }
}

__device__ void ph_rwkv_prep(const P& p, float* lds) {
    const bf16_t* PS = (const bf16_t*)(p.ws + WS_PS);
    const float* mu = p.in[10]; const float* w0 = p.in[11]; const float* w2 = p.in[12]; const float* a0 = p.in[13]; const float* a2 = p.in[14]; const float* g2 = p.in[15];
    const float* k_k = p.in[16]; const float* k_a = p.in[17];
    bf16_t* R = (bf16_t*)(p.ws + WS_R); bf16_t* K2 = (bf16_t*)(p.ws + WS_K2); bf16_t* VV = (bf16_t*)(p.ws + WS_VV); bf16_t* KK = (bf16_t*)(p.ws + WS_KK); bf16_t* BB = (bf16_t*)(p.ws + WS_BB);
    bf16_t* G = (bf16_t*)(p.ws + WS_G); float* DD = (float*)(p.ws + WS_DD);
    float* s_tw = lds; float* s_al = lds + 8 * 64; float* s_sg = lds + 16 * 64;
    const int tid = threadIdx.x;
    for (int grp = blockIdx.x; grp < NT / 8; grp += gridDim.x) {
        const int m0 = grp * 8;
        __syncthreads();
        for (int e = tid; e < 8 * 288; e += NTHR) {
            const int tk = e / 288, c = e % 288, col = 1536 + c, m = m0 + tk;
            const float cur = bf2f(PS[(size_t)m * SHW + col]);
            const float prv = (m % SEQ) ? bf2f(PS[(size_t)(m - 1) * SHW + col]) : 0.f;
            const float mx = cur + (prv - cur) * mu[col];
            if (c < 64) s_tw[tk * 64 + c] = tanhf(mx); else if (c < 128) s_al[tk * 64 + (c - 64)] = mx; else s_sg[tk * 160 + (c - 128)] = sigmoidf_(mx);
        }
        __syncthreads();
        float accw[8], acca[8], accg[8];
#pragma unroll
        for (int i = 0; i < 8; ++i) { accw[i] = 0.f; acca[i] = 0.f; accg[i] = 0.f; }
        for (int i = 0; i < 64; ++i) { const float wv_ = w2[i * RW + tid], av_ = a2[i * RW + tid];
#pragma unroll
            for (int tk = 0; tk < 8; ++tk) { accw[tk] += s_tw[tk * 64 + i] * wv_; acca[tk] += s_al[tk * 64 + i] * av_; } }
        for (int i = 0; i < 160; ++i) { const float gv_ = g2[i * RW + tid];
#pragma unroll
            for (int tk = 0; tk < 8; ++tk) accg[tk] += s_sg[tk * 160 + i] * gv_; }
        const float w0c = w0[tid], a0c = a0[tid], kkc = k_k[tid], kac = k_a[tid], mur = mu[tid], muk = mu[512 + tid], muv = mu[1024 + tid];
#pragma unroll
        for (int tk = 0; tk < 8; ++tk) {
            const int m = m0 + tk; const bool first = (m % SEQ) == 0;
            const bf16_t* cr = PS + (size_t)m * SHW; const bf16_t* pr = PS + (size_t)(m - 1) * SHW;
            const float rc = bf2f(cr[tid]), kc = bf2f(cr[512 + tid]), vc = bf2f(cr[1024 + tid]);
            const float rp = first ? 0.f : bf2f(pr[tid]), kp = first ? 0.f : bf2f(pr[512 + tid]), vp = first ? 0.f : bf2f(pr[1024 + tid]);
            const float r = rc + (rp - rc) * mur, k = kc + (kp - kc) * muk, v = vc + (vp - vc) * muv;
            const float xw = -(w0c + accw[tk]);
            const float sp = fmaxf(xw, 0.f) + log1pf(__expf(-fabsf(xw)));
            const float w = -sp - 0.5f;
            const float dec = __expf(-__expf(w));
            const float a = sigmoidf_(a0c + acca[tk]);
            const float kkr = k * kkc;
            const float ss = wave_sum(kkr * kkr);
            const float kk = kkr / fmaxf(sqrtf(ss), 1e-12f);
            const float k2 = k * (1.f + (a - 1.f) * kac);
            const size_t o = (size_t)m * RW + tid;
            R[o] = f2bf(r); K2[o] = f2bf(k2); VV[o] = f2bf(v); KK[o] = f2bf(kk); BB[o] = f2bf(kk * a); G[o] = f2bf(accg[tk]); DD[o] = dec;
        }
    }
}

__device__ void ph_rwkv_scan(const P& p) {
    const bf16_t* R = (const bf16_t*)(p.ws + WS_R); const bf16_t* K2 = (const bf16_t*)(p.ws + WS_K2); const bf16_t* VV = (const bf16_t*)(p.ws + WS_VV);
    const bf16_t* KK = (const bf16_t*)(p.ws + WS_KK); const bf16_t* BB = (const bf16_t*)(p.ws + WS_BB); const float* DD = (const float*)(p.ws + WS_DD);
    float* YS = (float*)(p.ws + WS_YS);
    const int lane = threadIdx.x & 63, wv = threadIdx.x >> 6;
    for (int item = blockIdx.x; item < 128; item += gridDim.x) {
        const int bh = item >> 3, b = bh >> 3, h = bh & 7, i = (item & 7) * 8 + wv;
        const size_t base = (size_t)b * SEQ * RW + h * 64;
        float s = 0.f;
        float r = bf2f(R[base + lane]), k = bf2f(K2[base + lane]), kk = bf2f(KK[base + lane]), bb = bf2f(BB[base + lane]), d = DD[base + lane], v = bf2f(VV[base + i]);
        for (int t = 0; t < SEQ; ++t) {
            float rn = 0.f, kn = 0.f, kkn = 0.f, bbn = 0.f, dn = 0.f, vn = 0.f;
            if (t + 1 < SEQ) { const size_t o = base + (size_t)(t + 1) * RW;
                rn = bf2f(R[o + lane]); kn = bf2f(K2[o + lane]); kkn = bf2f(KK[o + lane]); bbn = bf2f(BB[o + lane]); dn = DD[o + lane]; vn = bf2f(VV[o + i]); }
            const float sa = -wave_sum(s * kk);
            s = s * d + sa * bb + v * k;
            const float y = wave_sum(s * r);
            if (lane == 0) YS[base + (size_t)t * RW + i] = y;
            r = rn; k = kn; kk = kkn; bb = bbn; d = dn; v = vn;
        }
    }
}

__device__ void ph_rwkv_post(const P& p) {
    const bf16_t* R = (const bf16_t*)(p.ws + WS_R); const bf16_t* K2 = (const bf16_t*)(p.ws + WS_K2); const bf16_t* VV = (const bf16_t*)(p.ws + WS_VV); const bf16_t* G = (const bf16_t*)(p.ws + WS_G);
    const float* YS = (const float*)(p.ws + WS_YS); bf16_t* ORW = (bf16_t*)(p.ws + WS_ORW);
    const float* r_k = p.in[18]; const float* ln_w = p.in[19]; const float* ln_b = p.in[20];
    const int tid = threadIdx.x;
    const float rkc = r_k[tid], lw = ln_w[tid], lb = ln_b[tid];
    for (int m = blockIdx.x; m < NT; m += gridDim.x) {
        const size_t o = (size_t)m * RW + tid;
        const float y = YS[o];
        const float mean = wave_sum(y) * (1.f / 64.f);
        const float dy = y - mean;
        const float var = wave_sum(dy * dy) * (1.f / 64.f);
        const float yn = dy * rsqrtf(var + GN_EPS) * lw + lb;
        const float r = bf2f(R[o]), k2 = bf2f(K2[o]), v = bf2f(VV[o]), g = bf2f(G[o]);
        const float rk = wave_sum(r * k2 * rkc);
        ORW[o] = f2bf((yn + rk * v) * g);
    }
}

__device__ void ph_moe_offsets(const P& p) {
    if (blockIdx.x == 0 && threadIdx.x == 0) {
        int* ctl = (int*)(p.ws + WS_CTL); int off = 0;
        for (int e = 0; e < NE; ++e) { ctl[CT_OFF + e] = off; ctl[CT_CUR + e] = 0; off += (ctl[CT_CNT + e] + 127) / 128 * 128; }
    }
}
__device__ void ph_moe_scatter(const P& p) {
    int* ctl = (int*)(p.ws + WS_CTL); const int* route = (const int*)(p.ws + WS_ROUTE);
    int* ltok = (int*)(p.ws + WS_LTOK); float* lw = (float*)(p.ws + WS_LW);
    for (int m = blockIdx.x * NTHR + threadIdx.x; m < NT; m += gridDim.x * NTHR) {
#pragma unroll
        for (int sl = 0; sl < 2; ++sl) { const int e = route[m * 4 + sl]; const int pos = ctl[CT_OFF + e] + atomicAdd(ctl + CT_CUR + e, 1); ltok[pos] = m; lw[pos] = __int_as_float(route[m * 4 + 2 + sl]); }
    }
}
__device__ void ph_moe1(const P& p, float* lds) {
    const int* ctl = (const int*)(p.ws + WS_CTL);
    for (int t = blockIdx.x; t < NE * 256 * 4; t += gridDim.x) {
        const int nt = t & 3, mt = (t >> 2) & 255, e = t >> 10;
        const int cnt = ctl[CT_CNT + e]; if (mt * 128 >= cnt) continue;
        const int off = ctl[CT_OFF + e];
        GemmArgs g; g.A1 = g.A2 = (const bf16_t*)(p.ws + WS_XN2); g.lda = DM; g.rowidx = (const int*)(p.ws + WS_LTOK) + off; g.rows_valid = cnt;
        g.B1 = p.in[28] + (size_t)e * DM * DE; g.B2 = p.in[29] + (size_t)e * DM * DE; g.ldb = DE; g.K = DM; g.N = DE;
        EpiMoe1 epi{(bf16_t*)(p.ws + WS_HID), (const float*)(p.ws + WS_LW), off, cnt};
        gemm_tile<true, false>(g, mt * 128, nt * 128, lds, epi);
    }
}
__device__ void ph_moe2(const P& p, float* lds) {
    const int* ctl = (const int*)(p.ws + WS_CTL);
    for (int t = blockIdx.x; t < NE * 256 * 8; t += gridDim.x) {
        const int nt = t & 7, mt = (t >> 3) & 255, e = t >> 11;
        const int cnt = ctl[CT_CNT + e]; if (mt * 128 >= cnt) continue;
        const int off = ctl[CT_OFF + e];
        GemmArgs g; g.A1 = g.A2 = (const bf16_t*)(p.ws + WS_HID) + (size_t)off * DE; g.lda = DE; g.rowidx = nullptr; g.rows_valid = cnt;
        g.B1 = g.B2 = p.in[30] + (size_t)e * DE * DM; g.ldb = DM; g.K = DE; g.N = DM;
        EpiMoe2 epi{(const int*)(p.ws + WS_LTOK), (const float*)(p.ws + WS_MOD), p.out, off, cnt};
        gemm_tile<false, false>(g, mt * 128, nt * 128, lds, epi);
    }
}

template <int PH>
__global__ void __launch_bounds__(NTHR) k_phase(P p) {
    extern __shared__ __attribute__((aligned(16))) float lds[];
    if constexpr (PH == 0) ph_mod(p, lds);
    if constexpr (PH == 1) ph_norm<false>(p, p.in[0], p.in[4], 0, (bf16_t*)(p.ws + WS_XN));
    if constexpr (PH == 2) { GemmArgs g; g.A1 = g.A2 = (const bf16_t*)(p.ws + WS_XN); g.lda = DM; g.rowidx = nullptr; g.rows_valid = NT; g.B1 = g.B2 = p.in[5]; g.ldb = INW; g.K = DM; g.N = INW;
        EpiInproj epi{p.ws, p.out}; ph_gemm_plain(g, NT, lds, epi); }
    if constexpr (PH == 3) { ph_headnorm((bf16_t*)(p.ws + WS_Q), p.in[8]); ph_kvnorm((bf16_t*)(p.ws + WS_KVN), p.in[6]); }
    if constexpr (PH == 4) { GemmArgs g; g.A1 = g.A2 = (const bf16_t*)(p.ws + WS_KVN); g.lda = KVL; g.rowidx = nullptr; g.rows_valid = NT; g.B1 = g.B2 = p.in[7]; g.ldb = 2 * AW; g.K = KVL; g.N = 2 * AW;
        EpiKV epi{p.ws}; ph_gemm_plain(g, NT, lds, epi); }
    if constexpr (PH == 5) ph_headnorm((bf16_t*)(p.ws + WS_K), p.in[9]);
    if constexpr (PH == 6) ph_dsa(p, lds);
    if constexpr (PH == 7) ph_rwkv_prep(p, lds);
    if constexpr (PH == 8) ph_rwkv_scan(p);
    if constexpr (PH == 9) ph_rwkv_post(p);
    if constexpr (PH == 10) { GemmArgs g; g.A1 = (const bf16_t*)(p.ws + WS_OATT); g.A2 = (const bf16_t*)(p.ws + WS_ORW); g.lda = AW; g.rowidx = nullptr; g.rows_valid = NT;
        g.B1 = p.in[21]; g.B2 = p.in[22]; g.ldb = DM; g.K = AW; g.N = DM;
        EpiMerge epi{p.ws, p.out};
        const int nmt = NT / 128, nnt = DM / 128;
        for (int t = blockIdx.x; t < nmt * nnt; t += gridDim.x) gemm_tile<true, true>(g, (t % nmt) * 128, (t / nmt) * 128, lds, epi); }
    if constexpr (PH == 11) { GemmArgs g; g.A1 = g.A2 = (const bf16_t*)(p.ws + WS_MERGED); g.lda = DM; g.rowidx = nullptr; g.rows_valid = NT; g.B1 = g.B2 = p.in[23]; g.ldb = DM; g.K = DM; g.N = DM;
        EpiOut epi{p.in[0], (const float*)(p.ws + WS_MOD), p.out}; ph_gemm_plain(g, NT, lds, epi); }
    if constexpr (PH == 12) ph_norm<true>(p, p.out, p.in[24], 1, (bf16_t*)(p.ws + WS_XN2));
    if constexpr (PH == 13) ph_moe_offsets(p);
    if constexpr (PH == 14) ph_moe_scatter(p);
    if constexpr (PH == 15) ph_moe1(p, lds);
    if constexpr (PH == 16) ph_moe2(p, lds);
}
constexpr int LDS_BYTES = 65536;
template <int PH> void launch(const P& p, int grid, hipStream_t st) { hipLaunchKernelGGL(k_phase<PH>, dim3(grid), dim3(NTHR), LDS_BYTES, st, p); }
}

extern "C" void kernel_launch(void* const* d_in, const int* in_sizes, int n_in, void* d_out, int out_size, void* d_ws, size_t ws_size, hipStream_t stream) {
    if (n_in != 31 || out_size != NT * DM || ws_size < WS_END) { fprintf(stderr, "kernel_launch: unexpected shapes (n_in %d out %d ws %zu need %zu)\n", n_in, out_size, ws_size, (size_t)WS_END); return; }
    P p{};
    for (int i = 0; i < 31; ++i) p.in[i] = (const float*)d_in[i];
    p.out = (float*)d_out; p.ws = (unsigned char*)d_ws;
    (void)hipMemsetAsync((char*)d_ws + WS_CTL, 0, 1 * MiB, stream);
    const int G = 512;
    launch<0>(p, 12, stream);
    launch<1>(p, G, stream);
    launch<2>(p, G, stream);
    launch<3>(p, G, stream);
    launch<4>(p, G, stream);
    launch<5>(p, G, stream);
    launch<6>(p, G, stream);
    launch<7>(p, G, stream);
    launch<8>(p, 128, stream);
    launch<9>(p, G, stream);
    launch<10>(p, G, stream);
    launch<11>(p, G, stream);
    launch<12>(p, G, stream);
    launch<13>(p, 1, stream);
    launch<14>(p, 32, stream);
    launch<15>(p, G, stream);
    launch<16>(p, G, stream);
}
```

```cpp
#include <hip/hip_runtime.h>
#include <hip/hip_cooperative_groups.h>
#include <cstdio>
#include <cstdint>

namespace {
constexpr int NB = 2, SEQ = 8192, DM = 1024, NT = NB * SEQ;
constexpr int AW = 512, KVL = 256, NIH = 8, IDD = 32, SHW = 1824, INW = 4936;
constexpr int C_KV = 512, C_QI = 768, C_PS = 1064, C_GA = 2888, C_GR = 3912;
constexpr int IDXW = 296;
constexpr int RW = 512, NE = 32, DE = 512;
constexpr int TOPK = 256;
constexpr float NORM_EPS = 1e-6f, GN_EPS = 64e-5f;
constexpr int NTHR = 512;

typedef unsigned short bf16_t;
__device__ __forceinline__ float bf2f(bf16_t v) { return __uint_as_float(((unsigned)v) << 16); }
__device__ __forceinline__ bf16_t f2bf(float f) { unsigned u = __float_as_uint(f); return (bf16_t)((u + 0x7fffu + ((u >> 16) & 1u)) >> 16); }

constexpr size_t MiB = 1u << 20;
constexpr size_t WS_CTL = 0;
constexpr size_t WS_MOD = 1 * MiB;
constexpr size_t WS_XN = 2 * MiB;
constexpr size_t WS_ORW = 2 * MiB;
constexpr size_t WS_G = 18 * MiB;
constexpr size_t WS_Q = 34 * MiB;
constexpr size_t WS_KVN = 50 * MiB;
constexpr size_t WS_K = 58 * MiB;
constexpr size_t WS_V = 74 * MiB;
constexpr size_t WS_IDX = 90 * MiB;
constexpr size_t WS_PS = 109 * MiB;
constexpr size_t WS_YS = 109 * MiB;
constexpr size_t WS_OATT = 166 * MiB;
constexpr size_t WS_R = 182 * MiB, WS_K2 = 198 * MiB, WS_VV = 214 * MiB, WS_KK = 230 * MiB, WS_BB = 246 * MiB;
constexpr size_t WS_DD = 262 * MiB;
constexpr size_t WS_MERGED = 34 * MiB;
constexpr size_t WS_XN2 = 66 * MiB;
constexpr size_t WS_ROUTE = 98 * MiB;
constexpr size_t WS_LTOK = 99 * MiB;
constexpr size_t WS_LW = 100 * MiB;
constexpr size_t WS_HID = 109 * MiB;
constexpr size_t WS_END = 294 * MiB;
constexpr int HID_ROWS = 36864;
constexpr int CT_CNT = 0, CT_OFF = 64, CT_CUR = 128;

struct P {
    const float* in[31];
    float* out;
    unsigned char* ws;
};

__device__ __forceinline__ float dpp_row_shr(float v, int n) {
    int iv = __builtin_bit_cast(int, v), r;
    switch (n) { case 1: r = __builtin_amdgcn_update_dpp(0, iv, 0x111, 0xf, 0xf, true); break; case 2: r = __builtin_amdgcn_update_dpp(0, iv, 0x112, 0xf, 0xf, true); break;
                 case 4: r = __builtin_amdgcn_update_dpp(0, iv, 0x114, 0xf, 0xf, true); break; default: r = __builtin_amdgcn_update_dpp(0, iv, 0x118, 0xf, 0xf, true); break; }
    return __builtin_bit_cast(float, r);
}
__device__ __forceinline__ float wave_sum(float v) {
    v += dpp_row_shr(v, 1); v += dpp_row_shr(v, 2); v += dpp_row_shr(v, 4); v += dpp_row_shr(v, 8);
    v += __builtin_bit_cast(float, __builtin_amdgcn_update_dpp(0, __builtin_bit_cast(int, v), 0x142, 0xa, 0xf, false));
    v += __builtin_bit_cast(float, __builtin_amdgcn_update_dpp(0, __builtin_bit_cast(int, v), 0x143, 0xc, 0xf, false));
    return __builtin_bit_cast(float, __builtin_amdgcn_readlane(__builtin_bit_cast(int, v), 63));
}
__device__ __forceinline__ float wave_max(float v) {
#pragma unroll
    for (int o = 32; o > 0; o >>= 1) v = fmaxf(v, __shfl_xor(v, o));
    return v;
}
__device__ __forceinline__ float sigmoidf_(float x) { return 1.f / (1.f + __expf(-x)); }

__device__ void ph_mod(const P& p, float* lds) {
    const float* c = p.in[1]; const float* W = p.in[2]; const float* bia = p.in[3];
    float* mod = (float*)(p.ws + WS_MOD);
    for (int i = threadIdx.x; i < NB * DM; i += NTHR) { float v = c[i]; lds[i] = v / (1.f + __expf(-v)); }
    __syncthreads();
    const int gt = blockIdx.x * NTHR + threadIdx.x, gs = gridDim.x * NTHR;
    for (int j = gt; j < 6 * DM; j += gs) {
        float a0 = 0.f, a1 = 0.f;
#pragma unroll 8
        for (int k = 0; k < DM; ++k) { float w = W[(size_t)k * (6 * DM) + j]; a0 += lds[k] * w; a1 += lds[DM + k] * w; }
        mod[j] = a0 + bia[j]; mod[6 * DM + j] = a1 + bia[j];
    }
}

template <bool ROUTE>
__device__ void ph_norm(const P& p, const float* src, const float* g, int which, bf16_t* dst) {
    const float* mod = (const float*)(p.ws + WS_MOD);
    const int lane = threadIdx.x & 63, wv = threadIdx.x >> 6;
    const int gw = blockIdx.x * (NTHR / 64) + wv, nw = gridDim.x * (NTHR / 64);
    for (int m = gw; m < NT; m += nw) {
        const int b = m / SEQ;
        const float* sh = mod + b * 6 * DM + (which ? 3 * DM : 0);
        const float* sc = sh + DM;
        const float4* xr = (const float4*)(src + (size_t)m * DM);
        float4 v[4]; float ss = 0.f;
#pragma unroll
        for (int j = 0; j < 4; ++j) { v[j] = xr[lane + 64 * j]; ss += v[j].x * v[j].x + v[j].y * v[j].y + v[j].z * v[j].z + v[j].w * v[j].w; }
        ss = wave_sum(ss);
        const float rstd = rsqrtf(ss * (1.f / DM) + NORM_EPS);
        float o[16];
#pragma unroll
        for (int j = 0; j < 4; ++j) {
            const int c0 = 4 * (lane + 64 * j);
            const float4 gg = *(const float4*)(g + c0), s1 = *(const float4*)(sc + c0), s0 = *(const float4*)(sh + c0);
            o[4 * j + 0] = v[j].x * rstd * gg.x * (1.f + s1.x) + s0.x; o[4 * j + 1] = v[j].y * rstd * gg.y * (1.f + s1.y) + s0.y;
            o[4 * j + 2] = v[j].z * rstd * gg.z * (1.f + s1.z) + s0.z; o[4 * j + 3] = v[j].w * rstd * gg.w * (1.f + s1.w) + s0.w;
            uint2 pk; pk.x = (unsigned)f2bf(o[4 * j]) | ((unsigned)f2bf(o[4 * j + 1]) << 16); pk.y = (unsigned)f2bf(o[4 * j + 2]) | ((unsigned)f2bf(o[4 * j + 3]) << 16);
            *(uint2*)(dst + (size_t)m * DM + c0) = pk;
        }
        if constexpr (ROUTE) {
            const float* wgr = p.in[25]; const float* wer = p.in[26]; const float* eb = p.in[27];
            float lg[4], le[32];
#pragma unroll
            for (int q = 0; q < 4; ++q) lg[q] = 0.f;
#pragma unroll
            for (int q = 0; q < 32; ++q) le[q] = 0.f;
#pragma unroll
            for (int j = 0; j < 4; ++j)
#pragma unroll
                for (int e = 0; e < 4; ++e) {
                    const int i = 4 * (lane + 64 * j) + e; const float xv = o[4 * j + e];
                    const float4 wg4 = *(const float4*)(wgr + (size_t)i * 4);
                    lg[0] += xv * wg4.x; lg[1] += xv * wg4.y; lg[2] += xv * wg4.z; lg[3] += xv * wg4.w;
                    const float4* we4 = (const float4*)(wer + (size_t)i * 32);
#pragma unroll
                    for (int q = 0; q < 8; ++q) { float4 w = we4[q]; le[4 * q] += xv * w.x; le[4 * q + 1] += xv * w.y; le[4 * q + 2] += xv * w.z; le[4 * q + 3] += xv * w.w; }
                }
#pragma unroll
            for (int q = 0; q < 4; ++q) lg[q] = wave_sum(lg[q]);
#pragma unroll
            for (int q = 0; q < 32; ++q) le[q] = wave_sum(le[q]);
            if (lane == 0) {
                int gs = 0; float mx = lg[0];
#pragma unroll
                for (int q = 1; q < 4; ++q) if (lg[q] > mx) { mx = lg[q]; gs = q; }
                float den = 0.f;
#pragma unroll
                for (int q = 0; q < 4; ++q) den += __expf(lg[q] - mx);
                const float pg = 1.f / den;
                float ev[8];
#pragma unroll
                for (int q = 0; q < 8; ++q) { float a = 0.f;
#pragma unroll
                    for (int gq = 0; gq < 4; ++gq) a = (gs == gq) ? le[gq * 8 + q] : a;
                    ev[q] = a + eb[gs * 8 + q]; }
                int i0 = 0; float v0 = ev[0];
#pragma unroll
                for (int q = 1; q < 8; ++q) if (ev[q] > v0) { v0 = ev[q]; i0 = q; }
                int i1 = -1; float v1 = -INFINITY;
#pragma unroll
                for (int q = 0; q < 8; ++q) if (q != i0 && ev[q] > v1) { v1 = ev[q]; i1 = q; }
                const float e1 = __expf(v1 - v0), w0 = pg / (1.f + e1), w1 = pg * e1 / (1.f + e1);
                int* route = (int*)(p.ws + WS_ROUTE) + (size_t)m * 4;
                route[0] = gs * 8 + i0; route[1] = gs * 8 + i1; route[2] = __float_as_int(w0); route[3] = __float_as_int(w1);
                int* ctl = (int*)(p.ws + WS_CTL);
                atomicAdd(ctl + CT_CNT + gs * 8 + i0, 1); atomicAdd(ctl + CT_CNT + gs * 8 + i1, 1);
            }
        }
    }
}

struct GemmArgs {
    const bf16_t* A1; const bf16_t* A2; int lda;
    const int* rowidx; int rows_valid;
    const float* B1; const float* B2; int ldb;
    int K, N;
};
template <bool DUAL, bool SEPA, class Epi>
__device__ void gemm_tile(const GemmArgs& g, int m0, int n0, float* lds, const Epi& epi) {
    float* As1 = lds; float* As2 = lds + 16 * 132; float* Bs1 = lds + 2 * 16 * 132; float* Bs2 = lds + 3 * 16 * 132;
    const int tid = threadIdx.x, tx = tid & 31, ty = tid >> 5;
    float acc1[8][4], acc2[8][4];
#pragma unroll
    for (int i = 0; i < 8; ++i)
#pragma unroll
        for (int j = 0; j < 4; ++j) { acc1[i][j] = 0.f; acc2[i][j] = 0.f; }
    const int ar = tid >> 2, akq = (tid & 3) * 4;
    long arow;
    { const int rr = m0 + ar; if (g.rowidx) { arow = (rr < g.rows_valid) ? (long)g.rowidx[rr] : -1; } else arow = rr; }
    const int bk = tid >> 5, bn = n0 + (tid & 31) * 4;
    const bool bok = bn < g.N;
    for (int k0 = 0; k0 < g.K; k0 += 16) {
        uint2 a1 = make_uint2(0, 0), a2 = make_uint2(0, 0);
        if (arow >= 0) { a1 = *(const uint2*)(g.A1 + (size_t)arow * g.lda + k0 + akq); if (SEPA) a2 = *(const uint2*)(g.A2 + (size_t)arow * g.lda + k0 + akq); }
        float4 b1 = make_float4(0, 0, 0, 0), b2 = make_float4(0, 0, 0, 0);
        if (bok) { b1 = *(const float4*)(g.B1 + (size_t)(k0 + bk) * g.ldb + bn); if (DUAL) b2 = *(const float4*)(g.B2 + (size_t)(k0 + bk) * g.ldb + bn); }
        __syncthreads();
        As1[(akq + 0) * 132 + ar] = bf2f((bf16_t)(a1.x & 0xffff)); As1[(akq + 1) * 132 + ar] = bf2f((bf16_t)(a1.x >> 16));
        As1[(akq + 2) * 132 + ar] = bf2f((bf16_t)(a1.y & 0xffff)); As1[(akq + 3) * 132 + ar] = bf2f((bf16_t)(a1.y >> 16));
        *(float4*)(Bs1 + bk * 132 + (tid & 31) * 4) = b1;
        if (DUAL) {
            if (SEPA) {
                As2[(akq + 0) * 132 + ar] = bf2f((bf16_t)(a2.x & 0xffff)); As2[(akq + 1) * 132 + ar] = bf2f((bf16_t)(a2.x >> 16));
                As2[(akq + 2) * 132 + ar] = bf2f((bf16_t)(a2.y & 0xffff)); As2[(akq + 3) * 132 + ar] = bf2f((bf16_t)(a2.y >> 16));
            }
            *(float4*)(Bs2 + bk * 132 + (tid & 31) * 4) = b2;
        }
        __syncthreads();
        const float* Asec = SEPA ? As2 : As1;
#pragma unroll 4
        for (int k = 0; k < 16; ++k) {
            const float4 x0 = *(const float4*)(As1 + k * 132 + ty * 8), x1 = *(const float4*)(As1 + k * 132 + ty * 8 + 4);
            const float4 bb = *(const float4*)(Bs1 + k * 132 + tx * 4);
            const float a[8] = {x0.x, x0.y, x0.z, x0.w, x1.x, x1.y, x1.z, x1.w};
            const float bv[4] = {bb.x, bb.y, bb.z, bb.w};
#pragma unroll
            for (int i = 0; i < 8; ++i)
#pragma unroll
                for (int j = 0; j < 4; ++j) acc1[i][j] += a[i] * bv[j];
            if (DUAL) {
                const float4 y0 = *(const float4*)(Asec + k * 132 + ty * 8), y1 = *(const float4*)(Asec + k * 132 + ty * 8 + 4);
                const float4 cc = *(const float4*)(Bs2 + k * 132 + tx * 4);
                const float a2v[8] = {y0.x, y0.y, y0.z, y0.w, y1.x, y1.y, y1.z, y1.w};
                const float cv[4] = {cc.x, cc.y, cc.z, cc.w};
#pragma unroll
                for (int i = 0; i < 8; ++i)
#pragma unroll
                    for (int j = 0; j < 4; ++j) acc2[i][j] += a2v[i] * cv[j];
            }
        }
    }
    __syncthreads();
#pragma unroll
    for (int i = 0; i < 8; ++i)
#pragma unroll
        for (int j = 0; j < 4; ++j) { const int n = n0 + tx * 4 + j; if (n < g.N) epi(m0 + ty * 8 + i, n, acc1[i][j], acc2[i][j]); }
}

struct EpiInproj {
    unsigned char* ws; float* gates;
    __device__ __forceinline__ void operator()(int m, int n, float v, float) const {
        if (n < C_KV) ((bf16_t*)(ws + WS_Q))[(size_t)m * AW + n] = f2bf(v);
        else if (n < C_QI) ((bf16_t*)(ws + WS_KVN))[(size_t)m * KVL + (n - C_KV)] = f2bf(v);
        else if (n < C_PS) ((float*)(ws + WS_IDX))[(size_t)m * IDXW + (n - C_QI)] = v;
        else if (n < C_GA) ((bf16_t*)(ws + WS_PS))[(size_t)m * SHW + (n - C_PS)] = f2bf(v);
        else if (n < C_GR) ((bf16_t*)gates)[(size_t)m * DM + (n - C_GA)] = f2bf(sigmoidf_(v));
        else ((bf16_t*)gates)[(size_t)NT * DM + (size_t)m * DM + (n - C_GR)] = f2bf(sigmoidf_(v));
    }
};
struct EpiKV {
    unsigned char* ws;
    __device__ __forceinline__ void operator()(int m, int n, float v, float) const {
        if (n < AW) ((bf16_t*)(ws + WS_K))[(size_t)m * AW + n] = f2bf(v);
        else ((bf16_t*)(ws + WS_V))[(size_t)m * AW + (n - AW)] = f2bf(v);
    }
};
struct EpiMerge {
    unsigned char* ws; const float* gates;
    __device__ __forceinline__ void operator()(int m, int n, float va, float vr) const {
        const float ga = bf2f(((const bf16_t*)gates)[(size_t)m * DM + n]), gr = bf2f(((const bf16_t*)gates)[(size_t)NT * DM + (size_t)m * DM + n]);
        ((bf16_t*)(ws + WS_MERGED))[(size_t)m * DM + n] = f2bf(ga * va + gr * vr);
    }
};
struct EpiOut {
    const float* x; const float* mod; float* out;
    __device__ __forceinline__ void operator()(int m, int n, float v, float) const {
        const int b = m / SEQ; out[(size_t)m * DM + n] = x[(size_t)m * DM + n] + mod[b * 6 * DM + 2 * DM + n] * v;
    }
};
struct EpiMoe1 {
    bf16_t* hid; const float* lw; int rowbase, cnt;
    __device__ __forceinline__ void operator()(int m, int n, float g, float u) const {
        if (m < cnt) { const float w = lw[rowbase + m]; hid[(size_t)(rowbase + m) * DE + n] = f2bf(w * (g / (1.f + __expf(-g))) * u); }
    }
};
struct EpiMoe2 {
    const int* ltok; const float* mod; float* out; int rowbase, cnt;
    __device__ __forceinline__ void operator()(int m, int n, float v, float) const {
        if (m < cnt) { const int tok = ltok[rowbase + m]; const int b = tok / SEQ; atomicAdd(out + (size_t)tok * DM + n, mod[b * 6 * DM + 5 * DM + n] * v); }
    }
};

template <class Epi>
__device__ void ph_gemm_plain(const GemmArgs& g, int M, float* lds, const Epi& epi) {
    const int nmt = M / 128, nnt = (g.N + 127) / 128;
    for (int t = blockIdx.x; t < nmt * nnt; t += gridDim.x) { const int mt = t % nmt, nt = t / nmt; gemm_tile<false, false>(g, mt * 128, nt * 128, lds, epi); }
}

__device__ void ph_headnorm(bf16_t* X, const float* g) {
    const int lane = threadIdx.x & 63, wv = threadIdx.x >> 6;
    const int gw = blockIdx.x * (NTHR / 64) + wv, nw = gridDim.x * (NTHR / 64);
    for (int m = gw; m < NT; m += nw) {
        uint4 raw = *(const uint4*)(X + (size_t)m * AW + lane * 8);
        float v[8] = {bf2f(raw.x & 0xffff), bf2f(raw.x >> 16), bf2f(raw.y & 0xffff), bf2f(raw.y >> 16), bf2f(raw.z & 0xffff), bf2f(raw.z >> 16), bf2f(raw.w & 0xffff), bf2f(raw.w >> 16)};
        float ss = 0.f;
#pragma unroll
        for (int i = 0; i < 8; ++i) ss += v[i] * v[i];
        ss += __shfl_xor(ss, 1); ss += __shfl_xor(ss, 2); ss += __shfl_xor(ss, 4);
        const float rstd = rsqrtf(ss * (1.f / 64.f) + NORM_EPS);
        const int d0 = (lane & 7) * 8;
        unsigned o[4];
#pragma unroll
        for (int i = 0; i < 4; ++i) o[i] = (unsigned)f2bf(v[2 * i] * rstd * g[d0 + 2 * i]) | ((unsigned)f2bf(v[2 * i + 1] * rstd * g[d0 + 2 * i + 1]) << 16);
        *(uint4*)(X + (size_t)m * AW + lane * 8) = make_uint4(o[0], o[1], o[2], o[3]);
    }
}
__device__ void ph_kvnorm(bf16_t* X, const float* g) {
    const int lane = threadIdx.x & 63, wv = threadIdx.x >> 6;
    const int gw = blockIdx.x * (NTHR / 64) + wv, nw = gridDim.x * (NTHR / 64);
    for (int m = gw; m < NT; m += nw) {
        uint2 raw = *(const uint2*)(X + (size_t)m * KVL + lane * 4);
        float v[4] = {bf2f(raw.x & 0xffff), bf2f(raw.x >> 16), bf2f(raw.y & 0xffff), bf2f(raw.y >> 16)};
        float ss = wave_sum(v[0] * v[0] + v[1] * v[1] + v[2] * v[2] + v[3] * v[3]);
        const float rstd = rsqrtf(ss * (1.f / 256.f) + NORM_EPS);
        uint2 o; o.x = (unsigned)f2bf(v[0] * rstd * g[lane * 4]) | ((unsigned)f2bf(v[1] * rstd * g[lane * 4 + 1]) << 16);
        o.y = (unsigned)f2bf(v[2] * rstd * g[lane * 4 + 2]) | ((unsigned)f2bf(v[3] * rstd * g[lane * 4 + 3]) << 16);
        *(uint2*)(X + (size_t)m * KVL + lane * 4) = o;
    }
}

__device__ __forceinline__ unsigned f2key(float f) { unsigned u = __float_as_uint(f); return (u & 0x80000000u) ? ~u : (u | 0x80000000u); }
__device__ void ph_dsa(const P& p, float* lds) {
    const float* IDX = (const float*)(p.ws + WS_IDX);
    const bf16_t* Q = (const bf16_t*)(p.ws + WS_Q); const bf16_t* Kb = (const bf16_t*)(p.ws + WS_K); const bf16_t* Vb = (const bf16_t*)(p.ws + WS_V);
    bf16_t* O = (bf16_t*)(p.ws + WS_OATT);
    unsigned* s_key = (unsigned*)lds;
    float* s_qi = lds + 8192;
    float* s_w = s_qi + 256;
    float* s_q = s_w + 8;
    int* s_sel = (int*)(s_q + 512);
    float* s_lg = (float*)(s_sel + 256);
    unsigned* s_hist = (unsigned*)(s_lg + 2048);
    int* s_misc = (int*)(s_hist + 256);
    float* s_inv = (float*)(s_misc + 16);
    const int tid = threadIdx.x, lane = tid & 63, wv = tid >> 6;
    const float idx_scale = 0.17677669529663687f * 0.35355339059327373f;
    for (int tq = blockIdx.x; tq < NT; tq += gridDim.x) {
        const int b = tq / SEQ, t = tq % SEQ, n = t + 1;
        __syncthreads();
        const float* ir = IDX + (size_t)tq * IDXW;
        if (tid < 256) s_qi[tid] = ir[tid];
        if (tid < 8) s_w[tid] = ir[288 + tid] * idx_scale;
        s_q[tid] = bf2f(Q[(size_t)tq * AW + tid]);
        __syncthreads();
        int nsel;
        if (n <= TOPK) { if (tid < n) s_sel[tid] = tid; nsel = n; __syncthreads(); }
        else {
            for (int s = tid; s < n; s += NTHR) {
                const float4* kp = (const float4*)(IDX + (size_t)(b * SEQ + s) * IDXW + 256);
                float kv[32];
#pragma unroll
                for (int i = 0; i < 8; ++i) { float4 v4 = kp[i]; kv[4 * i] = v4.x; kv[4 * i + 1] = v4.y; kv[4 * i + 2] = v4.z; kv[4 * i + 3] = v4.w; }
                float sc = 0.f;
#pragma unroll 1
                for (int h = 0; h < 8; ++h) { float d = 0.f;
#pragma unroll
                    for (int i = 0; i < 32; ++i) d += s_qi[h * 32 + i] * kv[i];
                    sc += s_w[h] * fmaxf(d, 0.f); }
                s_key[s] = f2key(sc);
            }
            unsigned prefix = 0; int remaining = TOPK; int cnt_eq = 0;
            for (int pass = 0; pass < 4; ++pass) {
                const int shift = 24 - 8 * pass;
                if (tid < 256) s_hist[tid] = 0;
                __syncthreads();
                for (int s = tid; s < n; s += NTHR) { const unsigned k = s_key[s]; if (pass == 0 || (k >> (shift + 8)) == (prefix >> (shift + 8))) atomicAdd(&s_hist[(k >> shift) & 255u], 1u); }
                __syncthreads();
                unsigned hv = 0, suf = 0;
                if (tid < 256) { hv = s_hist[tid]; suf = hv;
#pragma unroll
                    for (int o = 1; o < 64; o <<= 1) { unsigned oth = __shfl_down(suf, o); if (lane + o < 64) suf += oth; }
                    if (lane == 0) s_misc[4 + wv] = (int)suf; }
                __syncthreads();
                if (tid < 256) { for (int w2 = wv + 1; w2 < 4; ++w2) suf += (unsigned)s_misc[4 + w2];
                    const unsigned above = suf - hv;
                    if ((int)above < remaining && remaining <= (int)(above + hv)) { s_misc[0] = tid; s_misc[1] = remaining - (int)above; s_misc[2] = (int)hv; } }
                __syncthreads();
                prefix |= ((unsigned)s_misc[0]) << shift; remaining = s_misc[1]; cnt_eq = s_misc[2];
                __syncthreads();
            }
            if (tid == 0) s_misc[3] = 0;
            __syncthreads();
            for (int s = tid; s < n; s += NTHR) { const unsigned k = s_key[s]; if (k > prefix || (k == prefix && cnt_eq == remaining)) { int pos = atomicAdd(&s_misc[3], 1); s_sel[pos] = s; } }
            __syncthreads();
            if (cnt_eq != remaining && wv == 0) {
                int base = s_misc[3], taken = 0;
                for (int s0 = 0; s0 < n && taken < remaining; s0 += 64) { const int s = s0 + lane; const bool f = (s < n) && (s_key[s] == prefix);
                    const unsigned long long mk = __ballot(f); const int pre = __popcll(mk & ((1ull << lane) - 1ull));
                    if (f && taken + pre < remaining) s_sel[base + taken + pre] = s;
                    taken += __popcll(mk); }
            }
            nsel = TOPK;
            __syncthreads();
        }
        {
            const int j = tid & 255, hh = tid >> 8;
            float lg4[4] = {-INFINITY, -INFINITY, -INFINITY, -INFINITY};
            if (j < nsel) {
                const int s = s_sel[j];
                const uint4* kr = (const uint4*)(Kb + (size_t)(b * SEQ + s) * AW + hh * 256);
#pragma unroll
                for (int h4 = 0; h4 < 4; ++h4) { float d = 0.f; const float* qv = s_q + (hh * 4 + h4) * 64;
#pragma unroll
                    for (int c = 0; c < 8; ++c) { uint4 r = kr[h4 * 8 + c];
                        d += qv[c * 8 + 0] * bf2f(r.x & 0xffff) + qv[c * 8 + 1] * bf2f(r.x >> 16) + qv[c * 8 + 2] * bf2f(r.y & 0xffff) + qv[c * 8 + 3] * bf2f(r.y >> 16)
                           + qv[c * 8 + 4] * bf2f(r.z & 0xffff) + qv[c * 8 + 5] * bf2f(r.z >> 16) + qv[c * 8 + 6] * bf2f(r.w & 0xffff) + qv[c * 8 + 7] * bf2f(r.w >> 16); }
                    const int h = hh * 4 + h4; const float slope = exp2f(-(float)(h + 1));
                    lg4[h4] = d * 0.125f - slope * (float)(t - s); }
            }
#pragma unroll
            for (int h4 = 0; h4 < 4; ++h4) s_lg[(hh * 4 + h4) * 256 + j] = lg4[h4];
        }
        __syncthreads();
        {
            float v[4]; float mx = -INFINITY;
#pragma unroll
            for (int i = 0; i < 4; ++i) { v[i] = s_lg[wv * 256 + lane + 64 * i]; mx = fmaxf(mx, v[i]); }
            mx = wave_max(mx); float sm = 0.f;
#pragma unroll
            for (int i = 0; i < 4; ++i) { v[i] = __expf(v[i] - mx); sm += v[i]; s_lg[wv * 256 + lane + 64 * i] = v[i]; }
            sm = wave_sum(sm);
            if (lane == 0) s_inv[wv] = 1.f / sm;
        }
        __syncthreads();
        {
            float acc = 0.f; const float* pr = s_lg + wv * 256;
            const bf16_t* vb = Vb + (size_t)b * SEQ * AW + tid;
#pragma unroll 8
            for (int j = 0; j < nsel; ++j) acc += pr[j] * bf2f(vb[(size_t)s_sel[j] * AW]);
            O[(size_t)tq * AW + tid] = f2bf(acc * s_inv[wv]);
        }
    }
}

__device__ void ph_rwkv_prep(const P& p, float* lds) {
    const bf16_t* PS = (const bf16_t*)(p.ws + WS_PS);
    const float* mu = p.in[10]; const float* w0 = p.in[11]; const float* w2 = p.in[12]; const float* a0 = p.in[13]; const float* a2 = p.in[14]; const float* g2 = p.in[15];
    const float* k_k = p.in[16]; const float* k_a = p.in[17];
    bf16_t* R = (bf16_t*)(p.ws + WS_R); bf16_t* K2 = (bf16_t*)(p.ws + WS_K2); bf16_t* VV = (bf16_t*)(p.ws + WS_VV); bf16_t* KK = (bf16_t*)(p.ws + WS_KK); bf16_t* BB = (bf16_t*)(p.ws + WS_BB);
    bf16_t* G = (bf16_t*)(p.ws + WS_G); float* DD = (float*)(p.ws + WS_DD);
    float* s_tw = lds; float* s_al = lds + 8 * 64; float* s_sg = lds + 16 * 64;
    const int tid = threadIdx.x;
    for (int grp = blockIdx.x; grp < NT / 8; grp += gridDim.x) {
        const int m0 = grp * 8;
        __syncthreads();
        for (int e = tid; e < 8 * 288; e += NTHR) {
            const int tk = e / 288, c = e % 288, col = 1536 + c, m = m0 + tk;
            const float cur = bf2f(PS[(size_t)m * SHW + col]);
            const float prv = (m % SEQ) ? bf2f(PS[(size_t)(m - 1) * SHW + col]) : 0.f;
            const float mx = cur + (prv - cur) * mu[col];
            if (c < 64) s_tw[tk * 64 + c] = tanhf(mx); else if (c < 128) s_al[tk * 64 + (c - 64)] = mx; else s_sg[tk * 160 + (c - 128)] = sigmoidf_(mx);
        }
        __syncthreads();
        float accw[8], acca[8], accg[8];
#pragma unroll
        for (int i = 0; i < 8; ++i) { accw[i] = 0.f; acca[i] = 0.f; accg[i] = 0.f; }
        for (int i = 0; i < 64; ++i) { const float wv_ = w2[i * RW + tid], av_ = a2[i * RW + tid];
#pragma unroll
            for (int tk = 0; tk < 8; ++tk) { accw[tk] += s_tw[tk * 64 + i] * wv_; acca[tk] += s_al[tk * 64 + i] * av_; } }
        for (int i = 0; i < 160; ++i) { const float gv_ = g2[i * RW + tid];
#pragma unroll
            for (int tk = 0; tk < 8; ++tk) accg[tk] += s_sg[tk * 160 + i] * gv_; }
        const float w0c = w0[tid], a0c = a0[tid], kkc = k_k[tid], kac = k_a[tid], mur = mu[tid], muk = mu[512 + tid], muv = mu[1024 + tid];
#pragma unroll
        for (int tk = 0; tk < 8; ++tk) {
            const int m = m0 + tk; const bool first = (m % SEQ) == 0;
            const bf16_t* cr = PS + (size_t)m * SHW; const bf16_t* pr = PS + (size_t)(m - 1) * SHW;
            const float rc = bf2f(cr[tid]), kc = bf2f(cr[512 + tid]), vc = bf2f(cr[1024 + tid]);
            const float rp = first ? 0.f : bf2f(pr[tid]), kp = first ? 0.f : bf2f(pr[512 + tid]), vp = first ? 0.f : bf2f(pr[1024 + tid]);
            const float r = rc + (rp - rc) * mur, k = kc + (kp - kc) * muk, v = vc + (vp - vc) * muv;
            const float xw = -(w0c + accw[tk]);
            const float sp = fmaxf(xw, 0.f) + log1pf(__expf(-fabsf(xw)));
            const float w = -sp - 0.5f;
            const float dec = __expf(-__expf(w));
            const float a = sigmoidf_(a0c + acca[tk]);
            const float kkr = k * kkc;
            const float ss = wave_sum(kkr * kkr);
            const float kk = kkr / fmaxf(sqrtf(ss), 1e-12f);
            const float k2 = k * (1.f + (a - 1.f) * kac);
            const size_t o = (size_t)m * RW + tid;
            R[o] = f2bf(r); K2[o] = f2bf(k2); VV[o] = f2bf(v); KK[o] = f2bf(kk); BB[o] = f2bf(kk * a); G[o] = f2bf(accg[tk]); DD[o] = dec;
        }
    }
}

__device__ void ph_rwkv_scan(const P& p) {
    const bf16_t* R = (const bf16_t*)(p.ws + WS_R); const bf16_t* K2 = (const bf16_t*)(p.ws + WS_K2); const bf16_t* VV = (const bf16_t*)(p.ws + WS_VV);
    const bf16_t* KK = (const bf16_t*)(p.ws + WS_KK); const bf16_t* BB = (const bf16_t*)(p.ws + WS_BB); const float* DD = (const float*)(p.ws + WS_DD);
    float* YS = (float*)(p.ws + WS_YS);
    const int lane = threadIdx.x & 63, wv = threadIdx.x >> 6;
    for (int item = blockIdx.x; item < 128; item += gridDim.x) {
        const int bh = item >> 3, b = bh >> 3, h = bh & 7, i = (item & 7) * 8 + wv;
        const size_t base = (size_t)b * SEQ * RW + h * 64;
        float s = 0.f;
        float r = bf2f(R[base + lane]), k = bf2f(K2[base + lane]), kk = bf2f(KK[base + lane]), bb = bf2f(BB[base + lane]), d = DD[base + lane], v = bf2f(VV[base + i]);
        for (int t = 0; t < SEQ; ++t) {
            float rn = 0.f, kn = 0.f, kkn = 0.f, bbn = 0.f, dn = 0.f, vn = 0.f;
            if (t + 1 < SEQ) { const size_t o = base + (size_t)(t + 1) * RW;
                rn = bf2f(R[o + lane]); kn = bf2f(K2[o + lane]); kkn = bf2f(KK[o + lane]); bbn = bf2f(BB[o + lane]); dn = DD[o + lane]; vn = bf2f(VV[o + i]); }
            const float sa = -wave_sum(s * kk);
            s = s * d + sa * bb + v * k;
            const float y = wave_sum(s * r);
            if (lane == 0) YS[base + (size_t)t * RW + i] = y;
            r = rn; k = kn; kk = kkn; bb = bbn; d = dn; v = vn;
        }
    }
}

__device__ void ph_rwkv_post(const P& p) {
    const bf16_t* R = (const bf16_t*)(p.ws + WS_R); const bf16_t* K2 = (const bf16_t*)(p.ws + WS_K2); const bf16_t* VV = (const bf16_t*)(p.ws + WS_VV); const bf16_t* G = (const bf16_t*)(p.ws + WS_G);
    const float* YS = (const float*)(p.ws + WS_YS); bf16_t* ORW = (bf16_t*)(p.ws + WS_ORW);
    const float* r_k = p.in[18]; const float* ln_w = p.in[19]; const float* ln_b = p.in[20];
    const int tid = threadIdx.x;
    const float rkc = r_k[tid], lw = ln_w[tid], lb = ln_b[tid];
    for (int m = blockIdx.x; m < NT; m += gridDim.x) {
        const size_t o = (size_t)m * RW + tid;
        const float y = YS[o];
        const float mean = wave_sum(y) * (1.f / 64.f);
        const float dy = y - mean;
        const float var = wave_sum(dy * dy) * (1.f / 64.f);
        const float yn = dy * rsqrtf(var + GN_EPS) * lw + lb;
        const float r = bf2f(R[o]), k2 = bf2f(K2[o]), v = bf2f(VV[o]), g = bf2f(G[o]);
        const float rk = wave_sum(r * k2 * rkc);
        ORW[o] = f2bf((yn + rk * v) * g);
    }
}

__device__ void ph_moe_offsets(const P& p) {
    if (blockIdx.x == 0 && threadIdx.x == 0) {
        int* ctl = (int*)(p.ws + WS_CTL); int off = 0;
        for (int e = 0; e < NE; ++e) { ctl[CT_OFF + e] = off; ctl[CT_CUR + e] = 0; off += (ctl[CT_CNT + e] + 127) / 128 * 128; }
    }
}
__device__ void ph_moe_scatter(const P& p) {
    int* ctl = (int*)(p.ws + WS_CTL); const int* route = (const int*)(p.ws + WS_ROUTE);
    int* ltok = (int*)(p.ws + WS_LTOK); float* lw = (float*)(p.ws + WS_LW);
    for (int m = blockIdx.x * NTHR + threadIdx.x; m < NT; m += gridDim.x * NTHR) {
#pragma unroll
        for (int sl = 0; sl < 2; ++sl) { const int e = route[m * 4 + sl]; const int pos = ctl[CT_OFF + e] + atomicAdd(ctl + CT_CUR + e, 1); ltok[pos] = m; lw[pos] = __int_as_float(route[m * 4 + 2 + sl]); }
    }
}
__device__ void ph_moe1(const P& p, float* lds) {
    const int* ctl = (const int*)(p.ws + WS_CTL);
    for (int t = blockIdx.x; t < NE * 256 * 4; t += gridDim.x) {
        const int nt = t & 3, mt = (t >> 2) & 255, e = t >> 10;
        const int cnt = ctl[CT_CNT + e]; if (mt * 128 >= cnt) continue;
        const int off = ctl[CT_OFF + e];
        GemmArgs g; g.A1 = g.A2 = (const bf16_t*)(p.ws + WS_XN2); g.lda = DM; g.rowidx = (const int*)(p.ws + WS_LTOK) + off; g.rows_valid = cnt;
        g.B1 = p.in[28] + (size_t)e * DM * DE; g.B2 = p.in[29] + (size_t)e * DM * DE; g.ldb = DE; g.K = DM; g.N = DE;
        EpiMoe1 epi{(bf16_t*)(p.ws + WS_HID), (const float*)(p.ws + WS_LW), off, cnt};
        gemm_tile<true, false>(g, mt * 128, nt * 128, lds, epi);
    }
}
__device__ void ph_moe2(const P& p, float* lds) {
    const int* ctl = (const int*)(p.ws + WS_CTL);
    for (int t = blockIdx.x; t < NE * 256 * 8; t += gridDim.x) {
        const int nt = t & 7, mt = (t >> 3) & 255, e = t >> 11;
        const int cnt = ctl[CT_CNT + e]; if (mt * 128 >= cnt) continue;
        const int off = ctl[CT_OFF + e];
        GemmArgs g; g.A1 = g.A2 = (const bf16_t*)(p.ws + WS_HID) + (size_t)off * DE; g.lda = DE; g.rowidx = nullptr; g.rows_valid = cnt;
        g.B1 = g.B2 = p.in[30] + (size_t)e * DE * DM; g.ldb = DM; g.K = DE; g.N = DM;
        EpiMoe2 epi{(const int*)(p.ws + WS_LTOK), (const float*)(p.ws + WS_MOD), p.out, off, cnt};
        gemm_tile<false, false>(g, mt * 128, nt * 128, lds, epi);
    }
}

template <int PH>
__device__ __forceinline__ void run_phase(const P& p, float* lds) {
    if constexpr (PH == 0) ph_mod(p, lds);
    if constexpr (PH == 1) ph_norm<false>(p, p.in[0], p.in[4], 0, (bf16_t*)(p.ws + WS_XN));
    if constexpr (PH == 2) { GemmArgs g; g.A1 = g.A2 = (const bf16_t*)(p.ws + WS_XN); g.lda = DM; g.rowidx = nullptr; g.rows_valid = NT; g.B1 = g.B2 = p.in[5]; g.ldb = INW; g.K = DM; g.N = INW;
        EpiInproj epi{p.ws, p.out}; ph_gemm_plain(g, NT, lds, epi); }
    if constexpr (PH == 3) { ph_headnorm((bf16_t*)(p.ws + WS_Q), p.in[8]); ph_kvnorm((bf16_t*)(p.ws + WS_KVN), p.in[6]); }
    if constexpr (PH == 4) { GemmArgs g; g.A1 = g.A2 = (const bf16_t*)(p.ws + WS_KVN); g.lda = KVL; g.rowidx = nullptr; g.rows_valid = NT; g.B1 = g.B2 = p.in[7]; g.ldb = 2 * AW; g.K = KVL; g.N = 2 * AW;
        EpiKV epi{p.ws}; ph_gemm_plain(g, NT, lds, epi); }
    if constexpr (PH == 5) ph_headnorm((bf16_t*)(p.ws + WS_K), p.in[9]);
    if constexpr (PH == 6) ph_dsa(p, lds);
    if constexpr (PH == 7) ph_rwkv_prep(p, lds);
    if constexpr (PH == 8) ph_rwkv_scan(p);
    if constexpr (PH == 9) ph_rwkv_post(p);
    if constexpr (PH == 10) { GemmArgs g; g.A1 = (const bf16_t*)(p.ws + WS_OATT); g.A2 = (const bf16_t*)(p.ws + WS_ORW); g.lda = AW; g.rowidx = nullptr; g.rows_valid = NT;
        g.B1 = p.in[21]; g.B2 = p.in[22]; g.ldb = DM; g.K = AW; g.N = DM;
        EpiMerge epi{p.ws, p.out};
        const int nmt = NT / 128, nnt = DM / 128;
        for (int t = blockIdx.x; t < nmt * nnt; t += gridDim.x) gemm_tile<true, true>(g, (t % nmt) * 128, (t / nmt) * 128, lds, epi); }
    if constexpr (PH == 11) { GemmArgs g; g.A1 = g.A2 = (const bf16_t*)(p.ws + WS_MERGED); g.lda = DM; g.rowidx = nullptr; g.rows_valid = NT; g.B1 = g.B2 = p.in[23]; g.ldb = DM; g.K = DM; g.N = DM;
        EpiOut epi{p.in[0], (const float*)(p.ws + WS_MOD), p.out}; ph_gemm_plain(g, NT, lds, epi); }
    if constexpr (PH == 12) ph_norm<true>(p, p.out, p.in[24], 1, (bf16_t*)(p.ws + WS_XN2));
    if constexpr (PH == 13) ph_moe_offsets(p);
    if constexpr (PH == 14) ph_moe_scatter(p);
    if constexpr (PH == 15) ph_moe1(p, lds);
    if constexpr (PH == 16) ph_moe2(p, lds);
}
constexpr int LDS_BYTES = 65536;
constexpr int NPHASE = 17;
template <int PH> __device__ __forceinline__ void run_all(const P& p, float* lds, cooperative_groups::grid_group& grid) {
    run_phase<PH>(p, lds);
    if constexpr (PH + 1 < NPHASE) { grid.sync(); run_all<PH + 1>(p, lds, grid); }
}
__global__ void __launch_bounds__(NTHR) k_mega(P p) {
    extern __shared__ __attribute__((aligned(16))) float lds[];
    cooperative_groups::grid_group grid = cooperative_groups::this_grid();
    run_all<0>(p, lds, grid);
}
}

extern "C" void kernel_launch(void* const* d_in, const int* in_sizes, int n_in, void* d_out, int out_size, void* d_ws, size_t ws_size, hipStream_t stream) {
    if (n_in != 31 || out_size != NT * DM || ws_size < WS_END) { fprintf(stderr, "kernel_launch: unexpected shapes (n_in %d out %d ws %zu need %zu)\n", n_in, out_size, ws_size, (size_t)WS_END); return; }
    P p{};
    for (int i = 0; i < 31; ++i) p.in[i] = (const float*)d_in[i];
    p.out = (float*)d_out; p.ws = (unsigned char*)d_ws;
    (void)hipMemsetAsync((char*)d_ws + WS_CTL, 0, 1 * MiB, stream);
    static int grid_blocks = 0;
    if (!grid_blocks) {
        int dev = 0, cus = 0, per_cu = 0;
        (void)hipGetDevice(&dev);
        (void)hipDeviceGetAttribute(&cus, hipDeviceAttributeMultiprocessorCount, dev);
        (void)hipFuncSetAttribute((const void*)k_mega, hipFuncAttributeMaxDynamicSharedMemorySize, LDS_BYTES);
        (void)hipOccupancyMaxActiveBlocksPerMultiprocessor(&per_cu, (const void*)k_mega, NTHR, LDS_BYTES);
        if (per_cu < 1) per_cu = 1;
        if (per_cu > 2) per_cu = 2;
        grid_blocks = cus * per_cu;
        fprintf(stderr, "kernel_launch: cus %d per_cu %d grid %d\n", cus, per_cu, grid_blocks);
    }
    void* args[] = {&p};
    hipError_t e = hipLaunchCooperativeKernel((const void*)k_mega, dim3(grid_blocks), dim3(NTHR), args, LDS_BYTES, stream);
    if (e != hipSuccess) fprintf(stderr, "cooperative launch failed: %s (grid %d)\n", hipGetErrorString(e), grid_blocks);
}
```

```cpp
#include <hip/hip_runtime.h>
#include <cstdio>
#include <cstdint>

namespace {
constexpr int NB = 2, SEQ = 8192, DM = 1024, NT = NB * SEQ;
constexpr int AW = 512, KVL = 256, NIH = 8, IDD = 32, SHW = 1824, INW = 4936;
constexpr int C_KV = 512, C_QI = 768, C_PS = 1064, C_GA = 2888, C_GR = 3912;
constexpr int IDXW = 296;
constexpr int RW = 512, NE = 32, DE = 512;
constexpr int TOPK = 256;
constexpr float NORM_EPS = 1e-6f, GN_EPS = 64e-5f;
constexpr int NTHR = 512;

typedef unsigned short bf16_t;
__device__ __forceinline__ float bf2f(bf16_t v) { return __uint_as_float(((unsigned)v) << 16); }
__device__ __forceinline__ bf16_t f2bf(float f) { unsigned u = __float_as_uint(f); return (bf16_t)((u + 0x7fffu + ((u >> 16) & 1u)) >> 16); }

constexpr size_t MiB = 1u << 20;
constexpr size_t WS_CTL = 0;
constexpr size_t WS_MOD = 1 * MiB;
constexpr size_t WS_WIN = 2 * MiB;
constexpr size_t WS_WKV = 12 * MiB;
constexpr size_t WS_WBA = 13 * MiB;
constexpr size_t WS_WBR = 14 * MiB;
constexpr size_t WS_WOUT = 15 * MiB;
constexpr size_t WS_XN = 17 * MiB;
constexpr size_t WS_G = 17 * MiB;
constexpr size_t WS_ORW = 33 * MiB;
constexpr size_t WS_Q = 49 * MiB;
constexpr size_t WS_KVN = 65 * MiB;
constexpr size_t WS_K = 73 * MiB;
constexpr size_t WS_V = 89 * MiB;
constexpr size_t WS_IDX = 105 * MiB;
constexpr size_t WS_PS = 124 * MiB;
constexpr size_t WS_YS = 124 * MiB;
constexpr size_t WS_OATT = 181 * MiB;
constexpr size_t WS_R = 49 * MiB, WS_K2 = 65 * MiB, WS_VV = 81 * MiB, WS_KK = 97 * MiB;
constexpr size_t WS_BB = 197 * MiB;
constexpr size_t WS_DD = 213 * MiB;
constexpr size_t WS_MERGED = 197 * MiB;
constexpr size_t WS_XN2 = 229 * MiB;
constexpr size_t WS_WGU = 49 * MiB;
constexpr size_t WS_WDN = 113 * MiB;
constexpr size_t WS_HID = 145 * MiB;
constexpr size_t WS_ROUTE = 193 * MiB;
constexpr size_t WS_LTOK = 194 * MiB;
constexpr size_t WS_LW = 195 * MiB;
constexpr size_t WS_END = 261 * MiB;
constexpr int HID_ROWS = 49152;
constexpr int CT_CNT = 0, CT_OFF = 64, CT_CUR = 128, CT_NU = 192;
constexpr int CT_TAB1 = 1024, CT_TAB2A = 1024 + 4 * 1024, CT_TAB2B = 1024 + 8 * 1024;

struct P {
    const float* in[31];
    float* out;
    unsigned char* ws;
};

__device__ __forceinline__ int otid() { int t = threadIdx.x; asm volatile("" : "+v"(t)); return t; }
__device__ __forceinline__ float dpp_row_shr(float v, int n) {
    int iv = __builtin_bit_cast(int, v), r;
    switch (n) { case 1: r = __builtin_amdgcn_update_dpp(0, iv, 0x111, 0xf, 0xf, true); break; case 2: r = __builtin_amdgcn_update_dpp(0, iv, 0x112, 0xf, 0xf, true); break;
                 case 4: r = __builtin_amdgcn_update_dpp(0, iv, 0x114, 0xf, 0xf, true); break; default: r = __builtin_amdgcn_update_dpp(0, iv, 0x118, 0xf, 0xf, true); break; }
    return __builtin_bit_cast(float, r);
}
__device__ __forceinline__ float wave_sum(float v) {
    v += dpp_row_shr(v, 1); v += dpp_row_shr(v, 2); v += dpp_row_shr(v, 4); v += dpp_row_shr(v, 8);
    v += __builtin_bit_cast(float, __builtin_amdgcn_update_dpp(0, __builtin_bit_cast(int, v), 0x142, 0xa, 0xf, false));
    v += __builtin_bit_cast(float, __builtin_amdgcn_update_dpp(0, __builtin_bit_cast(int, v), 0x143, 0xc, 0xf, false));
    return __builtin_bit_cast(float, __builtin_amdgcn_readlane(__builtin_bit_cast(int, v), 63));
}
__device__ __forceinline__ float wave_max(float v) {
#pragma unroll
    for (int o = 32; o > 0; o >>= 1) v = fmaxf(v, __shfl_xor(v, o));
    return v;
}
__device__ __forceinline__ float sigmoidf_(float x) { return 1.f / (1.f + __expf(-x)); }

#define XB_TMO      128
#define XB_XCNT(j)  (256  + 64 * (j))
#define XB_XSUB(j)  (1280 + 64 * (j))
#define XB_XGEN(j)  (2304 + 64 * (j))
#define XB_TOP      3328
#define XB_TOPGEN   3392
#define XCD_BAR_WORDS 3456
#define XB_SPIN_CAP (1u << 22)
#define LAS3 __attribute__((address_space(3)))
__device__ __forceinline__ unsigned xb_ld(unsigned* p)              { return __hip_atomic_load(p, __ATOMIC_RELAXED, __HIP_MEMORY_SCOPE_AGENT); }
__device__ __forceinline__ unsigned xb_add(unsigned* p, unsigned v) { return __hip_atomic_fetch_add(p, v, __ATOMIC_RELAXED, __HIP_MEMORY_SCOPE_AGENT); }
__device__ __forceinline__ unsigned xb_xcc_id() { return (unsigned)__builtin_amdgcn_s_getreg((3 << 11) | 20) & 0xFu; }
#define XB_SPIN(cond, bar) do { unsigned _sp = 0; while (cond) { __builtin_amdgcn_s_sleep(1); \
    if ((++_sp & 255u) == 0u) { if (xb_ld(&(bar)[XB_TMO])) break; if (_sp > XB_SPIN_CAP) { atomicAdd(&(bar)[XB_TMO], 1u); break; } } } } while (0)
struct XcdBarrier { unsigned* bar; unsigned x; volatile LAS3 unsigned* st; };
__device__ __forceinline__ XcdBarrier xcd_barrier_post(unsigned* bar, volatile LAS3 unsigned* st) {
    XcdBarrier b; b.bar = bar; b.x = xb_xcc_id(); b.st = st;
    if (otid() == 0) (void)xb_add(&bar[XB_XCNT(b.x)], 1u);
    return b;
}
__device__ __forceinline__ void xcd_barrier_complete(unsigned* bar, unsigned x, unsigned& nloc, unsigned& nx) {
    const unsigned G = gridDim.x * gridDim.y * gridDim.z;
    unsigned sum, cnt, mine, sp = 0u;
    for (;;) {
        sum = 0u; cnt = 0u; mine = 0u;
#pragma unroll
        for (unsigned j = 0; j < 16; ++j) { const unsigned c = xb_ld(&bar[XB_XCNT(j)]); sum += c; cnt += (c > 0u) ? 1u : 0u; mine = (j == x) ? c : mine; }
        if (sum == G) break;
        __builtin_amdgcn_s_sleep(1);
        if ((++sp & 255u) == 0u) { if (xb_ld(&bar[XB_TMO])) break; if (sp > XB_SPIN_CAP) { atomicAdd(&bar[XB_TMO], 1u); break; } }
    }
    nloc = mine > 0u ? mine : 1u; nx = cnt > 0u ? cnt : 1u;
}
__device__ __forceinline__ void xcd_barrier(const XcdBarrier& b) {
    asm volatile("s_waitcnt vmcnt(0)" ::: "memory");
    __syncthreads();
    if (otid() == 0) {
        unsigned* bar = b.bar;
        __builtin_amdgcn_s_waitcnt(0);
        unsigned nloc = b.st[0], nx = b.st[1];
        if (nloc == 0u) { xcd_barrier_complete(bar, b.x, nloc, nx); b.st[0] = nloc; b.st[1] = nx; }
        const unsigned old = xb_add(&bar[XB_XSUB(b.x)], 1u);
        const unsigned gen = old / nloc;
        if (old + 1u == (gen + 1u) * nloc) {
            __builtin_amdgcn_fence(__ATOMIC_RELEASE, "agent");
            asm volatile("s_waitcnt vmcnt(0)" ::: "memory");
            const unsigned og = xb_add(&bar[XB_TOP], 1u);
            const unsigned tg = og / nx;
            if (og + 1u == (tg + 1u) * nx) xb_add(&bar[XB_TOPGEN], 1u);
            else XB_SPIN(xb_ld(&bar[XB_TOPGEN]) == tg, bar);
            __builtin_amdgcn_fence(__ATOMIC_ACQUIRE, "agent");
            xb_add(&bar[XB_XGEN(b.x)], 1u);
            asm volatile("s_waitcnt vmcnt(0)" ::: "memory");
        } else {
            XB_SPIN(xb_ld(&bar[XB_XGEN(b.x)]) == gen, bar);
            __builtin_amdgcn_fence(__ATOMIC_ACQUIRE, "agent");
            asm volatile("s_waitcnt vmcnt(0)" ::: "memory");
        }
    }
    __syncthreads();
}

__device__ void ph_mod(const P& p, float* lds) {
    const float* c = p.in[1]; const float* W = p.in[2]; const float* bia = p.in[3];
    float* mod = (float*)(p.ws + WS_MOD);
    for (int i = otid(); i < NB * DM; i += NTHR) { float v = c[i]; lds[i] = v / (1.f + __expf(-v)); }
    __syncthreads();
    const int gt = blockIdx.x * NTHR + otid(), gs = gridDim.x * NTHR;
    for (int j = gt; j < 6 * DM; j += gs) {
        float a0 = 0.f, a1 = 0.f;
#pragma unroll 8
        for (int k = 0; k < DM; ++k) { float w = W[(size_t)k * (6 * DM) + j]; a0 += lds[k] * w; a1 += lds[DM + k] * w; }
        mod[j] = a0 + bia[j]; mod[6 * DM + j] = a1 + bia[j];
    }
}

__device__ void ph_norm(const P& p, const float* src, const float* g, int which, bf16_t* dst) {
    const float* mod = (const float*)(p.ws + WS_MOD);
    const int lane = otid() & 63, wv = otid() >> 6;
    const int gw = blockIdx.x * (NTHR / 64) + wv, nw = gridDim.x * (NTHR / 64);
    for (int m = gw; m < NT; m += nw) {
        const int b = m / SEQ;
        const float* sh = mod + b * 6 * DM + (which ? 3 * DM : 0);
        const float* sc = sh + DM;
        const float4* xr = (const float4*)(src + (size_t)m * DM);
        float4 v[4]; float ss = 0.f;
#pragma unroll
        for (int j = 0; j < 4; ++j) { v[j] = xr[lane + 64 * j]; ss += v[j].x * v[j].x + v[j].y * v[j].y + v[j].z * v[j].z + v[j].w * v[j].w; }
        ss = wave_sum(ss);
        const float rstd = rsqrtf(ss * (1.f / DM) + NORM_EPS);
        float o[16];
#pragma unroll
        for (int j = 0; j < 4; ++j) {
            int c0 = 4 * (lane + 64 * j); asm volatile("" : "+v"(c0));
            const float4 gg = *(const float4*)(g + c0), s1 = *(const float4*)(sc + c0), s0 = *(const float4*)(sh + c0);
            o[4 * j + 0] = v[j].x * rstd * gg.x * (1.f + s1.x) + s0.x; o[4 * j + 1] = v[j].y * rstd * gg.y * (1.f + s1.y) + s0.y;
            o[4 * j + 2] = v[j].z * rstd * gg.z * (1.f + s1.z) + s0.z; o[4 * j + 3] = v[j].w * rstd * gg.w * (1.f + s1.w) + s0.w;
            uint2 pk; pk.x = (unsigned)f2bf(o[4 * j]) | ((unsigned)f2bf(o[4 * j + 1]) << 16); pk.y = (unsigned)f2bf(o[4 * j + 2]) | ((unsigned)f2bf(o[4 * j + 3]) << 16);
            *(uint2*)(dst + (size_t)m * DM + c0) = pk;
        }
    }
}

__device__ void ph_norm_route(const P& p, float* lds) {
    const float* mod = (const float*)(p.ws + WS_MOD); const float* src = p.out; const float* g = p.in[24]; bf16_t* dst = (bf16_t*)(p.ws + WS_XN2);
    const float* wgr = p.in[25]; const float* wer = p.in[26]; const float* eb = p.in[27];
    const int tid = otid(), lane = tid & 63, wv = tid >> 6;
    float* sx = lds + wv * 4096;
    const int gw = blockIdx.x * (NTHR / 64) + wv, nw = gridDim.x * (NTHR / 64);
    for (int m0 = gw * 4; m0 < NT; m0 += nw * 4) {
        const int b = m0 / SEQ;
        const float* sh = mod + b * 6 * DM + 3 * DM; const float* sc = sh + DM;
#pragma unroll 1
        for (int tk = 0; tk < 4; ++tk) {
            const int m = m0 + tk;
            const float4* xr = (const float4*)(src + (size_t)m * DM);
            float4 v[4]; float ss = 0.f;
#pragma unroll
            for (int j = 0; j < 4; ++j) { v[j] = xr[lane + 64 * j]; ss += v[j].x * v[j].x + v[j].y * v[j].y + v[j].z * v[j].z + v[j].w * v[j].w; }
            ss = wave_sum(ss);
            const float rstd = rsqrtf(ss * (1.f / DM) + NORM_EPS);
#pragma unroll
            for (int j = 0; j < 4; ++j) {
                const int c0 = 4 * (lane + 64 * j);
                const float4 gg = *(const float4*)(g + c0), s1 = *(const float4*)(sc + c0), s0 = *(const float4*)(sh + c0);
                const float o0 = v[j].x * rstd * gg.x * (1.f + s1.x) + s0.x, o1 = v[j].y * rstd * gg.y * (1.f + s1.y) + s0.y;
                const float o2 = v[j].z * rstd * gg.z * (1.f + s1.z) + s0.z, o3 = v[j].w * rstd * gg.w * (1.f + s1.w) + s0.w;
                uint2 pk; pk.x = (unsigned)f2bf(o0) | ((unsigned)f2bf(o1) << 16); pk.y = (unsigned)f2bf(o2) | ((unsigned)f2bf(o3) << 16);
                *(uint2*)(dst + (size_t)m * DM + c0) = pk;
                sx[(c0 + 0) * 4 + tk] = o0; sx[(c0 + 1) * 4 + tk] = o1; sx[(c0 + 2) * 4 + tk] = o2; sx[(c0 + 3) * 4 + tk] = o3;
            }
        }
        __builtin_amdgcn_wave_barrier(); asm volatile("s_waitcnt lgkmcnt(0)" ::: "memory");
        float ae[4] = {0.f, 0.f, 0.f, 0.f}, ag[4] = {0.f, 0.f, 0.f, 0.f};
        { const int e = lane & 31, kb = (lane >> 5) * 512;
#pragma unroll 8
          for (int i = 0; i < 512; ++i) { const float w = wer[(size_t)(kb + i) * 32 + e]; const float4 xv = *(const float4*)(sx + (kb + i) * 4);
              ae[0] += xv.x * w; ae[1] += xv.y * w; ae[2] += xv.z * w; ae[3] += xv.w * w; } }
        { const int gq = lane & 3, kb = (lane >> 2) * 64;
#pragma unroll 8
          for (int i = 0; i < 64; ++i) { const float w = wgr[(size_t)(kb + i) * 4 + gq]; const float4 xv = *(const float4*)(sx + (kb + i) * 4);
              ag[0] += xv.x * w; ag[1] += xv.y * w; ag[2] += xv.z * w; ag[3] += xv.w * w; } }
#pragma unroll
        for (int tk = 0; tk < 4; ++tk) {
            ae[tk] += __shfl_xor(ae[tk], 32);
            ag[tk] += __shfl_xor(ag[tk], 4); ag[tk] += __shfl_xor(ag[tk], 8); ag[tk] += __shfl_xor(ag[tk], 16); ag[tk] += __shfl_xor(ag[tk], 32);
        }
#pragma unroll
        for (int tk = 0; tk < 4; ++tk) {
            float lg[4];
#pragma unroll
            for (int q = 0; q < 4; ++q) lg[q] = __shfl(ag[tk], q);
            int gs = 0; float mx = lg[0];
#pragma unroll
            for (int q = 1; q < 4; ++q) if (lg[q] > mx) { mx = lg[q]; gs = q; }
            float den = 0.f;
#pragma unroll
            for (int q = 0; q < 4; ++q) den += __expf(lg[q] - mx);
            const float pg = 1.f / den;
            float ev[8];
#pragma unroll
            for (int q = 0; q < 8; ++q) ev[q] = __shfl(ae[tk], gs * 8 + q) + eb[gs * 8 + q];
            int i0 = 0; float v0 = ev[0];
#pragma unroll
            for (int q = 1; q < 8; ++q) if (ev[q] > v0) { v0 = ev[q]; i0 = q; }
            int i1 = -1; float v1 = -INFINITY;
#pragma unroll
            for (int q = 0; q < 8; ++q) if (q != i0 && ev[q] > v1) { v1 = ev[q]; i1 = q; }
            if (lane == 0) {
                const float e1 = __expf(v1 - v0), w0 = pg / (1.f + e1), w1 = pg * e1 / (1.f + e1);
                int* route = (int*)(p.ws + WS_ROUTE) + (size_t)(m0 + tk) * 4;
                route[0] = gs * 8 + i0; route[1] = gs * 8 + i1; route[2] = __float_as_int(w0); route[3] = __float_as_int(w1);
                int* ctl = (int*)(p.ws + WS_CTL);
                atomicAdd(ctl + CT_CNT + gs * 8 + i0, 1); atomicAdd(ctl + CT_CNT + 32 + gs * 8 + i1, 1);
            }
        }
        __builtin_amdgcn_wave_barrier();
    }
}

namespace pg8 {
#define PG8_LAS __attribute__((address_space(3)))
typedef short bf16x8 __attribute__((ext_vector_type(8)));
typedef float f32x4 __attribute__((ext_vector_type(4)));
typedef unsigned u32x4 __attribute__((ext_vector_type(4)));
constexpr int BM = 256, BK = 64, HALF = 128, HTB = HALF * BK * 2, STAGE_BYTES = 8 * HTB, NXCD = 8, WGM = 8;
__host__ __device__ __forceinline__ int lds_byte(int r, int c) { const int st = (r >> 4) * 2 + (c >> 5), rr = r & 15, cc = c & 31, ob = rr * 64 + cc * 2; return st * 1024 + (ob ^ (((ob >> 9) & 1) << 5)); }
__host__ __device__ __forceinline__ void stage_rc(int b, int& R, int& C) { const int st = b / 1024, sb = b % 1024, swz = sb ^ (((sb >> 9) & 1) << 5); R = (st >> 1) * 16 + swz / 64; C = (st & 1) * 32 + (swz % 64) / 2; }
__host__ __device__ __forceinline__ int perm32(int rho) { const int n = rho >> 4, i = rho & 15; return 8 * (i >> 2) + 4 * n + (i & 3); }

struct Unit { int arow, brow, pm, pn, aux; };
struct Gemm { const bf16_t* A; const bf16_t* Bt; int K; const int* gather; };

struct StaticOrder {
    int nM, nN, nwg, G, c;
    __device__ void init(int M, int N, int G_, int c_) { nM = M / BM; nN = N / BM; nwg = nM * nN; G = G_; c = c_; }
    __device__ bool next(int i, Unit& u) const {
        const long L = (long)i * G + c; if (L >= nwg) return false;
        int wgid = (int)L; { const int q = nwg / NXCD, r = nwg % NXCD, xcd = wgid % NXCD, off = wgid / NXCD; wgid = (xcd < r ? xcd * (q + 1) : r * (q + 1) + (xcd - r) * q) + off; }
        const int nig = WGM * nN, gid = wgid / nig, fm = gid * WGM, gsz = (nM - fm) < WGM ? (nM - fm) : WGM;
        u.pm = fm + ((wgid % nig) % gsz); u.pn = (wgid % nig) / gsz; u.arow = u.pm * BM; u.brow = u.pn * BM; u.aux = 0; return true;
    }
};
struct TableOrder {
    const int4* tab; int n, G, c;
    __device__ bool next(int i, Unit& u) const {
        const int L = i * G + c; if (L >= n) return false;
        const int4 e = tab[L]; u.arow = __builtin_amdgcn_readfirstlane(e.x); u.brow = __builtin_amdgcn_readfirstlane(e.y); u.aux = __builtin_amdgcn_readfirstlane(e.z); u.pn = __builtin_amdgcn_readfirstlane(e.w); u.pm = 0; return true;
    }
};
__device__ __forceinline__ unsigned cvt_pk_bf16(float lo, float hi) { unsigned r; asm volatile("v_cvt_pk_bf16_f32 %0, %1, %2" : "=v"(r) : "v"(lo), "v"(hi)); return r; }

template <class Epi, class Sched>
__device__ __forceinline__ void gemm_phase(PG8_LAS unsigned char* lds, const Gemm g, const Sched& S, const Epi& E) {
    const int tid = otid(), wid = __builtin_amdgcn_readfirstlane(tid >> 6), lane = tid & 63, wr = wid >> 2, wc = wid & 3, fr = lane & 15, fq = lane >> 4;
    const int K = g.K, nt = K / BK;
    int RA0; unsigned cofA0, voffB0;
    { int R, C; stage_rc(tid * 16, R, C); const int Rb = Epi::PERM ? ((R & ~31) + perm32(R & 31)) : R; RA0 = R; cofA0 = (unsigned)C * 2u; voffB0 = (unsigned)(Rb * K + C) * 2u; }
    const size_t rstep64 = (size_t)64 * K * 2;
    const size_t kstep = (size_t)(BK * 2);
    const size_t hstep = (size_t)HALF * K * 2;
    const unsigned ldsw = (unsigned)wid * 1024u;
    const int aoff = lds_byte(wr * 64 + fr, fq * 8), boff = lds_byte(wc * 32 + fr, fq * 8);
#define PG8_SA(b, h) (((b) * 2 + (h)) * HTB)
#define PG8_SB(b, h) ((4 + (b) * 2 + (h)) * HTB)
#define PG8_STAGE_B(bufoff, gbase) do { _Pragma("unroll") for (int _i = 0; _i < 2; ++_i) \
        __builtin_amdgcn_global_load_lds((const unsigned*)((const char*)(gbase) + _i * rstep64 + voffB0), (PG8_LAS unsigned*)(lds + (bufoff) + ldsw + _i * 8192), 16, 0, 0); } while (0)
#define PG8_STAGE_A(bufoff, o2, kb) do { _Pragma("unroll") for (int _i = 0; _i < 2; ++_i) \
        __builtin_amdgcn_global_load_lds((const unsigned*)((const char*)g.A + (size_t)(o2)[_i] + (size_t)(kb)), (PG8_LAS unsigned*)(lds + (bufoff) + ldsw + _i * 8192), 16, 0, 0); } while (0)
#define PG8_LDA(dst, b, h) do { _Pragma("unroll") for (int m = 0; m < 4; ++m) _Pragma("unroll") for (int k = 0; k < 2; ++k) dst[m][k] = *(const PG8_LAS bf16x8*)(lds + PG8_SA(b, h) + aoff + m * 2048 + k * 1024); } while (0)
#define PG8_LDB(dst, b, h) do { _Pragma("unroll") for (int n = 0; n < 2; ++n) _Pragma("unroll") for (int k = 0; k < 2; ++k) dst[n][k] = *(const PG8_LAS bf16x8*)(lds + PG8_SB(b, h) + boff + n * 2048 + k * 1024); } while (0)
#define PG8_MMA(ai, bj, At, Bt) do { __builtin_amdgcn_s_setprio(1); _Pragma("unroll") for (int m = 0; m < 4; ++m) _Pragma("unroll") for (int n = 0; n < 2; ++n) _Pragma("unroll") for (int k = 0; k < 2; ++k) \
        acc[ai][bj][m][n] = __builtin_amdgcn_mfma_f32_16x16x32_bf16(Bt[n][k], At[m][k], acc[ai][bj][m][n], 0, 0, 0); __builtin_amdgcn_s_setprio(0); } while (0)
#define PG8_WAIT_V(n) asm volatile("s_waitcnt vmcnt(" #n ")" ::: "memory")
#define PG8_WAIT_L(n) asm volatile("s_waitcnt lgkmcnt(" #n ")" ::: "memory")
#define PG8_BAR __builtin_amdgcn_s_barrier()
#define PG8_SCHED __builtin_amdgcn_sched_barrier(0)
#define PG8_AOFFS(u, dst) do { _Pragma("unroll") for (int _h = 0; _h < 2; ++_h) _Pragma("unroll") for (int _i = 0; _i < 2; ++_i) { \
        const int _tr = (u).arow + _h * HALF + RA0 + 64 * _i; const unsigned _row = g.gather ? (unsigned)g.gather[_tr] : (unsigned)_tr; dst[_h][_i] = _row * (unsigned)(K * 2) + cofA0; } } while (0)
    Unit cur, nxt; int ui = 0;
    if (!S.next(0, cur)) return;
    f32x4 acc[2][2][4][2];
#pragma unroll
    for (int a = 0; a < 2; ++a)
#pragma unroll
        for (int b = 0; b < 2; ++b)
#pragma unroll
            for (int m = 0; m < 4; ++m)
#pragma unroll
                for (int n = 0; n < 2; ++n) acc[a][b][m][n] = (f32x4){0.f, 0.f, 0.f, 0.f};
    bf16x8 At[4][2], B0[2][2], B1[2][2];
    unsigned cof[2][2];
    PG8_AOFFS(cur, cof);
    const char* cB = (const char*)g.Bt + (size_t)cur.brow * K * 2;
    PG8_STAGE_B(PG8_SB(0, 0), cB); PG8_STAGE_B(PG8_SB(0, 1), cB + hstep); PG8_STAGE_A(PG8_SA(0, 0), cof[0], 0); PG8_STAGE_A(PG8_SA(0, 1), cof[1], 0);
    if (wr == 1) PG8_BAR;
    PG8_WAIT_V(2); PG8_BAR;
    PG8_STAGE_B(PG8_SB(1, 0), cB + kstep); PG8_STAGE_A(PG8_SA(1, 0), cof[0], kstep); PG8_STAGE_B(PG8_SB(1, 1), cB + hstep + kstep);
    PG8_WAIT_V(6); PG8_BAR;
    for (;;) {
        const bool has_next = S.next(ui + 1, nxt);
        if (!has_next) nxt = cur;
        const char* nB = (const char*)g.Bt + (size_t)nxt.brow * K * 2;
        for (int t = 0; t < nt; t += 2) {
            const bool last = (t == nt - 2);
            const size_t k1 = (size_t)(t + 1) * kstep;
            const size_t k2 = last ? 0 : (size_t)(t + 2) * kstep, k3 = k2 + kstep;
            const char* b2 = last ? nB : cB + (size_t)(t + 2) * kstep; const char* b3 = b2 + kstep;
            PG8_LDB(B0, 0, 0); PG8_LDB(B1, 0, 1); PG8_SCHED; PG8_LDA(At, 0, 0); PG8_STAGE_A(PG8_SA(1, 1), cof[1], k1);
            if (last) { PG8_AOFFS(nxt, cof); }
            PG8_WAIT_V(8); PG8_WAIT_L(0); PG8_BAR; PG8_MMA(0, 0, At, B0); PG8_MMA(0, 1, At, B1); PG8_BAR; PG8_SCHED;
            PG8_LDA(At, 0, 1); PG8_STAGE_B(PG8_SB(0, 0), b2); PG8_STAGE_B(PG8_SB(0, 1), b2 + hstep); PG8_STAGE_A(PG8_SA(0, 0), cof[0], k2);
            PG8_WAIT_V(8); PG8_WAIT_L(0); PG8_BAR; PG8_MMA(1, 0, At, B0); PG8_MMA(1, 1, At, B1); PG8_BAR; PG8_SCHED;
            PG8_LDB(B0, 1, 0); PG8_LDB(B1, 1, 1); PG8_SCHED; PG8_LDA(At, 1, 0); PG8_STAGE_A(PG8_SA(0, 1), cof[1], k2);
            PG8_WAIT_V(8); PG8_WAIT_L(0); PG8_BAR; PG8_MMA(0, 0, At, B0); PG8_MMA(0, 1, At, B1); PG8_BAR; PG8_SCHED;
            PG8_LDA(At, 1, 1); PG8_STAGE_B(PG8_SB(1, 0), b3); PG8_STAGE_B(PG8_SB(1, 1), b3 + hstep); PG8_STAGE_A(PG8_SA(1, 0), cof[0], k3);
            PG8_WAIT_V(8); PG8_WAIT_L(0); PG8_BAR; PG8_MMA(1, 0, At, B0); PG8_MMA(1, 1, At, B1); PG8_BAR; PG8_SCHED;
        }
        if (wr == 0) PG8_BAR;
        { const int l2 = otid() & 63; E(acc, cur, wr, wc, l2 & 15, l2 >> 4); }
        if (!has_next) break;
#pragma unroll
        for (int a = 0; a < 2; ++a)
#pragma unroll
            for (int b = 0; b < 2; ++b)
#pragma unroll
                for (int m = 0; m < 4; ++m)
#pragma unroll
                    for (int n = 0; n < 2; ++n) acc[a][b][m][n] = (f32x4){0.f, 0.f, 0.f, 0.f};
        cur = nxt; cB = nB; ++ui;
        if (wr == 1) PG8_BAR;
    }
    PG8_WAIT_V(0);
    PG8_BAR;
#undef PG8_SA
#undef PG8_SB
#undef PG8_STAGE_A
#undef PG8_STAGE_B
#undef PG8_LDA
#undef PG8_LDB
#undef PG8_MMA
#undef PG8_WAIT_V
#undef PG8_WAIT_L
#undef PG8_BAR
#undef PG8_SCHED
#undef PG8_AOFFS
}

#define PG8_FENCE asm volatile("" ::: "memory")
#define PG8_FOR_TILE(ai, m, bj) _Pragma("unroll") for (int ai = 0; ai < 2; ++ai) _Pragma("unroll") for (int m = 0; m < 4; ++m) _Pragma("unroll") for (int bj = 0; bj < 2; ++bj)
__device__ __forceinline__ u32x4 pack8(const f32x4& v0, const f32x4& v1) { u32x4 w; w.x = cvt_pk_bf16(v0[0], v0[1]); w.y = cvt_pk_bf16(v0[2], v0[3]); w.z = cvt_pk_bf16(v1[0], v1[1]); w.w = cvt_pk_bf16(v1[2], v1[3]); return w; }
__device__ __forceinline__ float sigm(float x) { return 1.f / (1.f + __expf(-x)); }
struct EpiInproj {
    static constexpr bool PERM = true;
    unsigned char* ws; bf16_t* gates;
    __device__ __forceinline__ void operator()(const f32x4 (&acc)[2][2][4][2], const Unit& u, int wr, int wc, int fr, int fq) const {
        PG8_FOR_TILE(ai, m, bj) { PG8_FENCE;
            int row = u.pm * BM + ai * HALF + wr * 64 + m * 16 + fr; asm volatile("" : "+v"(row)); const int col = u.pn * BM + bj * HALF + wc * 32 + 8 * fq;
            const f32x4 v0 = acc[ai][bj][m][0], v1 = acc[ai][bj][m][1];
            if (col < C_KV) *(u32x4*)((bf16_t*)(ws + WS_Q) + (size_t)row * AW + col) = pack8(v0, v1);
            else if (col < C_QI) *(u32x4*)((bf16_t*)(ws + WS_KVN) + (size_t)row * KVL + (col - C_KV)) = pack8(v0, v1);
            else if (col < C_PS) { float* d = (float*)(ws + WS_IDX) + (size_t)row * IDXW + (col - C_QI); *(f32x4*)d = v0; *(f32x4*)(d + 4) = v1; }
            else if (col < C_GA) *(u32x4*)((bf16_t*)(ws + WS_PS) + (size_t)row * SHW + (col - C_PS)) = pack8(v0, v1);
            else if (col < INW) {
                f32x4 s0, s1;
#pragma unroll
                for (int e = 0; e < 4; ++e) { s0[e] = sigm(v0[e]); s1[e] = sigm(v1[e]); }
                bf16_t* d = (col < C_GR) ? gates + (size_t)row * DM + (col - C_GA) : gates + (size_t)NT * DM + (size_t)row * DM + (col - C_GR);
                *(u32x4*)d = pack8(s0, s1);
            }
        }
    }
};
struct EpiKV {
    static constexpr bool PERM = true;
    unsigned char* ws;
    __device__ __forceinline__ void operator()(const f32x4 (&acc)[2][2][4][2], const Unit& u, int wr, int wc, int fr, int fq) const {
        PG8_FOR_TILE(ai, m, bj) { PG8_FENCE;
            int row = u.pm * BM + ai * HALF + wr * 64 + m * 16 + fr; asm volatile("" : "+v"(row)); const int col = u.pn * BM + bj * HALF + wc * 32 + 8 * fq;
            bf16_t* d = (col < AW) ? (bf16_t*)(ws + WS_K) + (size_t)row * AW + col : (bf16_t*)(ws + WS_V) + (size_t)row * AW + (col - AW);
            *(u32x4*)d = pack8(acc[ai][bj][m][0], acc[ai][bj][m][1]);
        }
    }
};
template <bool SECOND> struct EpiMerge {
    static constexpr bool PERM = true;
    bf16_t* merged; const bf16_t* gate;
    __device__ __forceinline__ void operator()(const f32x4 (&acc)[2][2][4][2], const Unit& u, int wr, int wc, int fr, int fq) const {
        PG8_FOR_TILE(ai, m, bj) { PG8_FENCE;
            int row = u.pm * BM + ai * HALF + wr * 64 + m * 16 + fr; asm volatile("" : "+v"(row)); const int col = u.pn * BM + bj * HALF + wc * 32 + 8 * fq;
            const u32x4 gw = *(const u32x4*)(gate + (size_t)row * DM + col);
            f32x4 v0 = acc[ai][bj][m][0], v1 = acc[ai][bj][m][1];
            v0[0] *= __uint_as_float(gw.x << 16); v0[1] *= __uint_as_float(gw.x & 0xffff0000u); v0[2] *= __uint_as_float(gw.y << 16); v0[3] *= __uint_as_float(gw.y & 0xffff0000u);
            v1[0] *= __uint_as_float(gw.z << 16); v1[1] *= __uint_as_float(gw.z & 0xffff0000u); v1[2] *= __uint_as_float(gw.w << 16); v1[3] *= __uint_as_float(gw.w & 0xffff0000u);
            u32x4* d = (u32x4*)(merged + (size_t)row * DM + col);
            if (SECOND) { const u32x4 pw = *d;
                v0[0] += __uint_as_float(pw.x << 16); v0[1] += __uint_as_float(pw.x & 0xffff0000u); v0[2] += __uint_as_float(pw.y << 16); v0[3] += __uint_as_float(pw.y & 0xffff0000u);
                v1[0] += __uint_as_float(pw.z << 16); v1[1] += __uint_as_float(pw.z & 0xffff0000u); v1[2] += __uint_as_float(pw.w << 16); v1[3] += __uint_as_float(pw.w & 0xffff0000u); }
            *d = pack8(v0, v1);
        }
    }
};
struct EpiOut {
    static constexpr bool PERM = false;
    const float* x; const float* mod; float* out;
    __device__ __forceinline__ void operator()(const f32x4 (&acc)[2][2][4][2], const Unit& u, int wr, int wc, int fr, int fq) const {
        PG8_FOR_TILE(ai, m, bj) { PG8_FENCE;
            int row = u.pm * BM + ai * HALF + wr * 64 + m * 16 + fr; asm volatile("" : "+v"(row)); const float* gt = mod + (row / SEQ) * 6 * DM + 2 * DM;
#pragma unroll
            for (int n = 0; n < 2; ++n) { const int col = u.pn * BM + bj * HALF + wc * 32 + 16 * n + 4 * fq;
                const f32x4 xv = *(const f32x4*)(x + (size_t)row * DM + col), gv = *(const f32x4*)(gt + col);
                *(f32x4*)(out + (size_t)row * DM + col) = xv + gv * acc[ai][bj][m][n]; }
        }
    }
};
struct EpiMoe1 {
    static constexpr bool PERM = true;
    bf16_t* hid; const float* lw;
    __device__ __forceinline__ void operator()(const f32x4 (&acc)[2][2][4][2], const Unit& u, int wr, int wc, int fr, int fq) const {
#pragma unroll
        for (int ai = 0; ai < 2; ++ai)
#pragma unroll
            for (int m = 0; m < 4; ++m) {
                const int tr = ai * HALF + wr * 64 + m * 16 + fr; PG8_FENCE;
                if (tr < u.aux) {
                    const float w = lw[u.arow + tr]; f32x4 h0, h1;
#pragma unroll
                    for (int e = 0; e < 4; ++e) { const float g0 = acc[ai][0][m][0][e], g1 = acc[ai][0][m][1][e];
                        h0[e] = w * (g0 / (1.f + __expf(-g0))) * acc[ai][1][m][0][e]; h1[e] = w * (g1 / (1.f + __expf(-g1))) * acc[ai][1][m][1][e]; }
                    *(u32x4*)(hid + (size_t)(u.arow + tr) * DE + u.pn * HALF + wc * 32 + 8 * fq) = pack8(h0, h1);
                }
            }
    }
};
struct EpiMoe2 {
    static constexpr bool PERM = false;
    const int* ltok; const float* mod; float* out;
    __device__ __forceinline__ void operator()(const f32x4 (&acc)[2][2][4][2], const Unit& u, int wr, int wc, int fr, int fq) const {
#pragma unroll
        for (int ai = 0; ai < 2; ++ai)
#pragma unroll
            for (int m = 0; m < 4; ++m) {
                const int tr = ai * HALF + wr * 64 + m * 16 + fr; PG8_FENCE;
                if (tr < u.aux) {
                    const int tok = ltok[u.arow + tr]; const float* gt = mod + (tok / SEQ) * 6 * DM + 5 * DM; float* orow = out + (size_t)tok * DM;
#pragma unroll
                    for (int bj = 0; bj < 2; ++bj)
#pragma unroll
                        for (int n = 0; n < 2; ++n) { const int col = u.pn * BM + bj * HALF + wc * 32 + 16 * n + 4 * fq;
                            const f32x4 gv = *(const f32x4*)(gt + col); f32x4* d = (f32x4*)(orow + col); *d = *d + gv * acc[ai][bj][m][n]; }
                }
            }
    }
};
}

__device__ __forceinline__ unsigned pk2(float lo, float hi) { return (unsigned)f2bf(lo) | ((unsigned)f2bf(hi) << 16); }
__device__ __forceinline__ void transpose_item(const float* W, int K, int N, bf16_t* WT, size_t drow0, int k0, int n0, float* scr, int lane) {
#pragma unroll 8
    for (int i = 0; i < 32; ++i) { const int kk = 2 * i + (lane >> 5), n = n0 + (lane & 31); scr[kk * 33 + (lane & 31)] = (n < N) ? W[(size_t)(k0 + kk) * N + n] : 0.f; }
    asm volatile("s_waitcnt lgkmcnt(0)" ::: "memory");
    const int c = lane & 7;
#pragma unroll
    for (int j = 0; j < 4; ++j) { const int n = (lane >> 3) + 8 * j; const float* s_ = scr + (8 * c) * 33 + n;
        uint4 o; o.x = pk2(s_[0 * 33], s_[1 * 33]); o.y = pk2(s_[2 * 33], s_[3 * 33]); o.z = pk2(s_[4 * 33], s_[5 * 33]); o.w = pk2(s_[6 * 33], s_[7 * 33]);
        *(uint4*)(WT + (drow0 + n) * K + k0 + 8 * c) = o; }
    asm volatile("s_waitcnt lgkmcnt(0)" ::: "memory");
}
__device__ void ph_convert_mixer_weights(const P& p, float* lds) {
    const int lane = otid() & 63, wv = otid() >> 6;
    float* scr = lds + wv * (64 * 33);
    const int gw = blockIdx.x * (NTHR / 64) + wv, nw = gridDim.x * (NTHR / 64);
    struct M { const float* W; int K, N, Npad; size_t dst; };
    const M ms[5] = { {p.in[5], DM, INW, 5120, WS_WIN}, {p.in[7], KVL, 2 * AW, 2 * AW, WS_WKV}, {p.in[21], AW, DM, DM, WS_WBA}, {p.in[22], RW, DM, DM, WS_WBR}, {p.in[23], DM, DM, DM, WS_WOUT} };
    int base = 0;
#pragma unroll
    for (int q = 0; q < 5; ++q) {
        const int nkb = ms[q].K / 64, nnb = ms[q].Npad / 32, nitems = nkb * nnb;
        for (int it = gw; it < base + nitems; it += nw) { if (it < base) continue; const int r = it - base; const int kb = r / nnb, nb = r % nnb;
            transpose_item(ms[q].W, ms[q].K, ms[q].N, (bf16_t*)(p.ws + ms[q].dst), (size_t)nb * 32, kb * 64, nb * 32, scr, lane); }
        base += nitems;
    }
}
__device__ void ph_convert_expert_weights(const P& p, float* lds) {
    const int lane = otid() & 63, wv = otid() >> 6;
    float* scr = lds + wv * (64 * 33);
    const int gw = blockIdx.x * (NTHR / 64) + wv, nw = gridDim.x * (NTHR / 64);
    for (int it = gw; it < NE * 2 * 256; it += nw) { const int e = it >> 9, which = (it >> 8) & 1, r = it & 255, kb = r >> 4, nb = r & 15, n0 = nb * 32;
        transpose_item(p.in[28 + which] + (size_t)e * DM * DE, DM, DE, (bf16_t*)(p.ws + WS_WGU), (size_t)e * 1024 + (n0 >> 7) * 256 + which * 128 + (n0 & 127), kb * 64, n0, scr, lane); }
    for (int it = gw; it < NE * 256; it += nw) { const int e = it >> 8, r = it & 255, kb = r >> 5, nb = r & 31;
        transpose_item(p.in[30] + (size_t)e * DE * DM, DE, DM, (bf16_t*)(p.ws + WS_WDN), (size_t)e * 1024 + nb * 32, kb * 64, nb * 32, scr, lane); }
}

__device__ void ph_headnorm(bf16_t* X, const float* g) {
    const int lane = otid() & 63, wv = otid() >> 6;
    const int gw = blockIdx.x * (NTHR / 64) + wv, nw = gridDim.x * (NTHR / 64);
    for (int m = gw; m < NT; m += nw) {
        uint4 raw = *(const uint4*)(X + (size_t)m * AW + lane * 8);
        float v[8] = {bf2f(raw.x & 0xffff), bf2f(raw.x >> 16), bf2f(raw.y & 0xffff), bf2f(raw.y >> 16), bf2f(raw.z & 0xffff), bf2f(raw.z >> 16), bf2f(raw.w & 0xffff), bf2f(raw.w >> 16)};
        float ss = 0.f;
#pragma unroll
        for (int i = 0; i < 8; ++i) ss += v[i] * v[i];
        ss += __shfl_xor(ss, 1); ss += __shfl_xor(ss, 2); ss += __shfl_xor(ss, 4);
        const float rstd = rsqrtf(ss * (1.f / 64.f) + NORM_EPS);
        const int d0 = (lane & 7) * 8;
        unsigned o[4];
#pragma unroll
        for (int i = 0; i < 4; ++i) o[i] = (unsigned)f2bf(v[2 * i] * rstd * g[d0 + 2 * i]) | ((unsigned)f2bf(v[2 * i + 1] * rstd * g[d0 + 2 * i + 1]) << 16);
        *(uint4*)(X + (size_t)m * AW + lane * 8) = make_uint4(o[0], o[1], o[2], o[3]);
    }
}
__device__ void ph_kvnorm(bf16_t* X, const float* g) {
    const int lane = otid() & 63, wv = otid() >> 6;
    const int gw = blockIdx.x * (NTHR / 64) + wv, nw = gridDim.x * (NTHR / 64);
    for (int m = gw; m < NT; m += nw) {
        uint2 raw = *(const uint2*)(X + (size_t)m * KVL + lane * 4);
        float v[4] = {bf2f(raw.x & 0xffff), bf2f(raw.x >> 16), bf2f(raw.y & 0xffff), bf2f(raw.y >> 16)};
        float ss = wave_sum(v[0] * v[0] + v[1] * v[1] + v[2] * v[2] + v[3] * v[3]);
        const float rstd = rsqrtf(ss * (1.f / 256.f) + NORM_EPS);
        uint2 o; o.x = (unsigned)f2bf(v[0] * rstd * g[lane * 4]) | ((unsigned)f2bf(v[1] * rstd * g[lane * 4 + 1]) << 16);
        o.y = (unsigned)f2bf(v[2] * rstd * g[lane * 4 + 2]) | ((unsigned)f2bf(v[3] * rstd * g[lane * 4 + 3]) << 16);
        *(uint2*)(X + (size_t)m * KVL + lane * 4) = o;
    }
}

__device__ __forceinline__ unsigned f2key(float f) { unsigned u = __float_as_uint(f); return (u & 0x80000000u) ? ~u : (u | 0x80000000u); }
__device__ void ph_dsa(const P& p, float* lds) {
    const float* IDX = (const float*)(p.ws + WS_IDX);
    const bf16_t* Q = (const bf16_t*)(p.ws + WS_Q); const bf16_t* Kb = (const bf16_t*)(p.ws + WS_K); const bf16_t* Vb = (const bf16_t*)(p.ws + WS_V);
    bf16_t* O = (bf16_t*)(p.ws + WS_OATT);
    unsigned* s_key = (unsigned*)lds;
    float* s_qi = lds + 8192;
    float* s_w = s_qi + 256;
    float* s_q = s_w + 8;
    int* s_sel = (int*)(s_q + 512);
    float* s_lg = (float*)(s_sel + 256);
    unsigned* s_hist = (unsigned*)(s_lg + 2048);
    int* s_misc = (int*)(s_hist + 256);
    float* s_inv = (float*)(s_misc + 16);
    const int tid = otid(), lane = tid & 63, wv = tid >> 6;
    const float idx_scale = 0.17677669529663687f * 0.35355339059327373f;
    for (int tq = blockIdx.x; tq < NT; tq += gridDim.x) {
        const int b = tq / SEQ, t = tq % SEQ, n = t + 1;
        __syncthreads();
        const float* ir = IDX + (size_t)tq * IDXW;
        if (tid < 256) s_qi[tid] = ir[tid];
        if (tid < 8) s_w[tid] = ir[288 + tid] * idx_scale;
        s_q[tid] = bf2f(Q[(size_t)tq * AW + tid]);
        __syncthreads();
        int nsel;
        if (n <= TOPK) { if (tid < n) s_sel[tid] = tid; nsel = n; __syncthreads(); }
        else {
            for (int s = tid; s < n; s += NTHR) {
                const float4* kp = (const float4*)(IDX + (size_t)(b * SEQ + s) * IDXW + 256);
                float kv[32];
#pragma unroll
                for (int i = 0; i < 8; ++i) { float4 v4 = kp[i]; kv[4 * i] = v4.x; kv[4 * i + 1] = v4.y; kv[4 * i + 2] = v4.z; kv[4 * i + 3] = v4.w; }
                float sc = 0.f;
#pragma unroll 1
                for (int h = 0; h < 8; ++h) { float d = 0.f;
#pragma unroll
                    for (int i = 0; i < 32; ++i) d += s_qi[h * 32 + i] * kv[i];
                    sc += s_w[h] * fmaxf(d, 0.f); }
                s_key[s] = f2key(sc);
            }
            unsigned prefix = 0; int remaining = TOPK; int cnt_eq = 0;
            for (int pass = 0; pass < 4; ++pass) {
                const int shift = 24 - 8 * pass;
                if (tid < 256) s_hist[tid] = 0;
                __syncthreads();
                for (int s = tid; s < n; s += NTHR) { const unsigned k = s_key[s]; if (pass == 0 || (k >> (shift + 8)) == (prefix >> (shift + 8))) atomicAdd(&s_hist[(k >> shift) & 255u], 1u); }
                __syncthreads();
                unsigned hv = 0, suf = 0;
                if (tid < 256) { hv = s_hist[tid]; suf = hv;
#pragma unroll
                    for (int o = 1; o < 64; o <<= 1) { unsigned oth = __shfl_down(suf, o); if (lane + o < 64) suf += oth; }
                    if (lane == 0) s_misc[4 + wv] = (int)suf; }
                __syncthreads();
                if (tid < 256) { for (int w2 = wv + 1; w2 < 4; ++w2) suf += (unsigned)s_misc[4 + w2];
                    const unsigned above = suf - hv;
                    if ((int)above < remaining && remaining <= (int)(above + hv)) { s_misc[0] = tid; s_misc[1] = remaining - (int)above; s_misc[2] = (int)hv; } }
                __syncthreads();
                prefix |= ((unsigned)s_misc[0]) << shift; remaining = s_misc[1]; cnt_eq = s_misc[2];
                __syncthreads();
            }
            if (tid == 0) s_misc[3] = 0;
            __syncthreads();
            for (int s = tid; s < n; s += NTHR) { const unsigned k = s_key[s]; if (k > prefix || (k == prefix && cnt_eq == remaining)) { int pos = atomicAdd(&s_misc[3], 1); s_sel[pos] = s; } }
            __syncthreads();
            if (cnt_eq != remaining && wv == 0) {
                int base = s_misc[3], taken = 0;
                for (int s0 = 0; s0 < n && taken < remaining; s0 += 64) { const int s = s0 + lane; const bool f = (s < n) && (s_key[s] == prefix);
                    const unsigned long long mk = __ballot(f); const int pre = __popcll(mk & ((1ull << lane) - 1ull));
                    if (f && taken + pre < remaining) s_sel[base + taken + pre] = s;
                    taken += __popcll(mk); }
            }
            nsel = TOPK;
            __syncthreads();
        }
        {
            const int j = tid & 255, hh = tid >> 8;
            float lg4[4] = {-INFINITY, -INFINITY, -INFINITY, -INFINITY};
            if (j < nsel) {
                const int s = s_sel[j];
                const uint4* kr = (const uint4*)(Kb + (size_t)(b * SEQ + s) * AW + hh * 256);
#pragma unroll
                for (int h4 = 0; h4 < 4; ++h4) { float d = 0.f; const float* qv = s_q + (hh * 4 + h4) * 64;
#pragma unroll
                    for (int c = 0; c < 8; ++c) { uint4 r = kr[h4 * 8 + c];
                        d += qv[c * 8 + 0] * bf2f(r.x & 0xffff) + qv[c * 8 + 1] * bf2f(r.x >> 16) + qv[c * 8 + 2] * bf2f(r.y & 0xffff) + qv[c * 8 + 3] * bf2f(r.y >> 16)
                           + qv[c * 8 + 4] * bf2f(r.z & 0xffff) + qv[c * 8 + 5] * bf2f(r.z >> 16) + qv[c * 8 + 6] * bf2f(r.w & 0xffff) + qv[c * 8 + 7] * bf2f(r.w >> 16); }
                    const int h = hh * 4 + h4; const float slope = exp2f(-(float)(h + 1));
                    lg4[h4] = d * 0.125f - slope * (float)(t - s); }
            }
#pragma unroll
            for (int h4 = 0; h4 < 4; ++h4) s_lg[(hh * 4 + h4) * 256 + j] = lg4[h4];
        }
        __syncthreads();
        {
            float v[4]; float mx = -INFINITY;
#pragma unroll
            for (int i = 0; i < 4; ++i) { v[i] = s_lg[wv * 256 + lane + 64 * i]; mx = fmaxf(mx, v[i]); }
            mx = wave_max(mx); float sm = 0.f;
#pragma unroll
            for (int i = 0; i < 4; ++i) { v[i] = __expf(v[i] - mx); sm += v[i]; s_lg[wv * 256 + lane + 64 * i] = v[i]; }
            sm = wave_sum(sm);
            if (lane == 0) s_inv[wv] = 1.f / sm;
        }
        __syncthreads();
        {
            float acc = 0.f; const float* pr = s_lg + wv * 256;
            const bf16_t* vb = Vb + (size_t)b * SEQ * AW + tid;
#pragma unroll 8
            for (int j = 0; j < nsel; ++j) acc += pr[j] * bf2f(vb[(size_t)s_sel[j] * AW]);
            O[(size_t)tq * AW + tid] = f2bf(acc * s_inv[wv]);
        }
    }
}

__device__ void ph_rwkv_prep(const P& p, float* lds) {
    const bf16_t* PS = (const bf16_t*)(p.ws + WS_PS);
    const float* mu = p.in[10]; const float* w0 = p.in[11]; const float* w2 = p.in[12]; const float* a0 = p.in[13]; const float* a2 = p.in[14]; const float* g2 = p.in[15];
    const float* k_k = p.in[16]; const float* k_a = p.in[17];
    bf16_t* R = (bf16_t*)(p.ws + WS_R); bf16_t* K2 = (bf16_t*)(p.ws + WS_K2); bf16_t* VV = (bf16_t*)(p.ws + WS_VV); bf16_t* KK = (bf16_t*)(p.ws + WS_KK); bf16_t* BB = (bf16_t*)(p.ws + WS_BB);
    bf16_t* G = (bf16_t*)(p.ws + WS_G); float* DD = (float*)(p.ws + WS_DD);
    float* s_tw = lds; float* s_al = lds + 8 * 64; float* s_sg = lds + 16 * 64;
    const int tid = otid();
    for (int grp = blockIdx.x; grp < NT / 8; grp += gridDim.x) {
        const int m0 = grp * 8;
        __syncthreads();
        for (int e = tid; e < 8 * 288; e += NTHR) {
            const int tk = e / 288, c = e % 288, col = 1536 + c, m = m0 + tk;
            const float cur = bf2f(PS[(size_t)m * SHW + col]);
            const float prv = (m % SEQ) ? bf2f(PS[(size_t)(m - 1) * SHW + col]) : 0.f;
            const float mx = cur + (prv - cur) * mu[col];
            if (c < 64) s_tw[tk * 64 + c] = tanhf(mx); else if (c < 128) s_al[tk * 64 + (c - 64)] = mx; else s_sg[tk * 160 + (c - 128)] = sigmoidf_(mx);
        }
        __syncthreads();
        float accw[8], acca[8], accg[8];
#pragma unroll
        for (int i = 0; i < 8; ++i) { accw[i] = 0.f; acca[i] = 0.f; accg[i] = 0.f; }
        for (int i = 0; i < 64; ++i) { const float wv_ = w2[i * RW + tid], av_ = a2[i * RW + tid];
#pragma unroll
            for (int tk = 0; tk < 8; ++tk) { accw[tk] += s_tw[tk * 64 + i] * wv_; acca[tk] += s_al[tk * 64 + i] * av_; } }
        for (int i = 0; i < 160; ++i) { const float gv_ = g2[i * RW + tid];
#pragma unroll
            for (int tk = 0; tk < 8; ++tk) accg[tk] += s_sg[tk * 160 + i] * gv_; }
        const float w0c = w0[tid], a0c = a0[tid], kkc = k_k[tid], kac = k_a[tid], mur = mu[tid], muk = mu[512 + tid], muv = mu[1024 + tid];
#pragma unroll
        for (int tk = 0; tk < 8; ++tk) {
            const int m = m0 + tk; const bool first = (m % SEQ) == 0;
            const bf16_t* cr = PS + (size_t)m * SHW; const bf16_t* pr = PS + (size_t)(m - 1) * SHW;
            const float rc = bf2f(cr[tid]), kc = bf2f(cr[512 + tid]), vc = bf2f(cr[1024 + tid]);
            const float rp = first ? 0.f : bf2f(pr[tid]), kp = first ? 0.f : bf2f(pr[512 + tid]), vp = first ? 0.f : bf2f(pr[1024 + tid]);
            const float r = rc + (rp - rc) * mur, k = kc + (kp - kc) * muk, v = vc + (vp - vc) * muv;
            const float xw = -(w0c + accw[tk]);
            const float sp = fmaxf(xw, 0.f) + log1pf(__expf(-fabsf(xw)));
            const float w = -sp - 0.5f;
            const float dec = __expf(-__expf(w));
            const float a = sigmoidf_(a0c + acca[tk]);
            const float kkr = k * kkc;
            const float ss = wave_sum(kkr * kkr);
            const float kk = kkr / fmaxf(sqrtf(ss), 1e-12f);
            const float k2 = k * (1.f + (a - 1.f) * kac);
            const size_t o = (size_t)m * RW + tid;
            R[o] = f2bf(r); K2[o] = f2bf(k2); VV[o] = f2bf(v); KK[o] = f2bf(kk); BB[o] = f2bf(kk * a); G[o] = f2bf(accg[tk]); DD[o] = dec;
        }
    }
}

__device__ void ph_rwkv_scan(const P& p) {
    const bf16_t* R = (const bf16_t*)(p.ws + WS_R); const bf16_t* K2 = (const bf16_t*)(p.ws + WS_K2); const bf16_t* VV = (const bf16_t*)(p.ws + WS_VV);
    const bf16_t* KK = (const bf16_t*)(p.ws + WS_KK); const bf16_t* BB = (const bf16_t*)(p.ws + WS_BB); const float* DD = (const float*)(p.ws + WS_DD);
    float* YS = (float*)(p.ws + WS_YS);
    const int lane = otid() & 63, wv = otid() >> 6;
    for (int item = blockIdx.x; item < 128; item += gridDim.x) {
        const int bh = item >> 3, b = bh >> 3, h = bh & 7, i = (item & 7) * 8 + wv;
        const size_t base = (size_t)b * SEQ * RW + h * 64;
        float s = 0.f;
        float r = bf2f(R[base + lane]), k = bf2f(K2[base + lane]), kk = bf2f(KK[base + lane]), bb = bf2f(BB[base + lane]), d = DD[base + lane], v = bf2f(VV[base + i]);
        for (int t = 0; t < SEQ; ++t) {
            float rn = 0.f, kn = 0.f, kkn = 0.f, bbn = 0.f, dn = 0.f, vn = 0.f;
            if (t + 1 < SEQ) { const size_t o = base + (size_t)(t + 1) * RW;
                rn = bf2f(R[o + lane]); kn = bf2f(K2[o + lane]); kkn = bf2f(KK[o + lane]); bbn = bf2f(BB[o + lane]); dn = DD[o + lane]; vn = bf2f(VV[o + i]); }
            const float sa = -wave_sum(s * kk);
            s = s * d + sa * bb + v * k;
            const float y = wave_sum(s * r);
            if (lane == 0) YS[base + (size_t)t * RW + i] = y;
            r = rn; k = kn; kk = kkn; bb = bbn; d = dn; v = vn;
        }
    }
}

__device__ void ph_rwkv_post(const P& p) {
    const bf16_t* R = (const bf16_t*)(p.ws + WS_R); const bf16_t* K2 = (const bf16_t*)(p.ws + WS_K2); const bf16_t* VV = (const bf16_t*)(p.ws + WS_VV); const bf16_t* G = (const bf16_t*)(p.ws + WS_G);
    const float* YS = (const float*)(p.ws + WS_YS); bf16_t* ORW = (bf16_t*)(p.ws + WS_ORW);
    const float* r_k = p.in[18]; const float* ln_w = p.in[19]; const float* ln_b = p.in[20];
    const int tid = otid();
    const float rkc = r_k[tid], lw = ln_w[tid], lb = ln_b[tid];
    for (int m = blockIdx.x; m < NT; m += gridDim.x) {
        const size_t o = (size_t)m * RW + tid;
        const float y = YS[o];
        const float mean = wave_sum(y) * (1.f / 64.f);
        const float dy = y - mean;
        const float var = wave_sum(dy * dy) * (1.f / 64.f);
        const float yn = dy * rsqrtf(var + GN_EPS) * lw + lb;
        const float r = bf2f(R[o]), k2 = bf2f(K2[o]), v = bf2f(VV[o]), g = bf2f(G[o]);
        const float rk = wave_sum(r * k2 * rkc);
        ORW[o] = f2bf((yn + rk * v) * g);
    }
}

__device__ void ph_moe_offsets(const P& p) {
    if (blockIdx.x != 0) return;
    int* ctl = (int*)(p.ws + WS_CTL); int* ltok = (int*)(p.ws + WS_LTOK);
    if (otid() == 0) {
        int off = 0, n1 = 0, n2a = 0, n2b = 0;
        int4* t1 = (int4*)(ctl + CT_TAB1); int4* t2a = (int4*)(ctl + CT_TAB2A); int4* t2b = (int4*)(ctl + CT_TAB2B);
        for (int li = 0; li < 64; ++li) {
            const int cnt = ctl[CT_CNT + li], e = li & 31; ctl[CT_OFF + li] = off;
            for (int mt = 0; mt * 256 < cnt; ++mt) {
                const int rem = cnt - mt * 256;
                for (int nt = 0; nt < 4; ++nt) {
                    t1[n1++] = make_int4(off + mt * 256, e * 1024 + nt * 256, rem, nt);
                    if (li < 32) t2a[n2a++] = make_int4(off + mt * 256, e * 1024 + nt * 256, rem, nt); else t2b[n2b++] = make_int4(off + mt * 256, e * 1024 + nt * 256, rem, nt);
                }
            }
            off += (cnt + 255) / 256 * 256;
        }
        ctl[CT_NU] = n1; ctl[CT_NU + 1] = n2a; ctl[CT_NU + 2] = n2b;
    }
    __syncthreads();
    for (int li = 0; li < 64; ++li) { const int cnt = ctl[CT_CNT + li], off = ctl[CT_OFF + li], pad = (cnt + 255) / 256 * 256;
        for (int r = cnt + otid(); r < pad; r += NTHR) ltok[off + r] = 0; }
}
__device__ void ph_moe_scatter(const P& p) {
    int* ctl = (int*)(p.ws + WS_CTL); const int* route = (const int*)(p.ws + WS_ROUTE);
    int* ltok = (int*)(p.ws + WS_LTOK); float* lw = (float*)(p.ws + WS_LW);
    for (int m = blockIdx.x * NTHR + otid(); m < NT; m += gridDim.x * NTHR) {
#pragma unroll
        for (int sl = 0; sl < 2; ++sl) { const int li = sl * 32 + route[m * 4 + sl]; const int pos = ctl[CT_OFF + li] + atomicAdd(ctl + CT_CUR + li, 1); ltok[pos] = m; lw[pos] = __int_as_float(route[m * 4 + 2 + sl]); }
    }
}

template <int PH>
__device__ __forceinline__ void run_phase(const P& p, unsigned char* lds_raw) {
    float* lds = (float*)lds_raw; PG8_LAS unsigned char* ldsg = (PG8_LAS unsigned char*)lds_raw;
    const int G = gridDim.x, c = blockIdx.x;
    if constexpr (PH == 0) { ph_mod(p, lds); __syncthreads(); ph_convert_mixer_weights(p, lds); }
    if constexpr (PH == 1) ph_norm(p, p.in[0], p.in[4], 0, (bf16_t*)(p.ws + WS_XN));
    if constexpr (PH == 2) { pg8::Gemm g{(const bf16_t*)(p.ws + WS_XN), (const bf16_t*)(p.ws + WS_WIN), DM, nullptr}; pg8::StaticOrder S; S.init(NT, 5120, G, c);
        pg8::EpiInproj E{p.ws, (bf16_t*)p.out}; pg8::gemm_phase(ldsg, g, S, E); }
    if constexpr (PH == 3) { ph_headnorm((bf16_t*)(p.ws + WS_Q), p.in[8]); ph_kvnorm((bf16_t*)(p.ws + WS_KVN), p.in[6]); }
    if constexpr (PH == 4) { pg8::Gemm g{(const bf16_t*)(p.ws + WS_KVN), (const bf16_t*)(p.ws + WS_WKV), KVL, nullptr}; pg8::StaticOrder S; S.init(NT, 2 * AW, G, c);
        pg8::EpiKV E{p.ws}; pg8::gemm_phase(ldsg, g, S, E); }
    if constexpr (PH == 5) ph_headnorm((bf16_t*)(p.ws + WS_K), p.in[9]);
    if constexpr (PH == 6) ph_dsa(p, lds);
    if constexpr (PH == 7) ph_rwkv_prep(p, lds);
    if constexpr (PH == 8) ph_rwkv_scan(p);
    if constexpr (PH == 9) ph_rwkv_post(p);
    if constexpr (PH == 10) { pg8::Gemm g{(const bf16_t*)(p.ws + WS_OATT), (const bf16_t*)(p.ws + WS_WBA), AW, nullptr}; pg8::StaticOrder S; S.init(NT, DM, G, c);
        pg8::EpiMerge<false> E{(bf16_t*)(p.ws + WS_MERGED), (const bf16_t*)p.out}; pg8::gemm_phase(ldsg, g, S, E);
        ph_convert_expert_weights(p, lds); }
    if constexpr (PH == 11) { pg8::Gemm g{(const bf16_t*)(p.ws + WS_ORW), (const bf16_t*)(p.ws + WS_WBR), RW, nullptr}; pg8::StaticOrder S; S.init(NT, DM, G, c);
        pg8::EpiMerge<true> E{(bf16_t*)(p.ws + WS_MERGED), (const bf16_t*)p.out + (size_t)NT * DM}; pg8::gemm_phase(ldsg, g, S, E); }
    if constexpr (PH == 12) { pg8::Gemm g{(const bf16_t*)(p.ws + WS_MERGED), (const bf16_t*)(p.ws + WS_WOUT), DM, nullptr}; pg8::StaticOrder S; S.init(NT, DM, G, c);
        pg8::EpiOut E{p.in[0], (const float*)(p.ws + WS_MOD), p.out}; pg8::gemm_phase(ldsg, g, S, E); }
    if constexpr (PH == 13) ph_norm_route(p, lds);
    if constexpr (PH == 14) ph_moe_offsets(p);
    if constexpr (PH == 15) ph_moe_scatter(p);
    if constexpr (PH == 16) { const int* ctl = (const int*)(p.ws + WS_CTL);
        pg8::Gemm g{(const bf16_t*)(p.ws + WS_XN2), (const bf16_t*)(p.ws + WS_WGU), DM, (const int*)(p.ws + WS_LTOK)}; pg8::TableOrder S{(const int4*)(ctl + CT_TAB1), ctl[CT_NU], G, c};
        pg8::EpiMoe1 E{(bf16_t*)(p.ws + WS_HID), (const float*)(p.ws + WS_LW)}; pg8::gemm_phase(ldsg, g, S, E); }
    if constexpr (PH == 17 || PH == 18) { const int* ctl = (const int*)(p.ws + WS_CTL);
        pg8::Gemm g{(const bf16_t*)(p.ws + WS_HID), (const bf16_t*)(p.ws + WS_WDN), DE, nullptr};
        pg8::TableOrder S{(const int4*)(ctl + (PH == 17 ? CT_TAB2A : CT_TAB2B)), ctl[CT_NU + (PH == 17 ? 1 : 2)], G, c};
        pg8::EpiMoe2 E{(const int*)(p.ws + WS_LTOK), (const float*)(p.ws + WS_MOD), p.out}; pg8::gemm_phase(ldsg, g, S, E); }
}
constexpr int LDS_BYTES = 147456;
constexpr int NPHASE = 19;
constexpr int CT_BAR = 65536;
constexpr int LDS_ST = LDS_BYTES - 64;
template <int PH> __device__ __forceinline__ void run_all(const P& p, unsigned char* lds, const XcdBarrier& bar) {
    run_phase<PH>(p, lds);
    if constexpr (PH + 1 < NPHASE) { xcd_barrier(bar); run_all<PH + 1>(p, lds, bar); }
}
__global__ void __launch_bounds__(NTHR, 2) k_mega(P p) {
    extern __shared__ __attribute__((aligned(16))) unsigned char lds[];
    volatile LAS3 unsigned* st = (volatile LAS3 unsigned*)((LAS3 unsigned char*)lds + LDS_ST);
    if (otid() < 16) st[otid()] = 0u;
    __syncthreads();
    const XcdBarrier bar = xcd_barrier_post((unsigned*)(p.ws + WS_CTL) + CT_BAR, st);
    run_all<0>(p, lds, bar);
}
}

extern "C" void kernel_launch(void* const* d_in, const int* in_sizes, int n_in, void* d_out, int out_size, void* d_ws, size_t ws_size, hipStream_t stream) {
    if (n_in != 31 || out_size != NT * DM || ws_size < WS_END) { fprintf(stderr, "kernel_launch: unexpected shapes (n_in %d out %d ws %zu need %zu)\n", n_in, out_size, ws_size, (size_t)WS_END); return; }
    P p{};
    for (int i = 0; i < 31; ++i) p.in[i] = (const float*)d_in[i];
    p.out = (float*)d_out; p.ws = (unsigned char*)d_ws;
    (void)hipMemsetAsync((char*)d_ws + WS_CTL, 0, 1 * MiB, stream);
    static int grid_blocks = 0;
    if (!grid_blocks) {
        int dev = 0, cus = 0, per_cu = 0;
        (void)hipGetDevice(&dev);
        (void)hipDeviceGetAttribute(&cus, hipDeviceAttributeMultiprocessorCount, dev);
        (void)hipFuncSetAttribute((const void*)k_mega, hipFuncAttributeMaxDynamicSharedMemorySize, LDS_BYTES);
        (void)hipOccupancyMaxActiveBlocksPerMultiprocessor(&per_cu, (const void*)k_mega, NTHR, LDS_BYTES);
        if (per_cu < 1) per_cu = 1;
        if (per_cu > 1) per_cu = 1;
        grid_blocks = cus * per_cu;
        fprintf(stderr, "kernel_launch: cus %d per_cu %d grid %d\n", cus, per_cu, grid_blocks);
    }
    hipLaunchKernelGGL(k_mega, dim3(grid_blocks), dim3(NTHR), LDS_BYTES, stream, p);
}
```

```cpp
#include <hip/hip_runtime.h>
#include <cstdio>
#include <cstdint>

namespace {
constexpr int NB = 2, SEQ = 8192, DM = 1024, NT = NB * SEQ;
constexpr int AW = 512, KVL = 256, NIH = 8, IDD = 32, SHW = 1824, INW = 4936;
constexpr int C_KV = 512, C_QI = 768, C_PS = 1064, C_GA = 2888, C_GR = 3912;
constexpr int IDXW = 296;
constexpr int RW = 512, NE = 32, DE = 512;
constexpr int TOPK = 256;
constexpr float NORM_EPS = 1e-6f, GN_EPS = 64e-5f;
constexpr int NTHR = 512;

typedef unsigned short bf16_t;
__device__ __forceinline__ float bf2f(bf16_t v) { return __uint_as_float(((unsigned)v) << 16); }
__device__ __forceinline__ bf16_t f2bf(float f) { unsigned u = __float_as_uint(f); return (bf16_t)((u + 0x7fffu + ((u >> 16) & 1u)) >> 16); }

constexpr size_t MiB = 1u << 20;
constexpr size_t WS_CTL = 0;
constexpr size_t WS_MOD = 1 * MiB;
constexpr size_t WS_WIN = 2 * MiB;
constexpr size_t WS_WKV = 12 * MiB;
constexpr size_t WS_WBA = 13 * MiB;
constexpr size_t WS_WBR = 14 * MiB;
constexpr size_t WS_WOUT = 15 * MiB;
constexpr size_t WS_XN = 17 * MiB;
constexpr size_t WS_G = 17 * MiB;
constexpr size_t WS_ORW = 33 * MiB;
constexpr size_t WS_Q = 49 * MiB;
constexpr size_t WS_KVN = 65 * MiB;
constexpr size_t WS_K = 73 * MiB;
constexpr size_t WS_V = 89 * MiB;
constexpr size_t WS_IDX = 105 * MiB;
constexpr size_t WS_PS = 124 * MiB;
constexpr size_t WS_YS = 124 * MiB;
constexpr size_t WS_OATT = 181 * MiB;
constexpr size_t WS_R = 49 * MiB, WS_K2 = 65 * MiB, WS_VV = 81 * MiB, WS_KK = 97 * MiB;
constexpr size_t WS_BB = 197 * MiB;
constexpr size_t WS_DD = 213 * MiB;
constexpr size_t WS_MERGED = 197 * MiB;
constexpr size_t WS_XN2 = 229 * MiB;
constexpr size_t WS_WGU = 49 * MiB;
constexpr size_t WS_WDN = 113 * MiB;
constexpr size_t WS_HID = 145 * MiB;
constexpr size_t WS_ROUTE = 193 * MiB;
constexpr size_t WS_LTOK = 194 * MiB;
constexpr size_t WS_LW = 195 * MiB;
constexpr size_t WS_G1T = 156 * MiB;
constexpr size_t WS_G2T = 245 * MiB;
constexpr size_t WS_PT = 261 * MiB;
constexpr size_t WS_QT = 277 * MiB;
constexpr size_t WS_SX = 97 * MiB;
constexpr size_t WS_END = 293 * MiB;
constexpr int HID_ROWS = 49152;
constexpr int CT_CNT = 0, CT_OFF = 64, CT_CUR = 128, CT_NU = 192;
constexpr int CT_TAB1 = 1024, CT_TAB2A = 1024 + 4 * 1024, CT_TAB2B = 1024 + 8 * 1024;

struct P {
    const float* in[31];
    float* out;
    unsigned char* ws;
};

__device__ __forceinline__ int otid() { int t = threadIdx.x; asm volatile("" : "+v"(t)); return t; }
__device__ __forceinline__ float dpp_row_shr(float v, int n) {
    int iv = __builtin_bit_cast(int, v), r;
    switch (n) { case 1: r = __builtin_amdgcn_update_dpp(0, iv, 0x111, 0xf, 0xf, true); break; case 2: r = __builtin_amdgcn_update_dpp(0, iv, 0x112, 0xf, 0xf, true); break;
                 case 4: r = __builtin_amdgcn_update_dpp(0, iv, 0x114, 0xf, 0xf, true); break; default: r = __builtin_amdgcn_update_dpp(0, iv, 0x118, 0xf, 0xf, true); break; }
    return __builtin_bit_cast(float, r);
}
__device__ __forceinline__ float wave_sum(float v) {
    v += dpp_row_shr(v, 1); v += dpp_row_shr(v, 2); v += dpp_row_shr(v, 4); v += dpp_row_shr(v, 8);
    v += __builtin_bit_cast(float, __builtin_amdgcn_update_dpp(0, __builtin_bit_cast(int, v), 0x142, 0xa, 0xf, false));
    v += __builtin_bit_cast(float, __builtin_amdgcn_update_dpp(0, __builtin_bit_cast(int, v), 0x143, 0xc, 0xf, false));
    return __builtin_bit_cast(float, __builtin_amdgcn_readlane(__builtin_bit_cast(int, v), 63));
}
__device__ __forceinline__ float wave_max(float v) {
#pragma unroll
    for (int o = 32; o > 0; o >>= 1) v = fmaxf(v, __shfl_xor(v, o));
    return v;
}
__device__ __forceinline__ float sigmoidf_(float x) { return 1.f / (1.f + __expf(-x)); }

#define XB_TMO      128
#define XB_XCNT(j)  (256  + 64 * (j))
#define XB_XSUB(j)  (1280 + 64 * (j))
#define XB_XGEN(j)  (2304 + 64 * (j))
#define XB_TOP      3328
#define XB_TOPGEN   3392
#define XCD_BAR_WORDS 3456
#define XB_SPIN_CAP (1u << 22)
#define LAS3 __attribute__((address_space(3)))
__device__ __forceinline__ unsigned xb_ld(unsigned* p)              { return __hip_atomic_load(p, __ATOMIC_RELAXED, __HIP_MEMORY_SCOPE_AGENT); }
__device__ __forceinline__ unsigned xb_add(unsigned* p, unsigned v) { return __hip_atomic_fetch_add(p, v, __ATOMIC_RELAXED, __HIP_MEMORY_SCOPE_AGENT); }
__device__ __forceinline__ unsigned xb_xcc_id() { return (unsigned)__builtin_amdgcn_s_getreg((3 << 11) | 20) & 0xFu; }
#define XB_SPIN(cond, bar) do { unsigned _sp = 0; while (cond) { __builtin_amdgcn_s_sleep(1); \
    if ((++_sp & 255u) == 0u) { if (xb_ld(&(bar)[XB_TMO])) break; if (_sp > XB_SPIN_CAP) { atomicAdd(&(bar)[XB_TMO], 1u); break; } } } } while (0)
struct XcdBarrier { unsigned* bar; unsigned x; volatile LAS3 unsigned* st; };
__device__ __forceinline__ XcdBarrier xcd_barrier_post(unsigned* bar, volatile LAS3 unsigned* st) {
    XcdBarrier b; b.bar = bar; b.x = xb_xcc_id(); b.st = st;
    if (otid() == 0) (void)xb_add(&bar[XB_XCNT(b.x)], 1u);
    return b;
}
__device__ __forceinline__ void xcd_barrier_complete(unsigned* bar, unsigned x, unsigned& nloc, unsigned& nx) {
    const unsigned G = gridDim.x * gridDim.y * gridDim.z;
    unsigned sum, cnt, mine, sp = 0u;
    for (;;) {
        sum = 0u; cnt = 0u; mine = 0u;
#pragma unroll
        for (unsigned j = 0; j < 16; ++j) { const unsigned c = xb_ld(&bar[XB_XCNT(j)]); sum += c; cnt += (c > 0u) ? 1u : 0u; mine = (j == x) ? c : mine; }
        if (sum == G) break;
        __builtin_amdgcn_s_sleep(1);
        if ((++sp & 255u) == 0u) { if (xb_ld(&bar[XB_TMO])) break; if (sp > XB_SPIN_CAP) { atomicAdd(&bar[XB_TMO], 1u); break; } }
    }
    nloc = mine > 0u ? mine : 1u; nx = cnt > 0u ? cnt : 1u;
}
__device__ __forceinline__ void xcd_barrier(const XcdBarrier& b) {
    asm volatile("s_waitcnt vmcnt(0)" ::: "memory");
    __syncthreads();
    if (otid() == 0) {
        unsigned* bar = b.bar;
        __builtin_amdgcn_s_waitcnt(0);
        unsigned nloc = b.st[0], nx = b.st[1];
        if (nloc == 0u) { xcd_barrier_complete(bar, b.x, nloc, nx); b.st[0] = nloc; b.st[1] = nx; }
        const unsigned old = xb_add(&bar[XB_XSUB(b.x)], 1u);
        const unsigned gen = old / nloc;
        if (old + 1u == (gen + 1u) * nloc) {
            __builtin_amdgcn_fence(__ATOMIC_RELEASE, "agent");
            asm volatile("s_waitcnt vmcnt(0)" ::: "memory");
            const unsigned og = xb_add(&bar[XB_TOP], 1u);
            const unsigned tg = og / nx;
            if (og + 1u == (tg + 1u) * nx) xb_add(&bar[XB_TOPGEN], 1u);
            else XB_SPIN(xb_ld(&bar[XB_TOPGEN]) == tg, bar);
            __builtin_amdgcn_fence(__ATOMIC_ACQUIRE, "agent");
            xb_add(&bar[XB_XGEN(b.x)], 1u);
            asm volatile("s_waitcnt vmcnt(0)" ::: "memory");
        } else {
            XB_SPIN(xb_ld(&bar[XB_XGEN(b.x)]) == gen, bar);
            __builtin_amdgcn_fence(__ATOMIC_ACQUIRE, "agent");
            asm volatile("s_waitcnt vmcnt(0)" ::: "memory");
        }
    }
    __syncthreads();
}

__device__ void ph_mod(const P& p, float* lds) {
    const float* c = p.in[1]; const float* W = p.in[2]; const float* bia = p.in[3];
    float* mod = (float*)(p.ws + WS_MOD);
    for (int i = otid(); i < NB * DM; i += NTHR) { float v = c[i]; lds[i] = v / (1.f + __expf(-v)); }
    __syncthreads();
    const int gt = blockIdx.x * NTHR + otid(), gs = gridDim.x * NTHR;
    for (int j = gt; j < 6 * DM; j += gs) {
        float a0 = 0.f, a1 = 0.f;
#pragma unroll 8
        for (int k = 0; k < DM; ++k) { float w = W[(size_t)k * (6 * DM) + j]; a0 += lds[k] * w; a1 += lds[DM + k] * w; }
        mod[j] = a0 + bia[j]; mod[6 * DM + j] = a1 + bia[j];
    }
}

__device__ void ph_norm(const P& p, const float* src, const float* g, int which, bf16_t* dst) {
    const float* mod = (const float*)(p.ws + WS_MOD);
    const int lane = otid() & 63, wv = otid() >> 6;
    const int gw = blockIdx.x * (NTHR / 64) + wv, nw = gridDim.x * (NTHR / 64);
    for (int m = gw; m < NT; m += nw) {
        const int b = m / SEQ;
        const float* sh = mod + b * 6 * DM + (which ? 3 * DM : 0);
        const float* sc = sh + DM;
        const float4* xr = (const float4*)(src + (size_t)m * DM);
        float4 v[4]; float ss = 0.f;
#pragma unroll
        for (int j = 0; j < 4; ++j) { v[j] = xr[lane + 64 * j]; ss += v[j].x * v[j].x + v[j].y * v[j].y + v[j].z * v[j].z + v[j].w * v[j].w; }
        ss = wave_sum(ss);
        const float rstd = rsqrtf(ss * (1.f / DM) + NORM_EPS);
        float o[16];
#pragma unroll
        for (int j = 0; j < 4; ++j) {
            int c0 = 4 * (lane + 64 * j); asm volatile("" : "+v"(c0));
            const float4 gg = *(const float4*)(g + c0), s1 = *(const float4*)(sc + c0), s0 = *(const float4*)(sh + c0);
            o[4 * j + 0] = v[j].x * rstd * gg.x * (1.f + s1.x) + s0.x; o[4 * j + 1] = v[j].y * rstd * gg.y * (1.f + s1.y) + s0.y;
            o[4 * j + 2] = v[j].z * rstd * gg.z * (1.f + s1.z) + s0.z; o[4 * j + 3] = v[j].w * rstd * gg.w * (1.f + s1.w) + s0.w;
            uint2 pk; pk.x = (unsigned)f2bf(o[4 * j]) | ((unsigned)f2bf(o[4 * j + 1]) << 16); pk.y = (unsigned)f2bf(o[4 * j + 2]) | ((unsigned)f2bf(o[4 * j + 3]) << 16);
            *(uint2*)(dst + (size_t)m * DM + c0) = pk;
        }
    }
}

__device__ void ph_norm_route(const P& p, float* lds) {
    const float* mod = (const float*)(p.ws + WS_MOD); const float* src = p.out; const float* g = p.in[24]; bf16_t* dst = (bf16_t*)(p.ws + WS_XN2);
    const float* wgr = p.in[25]; const float* wer = p.in[26]; const float* eb = p.in[27];
    const int tid = otid(), lane = tid & 63, wv = tid >> 6;
    float* sx = lds + wv * 4096;
    const int gw = blockIdx.x * (NTHR / 64) + wv, nw = gridDim.x * (NTHR / 64);
    for (int m0 = gw * 4; m0 < NT; m0 += nw * 4) {
        const int b = m0 / SEQ;
        const float* sh = mod + b * 6 * DM + 3 * DM; const float* sc = sh + DM;
#pragma unroll 1
        for (int tk = 0; tk < 4; ++tk) {
            const int m = m0 + tk;
            const float4* xr = (const float4*)(src + (size_t)m * DM);
            float4 v[4]; float ss = 0.f;
#pragma unroll
            for (int j = 0; j < 4; ++j) { v[j] = xr[lane + 64 * j]; ss += v[j].x * v[j].x + v[j].y * v[j].y + v[j].z * v[j].z + v[j].w * v[j].w; }
            ss = wave_sum(ss);
            const float rstd = rsqrtf(ss * (1.f / DM) + NORM_EPS);
#pragma unroll
            for (int j = 0; j < 4; ++j) {
                const int c0 = 4 * (lane + 64 * j);
                const float4 gg = *(const float4*)(g + c0), s1 = *(const float4*)(sc + c0), s0 = *(const float4*)(sh + c0);
                const float o0 = v[j].x * rstd * gg.x * (1.f + s1.x) + s0.x, o1 = v[j].y * rstd * gg.y * (1.f + s1.y) + s0.y;
                const float o2 = v[j].z * rstd * gg.z * (1.f + s1.z) + s0.z, o3 = v[j].w * rstd * gg.w * (1.f + s1.w) + s0.w;
                uint2 pk; pk.x = (unsigned)f2bf(o0) | ((unsigned)f2bf(o1) << 16); pk.y = (unsigned)f2bf(o2) | ((unsigned)f2bf(o3) << 16);
                *(uint2*)(dst + (size_t)m * DM + c0) = pk;
                sx[(c0 + 0) * 4 + tk] = o0; sx[(c0 + 1) * 4 + tk] = o1; sx[(c0 + 2) * 4 + tk] = o2; sx[(c0 + 3) * 4 + tk] = o3;
            }
        }
        __builtin_amdgcn_wave_barrier(); asm volatile("s_waitcnt lgkmcnt(0)" ::: "memory");
        float ae[4] = {0.f, 0.f, 0.f, 0.f}, ag[4] = {0.f, 0.f, 0.f, 0.f};
        { const int e = lane & 31, kb = (lane >> 5) * 512;
#pragma unroll 8
          for (int i = 0; i < 512; ++i) { const float w = wer[(size_t)(kb + i) * 32 + e]; const float4 xv = *(const float4*)(sx + (kb + i) * 4);
              ae[0] += xv.x * w; ae[1] += xv.y * w; ae[2] += xv.z * w; ae[3] += xv.w * w; } }
        { const int gq = lane & 3, kb = (lane >> 2) * 64;
#pragma unroll 8
          for (int i = 0; i < 64; ++i) { const float w = wgr[(size_t)(kb + i) * 4 + gq]; const float4 xv = *(const float4*)(sx + (kb + i) * 4);
              ag[0] += xv.x * w; ag[1] += xv.y * w; ag[2] += xv.z * w; ag[3] += xv.w * w; } }
#pragma unroll
        for (int tk = 0; tk < 4; ++tk) {
            ae[tk] += __shfl_xor(ae[tk], 32);
            ag[tk] += __shfl_xor(ag[tk], 4); ag[tk] += __shfl_xor(ag[tk], 8); ag[tk] += __shfl_xor(ag[tk], 16); ag[tk] += __shfl_xor(ag[tk], 32);
        }
#pragma unroll
        for (int tk = 0; tk < 4; ++tk) {
            float lg[4];
#pragma unroll
            for (int q = 0; q < 4; ++q) lg[q] = __shfl(ag[tk], q);
            int gs = 0; float mx = lg[0];
#pragma unroll
            for (int q = 1; q < 4; ++q) if (lg[q] > mx) { mx = lg[q]; gs = q; }
            float den = 0.f;
#pragma unroll
            for (int q = 0; q < 4; ++q) den += __expf(lg[q] - mx);
            const float pg = 1.f / den;
            float ev[8];
#pragma unroll
            for (int q = 0; q < 8; ++q) ev[q] = __shfl(ae[tk], gs * 8 + q) + eb[gs * 8 + q];
            int i0 = 0; float v0 = ev[0];
#pragma unroll
            for (int q = 1; q < 8; ++q) if (ev[q] > v0) { v0 = ev[q]; i0 = q; }
            int i1 = -1; float v1 = -INFINITY;
#pragma unroll
            for (int q = 0; q < 8; ++q) if (q != i0 && ev[q] > v1) { v1 = ev[q]; i1 = q; }
            if (lane == 0) {
                const float e1 = __expf(v1 - v0), w0 = pg / (1.f + e1), w1 = pg * e1 / (1.f + e1);
                int* route = (int*)(p.ws + WS_ROUTE) + (size_t)(m0 + tk) * 4;
                route[0] = gs * 8 + i0; route[1] = gs * 8 + i1; route[2] = __float_as_int(w0); route[3] = __float_as_int(w1);
                int* ctl = (int*)(p.ws + WS_CTL);
                atomicAdd(ctl + CT_CNT + gs * 8 + i0, 1); atomicAdd(ctl + CT_CNT + 32 + gs * 8 + i1, 1);
            }
        }
        __builtin_amdgcn_wave_barrier();
    }
}

namespace pg8 {
#define PG8_LAS __attribute__((address_space(3)))
typedef short bf16x8 __attribute__((ext_vector_type(8)));
typedef float f32x4 __attribute__((ext_vector_type(4)));
typedef unsigned u32x4 __attribute__((ext_vector_type(4)));
constexpr int BM = 256, BK = 64, HALF = 128, HTB = HALF * BK * 2, STAGE_BYTES = 8 * HTB, NXCD = 8, WGM = 8;
__host__ __device__ __forceinline__ int lds_byte(int r, int c) { const int st = (r >> 4) * 2 + (c >> 5), rr = r & 15, cc = c & 31, ob = rr * 64 + cc * 2; return st * 1024 + (ob ^ (((ob >> 9) & 1) << 5)); }
__host__ __device__ __forceinline__ void stage_rc(int b, int& R, int& C) { const int st = b / 1024, sb = b % 1024, swz = sb ^ (((sb >> 9) & 1) << 5); R = (st >> 1) * 16 + swz / 64; C = (st & 1) * 32 + (swz % 64) / 2; }
__host__ __device__ __forceinline__ int perm32(int rho) { const int n = rho >> 4, i = rho & 15; return 8 * (i >> 2) + 4 * n + (i & 3); }

struct Unit { int arow, brow, pm, pn, aux; };
struct Gemm { const bf16_t* A; const bf16_t* Bt; int K; const int* gather; };

struct StaticOrder {
    int nM, nN, nwg, G, c;
    __device__ void init(int M, int N, int G_, int c_) { nM = M / BM; nN = N / BM; nwg = nM * nN; G = G_; c = c_; }
    __device__ bool next(int i, Unit& u) const {
        const long L = (long)i * G + c; if (L >= nwg) return false;
        int wgid = (int)L; { const int q = nwg / NXCD, r = nwg % NXCD, xcd = wgid % NXCD, off = wgid / NXCD; wgid = (xcd < r ? xcd * (q + 1) : r * (q + 1) + (xcd - r) * q) + off; }
        const int nig = WGM * nN, gid = wgid / nig, fm = gid * WGM, gsz = (nM - fm) < WGM ? (nM - fm) : WGM;
        u.pm = fm + ((wgid % nig) % gsz); u.pn = (wgid % nig) / gsz; u.arow = u.pm * BM; u.brow = u.pn * BM; u.aux = 0; return true;
    }
};
struct TableOrder {
    const int4* tab; int n, G, c;
    __device__ bool next(int i, Unit& u) const {
        const int L = i * G + c; if (L >= n) return false;
        const int4 e = tab[L]; u.arow = __builtin_amdgcn_readfirstlane(e.x); u.brow = __builtin_amdgcn_readfirstlane(e.y); u.aux = __builtin_amdgcn_readfirstlane(e.z); u.pn = __builtin_amdgcn_readfirstlane(e.w); u.pm = 0; return true;
    }
};
__device__ __forceinline__ unsigned cvt_pk_bf16(float lo, float hi) { unsigned r; asm volatile("v_cvt_pk_bf16_f32 %0, %1, %2" : "=v"(r) : "v"(lo), "v"(hi)); return r; }

template <class Epi, class Sched>
__device__ __forceinline__ void gemm_phase(PG8_LAS unsigned char* lds, const Gemm g, const Sched& S, const Epi& E) {
    const int tid = otid(), wid = __builtin_amdgcn_readfirstlane(tid >> 6), lane = tid & 63, wr = wid >> 2, wc = wid & 3, fr = lane & 15, fq = lane >> 4;
    const int K = g.K, nt = K / BK;
    int RA0; unsigned cofA0, voffB0;
    { int R, C; stage_rc(tid * 16, R, C); const int Rb = Epi::PERM ? ((R & ~31) + perm32(R & 31)) : R; RA0 = R; cofA0 = (unsigned)C * 2u; voffB0 = (unsigned)(Rb * K + C) * 2u; }
    const size_t rstep64 = (size_t)64 * K * 2;
    const size_t kstep = (size_t)(BK * 2);
    const size_t hstep = (size_t)HALF * K * 2;
    const unsigned ldsw = (unsigned)wid * 1024u;
    const int aoff = lds_byte(wr * 64 + fr, fq * 8), boff = lds_byte(wc * 32 + fr, fq * 8);
#define PG8_SA(b, h) (((b) * 2 + (h)) * HTB)
#define PG8_SB(b, h) ((4 + (b) * 2 + (h)) * HTB)
#define PG8_STAGE_B(bufoff, gbase) do { _Pragma("unroll") for (int _i = 0; _i < 2; ++_i) \
        __builtin_amdgcn_global_load_lds((const unsigned*)((const char*)(gbase) + _i * rstep64 + voffB0), (PG8_LAS unsigned*)(lds + (bufoff) + ldsw + _i * 8192), 16, 0, 0); } while (0)
#define PG8_STAGE_A(bufoff, o2, kb) do { _Pragma("unroll") for (int _i = 0; _i < 2; ++_i) \
        __builtin_amdgcn_global_load_lds((const unsigned*)((const char*)g.A + (size_t)(o2)[_i] + (size_t)(kb)), (PG8_LAS unsigned*)(lds + (bufoff) + ldsw + _i * 8192), 16, 0, 0); } while (0)
#define PG8_LDA(dst, b, h) do { _Pragma("unroll") for (int m = 0; m < 4; ++m) _Pragma("unroll") for (int k = 0; k < 2; ++k) dst[m][k] = *(const PG8_LAS bf16x8*)(lds + PG8_SA(b, h) + aoff + m * 2048 + k * 1024); } while (0)
#define PG8_LDB(dst, b, h) do { _Pragma("unroll") for (int n = 0; n < 2; ++n) _Pragma("unroll") for (int k = 0; k < 2; ++k) dst[n][k] = *(const PG8_LAS bf16x8*)(lds + PG8_SB(b, h) + boff + n * 2048 + k * 1024); } while (0)
#define PG8_MMA(ai, bj, At, Bt) do { __builtin_amdgcn_s_setprio(1); _Pragma("unroll") for (int m = 0; m < 4; ++m) _Pragma("unroll") for (int n = 0; n < 2; ++n) _Pragma("unroll") for (int k = 0; k < 2; ++k) \
        acc[ai][bj][m][n] = __builtin_amdgcn_mfma_f32_16x16x32_bf16(Bt[n][k], At[m][k], acc[ai][bj][m][n], 0, 0, 0); __builtin_amdgcn_s_setprio(0); } while (0)
#define PG8_WAIT_V(n) asm volatile("s_waitcnt vmcnt(" #n ")" ::: "memory")
#define PG8_WAIT_L(n) asm volatile("s_waitcnt lgkmcnt(" #n ")" ::: "memory")
#define PG8_BAR __builtin_amdgcn_s_barrier()
#define PG8_SCHED __builtin_amdgcn_sched_barrier(0)
#define PG8_AOFFS(u, dst) do { _Pragma("unroll") for (int _h = 0; _h < 2; ++_h) _Pragma("unroll") for (int _i = 0; _i < 2; ++_i) { \
        const int _tr = (u).arow + _h * HALF + RA0 + 64 * _i; const unsigned _row = g.gather ? (unsigned)g.gather[_tr] : (unsigned)_tr; dst[_h][_i] = _row * (unsigned)(K * 2) + cofA0; } } while (0)
    Unit cur, nxt; int ui = 0;
    if (!S.next(0, cur)) return;
    f32x4 acc[2][2][4][2];
#pragma unroll
    for (int a = 0; a < 2; ++a)
#pragma unroll
        for (int b = 0; b < 2; ++b)
#pragma unroll
            for (int m = 0; m < 4; ++m)
#pragma unroll
                for (int n = 0; n < 2; ++n) acc[a][b][m][n] = (f32x4){0.f, 0.f, 0.f, 0.f};
    bf16x8 At[4][2], B0[2][2], B1[2][2];
    unsigned cof[2][2];
    PG8_AOFFS(cur, cof);
    const char* cB = (const char*)g.Bt + (size_t)cur.brow * K * 2;
    PG8_STAGE_B(PG8_SB(0, 0), cB); PG8_STAGE_B(PG8_SB(0, 1), cB + hstep); PG8_STAGE_A(PG8_SA(0, 0), cof[0], 0); PG8_STAGE_A(PG8_SA(0, 1), cof[1], 0);
    if (wr == 1) PG8_BAR;
    PG8_WAIT_V(2); PG8_BAR;
    PG8_STAGE_B(PG8_SB(1, 0), cB + kstep); PG8_STAGE_A(PG8_SA(1, 0), cof[0], kstep); PG8_STAGE_B(PG8_SB(1, 1), cB + hstep + kstep);
    PG8_WAIT_V(6); PG8_BAR;
    for (;;) {
        const bool has_next = S.next(ui + 1, nxt);
        if (!has_next) nxt = cur;
        const char* nB = (const char*)g.Bt + (size_t)nxt.brow * K * 2;
        for (int t = 0; t < nt; t += 2) {
            const bool last = (t == nt - 2);
            const size_t k1 = (size_t)(t + 1) * kstep;
            const size_t k2 = last ? 0 : (size_t)(t + 2) * kstep, k3 = k2 + kstep;
            const char* b2 = last ? nB : cB + (size_t)(t + 2) * kstep; const char* b3 = b2 + kstep;
            PG8_LDB(B0, 0, 0); PG8_LDB(B1, 0, 1); PG8_SCHED; PG8_LDA(At, 0, 0); PG8_STAGE_A(PG8_SA(1, 1), cof[1], k1);
            if (last) { PG8_AOFFS(nxt, cof); }
            PG8_WAIT_V(8); PG8_WAIT_L(0); PG8_BAR; PG8_MMA(0, 0, At, B0); PG8_MMA(0, 1, At, B1); PG8_BAR; PG8_SCHED;
            PG8_LDA(At, 0, 1); PG8_STAGE_B(PG8_SB(0, 0), b2); PG8_STAGE_B(PG8_SB(0, 1), b2 + hstep); PG8_STAGE_A(PG8_SA(0, 0), cof[0], k2);
            PG8_WAIT_V(8); PG8_WAIT_L(0); PG8_BAR; PG8_MMA(1, 0, At, B0); PG8_MMA(1, 1, At, B1); PG8_BAR; PG8_SCHED;
            PG8_LDB(B0, 1, 0); PG8_LDB(B1, 1, 1); PG8_SCHED; PG8_LDA(At, 1, 0); PG8_STAGE_A(PG8_SA(0, 1), cof[1], k2);
            PG8_WAIT_V(8); PG8_WAIT_L(0); PG8_BAR; PG8_MMA(0, 0, At, B0); PG8_MMA(0, 1, At, B1); PG8_BAR; PG8_SCHED;
            PG8_LDA(At, 1, 1); PG8_STAGE_B(PG8_SB(1, 0), b3); PG8_STAGE_B(PG8_SB(1, 1), b3 + hstep); PG8_STAGE_A(PG8_SA(1, 0), cof[0], k3);
            PG8_WAIT_V(8); PG8_WAIT_L(0); PG8_BAR; PG8_MMA(1, 0, At, B0); PG8_MMA(1, 1, At, B1); PG8_BAR; PG8_SCHED;
        }
        if (wr == 0) PG8_BAR;
        { const int l2 = otid() & 63; E(acc, cur, wr, wc, l2 & 15, l2 >> 4); }
        if (!has_next) break;
#pragma unroll
        for (int a = 0; a < 2; ++a)
#pragma unroll
            for (int b = 0; b < 2; ++b)
#pragma unroll
                for (int m = 0; m < 4; ++m)
#pragma unroll
                    for (int n = 0; n < 2; ++n) acc[a][b][m][n] = (f32x4){0.f, 0.f, 0.f, 0.f};
        cur = nxt; cB = nB; ++ui;
        if (wr == 1) PG8_BAR;
    }
    PG8_WAIT_V(0);
    PG8_BAR;
#undef PG8_SA
#undef PG8_SB
#undef PG8_STAGE_A
#undef PG8_STAGE_B
#undef PG8_LDA
#undef PG8_LDB
#undef PG8_MMA
#undef PG8_WAIT_V
#undef PG8_WAIT_L
#undef PG8_BAR
#undef PG8_SCHED
#undef PG8_AOFFS
}

#define PG8_FENCE asm volatile("" ::: "memory")
#define PG8_FOR_TILE(ai, m, bj) _Pragma("unroll") for (int ai = 0; ai < 2; ++ai) _Pragma("unroll") for (int m = 0; m < 4; ++m) _Pragma("unroll") for (int bj = 0; bj < 2; ++bj)
__device__ __forceinline__ u32x4 pack8(const f32x4& v0, const f32x4& v1) { u32x4 w; w.x = cvt_pk_bf16(v0[0], v0[1]); w.y = cvt_pk_bf16(v0[2], v0[3]); w.z = cvt_pk_bf16(v1[0], v1[1]); w.w = cvt_pk_bf16(v1[2], v1[3]); return w; }
__device__ __forceinline__ float sigm(float x) { return 1.f / (1.f + __expf(-x)); }
struct EpiInproj {
    static constexpr bool PERM = true;
    unsigned char* ws; bf16_t* gates;
    __device__ __forceinline__ void operator()(const f32x4 (&acc)[2][2][4][2], const Unit& u, int wr, int wc, int fr, int fq) const {
        PG8_FOR_TILE(ai, m, bj) { PG8_FENCE;
            int row = u.pm * BM + ai * HALF + wr * 64 + m * 16 + fr; asm volatile("" : "+v"(row)); const int col = u.pn * BM + bj * HALF + wc * 32 + 8 * fq;
            const f32x4 v0 = acc[ai][bj][m][0], v1 = acc[ai][bj][m][1];
            if (col < C_KV) *(u32x4*)((bf16_t*)(ws + WS_Q) + (size_t)row * AW + col) = pack8(v0, v1);
            else if (col < C_QI) *(u32x4*)((bf16_t*)(ws + WS_KVN) + (size_t)row * KVL + (col - C_KV)) = pack8(v0, v1);
            else if (col < C_PS) { float* d = (float*)(ws + WS_IDX) + (size_t)row * IDXW + (col - C_QI); *(f32x4*)d = v0; *(f32x4*)(d + 4) = v1; }
            else if (col < C_GA) *(u32x4*)((bf16_t*)(ws + WS_PS) + (size_t)row * SHW + (col - C_PS)) = pack8(v0, v1);
            else if (col < INW) {
                f32x4 s0, s1;
#pragma unroll
                for (int e = 0; e < 4; ++e) { s0[e] = sigm(v0[e]); s1[e] = sigm(v1[e]); }
                bf16_t* d = (col < C_GR) ? gates + (size_t)row * DM + (col - C_GA) : gates + (size_t)NT * DM + (size_t)row * DM + (col - C_GR);
                *(u32x4*)d = pack8(s0, s1);
            }
        }
    }
};
struct EpiKV {
    static constexpr bool PERM = true;
    unsigned char* ws;
    __device__ __forceinline__ void operator()(const f32x4 (&acc)[2][2][4][2], const Unit& u, int wr, int wc, int fr, int fq) const {
        PG8_FOR_TILE(ai, m, bj) { PG8_FENCE;
            int row = u.pm * BM + ai * HALF + wr * 64 + m * 16 + fr; asm volatile("" : "+v"(row)); const int col = u.pn * BM + bj * HALF + wc * 32 + 8 * fq;
            bf16_t* d = (col < AW) ? (bf16_t*)(ws + WS_K) + (size_t)row * AW + col : (bf16_t*)(ws + WS_V) + (size_t)row * AW + (col - AW);
            *(u32x4*)d = pack8(acc[ai][bj][m][0], acc[ai][bj][m][1]);
        }
    }
};
template <bool SECOND> struct EpiMerge {
    static constexpr bool PERM = true;
    bf16_t* merged; const bf16_t* gate;
    __device__ __forceinline__ void operator()(const f32x4 (&acc)[2][2][4][2], const Unit& u, int wr, int wc, int fr, int fq) const {
        PG8_FOR_TILE(ai, m, bj) { PG8_FENCE;
            int row = u.pm * BM + ai * HALF + wr * 64 + m * 16 + fr; asm volatile("" : "+v"(row)); const int col = u.pn * BM + bj * HALF + wc * 32 + 8 * fq;
            const u32x4 gw = *(const u32x4*)(gate + (size_t)row * DM + col);
            f32x4 v0 = acc[ai][bj][m][0], v1 = acc[ai][bj][m][1];
            v0[0] *= __uint_as_float(gw.x << 16); v0[1] *= __uint_as_float(gw.x & 0xffff0000u); v0[2] *= __uint_as_float(gw.y << 16); v0[3] *= __uint_as_float(gw.y & 0xffff0000u);
            v1[0] *= __uint_as_float(gw.z << 16); v1[1] *= __uint_as_float(gw.z & 0xffff0000u); v1[2] *= __uint_as_float(gw.w << 16); v1[3] *= __uint_as_float(gw.w & 0xffff0000u);
            u32x4* d = (u32x4*)(merged + (size_t)row * DM + col);
            if (SECOND) { const u32x4 pw = *d;
                v0[0] += __uint_as_float(pw.x << 16); v0[1] += __uint_as_float(pw.x & 0xffff0000u); v0[2] += __uint_as_float(pw.y << 16); v0[3] += __uint_as_float(pw.y & 0xffff0000u);
                v1[0] += __uint_as_float(pw.z << 16); v1[1] += __uint_as_float(pw.z & 0xffff0000u); v1[2] += __uint_as_float(pw.w << 16); v1[3] += __uint_as_float(pw.w & 0xffff0000u); }
            *d = pack8(v0, v1);
        }
    }
};
struct EpiOut {
    static constexpr bool PERM = false;
    const float* x; const float* mod; float* out;
    __device__ __forceinline__ void operator()(const f32x4 (&acc)[2][2][4][2], const Unit& u, int wr, int wc, int fr, int fq) const {
        PG8_FOR_TILE(ai, m, bj) { PG8_FENCE;
            int row = u.pm * BM + ai * HALF + wr * 64 + m * 16 + fr; asm volatile("" : "+v"(row)); const float* gt = mod + (row / SEQ) * 6 * DM + 2 * DM;
#pragma unroll
            for (int n = 0; n < 2; ++n) { const int col = u.pn * BM + bj * HALF + wc * 32 + 16 * n + 4 * fq;
                const f32x4 xv = *(const f32x4*)(x + (size_t)row * DM + col), gv = *(const f32x4*)(gt + col);
                *(f32x4*)(out + (size_t)row * DM + col) = xv + gv * acc[ai][bj][m][n]; }
        }
    }
};
struct EpiMoe1 {
    static constexpr bool PERM = true;
    bf16_t* hid; const float* lw;
    __device__ __forceinline__ void operator()(const f32x4 (&acc)[2][2][4][2], const Unit& u, int wr, int wc, int fr, int fq) const {
#pragma unroll
        for (int ai = 0; ai < 2; ++ai)
#pragma unroll
            for (int m = 0; m < 4; ++m) {
                const int tr = ai * HALF + wr * 64 + m * 16 + fr; PG8_FENCE;
                if (tr < u.aux) {
                    const float w = lw[u.arow + tr]; f32x4 h0, h1;
#pragma unroll
                    for (int e = 0; e < 4; ++e) { const float g0 = acc[ai][0][m][0][e], g1 = acc[ai][0][m][1][e];
                        h0[e] = w * (g0 / (1.f + __expf(-g0))) * acc[ai][1][m][0][e]; h1[e] = w * (g1 / (1.f + __expf(-g1))) * acc[ai][1][m][1][e]; }
                    *(u32x4*)(hid + (size_t)(u.arow + tr) * DE + u.pn * HALF + wc * 32 + 8 * fq) = pack8(h0, h1);
                }
            }
    }
};
struct EpiMoe2 {
    static constexpr bool PERM = false;
    const int* ltok; const float* mod; float* out;
    __device__ __forceinline__ void operator()(const f32x4 (&acc)[2][2][4][2], const Unit& u, int wr, int wc, int fr, int fq) const {
#pragma unroll
        for (int ai = 0; ai < 2; ++ai)
#pragma unroll
            for (int m = 0; m < 4; ++m) {
                const int tr = ai * HALF + wr * 64 + m * 16 + fr; PG8_FENCE;
                if (tr < u.aux) {
                    const int tok = ltok[u.arow + tr]; const float* gt = mod + (tok / SEQ) * 6 * DM + 5 * DM; float* orow = out + (size_t)tok * DM;
#pragma unroll
                    for (int bj = 0; bj < 2; ++bj)
#pragma unroll
                        for (int n = 0; n < 2; ++n) { const int col = u.pn * BM + bj * HALF + wc * 32 + 16 * n + 4 * fq;
                            const f32x4 gv = *(const f32x4*)(gt + col); f32x4* d = (f32x4*)(orow + col); *d = *d + gv * acc[ai][bj][m][n]; }
                }
            }
    }
};
}

__device__ __forceinline__ unsigned pk2(float lo, float hi) { return (unsigned)f2bf(lo) | ((unsigned)f2bf(hi) << 16); }
__device__ __forceinline__ void transpose_item(const float* W, int K, int N, bf16_t* WT, size_t drow0, int k0, int n0, float* scr, int lane) {
#pragma unroll 8
    for (int i = 0; i < 32; ++i) { const int kk = 2 * i + (lane >> 5), n = n0 + (lane & 31); scr[kk * 33 + (lane & 31)] = (n < N) ? W[(size_t)(k0 + kk) * N + n] : 0.f; }
    asm volatile("s_waitcnt lgkmcnt(0)" ::: "memory");
    const int c = lane & 7;
#pragma unroll
    for (int j = 0; j < 4; ++j) { const int n = (lane >> 3) + 8 * j; const float* s_ = scr + (8 * c) * 33 + n;
        uint4 o; o.x = pk2(s_[0 * 33], s_[1 * 33]); o.y = pk2(s_[2 * 33], s_[3 * 33]); o.z = pk2(s_[4 * 33], s_[5 * 33]); o.w = pk2(s_[6 * 33], s_[7 * 33]);
        *(uint4*)(WT + (drow0 + n) * K + k0 + 8 * c) = o; }
    asm volatile("s_waitcnt lgkmcnt(0)" ::: "memory");
}
__device__ void ph_convert_mixer_weights(const P& p, float* lds) {
    const int lane = otid() & 63, wv = otid() >> 6;
    float* scr = lds + wv * (64 * 33);
    const int gw = blockIdx.x * (NTHR / 64) + wv, nw = gridDim.x * (NTHR / 64);
    struct M { const float* W; int K, N, Npad; size_t dst; };
    const M ms[5] = { {p.in[5], DM, INW, 5120, WS_WIN}, {p.in[7], KVL, 2 * AW, 2 * AW, WS_WKV}, {p.in[21], AW, DM, DM, WS_WBA}, {p.in[22], RW, DM, DM, WS_WBR}, {p.in[23], DM, DM, DM, WS_WOUT} };
    int base = 0;
#pragma unroll
    for (int q = 0; q < 5; ++q) {
        const int nkb = ms[q].K / 64, nnb = ms[q].Npad / 32, nitems = nkb * nnb;
        for (int it = gw; it < base + nitems; it += nw) { if (it < base) continue; const int r = it - base; const int kb = r / nnb, nb = r % nnb;
            transpose_item(ms[q].W, ms[q].K, ms[q].N, (bf16_t*)(p.ws + ms[q].dst), (size_t)nb * 32, kb * 64, nb * 32, scr, lane); }
        base += nitems;
    }
}
__device__ void ph_convert_expert_weights(const P& p, float* lds) {
    const int lane = otid() & 63, wv = otid() >> 6;
    float* scr = lds + wv * (64 * 33);
    const int gw = blockIdx.x * (NTHR / 64) + wv, nw = gridDim.x * (NTHR / 64);
    for (int it = gw; it < NE * 2 * 256; it += nw) { const int e = it >> 9, which = (it >> 8) & 1, r = it & 255, kb = r >> 4, nb = r & 15, n0 = nb * 32;
        transpose_item(p.in[28 + which] + (size_t)e * DM * DE, DM, DE, (bf16_t*)(p.ws + WS_WGU), (size_t)e * 1024 + (n0 >> 7) * 256 + which * 128 + (n0 & 127), kb * 64, n0, scr, lane); }
    for (int it = gw; it < NE * 256; it += nw) { const int e = it >> 8, r = it & 255, kb = r >> 5, nb = r & 31;
        transpose_item(p.in[30] + (size_t)e * DE * DM, DE, DM, (bf16_t*)(p.ws + WS_WDN), (size_t)e * 1024 + nb * 32, kb * 64, nb * 32, scr, lane); }
}

__device__ void ph_headnorm(bf16_t* X, const float* g) {
    const int lane = otid() & 63, wv = otid() >> 6;
    const int gw = blockIdx.x * (NTHR / 64) + wv, nw = gridDim.x * (NTHR / 64);
    for (int m = gw; m < NT; m += nw) {
        uint4 raw = *(const uint4*)(X + (size_t)m * AW + lane * 8);
        float v[8] = {bf2f(raw.x & 0xffff), bf2f(raw.x >> 16), bf2f(raw.y & 0xffff), bf2f(raw.y >> 16), bf2f(raw.z & 0xffff), bf2f(raw.z >> 16), bf2f(raw.w & 0xffff), bf2f(raw.w >> 16)};
        float ss = 0.f;
#pragma unroll
        for (int i = 0; i < 8; ++i) ss += v[i] * v[i];
        ss += __shfl_xor(ss, 1); ss += __shfl_xor(ss, 2); ss += __shfl_xor(ss, 4);
        const float rstd = rsqrtf(ss * (1.f / 64.f) + NORM_EPS);
        const int d0 = (lane & 7) * 8;
        unsigned o[4];
#pragma unroll
        for (int i = 0; i < 4; ++i) o[i] = (unsigned)f2bf(v[2 * i] * rstd * g[d0 + 2 * i]) | ((unsigned)f2bf(v[2 * i + 1] * rstd * g[d0 + 2 * i + 1]) << 16);
        *(uint4*)(X + (size_t)m * AW + lane * 8) = make_uint4(o[0], o[1], o[2], o[3]);
    }
}
__device__ void ph_kvnorm(bf16_t* X, const float* g) {
    const int lane = otid() & 63, wv = otid() >> 6;
    const int gw = blockIdx.x * (NTHR / 64) + wv, nw = gridDim.x * (NTHR / 64);
    for (int m = gw; m < NT; m += nw) {
        uint2 raw = *(const uint2*)(X + (size_t)m * KVL + lane * 4);
        float v[4] = {bf2f(raw.x & 0xffff), bf2f(raw.x >> 16), bf2f(raw.y & 0xffff), bf2f(raw.y >> 16)};
        float ss = wave_sum(v[0] * v[0] + v[1] * v[1] + v[2] * v[2] + v[3] * v[3]);
        const float rstd = rsqrtf(ss * (1.f / 256.f) + NORM_EPS);
        uint2 o; o.x = (unsigned)f2bf(v[0] * rstd * g[lane * 4]) | ((unsigned)f2bf(v[1] * rstd * g[lane * 4 + 1]) << 16);
        o.y = (unsigned)f2bf(v[2] * rstd * g[lane * 4 + 2]) | ((unsigned)f2bf(v[3] * rstd * g[lane * 4 + 3]) << 16);
        *(uint2*)(X + (size_t)m * KVL + lane * 4) = o;
    }
}

__device__ __forceinline__ unsigned f2key(float f) { unsigned u = __float_as_uint(f); return (u & 0x80000000u) ? ~u : (u | 0x80000000u); }
__device__ void ph_dsa(const P& p, float* lds) {
    const float* IDX = (const float*)(p.ws + WS_IDX);
    const bf16_t* Q = (const bf16_t*)(p.ws + WS_Q); const bf16_t* Kb = (const bf16_t*)(p.ws + WS_K); const bf16_t* Vb = (const bf16_t*)(p.ws + WS_V);
    bf16_t* O = (bf16_t*)(p.ws + WS_OATT);
    unsigned* s_key = (unsigned*)lds;
    float* s_qi = lds + 8192;
    float* s_w = s_qi + 256;
    float* s_q = s_w + 8;
    int* s_sel = (int*)(s_q + 512);
    float* s_lg = (float*)(s_sel + 256);
    unsigned* s_hist = (unsigned*)(s_lg + 2048);
    int* s_misc = (int*)(s_hist + 256);
    float* s_inv = (float*)(s_misc + 16);
    const int tid = otid(), lane = tid & 63, wv = tid >> 6;
    const float idx_scale = 0.17677669529663687f * 0.35355339059327373f;
    for (int tq = blockIdx.x; tq < NT; tq += gridDim.x) {
        const int b = tq / SEQ, t = tq % SEQ, n = t + 1;
        __syncthreads();
        const float* ir = IDX + (size_t)tq * IDXW;
        if (tid < 256) s_qi[tid] = ir[tid];
        if (tid < 8) s_w[tid] = ir[288 + tid] * idx_scale;
        s_q[tid] = bf2f(Q[(size_t)tq * AW + tid]);
        __syncthreads();
        int nsel;
        if (n <= TOPK) { if (tid < n) s_sel[tid] = tid; nsel = n; __syncthreads(); }
        else {
            for (int s = tid; s < n; s += NTHR) {
                const float4* kp = (const float4*)(IDX + (size_t)(b * SEQ + s) * IDXW + 256);
                float kv[32];
#pragma unroll
                for (int i = 0; i < 8; ++i) { float4 v4 = kp[i]; kv[4 * i] = v4.x; kv[4 * i + 1] = v4.y; kv[4 * i + 2] = v4.z; kv[4 * i + 3] = v4.w; }
                float sc = 0.f;
#pragma unroll 1
                for (int h = 0; h < 8; ++h) { float d = 0.f;
#pragma unroll
                    for (int i = 0; i < 32; ++i) d += s_qi[h * 32 + i] * kv[i];
                    sc += s_w[h] * fmaxf(d, 0.f); }
                s_key[s] = f2key(sc);
            }
            unsigned prefix = 0; int remaining = TOPK; int cnt_eq = 0;
            for (int pass = 0; pass < 4; ++pass) {
                const int shift = 24 - 8 * pass;
                if (tid < 256) s_hist[tid] = 0;
                __syncthreads();
                for (int s = tid; s < n; s += NTHR) { const unsigned k = s_key[s]; if (pass == 0 || (k >> (shift + 8)) == (prefix >> (shift + 8))) atomicAdd(&s_hist[(k >> shift) & 255u], 1u); }
                __syncthreads();
                unsigned hv = 0, suf = 0;
                if (tid < 256) { hv = s_hist[tid]; suf = hv;
#pragma unroll
                    for (int o = 1; o < 64; o <<= 1) { unsigned oth = __shfl_down(suf, o); if (lane + o < 64) suf += oth; }
                    if (lane == 0) s_misc[4 + wv] = (int)suf; }
                __syncthreads();
                if (tid < 256) { for (int w2 = wv + 1; w2 < 4; ++w2) suf += (unsigned)s_misc[4 + w2];
                    const unsigned above = suf - hv;
                    if ((int)above < remaining && remaining <= (int)(above + hv)) { s_misc[0] = tid; s_misc[1] = remaining - (int)above; s_misc[2] = (int)hv; } }
                __syncthreads();
                prefix |= ((unsigned)s_misc[0]) << shift; remaining = s_misc[1]; cnt_eq = s_misc[2];
                __syncthreads();
            }
            if (tid == 0) s_misc[3] = 0;
            __syncthreads();
            for (int s = tid; s < n; s += NTHR) { const unsigned k = s_key[s]; if (k > prefix || (k == prefix && cnt_eq == remaining)) { int pos = atomicAdd(&s_misc[3], 1); s_sel[pos] = s; } }
            __syncthreads();
            if (cnt_eq != remaining && wv == 0) {
                int base = s_misc[3], taken = 0;
                for (int s0 = 0; s0 < n && taken < remaining; s0 += 64) { const int s = s0 + lane; const bool f = (s < n) && (s_key[s] == prefix);
                    const unsigned long long mk = __ballot(f); const int pre = __popcll(mk & ((1ull << lane) - 1ull));
                    if (f && taken + pre < remaining) s_sel[base + taken + pre] = s;
                    taken += __popcll(mk); }
            }
            nsel = TOPK;
            __syncthreads();
        }
        {
            const int j = tid & 255, hh = tid >> 8;
            float lg4[4] = {-INFINITY, -INFINITY, -INFINITY, -INFINITY};
            if (j < nsel) {
                const int s = s_sel[j];
                const uint4* kr = (const uint4*)(Kb + (size_t)(b * SEQ + s) * AW + hh * 256);
#pragma unroll
                for (int h4 = 0; h4 < 4; ++h4) { float d = 0.f; const float* qv = s_q + (hh * 4 + h4) * 64;
#pragma unroll
                    for (int c = 0; c < 8; ++c) { uint4 r = kr[h4 * 8 + c];
                        d += qv[c * 8 + 0] * bf2f(r.x & 0xffff) + qv[c * 8 + 1] * bf2f(r.x >> 16) + qv[c * 8 + 2] * bf2f(r.y & 0xffff) + qv[c * 8 + 3] * bf2f(r.y >> 16)
                           + qv[c * 8 + 4] * bf2f(r.z & 0xffff) + qv[c * 8 + 5] * bf2f(r.z >> 16) + qv[c * 8 + 6] * bf2f(r.w & 0xffff) + qv[c * 8 + 7] * bf2f(r.w >> 16); }
                    const int h = hh * 4 + h4; const float slope = exp2f(-(float)(h + 1));
                    lg4[h4] = d * 0.125f - slope * (float)(t - s); }
            }
#pragma unroll
            for (int h4 = 0; h4 < 4; ++h4) s_lg[(hh * 4 + h4) * 256 + j] = lg4[h4];
        }
        __syncthreads();
        {
            float v[4]; float mx = -INFINITY;
#pragma unroll
            for (int i = 0; i < 4; ++i) { v[i] = s_lg[wv * 256 + lane + 64 * i]; mx = fmaxf(mx, v[i]); }
            mx = wave_max(mx); float sm = 0.f;
#pragma unroll
            for (int i = 0; i < 4; ++i) { v[i] = __expf(v[i] - mx); sm += v[i]; s_lg[wv * 256 + lane + 64 * i] = v[i]; }
            sm = wave_sum(sm);
            if (lane == 0) s_inv[wv] = 1.f / sm;
        }
        __syncthreads();
        {
            float acc = 0.f; const float* pr = s_lg + wv * 256;
            const bf16_t* vb = Vb + (size_t)b * SEQ * AW + tid;
#pragma unroll 8
            for (int j = 0; j < nsel; ++j) acc += pr[j] * bf2f(vb[(size_t)s_sel[j] * AW]);
            O[(size_t)tq * AW + tid] = f2bf(acc * s_inv[wv]);
        }
    }
}

__device__ void ph_rwkv_prep(const P& p, float* lds) {
    const bf16_t* PS = (const bf16_t*)(p.ws + WS_PS);
    const float* mu = p.in[10]; const float* w0 = p.in[11]; const float* w2 = p.in[12]; const float* a0 = p.in[13]; const float* a2 = p.in[14]; const float* g2 = p.in[15];
    const float* k_k = p.in[16]; const float* k_a = p.in[17];
    bf16_t* R = (bf16_t*)(p.ws + WS_R); bf16_t* K2 = (bf16_t*)(p.ws + WS_K2); bf16_t* VV = (bf16_t*)(p.ws + WS_VV); bf16_t* KK = (bf16_t*)(p.ws + WS_KK); bf16_t* BB = (bf16_t*)(p.ws + WS_BB);
    bf16_t* G = (bf16_t*)(p.ws + WS_G); float* DD = (float*)(p.ws + WS_DD);
    float* s_tw = lds; float* s_al = lds + 8 * 64; float* s_sg = lds + 16 * 64;
    const int tid = otid();
    for (int grp = blockIdx.x; grp < NT / 8; grp += gridDim.x) {
        const int m0 = grp * 8;
        __syncthreads();
        for (int e = tid; e < 8 * 288; e += NTHR) {
            const int tk = e / 288, c = e % 288, col = 1536 + c, m = m0 + tk;
            const float cur = bf2f(PS[(size_t)m * SHW + col]);
            const float prv = (m % SEQ) ? bf2f(PS[(size_t)(m - 1) * SHW + col]) : 0.f;
            const float mx = cur + (prv - cur) * mu[col];
            if (c < 64) s_tw[tk * 64 + c] = tanhf(mx); else if (c < 128) s_al[tk * 64 + (c - 64)] = mx; else s_sg[tk * 160 + (c - 128)] = sigmoidf_(mx);
        }
        __syncthreads();
        float accw[8], acca[8], accg[8];
#pragma unroll
        for (int i = 0; i < 8; ++i) { accw[i] = 0.f; acca[i] = 0.f; accg[i] = 0.f; }
        for (int i = 0; i < 64; ++i) { const float wv_ = w2[i * RW + tid], av_ = a2[i * RW + tid];
#pragma unroll
            for (int tk = 0; tk < 8; ++tk) { accw[tk] += s_tw[tk * 64 + i] * wv_; acca[tk] += s_al[tk * 64 + i] * av_; } }
        for (int i = 0; i < 160; ++i) { const float gv_ = g2[i * RW + tid];
#pragma unroll
            for (int tk = 0; tk < 8; ++tk) accg[tk] += s_sg[tk * 160 + i] * gv_; }
        const float w0c = w0[tid], a0c = a0[tid], kkc = k_k[tid], kac = k_a[tid], mur = mu[tid], muk = mu[512 + tid], muv = mu[1024 + tid];
#pragma unroll
        for (int tk = 0; tk < 8; ++tk) {
            const int m = m0 + tk; const bool first = (m % SEQ) == 0;
            const bf16_t* cr = PS + (size_t)m * SHW; const bf16_t* pr = PS + (size_t)(m - 1) * SHW;
            const float rc = bf2f(cr[tid]), kc = bf2f(cr[512 + tid]), vc = bf2f(cr[1024 + tid]);
            const float rp = first ? 0.f : bf2f(pr[tid]), kp = first ? 0.f : bf2f(pr[512 + tid]), vp = first ? 0.f : bf2f(pr[1024 + tid]);
            const float r = rc + (rp - rc) * mur, k = kc + (kp - kc) * muk, v = vc + (vp - vc) * muv;
            const float xw = -(w0c + accw[tk]);
            const float sp = fmaxf(xw, 0.f) + log1pf(__expf(-fabsf(xw)));
            const float w = -sp - 0.5f;
            const float dec = -__expf(w);
            const float a = sigmoidf_(a0c + acca[tk]);
            const float kkr = k * kkc;
            const float ss = wave_sum(kkr * kkr);
            const float kk = kkr / fmaxf(sqrtf(ss), 1e-12f);
            const float k2 = k * (1.f + (a - 1.f) * kac);
            const size_t o = (size_t)m * RW + tid;
            R[o] = f2bf(r); K2[o] = f2bf(k2); VV[o] = f2bf(v); KK[o] = f2bf(kk); BB[o] = f2bf(kk * a); G[o] = f2bf(accg[tk]); DD[o] = dec;
        }
    }
}

typedef short bf16x8_t __attribute__((ext_vector_type(8)));
typedef float f32x4_t __attribute__((ext_vector_type(4)));
constexpr int LP = 72;
constexpr int SLOT = 64 * LP;
template <bool XC, bool YC>
__device__ __forceinline__ f32x4_t mm_tile(const bf16_t* X, int xrs, int xcs, const bf16_t* Y, int yrs, int ycs, int tr, int tc, f32x4_t acc, int lane) {
    const int r = lane & 15, q = lane >> 4;
#pragma unroll
    for (int s2 = 0; s2 < 2; ++s2) {
        bf16x8_t a, b;
        const bf16_t* xp = X + (16 * tr + r) * xrs + (32 * s2 + 8 * q) * xcs;
        if (XC) a = *(const bf16x8_t*)xp; else {
#pragma unroll
            for (int j = 0; j < 8; ++j) a[j] = (short)xp[j * xcs]; }
        const bf16_t* yp = Y + (32 * s2 + 8 * q) * yrs + (16 * tc + r) * ycs;
        if (YC) b = *(const bf16x8_t*)yp; else {
#pragma unroll
            for (int j = 0; j < 8; ++j) b[j] = (short)yp[j * yrs]; }
        acc = __builtin_amdgcn_mfma_f32_16x16x32_bf16(a, b, acc, 0, 0, 0);
    }
    return acc;
}
__device__ __forceinline__ void st_tile(const f32x4_t& acc, bf16_t* D, int drs, int dcs, int tr, int tc, int lane) {
    const int row0 = 16 * tr + 4 * (lane >> 4), col = 16 * tc + (lane & 15);
#pragma unroll
    for (int e = 0; e < 4; ++e) D[(row0 + e) * drs + col * dcs] = f2bf(acc[e]);
}
__device__ __forceinline__ f32x4_t ld_tile(const bf16_t* D, int drs, int dcs, int tr, int tc, int lane) {
    const int row0 = 16 * tr + 4 * (lane >> 4), col = 16 * tc + (lane & 15); f32x4_t v;
#pragma unroll
    for (int e = 0; e < 4; ++e) v[e] = bf2f(D[(row0 + e) * drs + col * dcs]);
    return v;
}
template <bool STRICT> __device__ __forceinline__ void triu_tile(f32x4_t& acc, int tr, int tc, int lane) {
    const int row0 = 16 * tr + 4 * (lane >> 4), col = 16 * tc + (lane & 15);
#pragma unroll
    for (int e = 0; e < 4; ++e) { const bool keep = STRICT ? (row0 + e < col) : (row0 + e <= col); acc[e] = keep ? acc[e] : 0.f; }
}

__device__ void ph_rwkv_r1(const P& p, float* ldsf) {
    const bf16_t* R = (const bf16_t*)(p.ws + WS_R); const bf16_t* K2 = (const bf16_t*)(p.ws + WS_K2); const bf16_t* VV = (const bf16_t*)(p.ws + WS_VV);
    const bf16_t* KK = (const bf16_t*)(p.ws + WS_KK); const bf16_t* BB = (const bf16_t*)(p.ws + WS_BB); const float* DD = (const float*)(p.ws + WS_DD);
    bf16_t* G1T = (bf16_t*)(p.ws + WS_G1T); bf16_t* G2T = (bf16_t*)(p.ws + WS_G2T); bf16_t* PT = (bf16_t*)(p.ws + WS_PT); bf16_t* QT = (bf16_t*)(p.ws + WS_QT);
    bf16_t* L = (bf16_t*)ldsf;
    bf16_t* At = L + 0 * SLOT; bf16_t* Bt = L + 1 * SLOT; bf16_t* Kt = L + 2 * SLOT; bf16_t* Rt = L + 3 * SLOT; bf16_t* Vm = L + 4 * SLOT; bf16_t* Bh = L + 5 * SLOT; bf16_t* Kh = L + 6 * SLOT;
    bf16_t* S7 = L + 7 * SLOT; bf16_t* S8 = L + 8 * SLOT; bf16_t* S9 = L + 9 * SLOT; bf16_t* S10 = L + 10 * SLOT; bf16_t* S11 = L + 11 * SLOT;
    float* cs = (float*)(L + 12 * SLOT);
    float* segs = cs + 64 * 65;
    const int tid = otid(), lane = tid & 63, wv = tid >> 6;
    const int t0 = 2 * wv, t1 = 2 * wv + 1;
    for (int ch = blockIdx.x; ch < NB * 8 * (SEQ / 64); ch += gridDim.x) {
        const int bh = ch >> 7, c = ch & 127, b = bh >> 3, h = bh & 7;
        const size_t gbase = ((size_t)b * SEQ + (size_t)c * 64) * RW + h * 64;
        __syncthreads();
        const int st = tid >> 3, sj = (tid & 7) * 8;
        { const float4 l0 = *(const float4*)(DD + gbase + (size_t)st * RW + sj), l1 = *(const float4*)(DD + gbase + (size_t)st * RW + sj + 4);
          float* d = cs + st * 65 + sj; d[0] = l0.x; d[1] = l0.y; d[2] = l0.z; d[3] = l0.w; d[4] = l1.x; d[5] = l1.y; d[6] = l1.z; d[7] = l1.w; }
        __syncthreads();
        { const int j = tid & 63, sg = tid >> 6; float run = 0.f;
#pragma unroll
          for (int i = 0; i < 8; ++i) { run += cs[(sg * 8 + i) * 65 + j]; }
          segs[sg * 64 + j] = run; }
        __syncthreads();
        { const int j = tid & 63, sg = tid >> 6; float run = 0.f;
          for (int q = 0; q < sg; ++q) run += segs[q * 64 + j];
#pragma unroll
          for (int i = 0; i < 8; ++i) { run += cs[(sg * 8 + i) * 65 + j]; cs[(sg * 8 + i) * 65 + j] = run; } }
        __syncthreads();
        {
            const uint4 rr = *(const uint4*)(R + gbase + (size_t)st * RW + sj), kr = *(const uint4*)(K2 + gbase + (size_t)st * RW + sj), vr = *(const uint4*)(VV + gbase + (size_t)st * RW + sj);
            const uint4 kkr = *(const uint4*)(KK + gbase + (size_t)st * RW + sj), br = *(const uint4*)(BB + gbase + (size_t)st * RW + sj);
            const unsigned rw_[4] = {rr.x, rr.y, rr.z, rr.w}, kw_[4] = {kr.x, kr.y, kr.z, kr.w}, kkw_[4] = {kkr.x, kkr.y, kkr.z, kkr.w}, bw_[4] = {br.x, br.y, br.z, br.w};
            *(uint4*)(Vm + st * LP + sj) = vr;
            unsigned oa[4], ob[4], ok[4], orr[4], obh[4], okh[4];
#pragma unroll
            for (int e2 = 0; e2 < 4; ++e2) {
                float va[2], vb[2], vk[2], vr2[2], vbh[2], vkh[2];
#pragma unroll
                for (int hf = 0; hf < 2; ++hf) {
                    const int j = sj + 2 * e2 + hf;
                    const float lgI = cs[st * 65 + j], lgE = st ? cs[(st - 1) * 65 + j] : 0.f, gl = cs[63 * 65 + j];
                    const float rv = hf ? __uint_as_float(rw_[e2] & 0xffff0000u) : __uint_as_float(rw_[e2] << 16);
                    const float kv = hf ? __uint_as_float(kw_[e2] & 0xffff0000u) : __uint_as_float(kw_[e2] << 16);
                    const float kkv = hf ? __uint_as_float(kkw_[e2] & 0xffff0000u) : __uint_as_float(kkw_[e2] << 16);
                    const float bv = hf ? __uint_as_float(bw_[e2] & 0xffff0000u) : __uint_as_float(bw_[e2] << 16);
                    const float einv = __expf(-lgI), eh = __expf(gl - lgI);
                    va[hf] = -kkv * __expf(lgE); vb[hf] = bv * einv; vk[hf] = kv * einv; vr2[hf] = rv * __expf(lgI); vbh[hf] = bv * eh; vkh[hf] = kv * eh;
                }
                oa[e2] = (unsigned)f2bf(va[0]) | ((unsigned)f2bf(va[1]) << 16); ob[e2] = (unsigned)f2bf(vb[0]) | ((unsigned)f2bf(vb[1]) << 16);
                ok[e2] = (unsigned)f2bf(vk[0]) | ((unsigned)f2bf(vk[1]) << 16); orr[e2] = (unsigned)f2bf(vr2[0]) | ((unsigned)f2bf(vr2[1]) << 16);
                obh[e2] = (unsigned)f2bf(vbh[0]) | ((unsigned)f2bf(vbh[1]) << 16); okh[e2] = (unsigned)f2bf(vkh[0]) | ((unsigned)f2bf(vkh[1]) << 16);
            }
            *(uint4*)(At + st * LP + sj) = make_uint4(oa[0], oa[1], oa[2], oa[3]); *(uint4*)(Bt + st * LP + sj) = make_uint4(ob[0], ob[1], ob[2], ob[3]);
            *(uint4*)(Kt + st * LP + sj) = make_uint4(ok[0], ok[1], ok[2], ok[3]); *(uint4*)(Rt + st * LP + sj) = make_uint4(orr[0], orr[1], orr[2], orr[3]);
            *(uint4*)(Bh + st * LP + sj) = make_uint4(obh[0], obh[1], obh[2], obh[3]); *(uint4*)(Kh + st * LP + sj) = make_uint4(okh[0], okh[1], okh[2], okh[3]);
        }
        __syncthreads();
#define R1_FOR_TILES(idx, tr, tc) _Pragma("unroll") for (int _q = 0; _q < 2; ++_q) { const int idx = _q ? t1 : t0; const int tr = idx >> 2, tc = idx & 3;
#define R1_END }
        const f32x4_t zero4 = {0.f, 0.f, 0.f, 0.f};
        R1_FOR_TILES(idx, tr, tc)
            f32x4_t mab = mm_tile<true, true>(Bt, LP, 1, At, 1, LP, tr, tc, zero4, lane); triu_tile<true>(mab, tr, tc, lane); st_tile(mab, S7, LP, 1, tr, tc, lane);
            { f32x4_t tt = mab; const int row0 = 16 * tr + 4 * (lane >> 4), col = 16 * tc + (lane & 15);
#pragma unroll
              for (int e = 0; e < 4; ++e) tt[e] += (row0 + e == col) ? 1.f : 0.f;
              st_tile(tt, S11, LP, 1, tr, tc, lane); }
            f32x4_t mka = mm_tile<true, true>(Kt, LP, 1, At, 1, LP, tr, tc, zero4, lane); triu_tile<true>(mka, tr, tc, lane); st_tile(mka, S8, LP, 1, tr, tc, lane);
            f32x4_t nbr = mm_tile<true, true>(Bt, LP, 1, Rt, 1, LP, tr, tc, zero4, lane); triu_tile<false>(nbr, tr, tc, lane); st_tile(nbr, S9, LP, 1, tr, tc, lane);
            f32x4_t nkr = mm_tile<true, true>(Kt, LP, 1, Rt, 1, LP, tr, tc, zero4, lane); triu_tile<false>(nkr, tr, tc, lane); st_tile(nkr, S10, LP, 1, tr, tc, lane);
        R1_END
        __syncthreads();
        bf16_t* Pc = S7; bf16_t* Pn = Kt; bf16_t* Tc = S11; bf16_t* Tn = Bt;
#pragma unroll 1
        for (int lvl = 0; lvl < 5; ++lvl) {
            R1_FOR_TILES(idx, tr, tc)
                f32x4_t pp = mm_tile<true, false>(Pc, LP, 1, Pc, LP, 1, tr, tc, zero4, lane); st_tile(pp, Pn, LP, 1, tr, tc, lane);
            R1_END
            __syncthreads();
            R1_FOR_TILES(idx, tr, tc)
                f32x4_t tn = ld_tile(Tc, LP, 1, tr, tc, lane); tn = mm_tile<true, false>(Tc, LP, 1, Pn, LP, 1, tr, tc, tn, lane); st_tile(tn, Tn, LP, 1, tr, tc, lane);
            R1_END
            __syncthreads();
            bf16_t* x_ = Pc; Pc = Pn; Pn = x_; x_ = Tc; Tc = Tn; Tn = x_;
        }
        bf16_t* W1 = Pc; bf16_t* W2 = Pn; bf16_t* Qk = Tn;
        R1_FOR_TILES(idx, tr, tc)
            f32x4_t w1 = mm_tile<false, false>(At, 1, LP, Tc, LP, 1, tr, tc, zero4, lane); st_tile(w1, W1, LP, 1, tr, tc, lane);
            f32x4_t w2 = mm_tile<true, false>(S8, LP, 1, Tc, LP, 1, tr, tc, zero4, lane); st_tile(w2, W2, LP, 1, tr, tc, lane);
        R1_END
        __syncthreads();
        const size_t ob_ = (size_t)ch * 4096;
        R1_FOR_TILES(idx, tr, tc)
            f32x4_t g1 = ld_tile(Rt, 1, LP, tr, tc, lane); g1 = mm_tile<true, false>(W1, LP, 1, S9, LP, 1, tr, tc, g1, lane); st_tile(g1, G1T + ob_, 1, 64, tr, tc, lane);
            f32x4_t g2 = ld_tile(S10, LP, 1, tr, tc, lane); g2 = mm_tile<true, false>(W2, LP, 1, S9, LP, 1, tr, tc, g2, lane); st_tile(g2, G2T + ob_, 1, 64, tr, tc, lane);
            f32x4_t pm = mm_tile<true, false>(W1, LP, 1, Bh, LP, 1, tr, tc, zero4, lane);
            { const int row0 = 16 * tr + 4 * (lane >> 4), col = 16 * tc + (lane & 15);
#pragma unroll
              for (int e = 0; e < 4; ++e) pm[e] += (row0 + e == col) ? __expf(cs[63 * 65 + col]) : 0.f; }
            st_tile(pm, PT + ob_, 1, 64, tr, tc, lane);
            f32x4_t qk = ld_tile(Kh, LP, 1, tr, tc, lane); qk = mm_tile<true, false>(W2, LP, 1, Bh, LP, 1, tr, tc, qk, lane); st_tile(qk, Qk, LP, 1, tr, tc, lane);
        R1_END
        __syncthreads();
        R1_FOR_TILES(idx, tr, tc)
            f32x4_t qt = mm_tile<false, false>(Qk, 1, LP, Vm, LP, 1, tr, tc, zero4, lane); st_tile(qt, QT + ob_, 64, 1, tr, tc, lane);
        R1_END
    }
}
__device__ void ph_rwkv_r2(const P& p, float* ldsf) {
    const bf16_t* PT = (const bf16_t*)(p.ws + WS_PT); const bf16_t* QT = (const bf16_t*)(p.ws + WS_QT); bf16_t* SX = (bf16_t*)(p.ws + WS_SX);
    bf16_t* L = (bf16_t*)ldsf; bf16_t* X0 = L; bf16_t* X1 = L + SLOT;
    const int tid = otid(), lane = tid & 63, wv = tid >> 6; const int t0 = 2 * wv, t1 = 2 * wv + 1;
    for (int bh = blockIdx.x; bh < NB * 8; bh += gridDim.x) {
        __syncthreads();
        for (int e = tid; e < SLOT; e += NTHR) X0[e] = 0;
        __syncthreads();
        bf16_t* Xc = X0; bf16_t* Xn = X1;
        for (int c = 0; c < SEQ / 64; ++c) {
            const size_t ob_ = ((size_t)bh * 128 + c) * 4096;
            R1_FOR_TILES(idx, tr, tc)
                { f32x4_t xv = ld_tile(Xc, LP, 1, tr, tc, lane); st_tile(xv, SX + ob_, 1, 64, tr, tc, lane); }
                f32x4_t xn = ld_tile(QT + ob_, 64, 1, tr, tc, lane);
                xn = mm_tile<true, false>(PT + ob_, 64, 1, Xc, LP, 1, tr, tc, xn, lane);
                st_tile(xn, Xn, LP, 1, tr, tc, lane);
            R1_END
            __syncthreads();
            bf16_t* x_ = Xc; Xc = Xn; Xn = x_;
        }
    }
}
__device__ void ph_rwkv_r3(const P& p, float* ldsf) {
    const bf16_t* VV = (const bf16_t*)(p.ws + WS_VV); const bf16_t* G1T = (const bf16_t*)(p.ws + WS_G1T); const bf16_t* G2T = (const bf16_t*)(p.ws + WS_G2T); const bf16_t* SX = (const bf16_t*)(p.ws + WS_SX);
    float* YS = (float*)(p.ws + WS_YS);
    bf16_t* Vm = (bf16_t*)ldsf;
    const int tid = otid(), lane = tid & 63, wv = tid >> 6; const int t0 = 2 * wv, t1 = 2 * wv + 1;
    for (int ch = blockIdx.x; ch < NB * 8 * (SEQ / 64); ch += gridDim.x) {
        const int bh = ch >> 7, c = ch & 127, b = bh >> 3, h = bh & 7;
        const size_t gbase = ((size_t)b * SEQ + (size_t)c * 64) * RW + h * 64, ob_ = (size_t)ch * 4096;
        __syncthreads();
        { const int st = tid >> 3, sj = (tid & 7) * 8; *(uint4*)(Vm + st * LP + sj) = *(const uint4*)(VV + gbase + (size_t)st * RW + sj); }
        __syncthreads();
        R1_FOR_TILES(idx, tr, tc)
            const f32x4_t zero4 = {0.f, 0.f, 0.f, 0.f};
            f32x4_t y = mm_tile<true, true>(SX + ob_, 64, 1, G1T + ob_, 1, 64, tr, tc, zero4, lane);
            y = mm_tile<false, true>(Vm, 1, LP, G2T + ob_, 1, 64, tr, tc, y, lane);
            const int i0 = 16 * tr + 4 * (lane >> 4), t = 16 * tc + (lane & 15);
            *(f32x4_t*)(YS + gbase + (size_t)t * RW + i0) = y;
        R1_END
    }
}
#undef R1_FOR_TILES
#undef R1_END

__device__ void ph_rwkv_post(const P& p) {
    const bf16_t* R = (const bf16_t*)(p.ws + WS_R); const bf16_t* K2 = (const bf16_t*)(p.ws + WS_K2); const bf16_t* VV = (const bf16_t*)(p.ws + WS_VV); const bf16_t* G = (const bf16_t*)(p.ws + WS_G);
    const float* YS = (const float*)(p.ws + WS_YS); bf16_t* ORW = (bf16_t*)(p.ws + WS_ORW);
    const float* r_k = p.in[18]; const float* ln_w = p.in[19]; const float* ln_b = p.in[20];
    const int tid = otid();
    const float rkc = r_k[tid], lw = ln_w[tid], lb = ln_b[tid];
    for (int m = blockIdx.x; m < NT; m += gridDim.x) {
        const size_t o = (size_t)m * RW + tid;
        const float y = YS[o];
        const float mean = wave_sum(y) * (1.f / 64.f);
        const float dy = y - mean;
        const float var = wave_sum(dy * dy) * (1.f / 64.f);
        const float yn = dy * rsqrtf(var + GN_EPS) * lw + lb;
        const float r = bf2f(R[o]), k2 = bf2f(K2[o]), v = bf2f(VV[o]), g = bf2f(G[o]);
        const float rk = wave_sum(r * k2 * rkc);
        ORW[o] = f2bf((yn + rk * v) * g);
    }
}

__device__ void ph_moe_offsets(const P& p) {
    if (blockIdx.x != 0) return;
    int* ctl = (int*)(p.ws + WS_CTL); int* ltok = (int*)(p.ws + WS_LTOK);
    if (otid() == 0) {
        int off = 0, n1 = 0, n2a = 0, n2b = 0;
        int4* t1 = (int4*)(ctl + CT_TAB1); int4* t2a = (int4*)(ctl + CT_TAB2A); int4* t2b = (int4*)(ctl + CT_TAB2B);
        for (int li = 0; li < 64; ++li) {
            const int cnt = ctl[CT_CNT + li], e = li & 31; ctl[CT_OFF + li] = off;
            for (int mt = 0; mt * 256 < cnt; ++mt) {
                const int rem = cnt - mt * 256;
                for (int nt = 0; nt < 4; ++nt) {
                    t1[n1++] = make_int4(off + mt * 256, e * 1024 + nt * 256, rem, nt);
                    if (li < 32) t2a[n2a++] = make_int4(off + mt * 256, e * 1024 + nt * 256, rem, nt); else t2b[n2b++] = make_int4(off + mt * 256, e * 1024 + nt * 256, rem, nt);
                }
            }
            off += (cnt + 255) / 256 * 256;
        }
        ctl[CT_NU] = n1; ctl[CT_NU + 1] = n2a; ctl[CT_NU + 2] = n2b;
    }
    __syncthreads();
    for (int li = 0; li < 64; ++li) { const int cnt = ctl[CT_CNT + li], off = ctl[CT_OFF + li], pad = (cnt + 255) / 256 * 256;
        for (int r = cnt + otid(); r < pad; r += NTHR) ltok[off + r] = 0; }
}
__device__ void ph_moe_scatter(const P& p) {
    int* ctl = (int*)(p.ws + WS_CTL); const int* route = (const int*)(p.ws + WS_ROUTE);
    int* ltok = (int*)(p.ws + WS_LTOK); float* lw = (float*)(p.ws + WS_LW);
    for (int m = blockIdx.x * NTHR + otid(); m < NT; m += gridDim.x * NTHR) {
#pragma unroll
        for (int sl = 0; sl < 2; ++sl) { const int li = sl * 32 + route[m * 4 + sl]; const int pos = ctl[CT_OFF + li] + atomicAdd(ctl + CT_CUR + li, 1); ltok[pos] = m; lw[pos] = __int_as_float(route[m * 4 + 2 + sl]); }
    }
}

template <int PH>
__device__ __forceinline__ void run_phase(const P& p, unsigned char* lds_raw) {
    float* lds = (float*)lds_raw; PG8_LAS unsigned char* ldsg = (PG8_LAS unsigned char*)lds_raw;
    const int G = gridDim.x, c = blockIdx.x;
    if constexpr (PH == 0) { ph_mod(p, lds); __syncthreads(); ph_convert_mixer_weights(p, lds); }
    if constexpr (PH == 1) ph_norm(p, p.in[0], p.in[4], 0, (bf16_t*)(p.ws + WS_XN));
    if constexpr (PH == 2) { pg8::Gemm g{(const bf16_t*)(p.ws + WS_XN), (const bf16_t*)(p.ws + WS_WIN), DM, nullptr}; pg8::StaticOrder S; S.init(NT, 5120, G, c);
        pg8::EpiInproj E{p.ws, (bf16_t*)p.out}; pg8::gemm_phase(ldsg, g, S, E); }
    if constexpr (PH == 3) { ph_headnorm((bf16_t*)(p.ws + WS_Q), p.in[8]); ph_kvnorm((bf16_t*)(p.ws + WS_KVN), p.in[6]); }
    if constexpr (PH == 4) { pg8::Gemm g{(const bf16_t*)(p.ws + WS_KVN), (const bf16_t*)(p.ws + WS_WKV), KVL, nullptr}; pg8::StaticOrder S; S.init(NT, 2 * AW, G, c);
        pg8::EpiKV E{p.ws}; pg8::gemm_phase(ldsg, g, S, E); }
    if constexpr (PH == 5) ph_headnorm((bf16_t*)(p.ws + WS_K), p.in[9]);
    if constexpr (PH == 6) ph_dsa(p, lds);
    if constexpr (PH == 7) ph_rwkv_prep(p, lds);
    if constexpr (PH == 8) ph_rwkv_r1(p, lds);
    if constexpr (PH == 19) ph_rwkv_r2(p, lds);
    if constexpr (PH == 20) ph_rwkv_r3(p, lds);
    if constexpr (PH == 9) ph_rwkv_post(p);
    if constexpr (PH == 10) { pg8::Gemm g{(const bf16_t*)(p.ws + WS_OATT), (const bf16_t*)(p.ws + WS_WBA), AW, nullptr}; pg8::StaticOrder S; S.init(NT, DM, G, c);
        pg8::EpiMerge<false> E{(bf16_t*)(p.ws + WS_MERGED), (const bf16_t*)p.out}; pg8::gemm_phase(ldsg, g, S, E);
        ph_convert_expert_weights(p, lds); }
    if constexpr (PH == 11) { pg8::Gemm g{(const bf16_t*)(p.ws + WS_ORW), (const bf16_t*)(p.ws + WS_WBR), RW, nullptr}; pg8::StaticOrder S; S.init(NT, DM, G, c);
        pg8::EpiMerge<true> E{(bf16_t*)(p.ws + WS_MERGED), (const bf16_t*)p.out + (size_t)NT * DM}; pg8::gemm_phase(ldsg, g, S, E); }
    if constexpr (PH == 12) { pg8::Gemm g{(const bf16_t*)(p.ws + WS_MERGED), (const bf16_t*)(p.ws + WS_WOUT), DM, nullptr}; pg8::StaticOrder S; S.init(NT, DM, G, c);
        pg8::EpiOut E{p.in[0], (const float*)(p.ws + WS_MOD), p.out}; pg8::gemm_phase(ldsg, g, S, E); }
    if constexpr (PH == 13) ph_norm_route(p, lds);
    if constexpr (PH == 14) ph_moe_offsets(p);
    if constexpr (PH == 15) ph_moe_scatter(p);
    if constexpr (PH == 16) { const int* ctl = (const int*)(p.ws + WS_CTL);
        pg8::Gemm g{(const bf16_t*)(p.ws + WS_XN2), (const bf16_t*)(p.ws + WS_WGU), DM, (const int*)(p.ws + WS_LTOK)}; pg8::TableOrder S{(const int4*)(ctl + CT_TAB1), ctl[CT_NU], G, c};
        pg8::EpiMoe1 E{(bf16_t*)(p.ws + WS_HID), (const float*)(p.ws + WS_LW)}; pg8::gemm_phase(ldsg, g, S, E); }
    if constexpr (PH == 17 || PH == 18) { const int* ctl = (const int*)(p.ws + WS_CTL);
        pg8::Gemm g{(const bf16_t*)(p.ws + WS_HID), (const bf16_t*)(p.ws + WS_WDN), DE, nullptr};
        pg8::TableOrder S{(const int4*)(ctl + (PH == 17 ? CT_TAB2A : CT_TAB2B)), ctl[CT_NU + (PH == 17 ? 1 : 2)], G, c};
        pg8::EpiMoe2 E{(const int*)(p.ws + WS_LTOK), (const float*)(p.ws + WS_MOD), p.out}; pg8::gemm_phase(ldsg, g, S, E); }
}
constexpr int LDS_BYTES = 147456;
constexpr int ORDER[] = {0, 1, 2, 3, 4, 5, 6, 7, 8, 19, 20, 9, 10, 11, 12, 13, 14, 15, 16, 17, 18};
constexpr int NPHASE = sizeof(ORDER) / sizeof(int);
constexpr int CT_BAR = 65536;
constexpr int LDS_ST = LDS_BYTES - 64;
template <int I> __device__ __forceinline__ void run_all(const P& p, unsigned char* lds, const XcdBarrier& bar) {
    run_phase<ORDER[I]>(p, lds);
    if constexpr (I + 1 < NPHASE) { xcd_barrier(bar); run_all<I + 1>(p, lds, bar); }
}
__global__ void __launch_bounds__(NTHR, 2) k_mega(P p) {
    extern __shared__ __attribute__((aligned(16))) unsigned char lds[];
    volatile LAS3 unsigned* st = (volatile LAS3 unsigned*)((LAS3 unsigned char*)lds + LDS_ST);
    if (otid() < 16) st[otid()] = 0u;
    __syncthreads();
    const XcdBarrier bar = xcd_barrier_post((unsigned*)(p.ws + WS_CTL) + CT_BAR, st);
    run_all<0>(p, lds, bar);
}
}

extern "C" void kernel_launch(void* const* d_in, const int* in_sizes, int n_in, void* d_out, int out_size, void* d_ws, size_t ws_size, hipStream_t stream) {
    if (n_in != 31 || out_size != NT * DM || ws_size < WS_END) { fprintf(stderr, "kernel_launch: unexpected shapes (n_in %d out %d ws %zu need %zu)\n", n_in, out_size, ws_size, (size_t)WS_END); return; }
    P p{};
    for (int i = 0; i < 31; ++i) p.in[i] = (const float*)d_in[i];
    p.out = (float*)d_out; p.ws = (unsigned char*)d_ws;
    (void)hipMemsetAsync((char*)d_ws + WS_CTL, 0, 1 * MiB, stream);
    static int grid_blocks = 0;
    if (!grid_blocks) {
        int dev = 0, cus = 0, per_cu = 0;
        (void)hipGetDevice(&dev);
        (void)hipDeviceGetAttribute(&cus, hipDeviceAttributeMultiprocessorCount, dev);
        (void)hipFuncSetAttribute((const void*)k_mega, hipFuncAttributeMaxDynamicSharedMemorySize, LDS_BYTES);
        (void)hipOccupancyMaxActiveBlocksPerMultiprocessor(&per_cu, (const void*)k_mega, NTHR, LDS_BYTES);
        if (per_cu < 1) per_cu = 1;
        if (per_cu > 1) per_cu = 1;
        grid_blocks = cus * per_cu;
        fprintf(stderr, "kernel_launch: cus %d per_cu %d grid %d\n", cus, per_cu, grid_blocks);
    }
    hipLaunchKernelGGL(k_mega, dim3(grid_blocks), dim3(NTHR), LDS_BYTES, stream, p);
}
```

```cpp
#include <hip/hip_runtime.h>
#include <cstdio>
#include <cstdint>

namespace {
constexpr int NB = 2, SEQ = 8192, DM = 1024, NT = NB * SEQ;
constexpr int AW = 512, KVL = 256, NIH = 8, IDD = 32, SHW = 1824, INW = 4936;
constexpr int C_KV = 512, C_QI = 768, C_PS = 1064, C_GA = 2888, C_GR = 3912;
constexpr int IDXW = 296;
constexpr int RW = 512, NE = 32, DE = 512;
constexpr int TOPK = 256;
constexpr float NORM_EPS = 1e-6f, GN_EPS = 64e-5f;
constexpr int NTHR = 512;

typedef unsigned short bf16_t;
__device__ __forceinline__ float bf2f(bf16_t v) { return __uint_as_float(((unsigned)v) << 16); }
__device__ __forceinline__ bf16_t f2bf(float f) { unsigned u = __float_as_uint(f); return (bf16_t)((u + 0x7fffu + ((u >> 16) & 1u)) >> 16); }

constexpr size_t MiB = 1u << 20;
constexpr size_t WS_CTL = 0;
constexpr size_t WS_MOD = 1 * MiB;
constexpr size_t WS_WIN = 2 * MiB;
constexpr size_t WS_WKV = 12 * MiB;
constexpr size_t WS_WBA = 13 * MiB;
constexpr size_t WS_WBR = 14 * MiB;
constexpr size_t WS_WOUT = 15 * MiB;
constexpr size_t WS_XN = 17 * MiB;
constexpr size_t WS_G = 17 * MiB;
constexpr size_t WS_ORW = 33 * MiB;
constexpr size_t WS_Q = 49 * MiB;
constexpr size_t WS_KVN = 65 * MiB;
constexpr size_t WS_K = 73 * MiB;
constexpr size_t WS_V = 89 * MiB;
constexpr size_t WS_QI = 105 * MiB;
constexpr size_t WS_KI = 113 * MiB;
constexpr size_t WS_WI = 114 * MiB;
constexpr size_t WS_MASK = 197 * MiB;
constexpr size_t WS_PS = 124 * MiB;
constexpr size_t WS_YS = 124 * MiB;
constexpr size_t WS_OATT = 181 * MiB;
constexpr size_t WS_R = 49 * MiB, WS_K2 = 65 * MiB, WS_VV = 81 * MiB, WS_KK = 97 * MiB;
constexpr size_t WS_BB = 197 * MiB;
constexpr size_t WS_DD = 213 * MiB;
constexpr size_t WS_MERGED = 197 * MiB;
constexpr size_t WS_XN2 = 229 * MiB;
constexpr size_t WS_WGU = 49 * MiB;
constexpr size_t WS_WDN = 113 * MiB;
constexpr size_t WS_HID = 145 * MiB;
constexpr size_t WS_ROUTE = 193 * MiB;
constexpr size_t WS_LTOK = 194 * MiB;
constexpr size_t WS_LW = 195 * MiB;
constexpr size_t WS_G1T = 156 * MiB;
constexpr size_t WS_G2T = 245 * MiB;
constexpr size_t WS_PT = 261 * MiB;
constexpr size_t WS_QT = 277 * MiB;
constexpr size_t WS_SX = 97 * MiB;
constexpr size_t WS_END = 293 * MiB;
constexpr int HID_ROWS = 49152;
constexpr int CT_CNT = 0, CT_OFF = 64, CT_CUR = 128, CT_NU = 192;
constexpr int CT_TAB1 = 1024, CT_TAB2A = 1024 + 4 * 1024, CT_TAB2B = 1024 + 8 * 1024;

struct P {
    const float* in[31];
    float* out;
    unsigned char* ws;
};

__device__ __forceinline__ int otid() { int t = threadIdx.x; asm volatile("" : "+v"(t)); return t; }
__device__ __forceinline__ float dpp_row_shr(float v, int n) {
    int iv = __builtin_bit_cast(int, v), r;
    switch (n) { case 1: r = __builtin_amdgcn_update_dpp(0, iv, 0x111, 0xf, 0xf, true); break; case 2: r = __builtin_amdgcn_update_dpp(0, iv, 0x112, 0xf, 0xf, true); break;
                 case 4: r = __builtin_amdgcn_update_dpp(0, iv, 0x114, 0xf, 0xf, true); break; default: r = __builtin_amdgcn_update_dpp(0, iv, 0x118, 0xf, 0xf, true); break; }
    return __builtin_bit_cast(float, r);
}
__device__ __forceinline__ float wave_sum(float v) {
    v += dpp_row_shr(v, 1); v += dpp_row_shr(v, 2); v += dpp_row_shr(v, 4); v += dpp_row_shr(v, 8);
    v += __builtin_bit_cast(float, __builtin_amdgcn_update_dpp(0, __builtin_bit_cast(int, v), 0x142, 0xa, 0xf, false));
    v += __builtin_bit_cast(float, __builtin_amdgcn_update_dpp(0, __builtin_bit_cast(int, v), 0x143, 0xc, 0xf, false));
    return __builtin_bit_cast(float, __builtin_amdgcn_readlane(__builtin_bit_cast(int, v), 63));
}
__device__ __forceinline__ float wave_max(float v) {
#pragma unroll
    for (int o = 32; o > 0; o >>= 1) v = fmaxf(v, __shfl_xor(v, o));
    return v;
}
typedef short bf16x8_t __attribute__((ext_vector_type(8)));
typedef float f32x4_t __attribute__((ext_vector_type(4)));
constexpr int LP = 72;
constexpr int SLOT = 64 * LP;
__device__ __forceinline__ float sigmoidf_(float x) { return 1.f / (1.f + __expf(-x)); }

#define XB_TMO      128
#define XB_XCNT(j)  (256  + 64 * (j))
#define XB_XSUB(j)  (1280 + 64 * (j))
#define XB_XGEN(j)  (2304 + 64 * (j))
#define XB_TOP      3328
#define XB_TOPGEN   3392
#define XCD_BAR_WORDS 3456
#define XB_SPIN_CAP (1u << 22)
#define LAS3 __attribute__((address_space(3)))
__device__ __forceinline__ unsigned xb_ld(unsigned* p)              { return __hip_atomic_load(p, __ATOMIC_RELAXED, __HIP_MEMORY_SCOPE_AGENT); }
__device__ __forceinline__ unsigned xb_add(unsigned* p, unsigned v) { return __hip_atomic_fetch_add(p, v, __ATOMIC_RELAXED, __HIP_MEMORY_SCOPE_AGENT); }
__device__ __forceinline__ unsigned xb_xcc_id() { return (unsigned)__builtin_amdgcn_s_getreg((3 << 11) | 20) & 0xFu; }
#define XB_SPIN(cond, bar) do { unsigned _sp = 0; while (cond) { __builtin_amdgcn_s_sleep(1); \
    if ((++_sp & 255u) == 0u) { if (xb_ld(&(bar)[XB_TMO])) break; if (_sp > XB_SPIN_CAP) { atomicAdd(&(bar)[XB_TMO], 1u); break; } } } } while (0)
struct XcdBarrier { unsigned* bar; unsigned x; volatile LAS3 unsigned* st; };
__device__ __forceinline__ XcdBarrier xcd_barrier_post(unsigned* bar, volatile LAS3 unsigned* st) {
    XcdBarrier b; b.bar = bar; b.x = xb_xcc_id(); b.st = st;
    if (otid() == 0) (void)xb_add(&bar[XB_XCNT(b.x)], 1u);
    return b;
}
__device__ __forceinline__ void xcd_barrier_complete(unsigned* bar, unsigned x, unsigned& nloc, unsigned& nx) {
    const unsigned G = gridDim.x * gridDim.y * gridDim.z;
    unsigned sum, cnt, mine, sp = 0u;
    for (;;) {
        sum = 0u; cnt = 0u; mine = 0u;
#pragma unroll
        for (unsigned j = 0; j < 16; ++j) { const unsigned c = xb_ld(&bar[XB_XCNT(j)]); sum += c; cnt += (c > 0u) ? 1u : 0u; mine = (j == x) ? c : mine; }
        if (sum == G) break;
        __builtin_amdgcn_s_sleep(1);
        if ((++sp & 255u) == 0u) { if (xb_ld(&bar[XB_TMO])) break; if (sp > XB_SPIN_CAP) { atomicAdd(&bar[XB_TMO], 1u); break; } }
    }
    nloc = mine > 0u ? mine : 1u; nx = cnt > 0u ? cnt : 1u;
}
__device__ __forceinline__ void xcd_barrier(const XcdBarrier& b) {
    asm volatile("s_waitcnt vmcnt(0)" ::: "memory");
    __syncthreads();
    if (otid() == 0) {
        unsigned* bar = b.bar;
        __builtin_amdgcn_s_waitcnt(0);
        unsigned nloc = b.st[0], nx = b.st[1];
        if (nloc == 0u) { xcd_barrier_complete(bar, b.x, nloc, nx); b.st[0] = nloc; b.st[1] = nx; }
        const unsigned old = xb_add(&bar[XB_XSUB(b.x)], 1u);
        const unsigned gen = old / nloc;
        if (old + 1u == (gen + 1u) * nloc) {
            __builtin_amdgcn_fence(__ATOMIC_RELEASE, "agent");
            asm volatile("s_waitcnt vmcnt(0)" ::: "memory");
            const unsigned og = xb_add(&bar[XB_TOP], 1u);
            const unsigned tg = og / nx;
            if (og + 1u == (tg + 1u) * nx) xb_add(&bar[XB_TOPGEN], 1u);
            else XB_SPIN(xb_ld(&bar[XB_TOPGEN]) == tg, bar);
            __builtin_amdgcn_fence(__ATOMIC_ACQUIRE, "agent");
            xb_add(&bar[XB_XGEN(b.x)], 1u);
            asm volatile("s_waitcnt vmcnt(0)" ::: "memory");
        } else {
            XB_SPIN(xb_ld(&bar[XB_XGEN(b.x)]) == gen, bar);
            __builtin_amdgcn_fence(__ATOMIC_ACQUIRE, "agent");
            asm volatile("s_waitcnt vmcnt(0)" ::: "memory");
        }
    }
    __syncthreads();
}

__device__ void ph_mod(const P& p, float* lds) {
    const float* c = p.in[1]; const float* W = p.in[2]; const float* bia = p.in[3];
    float* mod = (float*)(p.ws + WS_MOD);
    for (int i = otid(); i < NB * DM; i += NTHR) { float v = c[i]; lds[i] = v / (1.f + __expf(-v)); }
    __syncthreads();
    const int gt = blockIdx.x * NTHR + otid(), gs = gridDim.x * NTHR;
    for (int j = gt; j < 6 * DM; j += gs) {
        float a0 = 0.f, a1 = 0.f;
#pragma unroll 8
        for (int k = 0; k < DM; ++k) { float w = W[(size_t)k * (6 * DM) + j]; a0 += lds[k] * w; a1 += lds[DM + k] * w; }
        mod[j] = a0 + bia[j]; mod[6 * DM + j] = a1 + bia[j];
    }
}

__device__ void ph_norm(const P& p, const float* src, const float* g, int which, bf16_t* dst) {
    const float* mod = (const float*)(p.ws + WS_MOD);
    const int lane = otid() & 63, wv = otid() >> 6;
    const int gw = blockIdx.x * (NTHR / 64) + wv, nw = gridDim.x * (NTHR / 64);
    for (int m = gw; m < NT; m += nw) {
        const int b = m / SEQ;
        const float* sh = mod + b * 6 * DM + (which ? 3 * DM : 0);
        const float* sc = sh + DM;
        const float4* xr = (const float4*)(src + (size_t)m * DM);
        float4 v[4]; float ss = 0.f;
#pragma unroll
        for (int j = 0; j < 4; ++j) { v[j] = xr[lane + 64 * j]; ss += v[j].x * v[j].x + v[j].y * v[j].y + v[j].z * v[j].z + v[j].w * v[j].w; }
        ss = wave_sum(ss);
        const float rstd = rsqrtf(ss * (1.f / DM) + NORM_EPS);
        float o[16];
#pragma unroll
        for (int j = 0; j < 4; ++j) {
            int c0 = 4 * (lane + 64 * j); asm volatile("" : "+v"(c0));
            const float4 gg = *(const float4*)(g + c0), s1 = *(const float4*)(sc + c0), s0 = *(const float4*)(sh + c0);
            o[4 * j + 0] = v[j].x * rstd * gg.x * (1.f + s1.x) + s0.x; o[4 * j + 1] = v[j].y * rstd * gg.y * (1.f + s1.y) + s0.y;
            o[4 * j + 2] = v[j].z * rstd * gg.z * (1.f + s1.z) + s0.z; o[4 * j + 3] = v[j].w * rstd * gg.w * (1.f + s1.w) + s0.w;
            uint2 pk; pk.x = (unsigned)f2bf(o[4 * j]) | ((unsigned)f2bf(o[4 * j + 1]) << 16); pk.y = (unsigned)f2bf(o[4 * j + 2]) | ((unsigned)f2bf(o[4 * j + 3]) << 16);
            *(uint2*)(dst + (size_t)m * DM + c0) = pk;
        }
    }
}

__device__ void ph_norm_route(const P& p, float* lds) {
    const float* mod = (const float*)(p.ws + WS_MOD); const float* src = p.out; const float* g = p.in[24]; bf16_t* dst = (bf16_t*)(p.ws + WS_XN2);
    const float* wgr = p.in[25]; const float* wer = p.in[26]; const float* eb = p.in[27];
    const int tid = otid(), lane = tid & 63, wv = tid >> 6;
    float* sx = lds + wv * 4096;
    const int gw = blockIdx.x * (NTHR / 64) + wv, nw = gridDim.x * (NTHR / 64);
    for (int m0 = gw * 4; m0 < NT; m0 += nw * 4) {
        const int b = m0 / SEQ;
        const float* sh = mod + b * 6 * DM + 3 * DM; const float* sc = sh + DM;
#pragma unroll 1
        for (int tk = 0; tk < 4; ++tk) {
            const int m = m0 + tk;
            const float4* xr = (const float4*)(src + (size_t)m * DM);
            float4 v[4]; float ss = 0.f;
#pragma unroll
            for (int j = 0; j < 4; ++j) { v[j] = xr[lane + 64 * j]; ss += v[j].x * v[j].x + v[j].y * v[j].y + v[j].z * v[j].z + v[j].w * v[j].w; }
            ss = wave_sum(ss);
            const float rstd = rsqrtf(ss * (1.f / DM) + NORM_EPS);
#pragma unroll
            for (int j = 0; j < 4; ++j) {
                const int c0 = 4 * (lane + 64 * j);
                const float4 gg = *(const float4*)(g + c0), s1 = *(const float4*)(sc + c0), s0 = *(const float4*)(sh + c0);
                const float o0 = v[j].x * rstd * gg.x * (1.f + s1.x) + s0.x, o1 = v[j].y * rstd * gg.y * (1.f + s1.y) + s0.y;
                const float o2 = v[j].z * rstd * gg.z * (1.f + s1.z) + s0.z, o3 = v[j].w * rstd * gg.w * (1.f + s1.w) + s0.w;
                uint2 pk; pk.x = (unsigned)f2bf(o0) | ((unsigned)f2bf(o1) << 16); pk.y = (unsigned)f2bf(o2) | ((unsigned)f2bf(o3) << 16);
                *(uint2*)(dst + (size_t)m * DM + c0) = pk;
                sx[(c0 + 0) * 4 + tk] = o0; sx[(c0 + 1) * 4 + tk] = o1; sx[(c0 + 2) * 4 + tk] = o2; sx[(c0 + 3) * 4 + tk] = o3;
            }
        }
        __builtin_amdgcn_wave_barrier(); asm volatile("s_waitcnt lgkmcnt(0)" ::: "memory");
        float ae[4] = {0.f, 0.f, 0.f, 0.f}, ag[4] = {0.f, 0.f, 0.f, 0.f};
        { const int e = lane & 31, kb = (lane >> 5) * 512;
#pragma unroll 8
          for (int i = 0; i < 512; ++i) { const float w = wer[(size_t)(kb + i) * 32 + e]; const float4 xv = *(const float4*)(sx + (kb + i) * 4);
              ae[0] += xv.x * w; ae[1] += xv.y * w; ae[2] += xv.z * w; ae[3] += xv.w * w; } }
        { const int gq = lane & 3, kb = (lane >> 2) * 64;
#pragma unroll 8
          for (int i = 0; i < 64; ++i) { const float w = wgr[(size_t)(kb + i) * 4 + gq]; const float4 xv = *(const float4*)(sx + (kb + i) * 4);
              ag[0] += xv.x * w; ag[1] += xv.y * w; ag[2] += xv.z * w; ag[3] += xv.w * w; } }
#pragma unroll
        for (int tk = 0; tk < 4; ++tk) {
            ae[tk] += __shfl_xor(ae[tk], 32);
            ag[tk] += __shfl_xor(ag[tk], 4); ag[tk] += __shfl_xor(ag[tk], 8); ag[tk] += __shfl_xor(ag[tk], 16); ag[tk] += __shfl_xor(ag[tk], 32);
        }
#pragma unroll
        for (int tk = 0; tk < 4; ++tk) {
            float lg[4];
#pragma unroll
            for (int q = 0; q < 4; ++q) lg[q] = __shfl(ag[tk], q);
            int gs = 0; float mx = lg[0];
#pragma unroll
            for (int q = 1; q < 4; ++q) if (lg[q] > mx) { mx = lg[q]; gs = q; }
            float den = 0.f;
#pragma unroll
            for (int q = 0; q < 4; ++q) den += __expf(lg[q] - mx);
            const float pg = 1.f / den;
            float ev[8];
#pragma unroll
            for (int q = 0; q < 8; ++q) ev[q] = __shfl(ae[tk], gs * 8 + q) + eb[gs * 8 + q];
            int i0 = 0; float v0 = ev[0];
#pragma unroll
            for (int q = 1; q < 8; ++q) if (ev[q] > v0) { v0 = ev[q]; i0 = q; }
            int i1 = -1; float v1 = -INFINITY;
#pragma unroll
            for (int q = 0; q < 8; ++q) if (q != i0 && ev[q] > v1) { v1 = ev[q]; i1 = q; }
            if (lane == 0) {
                const float e1 = __expf(v1 - v0), w0 = pg / (1.f + e1), w1 = pg * e1 / (1.f + e1);
                int* route = (int*)(p.ws + WS_ROUTE) + (size_t)(m0 + tk) * 4;
                route[0] = gs * 8 + i0; route[1] = gs * 8 + i1; route[2] = __float_as_int(w0); route[3] = __float_as_int(w1);
                int* ctl = (int*)(p.ws + WS_CTL);
                atomicAdd(ctl + CT_CNT + gs * 8 + i0, 1); atomicAdd(ctl + CT_CNT + 32 + gs * 8 + i1, 1);
            }
        }
        __builtin_amdgcn_wave_barrier();
    }
}

namespace pg8 {
#define PG8_LAS __attribute__((address_space(3)))
typedef short bf16x8 __attribute__((ext_vector_type(8)));
typedef float f32x4 __attribute__((ext_vector_type(4)));
typedef unsigned u32x4 __attribute__((ext_vector_type(4)));
constexpr int BM = 256, BK = 64, HALF = 128, HTB = HALF * BK * 2, STAGE_BYTES = 8 * HTB, NXCD = 8, WGM = 8;
__host__ __device__ __forceinline__ int lds_byte(int r, int c) { const int st = (r >> 4) * 2 + (c >> 5), rr = r & 15, cc = c & 31, ob = rr * 64 + cc * 2; return st * 1024 + (ob ^ (((ob >> 9) & 1) << 5)); }
__host__ __device__ __forceinline__ void stage_rc(int b, int& R, int& C) { const int st = b / 1024, sb = b % 1024, swz = sb ^ (((sb >> 9) & 1) << 5); R = (st >> 1) * 16 + swz / 64; C = (st & 1) * 32 + (swz % 64) / 2; }
__host__ __device__ __forceinline__ int perm32(int rho) { const int n = rho >> 4, i = rho & 15; return 8 * (i >> 2) + 4 * n + (i & 3); }

struct Unit { int arow, brow, pm, pn, aux; };
struct Gemm { const bf16_t* A; const bf16_t* Bt; int K; const int* gather; };

struct StaticOrder {
    int nM, nN, nwg, G, c;
    __device__ void init(int M, int N, int G_, int c_) { nM = M / BM; nN = N / BM; nwg = nM * nN; G = G_; c = c_; }
    __device__ bool next(int i, Unit& u) const {
        const long L = (long)i * G + c; if (L >= nwg) return false;
        int wgid = (int)L; { const int q = nwg / NXCD, r = nwg % NXCD, xcd = wgid % NXCD, off = wgid / NXCD; wgid = (xcd < r ? xcd * (q + 1) : r * (q + 1) + (xcd - r) * q) + off; }
        const int nig = WGM * nN, gid = wgid / nig, fm = gid * WGM, gsz = (nM - fm) < WGM ? (nM - fm) : WGM;
        u.pm = fm + ((wgid % nig) % gsz); u.pn = (wgid % nig) / gsz; u.arow = u.pm * BM; u.brow = u.pn * BM; u.aux = 0; return true;
    }
};
struct TableOrder {
    const int4* tab; int n, G, c;
    __device__ bool next(int i, Unit& u) const {
        const int L = i * G + c; if (L >= n) return false;
        const int4 e = tab[L]; u.arow = __builtin_amdgcn_readfirstlane(e.x); u.brow = __builtin_amdgcn_readfirstlane(e.y); u.aux = __builtin_amdgcn_readfirstlane(e.z); u.pn = __builtin_amdgcn_readfirstlane(e.w); u.pm = 0; return true;
    }
};
__device__ __forceinline__ unsigned cvt_pk_bf16(float lo, float hi) { unsigned r; asm volatile("v_cvt_pk_bf16_f32 %0, %1, %2" : "=v"(r) : "v"(lo), "v"(hi)); return r; }

template <class Epi, class Sched>
__device__ __forceinline__ void gemm_phase(PG8_LAS unsigned char* lds, const Gemm g, const Sched& S, const Epi& E) {
    const int tid = otid(), wid = __builtin_amdgcn_readfirstlane(tid >> 6), lane = tid & 63, wr = wid >> 2, wc = wid & 3, fr = lane & 15, fq = lane >> 4;
    const int K = g.K, nt = K / BK;
    int RA0; unsigned cofA0, voffB0;
    { int R, C; stage_rc(tid * 16, R, C); const int Rb = Epi::PERM ? ((R & ~31) + perm32(R & 31)) : R; RA0 = R; cofA0 = (unsigned)C * 2u; voffB0 = (unsigned)(Rb * K + C) * 2u; }
    const size_t rstep64 = (size_t)64 * K * 2;
    const size_t kstep = (size_t)(BK * 2);
    const size_t hstep = (size_t)HALF * K * 2;
    const unsigned ldsw = (unsigned)wid * 1024u;
    const int aoff = lds_byte(wr * 64 + fr, fq * 8), boff = lds_byte(wc * 32 + fr, fq * 8);
#define PG8_SA(b, h) (((b) * 2 + (h)) * HTB)
#define PG8_SB(b, h) ((4 + (b) * 2 + (h)) * HTB)
#define PG8_STAGE_B(bufoff, gbase) do { _Pragma("unroll") for (int _i = 0; _i < 2; ++_i) \
        __builtin_amdgcn_global_load_lds((const unsigned*)((const char*)(gbase) + _i * rstep64 + voffB0), (PG8_LAS unsigned*)(lds + (bufoff) + ldsw + _i * 8192), 16, 0, 0); } while (0)
#define PG8_STAGE_A(bufoff, o2, kb) do { _Pragma("unroll") for (int _i = 0; _i < 2; ++_i) \
        __builtin_amdgcn_global_load_lds((const unsigned*)((const char*)g.A + (size_t)(o2)[_i] + (size_t)(kb)), (PG8_LAS unsigned*)(lds + (bufoff) + ldsw + _i * 8192), 16, 0, 0); } while (0)
#define PG8_LDA(dst, b, h) do { _Pragma("unroll") for (int m = 0; m < 4; ++m) _Pragma("unroll") for (int k = 0; k < 2; ++k) dst[m][k] = *(const PG8_LAS bf16x8*)(lds + PG8_SA(b, h) + aoff + m * 2048 + k * 1024); } while (0)
#define PG8_LDB(dst, b, h) do { _Pragma("unroll") for (int n = 0; n < 2; ++n) _Pragma("unroll") for (int k = 0; k < 2; ++k) dst[n][k] = *(const PG8_LAS bf16x8*)(lds + PG8_SB(b, h) + boff + n * 2048 + k * 1024); } while (0)
#define PG8_MMA(ai, bj, At, Bt) do { __builtin_amdgcn_s_setprio(1); _Pragma("unroll") for (int m = 0; m < 4; ++m) _Pragma("unroll") for (int n = 0; n < 2; ++n) _Pragma("unroll") for (int k = 0; k < 2; ++k) \
        acc[ai][bj][m][n] = __builtin_amdgcn_mfma_f32_16x16x32_bf16(Bt[n][k], At[m][k], acc[ai][bj][m][n], 0, 0, 0); __builtin_amdgcn_s_setprio(0); } while (0)
#define PG8_WAIT_V(n) asm volatile("s_waitcnt vmcnt(" #n ")" ::: "memory")
#define PG8_WAIT_L(n) asm volatile("s_waitcnt lgkmcnt(" #n ")" ::: "memory")
#define PG8_BAR __builtin_amdgcn_s_barrier()
#define PG8_SCHED __builtin_amdgcn_sched_barrier(0)
#define PG8_AOFFS(u, dst) do { _Pragma("unroll") for (int _h = 0; _h < 2; ++_h) _Pragma("unroll") for (int _i = 0; _i < 2; ++_i) { \
        const int _tr = (u).arow + _h * HALF + RA0 + 64 * _i; const unsigned _row = g.gather ? (unsigned)g.gather[_tr] : (unsigned)_tr; dst[_h][_i] = _row * (unsigned)(K * 2) + cofA0; } } while (0)
    Unit cur, nxt; int ui = 0;
    if (!S.next(0, cur)) return;
    f32x4 acc[2][2][4][2];
#pragma unroll
    for (int a = 0; a < 2; ++a)
#pragma unroll
        for (int b = 0; b < 2; ++b)
#pragma unroll
            for (int m = 0; m < 4; ++m)
#pragma unroll
                for (int n = 0; n < 2; ++n) acc[a][b][m][n] = (f32x4){0.f, 0.f, 0.f, 0.f};
    bf16x8 At[4][2], B0[2][2], B1[2][2];
    unsigned cof[2][2];
    PG8_AOFFS(cur, cof);
    const char* cB = (const char*)g.Bt + (size_t)cur.brow * K * 2;
    PG8_STAGE_B(PG8_SB(0, 0), cB); PG8_STAGE_B(PG8_SB(0, 1), cB + hstep); PG8_STAGE_A(PG8_SA(0, 0), cof[0], 0); PG8_STAGE_A(PG8_SA(0, 1), cof[1], 0);
    if (wr == 1) PG8_BAR;
    PG8_WAIT_V(2); PG8_BAR;
    PG8_STAGE_B(PG8_SB(1, 0), cB + kstep); PG8_STAGE_A(PG8_SA(1, 0), cof[0], kstep); PG8_STAGE_B(PG8_SB(1, 1), cB + hstep + kstep);
    PG8_WAIT_V(6); PG8_BAR;
    for (;;) {
        const bool has_next = S.next(ui + 1, nxt);
        if (!has_next) nxt = cur;
        const char* nB = (const char*)g.Bt + (size_t)nxt.brow * K * 2;
        for (int t = 0; t < nt; t += 2) {
            const bool last = (t == nt - 2);
            const size_t k1 = (size_t)(t + 1) * kstep;
            const size_t k2 = last ? 0 : (size_t)(t + 2) * kstep, k3 = k2 + kstep;
            const char* b2 = last ? nB : cB + (size_t)(t + 2) * kstep; const char* b3 = b2 + kstep;
            PG8_LDB(B0, 0, 0); PG8_LDB(B1, 0, 1); PG8_SCHED; PG8_LDA(At, 0, 0); PG8_STAGE_A(PG8_SA(1, 1), cof[1], k1);
            if (last) { PG8_AOFFS(nxt, cof); }
            PG8_WAIT_V(8); PG8_WAIT_L(0); PG8_BAR; PG8_MMA(0, 0, At, B0); PG8_MMA(0, 1, At, B1); PG8_BAR; PG8_SCHED;
            PG8_LDA(At, 0, 1); PG8_STAGE_B(PG8_SB(0, 0), b2); PG8_STAGE_B(PG8_SB(0, 1), b2 + hstep); PG8_STAGE_A(PG8_SA(0, 0), cof[0], k2);
            PG8_WAIT_V(8); PG8_WAIT_L(0); PG8_BAR; PG8_MMA(1, 0, At, B0); PG8_MMA(1, 1, At, B1); PG8_BAR; PG8_SCHED;
            PG8_LDB(B0, 1, 0); PG8_LDB(B1, 1, 1); PG8_SCHED; PG8_LDA(At, 1, 0); PG8_STAGE_A(PG8_SA(0, 1), cof[1], k2);
            PG8_WAIT_V(8); PG8_WAIT_L(0); PG8_BAR; PG8_MMA(0, 0, At, B0); PG8_MMA(0, 1, At, B1); PG8_BAR; PG8_SCHED;
            PG8_LDA(At, 1, 1); PG8_STAGE_B(PG8_SB(1, 0), b3); PG8_STAGE_B(PG8_SB(1, 1), b3 + hstep); PG8_STAGE_A(PG8_SA(1, 0), cof[0], k3);
            PG8_WAIT_V(8); PG8_WAIT_L(0); PG8_BAR; PG8_MMA(1, 0, At, B0); PG8_MMA(1, 1, At, B1); PG8_BAR; PG8_SCHED;
        }
        if (wr == 0) PG8_BAR;
        { const int l2 = otid() & 63; E(acc, cur, wr, wc, l2 & 15, l2 >> 4); }
        if (!has_next) break;
#pragma unroll
        for (int a = 0; a < 2; ++a)
#pragma unroll
            for (int b = 0; b < 2; ++b)
#pragma unroll
                for (int m = 0; m < 4; ++m)
#pragma unroll
                    for (int n = 0; n < 2; ++n) acc[a][b][m][n] = (f32x4){0.f, 0.f, 0.f, 0.f};
        cur = nxt; cB = nB; ++ui;
        if (wr == 1) PG8_BAR;
    }
    PG8_WAIT_V(0);
    PG8_BAR;
#undef PG8_SA
#undef PG8_SB
#undef PG8_STAGE_A
#undef PG8_STAGE_B
#undef PG8_LDA
#undef PG8_LDB
#undef PG8_MMA
#undef PG8_WAIT_V
#undef PG8_WAIT_L
#undef PG8_BAR
#undef PG8_SCHED
#undef PG8_AOFFS
}

#define PG8_FENCE asm volatile("" ::: "memory")
#define PG8_FOR_TILE(ai, m, bj) _Pragma("unroll") for (int ai = 0; ai < 2; ++ai) _Pragma("unroll") for (int m = 0; m < 4; ++m) _Pragma("unroll") for (int bj = 0; bj < 2; ++bj)
__device__ __forceinline__ u32x4 pack8(const f32x4& v0, const f32x4& v1) { u32x4 w; w.x = cvt_pk_bf16(v0[0], v0[1]); w.y = cvt_pk_bf16(v0[2], v0[3]); w.z = cvt_pk_bf16(v1[0], v1[1]); w.w = cvt_pk_bf16(v1[2], v1[3]); return w; }
__device__ __forceinline__ float sigm(float x) { return 1.f / (1.f + __expf(-x)); }
struct EpiInproj {
    static constexpr bool PERM = true;
    unsigned char* ws; bf16_t* gates;
    __device__ __forceinline__ void operator()(const f32x4 (&acc)[2][2][4][2], const Unit& u, int wr, int wc, int fr, int fq) const {
        PG8_FOR_TILE(ai, m, bj) { PG8_FENCE;
            int row = u.pm * BM + ai * HALF + wr * 64 + m * 16 + fr; asm volatile("" : "+v"(row)); const int col = u.pn * BM + bj * HALF + wc * 32 + 8 * fq;
            const f32x4 v0 = acc[ai][bj][m][0], v1 = acc[ai][bj][m][1];
            if (col < C_KV) *(u32x4*)((bf16_t*)(ws + WS_Q) + (size_t)row * AW + col) = pack8(v0, v1);
            else if (col < C_QI) *(u32x4*)((bf16_t*)(ws + WS_KVN) + (size_t)row * KVL + (col - C_KV)) = pack8(v0, v1);
            else if (col < C_PS) {
                if (col < 1056) {
                    typedef _Float16 h8 __attribute__((ext_vector_type(8)));
                    h8 hv; hv[0] = (_Float16)v0[0]; hv[1] = (_Float16)v0[1]; hv[2] = (_Float16)v0[2]; hv[3] = (_Float16)v0[3]; hv[4] = (_Float16)v1[0]; hv[5] = (_Float16)v1[1]; hv[6] = (_Float16)v1[2]; hv[7] = (_Float16)v1[3];
                    _Float16* d = (col < 1024) ? (_Float16*)(ws + WS_QI) + (size_t)row * 256 + (col - C_QI) : (_Float16*)(ws + WS_KI) + (size_t)row * 32 + (col - 1024);
                    *(h8*)d = hv;
                } else { const float sc_ = 0.17677669529663687f * 0.35355339059327373f; float* d = (float*)(ws + WS_WI) + (size_t)row * 8; *(f32x4*)d = v0 * sc_; *(f32x4*)(d + 4) = v1 * sc_; }
            }
            else if (col < C_GA) *(u32x4*)((bf16_t*)(ws + WS_PS) + (size_t)row * SHW + (col - C_PS)) = pack8(v0, v1);
            else if (col < INW) {
                f32x4 s0, s1;
#pragma unroll
                for (int e = 0; e < 4; ++e) { s0[e] = sigm(v0[e]); s1[e] = sigm(v1[e]); }
                bf16_t* d = (col < C_GR) ? gates + (size_t)row * DM + (col - C_GA) : gates + (size_t)NT * DM + (size_t)row * DM + (col - C_GR);
                *(u32x4*)d = pack8(s0, s1);
            }
        }
    }
};
struct EpiKV {
    static constexpr bool PERM = true;
    unsigned char* ws;
    __device__ __forceinline__ void operator()(const f32x4 (&acc)[2][2][4][2], const Unit& u, int wr, int wc, int fr, int fq) const {
        PG8_FOR_TILE(ai, m, bj) { PG8_FENCE;
            int row = u.pm * BM + ai * HALF + wr * 64 + m * 16 + fr; asm volatile("" : "+v"(row)); const int col = u.pn * BM + bj * HALF + wc * 32 + 8 * fq;
            if (col < AW) *(u32x4*)((bf16_t*)(ws + WS_K) + (size_t)row * AW + col) = pack8(acc[ai][bj][m][0], acc[ai][bj][m][1]);
            else {
                bf16_t* d = (bf16_t*)(ws + WS_V) + ((size_t)(row / SEQ) * 512 + (col - AW)) * SEQ + (row % SEQ);
#pragma unroll
                for (int e = 0; e < 4; ++e) { d[(size_t)e * SEQ] = f2bf(acc[ai][bj][m][0][e]); d[(size_t)(4 + e) * SEQ] = f2bf(acc[ai][bj][m][1][e]); }
            }
        }
    }
};
template <bool SECOND> struct EpiMerge {
    static constexpr bool PERM = true;
    bf16_t* merged; const bf16_t* gate;
    __device__ __forceinline__ void operator()(const f32x4 (&acc)[2][2][4][2], const Unit& u, int wr, int wc, int fr, int fq) const {
        PG8_FOR_TILE(ai, m, bj) { PG8_FENCE;
            int row = u.pm * BM + ai * HALF + wr * 64 + m * 16 + fr; asm volatile("" : "+v"(row)); const int col = u.pn * BM + bj * HALF + wc * 32 + 8 * fq;
            const u32x4 gw = *(const u32x4*)(gate + (size_t)row * DM + col);
            f32x4 v0 = acc[ai][bj][m][0], v1 = acc[ai][bj][m][1];
            v0[0] *= __uint_as_float(gw.x << 16); v0[1] *= __uint_as_float(gw.x & 0xffff0000u); v0[2] *= __uint_as_float(gw.y << 16); v0[3] *= __uint_as_float(gw.y & 0xffff0000u);
            v1[0] *= __uint_as_float(gw.z << 16); v1[1] *= __uint_as_float(gw.z & 0xffff0000u); v1[2] *= __uint_as_float(gw.w << 16); v1[3] *= __uint_as_float(gw.w & 0xffff0000u);
            u32x4* d = (u32x4*)(merged + (size_t)row * DM + col);
            if (SECOND) { const u32x4 pw = *d;
                v0[0] += __uint_as_float(pw.x << 16); v0[1] += __uint_as_float(pw.x & 0xffff0000u); v0[2] += __uint_as_float(pw.y << 16); v0[3] += __uint_as_float(pw.y & 0xffff0000u);
                v1[0] += __uint_as_float(pw.z << 16); v1[1] += __uint_as_float(pw.z & 0xffff0000u); v1[2] += __uint_as_float(pw.w << 16); v1[3] += __uint_as_float(pw.w & 0xffff0000u); }
            *d = pack8(v0, v1);
        }
    }
};
struct EpiOut {
    static constexpr bool PERM = false;
    const float* x; const float* mod; float* out;
    __device__ __forceinline__ void operator()(const f32x4 (&acc)[2][2][4][2], const Unit& u, int wr, int wc, int fr, int fq) const {
        PG8_FOR_TILE(ai, m, bj) { PG8_FENCE;
            int row = u.pm * BM + ai * HALF + wr * 64 + m * 16 + fr; asm volatile("" : "+v"(row)); const float* gt = mod + (row / SEQ) * 6 * DM + 2 * DM;
#pragma unroll
            for (int n = 0; n < 2; ++n) { const int col = u.pn * BM + bj * HALF + wc * 32 + 16 * n + 4 * fq;
                const f32x4 xv = *(const f32x4*)(x + (size_t)row * DM + col), gv = *(const f32x4*)(gt + col);
                *(f32x4*)(out + (size_t)row * DM + col) = xv + gv * acc[ai][bj][m][n]; }
        }
    }
};
struct EpiMoe1 {
    static constexpr bool PERM = true;
    bf16_t* hid; const float* lw;
    __device__ __forceinline__ void operator()(const f32x4 (&acc)[2][2][4][2], const Unit& u, int wr, int wc, int fr, int fq) const {
#pragma unroll
        for (int ai = 0; ai < 2; ++ai)
#pragma unroll
            for (int m = 0; m < 4; ++m) {
                const int tr = ai * HALF + wr * 64 + m * 16 + fr; PG8_FENCE;
                if (tr < u.aux) {
                    const float w = lw[u.arow + tr]; f32x4 h0, h1;
#pragma unroll
                    for (int e = 0; e < 4; ++e) { const float g0 = acc[ai][0][m][0][e], g1 = acc[ai][0][m][1][e];
                        h0[e] = w * (g0 / (1.f + __expf(-g0))) * acc[ai][1][m][0][e]; h1[e] = w * (g1 / (1.f + __expf(-g1))) * acc[ai][1][m][1][e]; }
                    *(u32x4*)(hid + (size_t)(u.arow + tr) * DE + u.pn * HALF + wc * 32 + 8 * fq) = pack8(h0, h1);
                }
            }
    }
};
struct EpiMoe2 {
    static constexpr bool PERM = false;
    const int* ltok; const float* mod; float* out;
    __device__ __forceinline__ void operator()(const f32x4 (&acc)[2][2][4][2], const Unit& u, int wr, int wc, int fr, int fq) const {
#pragma unroll
        for (int ai = 0; ai < 2; ++ai)
#pragma unroll
            for (int m = 0; m < 4; ++m) {
                const int tr = ai * HALF + wr * 64 + m * 16 + fr; PG8_FENCE;
                if (tr < u.aux) {
                    const int tok = ltok[u.arow + tr]; const float* gt = mod + (tok / SEQ) * 6 * DM + 5 * DM; float* orow = out + (size_t)tok * DM;
#pragma unroll
                    for (int bj = 0; bj < 2; ++bj)
#pragma unroll
                        for (int n = 0; n < 2; ++n) { const int col = u.pn * BM + bj * HALF + wc * 32 + 16 * n + 4 * fq;
                            const f32x4 gv = *(const f32x4*)(gt + col); f32x4* d = (f32x4*)(orow + col); *d = *d + gv * acc[ai][bj][m][n]; }
                }
            }
    }
};
}

__device__ __forceinline__ unsigned pk2(float lo, float hi) { return (unsigned)f2bf(lo) | ((unsigned)f2bf(hi) << 16); }
__device__ __forceinline__ void transpose_item(const float* W, int K, int N, bf16_t* WT, size_t drow0, int k0, int n0, float* scr, int lane) {
#pragma unroll 8
    for (int i = 0; i < 32; ++i) { const int kk = 2 * i + (lane >> 5), n = n0 + (lane & 31); scr[kk * 33 + (lane & 31)] = (n < N) ? W[(size_t)(k0 + kk) * N + n] : 0.f; }
    asm volatile("s_waitcnt lgkmcnt(0)" ::: "memory");
    const int c = lane & 7;
#pragma unroll
    for (int j = 0; j < 4; ++j) { const int n = (lane >> 3) + 8 * j; const float* s_ = scr + (8 * c) * 33 + n;
        uint4 o; o.x = pk2(s_[0 * 33], s_[1 * 33]); o.y = pk2(s_[2 * 33], s_[3 * 33]); o.z = pk2(s_[4 * 33], s_[5 * 33]); o.w = pk2(s_[6 * 33], s_[7 * 33]);
        *(uint4*)(WT + (drow0 + n) * K + k0 + 8 * c) = o; }
    asm volatile("s_waitcnt lgkmcnt(0)" ::: "memory");
}
__device__ void ph_convert_mixer_weights(const P& p, float* lds) {
    const int lane = otid() & 63, wv = otid() >> 6;
    float* scr = lds + wv * (64 * 33);
    const int gw = blockIdx.x * (NTHR / 64) + wv, nw = gridDim.x * (NTHR / 64);
    struct M { const float* W; int K, N, Npad; size_t dst; };
    const M ms[5] = { {p.in[5], DM, INW, 5120, WS_WIN}, {p.in[7], KVL, 2 * AW, 2 * AW, WS_WKV}, {p.in[21], AW, DM, DM, WS_WBA}, {p.in[22], RW, DM, DM, WS_WBR}, {p.in[23], DM, DM, DM, WS_WOUT} };
    int base = 0;
#pragma unroll
    for (int q = 0; q < 5; ++q) {
        const int nkb = ms[q].K / 64, nnb = ms[q].Npad / 32, nitems = nkb * nnb;
        for (int it = gw; it < base + nitems; it += nw) { if (it < base) continue; const int r = it - base; const int kb = r / nnb, nb = r % nnb;
            transpose_item(ms[q].W, ms[q].K, ms[q].N, (bf16_t*)(p.ws + ms[q].dst), (size_t)nb * 32, kb * 64, nb * 32, scr, lane); }
        base += nitems;
    }
}
__device__ void ph_convert_expert_weights(const P& p, float* lds) {
    const int lane = otid() & 63, wv = otid() >> 6;
    float* scr = lds + wv * (64 * 33);
    const int gw = blockIdx.x * (NTHR / 64) + wv, nw = gridDim.x * (NTHR / 64);
    for (int it = gw; it < NE * 2 * 256; it += nw) { const int e = it >> 9, which = (it >> 8) & 1, r = it & 255, kb = r >> 4, nb = r & 15, n0 = nb * 32;
        transpose_item(p.in[28 + which] + (size_t)e * DM * DE, DM, DE, (bf16_t*)(p.ws + WS_WGU), (size_t)e * 1024 + (n0 >> 7) * 256 + which * 128 + (n0 & 127), kb * 64, n0, scr, lane); }
    for (int it = gw; it < NE * 256; it += nw) { const int e = it >> 8, r = it & 255, kb = r >> 5, nb = r & 31;
        transpose_item(p.in[30] + (size_t)e * DE * DM, DE, DM, (bf16_t*)(p.ws + WS_WDN), (size_t)e * 1024 + nb * 32, kb * 64, nb * 32, scr, lane); }
}

__device__ void ph_headnorm(bf16_t* X, const float* g) {
    const int lane = otid() & 63, wv = otid() >> 6;
    const int gw = blockIdx.x * (NTHR / 64) + wv, nw = gridDim.x * (NTHR / 64);
    for (int m = gw; m < NT; m += nw) {
        uint4 raw = *(const uint4*)(X + (size_t)m * AW + lane * 8);
        float v[8] = {bf2f(raw.x & 0xffff), bf2f(raw.x >> 16), bf2f(raw.y & 0xffff), bf2f(raw.y >> 16), bf2f(raw.z & 0xffff), bf2f(raw.z >> 16), bf2f(raw.w & 0xffff), bf2f(raw.w >> 16)};
        float ss = 0.f;
#pragma unroll
        for (int i = 0; i < 8; ++i) ss += v[i] * v[i];
        ss += __shfl_xor(ss, 1); ss += __shfl_xor(ss, 2); ss += __shfl_xor(ss, 4);
        const float rstd = rsqrtf(ss * (1.f / 64.f) + NORM_EPS);
        const int d0 = (lane & 7) * 8;
        unsigned o[4];
#pragma unroll
        for (int i = 0; i < 4; ++i) o[i] = (unsigned)f2bf(v[2 * i] * rstd * g[d0 + 2 * i]) | ((unsigned)f2bf(v[2 * i + 1] * rstd * g[d0 + 2 * i + 1]) << 16);
        *(uint4*)(X + (size_t)m * AW + lane * 8) = make_uint4(o[0], o[1], o[2], o[3]);
    }
}
__device__ void ph_kvnorm(bf16_t* X, const float* g) {
    const int lane = otid() & 63, wv = otid() >> 6;
    const int gw = blockIdx.x * (NTHR / 64) + wv, nw = gridDim.x * (NTHR / 64);
    for (int m = gw; m < NT; m += nw) {
        uint2 raw = *(const uint2*)(X + (size_t)m * KVL + lane * 4);
        float v[4] = {bf2f(raw.x & 0xffff), bf2f(raw.x >> 16), bf2f(raw.y & 0xffff), bf2f(raw.y >> 16)};
        float ss = wave_sum(v[0] * v[0] + v[1] * v[1] + v[2] * v[2] + v[3] * v[3]);
        const float rstd = rsqrtf(ss * (1.f / 256.f) + NORM_EPS);
        uint2 o; o.x = (unsigned)f2bf(v[0] * rstd * g[lane * 4]) | ((unsigned)f2bf(v[1] * rstd * g[lane * 4 + 1]) << 16);
        o.y = (unsigned)f2bf(v[2] * rstd * g[lane * 4 + 2]) | ((unsigned)f2bf(v[3] * rstd * g[lane * 4 + 3]) << 16);
        *(uint2*)(X + (size_t)m * KVL + lane * 4) = o;
    }
}

typedef _Float16 half8_t __attribute__((ext_vector_type(8)));
typedef float f32x16_t __attribute__((ext_vector_type(16)));
__device__ __forceinline__ unsigned f2key(float f) { unsigned u = __float_as_uint(f); return (u & 0x80000000u) ? ~u : (u | 0x80000000u); }
__device__ void ph_dsa_select(const P& p, float* ldsf) {
    const _Float16* QI = (const _Float16*)(p.ws + WS_QI); const _Float16* KI = (const _Float16*)(p.ws + WS_KI); const float* WI = (const float*)(p.ws + WS_WI);
    unsigned long long* MASK = (unsigned long long*)(p.ws + WS_MASK);
    unsigned* sc = (unsigned*)ldsf;
    unsigned* hist = sc + 4 * 8192;
    int* misc = (int*)(hist + 4 * 256);
    const int tid = otid(), lane = tid & 63, wv = tid >> 6, hh = lane >> 5, r32 = lane & 31;
    for (int item = blockIdx.x; item < NT / 4; item += gridDim.x) {
        const int tq0 = item * 4, b = tq0 / SEQ, t0 = tq0 % SEQ;
        __syncthreads();
        const int row = wv >> 1, wr = wv & 1;
        const int tr_ = t0 + row, nr = tr_ + 1;
        const int nwords = ((tr_ >> 8) + 1) * 4;
        unsigned long long* mrow = MASK + (size_t)(tq0 + row) * 128;
        if (t0 + 3 < TOPK) {
            for (int wi = wr; wi < nwords; wi += 2) { const int s_ = wi * 64 + lane; const unsigned long long mk = __ballot(s_ <= tr_); if (lane == 0) mrow[wi] = mk; }
            continue;
        }
        {
            const int tl_a = r32 >> 3, h_a = r32 & 7;
            half8_t a0 = *(const half8_t*)(QI + (size_t)(tq0 + tl_a) * 256 + h_a * 32 + 8 * hh), a1 = *(const half8_t*)(QI + (size_t)(tq0 + tl_a) * 256 + h_a * 32 + 16 + 8 * hh);
            float w[4][4];
#pragma unroll
            for (int tl = 0; tl < 4; ++tl) { const float4 wv4 = *(const float4*)(WI + (size_t)(tq0 + tl) * 8 + 4 * hh); w[tl][0] = wv4.x; w[tl][1] = wv4.y; w[tl][2] = wv4.z; w[tl][3] = wv4.w; }
            const int ntile = (t0 + 3) / 32 + 1;
            for (int tile = wv; tile < ntile; tile += 8) {
                const int key = tile * 32 + r32;
                const _Float16* kp = KI + (size_t)(b * SEQ + key) * 32 + 8 * hh;
                const half8_t b0 = *(const half8_t*)kp, b1 = *(const half8_t*)(kp + 16);
                f32x16_t c;
#pragma unroll
                for (int i = 0; i < 16; ++i) c[i] = 0.f;
                c = __builtin_amdgcn_mfma_f32_32x32x16_f16(a0, b0, c, 0, 0, 0);
                c = __builtin_amdgcn_mfma_f32_32x32x16_f16(a1, b1, c, 0, 0, 0);
                float x[4];
#pragma unroll
                for (int tl = 0; tl < 4; ++tl) { x[tl] = 0.f;
#pragma unroll
                    for (int e = 0; e < 4; ++e) x[tl] += w[tl][e] * fmaxf(c[4 * tl + e], 0.f); }
                const auto s01 = __builtin_amdgcn_permlane32_swap(__float_as_uint(x[0]), __float_as_uint(x[1]), false, false);
                const auto s23 = __builtin_amdgcn_permlane32_swap(__float_as_uint(x[2]), __float_as_uint(x[3]), false, false);
                const float v01 = __uint_as_float(s01[0]) + __uint_as_float(s01[1]);
                const float v23 = __uint_as_float(s23[0]) + __uint_as_float(s23[1]);
                sc[(hh) * 8192 + key] = (key <= t0 + hh) ? f2key(v01) : 0u;
                sc[(2 + hh) * 8192 + key] = (key <= t0 + 2 + hh) ? f2key(v23) : 0u;
            }
        }
        __syncthreads();
        unsigned prefix = 0; int remaining = TOPK, cnt_eq = 0;
        const int t128 = wr * 64 + lane;
        const unsigned* scr = sc + row * 8192; unsigned* hrow = hist + row * 256; int* mrw = misc + row * 8;
#pragma unroll 1
        for (int pass = 0; pass < 4; ++pass) {
            const int shift = 24 - 8 * pass;
            for (int i = t128; i < 256; i += 128) hrow[i] = 0u;
            __syncthreads();
            for (int s_ = t128; s_ < nr; s_ += 128) { const unsigned k = scr[s_]; if (pass == 0 || (k >> (shift + 8)) == (prefix >> (shift + 8))) atomicAdd(&hrow[(k >> shift) & 255u], 1u); }
            __syncthreads();
            if (wr == 0) {
                const unsigned h0 = hrow[4 * lane], h1 = hrow[4 * lane + 1], h2 = hrow[4 * lane + 2], h3 = hrow[4 * lane + 3];
                unsigned suf = h0 + h1 + h2 + h3;
#pragma unroll
                for (int o = 1; o < 64; o <<= 1) { const unsigned oth = __shfl_down(suf, o); if (lane + o < 64) suf += oth; }
                const unsigned above3 = suf - (h0 + h1 + h2 + h3);
                const unsigned ab[4] = {above3 + h3 + h2 + h1, above3 + h3 + h2, above3 + h3, above3}; const unsigned hv[4] = {h0, h1, h2, h3};
#pragma unroll
                for (int q = 0; q < 4; ++q) if ((int)ab[q] < remaining && remaining <= (int)(ab[q] + hv[q])) { mrw[0] = 4 * lane + q; mrw[1] = remaining - (int)ab[q]; mrw[2] = (int)hv[q]; }
            }
            __syncthreads();
            prefix |= ((unsigned)mrw[0]) << shift; remaining = mrw[1]; cnt_eq = mrw[2];
        }
        if (cnt_eq == remaining) {
            for (int wi = wr; wi < nwords; wi += 2) { const int s_ = wi * 64 + lane; const bool f = (s_ < nr) && (scr[s_ & 8191] >= prefix); const unsigned long long mk = __ballot(f); if (lane == 0) mrow[wi] = mk; }
        } else if (wr == 0) {
            int taken = 0;
            for (int wi = 0; wi < nwords; ++wi) { const int s_ = wi * 64 + lane; const unsigned k = (s_ < nr) ? scr[s_ & 8191] : 0u; const bool eq = (s_ < nr) && (k == prefix);
                const unsigned long long me = __ballot(eq); const int pre = __popcll(me & ((1ull << lane) - 1ull));
                const bool f = (s_ < nr) && (k > prefix || (eq && taken + pre < remaining));
                const unsigned long long mk = __ballot(f); if (lane == 0) mrow[wi] = mk; taken += __popcll(me); }
        }
    }
}

typedef unsigned u32x4_t __attribute__((ext_vector_type(4)));
__device__ __forceinline__ bf16x8_t pack_step16(const f32x16_t& x, int s2) {
    u32x4_t pk;
    if (s2 == 0) asm volatile("s_nop 1\n\tv_cvt_pk_bf16_f32 %0, %4, %5\n\tv_cvt_pk_bf16_f32 %1, %6, %7\n\tv_cvt_pk_bf16_f32 %2, %8, %9\n\tv_cvt_pk_bf16_f32 %3, %10, %11\n\ts_nop 1"
               : "=&v"(pk[0]), "=&v"(pk[1]), "=&v"(pk[2]), "=&v"(pk[3]) : "v"(x[0]), "v"(x[1]), "v"(x[2]), "v"(x[3]), "v"(x[4]), "v"(x[5]), "v"(x[6]), "v"(x[7]));
    else asm volatile("s_nop 1\n\tv_cvt_pk_bf16_f32 %0, %4, %5\n\tv_cvt_pk_bf16_f32 %1, %6, %7\n\tv_cvt_pk_bf16_f32 %2, %8, %9\n\tv_cvt_pk_bf16_f32 %3, %10, %11\n\ts_nop 1"
               : "=&v"(pk[0]), "=&v"(pk[1]), "=&v"(pk[2]), "=&v"(pk[3]) : "v"(x[8]), "v"(x[9]), "v"(x[10]), "v"(x[11]), "v"(x[12]), "v"(x[13]), "v"(x[14]), "v"(x[15]));
    return __builtin_bit_cast(bf16x8_t, pk);
}
__device__ __forceinline__ float xhalf_max(float x) { const auto t = __builtin_amdgcn_permlane32_swap(__float_as_uint(x), __float_as_uint(x), false, false); return fmaxf(__uint_as_float(t[0]), __uint_as_float(t[1])); }
__device__ __forceinline__ float xhalf_sum(float x) { const auto t = __builtin_amdgcn_permlane32_swap(__float_as_uint(x), __float_as_uint(x), false, false); return __uint_as_float(t[0]) + __uint_as_float(t[1]); }
__device__ __forceinline__ short bf16_of_int(int v) { return (short)(__float_as_uint((float)v) >> 16); }
#define MFMA32(a, b, c) __builtin_amdgcn_mfma_f32_32x32x16_bf16((a), (b), (c), 0, 0, 0)
__device__ void ph_dsa_attn(const P& p, float* ldsf) {
    const unsigned long long* MASK = (const unsigned long long*)(p.ws + WS_MASK);
    const bf16_t* Q = (const bf16_t*)(p.ws + WS_Q); const bf16_t* Kg = (const bf16_t*)(p.ws + WS_K); const bf16_t* VT = (const bf16_t*)(p.ws + WS_V);
    bf16_t* O = (bf16_t*)(p.ws + WS_OATT);
    bf16_t* L = (bf16_t*)ldsf;
    const int tid = otid(), lane = tid & 63, wv = tid >> 6, hh = lane >> 5, r32 = lane & 31;
    const float CS = 0.125f * 1.4426950408889634f;
    const float NEG = -1e30f;
    const int skey = tid >> 3, sch = (tid & 7) * 8;
    for (int u = blockIdx.x; u < 256; u += gridDim.x) {
        const int bh = u & 15, pr = u >> 4, b = bh >> 3, h = bh & 7;
        const bf16_t* Kbase = Kg + (size_t)b * SEQ * AW + h * 64; const bf16_t* Vbase = VT + (size_t)bh * 64 * SEQ;
#pragma unroll 1
        for (int half = 0; half < 2; ++half) {
            const int qb = half ? 31 - pr : pr;
            const int q0 = qb * 256 + wv * 32, q = q0 + r32, ntile = 4 * (qb + 1);
            const size_t qrow = (size_t)b * SEQ + q;
            bf16x8_t bq[5];
#pragma unroll
            for (int s2 = 0; s2 < 4; ++s2) bq[s2] = *(const bf16x8_t*)(Q + qrow * AW + h * 64 + 16 * s2 + 8 * hh);
#pragma unroll
            for (int j = 0; j < 8; ++j) bq[4][j] = 0;
            if (hh == 0) { bq[4][0] = bf16_of_int(256 >> h); bq[4][1] = (short)(__float_as_uint(4.f / (float)(1 << h)) >> 16); }
            f32x16_t o0, o1;
#pragma unroll
            for (int i = 0; i < 16; ++i) { o0[i] = 0.f; o1[i] = 0.f; }
            float m_run = NEG, l_run = 0.f;
            __syncthreads();
            { const uint4 kr = *(const uint4*)(Kbase + (size_t)skey * AW + sch), vr = *(const uint4*)(Vbase + (size_t)skey * SEQ + sch);
              *(uint4*)(L + skey * LP + sch) = kr; *(uint4*)(L + 2 * SLOT + skey * LP + sch) = vr; }
            unsigned long long mw = MASK[qrow * 128];
            __syncthreads();
#pragma unroll 1
            for (int kt = 0; kt < ntile; ++kt) {
                const int buf = kt & 1; const bool more = kt + 1 < ntile;
                uint4 kr = make_uint4(0, 0, 0, 0), vr = make_uint4(0, 0, 0, 0); unsigned long long mwn = 0ull;
                if (more) { kr = *(const uint4*)(Kbase + (size_t)((kt + 1) * 64 + skey) * AW + sch); vr = *(const uint4*)(Vbase + (size_t)skey * SEQ + (kt + 1) * 64 + sch); mwn = MASK[qrow * 128 + kt + 1]; }
                if (kt * 64 <= q0 + 31) {
                    const bf16_t* Kl = L + buf * SLOT; const bf16_t* Vl = L + (2 + buf) * SLOT;
                    f32x16_t p0, p1;
#pragma unroll
                    for (int i = 0; i < 16; ++i) { p0[i] = 0.f; p1[i] = 0.f; }
#pragma unroll
                    for (int s2 = 0; s2 < 4; ++s2) {
                        const bf16x8_t a0 = *(const bf16x8_t*)(Kl + r32 * LP + 16 * s2 + 8 * hh), a1 = *(const bf16x8_t*)(Kl + (32 + r32) * LP + 16 * s2 + 8 * hh);
                        p0 = MFMA32(a0, bq[s2], p0); p1 = MFMA32(a1, bq[s2], p1);
                    }
                    { bf16x8_t g0, g1;
#pragma unroll
                      for (int j = 0; j < 8; ++j) { g0[j] = 0; g1[j] = 0; }
                      if (hh == 0) { g0[0] = bf16_of_int(kt); g0[1] = bf16_of_int(r32); g1[0] = g0[0]; g1[1] = bf16_of_int(32 + r32); }
                      p0 = MFMA32(g0, bq[4], p0); p1 = MFMA32(g1, bq[4], p1); }
                    const unsigned wl = (unsigned)mw >> (4 * hh), wh = (unsigned)(mw >> 32) >> (4 * hh);
                    float mx = NEG;
#pragma unroll
                    for (int i = 0; i < 16; ++i) { const int bp = (i & 3) + 8 * (i >> 2);
                        const int m0 = ((int)(wl << (31 - bp))) >> 31, m1 = ((int)(wh << (31 - bp))) >> 31;
                        p0[i] = __uint_as_float((__float_as_uint(p0[i]) & (unsigned)m0) | (__float_as_uint(NEG) & ~(unsigned)m0));
                        p1[i] = __uint_as_float((__float_as_uint(p1[i]) & (unsigned)m1) | (__float_as_uint(NEG) & ~(unsigned)m1));
                        mx = fmaxf(mx, fmaxf(p0[i], p1[i])); }
                    mx = xhalf_max(mx);
                    const float m_new = fmaxf(m_run, mx);
                    const float alpha = __builtin_amdgcn_exp2f((m_run - m_new) * CS);
                    m_run = m_new;
                    const float mc = fmaxf(m_new, -1e20f) * CS;
                    float rs = 0.f;
#pragma unroll
                    for (int i = 0; i < 16; ++i) { p0[i] = __builtin_amdgcn_exp2f(p0[i] * CS - mc); p1[i] = __builtin_amdgcn_exp2f(p1[i] * CS - mc); rs += p0[i] + p1[i]; }
                    l_run = l_run * alpha + rs;
#pragma unroll
                    for (int i = 0; i < 16; ++i) { o0[i] *= alpha; o1[i] *= alpha; }
                    bf16x8_t pb[4];
                    pb[0] = pack_step16(p0, 0); pb[1] = pack_step16(p0, 1); pb[2] = pack_step16(p1, 0); pb[3] = pack_step16(p1, 1);
#pragma unroll
                    for (int ks = 0; ks < 4; ++ks) {
                        const int kofs = 32 * (ks >> 1) + 16 * (ks & 1) + 4 * hh;
                        typedef short s16x4_t __attribute__((ext_vector_type(4)));
                        const s16x4_t v00 = *(const s16x4_t*)(Vl + r32 * LP + kofs), v01 = *(const s16x4_t*)(Vl + r32 * LP + kofs + 8);
                        const s16x4_t v10 = *(const s16x4_t*)(Vl + (32 + r32) * LP + kofs), v11 = *(const s16x4_t*)(Vl + (32 + r32) * LP + kofs + 8);
                        bf16x8_t av0, av1;
#pragma unroll
                        for (int j = 0; j < 4; ++j) { av0[j] = v00[j]; av0[4 + j] = v01[j]; av1[j] = v10[j]; av1[4 + j] = v11[j]; }
                        o0 = MFMA32(av0, pb[ks], o0); o1 = MFMA32(av1, pb[ks], o1);
                    }
                }
                if (more) { *(uint4*)(L + (buf ^ 1) * SLOT + skey * LP + sch) = kr; *(uint4*)(L + (2 + (buf ^ 1)) * SLOT + skey * LP + sch) = vr; }
                mw = mwn;
                __syncthreads();
            }
            const float inv = 1.f / xhalf_sum(l_run);
            bf16_t* orow = O + qrow * AW + h * 64 + 4 * hh;
#pragma unroll
            for (int g = 0; g < 4; ++g) {
                uint2 w0, w1;
                w0.x = (unsigned)f2bf(o0[4 * g] * inv) | ((unsigned)f2bf(o0[4 * g + 1] * inv) << 16); w0.y = (unsigned)f2bf(o0[4 * g + 2] * inv) | ((unsigned)f2bf(o0[4 * g + 3] * inv) << 16);
                w1.x = (unsigned)f2bf(o1[4 * g] * inv) | ((unsigned)f2bf(o1[4 * g + 1] * inv) << 16); w1.y = (unsigned)f2bf(o1[4 * g + 2] * inv) | ((unsigned)f2bf(o1[4 * g + 3] * inv) << 16);
                *(uint2*)(orow + 8 * g) = w0; *(uint2*)(orow + 32 + 8 * g) = w1;
            }
        }
    }
}

__device__ void ph_rwkv_prep(const P& p, float* lds) {
    const bf16_t* PS = (const bf16_t*)(p.ws + WS_PS);
    const float* mu = p.in[10]; const float* w0 = p.in[11]; const float* w2 = p.in[12]; const float* a0 = p.in[13]; const float* a2 = p.in[14]; const float* g2 = p.in[15];
    const float* k_k = p.in[16]; const float* k_a = p.in[17];
    bf16_t* R = (bf16_t*)(p.ws + WS_R); bf16_t* K2 = (bf16_t*)(p.ws + WS_K2); bf16_t* VV = (bf16_t*)(p.ws + WS_VV); bf16_t* KK = (bf16_t*)(p.ws + WS_KK); bf16_t* BB = (bf16_t*)(p.ws + WS_BB);
    bf16_t* G = (bf16_t*)(p.ws + WS_G); float* DD = (float*)(p.ws + WS_DD);
    float* s_tw = lds; float* s_al = lds + 8 * 64; float* s_sg = lds + 16 * 64;
    const int tid = otid();
    for (int grp = blockIdx.x; grp < NT / 8; grp += gridDim.x) {
        const int m0 = grp * 8;
        __syncthreads();
        for (int e = tid; e < 8 * 288; e += NTHR) {
            const int tk = e / 288, c = e % 288, col = 1536 + c, m = m0 + tk;
            const float cur = bf2f(PS[(size_t)m * SHW + col]);
            const float prv = (m % SEQ) ? bf2f(PS[(size_t)(m - 1) * SHW + col]) : 0.f;
            const float mx = cur + (prv - cur) * mu[col];
            if (c < 64) s_tw[tk * 64 + c] = tanhf(mx); else if (c < 128) s_al[tk * 64 + (c - 64)] = mx; else s_sg[tk * 160 + (c - 128)] = sigmoidf_(mx);
        }
        __syncthreads();
        float accw[8], acca[8], accg[8];
#pragma unroll
        for (int i = 0; i < 8; ++i) { accw[i] = 0.f; acca[i] = 0.f; accg[i] = 0.f; }
        for (int i = 0; i < 64; ++i) { const float wv_ = w2[i * RW + tid], av_ = a2[i * RW + tid];
#pragma unroll
            for (int tk = 0; tk < 8; ++tk) { accw[tk] += s_tw[tk * 64 + i] * wv_; acca[tk] += s_al[tk * 64 + i] * av_; } }
        for (int i = 0; i < 160; ++i) { const float gv_ = g2[i * RW + tid];
#pragma unroll
            for (int tk = 0; tk < 8; ++tk) accg[tk] += s_sg[tk * 160 + i] * gv_; }
        const float w0c = w0[tid], a0c = a0[tid], kkc = k_k[tid], kac = k_a[tid], mur = mu[tid], muk = mu[512 + tid], muv = mu[1024 + tid];
#pragma unroll
        for (int tk = 0; tk < 8; ++tk) {
            const int m = m0 + tk; const bool first = (m % SEQ) == 0;
            const bf16_t* cr = PS + (size_t)m * SHW; const bf16_t* pr = PS + (size_t)(m - 1) * SHW;
            const float rc = bf2f(cr[tid]), kc = bf2f(cr[512 + tid]), vc = bf2f(cr[1024 + tid]);
            const float rp = first ? 0.f : bf2f(pr[tid]), kp = first ? 0.f : bf2f(pr[512 + tid]), vp = first ? 0.f : bf2f(pr[1024 + tid]);
            const float r = rc + (rp - rc) * mur, k = kc + (kp - kc) * muk, v = vc + (vp - vc) * muv;
            const float xw = -(w0c + accw[tk]);
            const float sp = fmaxf(xw, 0.f) + log1pf(__expf(-fabsf(xw)));
            const float w = -sp - 0.5f;
            const float dec = -__expf(w);
            const float a = sigmoidf_(a0c + acca[tk]);
            const float kkr = k * kkc;
            const float ss = wave_sum(kkr * kkr);
            const float kk = kkr / fmaxf(sqrtf(ss), 1e-12f);
            const float k2 = k * (1.f + (a - 1.f) * kac);
            const size_t o = (size_t)m * RW + tid;
            R[o] = f2bf(r); K2[o] = f2bf(k2); VV[o] = f2bf(v); KK[o] = f2bf(kk); BB[o] = f2bf(kk * a); G[o] = f2bf(accg[tk]); DD[o] = dec;
        }
    }
}

template <bool XC, bool YC>
__device__ __forceinline__ f32x4_t mm_tile(const bf16_t* X, int xrs, int xcs, const bf16_t* Y, int yrs, int ycs, int tr, int tc, f32x4_t acc, int lane) {
    const int r = lane & 15, q = lane >> 4;
#pragma unroll
    for (int s2 = 0; s2 < 2; ++s2) {
        bf16x8_t a, b;
        const bf16_t* xp = X + (16 * tr + r) * xrs + (32 * s2 + 8 * q) * xcs;
        if (XC) a = *(const bf16x8_t*)xp; else {
#pragma unroll
            for (int j = 0; j < 8; ++j) a[j] = (short)xp[j * xcs]; }
        const bf16_t* yp = Y + (32 * s2 + 8 * q) * yrs + (16 * tc + r) * ycs;
        if (YC) b = *(const bf16x8_t*)yp; else {
#pragma unroll
            for (int j = 0; j < 8; ++j) b[j] = (short)yp[j * yrs]; }
        acc = __builtin_amdgcn_mfma_f32_16x16x32_bf16(a, b, acc, 0, 0, 0);
    }
    return acc;
}
__device__ __forceinline__ void st_tile(const f32x4_t& acc, bf16_t* D, int drs, int dcs, int tr, int tc, int lane) {
    const int row0 = 16 * tr + 4 * (lane >> 4), col = 16 * tc + (lane & 15);
#pragma unroll
    for (int e = 0; e < 4; ++e) D[(row0 + e) * drs + col * dcs] = f2bf(acc[e]);
}
__device__ __forceinline__ f32x4_t ld_tile(const bf16_t* D, int drs, int dcs, int tr, int tc, int lane) {
    const int row0 = 16 * tr + 4 * (lane >> 4), col = 16 * tc + (lane & 15); f32x4_t v;
#pragma unroll
    for (int e = 0; e < 4; ++e) v[e] = bf2f(D[(row0 + e) * drs + col * dcs]);
    return v;
}
template <bool STRICT> __device__ __forceinline__ void triu_tile(f32x4_t& acc, int tr, int tc, int lane) {
    const int row0 = 16 * tr + 4 * (lane >> 4), col = 16 * tc + (lane & 15);
#pragma unroll
    for (int e = 0; e < 4; ++e) { const bool keep = STRICT ? (row0 + e < col) : (row0 + e <= col); acc[e] = keep ? acc[e] : 0.f; }
}

__device__ void ph_rwkv_r1(const P& p, float* ldsf) {
    const bf16_t* R = (const bf16_t*)(p.ws + WS_R); const bf16_t* K2 = (const bf16_t*)(p.ws + WS_K2); const bf16_t* VV = (const bf16_t*)(p.ws + WS_VV);
    const bf16_t* KK = (const bf16_t*)(p.ws + WS_KK); const bf16_t* BB = (const bf16_t*)(p.ws + WS_BB); const float* DD = (const float*)(p.ws + WS_DD);
    bf16_t* G1T = (bf16_t*)(p.ws + WS_G1T); bf16_t* G2T = (bf16_t*)(p.ws + WS_G2T); bf16_t* PT = (bf16_t*)(p.ws + WS_PT); bf16_t* QT = (bf16_t*)(p.ws + WS_QT);
    bf16_t* L = (bf16_t*)ldsf;
    bf16_t* At = L + 0 * SLOT; bf16_t* Bt = L + 1 * SLOT; bf16_t* Kt = L + 2 * SLOT; bf16_t* Rt = L + 3 * SLOT; bf16_t* Vm = L + 4 * SLOT; bf16_t* Bh = L + 5 * SLOT; bf16_t* Kh = L + 6 * SLOT;
    bf16_t* S7 = L + 7 * SLOT; bf16_t* S8 = L + 8 * SLOT; bf16_t* S9 = L + 9 * SLOT; bf16_t* S10 = L + 10 * SLOT; bf16_t* S11 = L + 11 * SLOT;
    float* cs = (float*)(L + 12 * SLOT);
    float* segs = cs + 64 * 65;
    const int tid = otid(), lane = tid & 63, wv = tid >> 6;
    const int t0 = 2 * wv, t1 = 2 * wv + 1;
    for (int ch = blockIdx.x; ch < NB * 8 * (SEQ / 64); ch += gridDim.x) {
        const int bh = ch >> 7, c = ch & 127, b = bh >> 3, h = bh & 7;
        const size_t gbase = ((size_t)b * SEQ + (size_t)c * 64) * RW + h * 64;
        __syncthreads();
        const int st = tid >> 3, sj = (tid & 7) * 8;
        { const float4 l0 = *(const float4*)(DD + gbase + (size_t)st * RW + sj), l1 = *(const float4*)(DD + gbase + (size_t)st * RW + sj + 4);
          float* d = cs + st * 65 + sj; d[0] = l0.x; d[1] = l0.y; d[2] = l0.z; d[3] = l0.w; d[4] = l1.x; d[5] = l1.y; d[6] = l1.z; d[7] = l1.w; }
        __syncthreads();
        { const int j = tid & 63, sg = tid >> 6; float run = 0.f;
#pragma unroll
          for (int i = 0; i < 8; ++i) { run += cs[(sg * 8 + i) * 65 + j]; }
          segs[sg * 64 + j] = run; }
        __syncthreads();
        { const int j = tid & 63, sg = tid >> 6; float run = 0.f;
          for (int q = 0; q < sg; ++q) run += segs[q * 64 + j];
#pragma unroll
          for (int i = 0; i < 8; ++i) { run += cs[(sg * 8 + i) * 65 + j]; cs[(sg * 8 + i) * 65 + j] = run; } }
        __syncthreads();
        {
            const uint4 rr = *(const uint4*)(R + gbase + (size_t)st * RW + sj), kr = *(const uint4*)(K2 + gbase + (size_t)st * RW + sj), vr = *(const uint4*)(VV + gbase + (size_t)st * RW + sj);
            const uint4 kkr = *(const uint4*)(KK + gbase + (size_t)st * RW + sj), br = *(const uint4*)(BB + gbase + (size_t)st * RW + sj);
            const unsigned rw_[4] = {rr.x, rr.y, rr.z, rr.w}, kw_[4] = {kr.x, kr.y, kr.z, kr.w}, kkw_[4] = {kkr.x, kkr.y, kkr.z, kkr.w}, bw_[4] = {br.x, br.y, br.z, br.w};
            *(uint4*)(Vm + st * LP + sj) = vr;
            unsigned oa[4], ob[4], ok[4], orr[4], obh[4], okh[4];
#pragma unroll
            for (int e2 = 0; e2 < 4; ++e2) {
                float va[2], vb[2], vk[2], vr2[2], vbh[2], vkh[2];
#pragma unroll
                for (int hf = 0; hf < 2; ++hf) {
                    const int j = sj + 2 * e2 + hf;
                    const float lgI = cs[st * 65 + j], lgE = st ? cs[(st - 1) * 65 + j] : 0.f, gl = cs[63 * 65 + j];
                    const float rv = hf ? __uint_as_float(rw_[e2] & 0xffff0000u) : __uint_as_float(rw_[e2] << 16);
                    const float kv = hf ? __uint_as_float(kw_[e2] & 0xffff0000u) : __uint_as_float(kw_[e2] << 16);
                    const float kkv = hf ? __uint_as_float(kkw_[e2] & 0xffff0000u) : __uint_as_float(kkw_[e2] << 16);
                    const float bv = hf ? __uint_as_float(bw_[e2] & 0xffff0000u) : __uint_as_float(bw_[e2] << 16);
                    const float einv = __expf(-lgI), eh = __expf(gl - lgI);
                    va[hf] = -kkv * __expf(lgE); vb[hf] = bv * einv; vk[hf] = kv * einv; vr2[hf] = rv * __expf(lgI); vbh[hf] = bv * eh; vkh[hf] = kv * eh;
                }
                oa[e2] = (unsigned)f2bf(va[0]) | ((unsigned)f2bf(va[1]) << 16); ob[e2] = (unsigned)f2bf(vb[0]) | ((unsigned)f2bf(vb[1]) << 16);
                ok[e2] = (unsigned)f2bf(vk[0]) | ((unsigned)f2bf(vk[1]) << 16); orr[e2] = (unsigned)f2bf(vr2[0]) | ((unsigned)f2bf(vr2[1]) << 16);
                obh[e2] = (unsigned)f2bf(vbh[0]) | ((unsigned)f2bf(vbh[1]) << 16); okh[e2] = (unsigned)f2bf(vkh[0]) | ((unsigned)f2bf(vkh[1]) << 16);
            }
            *(uint4*)(At + st * LP + sj) = make_uint4(oa[0], oa[1], oa[2], oa[3]); *(uint4*)(Bt + st * LP + sj) = make_uint4(ob[0], ob[1], ob[2], ob[3]);
            *(uint4*)(Kt + st * LP + sj) = make_uint4(ok[0], ok[1], ok[2], ok[3]); *(uint4*)(Rt + st * LP + sj) = make_uint4(orr[0], orr[1], orr[2], orr[3]);
            *(uint4*)(Bh + st * LP + sj) = make_uint4(obh[0], obh[1], obh[2], obh[3]); *(uint4*)(Kh + st * LP + sj) = make_uint4(okh[0], okh[1], okh[2], okh[3]);
        }
        __syncthreads();
#define R1_FOR_TILES(idx, tr, tc) _Pragma("unroll") for (int _q = 0; _q < 2; ++_q) { const int idx = _q ? t1 : t0; const int tr = idx >> 2, tc = idx & 3;
#define R1_END }
        const f32x4_t zero4 = {0.f, 0.f, 0.f, 0.f};
        R1_FOR_TILES(idx, tr, tc)
            f32x4_t mab = mm_tile<true, true>(Bt, LP, 1, At, 1, LP, tr, tc, zero4, lane); triu_tile<true>(mab, tr, tc, lane); st_tile(mab, S7, LP, 1, tr, tc, lane);
            { f32x4_t tt = mab; const int row0 = 16 * tr + 4 * (lane >> 4), col = 16 * tc + (lane & 15);
#pragma unroll
              for (int e = 0; e < 4; ++e) tt[e] += (row0 + e == col) ? 1.f : 0.f;
              st_tile(tt, S11, LP, 1, tr, tc, lane); }
            f32x4_t mka = mm_tile<true, true>(Kt, LP, 1, At, 1, LP, tr, tc, zero4, lane); triu_tile<true>(mka, tr, tc, lane); st_tile(mka, S8, LP, 1, tr, tc, lane);
            f32x4_t nbr = mm_tile<true, true>(Bt, LP, 1, Rt, 1, LP, tr, tc, zero4, lane); triu_tile<false>(nbr, tr, tc, lane); st_tile(nbr, S9, LP, 1, tr, tc, lane);
            f32x4_t nkr = mm_tile<true, true>(Kt, LP, 1, Rt, 1, LP, tr, tc, zero4, lane); triu_tile<false>(nkr, tr, tc, lane); st_tile(nkr, S10, LP, 1, tr, tc, lane);
        R1_END
        __syncthreads();
        bf16_t* Pc = S7; bf16_t* Pn = Kt; bf16_t* Tc = S11; bf16_t* Tn = Bt;
#pragma unroll 1
        for (int lvl = 0; lvl < 5; ++lvl) {
            R1_FOR_TILES(idx, tr, tc)
                f32x4_t pp = mm_tile<true, false>(Pc, LP, 1, Pc, LP, 1, tr, tc, zero4, lane); st_tile(pp, Pn, LP, 1, tr, tc, lane);
            R1_END
            __syncthreads();
            R1_FOR_TILES(idx, tr, tc)
                f32x4_t tn = ld_tile(Tc, LP, 1, tr, tc, lane); tn = mm_tile<true, false>(Tc, LP, 1, Pn, LP, 1, tr, tc, tn, lane); st_tile(tn, Tn, LP, 1, tr, tc, lane);
            R1_END
            __syncthreads();
            bf16_t* x_ = Pc; Pc = Pn; Pn = x_; x_ = Tc; Tc = Tn; Tn = x_;
        }
        bf16_t* W1 = Pc; bf16_t* W2 = Pn; bf16_t* Qk = Tn;
        R1_FOR_TILES(idx, tr, tc)
            f32x4_t w1 = mm_tile<false, false>(At, 1, LP, Tc, LP, 1, tr, tc, zero4, lane); st_tile(w1, W1, LP, 1, tr, tc, lane);
            f32x4_t w2 = mm_tile<true, false>(S8, LP, 1, Tc, LP, 1, tr, tc, zero4, lane); st_tile(w2, W2, LP, 1, tr, tc, lane);
        R1_END
        __syncthreads();
        const size_t ob_ = (size_t)ch * 4096;
        R1_FOR_TILES(idx, tr, tc)
            f32x4_t g1 = ld_tile(Rt, 1, LP, tr, tc, lane); g1 = mm_tile<true, false>(W1, LP, 1, S9, LP, 1, tr, tc, g1, lane); st_tile(g1, G1T + ob_, 1, 64, tr, tc, lane);
            f32x4_t g2 = ld_tile(S10, LP, 1, tr, tc, lane); g2 = mm_tile<true, false>(W2, LP, 1, S9, LP, 1, tr, tc, g2, lane); st_tile(g2, G2T + ob_, 1, 64, tr, tc, lane);
            f32x4_t pm = mm_tile<true, false>(W1, LP, 1, Bh, LP, 1, tr, tc, zero4, lane);
            { const int row0 = 16 * tr + 4 * (lane >> 4), col = 16 * tc + (lane & 15);
#pragma unroll
              for (int e = 0; e < 4; ++e) pm[e] += (row0 + e == col) ? __expf(cs[63 * 65 + col]) : 0.f; }
            st_tile(pm, PT + ob_, 1, 64, tr, tc, lane);
            f32x4_t qk = ld_tile(Kh, LP, 1, tr, tc, lane); qk = mm_tile<true, false>(W2, LP, 1, Bh, LP, 1, tr, tc, qk, lane); st_tile(qk, Qk, LP, 1, tr, tc, lane);
        R1_END
        __syncthreads();
        R1_FOR_TILES(idx, tr, tc)
            f32x4_t qt = mm_tile<false, false>(Qk, 1, LP, Vm, LP, 1, tr, tc, zero4, lane); st_tile(qt, QT + ob_, 64, 1, tr, tc, lane);
        R1_END
    }
}
__device__ void ph_rwkv_r2(const P& p, float* ldsf) {
    const bf16_t* PT = (const bf16_t*)(p.ws + WS_PT); const bf16_t* QT = (const bf16_t*)(p.ws + WS_QT); bf16_t* SX = (bf16_t*)(p.ws + WS_SX);
    bf16_t* L = (bf16_t*)ldsf; bf16_t* X0 = L; bf16_t* X1 = L + SLOT;
    const int tid = otid(), lane = tid & 63, wv = tid >> 6; const int t0 = 2 * wv, t1 = 2 * wv + 1;
    for (int bh = blockIdx.x; bh < NB * 8; bh += gridDim.x) {
        __syncthreads();
        for (int e = tid; e < SLOT; e += NTHR) X0[e] = 0;
        __syncthreads();
        bf16_t* Xc = X0; bf16_t* Xn = X1;
        for (int c = 0; c < SEQ / 64; ++c) {
            const size_t ob_ = ((size_t)bh * 128 + c) * 4096;
            R1_FOR_TILES(idx, tr, tc)
                { f32x4_t xv = ld_tile(Xc, LP, 1, tr, tc, lane); st_tile(xv, SX + ob_, 1, 64, tr, tc, lane); }
                f32x4_t xn = ld_tile(QT + ob_, 64, 1, tr, tc, lane);
                xn = mm_tile<true, false>(PT + ob_, 64, 1, Xc, LP, 1, tr, tc, xn, lane);
                st_tile(xn, Xn, LP, 1, tr, tc, lane);
            R1_END
            __syncthreads();
            bf16_t* x_ = Xc; Xc = Xn; Xn = x_;
        }
    }
}
__device__ void ph_rwkv_r3(const P& p, float* ldsf) {
    const bf16_t* VV = (const bf16_t*)(p.ws + WS_VV); const bf16_t* G1T = (const bf16_t*)(p.ws + WS_G1T); const bf16_t* G2T = (const bf16_t*)(p.ws + WS_G2T); const bf16_t* SX = (const bf16_t*)(p.ws + WS_SX);
    float* YS = (float*)(p.ws + WS_YS);
    bf16_t* Vm = (bf16_t*)ldsf;
    const int tid = otid(), lane = tid & 63, wv = tid >> 6; const int t0 = 2 * wv, t1 = 2 * wv + 1;
    for (int ch = blockIdx.x; ch < NB * 8 * (SEQ / 64); ch += gridDim.x) {
        const int bh = ch >> 7, c = ch & 127, b = bh >> 3, h = bh & 7;
        const size_t gbase = ((size_t)b * SEQ + (size_t)c * 64) * RW + h * 64, ob_ = (size_t)ch * 4096;
        __syncthreads();
        { const int st = tid >> 3, sj = (tid & 7) * 8; *(uint4*)(Vm + st * LP + sj) = *(const uint4*)(VV + gbase + (size_t)st * RW + sj); }
        __syncthreads();
        R1_FOR_TILES(idx, tr, tc)
            const f32x4_t zero4 = {0.f, 0.f, 0.f, 0.f};
            f32x4_t y = mm_tile<true, true>(SX + ob_, 64, 1, G1T + ob_, 1, 64, tr, tc, zero4, lane);
            y = mm_tile<false, true>(Vm, 1, LP, G2T + ob_, 1, 64, tr, tc, y, lane);
            const int i0 = 16 * tr + 4 * (lane >> 4), t = 16 * tc + (lane & 15);
            *(f32x4_t*)(YS + gbase + (size_t)t * RW + i0) = y;
        R1_END
    }
}
#undef R1_FOR_TILES
#undef R1_END

__device__ void ph_rwkv_post(const P& p) {
    const bf16_t* R = (const bf16_t*)(p.ws + WS_R); const bf16_t* K2 = (const bf16_t*)(p.ws + WS_K2); const bf16_t* VV = (const bf16_t*)(p.ws + WS_VV); const bf16_t* G = (const bf16_t*)(p.ws + WS_G);
    const float* YS = (const float*)(p.ws + WS_YS); bf16_t* ORW = (bf16_t*)(p.ws + WS_ORW);
    const float* r_k = p.in[18]; const float* ln_w = p.in[19]; const float* ln_b = p.in[20];
    const int tid = otid();
    const float rkc = r_k[tid], lw = ln_w[tid], lb = ln_b[tid];
    for (int m = blockIdx.x; m < NT; m += gridDim.x) {
        const size_t o = (size_t)m * RW + tid;
        const float y = YS[o];
        const float mean = wave_sum(y) * (1.f / 64.f);
        const float dy = y - mean;
        const float var = wave_sum(dy * dy) * (1.f / 64.f);
        const float yn = dy * rsqrtf(var + GN_EPS) * lw + lb;
        const float r = bf2f(R[o]), k2 = bf2f(K2[o]), v = bf2f(VV[o]), g = bf2f(G[o]);
        const float rk = wave_sum(r * k2 * rkc);
        ORW[o] = f2bf((yn + rk * v) * g);
    }
}

__device__ void ph_moe_offsets(const P& p) {
    if (blockIdx.x != 0) return;
    int* ctl = (int*)(p.ws + WS_CTL); int* ltok = (int*)(p.ws + WS_LTOK);
    if (otid() == 0) {
        int off = 0, n1 = 0, n2a = 0, n2b = 0;
        int4* t1 = (int4*)(ctl + CT_TAB1); int4* t2a = (int4*)(ctl + CT_TAB2A); int4* t2b = (int4*)(ctl + CT_TAB2B);
        for (int li = 0; li < 64; ++li) {
            const int cnt = ctl[CT_CNT + li], e = li & 31; ctl[CT_OFF + li] = off;
            for (int mt = 0; mt * 256 < cnt; ++mt) {
                const int rem = cnt - mt * 256;
                for (int nt = 0; nt < 4; ++nt) {
                    t1[n1++] = make_int4(off + mt * 256, e * 1024 + nt * 256, rem, nt);
                    if (li < 32) t2a[n2a++] = make_int4(off + mt * 256, e * 1024 + nt * 256, rem, nt); else t2b[n2b++] = make_int4(off + mt * 256, e * 1024 + nt * 256, rem, nt);
                }
            }
            off += (cnt + 255) / 256 * 256;
        }
        ctl[CT_NU] = n1; ctl[CT_NU + 1] = n2a; ctl[CT_NU + 2] = n2b;
    }
    __syncthreads();
    for (int li = 0; li < 64; ++li) { const int cnt = ctl[CT_CNT + li], off = ctl[CT_OFF + li], pad = (cnt + 255) / 256 * 256;
        for (int r = cnt + otid(); r < pad; r += NTHR) ltok[off + r] = 0; }
}
__device__ void ph_moe_scatter(const P& p) {
    int* ctl = (int*)(p.ws + WS_CTL); const int* route = (const int*)(p.ws + WS_ROUTE);
    int* ltok = (int*)(p.ws + WS_LTOK); float* lw = (float*)(p.ws + WS_LW);
    for (int m = blockIdx.x * NTHR + otid(); m < NT; m += gridDim.x * NTHR) {
#pragma unroll
        for (int sl = 0; sl < 2; ++sl) { const int li = sl * 32 + route[m * 4 + sl]; const int pos = ctl[CT_OFF + li] + atomicAdd(ctl + CT_CUR + li, 1); ltok[pos] = m; lw[pos] = __int_as_float(route[m * 4 + 2 + sl]); }
    }
}

template <int PH>
__device__ __forceinline__ void run_phase(const P& p, unsigned char* lds_raw) {
    float* lds = (float*)lds_raw; PG8_LAS unsigned char* ldsg = (PG8_LAS unsigned char*)lds_raw;
    const int G = gridDim.x, c = blockIdx.x;
    if constexpr (PH == 0) { ph_mod(p, lds); __syncthreads(); ph_convert_mixer_weights(p, lds); }
    if constexpr (PH == 1) ph_norm(p, p.in[0], p.in[4], 0, (bf16_t*)(p.ws + WS_XN));
    if constexpr (PH == 2) { pg8::Gemm g{(const bf16_t*)(p.ws + WS_XN), (const bf16_t*)(p.ws + WS_WIN), DM, nullptr}; pg8::StaticOrder S; S.init(NT, 5120, G, c);
        pg8::EpiInproj E{p.ws, (bf16_t*)p.out}; pg8::gemm_phase(ldsg, g, S, E); }
    if constexpr (PH == 3) { ph_headnorm((bf16_t*)(p.ws + WS_Q), p.in[8]); ph_kvnorm((bf16_t*)(p.ws + WS_KVN), p.in[6]); }
    if constexpr (PH == 4) { pg8::Gemm g{(const bf16_t*)(p.ws + WS_KVN), (const bf16_t*)(p.ws + WS_WKV), KVL, nullptr}; pg8::StaticOrder S; S.init(NT, 2 * AW, G, c);
        pg8::EpiKV E{p.ws}; pg8::gemm_phase(ldsg, g, S, E); }
    if constexpr (PH == 5) ph_headnorm((bf16_t*)(p.ws + WS_K), p.in[9]);
    if constexpr (PH == 6) ph_dsa_attn(p, lds);
    if constexpr (PH == 21) ph_dsa_select(p, lds);
    if constexpr (PH == 7) ph_rwkv_prep(p, lds);
    if constexpr (PH == 8) ph_rwkv_r1(p, lds);
    if constexpr (PH == 19) ph_rwkv_r2(p, lds);
    if constexpr (PH == 20) ph_rwkv_r3(p, lds);
    if constexpr (PH == 9) ph_rwkv_post(p);
    if constexpr (PH == 10) { pg8::Gemm g{(const bf16_t*)(p.ws + WS_OATT), (const bf16_t*)(p.ws + WS_WBA), AW, nullptr}; pg8::StaticOrder S; S.init(NT, DM, G, c);
        pg8::EpiMerge<false> E{(bf16_t*)(p.ws + WS_MERGED), (const bf16_t*)p.out}; pg8::gemm_phase(ldsg, g, S, E);
        ph_convert_expert_weights(p, lds); }
    if constexpr (PH == 11) { pg8::Gemm g{(const bf16_t*)(p.ws + WS_ORW), (const bf16_t*)(p.ws + WS_WBR), RW, nullptr}; pg8::StaticOrder S; S.init(NT, DM, G, c);
        pg8::EpiMerge<true> E{(bf16_t*)(p.ws + WS_MERGED), (const bf16_t*)p.out + (size_t)NT * DM}; pg8::gemm_phase(ldsg, g, S, E); }
    if constexpr (PH == 12) { pg8::Gemm g{(const bf16_t*)(p.ws + WS_MERGED), (const bf16_t*)(p.ws + WS_WOUT), DM, nullptr}; pg8::StaticOrder S; S.init(NT, DM, G, c);
        pg8::EpiOut E{p.in[0], (const float*)(p.ws + WS_MOD), p.out}; pg8::gemm_phase(ldsg, g, S, E); }
    if constexpr (PH == 13) ph_norm_route(p, lds);
    if constexpr (PH == 14) ph_moe_offsets(p);
    if constexpr (PH == 15) ph_moe_scatter(p);
    if constexpr (PH == 16) { const int* ctl = (const int*)(p.ws + WS_CTL);
        pg8::Gemm g{(const bf16_t*)(p.ws + WS_XN2), (const bf16_t*)(p.ws + WS_WGU), DM, (const int*)(p.ws + WS_LTOK)}; pg8::TableOrder S{(const int4*)(ctl + CT_TAB1), ctl[CT_NU], G, c};
        pg8::EpiMoe1 E{(bf16_t*)(p.ws + WS_HID), (const float*)(p.ws + WS_LW)}; pg8::gemm_phase(ldsg, g, S, E); }
    if constexpr (PH == 17 || PH == 18) { const int* ctl = (const int*)(p.ws + WS_CTL);
        pg8::Gemm g{(const bf16_t*)(p.ws + WS_HID), (const bf16_t*)(p.ws + WS_WDN), DE, nullptr};
        pg8::TableOrder S{(const int4*)(ctl + (PH == 17 ? CT_TAB2A : CT_TAB2B)), ctl[CT_NU + (PH == 17 ? 1 : 2)], G, c};
        pg8::EpiMoe2 E{(const int*)(p.ws + WS_LTOK), (const float*)(p.ws + WS_MOD), p.out}; pg8::gemm_phase(ldsg, g, S, E); }
}
constexpr int LDS_BYTES = 147456;
constexpr int ORDER[] = {0, 1, 2, 3, 4, 5, 21, 6, 7, 8, 19, 20, 9, 10, 11, 12, 13, 14, 15, 16, 17, 18};
constexpr int NPHASE = sizeof(ORDER) / sizeof(int);
constexpr int CT_BAR = 65536;
constexpr int LDS_ST = LDS_BYTES - 64;
template <int I> __device__ __forceinline__ void run_all(const P& p, unsigned char* lds, const XcdBarrier& bar) {
    run_phase<ORDER[I]>(p, lds);
    if constexpr (I + 1 < NPHASE) { xcd_barrier(bar); run_all<I + 1>(p, lds, bar); }
}
__global__ void __launch_bounds__(NTHR, 2) k_mega(P p) {
    extern __shared__ __attribute__((aligned(16))) unsigned char lds[];
    volatile LAS3 unsigned* st = (volatile LAS3 unsigned*)((LAS3 unsigned char*)lds + LDS_ST);
    if (otid() < 16) st[otid()] = 0u;
    __syncthreads();
    const XcdBarrier bar = xcd_barrier_post((unsigned*)(p.ws + WS_CTL) + CT_BAR, st);
    run_all<0>(p, lds, bar);
}
}

extern "C" void kernel_launch(void* const* d_in, const int* in_sizes, int n_in, void* d_out, int out_size, void* d_ws, size_t ws_size, hipStream_t stream) {
    if (n_in != 31 || out_size != NT * DM || ws_size < WS_END) { fprintf(stderr, "kernel_launch: unexpected shapes (n_in %d out %d ws %zu need %zu)\n", n_in, out_size, ws_size, (size_t)WS_END); return; }
    P p{};
    for (int i = 0; i < 31; ++i) p.in[i] = (const float*)d_in[i];
    p.out = (float*)d_out; p.ws = (unsigned char*)d_ws;
    (void)hipMemsetAsync((char*)d_ws + WS_CTL, 0, 1 * MiB, stream);
    static int grid_blocks = 0;
    if (!grid_blocks) {
        int dev = 0, cus = 0, per_cu = 0;
        (void)hipGetDevice(&dev);
        (void)hipDeviceGetAttribute(&cus, hipDeviceAttributeMultiprocessorCount, dev);
        (void)hipFuncSetAttribute((const void*)k_mega, hipFuncAttributeMaxDynamicSharedMemorySize, LDS_BYTES);
        (void)hipOccupancyMaxActiveBlocksPerMultiprocessor(&per_cu, (const void*)k_mega, NTHR, LDS_BYTES);
        if (per_cu < 1) per_cu = 1;
        if (per_cu > 1) per_cu = 1;
        grid_blocks = cus * per_cu;
        fprintf(stderr, "kernel_launch: cus %d per_cu %d grid %d\n", cus, per_cu, grid_blocks);
    }
    hipLaunchKernelGGL(k_mega, dim3(grid_blocks), dim3(NTHR), LDS_BYTES, stream, p);
}
```

```cpp
#include <hip/hip_runtime.h>
#include <cstdio>
#include <cstdint>

namespace {
constexpr int NB = 2, SEQ = 8192, DM = 1024, NT = NB * SEQ;
constexpr int AW = 512, KVL = 256, NIH = 8, IDD = 32, SHW = 1824, INW = 4936;
constexpr int C_KV = 512, C_QI = 768, C_PS = 1064, C_GA = 2888, C_GR = 3912;
constexpr int IDXW = 296;
constexpr int RW = 512, NE = 32, DE = 512;
constexpr int TOPK = 256;
constexpr float NORM_EPS = 1e-6f, GN_EPS = 64e-5f;
constexpr int NTHR = 512;

typedef unsigned short bf16_t;
__device__ __forceinline__ float bf2f(bf16_t v) { return __uint_as_float(((unsigned)v) << 16); }
__device__ __forceinline__ bf16_t f2bf(float f) { unsigned u = __float_as_uint(f); return (bf16_t)((u + 0x7fffu + ((u >> 16) & 1u)) >> 16); }

constexpr size_t MiB = 1u << 20;
constexpr size_t WS_CTL = 0;
constexpr size_t WS_MOD = 1 * MiB;
constexpr size_t WS_LW2T = 512 * 1024, WS_LA2T = 576 * 1024, WS_LG2T = 640 * 1024;
constexpr size_t WS_WIN = 2 * MiB;
constexpr size_t WS_WKV = 12 * MiB;
constexpr size_t WS_WBA = 13 * MiB;
constexpr size_t WS_WBR = 14 * MiB;
constexpr size_t WS_WOUT = 15 * MiB;
constexpr size_t WS_XN = 17 * MiB;
constexpr size_t WS_G = 17 * MiB;
constexpr size_t WS_ORW = 33 * MiB;
constexpr size_t WS_Q = 49 * MiB;
constexpr size_t WS_KVN = 65 * MiB;
constexpr size_t WS_K = 73 * MiB;
constexpr size_t WS_V = 89 * MiB;
constexpr size_t WS_QI = 105 * MiB;
constexpr size_t WS_KI = 113 * MiB;
constexpr size_t WS_WI = 114 * MiB;
constexpr size_t WS_MASK = 197 * MiB;
constexpr size_t WS_PS = 124 * MiB;
constexpr size_t WS_YS = 124 * MiB;
constexpr size_t WS_OATT = 181 * MiB;
constexpr size_t WS_R = 49 * MiB, WS_K2 = 65 * MiB, WS_VV = 81 * MiB, WS_KK = 97 * MiB;
constexpr size_t WS_BB = 197 * MiB;
constexpr size_t WS_DD = 213 * MiB;
constexpr size_t WS_MERGED = 197 * MiB;
constexpr size_t WS_XN2 = 229 * MiB;
constexpr size_t WS_WGU = 49 * MiB;
constexpr size_t WS_WDN = 113 * MiB;
constexpr size_t WS_HID = 145 * MiB;
constexpr size_t WS_ROUTE = 193 * MiB;
constexpr size_t WS_LTOK = 194 * MiB;
constexpr size_t WS_LW = 195 * MiB;
constexpr size_t WS_G1T = 156 * MiB;
constexpr size_t WS_G2T = 245 * MiB;
constexpr size_t WS_PT = 261 * MiB;
constexpr size_t WS_QT = 277 * MiB;
constexpr size_t WS_SX = 97 * MiB;
constexpr size_t WS_END = 293 * MiB;
constexpr int HID_ROWS = 49152;
constexpr int CT_CNT = 0, CT_OFF = 64, CT_CUR = 128, CT_NU = 192;
constexpr int CT_CNTB = 16384;
constexpr int CT_TAB1 = 1024, CT_TAB2A = 1024 + 4 * 1024, CT_TAB2B = 1024 + 8 * 1024;

struct P {
    const float* in[31];
    float* out;
    unsigned char* ws;
};

__device__ __forceinline__ int otid() { int t = threadIdx.x; asm volatile("" : "+v"(t)); return t; }
__device__ __forceinline__ float dpp_row_shr(float v, int n) {
    int iv = __builtin_bit_cast(int, v), r;
    switch (n) { case 1: r = __builtin_amdgcn_update_dpp(0, iv, 0x111, 0xf, 0xf, true); break; case 2: r = __builtin_amdgcn_update_dpp(0, iv, 0x112, 0xf, 0xf, true); break;
                 case 4: r = __builtin_amdgcn_update_dpp(0, iv, 0x114, 0xf, 0xf, true); break; default: r = __builtin_amdgcn_update_dpp(0, iv, 0x118, 0xf, 0xf, true); break; }
    return __builtin_bit_cast(float, r);
}
__device__ __forceinline__ float wave_sum(float v) {
    v += dpp_row_shr(v, 1); v += dpp_row_shr(v, 2); v += dpp_row_shr(v, 4); v += dpp_row_shr(v, 8);
    v += __builtin_bit_cast(float, __builtin_amdgcn_update_dpp(0, __builtin_bit_cast(int, v), 0x142, 0xa, 0xf, false));
    v += __builtin_bit_cast(float, __builtin_amdgcn_update_dpp(0, __builtin_bit_cast(int, v), 0x143, 0xc, 0xf, false));
    return __builtin_bit_cast(float, __builtin_amdgcn_readlane(__builtin_bit_cast(int, v), 63));
}
__device__ __forceinline__ float wave_max(float v) {
#pragma unroll
    for (int o = 32; o > 0; o >>= 1) v = fmaxf(v, __shfl_xor(v, o));
    return v;
}
typedef short bf16x8_t __attribute__((ext_vector_type(8)));
typedef float f32x4_t __attribute__((ext_vector_type(4)));
constexpr int LP = 72;
constexpr int SLOT = 64 * LP;
__device__ __forceinline__ float sigmoidf_(float x) { return 1.f / (1.f + __expf(-x)); }

#define XB_TMO      128
#define XB_XCNT(j)  (256  + 64 * (j))
#define XB_XSUB(j)  (1280 + 64 * (j))
#define XB_XGEN(j)  (2304 + 64 * (j))
#define XB_TOP      3328
#define XB_TOPGEN   3392
#define XCD_BAR_WORDS 3456
#define XB_SPIN_CAP (1u << 22)
#define LAS3 __attribute__((address_space(3)))
__device__ __forceinline__ unsigned xb_ld(unsigned* p)              { return __hip_atomic_load(p, __ATOMIC_RELAXED, __HIP_MEMORY_SCOPE_AGENT); }
__device__ __forceinline__ unsigned xb_add(unsigned* p, unsigned v) { return __hip_atomic_fetch_add(p, v, __ATOMIC_RELAXED, __HIP_MEMORY_SCOPE_AGENT); }
__device__ __forceinline__ unsigned xb_xcc_id() { return (unsigned)__builtin_amdgcn_s_getreg((3 << 11) | 20) & 0xFu; }
#define XB_SPIN(cond, bar) do { unsigned _sp = 0; while (cond) { __builtin_amdgcn_s_sleep(1); \
    if ((++_sp & 255u) == 0u) { if (xb_ld(&(bar)[XB_TMO])) break; if (_sp > XB_SPIN_CAP) { atomicAdd(&(bar)[XB_TMO], 1u); break; } } } } while (0)
struct XcdBarrier { unsigned* bar; unsigned x; volatile LAS3 unsigned* st; };
__device__ __forceinline__ XcdBarrier xcd_barrier_post(unsigned* bar, volatile LAS3 unsigned* st) {
    XcdBarrier b; b.bar = bar; b.x = xb_xcc_id(); b.st = st;
    if (otid() == 0) (void)xb_add(&bar[XB_XCNT(b.x)], 1u);
    return b;
}
__device__ __forceinline__ void xcd_barrier_complete(unsigned* bar, unsigned x, unsigned& nloc, unsigned& nx) {
    const unsigned G = gridDim.x * gridDim.y * gridDim.z;
    unsigned sum, cnt, mine, sp = 0u;
    for (;;) {
        sum = 0u; cnt = 0u; mine = 0u;
#pragma unroll
        for (unsigned j = 0; j < 16; ++j) { const unsigned c = xb_ld(&bar[XB_XCNT(j)]); sum += c; cnt += (c > 0u) ? 1u : 0u; mine = (j == x) ? c : mine; }
        if (sum == G) break;
        __builtin_amdgcn_s_sleep(1);
        if ((++sp & 255u) == 0u) { if (xb_ld(&bar[XB_TMO])) break; if (sp > XB_SPIN_CAP) { atomicAdd(&bar[XB_TMO], 1u); break; } }
    }
    nloc = mine > 0u ? mine : 1u; nx = cnt > 0u ? cnt : 1u;
}
__device__ __forceinline__ void xcd_barrier(const XcdBarrier& b) {
    asm volatile("s_waitcnt vmcnt(0)" ::: "memory");
    __syncthreads();
    if (otid() == 0) {
        unsigned* bar = b.bar;
        __builtin_amdgcn_s_waitcnt(0);
        unsigned nloc = b.st[0], nx = b.st[1];
        if (nloc == 0u) { xcd_barrier_complete(bar, b.x, nloc, nx); b.st[0] = nloc; b.st[1] = nx; }
        const unsigned old = xb_add(&bar[XB_XSUB(b.x)], 1u);
        const unsigned gen = old / nloc;
        if (old + 1u == (gen + 1u) * nloc) {
            __builtin_amdgcn_fence(__ATOMIC_RELEASE, "agent");
            asm volatile("s_waitcnt vmcnt(0)" ::: "memory");
            const unsigned og = xb_add(&bar[XB_TOP], 1u);
            const unsigned tg = og / nx;
            if (og + 1u == (tg + 1u) * nx) xb_add(&bar[XB_TOPGEN], 1u);
            else XB_SPIN(xb_ld(&bar[XB_TOPGEN]) == tg, bar);
            __builtin_amdgcn_fence(__ATOMIC_ACQUIRE, "agent");
            xb_add(&bar[XB_XGEN(b.x)], 1u);
            asm volatile("s_waitcnt vmcnt(0)" ::: "memory");
        } else {
            XB_SPIN(xb_ld(&bar[XB_XGEN(b.x)]) == gen, bar);
            __builtin_amdgcn_fence(__ATOMIC_ACQUIRE, "agent");
            asm volatile("s_waitcnt vmcnt(0)" ::: "memory");
        }
    }
    __syncthreads();
}

__device__ void ph_mod(const P& p, float* lds) {
    const float* c = p.in[1]; const float* W = p.in[2]; const float* bia = p.in[3];
    float* mod = (float*)(p.ws + WS_MOD);
    const int tid = otid(), lane = tid & 63, wv = tid >> 6;
    float* sil = lds; float* part = lds + NB * DM;
    for (int i = tid; i < NB * DM; i += NTHR) { const float v = c[i]; sil[i] = v / (1.f + __expf(-v)); }
    __syncthreads();
    const int cc = lane % 24, kk = lane / 24;
    for (int j0 = blockIdx.x * 24; j0 < 6 * DM; j0 += gridDim.x * 24) {
        float a0 = 0.f, a1 = 0.f;
        if (lane < 48) {
#pragma unroll 8
            for (int i = 0; i < 64; ++i) { const int k = 128 * wv + 2 * i + kk; const float w = W[(size_t)k * (6 * DM) + j0 + cc]; a0 += sil[k] * w; a1 += sil[DM + k] * w; }
        }
        a0 += __shfl(a0, (lane + 24) & 63); a1 += __shfl(a1, (lane + 24) & 63);
        if (lane < 24) { part[(wv * 2 + 0) * 24 + cc] = a0; part[(wv * 2 + 1) * 24 + cc] = a1; }
        __syncthreads();
        if (tid < 48) { const int bb = tid / 24, c2 = tid % 24; float sum = 0.f;
#pragma unroll
            for (int w2 = 0; w2 < 8; ++w2) sum += part[(w2 * 2 + bb) * 24 + c2];
            mod[bb * 6 * DM + j0 + c2] = sum + bia[j0 + c2]; }
        __syncthreads();
    }
}

__device__ void ph_norm(const P& p, const float* src, const float* g, int which, bf16_t* dst) {
    const float* mod = (const float*)(p.ws + WS_MOD);
    const int lane = otid() & 63, wv = otid() >> 6;
    const int gw = blockIdx.x * (NTHR / 64) + wv, nw = gridDim.x * (NTHR / 64);
    for (int m = gw; m < NT; m += nw) {
        const int b = m / SEQ;
        const float* sh = mod + b * 6 * DM + (which ? 3 * DM : 0);
        const float* sc = sh + DM;
        const float4* xr = (const float4*)(src + (size_t)m * DM);
        float4 v[4]; float ss = 0.f;
#pragma unroll
        for (int j = 0; j < 4; ++j) { v[j] = xr[lane + 64 * j]; ss += v[j].x * v[j].x + v[j].y * v[j].y + v[j].z * v[j].z + v[j].w * v[j].w; }
        ss = wave_sum(ss);
        const float rstd = rsqrtf(ss * (1.f / DM) + NORM_EPS);
        float o[16];
#pragma unroll
        for (int j = 0; j < 4; ++j) {
            int c0 = 4 * (lane + 64 * j); asm volatile("" : "+v"(c0));
            const float4 gg = *(const float4*)(g + c0), s1 = *(const float4*)(sc + c0), s0 = *(const float4*)(sh + c0);
            o[4 * j + 0] = v[j].x * rstd * gg.x * (1.f + s1.x) + s0.x; o[4 * j + 1] = v[j].y * rstd * gg.y * (1.f + s1.y) + s0.y;
            o[4 * j + 2] = v[j].z * rstd * gg.z * (1.f + s1.z) + s0.z; o[4 * j + 3] = v[j].w * rstd * gg.w * (1.f + s1.w) + s0.w;
            uint2 pk; pk.x = (unsigned)f2bf(o[4 * j]) | ((unsigned)f2bf(o[4 * j + 1]) << 16); pk.y = (unsigned)f2bf(o[4 * j + 2]) | ((unsigned)f2bf(o[4 * j + 3]) << 16);
            *(uint2*)(dst + (size_t)m * DM + c0) = pk;
        }
    }
}

__device__ void ph_norm_route(const P& p, float* lds) {
    const float* mod = (const float*)(p.ws + WS_MOD); const float* src = p.out; const float* g = p.in[24]; bf16_t* dst = (bf16_t*)(p.ws + WS_XN2);
    const float* wgr = p.in[25]; const float* wer = p.in[26]; const float* eb = p.in[27];
    const int tid = otid(), lane = tid & 63, wv = tid >> 6;
    float* sx = lds + wv * 4096;
    int* cntL = (int*)(lds + 8 * 4096);
    if (tid < 64) cntL[tid] = 0;
    __syncthreads();
    const int TPB = NT / gridDim.x;
    for (int m0 = blockIdx.x * TPB + wv * 4; m0 < (blockIdx.x + 1) * TPB; m0 += 8 * 4) {
        const int b = m0 / SEQ;
        const float* sh = mod + b * 6 * DM + 3 * DM; const float* sc = sh + DM;
#pragma unroll 1
        for (int tk = 0; tk < 4; ++tk) {
            const int m = m0 + tk;
            const float4* xr = (const float4*)(src + (size_t)m * DM);
            float4 v[4]; float ss = 0.f;
#pragma unroll
            for (int j = 0; j < 4; ++j) { v[j] = xr[lane + 64 * j]; ss += v[j].x * v[j].x + v[j].y * v[j].y + v[j].z * v[j].z + v[j].w * v[j].w; }
            ss = wave_sum(ss);
            const float rstd = rsqrtf(ss * (1.f / DM) + NORM_EPS);
#pragma unroll
            for (int j = 0; j < 4; ++j) {
                const int c0 = 4 * (lane + 64 * j);
                const float4 gg = *(const float4*)(g + c0), s1 = *(const float4*)(sc + c0), s0 = *(const float4*)(sh + c0);
                const float o0 = v[j].x * rstd * gg.x * (1.f + s1.x) + s0.x, o1 = v[j].y * rstd * gg.y * (1.f + s1.y) + s0.y;
                const float o2 = v[j].z * rstd * gg.z * (1.f + s1.z) + s0.z, o3 = v[j].w * rstd * gg.w * (1.f + s1.w) + s0.w;
                uint2 pk; pk.x = (unsigned)f2bf(o0) | ((unsigned)f2bf(o1) << 16); pk.y = (unsigned)f2bf(o2) | ((unsigned)f2bf(o3) << 16);
                *(uint2*)(dst + (size_t)m * DM + c0) = pk;
                sx[(c0 + 0) * 4 + tk] = o0; sx[(c0 + 1) * 4 + tk] = o1; sx[(c0 + 2) * 4 + tk] = o2; sx[(c0 + 3) * 4 + tk] = o3;
            }
        }
        __builtin_amdgcn_wave_barrier(); asm volatile("s_waitcnt lgkmcnt(0)" ::: "memory");
        float ae[4] = {0.f, 0.f, 0.f, 0.f}, ag[4] = {0.f, 0.f, 0.f, 0.f};
        { const int e = lane & 31, kb = (lane >> 5) * 512;
#pragma unroll 8
          for (int i = 0; i < 512; ++i) { const float w = wer[(size_t)(kb + i) * 32 + e]; const float4 xv = *(const float4*)(sx + (kb + i) * 4);
              ae[0] += xv.x * w; ae[1] += xv.y * w; ae[2] += xv.z * w; ae[3] += xv.w * w; } }
        { const int gq = lane & 3, kb = (lane >> 2) * 64;
#pragma unroll 8
          for (int i = 0; i < 64; ++i) { const float w = wgr[(size_t)(kb + i) * 4 + gq]; const float4 xv = *(const float4*)(sx + (kb + i) * 4);
              ag[0] += xv.x * w; ag[1] += xv.y * w; ag[2] += xv.z * w; ag[3] += xv.w * w; } }
#pragma unroll
        for (int tk = 0; tk < 4; ++tk) {
            ae[tk] += __shfl_xor(ae[tk], 32);
            ag[tk] += __shfl_xor(ag[tk], 4); ag[tk] += __shfl_xor(ag[tk], 8); ag[tk] += __shfl_xor(ag[tk], 16); ag[tk] += __shfl_xor(ag[tk], 32);
        }
#pragma unroll
        for (int tk = 0; tk < 4; ++tk) {
            float lg[4];
#pragma unroll
            for (int q = 0; q < 4; ++q) lg[q] = __shfl(ag[tk], q);
            int gs = 0; float mx = lg[0];
#pragma unroll
            for (int q = 1; q < 4; ++q) if (lg[q] > mx) { mx = lg[q]; gs = q; }
            float den = 0.f;
#pragma unroll
            for (int q = 0; q < 4; ++q) den += __expf(lg[q] - mx);
            const float pg = 1.f / den;
            float ev[8];
#pragma unroll
            for (int q = 0; q < 8; ++q) ev[q] = __shfl(ae[tk], gs * 8 + q) + eb[gs * 8 + q];
            int i0 = 0; float v0 = ev[0];
#pragma unroll
            for (int q = 1; q < 8; ++q) if (ev[q] > v0) { v0 = ev[q]; i0 = q; }
            int i1 = -1; float v1 = -INFINITY;
#pragma unroll
            for (int q = 0; q < 8; ++q) if (q != i0 && ev[q] > v1) { v1 = ev[q]; i1 = q; }
            if (lane == 0) {
                const float e1 = __expf(v1 - v0), w0 = pg / (1.f + e1), w1 = pg * e1 / (1.f + e1);
                const int x0 = gs * 8 + i0, x1 = gs * 8 + i1;
                const int rk0 = atomicAdd(&cntL[x0], 1), rk1 = atomicAdd(&cntL[32 + x1], 1);
                int4* route = (int4*)(p.ws + WS_ROUTE) + (size_t)(m0 + tk);
                *route = make_int4(x0 | (x1 << 8), rk0 | (rk1 << 16), __float_as_int(w0), __float_as_int(w1));
            }
        }
        __builtin_amdgcn_wave_barrier();
    }
    __syncthreads();
    if (tid < 64) ((int*)(p.ws + WS_CTL) + CT_CNTB)[blockIdx.x * 64 + tid] = cntL[tid];
}

namespace pg8 {
#define PG8_LAS __attribute__((address_space(3)))
typedef short bf16x8 __attribute__((ext_vector_type(8)));
typedef float f32x4 __attribute__((ext_vector_type(4)));
typedef unsigned u32x4 __attribute__((ext_vector_type(4)));
constexpr int BM = 256, BK = 64, HALF = 128, HTB = HALF * BK * 2, STAGE_BYTES = 8 * HTB, NXCD = 8, WGM = 8;
__host__ __device__ __forceinline__ int lds_byte(int r, int c) { const int st = (r >> 4) * 2 + (c >> 5), rr = r & 15, cc = c & 31, ob = rr * 64 + cc * 2; return st * 1024 + (ob ^ (((ob >> 9) & 1) << 5)); }
__host__ __device__ __forceinline__ void stage_rc(int b, int& R, int& C) { const int st = b / 1024, sb = b % 1024, swz = sb ^ (((sb >> 9) & 1) << 5); R = (st >> 1) * 16 + swz / 64; C = (st & 1) * 32 + (swz % 64) / 2; }
__host__ __device__ __forceinline__ int perm32(int rho) { const int n = rho >> 4, i = rho & 15; return 8 * (i >> 2) + 4 * n + (i & 3); }

struct Unit { int arow, brow, pm, pn, aux; };
struct Gemm { const bf16_t* A; const bf16_t* Bt; int K; const int* gather; };

struct StaticOrder {
    int nM, nN, nwg, G, c;
    __device__ void init(int M, int N, int G_, int c_) { nM = M / BM; nN = N / BM; nwg = nM * nN; G = G_; c = c_; }
    __device__ bool next(int i, Unit& u) const {
        const long L = (long)i * G + c; if (L >= nwg) return false;
        int wgid = (int)L; { const int q = nwg / NXCD, r = nwg % NXCD, xcd = wgid % NXCD, off = wgid / NXCD; wgid = (xcd < r ? xcd * (q + 1) : r * (q + 1) + (xcd - r) * q) + off; }
        const int nig = WGM * nN, gid = wgid / nig, fm = gid * WGM, gsz = (nM - fm) < WGM ? (nM - fm) : WGM;
        u.pm = fm + ((wgid % nig) % gsz); u.pn = (wgid % nig) / gsz; u.arow = u.pm * BM; u.brow = u.pn * BM; u.aux = 0; return true;
    }
};
struct TableOrder {
    const int4* tab; int n, G, c;
    __device__ bool next(int i, Unit& u) const {
        const int L = i * G + c; if (L >= n) return false;
        const int4 e = tab[L]; u.arow = __builtin_amdgcn_readfirstlane(e.x); u.brow = __builtin_amdgcn_readfirstlane(e.y); u.aux = __builtin_amdgcn_readfirstlane(e.z); u.pn = __builtin_amdgcn_readfirstlane(e.w); u.pm = 0; return true;
    }
};
__device__ __forceinline__ unsigned cvt_pk_bf16(float lo, float hi) { unsigned r; asm volatile("v_cvt_pk_bf16_f32 %0, %1, %2" : "=v"(r) : "v"(lo), "v"(hi)); return r; }

template <class Epi, class Sched>
__device__ __forceinline__ void gemm_phase(PG8_LAS unsigned char* lds, const Gemm g, const Sched& S, const Epi& E) {
    const int tid = otid(), wid = __builtin_amdgcn_readfirstlane(tid >> 6), lane = tid & 63, wr = wid >> 2, wc = wid & 3, fr = lane & 15, fq = lane >> 4;
    const int K = g.K, nt = K / BK;
    int RA0; unsigned cofA0, voffB0;
    { int R, C; stage_rc(tid * 16, R, C); const int Rb = Epi::PERM ? ((R & ~31) + perm32(R & 31)) : R; RA0 = R; cofA0 = (unsigned)C * 2u; voffB0 = (unsigned)(Rb * K + C) * 2u; }
    const size_t rstep64 = (size_t)64 * K * 2;
    const size_t kstep = (size_t)(BK * 2);
    const size_t hstep = (size_t)HALF * K * 2;
    const unsigned ldsw = (unsigned)wid * 1024u;
    const int aoff = lds_byte(wr * 64 + fr, fq * 8), boff = lds_byte(wc * 32 + fr, fq * 8);
#define PG8_SA(b, h) (((b) * 2 + (h)) * HTB)
#define PG8_SB(b, h) ((4 + (b) * 2 + (h)) * HTB)
#define PG8_STAGE_B(bufoff, gbase) do { _Pragma("unroll") for (int _i = 0; _i < 2; ++_i) \
        __builtin_amdgcn_global_load_lds((const unsigned*)((const char*)(gbase) + _i * rstep64 + voffB0), (PG8_LAS unsigned*)(lds + (bufoff) + ldsw + _i * 8192), 16, 0, 0); } while (0)
#define PG8_STAGE_A(bufoff, o2, kb) do { _Pragma("unroll") for (int _i = 0; _i < 2; ++_i) \
        __builtin_amdgcn_global_load_lds((const unsigned*)((const char*)g.A + (size_t)(o2)[_i] + (size_t)(kb)), (PG8_LAS unsigned*)(lds + (bufoff) + ldsw + _i * 8192), 16, 0, 0); } while (0)
#define PG8_LDA(dst, b, h) do { _Pragma("unroll") for (int m = 0; m < 4; ++m) _Pragma("unroll") for (int k = 0; k < 2; ++k) dst[m][k] = *(const PG8_LAS bf16x8*)(lds + PG8_SA(b, h) + aoff + m * 2048 + k * 1024); } while (0)
#define PG8_LDB(dst, b, h) do { _Pragma("unroll") for (int n = 0; n < 2; ++n) _Pragma("unroll") for (int k = 0; k < 2; ++k) dst[n][k] = *(const PG8_LAS bf16x8*)(lds + PG8_SB(b, h) + boff + n * 2048 + k * 1024); } while (0)
#define PG8_MMA(ai, bj, At, Bt) do { __builtin_amdgcn_s_setprio(1); _Pragma("unroll") for (int m = 0; m < 4; ++m) _Pragma("unroll") for (int n = 0; n < 2; ++n) _Pragma("unroll") for (int k = 0; k < 2; ++k) \
        acc[ai][bj][m][n] = __builtin_amdgcn_mfma_f32_16x16x32_bf16(Bt[n][k], At[m][k], acc[ai][bj][m][n], 0, 0, 0); __builtin_amdgcn_s_setprio(0); } while (0)
#define PG8_WAIT_V(n) asm volatile("s_waitcnt vmcnt(" #n ")" ::: "memory")
#define PG8_WAIT_L(n) asm volatile("s_waitcnt lgkmcnt(" #n ")" ::: "memory")
#define PG8_BAR __builtin_amdgcn_s_barrier()
#define PG8_SCHED __builtin_amdgcn_sched_barrier(0)
#define PG8_AOFFS(u, dst) do { _Pragma("unroll") for (int _h = 0; _h < 2; ++_h) _Pragma("unroll") for (int _i = 0; _i < 2; ++_i) { \
        const int _tr = (u).arow + _h * HALF + RA0 + 64 * _i; const unsigned _row = g.gather ? (unsigned)g.gather[_tr] : (unsigned)_tr; dst[_h][_i] = _row * (unsigned)(K * 2) + cofA0; } } while (0)
    Unit cur, nxt; int ui = 0;
    if (!S.next(0, cur)) return;
    f32x4 acc[2][2][4][2];
#pragma unroll
    for (int a = 0; a < 2; ++a)
#pragma unroll
        for (int b = 0; b < 2; ++b)
#pragma unroll
            for (int m = 0; m < 4; ++m)
#pragma unroll
                for (int n = 0; n < 2; ++n) acc[a][b][m][n] = (f32x4){0.f, 0.f, 0.f, 0.f};
    bf16x8 At[4][2], B0[2][2], B1[2][2];
    unsigned cof[2][2];
    PG8_AOFFS(cur, cof);
    const char* cB = (const char*)g.Bt + (size_t)cur.brow * K * 2;
    PG8_STAGE_B(PG8_SB(0, 0), cB); PG8_STAGE_B(PG8_SB(0, 1), cB + hstep); PG8_STAGE_A(PG8_SA(0, 0), cof[0], 0); PG8_STAGE_A(PG8_SA(0, 1), cof[1], 0);
    if (wr == 1) PG8_BAR;
    PG8_WAIT_V(2); PG8_BAR;
    PG8_STAGE_B(PG8_SB(1, 0), cB + kstep); PG8_STAGE_A(PG8_SA(1, 0), cof[0], kstep); PG8_STAGE_B(PG8_SB(1, 1), cB + hstep + kstep);
    PG8_WAIT_V(6); PG8_BAR;
    for (;;) {
        const bool has_next = S.next(ui + 1, nxt);
        if (!has_next) nxt = cur;
        const char* nB = (const char*)g.Bt + (size_t)nxt.brow * K * 2;
        for (int t = 0; t < nt; t += 2) {
            const bool last = (t == nt - 2);
            const size_t k1 = (size_t)(t + 1) * kstep;
            const size_t k2 = last ? 0 : (size_t)(t + 2) * kstep, k3 = k2 + kstep;
            const char* b2 = last ? nB : cB + (size_t)(t + 2) * kstep; const char* b3 = b2 + kstep;
            PG8_LDB(B0, 0, 0); PG8_LDB(B1, 0, 1); PG8_SCHED; PG8_LDA(At, 0, 0); PG8_STAGE_A(PG8_SA(1, 1), cof[1], k1);
            if (last) { PG8_AOFFS(nxt, cof); }
            PG8_WAIT_V(8); PG8_WAIT_L(0); PG8_BAR; PG8_MMA(0, 0, At, B0); PG8_MMA(0, 1, At, B1); PG8_BAR; PG8_SCHED;
            PG8_LDA(At, 0, 1); PG8_STAGE_B(PG8_SB(0, 0), b2); PG8_STAGE_B(PG8_SB(0, 1), b2 + hstep); PG8_STAGE_A(PG8_SA(0, 0), cof[0], k2);
            PG8_WAIT_V(8); PG8_WAIT_L(0); PG8_BAR; PG8_MMA(1, 0, At, B0); PG8_MMA(1, 1, At, B1); PG8_BAR; PG8_SCHED;
            PG8_LDB(B0, 1, 0); PG8_LDB(B1, 1, 1); PG8_SCHED; PG8_LDA(At, 1, 0); PG8_STAGE_A(PG8_SA(0, 1), cof[1], k2);
            PG8_WAIT_V(8); PG8_WAIT_L(0); PG8_BAR; PG8_MMA(0, 0, At, B0); PG8_MMA(0, 1, At, B1); PG8_BAR; PG8_SCHED;
            PG8_LDA(At, 1, 1); PG8_STAGE_B(PG8_SB(1, 0), b3); PG8_STAGE_B(PG8_SB(1, 1), b3 + hstep); PG8_STAGE_A(PG8_SA(1, 0), cof[0], k3);
            PG8_WAIT_V(8); PG8_WAIT_L(0); PG8_BAR; PG8_MMA(1, 0, At, B0); PG8_MMA(1, 1, At, B1); PG8_BAR; PG8_SCHED;
        }
        if (wr == 0) PG8_BAR;
        { const int l2 = otid() & 63; E(acc, cur, wr, wc, l2 & 15, l2 >> 4); }
        if (!has_next) break;
#pragma unroll
        for (int a = 0; a < 2; ++a)
#pragma unroll
            for (int b = 0; b < 2; ++b)
#pragma unroll
                for (int m = 0; m < 4; ++m)
#pragma unroll
                    for (int n = 0; n < 2; ++n) acc[a][b][m][n] = (f32x4){0.f, 0.f, 0.f, 0.f};
        cur = nxt; cB = nB; ++ui;
        if (wr == 1) PG8_BAR;
    }
    PG8_WAIT_V(0);
    PG8_BAR;
#undef PG8_SA
#undef PG8_SB
#undef PG8_STAGE_A
#undef PG8_STAGE_B
#undef PG8_LDA
#undef PG8_LDB
#undef PG8_MMA
#undef PG8_WAIT_V
#undef PG8_WAIT_L
#undef PG8_BAR
#undef PG8_SCHED
#undef PG8_AOFFS
}

#define PG8_FENCE asm volatile("" ::: "memory")
#define PG8_FOR_TILE(ai, m, bj) _Pragma("unroll") for (int ai = 0; ai < 2; ++ai) _Pragma("unroll") for (int m = 0; m < 4; ++m) _Pragma("unroll") for (int bj = 0; bj < 2; ++bj)
__device__ __forceinline__ u32x4 pack8(const f32x4& v0, const f32x4& v1) { u32x4 w; w.x = cvt_pk_bf16(v0[0], v0[1]); w.y = cvt_pk_bf16(v0[2], v0[3]); w.z = cvt_pk_bf16(v1[0], v1[1]); w.w = cvt_pk_bf16(v1[2], v1[3]); return w; }
__device__ __forceinline__ float sigm(float x) { return 1.f / (1.f + __expf(-x)); }
struct EpiInproj {
    static constexpr bool PERM = true;
    unsigned char* ws; bf16_t* gates;
    __device__ __forceinline__ void operator()(const f32x4 (&acc)[2][2][4][2], const Unit& u, int wr, int wc, int fr, int fq) const {
        PG8_FOR_TILE(ai, m, bj) { PG8_FENCE;
            int row = u.pm * BM + ai * HALF + wr * 64 + m * 16 + fr; asm volatile("" : "+v"(row)); const int col = u.pn * BM + bj * HALF + wc * 32 + 8 * fq;
            const f32x4 v0 = acc[ai][bj][m][0], v1 = acc[ai][bj][m][1];
            if (col < C_KV) *(u32x4*)((bf16_t*)(ws + WS_Q) + (size_t)row * AW + col) = pack8(v0, v1);
            else if (col < C_QI) *(u32x4*)((bf16_t*)(ws + WS_KVN) + (size_t)row * KVL + (col - C_KV)) = pack8(v0, v1);
            else if (col < C_PS) {
                if (col < 1056) {
                    typedef _Float16 h8 __attribute__((ext_vector_type(8)));
                    h8 hv; hv[0] = (_Float16)v0[0]; hv[1] = (_Float16)v0[1]; hv[2] = (_Float16)v0[2]; hv[3] = (_Float16)v0[3]; hv[4] = (_Float16)v1[0]; hv[5] = (_Float16)v1[1]; hv[6] = (_Float16)v1[2]; hv[7] = (_Float16)v1[3];
                    _Float16* d = (col < 1024) ? (_Float16*)(ws + WS_QI) + (size_t)row * 256 + (col - C_QI) : (_Float16*)(ws + WS_KI) + (size_t)row * 32 + (col - 1024);
                    *(h8*)d = hv;
                } else { const float sc_ = 0.17677669529663687f * 0.35355339059327373f; float* d = (float*)(ws + WS_WI) + (size_t)row * 8; *(f32x4*)d = v0 * sc_; *(f32x4*)(d + 4) = v1 * sc_; }
            }
            else if (col < C_GA) *(u32x4*)((bf16_t*)(ws + WS_PS) + (size_t)row * SHW + (col - C_PS)) = pack8(v0, v1);
            else if (col < INW) {
                f32x4 s0, s1;
#pragma unroll
                for (int e = 0; e < 4; ++e) { s0[e] = sigm(v0[e]); s1[e] = sigm(v1[e]); }
                bf16_t* d = (col < C_GR) ? gates + (size_t)row * DM + (col - C_GA) : gates + (size_t)NT * DM + (size_t)row * DM + (col - C_GR);
                *(u32x4*)d = pack8(s0, s1);
            }
        }
    }
};
struct EpiKV {
    static constexpr bool PERM = true;
    unsigned char* ws;
    __device__ __forceinline__ void operator()(const f32x4 (&acc)[2][2][4][2], const Unit& u, int wr, int wc, int fr, int fq) const {
        PG8_FOR_TILE(ai, m, bj) { PG8_FENCE;
            int row = u.pm * BM + ai * HALF + wr * 64 + m * 16 + fr; asm volatile("" : "+v"(row)); const int col = u.pn * BM + bj * HALF + wc * 32 + 8 * fq;
            if (col < AW) *(u32x4*)((bf16_t*)(ws + WS_K) + (size_t)row * AW + col) = pack8(acc[ai][bj][m][0], acc[ai][bj][m][1]);
            else {
                bf16_t* d = (bf16_t*)(ws + WS_V) + ((size_t)(row / SEQ) * 512 + (col - AW)) * SEQ + (row % SEQ);
#pragma unroll
                for (int e = 0; e < 4; ++e) { d[(size_t)e * SEQ] = f2bf(acc[ai][bj][m][0][e]); d[(size_t)(4 + e) * SEQ] = f2bf(acc[ai][bj][m][1][e]); }
            }
        }
    }
};
template <bool SECOND> struct EpiMerge {
    static constexpr bool PERM = true;
    bf16_t* merged; const bf16_t* gate;
    __device__ __forceinline__ void operator()(const f32x4 (&acc)[2][2][4][2], const Unit& u, int wr, int wc, int fr, int fq) const {
        PG8_FOR_TILE(ai, m, bj) { PG8_FENCE;
            int row = u.pm * BM + ai * HALF + wr * 64 + m * 16 + fr; asm volatile("" : "+v"(row)); const int col = u.pn * BM + bj * HALF + wc * 32 + 8 * fq;
            const u32x4 gw = *(const u32x4*)(gate + (size_t)row * DM + col);
            f32x4 v0 = acc[ai][bj][m][0], v1 = acc[ai][bj][m][1];
            v0[0] *= __uint_as_float(gw.x << 16); v0[1] *= __uint_as_float(gw.x & 0xffff0000u); v0[2] *= __uint_as_float(gw.y << 16); v0[3] *= __uint_as_float(gw.y & 0xffff0000u);
            v1[0] *= __uint_as_float(gw.z << 16); v1[1] *= __uint_as_float(gw.z & 0xffff0000u); v1[2] *= __uint_as_float(gw.w << 16); v1[3] *= __uint_as_float(gw.w & 0xffff0000u);
            u32x4* d = (u32x4*)(merged + (size_t)row * DM + col);
            if (SECOND) { const u32x4 pw = *d;
                v0[0] += __uint_as_float(pw.x << 16); v0[1] += __uint_as_float(pw.x & 0xffff0000u); v0[2] += __uint_as_float(pw.y << 16); v0[3] += __uint_as_float(pw.y & 0xffff0000u);
                v1[0] += __uint_as_float(pw.z << 16); v1[1] += __uint_as_float(pw.z & 0xffff0000u); v1[2] += __uint_as_float(pw.w << 16); v1[3] += __uint_as_float(pw.w & 0xffff0000u); }
            *d = pack8(v0, v1);
        }
    }
};
struct EpiOut {
    static constexpr bool PERM = false;
    const float* x; const float* mod; float* out;
    __device__ __forceinline__ void operator()(const f32x4 (&acc)[2][2][4][2], const Unit& u, int wr, int wc, int fr, int fq) const {
        PG8_FOR_TILE(ai, m, bj) { PG8_FENCE;
            int row = u.pm * BM + ai * HALF + wr * 64 + m * 16 + fr; asm volatile("" : "+v"(row)); const float* gt = mod + (row / SEQ) * 6 * DM + 2 * DM;
#pragma unroll
            for (int n = 0; n < 2; ++n) { const int col = u.pn * BM + bj * HALF + wc * 32 + 16 * n + 4 * fq;
                const f32x4 xv = *(const f32x4*)(x + (size_t)row * DM + col), gv = *(const f32x4*)(gt + col);
                *(f32x4*)(out + (size_t)row * DM + col) = xv + gv * acc[ai][bj][m][n]; }
        }
    }
};
struct EpiMoe1 {
    static constexpr bool PERM = true;
    bf16_t* hid; const float* lw;
    __device__ __forceinline__ void operator()(const f32x4 (&acc)[2][2][4][2], const Unit& u, int wr, int wc, int fr, int fq) const {
#pragma unroll
        for (int ai = 0; ai < 2; ++ai)
#pragma unroll
            for (int m = 0; m < 4; ++m) {
                const int tr = ai * HALF + wr * 64 + m * 16 + fr; PG8_FENCE;
                if (tr < u.aux) {
                    const float w = lw[u.arow + tr]; f32x4 h0, h1;
#pragma unroll
                    for (int e = 0; e < 4; ++e) { const float g0 = acc[ai][0][m][0][e], g1 = acc[ai][0][m][1][e];
                        h0[e] = w * (g0 / (1.f + __expf(-g0))) * acc[ai][1][m][0][e]; h1[e] = w * (g1 / (1.f + __expf(-g1))) * acc[ai][1][m][1][e]; }
                    *(u32x4*)(hid + (size_t)(u.arow + tr) * DE + u.pn * HALF + wc * 32 + 8 * fq) = pack8(h0, h1);
                }
            }
    }
};
struct EpiMoe2 {
    static constexpr bool PERM = false;
    const int* ltok; const float* mod; float* out;
    __device__ __forceinline__ void operator()(const f32x4 (&acc)[2][2][4][2], const Unit& u, int wr, int wc, int fr, int fq) const {
#pragma unroll
        for (int ai = 0; ai < 2; ++ai)
#pragma unroll
            for (int m = 0; m < 4; ++m) {
                const int tr = ai * HALF + wr * 64 + m * 16 + fr; PG8_FENCE;
                if (tr < u.aux) {
                    const int tok = ltok[u.arow + tr]; const float* gt = mod + (tok / SEQ) * 6 * DM + 5 * DM; float* orow = out + (size_t)tok * DM;
#pragma unroll
                    for (int bj = 0; bj < 2; ++bj)
#pragma unroll
                        for (int n = 0; n < 2; ++n) { const int col = u.pn * BM + bj * HALF + wc * 32 + 16 * n + 4 * fq;
                            const f32x4 gv = *(const f32x4*)(gt + col); f32x4* d = (f32x4*)(orow + col); *d = *d + gv * acc[ai][bj][m][n]; }
                }
            }
    }
};
}

__device__ __forceinline__ unsigned pk2(float lo, float hi) { return (unsigned)f2bf(lo) | ((unsigned)f2bf(hi) << 16); }
__device__ __forceinline__ void transpose_item(const float* W, int K, int N, bf16_t* WT, size_t drow0, int k0, int n0, float* scr, int lane, int Ksrc = 1 << 30) {
#pragma unroll 8
    for (int i = 0; i < 32; ++i) { const int kk = 2 * i + (lane >> 5), n = n0 + (lane & 31); scr[kk * 33 + (lane & 31)] = (n < N && k0 + kk < Ksrc) ? W[(size_t)(k0 + kk) * N + n] : 0.f; }
    asm volatile("s_waitcnt lgkmcnt(0)" ::: "memory");
    const int c = lane & 7;
#pragma unroll
    for (int j = 0; j < 4; ++j) { const int n = (lane >> 3) + 8 * j; const float* s_ = scr + (8 * c) * 33 + n;
        uint4 o; o.x = pk2(s_[0 * 33], s_[1 * 33]); o.y = pk2(s_[2 * 33], s_[3 * 33]); o.z = pk2(s_[4 * 33], s_[5 * 33]); o.w = pk2(s_[6 * 33], s_[7 * 33]);
        *(uint4*)(WT + (drow0 + n) * K + k0 + 8 * c) = o; }
    asm volatile("s_waitcnt lgkmcnt(0)" ::: "memory");
}
__device__ void ph_convert_mixer_weights(const P& p, float* lds) {
    const int lane = otid() & 63, wv = otid() >> 6;
    float* scr = lds + wv * (64 * 33);
    const int gw = blockIdx.x * (NTHR / 64) + wv, nw = gridDim.x * (NTHR / 64);
    struct M { const float* W; int K, N, Npad; size_t dst; };
    const M ms[5] = { {p.in[5], DM, INW, 5120, WS_WIN}, {p.in[7], KVL, 2 * AW, 2 * AW, WS_WKV}, {p.in[21], AW, DM, DM, WS_WBA}, {p.in[22], RW, DM, DM, WS_WBR}, {p.in[23], DM, DM, DM, WS_WOUT} };
    int base = 0;
#pragma unroll
    for (int q = 0; q < 5; ++q) {
        const int nkb = ms[q].K / 64, nnb = ms[q].Npad / 32, nitems = nkb * nnb;
        for (int it = gw; it < base + nitems; it += nw) { if (it < base) continue; const int r = it - base; const int kb = r / nnb, nb = r % nnb;
            transpose_item(ms[q].W, ms[q].K, ms[q].N, (bf16_t*)(p.ws + ms[q].dst), (size_t)nb * 32, kb * 64, nb * 32, scr, lane); }
        base += nitems;
    }
}
__device__ void ph_convert_lora_weights(const P& p, float* lds) {
    const int lane = otid() & 63, wv = otid() >> 6;
    float* scr = lds + wv * (64 * 33);
    const int gw = blockIdx.x * (NTHR / 64) + wv, nw = gridDim.x * (NTHR / 64);
    for (int it = gw; it < 16 + 16 + 48; it += nw) {
        if (it < 16) transpose_item(p.in[12], 64, RW, (bf16_t*)(p.ws + WS_LW2T), (size_t)it * 32, 0, it * 32, scr, lane);
        else if (it < 32) transpose_item(p.in[14], 64, RW, (bf16_t*)(p.ws + WS_LA2T), (size_t)(it - 16) * 32, 0, (it - 16) * 32, scr, lane);
        else { const int r = it - 32, kb = r >> 4, nb = r & 15; transpose_item(p.in[15], 192, RW, (bf16_t*)(p.ws + WS_LG2T), (size_t)nb * 32, kb * 64, nb * 32, scr, lane, 160); }
    }
}
__device__ void ph_convert_expert_weights(const P& p, float* lds) {
    const int lane = otid() & 63, wv = otid() >> 6;
    float* scr = lds + wv * (64 * 33);
    const int gw = blockIdx.x * (NTHR / 64) + wv, nw = gridDim.x * (NTHR / 64);
    for (int it = gw; it < NE * 2 * 256; it += nw) { const int e = it >> 9, which = (it >> 8) & 1, r = it & 255, kb = r >> 4, nb = r & 15, n0 = nb * 32;
        transpose_item(p.in[28 + which] + (size_t)e * DM * DE, DM, DE, (bf16_t*)(p.ws + WS_WGU), (size_t)e * 1024 + (n0 >> 7) * 256 + which * 128 + (n0 & 127), kb * 64, n0, scr, lane); }
    for (int it = gw; it < NE * 256; it += nw) { const int e = it >> 8, r = it & 255, kb = r >> 5, nb = r & 31;
        transpose_item(p.in[30] + (size_t)e * DE * DM, DE, DM, (bf16_t*)(p.ws + WS_WDN), (size_t)e * 1024 + nb * 32, kb * 64, nb * 32, scr, lane); }
}

__device__ void ph_headnorm(bf16_t* X, const float* g) {
    const int lane = otid() & 63, wv = otid() >> 6;
    const int gw = blockIdx.x * (NTHR / 64) + wv, nw = gridDim.x * (NTHR / 64);
    for (int m = gw; m < NT; m += nw) {
        uint4 raw = *(const uint4*)(X + (size_t)m * AW + lane * 8);
        float v[8] = {bf2f(raw.x & 0xffff), bf2f(raw.x >> 16), bf2f(raw.y & 0xffff), bf2f(raw.y >> 16), bf2f(raw.z & 0xffff), bf2f(raw.z >> 16), bf2f(raw.w & 0xffff), bf2f(raw.w >> 16)};
        float ss = 0.f;
#pragma unroll
        for (int i = 0; i < 8; ++i) ss += v[i] * v[i];
        ss += __shfl_xor(ss, 1); ss += __shfl_xor(ss, 2); ss += __shfl_xor(ss, 4);
        const float rstd = rsqrtf(ss * (1.f / 64.f) + NORM_EPS);
        const int d0 = (lane & 7) * 8;
        unsigned o[4];
#pragma unroll
        for (int i = 0; i < 4; ++i) o[i] = (unsigned)f2bf(v[2 * i] * rstd * g[d0 + 2 * i]) | ((unsigned)f2bf(v[2 * i + 1] * rstd * g[d0 + 2 * i + 1]) << 16);
        *(uint4*)(X + (size_t)m * AW + lane * 8) = make_uint4(o[0], o[1], o[2], o[3]);
    }
}
__device__ void ph_kvnorm(bf16_t* X, const float* g) {
    const int lane = otid() & 63, wv = otid() >> 6;
    const int gw = blockIdx.x * (NTHR / 64) + wv, nw = gridDim.x * (NTHR / 64);
    for (int m = gw; m < NT; m += nw) {
        uint2 raw = *(const uint2*)(X + (size_t)m * KVL + lane * 4);
        float v[4] = {bf2f(raw.x & 0xffff), bf2f(raw.x >> 16), bf2f(raw.y & 0xffff), bf2f(raw.y >> 16)};
        float ss = wave_sum(v[0] * v[0] + v[1] * v[1] + v[2] * v[2] + v[3] * v[3]);
        const float rstd = rsqrtf(ss * (1.f / 256.f) + NORM_EPS);
        uint2 o; o.x = (unsigned)f2bf(v[0] * rstd * g[lane * 4]) | ((unsigned)f2bf(v[1] * rstd * g[lane * 4 + 1]) << 16);
        o.y = (unsigned)f2bf(v[2] * rstd * g[lane * 4 + 2]) | ((unsigned)f2bf(v[3] * rstd * g[lane * 4 + 3]) << 16);
        *(uint2*)(X + (size_t)m * KVL + lane * 4) = o;
    }
}

typedef _Float16 half8_t __attribute__((ext_vector_type(8)));
typedef float f32x16_t __attribute__((ext_vector_type(16)));
__device__ __forceinline__ unsigned f2key(float f) { unsigned u = __float_as_uint(f); return (u & 0x80000000u) ? ~u : (u | 0x80000000u); }
__device__ void ph_dsa_select(const P& p, float* ldsf) {
    const _Float16* QI = (const _Float16*)(p.ws + WS_QI); const _Float16* KI = (const _Float16*)(p.ws + WS_KI); const float* WI = (const float*)(p.ws + WS_WI);
    unsigned long long* MASK = (unsigned long long*)(p.ws + WS_MASK);
    unsigned* sc = (unsigned*)ldsf;
    unsigned* hist = sc + 4 * 8192;
    int* misc = (int*)(hist + 4 * 256);
    const int tid = otid(), lane = tid & 63, wv = tid >> 6, hh = lane >> 5, r32 = lane & 31;
    for (int item = blockIdx.x; item < NT / 4; item += gridDim.x) {
        const int tq0 = item * 4, b = tq0 / SEQ, t0 = tq0 % SEQ;
        __syncthreads();
        const int row = wv >> 1, wr = wv & 1;
        const int tr_ = t0 + row, nr = tr_ + 1;
        const int nwords = ((tr_ >> 8) + 1) * 4;
        unsigned long long* mrow = MASK + (size_t)(tq0 + row) * 128;
        if (t0 + 3 < TOPK) {
            for (int wi = wr; wi < nwords; wi += 2) { const int s_ = wi * 64 + lane; const unsigned long long mk = __ballot(s_ <= tr_); if (lane == 0) mrow[wi] = mk; }
            continue;
        }
        {
            const int tl_a = r32 >> 3, h_a = r32 & 7;
            half8_t a0 = *(const half8_t*)(QI + (size_t)(tq0 + tl_a) * 256 + h_a * 32 + 8 * hh), a1 = *(const half8_t*)(QI + (size_t)(tq0 + tl_a) * 256 + h_a * 32 + 16 + 8 * hh);
            float w[4][4];
#pragma unroll
            for (int tl = 0; tl < 4; ++tl) { const float4 wv4 = *(const float4*)(WI + (size_t)(tq0 + tl) * 8 + 4 * hh); w[tl][0] = wv4.x; w[tl][1] = wv4.y; w[tl][2] = wv4.z; w[tl][3] = wv4.w; }
            const int ntile = (t0 + 3) / 32 + 1;
            for (int tile = wv; tile < ntile; tile += 8) {
                const int key = tile * 32 + r32;
                const _Float16* kp = KI + (size_t)(b * SEQ + key) * 32 + 8 * hh;
                const half8_t b0 = *(const half8_t*)kp, b1 = *(const half8_t*)(kp + 16);
                f32x16_t c;
#pragma unroll
                for (int i = 0; i < 16; ++i) c[i] = 0.f;
                c = __builtin_amdgcn_mfma_f32_32x32x16_f16(a0, b0, c, 0, 0, 0);
                c = __builtin_amdgcn_mfma_f32_32x32x16_f16(a1, b1, c, 0, 0, 0);
                float x[4];
#pragma unroll
                for (int tl = 0; tl < 4; ++tl) { x[tl] = 0.f;
#pragma unroll
                    for (int e = 0; e < 4; ++e) x[tl] += w[tl][e] * fmaxf(c[4 * tl + e], 0.f); }
                const auto s01 = __builtin_amdgcn_permlane32_swap(__float_as_uint(x[0]), __float_as_uint(x[1]), false, false);
                const auto s23 = __builtin_amdgcn_permlane32_swap(__float_as_uint(x[2]), __float_as_uint(x[3]), false, false);
                const float v01 = __uint_as_float(s01[0]) + __uint_as_float(s01[1]);
                const float v23 = __uint_as_float(s23[0]) + __uint_as_float(s23[1]);
                sc[(hh) * 8192 + key] = (key <= t0 + hh) ? f2key(v01) : 0u;
                sc[(2 + hh) * 8192 + key] = (key <= t0 + 2 + hh) ? f2key(v23) : 0u;
            }
        }
        __syncthreads();
        unsigned prefix = 0; int remaining = TOPK, cnt_eq = 0;
        const int t128 = wr * 64 + lane;
        const unsigned* scr = sc + row * 8192; unsigned* hrow = hist + row * 256; int* mrw = misc + row * 8;
#pragma unroll 1
        for (int pass = 0; pass < 4; ++pass) {
            const int shift = 24 - 8 * pass;
            for (int i = t128; i < 256; i += 128) hrow[i] = 0u;
            __syncthreads();
            for (int s_ = t128; s_ < nr; s_ += 128) { const unsigned k = scr[s_]; if (pass == 0 || (k >> (shift + 8)) == (prefix >> (shift + 8))) atomicAdd(&hrow[(k >> shift) & 255u], 1u); }
            __syncthreads();
            if (wr == 0) {
                const unsigned h0 = hrow[4 * lane], h1 = hrow[4 * lane + 1], h2 = hrow[4 * lane + 2], h3 = hrow[4 * lane + 3];
                unsigned suf = h0 + h1 + h2 + h3;
#pragma unroll
                for (int o = 1; o < 64; o <<= 1) { const unsigned oth = __shfl_down(suf, o); if (lane + o < 64) suf += oth; }
                const unsigned above3 = suf - (h0 + h1 + h2 + h3);
                const unsigned ab[4] = {above3 + h3 + h2 + h1, above3 + h3 + h2, above3 + h3, above3}; const unsigned hv[4] = {h0, h1, h2, h3};
#pragma unroll
                for (int q = 0; q < 4; ++q) if ((int)ab[q] < remaining && remaining <= (int)(ab[q] + hv[q])) { mrw[0] = 4 * lane + q; mrw[1] = remaining - (int)ab[q]; mrw[2] = (int)hv[q]; }
            }
            __syncthreads();
            prefix |= ((unsigned)mrw[0]) << shift; remaining = mrw[1]; cnt_eq = mrw[2];
        }
        if (cnt_eq == remaining) {
            for (int wi = wr; wi < nwords; wi += 2) { const int s_ = wi * 64 + lane; const bool f = (s_ < nr) && (scr[s_ & 8191] >= prefix); const unsigned long long mk = __ballot(f); if (lane == 0) mrow[wi] = mk; }
        } else if (wr == 0) {
            int taken = 0;
            for (int wi = 0; wi < nwords; ++wi) { const int s_ = wi * 64 + lane; const unsigned k = (s_ < nr) ? scr[s_ & 8191] : 0u; const bool eq = (s_ < nr) && (k == prefix);
                const unsigned long long me = __ballot(eq); const int pre = __popcll(me & ((1ull << lane) - 1ull));
                const bool f = (s_ < nr) && (k > prefix || (eq && taken + pre < remaining));
                const unsigned long long mk = __ballot(f); if (lane == 0) mrow[wi] = mk; taken += __popcll(me); }
        }
    }
}

typedef unsigned u32x4_t __attribute__((ext_vector_type(4)));
typedef __bf16 bf2_t __attribute__((ext_vector_type(2)));
typedef float f2_t __attribute__((ext_vector_type(2)));
__device__ __forceinline__ unsigned pk_bf16(float lo, float hi) { const f2_t v = {lo, hi}; return __builtin_bit_cast(unsigned, __builtin_convertvector(v, bf2_t)); }
__device__ __forceinline__ bf16x8_t pack_step16(const f32x16_t& x, int s2) {
    u32x4_t pk;
    if (s2 == 0) { pk[0] = pk_bf16(x[0], x[1]); pk[1] = pk_bf16(x[2], x[3]); pk[2] = pk_bf16(x[4], x[5]); pk[3] = pk_bf16(x[6], x[7]); }
    else { pk[0] = pk_bf16(x[8], x[9]); pk[1] = pk_bf16(x[10], x[11]); pk[2] = pk_bf16(x[12], x[13]); pk[3] = pk_bf16(x[14], x[15]); }
    return __builtin_bit_cast(bf16x8_t, pk);
}
__device__ __forceinline__ float xhalf_max(float x) { const auto t = __builtin_amdgcn_permlane32_swap(__float_as_uint(x), __float_as_uint(x), false, false); return fmaxf(__uint_as_float(t[0]), __uint_as_float(t[1])); }
__device__ __forceinline__ float xhalf_sum(float x) { const auto t = __builtin_amdgcn_permlane32_swap(__float_as_uint(x), __float_as_uint(x), false, false); return __uint_as_float(t[0]) + __uint_as_float(t[1]); }
__device__ __forceinline__ short bf16_of_int(int v) { return (short)(__float_as_uint((float)v) >> 16); }
#define MFMA32(a, b, c) __builtin_amdgcn_mfma_f32_32x32x16_bf16((a), (b), (c), 0, 0, 0)
__device__ void ph_dsa_attn(const P& p, float* ldsf) {
    const unsigned long long* MASK = (const unsigned long long*)(p.ws + WS_MASK);
    const bf16_t* Q = (const bf16_t*)(p.ws + WS_Q); const bf16_t* Kg = (const bf16_t*)(p.ws + WS_K); const bf16_t* VT = (const bf16_t*)(p.ws + WS_V);
    bf16_t* O = (bf16_t*)(p.ws + WS_OATT);
    bf16_t* L = (bf16_t*)ldsf;
    const int tid = otid(), lane = tid & 63, wv = tid >> 6, hh = lane >> 5, r32 = lane & 31;
    const float CS = 0.125f * 1.4426950408889634f;
    const float NEG = -1e30f;
    const int skey = tid >> 3, sch = (tid & 7) * 8;
    for (int u = blockIdx.x; u < 256; u += gridDim.x) {
        const int bh = u & 15, pr = u >> 4, b = bh >> 3, h = bh & 7;
        const bf16_t* Kbase = Kg + (size_t)b * SEQ * AW + h * 64; const bf16_t* Vbase = VT + (size_t)bh * 64 * SEQ;
#pragma unroll 1
        for (int half = 0; half < 2; ++half) {
            const int qb = half ? 31 - pr : pr;
            const int q0 = qb * 256 + wv * 32, q = q0 + r32, ntile = 4 * (qb + 1);
            const size_t qrow = (size_t)b * SEQ + q;
            bf16x8_t bq[5];
#pragma unroll
            for (int s2 = 0; s2 < 4; ++s2) bq[s2] = *(const bf16x8_t*)(Q + qrow * AW + h * 64 + 16 * s2 + 8 * hh);
#pragma unroll
            for (int j = 0; j < 8; ++j) bq[4][j] = 0;
            if (hh == 0) { bq[4][0] = bf16_of_int(256 >> h); bq[4][1] = (short)(__float_as_uint(4.f / (float)(1 << h)) >> 16); }
            f32x16_t o0, o1;
#pragma unroll
            for (int i = 0; i < 16; ++i) { o0[i] = 0.f; o1[i] = 0.f; }
            float m_run = NEG, l_run = 0.f;
            __syncthreads();
            { const uint4 kr = *(const uint4*)(Kbase + (size_t)skey * AW + sch), vr = *(const uint4*)(Vbase + (size_t)skey * SEQ + sch);
              *(uint4*)(L + skey * LP + sch) = kr; *(uint4*)(L + 2 * SLOT + skey * LP + sch) = vr; }
            unsigned long long mw = MASK[qrow * 128];
            __syncthreads();
#pragma unroll 1
            for (int kt = 0; kt < ntile; ++kt) {
                const int buf = kt & 1; const bool more = kt + 1 < ntile;
                uint4 kr = make_uint4(0, 0, 0, 0), vr = make_uint4(0, 0, 0, 0); unsigned long long mwn = 0ull;
                if (more) { kr = *(const uint4*)(Kbase + (size_t)((kt + 1) * 64 + skey) * AW + sch); vr = *(const uint4*)(Vbase + (size_t)skey * SEQ + (kt + 1) * 64 + sch); mwn = MASK[qrow * 128 + kt + 1]; }
                if (kt * 64 <= q0 + 31) {
                    const bf16_t* Kl = L + buf * SLOT; const bf16_t* Vl = L + (2 + buf) * SLOT;
                    f32x16_t p0, p1;
#pragma unroll
                    for (int i = 0; i < 16; ++i) { p0[i] = 0.f; p1[i] = 0.f; }
#pragma unroll
                    for (int s2 = 0; s2 < 4; ++s2) {
                        const bf16x8_t a0 = *(const bf16x8_t*)(Kl + r32 * LP + 16 * s2 + 8 * hh), a1 = *(const bf16x8_t*)(Kl + (32 + r32) * LP + 16 * s2 + 8 * hh);
                        p0 = MFMA32(a0, bq[s2], p0); p1 = MFMA32(a1, bq[s2], p1);
                    }
                    { bf16x8_t g0, g1;
#pragma unroll
                      for (int j = 0; j < 8; ++j) { g0[j] = 0; g1[j] = 0; }
                      if (hh == 0) { g0[0] = bf16_of_int(kt); g0[1] = bf16_of_int(r32); g1[0] = g0[0]; g1[1] = bf16_of_int(32 + r32); }
                      p0 = MFMA32(g0, bq[4], p0); p1 = MFMA32(g1, bq[4], p1); }
                    const unsigned wl = (unsigned)mw >> (4 * hh), wh = (unsigned)(mw >> 32) >> (4 * hh);
                    float mx = NEG;
#pragma unroll
                    for (int i = 0; i < 16; ++i) { const int bp = (i & 3) + 8 * (i >> 2);
                        const int m0 = ((int)(wl << (31 - bp))) >> 31, m1 = ((int)(wh << (31 - bp))) >> 31;
                        p0[i] = __uint_as_float((__float_as_uint(p0[i]) & (unsigned)m0) | (__float_as_uint(NEG) & ~(unsigned)m0));
                        p1[i] = __uint_as_float((__float_as_uint(p1[i]) & (unsigned)m1) | (__float_as_uint(NEG) & ~(unsigned)m1));
                        mx = fmaxf(mx, fmaxf(p0[i], p1[i])); }
                    mx = xhalf_max(mx);
                    const float m_new = fmaxf(m_run, mx);
                    const float alpha = __builtin_amdgcn_exp2f((m_run - m_new) * CS);
                    m_run = m_new;
                    const float mc = fmaxf(m_new, -1e20f) * CS;
                    float rs = 0.f;
#pragma unroll
                    for (int i = 0; i < 16; ++i) { p0[i] = __builtin_amdgcn_exp2f(p0[i] * CS - mc); p1[i] = __builtin_amdgcn_exp2f(p1[i] * CS - mc); rs += p0[i] + p1[i]; }
                    l_run = l_run * alpha + rs;
#pragma unroll
                    for (int i = 0; i < 16; ++i) { o0[i] *= alpha; o1[i] *= alpha; }
                    bf16x8_t pb[4];
                    pb[0] = pack_step16(p0, 0); pb[1] = pack_step16(p0, 1); pb[2] = pack_step16(p1, 0); pb[3] = pack_step16(p1, 1);
#pragma unroll
                    for (int ks = 0; ks < 4; ++ks) {
                        const int kofs = 32 * (ks >> 1) + 16 * (ks & 1) + 4 * hh;
                        typedef short s16x4_t __attribute__((ext_vector_type(4)));
                        const s16x4_t v00 = *(const s16x4_t*)(Vl + r32 * LP + kofs), v01 = *(const s16x4_t*)(Vl + r32 * LP + kofs + 8);
                        const s16x4_t v10 = *(const s16x4_t*)(Vl + (32 + r32) * LP + kofs), v11 = *(const s16x4_t*)(Vl + (32 + r32) * LP + kofs + 8);
                        bf16x8_t av0, av1;
#pragma unroll
                        for (int j = 0; j < 4; ++j) { av0[j] = v00[j]; av0[4 + j] = v01[j]; av1[j] = v10[j]; av1[4 + j] = v11[j]; }
                        o0 = MFMA32(av0, pb[ks], o0); o1 = MFMA32(av1, pb[ks], o1);
                    }
                }
                if (more) { *(uint4*)(L + (buf ^ 1) * SLOT + skey * LP + sch) = kr; *(uint4*)(L + (2 + (buf ^ 1)) * SLOT + skey * LP + sch) = vr; }
                mw = mwn;
                __syncthreads();
            }
            const float inv = 1.f / xhalf_sum(l_run);
            bf16_t* orow = O + qrow * AW + h * 64 + 4 * hh;
#pragma unroll
            for (int g = 0; g < 4; ++g) {
                uint2 w0, w1;
                w0.x = (unsigned)f2bf(o0[4 * g] * inv) | ((unsigned)f2bf(o0[4 * g + 1] * inv) << 16); w0.y = (unsigned)f2bf(o0[4 * g + 2] * inv) | ((unsigned)f2bf(o0[4 * g + 3] * inv) << 16);
                w1.x = (unsigned)f2bf(o1[4 * g] * inv) | ((unsigned)f2bf(o1[4 * g + 1] * inv) << 16); w1.y = (unsigned)f2bf(o1[4 * g + 2] * inv) | ((unsigned)f2bf(o1[4 * g + 3] * inv) << 16);
                *(uint2*)(orow + 8 * g) = w0; *(uint2*)(orow + 32 + 8 * g) = w1;
            }
        }
    }
}

constexpr int AP = 328, RP = 1544;
__device__ __forceinline__ f32x4_t mm16(const bf16_t* X, int xrs, const bf16_t* Y, int ycs, int nks, f32x4_t acc, int lane) {
    const int r = lane & 15, q = lane >> 4;
    for (int s2 = 0; s2 < nks; ++s2) {
        const bf16x8_t a = *(const bf16x8_t*)(X + r * xrs + 32 * s2 + 8 * q), b = *(const bf16x8_t*)(Y + r * ycs + 32 * s2 + 8 * q);
        acc = __builtin_amdgcn_mfma_f32_16x16x32_bf16(a, b, acc, 0, 0, 0);
    }
    return acc;
}
__device__ void ph_rwkv_prep(const P& p, float* ldsf) {
    const bf16_t* PS = (const bf16_t*)(p.ws + WS_PS);
    const float* mu = p.in[10]; const float* w0 = p.in[11]; const float* a0 = p.in[13]; const float* k_k = p.in[16]; const float* k_a = p.in[17];
    const bf16_t* W2T = (const bf16_t*)(p.ws + WS_LW2T); const bf16_t* A2T = (const bf16_t*)(p.ws + WS_LA2T); const bf16_t* G2T = (const bf16_t*)(p.ws + WS_LG2T);
    bf16_t* R = (bf16_t*)(p.ws + WS_R); bf16_t* K2 = (bf16_t*)(p.ws + WS_K2); bf16_t* VV = (bf16_t*)(p.ws + WS_VV); bf16_t* KK = (bf16_t*)(p.ws + WS_KK); bf16_t* BB = (bf16_t*)(p.ws + WS_BB);
    bf16_t* G = (bf16_t*)(p.ws + WS_G); float* DD = (float*)(p.ws + WS_DD);
    bf16_t* Amix = (bf16_t*)ldsf; bf16_t* RKV = Amix + 32 * AP;
    const int tid = otid(), lane = tid & 63, wv = tid >> 6, l15 = lane & 15, q4 = lane >> 4;
    for (int blk = blockIdx.x; blk < NT / 32; blk += gridDim.x) {
        const int m0 = blk * 32;
        __syncthreads();
        for (int ch = tid; ch < 32 * 228; ch += NTHR) {
            const int tk = ch / 228, c8 = (ch % 228) * 8, m = m0 + tk;
            const uint4 cu = *(const uint4*)(PS + (size_t)m * SHW + c8);
            uint4 pv = make_uint4(0, 0, 0, 0); if (m % SEQ) pv = *(const uint4*)(PS + (size_t)(m - 1) * SHW + c8);
            const unsigned cw[4] = {cu.x, cu.y, cu.z, cu.w}, pw[4] = {pv.x, pv.y, pv.z, pv.w};
            const float4 mu0 = *(const float4*)(mu + c8), mu1 = *(const float4*)(mu + c8 + 4); const float muv[8] = {mu0.x, mu0.y, mu0.z, mu0.w, mu1.x, mu1.y, mu1.z, mu1.w};
            float mx[8];
#pragma unroll
            for (int e = 0; e < 8; ++e) { const float c_ = (e & 1) ? __uint_as_float(cw[e >> 1] & 0xffff0000u) : __uint_as_float(cw[e >> 1] << 16), p_ = (e & 1) ? __uint_as_float(pw[e >> 1] & 0xffff0000u) : __uint_as_float(pw[e >> 1] << 16);
                mx[e] = c_ + (p_ - c_) * muv[e]; }
            bf16_t* dst;
            if (c8 < 1536) dst = RKV + tk * RP + c8;
            else { const int col = c8 - 1536; dst = Amix + tk * AP + col;
#pragma unroll
                for (int e = 0; e < 8; ++e) mx[e] = (col < 64) ? tanhf(mx[e]) : ((col < 128) ? mx[e] : sigmoidf_(mx[e])); }
            *(uint4*)dst = make_uint4(pk2(mx[0], mx[1]), pk2(mx[2], mx[3]), pk2(mx[4], mx[5]), pk2(mx[6], mx[7]));
        }
        if (tid < 128) *(uint4*)(Amix + (tid >> 2) * AP + 288 + (tid & 3) * 8) = make_uint4(0, 0, 0, 0);
        __syncthreads();
        const int h = wv;
#pragma unroll 1
        for (int rt = 0; rt < 2; ++rt) {
            f32x4_t aw[4], aa[4], ag[4];
            const f32x4_t z4 = {0.f, 0.f, 0.f, 0.f};
#pragma unroll
            for (int ct = 0; ct < 4; ++ct) { const int cb = 64 * h + 16 * ct;
                aw[ct] = mm16(Amix + 16 * rt * AP, AP, W2T + (size_t)cb * 64, 64, 2, z4, lane);
                aa[ct] = mm16(Amix + 16 * rt * AP + 64, AP, A2T + (size_t)cb * 64, 64, 2, z4, lane);
                ag[ct] = mm16(Amix + 16 * rt * AP + 128, AP, G2T + (size_t)cb * 192, 192, 6, z4, lane); }
            float ss[4] = {0.f, 0.f, 0.f, 0.f}; float kkr[4][4];
#pragma unroll
            for (int ct = 0; ct < 4; ++ct) { const int c = 64 * h + 16 * ct + l15; const float kkc = k_k[c];
#pragma unroll
                for (int e = 0; e < 4; ++e) { const float k = bf2f(RKV[(16 * rt + 4 * q4 + e) * RP + 512 + c]); kkr[ct][e] = k * kkc; ss[e] += kkr[ct][e] * kkr[ct][e]; } }
#pragma unroll
            for (int e = 0; e < 4; ++e) { ss[e] += __shfl_xor(ss[e], 1); ss[e] += __shfl_xor(ss[e], 2); ss[e] += __shfl_xor(ss[e], 4); ss[e] += __shfl_xor(ss[e], 8); ss[e] = 1.f / fmaxf(sqrtf(ss[e]), 1e-12f); }
#pragma unroll
            for (int ct = 0; ct < 4; ++ct) { const int c = 64 * h + 16 * ct + l15; const float w0c = w0[c], a0c = a0[c], kac = k_a[c];
#pragma unroll
                for (int e = 0; e < 4; ++e) { const int tk = 16 * rt + 4 * q4 + e;
                    const float r = bf2f(RKV[tk * RP + c]), k = bf2f(RKV[tk * RP + 512 + c]), v = bf2f(RKV[tk * RP + 1024 + c]);
                    const float xw = -(w0c + aw[ct][e]);
                    const float sp = fmaxf(xw, 0.f) + log1pf(__expf(-fabsf(xw)));
                    const float w = -sp - 0.5f;
                    const float a = sigmoidf_(a0c + aa[ct][e]);
                    const float kk = kkr[ct][e] * ss[e];
                    const size_t o = (size_t)(m0 + tk) * RW + c;
                    R[o] = f2bf(r); K2[o] = f2bf(k * (1.f + (a - 1.f) * kac)); VV[o] = f2bf(v); KK[o] = f2bf(kk); BB[o] = f2bf(kk * a); G[o] = f2bf(ag[ct][e]); DD[o] = -__expf(w);
                } }
        }
    }
}

template <bool XC, bool YC>
__device__ __forceinline__ f32x4_t mm_tile(const bf16_t* X, int xrs, int xcs, const bf16_t* Y, int yrs, int ycs, int tr, int tc, f32x4_t acc, int lane) {
    const int r = lane & 15, q = lane >> 4;
#pragma unroll
    for (int s2 = 0; s2 < 2; ++s2) {
        bf16x8_t a, b;
        const bf16_t* xp = X + (16 * tr + r) * xrs + (32 * s2 + 8 * q) * xcs;
        if (XC) a = *(const bf16x8_t*)xp; else {
#pragma unroll
            for (int j = 0; j < 8; ++j) a[j] = (short)xp[j * xcs]; }
        const bf16_t* yp = Y + (32 * s2 + 8 * q) * yrs + (16 * tc + r) * ycs;
        if (YC) b = *(const bf16x8_t*)yp; else {
#pragma unroll
            for (int j = 0; j < 8; ++j) b[j] = (short)yp[j * yrs]; }
        acc = __builtin_amdgcn_mfma_f32_16x16x32_bf16(a, b, acc, 0, 0, 0);
    }
    return acc;
}
__device__ __forceinline__ void st_tile(const f32x4_t& acc, bf16_t* D, int drs, int dcs, int tr, int tc, int lane) {
    const int row0 = 16 * tr + 4 * (lane >> 4), col = 16 * tc + (lane & 15);
#pragma unroll
    for (int e = 0; e < 4; ++e) D[(row0 + e) * drs + col * dcs] = f2bf(acc[e]);
}
__device__ __forceinline__ f32x4_t ld_tile(const bf16_t* D, int drs, int dcs, int tr, int tc, int lane) {
    const int row0 = 16 * tr + 4 * (lane >> 4), col = 16 * tc + (lane & 15); f32x4_t v;
#pragma unroll
    for (int e = 0; e < 4; ++e) v[e] = bf2f(D[(row0 + e) * drs + col * dcs]);
    return v;
}
template <bool STRICT> __device__ __forceinline__ void triu_tile(f32x4_t& acc, int tr, int tc, int lane) {
    const int row0 = 16 * tr + 4 * (lane >> 4), col = 16 * tc + (lane & 15);
#pragma unroll
    for (int e = 0; e < 4; ++e) { const bool keep = STRICT ? (row0 + e < col) : (row0 + e <= col); acc[e] = keep ? acc[e] : 0.f; }
}

__device__ void ph_rwkv_r1(const P& p, float* ldsf) {
    const bf16_t* R = (const bf16_t*)(p.ws + WS_R); const bf16_t* K2 = (const bf16_t*)(p.ws + WS_K2); const bf16_t* VV = (const bf16_t*)(p.ws + WS_VV);
    const bf16_t* KK = (const bf16_t*)(p.ws + WS_KK); const bf16_t* BB = (const bf16_t*)(p.ws + WS_BB); const float* DD = (const float*)(p.ws + WS_DD);
    bf16_t* G1T = (bf16_t*)(p.ws + WS_G1T); bf16_t* G2T = (bf16_t*)(p.ws + WS_G2T); bf16_t* PT = (bf16_t*)(p.ws + WS_PT); bf16_t* QT = (bf16_t*)(p.ws + WS_QT);
    bf16_t* L = (bf16_t*)ldsf;
    bf16_t* At = L + 0 * SLOT; bf16_t* Bt = L + 1 * SLOT; bf16_t* Kt = L + 2 * SLOT; bf16_t* Rt = L + 3 * SLOT; bf16_t* Vm = L + 4 * SLOT; bf16_t* Bh = L + 5 * SLOT; bf16_t* Kh = L + 6 * SLOT;
    bf16_t* S7 = L + 7 * SLOT; bf16_t* S8 = L + 8 * SLOT; bf16_t* S9 = L + 9 * SLOT; bf16_t* S10 = L + 10 * SLOT; bf16_t* S11 = L + 11 * SLOT;
    float* cs = (float*)(L + 12 * SLOT);
    float* segs = cs + 64 * 65;
    const int tid = otid(), lane = tid & 63, wv = tid >> 6;
    const int t0 = 2 * wv, t1 = 2 * wv + 1;
    for (int ch = blockIdx.x; ch < NB * 8 * (SEQ / 64); ch += gridDim.x) {
        const int bh = ch >> 7, c = ch & 127, b = bh >> 3, h = bh & 7;
        const size_t gbase = ((size_t)b * SEQ + (size_t)c * 64) * RW + h * 64;
        __syncthreads();
        const int st = tid >> 3, sj = (tid & 7) * 8;
        { const float4 l0 = *(const float4*)(DD + gbase + (size_t)st * RW + sj), l1 = *(const float4*)(DD + gbase + (size_t)st * RW + sj + 4);
          float* d = cs + st * 65 + sj; d[0] = l0.x; d[1] = l0.y; d[2] = l0.z; d[3] = l0.w; d[4] = l1.x; d[5] = l1.y; d[6] = l1.z; d[7] = l1.w; }
        __syncthreads();
        { const int j = tid & 63, sg = tid >> 6; float run = 0.f;
#pragma unroll
          for (int i = 0; i < 8; ++i) { run += cs[(sg * 8 + i) * 65 + j]; }
          segs[sg * 64 + j] = run; }
        __syncthreads();
        { const int j = tid & 63, sg = tid >> 6; float run = 0.f;
          for (int q = 0; q < sg; ++q) run += segs[q * 64 + j];
#pragma unroll
          for (int i = 0; i < 8; ++i) { run += cs[(sg * 8 + i) * 65 + j]; cs[(sg * 8 + i) * 65 + j] = run; } }
        __syncthreads();
        {
            const uint4 rr = *(const uint4*)(R + gbase + (size_t)st * RW + sj), kr = *(const uint4*)(K2 + gbase + (size_t)st * RW + sj), vr = *(const uint4*)(VV + gbase + (size_t)st * RW + sj);
            const uint4 kkr = *(const uint4*)(KK + gbase + (size_t)st * RW + sj), br = *(const uint4*)(BB + gbase + (size_t)st * RW + sj);
            const unsigned rw_[4] = {rr.x, rr.y, rr.z, rr.w}, kw_[4] = {kr.x, kr.y, kr.z, kr.w}, kkw_[4] = {kkr.x, kkr.y, kkr.z, kkr.w}, bw_[4] = {br.x, br.y, br.z, br.w};
            *(uint4*)(Vm + st * LP + sj) = vr;
            unsigned oa[4], ob[4], ok[4], orr[4], obh[4], okh[4];
#pragma unroll
            for (int e2 = 0; e2 < 4; ++e2) {
                float va[2], vb[2], vk[2], vr2[2], vbh[2], vkh[2];
#pragma unroll
                for (int hf = 0; hf < 2; ++hf) {
                    const int j = sj + 2 * e2 + hf;
                    const float lgI = cs[st * 65 + j], lgE = st ? cs[(st - 1) * 65 + j] : 0.f, gl = cs[63 * 65 + j];
                    const float rv = hf ? __uint_as_float(rw_[e2] & 0xffff0000u) : __uint_as_float(rw_[e2] << 16);
                    const float kv = hf ? __uint_as_float(kw_[e2] & 0xffff0000u) : __uint_as_float(kw_[e2] << 16);
                    const float kkv = hf ? __uint_as_float(kkw_[e2] & 0xffff0000u) : __uint_as_float(kkw_[e2] << 16);
                    const float bv = hf ? __uint_as_float(bw_[e2] & 0xffff0000u) : __uint_as_float(bw_[e2] << 16);
                    const float einv = __expf(-lgI), eh = __expf(gl - lgI);
                    va[hf] = -kkv * __expf(lgE); vb[hf] = bv * einv; vk[hf] = kv * einv; vr2[hf] = rv * __expf(lgI); vbh[hf] = bv * eh; vkh[hf] = kv * eh;
                }
                oa[e2] = (unsigned)f2bf(va[0]) | ((unsigned)f2bf(va[1]) << 16); ob[e2] = (unsigned)f2bf(vb[0]) | ((unsigned)f2bf(vb[1]) << 16);
                ok[e2] = (unsigned)f2bf(vk[0]) | ((unsigned)f2bf(vk[1]) << 16); orr[e2] = (unsigned)f2bf(vr2[0]) | ((unsigned)f2bf(vr2[1]) << 16);
                obh[e2] = (unsigned)f2bf(vbh[0]) | ((unsigned)f2bf(vbh[1]) << 16); okh[e2] = (unsigned)f2bf(vkh[0]) | ((unsigned)f2bf(vkh[1]) << 16);
            }
            *(uint4*)(At + st * LP + sj) = make_uint4(oa[0], oa[1], oa[2], oa[3]); *(uint4*)(Bt + st * LP + sj) = make_uint4(ob[0], ob[1], ob[2], ob[3]);
            *(uint4*)(Kt + st * LP + sj) = make_uint4(ok[0], ok[1], ok[2], ok[3]); *(uint4*)(Rt + st * LP + sj) = make_uint4(orr[0], orr[1], orr[2], orr[3]);
            *(uint4*)(Bh + st * LP + sj) = make_uint4(obh[0], obh[1], obh[2], obh[3]); *(uint4*)(Kh + st * LP + sj) = make_uint4(okh[0], okh[1], okh[2], okh[3]);
        }
        __syncthreads();
#define R1_FOR_TILES(idx, tr, tc) _Pragma("unroll") for (int _q = 0; _q < 2; ++_q) { const int idx = _q ? t1 : t0; const int tr = idx >> 2, tc = idx & 3;
#define R1_END }
        const f32x4_t zero4 = {0.f, 0.f, 0.f, 0.f};
        R1_FOR_TILES(idx, tr, tc)
            f32x4_t mab = mm_tile<true, true>(Bt, LP, 1, At, 1, LP, tr, tc, zero4, lane); triu_tile<true>(mab, tr, tc, lane); st_tile(mab, S7, LP, 1, tr, tc, lane);
            { f32x4_t tt = mab; const int row0 = 16 * tr + 4 * (lane >> 4), col = 16 * tc + (lane & 15);
#pragma unroll
              for (int e = 0; e < 4; ++e) tt[e] += (row0 + e == col) ? 1.f : 0.f;
              st_tile(tt, S11, LP, 1, tr, tc, lane); }
            f32x4_t mka = mm_tile<true, true>(Kt, LP, 1, At, 1, LP, tr, tc, zero4, lane); triu_tile<true>(mka, tr, tc, lane); st_tile(mka, S8, LP, 1, tr, tc, lane);
            f32x4_t nbr = mm_tile<true, true>(Bt, LP, 1, Rt, 1, LP, tr, tc, zero4, lane); triu_tile<false>(nbr, tr, tc, lane); st_tile(nbr, S9, LP, 1, tr, tc, lane);
            f32x4_t nkr = mm_tile<true, true>(Kt, LP, 1, Rt, 1, LP, tr, tc, zero4, lane); triu_tile<false>(nkr, tr, tc, lane); st_tile(nkr, S10, LP, 1, tr, tc, lane);
        R1_END
        __syncthreads();
        bf16_t* Pc = S7; bf16_t* Pn = Kt; bf16_t* Tc = S11; bf16_t* Tn = Bt;
#pragma unroll 1
        for (int lvl = 0; lvl < 5; ++lvl) {
            R1_FOR_TILES(idx, tr, tc)
                f32x4_t pp = mm_tile<true, false>(Pc, LP, 1, Pc, LP, 1, tr, tc, zero4, lane); st_tile(pp, Pn, LP, 1, tr, tc, lane);
            R1_END
            __syncthreads();
            R1_FOR_TILES(idx, tr, tc)
                f32x4_t tn = ld_tile(Tc, LP, 1, tr, tc, lane); tn = mm_tile<true, false>(Tc, LP, 1, Pn, LP, 1, tr, tc, tn, lane); st_tile(tn, Tn, LP, 1, tr, tc, lane);
            R1_END
            __syncthreads();
            bf16_t* x_ = Pc; Pc = Pn; Pn = x_; x_ = Tc; Tc = Tn; Tn = x_;
        }
        bf16_t* W1 = Pc; bf16_t* W2 = Pn; bf16_t* Qk = Tn;
        R1_FOR_TILES(idx, tr, tc)
            f32x4_t w1 = mm_tile<false, false>(At, 1, LP, Tc, LP, 1, tr, tc, zero4, lane); st_tile(w1, W1, LP, 1, tr, tc, lane);
            f32x4_t w2 = mm_tile<true, false>(S8, LP, 1, Tc, LP, 1, tr, tc, zero4, lane); st_tile(w2, W2, LP, 1, tr, tc, lane);
        R1_END
        __syncthreads();
        const size_t ob_ = (size_t)ch * 4096;
        R1_FOR_TILES(idx, tr, tc)
            f32x4_t g1 = ld_tile(Rt, 1, LP, tr, tc, lane); g1 = mm_tile<true, false>(W1, LP, 1, S9, LP, 1, tr, tc, g1, lane); st_tile(g1, G1T + ob_, 1, 64, tr, tc, lane);
            f32x4_t g2 = ld_tile(S10, LP, 1, tr, tc, lane); g2 = mm_tile<true, false>(W2, LP, 1, S9, LP, 1, tr, tc, g2, lane); st_tile(g2, G2T + ob_, 1, 64, tr, tc, lane);
            f32x4_t pm = mm_tile<true, false>(W1, LP, 1, Bh, LP, 1, tr, tc, zero4, lane);
            { const int row0 = 16 * tr + 4 * (lane >> 4), col = 16 * tc + (lane & 15);
#pragma unroll
              for (int e = 0; e < 4; ++e) pm[e] += (row0 + e == col) ? __expf(cs[63 * 65 + col]) : 0.f; }
            st_tile(pm, PT + ob_, 1, 64, tr, tc, lane);
            f32x4_t qk = ld_tile(Kh, LP, 1, tr, tc, lane); qk = mm_tile<true, false>(W2, LP, 1, Bh, LP, 1, tr, tc, qk, lane); st_tile(qk, Qk, LP, 1, tr, tc, lane);
        R1_END
        __syncthreads();
        R1_FOR_TILES(idx, tr, tc)
            f32x4_t qt = mm_tile<false, false>(Qk, 1, LP, Vm, LP, 1, tr, tc, zero4, lane);
            { const int row0 = 16 * tr + 4 * (lane >> 4), col = 16 * tc + (lane & 15);
#pragma unroll
              for (int e = 0; e < 4; ++e) { const int jp = row0 + e; QT[ob_ + (size_t)((((jp >> 5) * 2 + (col >> 5)) * 64 + (col & 31) + 32 * ((jp >> 2) & 1)) * 16 + (jp & 3) + 4 * ((jp & 31) >> 3))] = f2bf(qt[e]); } }
        R1_END
    }
}
__device__ void ph_rwkv_r2(const P& p) {
    const bf16_t* PT = (const bf16_t*)(p.ws + WS_PT); const bf16_t* QT = (const bf16_t*)(p.ws + WS_QT); bf16_t* SX = (bf16_t*)(p.ws + WS_SX);
    const int tid = otid(), lane = tid & 63, wv = tid >> 6, hh = lane >> 5, r32 = lane & 31;
    typedef short s16x4_t __attribute__((ext_vector_type(4)));
    for (int bh = blockIdx.x; bh < NB * 8; bh += gridDim.x) {
        if (wv >= 2) continue;
        const int cb = wv;
        f32x16_t x0, x1;
#pragma unroll
        for (int i = 0; i < 16; ++i) { x0[i] = 0.f; x1[i] = 0.f; }
        bf16x8_t pa[2][4]; uint4 qa[2][2];
#define R2_LOAD(c_) do { const size_t ob_ = ((size_t)bh * 128 + (c_)) * 4096; \
            _Pragma("unroll") for (int rb = 0; rb < 2; ++rb) { \
                _Pragma("unroll") for (int ks = 0; ks < 4; ++ks) { const bf16_t* pp = PT + ob_ + (size_t)(32 * rb + r32) * 64 + 32 * (ks >> 1) + 16 * (ks & 1) + 4 * hh; \
                    const s16x4_t lo = *(const s16x4_t*)pp, hi = *(const s16x4_t*)(pp + 8); \
                    _Pragma("unroll") for (int j = 0; j < 4; ++j) { pa[rb][ks][j] = lo[j]; pa[rb][ks][4 + j] = hi[j]; } } \
                const uint4* qp = (const uint4*)(QT + ob_ + (size_t)((rb * 2 + cb) * 64 + lane) * 16); qa[rb][0] = qp[0]; qa[rb][1] = qp[1]; } } while (0)
        R2_LOAD(0);
#pragma unroll 1
        for (int c = 0; c < SEQ / 64; ++c) {
            const size_t ob_ = ((size_t)bh * 128 + c) * 4096;
            const bf16x8_t xb0 = pack_step16(x0, 0), xb1 = pack_step16(x0, 1), xb2 = pack_step16(x1, 0), xb3 = pack_step16(x1, 1);
            { bf16_t* sp = SX + ob_ + (size_t)(32 * cb + r32) * 64 + 4 * hh;
              const uint4 u0 = __builtin_bit_cast(uint4, xb0), u1 = __builtin_bit_cast(uint4, xb1), u2 = __builtin_bit_cast(uint4, xb2), u3 = __builtin_bit_cast(uint4, xb3);
              *(uint2*)(sp + 0) = make_uint2(u0.x, u0.y); *(uint2*)(sp + 8) = make_uint2(u0.z, u0.w); *(uint2*)(sp + 16) = make_uint2(u1.x, u1.y); *(uint2*)(sp + 24) = make_uint2(u1.z, u1.w);
              *(uint2*)(sp + 32) = make_uint2(u2.x, u2.y); *(uint2*)(sp + 40) = make_uint2(u2.z, u2.w); *(uint2*)(sp + 48) = make_uint2(u3.x, u3.y); *(uint2*)(sp + 56) = make_uint2(u3.z, u3.w); }
            f32x16_t n0, n1;
            { const unsigned qw0[8] = {qa[0][0].x, qa[0][0].y, qa[0][0].z, qa[0][0].w, qa[0][1].x, qa[0][1].y, qa[0][1].z, qa[0][1].w};
              const unsigned qw1[8] = {qa[1][0].x, qa[1][0].y, qa[1][0].z, qa[1][0].w, qa[1][1].x, qa[1][1].y, qa[1][1].z, qa[1][1].w};
#pragma unroll
              for (int i = 0; i < 8; ++i) { n0[2 * i] = __uint_as_float(qw0[i] << 16); n0[2 * i + 1] = __uint_as_float(qw0[i] & 0xffff0000u); n1[2 * i] = __uint_as_float(qw1[i] << 16); n1[2 * i + 1] = __uint_as_float(qw1[i] & 0xffff0000u); } }
            const bf16x8_t a00 = pa[0][0], a01 = pa[0][1], a02 = pa[0][2], a03 = pa[0][3], a10 = pa[1][0], a11 = pa[1][1], a12 = pa[1][2], a13 = pa[1][3];
            if (c + 1 < SEQ / 64) R2_LOAD(c + 1);
            n0 = MFMA32(a00, xb0, n0); n0 = MFMA32(a01, xb1, n0); n0 = MFMA32(a02, xb2, n0); n0 = MFMA32(a03, xb3, n0);
            n1 = MFMA32(a10, xb0, n1); n1 = MFMA32(a11, xb1, n1); n1 = MFMA32(a12, xb2, n1); n1 = MFMA32(a13, xb3, n1);
            x0 = n0; x1 = n1;
        }
#undef R2_LOAD
    }
}
__device__ void ph_rwkv_r3(const P& p, float* ldsf) {
    const bf16_t* VV = (const bf16_t*)(p.ws + WS_VV); const bf16_t* G1T = (const bf16_t*)(p.ws + WS_G1T); const bf16_t* G2T = (const bf16_t*)(p.ws + WS_G2T); const bf16_t* SX = (const bf16_t*)(p.ws + WS_SX);
    float* YS = (float*)(p.ws + WS_YS);
    bf16_t* Vm = (bf16_t*)ldsf;
    const int tid = otid(), lane = tid & 63, wv = tid >> 6; const int t0 = 2 * wv, t1 = 2 * wv + 1;
    for (int ch = blockIdx.x; ch < NB * 8 * (SEQ / 64); ch += gridDim.x) {
        const int bh = ch >> 7, c = ch & 127, b = bh >> 3, h = bh & 7;
        const size_t gbase = ((size_t)b * SEQ + (size_t)c * 64) * RW + h * 64, ob_ = (size_t)ch * 4096;
        __syncthreads();
        { const int st = tid >> 3, sj = (tid & 7) * 8; *(uint4*)(Vm + st * LP + sj) = *(const uint4*)(VV + gbase + (size_t)st * RW + sj); }
        __syncthreads();
        R1_FOR_TILES(idx, tr, tc)
            const f32x4_t zero4 = {0.f, 0.f, 0.f, 0.f};
            f32x4_t y = mm_tile<true, true>(SX + ob_, 64, 1, G1T + ob_, 1, 64, tr, tc, zero4, lane);
            y = mm_tile<false, true>(Vm, 1, LP, G2T + ob_, 1, 64, tr, tc, y, lane);
            const int i0 = 16 * tr + 4 * (lane >> 4), t = 16 * tc + (lane & 15);
            *(f32x4_t*)(YS + gbase + (size_t)t * RW + i0) = y;
        R1_END
    }
}
#undef R1_FOR_TILES
#undef R1_END

__device__ void ph_rwkv_post(const P& p) {
    const bf16_t* R = (const bf16_t*)(p.ws + WS_R); const bf16_t* K2 = (const bf16_t*)(p.ws + WS_K2); const bf16_t* VV = (const bf16_t*)(p.ws + WS_VV); const bf16_t* G = (const bf16_t*)(p.ws + WS_G);
    const float* YS = (const float*)(p.ws + WS_YS); bf16_t* ORW = (bf16_t*)(p.ws + WS_ORW);
    const float* r_k = p.in[18]; const float* ln_w = p.in[19]; const float* ln_b = p.in[20];
    const int tid = otid();
    const float rkc = r_k[tid], lw = ln_w[tid], lb = ln_b[tid];
    for (int m = blockIdx.x; m < NT; m += gridDim.x) {
        const size_t o = (size_t)m * RW + tid;
        const float y = YS[o];
        const float mean = wave_sum(y) * (1.f / 64.f);
        const float dy = y - mean;
        const float var = wave_sum(dy * dy) * (1.f / 64.f);
        const float yn = dy * rsqrtf(var + GN_EPS) * lw + lb;
        const float r = bf2f(R[o]), k2 = bf2f(K2[o]), v = bf2f(VV[o]), g = bf2f(G[o]);
        const float rk = wave_sum(r * k2 * rkc);
        ORW[o] = f2bf((yn + rk * v) * g);
    }
}

__device__ void ph_moe_lists(const P& p, float* ldsf) {
    int* ctl = (int*)(p.ws + WS_CTL); const int* cntB = ctl + CT_CNTB;
    int* ltok = (int*)(p.ws + WS_LTOK); float* lw = (float*)(p.ws + WS_LW);
    int* part = (int*)ldsf;
    int* tot = part + 1024; int* pre = tot + 64; int* offL = pre + 64; int* tp = offL + 64;
    const int tid = otid(), lane = tid & 63, wv = tid >> 6, G = gridDim.x;
    { int t_ = 0, p_ = 0;
      for (int b2 = wv; b2 < G; b2 += 8) { const int v = cntB[b2 * 64 + lane]; t_ += v; p_ += (b2 < (int)blockIdx.x) ? v : 0; }
      part[wv * 64 + lane] = t_; part[512 + wv * 64 + lane] = p_; }
    __syncthreads();
    if (tid < 64) { int t_ = 0, p_ = 0;
#pragma unroll
        for (int w2 = 0; w2 < 8; ++w2) { t_ += part[w2 * 64 + tid]; p_ += part[512 + w2 * 64 + tid]; }
        tot[tid] = t_; pre[tid] = p_;
        const int nt_ = (t_ + 255) >> 8; int incl = nt_;
#pragma unroll
        for (int o = 1; o < 64; o <<= 1) { const int oth = __shfl_up(incl, o); if (lane >= o) incl += oth; }
        tp[tid] = incl - nt_; offL[tid] = (incl - nt_) * 256; if (tid == 63) tp[64] = incl; }
    __syncthreads();
    const int TPB = NT / G;
    for (int i = tid; i < TPB; i += NTHR) { const int m = blockIdx.x * TPB + i; const int4 r = ((const int4*)(p.ws + WS_ROUTE))[m];
        const int l0 = r.x & 255, l1 = 32 + ((r.x >> 8) & 255), rk0 = r.y & 0xffff, rk1 = (r.y >> 16) & 0xffff;
        const int p0 = offL[l0] + pre[l0] + rk0, p1 = offL[l1] + pre[l1] + rk1;
        ltok[p0] = m; lw[p0] = __int_as_float(r.z); ltok[p1] = m; lw[p1] = __int_as_float(r.w); }
    for (int li = blockIdx.x; li < 64; li += G) {
        const int cnt = tot[li], off = offL[li], e = li & 31, nt_ = (cnt + 255) >> 8;
        int4* t1 = (int4*)(ctl + CT_TAB1) + tp[li] * 4;
        int4* t2 = (li < 32) ? (int4*)(ctl + CT_TAB2A) + tp[li] * 4 : (int4*)(ctl + CT_TAB2B) + (tp[li] - tp[32]) * 4;
        for (int i = tid; i < nt_ * 4; i += NTHR) { const int mt = i >> 2, nt = i & 3; const int4 ent = make_int4(off + mt * 256, e * 1024 + nt * 256, cnt - mt * 256, nt); t1[i] = ent; t2[i] = ent; }
        for (int r = cnt + tid; r < nt_ * 256; r += NTHR) ltok[off + r] = 0;
    }
    if (blockIdx.x == 0 && tid == 0) { ctl[CT_NU] = tp[64] * 4; ctl[CT_NU + 1] = tp[32] * 4; ctl[CT_NU + 2] = (tp[64] - tp[32]) * 4; }
}

template <int PH>
__device__ __forceinline__ void run_phase(const P& p, unsigned char* lds_raw) {
    float* lds = (float*)lds_raw; PG8_LAS unsigned char* ldsg = (PG8_LAS unsigned char*)lds_raw;
    const int G = gridDim.x, c = blockIdx.x;
    if constexpr (PH == 0) { ph_mod(p, lds); __syncthreads(); ph_convert_mixer_weights(p, lds); __syncthreads(); ph_convert_lora_weights(p, lds); }
    if constexpr (PH == 1) ph_norm(p, p.in[0], p.in[4], 0, (bf16_t*)(p.ws + WS_XN));
    if constexpr (PH == 2) { pg8::Gemm g{(const bf16_t*)(p.ws + WS_XN), (const bf16_t*)(p.ws + WS_WIN), DM, nullptr}; pg8::StaticOrder S; S.init(NT, 5120, G, c);
        pg8::EpiInproj E{p.ws, (bf16_t*)p.out}; pg8::gemm_phase(ldsg, g, S, E); }
    if constexpr (PH == 3) { ph_headnorm((bf16_t*)(p.ws + WS_Q), p.in[8]); ph_kvnorm((bf16_t*)(p.ws + WS_KVN), p.in[6]); }
    if constexpr (PH == 4) { pg8::Gemm g{(const bf16_t*)(p.ws + WS_KVN), (const bf16_t*)(p.ws + WS_WKV), KVL, nullptr}; pg8::StaticOrder S; S.init(NT, 2 * AW, G, c);
        pg8::EpiKV E{p.ws}; pg8::gemm_phase(ldsg, g, S, E); }
    if constexpr (PH == 5) ph_headnorm((bf16_t*)(p.ws + WS_K), p.in[9]);
    if constexpr (PH == 6) ph_dsa_attn(p, lds);
    if constexpr (PH == 21) ph_dsa_select(p, lds);
    if constexpr (PH == 7) ph_rwkv_prep(p, lds);
    if constexpr (PH == 8) ph_rwkv_r1(p, lds);
    if constexpr (PH == 19) ph_rwkv_r2(p);
    if constexpr (PH == 20) ph_rwkv_r3(p, lds);
    if constexpr (PH == 9) ph_rwkv_post(p);
    if constexpr (PH == 10) { pg8::Gemm g{(const bf16_t*)(p.ws + WS_OATT), (const bf16_t*)(p.ws + WS_WBA), AW, nullptr}; pg8::StaticOrder S; S.init(NT, DM, G, c);
        pg8::EpiMerge<false> E{(bf16_t*)(p.ws + WS_MERGED), (const bf16_t*)p.out}; pg8::gemm_phase(ldsg, g, S, E);
        ph_convert_expert_weights(p, lds); }
    if constexpr (PH == 11) { pg8::Gemm g{(const bf16_t*)(p.ws + WS_ORW), (const bf16_t*)(p.ws + WS_WBR), RW, nullptr}; pg8::StaticOrder S; S.init(NT, DM, G, c);
        pg8::EpiMerge<true> E{(bf16_t*)(p.ws + WS_MERGED), (const bf16_t*)p.out + (size_t)NT * DM}; pg8::gemm_phase(ldsg, g, S, E); }
    if constexpr (PH == 12) { pg8::Gemm g{(const bf16_t*)(p.ws + WS_MERGED), (const bf16_t*)(p.ws + WS_WOUT), DM, nullptr}; pg8::StaticOrder S; S.init(NT, DM, G, c);
        pg8::EpiOut E{p.in[0], (const float*)(p.ws + WS_MOD), p.out}; pg8::gemm_phase(ldsg, g, S, E); }
    if constexpr (PH == 13) ph_norm_route(p, lds);
    if constexpr (PH == 14) ph_moe_lists(p, lds);
    if constexpr (PH == 16) { const int* ctl = (const int*)(p.ws + WS_CTL);
        pg8::Gemm g{(const bf16_t*)(p.ws + WS_XN2), (const bf16_t*)(p.ws + WS_WGU), DM, (const int*)(p.ws + WS_LTOK)}; pg8::TableOrder S{(const int4*)(ctl + CT_TAB1), ctl[CT_NU], G, c};
        pg8::EpiMoe1 E{(bf16_t*)(p.ws + WS_HID), (const float*)(p.ws + WS_LW)}; pg8::gemm_phase(ldsg, g, S, E); }
    if constexpr (PH == 17 || PH == 18) { const int* ctl = (const int*)(p.ws + WS_CTL);
        pg8::Gemm g{(const bf16_t*)(p.ws + WS_HID), (const bf16_t*)(p.ws + WS_WDN), DE, nullptr};
        pg8::TableOrder S{(const int4*)(ctl + (PH == 17 ? CT_TAB2A : CT_TAB2B)), ctl[CT_NU + (PH == 17 ? 1 : 2)], G, c};
        pg8::EpiMoe2 E{(const int*)(p.ws + WS_LTOK), (const float*)(p.ws + WS_MOD), p.out}; pg8::gemm_phase(ldsg, g, S, E); }
}
constexpr int LDS_BYTES = 147456;
constexpr int ORDER[] = {0, 1, 2, 3, 4, 5, 21, 6, 7, 8, 19, 20, 9, 10, 11, 12, 13, 14, 16, 17, 18};
constexpr int NPHASE = sizeof(ORDER) / sizeof(int);
constexpr int CT_BAR = 65536;
constexpr int LDS_ST = LDS_BYTES - 64;
template <int I> __device__ __forceinline__ void run_all(const P& p, unsigned char* lds, const XcdBarrier& bar) {
    run_phase<ORDER[I]>(p, lds);
    if constexpr (I + 1 < NPHASE) { xcd_barrier(bar); run_all<I + 1>(p, lds, bar); }
}
__global__ void __launch_bounds__(NTHR, 2) k_mega(P p) {
    extern __shared__ __attribute__((aligned(16))) unsigned char lds[];
    volatile LAS3 unsigned* st = (volatile LAS3 unsigned*)((LAS3 unsigned char*)lds + LDS_ST);
    if (otid() < 16) st[otid()] = 0u;
    __syncthreads();
    const XcdBarrier bar = xcd_barrier_post((unsigned*)(p.ws + WS_CTL) + CT_BAR, st);
    run_all<0>(p, lds, bar);
}
}

extern "C" void kernel_launch(void* const* d_in, const int* in_sizes, int n_in, void* d_out, int out_size, void* d_ws, size_t ws_size, hipStream_t stream) {
    if (n_in != 31 || out_size != NT * DM || ws_size < WS_END) { fprintf(stderr, "kernel_launch: unexpected shapes (n_in %d out %d ws %zu need %zu)\n", n_in, out_size, ws_size, (size_t)WS_END); return; }
    P p{};
    for (int i = 0; i < 31; ++i) p.in[i] = (const float*)d_in[i];
    p.out = (float*)d_out; p.ws = (unsigned char*)d_ws;
    (void)hipMemsetAsync((char*)d_ws + WS_CTL, 0, 1 * MiB, stream);
    static int grid_blocks = 0;
    if (!grid_blocks) {
        int dev = 0, cus = 0, per_cu = 0;
        (void)hipGetDevice(&dev);
        (void)hipDeviceGetAttribute(&cus, hipDeviceAttributeMultiprocessorCount, dev);
        (void)hipFuncSetAttribute((const void*)k_mega, hipFuncAttributeMaxDynamicSharedMemorySize, LDS_BYTES);
        (void)hipOccupancyMaxActiveBlocksPerMultiprocessor(&per_cu, (const void*)k_mega, NTHR, LDS_BYTES);
        if (per_cu < 1) per_cu = 1;
        if (per_cu > 1) per_cu = 1;
        grid_blocks = cus * per_cu;
        fprintf(stderr, "kernel_launch: cus %d per_cu %d grid %d\n", cus, per_cu, grid_blocks);
    }
    hipLaunchKernelGGL(k_mega, dim3(grid_blocks), dim3(NTHR), LDS_BYTES, stream, p);
}
```

```cpp
#include <hip/hip_runtime.h>
#include <cstdio>
#include <cstdint>

namespace {
constexpr int NB = 2, SEQ = 8192, DM = 1024, NT = NB * SEQ;
constexpr int AW = 512, KVL = 256, NIH = 8, IDD = 32, SHW = 1824, INW = 4936;
constexpr int C_KV = 512, C_QI = 768, C_PS = 1064, C_GA = 2888, C_GR = 3912;
constexpr int IDXW = 296;
constexpr int RW = 512, NE = 32, DE = 512;
constexpr int TOPK = 256;
constexpr float NORM_EPS = 1e-6f, GN_EPS = 64e-5f;
constexpr int NTHR = 512;

typedef unsigned short bf16_t;
__device__ __forceinline__ float bf2f(bf16_t v) { return __uint_as_float(((unsigned)v) << 16); }
__device__ __forceinline__ bf16_t f2bf(float f) { unsigned u = __float_as_uint(f); return (bf16_t)((u + 0x7fffu + ((u >> 16) & 1u)) >> 16); }

constexpr size_t MiB = 1u << 20;
constexpr size_t WS_CTL = 0;
constexpr size_t WS_MOD = 1 * MiB;
constexpr size_t WS_RSS = 128 * 1024;
constexpr size_t WS_LW2T = 512 * 1024, WS_LA2T = 576 * 1024, WS_LG2T = 640 * 1024;
constexpr size_t WS_WIN = 2 * MiB;
constexpr size_t WS_WKV = 12 * MiB;
constexpr size_t WS_WBA = 13 * MiB;
constexpr size_t WS_WBR = 14 * MiB;
constexpr size_t WS_WOUT = 15 * MiB;
constexpr size_t WS_XN = 17 * MiB;
constexpr size_t WS_K = 17 * MiB;
constexpr size_t WS_V = 33 * MiB;
constexpr size_t WS_Q = 49 * MiB;
constexpr size_t WS_KVN = 65 * MiB;
constexpr size_t WS_QI = 73 * MiB;
constexpr size_t WS_KI = 81 * MiB;
constexpr size_t WS_WI = 82 * MiB;
constexpr size_t WS_PS = 83 * MiB;
constexpr size_t WS_SX = 83 * MiB;
constexpr size_t WS_OATT = 99 * MiB;
constexpr size_t WS_ORW = 115 * MiB;
constexpr size_t WS_MASK = 140 * MiB;
constexpr size_t WS_R = 156 * MiB, WS_K2 = 172 * MiB, WS_VV = 188 * MiB;
constexpr size_t WS_KK = 204 * MiB;
constexpr size_t WS_BB = 220 * MiB;
constexpr size_t WS_DD = 236 * MiB;
constexpr size_t WS_G = 268 * MiB;
constexpr size_t WS_MERGED = 131 * MiB;
constexpr size_t WS_XN2 = 163 * MiB;
constexpr size_t WS_WGU = 195 * MiB;
constexpr size_t WS_WDN = 259 * MiB;
constexpr size_t WS_HID = 17 * MiB;
constexpr size_t WS_ROUTE = 65 * MiB;
constexpr size_t WS_LTOK = 66 * MiB;
constexpr size_t WS_LW = 67 * MiB;
constexpr size_t WS_END = 291 * MiB;
constexpr int HID_ROWS = 49152;
constexpr int CT_CNT = 0, CT_OFF = 64, CT_CUR = 128, CT_NU = 192, CT_Q = 256;
constexpr int CT_CNTB = 16384;
constexpr int CT_TAB1 = 1024, CT_TAB2A = 1024 + 4 * 1024, CT_TAB2B = 1024 + 8 * 1024;

struct P {
    const float* in[31];
    float* out;
    unsigned char* ws;
};

__device__ __forceinline__ int otid() { int t = threadIdx.x; asm volatile("" : "+v"(t)); return t; }
__device__ __forceinline__ float dpp_row_shr(float v, int n) {
    int iv = __builtin_bit_cast(int, v), r;
    switch (n) { case 1: r = __builtin_amdgcn_update_dpp(0, iv, 0x111, 0xf, 0xf, true); break; case 2: r = __builtin_amdgcn_update_dpp(0, iv, 0x112, 0xf, 0xf, true); break;
                 case 4: r = __builtin_amdgcn_update_dpp(0, iv, 0x114, 0xf, 0xf, true); break; default: r = __builtin_amdgcn_update_dpp(0, iv, 0x118, 0xf, 0xf, true); break; }
    return __builtin_bit_cast(float, r);
}
__device__ __forceinline__ float wave_sum(float v) {
    v += dpp_row_shr(v, 1); v += dpp_row_shr(v, 2); v += dpp_row_shr(v, 4); v += dpp_row_shr(v, 8);
    v += __builtin_bit_cast(float, __builtin_amdgcn_update_dpp(0, __builtin_bit_cast(int, v), 0x142, 0xa, 0xf, false));
    v += __builtin_bit_cast(float, __builtin_amdgcn_update_dpp(0, __builtin_bit_cast(int, v), 0x143, 0xc, 0xf, false));
    return __builtin_bit_cast(float, __builtin_amdgcn_readlane(__builtin_bit_cast(int, v), 63));
}
__device__ __forceinline__ float wave_max(float v) {
#pragma unroll
    for (int o = 32; o > 0; o >>= 1) v = fmaxf(v, __shfl_xor(v, o));
    return v;
}
typedef short bf16x8_t __attribute__((ext_vector_type(8)));
typedef float f32x4_t __attribute__((ext_vector_type(4)));
constexpr int LP = 72;
constexpr int SLOT = 64 * LP;
__device__ __forceinline__ float sigmoidf_(float x) { return 1.f / (1.f + __expf(-x)); }

#define XB_TMO      128
#define XB_XCNT(j)  (256  + 64 * (j))
#define XB_XSUB(j)  (1280 + 64 * (j))
#define XB_XGEN(j)  (2304 + 64 * (j))
#define XB_TOP      3328
#define XB_TOPGEN   3392
#define XCD_BAR_WORDS 3456
#define XB_SPIN_CAP (1u << 22)
#define LAS3 __attribute__((address_space(3)))
__device__ __forceinline__ unsigned xb_ld(unsigned* p)              { return __hip_atomic_load(p, __ATOMIC_RELAXED, __HIP_MEMORY_SCOPE_AGENT); }
__device__ __forceinline__ unsigned xb_add(unsigned* p, unsigned v) { return __hip_atomic_fetch_add(p, v, __ATOMIC_RELAXED, __HIP_MEMORY_SCOPE_AGENT); }
__device__ __forceinline__ unsigned xb_xcc_id() { return (unsigned)__builtin_amdgcn_s_getreg((3 << 11) | 20) & 0xFu; }
#define XB_SPIN(cond, bar) do { unsigned _sp = 0; while (cond) { __builtin_amdgcn_s_sleep(1); \
    if ((++_sp & 255u) == 0u) { if (xb_ld(&(bar)[XB_TMO])) break; if (_sp > XB_SPIN_CAP) { atomicAdd(&(bar)[XB_TMO], 1u); break; } } } } while (0)
struct XcdBarrier { unsigned* bar; unsigned x; volatile LAS3 unsigned* st; };
__device__ __forceinline__ XcdBarrier xcd_barrier_post(unsigned* bar, volatile LAS3 unsigned* st) {
    XcdBarrier b; b.bar = bar; b.x = xb_xcc_id(); b.st = st;
    if (otid() == 0) (void)xb_add(&bar[XB_XCNT(b.x)], 1u);
    return b;
}
__device__ __forceinline__ void xcd_barrier_complete(unsigned* bar, unsigned x, unsigned& nloc, unsigned& nx) {
    const unsigned G = gridDim.x * gridDim.y * gridDim.z;
    unsigned sum, cnt, mine, sp = 0u;
    for (;;) {
        sum = 0u; cnt = 0u; mine = 0u;
#pragma unroll
        for (unsigned j = 0; j < 16; ++j) { const unsigned c = xb_ld(&bar[XB_XCNT(j)]); sum += c; cnt += (c > 0u) ? 1u : 0u; mine = (j == x) ? c : mine; }
        if (sum == G) break;
        __builtin_amdgcn_s_sleep(1);
        if ((++sp & 255u) == 0u) { if (xb_ld(&bar[XB_TMO])) break; if (sp > XB_SPIN_CAP) { atomicAdd(&bar[XB_TMO], 1u); break; } }
    }
    nloc = mine > 0u ? mine : 1u; nx = cnt > 0u ? cnt : 1u;
}
__device__ __forceinline__ void xcd_barrier(const XcdBarrier& b) {
    asm volatile("s_waitcnt vmcnt(0)" ::: "memory");
    __syncthreads();
    if (otid() == 0) {
        unsigned* bar = b.bar;
        __builtin_amdgcn_s_waitcnt(0);
        unsigned nloc = b.st[0], nx = b.st[1];
        if (nloc == 0u) { xcd_barrier_complete(bar, b.x, nloc, nx); b.st[0] = nloc; b.st[1] = nx; }
        const unsigned old = xb_add(&bar[XB_XSUB(b.x)], 1u);
        const unsigned gen = old / nloc;
        if (old + 1u == (gen + 1u) * nloc) {
            __builtin_amdgcn_fence(__ATOMIC_RELEASE, "agent");
            asm volatile("s_waitcnt vmcnt(0)" ::: "memory");
            const unsigned og = xb_add(&bar[XB_TOP], 1u);
            const unsigned tg = og / nx;
            if (og + 1u == (tg + 1u) * nx) xb_add(&bar[XB_TOPGEN], 1u);
            else XB_SPIN(xb_ld(&bar[XB_TOPGEN]) == tg, bar);
            __builtin_amdgcn_fence(__ATOMIC_ACQUIRE, "agent");
            xb_add(&bar[XB_XGEN(b.x)], 1u);
            asm volatile("s_waitcnt vmcnt(0)" ::: "memory");
        } else {
            XB_SPIN(xb_ld(&bar[XB_XGEN(b.x)]) == gen, bar);
            __builtin_amdgcn_fence(__ATOMIC_ACQUIRE, "agent");
            asm volatile("s_waitcnt vmcnt(0)" ::: "memory");
        }
    }
    __syncthreads();
}

__device__ void ph_mod(const P& p, float* lds) {
    const float* c = p.in[1]; const float* W = p.in[2]; const float* bia = p.in[3];
    float* mod = (float*)(p.ws + WS_MOD);
    const int tid = otid(), lane = tid & 63, wv = tid >> 6;
    float* sil = lds; float* part = lds + NB * DM;
    for (int i = tid; i < NB * DM; i += NTHR) { const float v = c[i]; sil[i] = v / (1.f + __expf(-v)); }
    __syncthreads();
    const int cc = lane % 24, kk = lane / 24;
    for (int j0 = blockIdx.x * 24; j0 < 6 * DM; j0 += gridDim.x * 24) {
        float a0 = 0.f, a1 = 0.f;
        if (lane < 48) {
#pragma unroll 8
            for (int i = 0; i < 64; ++i) { const int k = 128 * wv + 2 * i + kk; const float w = W[(size_t)k * (6 * DM) + j0 + cc]; a0 += sil[k] * w; a1 += sil[DM + k] * w; }
        }
        a0 += __shfl(a0, (lane + 24) & 63); a1 += __shfl(a1, (lane + 24) & 63);
        if (lane < 24) { part[(wv * 2 + 0) * 24 + cc] = a0; part[(wv * 2 + 1) * 24 + cc] = a1; }
        __syncthreads();
        if (tid < 48) { const int bb = tid / 24, c2 = tid % 24; float sum = 0.f;
#pragma unroll
            for (int w2 = 0; w2 < 8; ++w2) sum += part[(w2 * 2 + bb) * 24 + c2];
            mod[bb * 6 * DM + j0 + c2] = sum + bia[j0 + c2]; }
        __syncthreads();
    }
}

__device__ void ph_norm(const P& p, const float* src, const float* g, int which, bf16_t* dst) {
    const float* mod = (const float*)(p.ws + WS_MOD);
    const int lane = otid() & 63, wv = otid() >> 6;
    const int gw = blockIdx.x * (NTHR / 64) + wv, nw = gridDim.x * (NTHR / 64);
    for (int m = gw; m < NT; m += nw) {
        const int b = m / SEQ;
        const float* sh = mod + b * 6 * DM + (which ? 3 * DM : 0);
        const float* sc = sh + DM;
        const float4* xr = (const float4*)(src + (size_t)m * DM);
        float4 v[4]; float ss = 0.f;
#pragma unroll
        for (int j = 0; j < 4; ++j) { v[j] = xr[lane + 64 * j]; ss += v[j].x * v[j].x + v[j].y * v[j].y + v[j].z * v[j].z + v[j].w * v[j].w; }
        ss = wave_sum(ss);
        const float rstd = rsqrtf(ss * (1.f / DM) + NORM_EPS);
        float o[16];
#pragma unroll
        for (int j = 0; j < 4; ++j) {
            int c0 = 4 * (lane + 64 * j); asm volatile("" : "+v"(c0));
            const float4 gg = *(const float4*)(g + c0), s1 = *(const float4*)(sc + c0), s0 = *(const float4*)(sh + c0);
            o[4 * j + 0] = v[j].x * rstd * gg.x * (1.f + s1.x) + s0.x; o[4 * j + 1] = v[j].y * rstd * gg.y * (1.f + s1.y) + s0.y;
            o[4 * j + 2] = v[j].z * rstd * gg.z * (1.f + s1.z) + s0.z; o[4 * j + 3] = v[j].w * rstd * gg.w * (1.f + s1.w) + s0.w;
            uint2 pk; pk.x = (unsigned)f2bf(o[4 * j]) | ((unsigned)f2bf(o[4 * j + 1]) << 16); pk.y = (unsigned)f2bf(o[4 * j + 2]) | ((unsigned)f2bf(o[4 * j + 3]) << 16);
            *(uint2*)(dst + (size_t)m * DM + c0) = pk;
        }
    }
}

__device__ void ph_norm_route(const P& p, float* lds) {
    const float* mod = (const float*)(p.ws + WS_MOD); const float* src = p.out; const float* g = p.in[24]; bf16_t* dst = (bf16_t*)(p.ws + WS_XN2);
    const float* wgr = p.in[25]; const float* wer = p.in[26]; const float* eb = p.in[27];
    const int tid = otid(), lane = tid & 63, wv = tid >> 6;
    float* sx = lds + wv * 4096;
    int* cntL = (int*)(lds + 8 * 4096);
    if (tid < 64) cntL[tid] = 0;
    __syncthreads();
    const int TPB = NT / gridDim.x;
    for (int m0 = blockIdx.x * TPB + wv * 4; m0 < (blockIdx.x + 1) * TPB; m0 += 8 * 4) {
        const int b = m0 / SEQ;
        const float* sh = mod + b * 6 * DM + 3 * DM; const float* sc = sh + DM;
#pragma unroll 1
        for (int tk = 0; tk < 4; ++tk) {
            const int m = m0 + tk;
            const float4* xr = (const float4*)(src + (size_t)m * DM);
            float4 v[4]; float ss = 0.f;
#pragma unroll
            for (int j = 0; j < 4; ++j) { v[j] = xr[lane + 64 * j]; ss += v[j].x * v[j].x + v[j].y * v[j].y + v[j].z * v[j].z + v[j].w * v[j].w; }
            ss = wave_sum(ss);
            const float rstd = rsqrtf(ss * (1.f / DM) + NORM_EPS);
#pragma unroll
            for (int j = 0; j < 4; ++j) {
                const int c0 = 4 * (lane + 64 * j);
                const float4 gg = *(const float4*)(g + c0), s1 = *(const float4*)(sc + c0), s0 = *(const float4*)(sh + c0);
                const float o0 = v[j].x * rstd * gg.x * (1.f + s1.x) + s0.x, o1 = v[j].y * rstd * gg.y * (1.f + s1.y) + s0.y;
                const float o2 = v[j].z * rstd * gg.z * (1.f + s1.z) + s0.z, o3 = v[j].w * rstd * gg.w * (1.f + s1.w) + s0.w;
                uint2 pk; pk.x = (unsigned)f2bf(o0) | ((unsigned)f2bf(o1) << 16); pk.y = (unsigned)f2bf(o2) | ((unsigned)f2bf(o3) << 16);
                *(uint2*)(dst + (size_t)m * DM + c0) = pk;
                sx[(c0 + 0) * 4 + tk] = o0; sx[(c0 + 1) * 4 + tk] = o1; sx[(c0 + 2) * 4 + tk] = o2; sx[(c0 + 3) * 4 + tk] = o3;
            }
        }
        __builtin_amdgcn_wave_barrier(); asm volatile("s_waitcnt lgkmcnt(0)" ::: "memory");
        float ae[4] = {0.f, 0.f, 0.f, 0.f}, ag[4] = {0.f, 0.f, 0.f, 0.f};
        { const int e = lane & 31, kb = (lane >> 5) * 512;
#pragma unroll 8
          for (int i = 0; i < 512; ++i) { const float w = wer[(size_t)(kb + i) * 32 + e]; const float4 xv = *(const float4*)(sx + (kb + i) * 4);
              ae[0] += xv.x * w; ae[1] += xv.y * w; ae[2] += xv.z * w; ae[3] += xv.w * w; } }
        { const int gq = lane & 3, kb = (lane >> 2) * 64;
#pragma unroll 8
          for (int i = 0; i < 64; ++i) { const float w = wgr[(size_t)(kb + i) * 4 + gq]; const float4 xv = *(const float4*)(sx + (kb + i) * 4);
              ag[0] += xv.x * w; ag[1] += xv.y * w; ag[2] += xv.z * w; ag[3] += xv.w * w; } }
#pragma unroll
        for (int tk = 0; tk < 4; ++tk) {
            ae[tk] += __shfl_xor(ae[tk], 32);
            ag[tk] += __shfl_xor(ag[tk], 4); ag[tk] += __shfl_xor(ag[tk], 8); ag[tk] += __shfl_xor(ag[tk], 16); ag[tk] += __shfl_xor(ag[tk], 32);
        }
#pragma unroll
        for (int tk = 0; tk < 4; ++tk) {
            float lg[4];
#pragma unroll
            for (int q = 0; q < 4; ++q) lg[q] = __shfl(ag[tk], q);
            int gs = 0; float mx = lg[0];
#pragma unroll
            for (int q = 1; q < 4; ++q) if (lg[q] > mx) { mx = lg[q]; gs = q; }
            float den = 0.f;
#pragma unroll
            for (int q = 0; q < 4; ++q) den += __expf(lg[q] - mx);
            const float pg = 1.f / den;
            float ev[8];
#pragma unroll
            for (int q = 0; q < 8; ++q) ev[q] = __shfl(ae[tk], gs * 8 + q) + eb[gs * 8 + q];
            int i0 = 0; float v0 = ev[0];
#pragma unroll
            for (int q = 1; q < 8; ++q) if (ev[q] > v0) { v0 = ev[q]; i0 = q; }
            int i1 = -1; float v1 = -INFINITY;
#pragma unroll
            for (int q = 0; q < 8; ++q) if (q != i0 && ev[q] > v1) { v1 = ev[q]; i1 = q; }
            if (lane == 0) {
                const float e1 = __expf(v1 - v0), w0 = pg / (1.f + e1), w1 = pg * e1 / (1.f + e1);
                const int x0 = gs * 8 + i0, x1 = gs * 8 + i1;
                const int rk0 = atomicAdd(&cntL[x0], 1), rk1 = atomicAdd(&cntL[32 + x1], 1);
                int4* route = (int4*)(p.ws + WS_ROUTE) + (size_t)(m0 + tk);
                *route = make_int4(x0 | (x1 << 8), rk0 | (rk1 << 16), __float_as_int(w0), __float_as_int(w1));
            }
        }
        __builtin_amdgcn_wave_barrier();
    }
    __syncthreads();
    if (tid < 64) ((int*)(p.ws + WS_CTL) + CT_CNTB)[blockIdx.x * 64 + tid] = cntL[tid];
}

namespace pg8 {
#define PG8_LAS __attribute__((address_space(3)))
typedef short bf16x8 __attribute__((ext_vector_type(8)));
typedef float f32x4 __attribute__((ext_vector_type(4)));
typedef unsigned u32x4 __attribute__((ext_vector_type(4)));
constexpr int BM = 256, BK = 64, HALF = 128, HTB = HALF * BK * 2, STAGE_BYTES = 8 * HTB, NXCD = 8, WGM = 8;
__host__ __device__ __forceinline__ int lds_byte(int r, int c) { const int st = (r >> 4) * 2 + (c >> 5), rr = r & 15, cc = c & 31, ob = rr * 64 + cc * 2; return st * 1024 + (ob ^ (((ob >> 9) & 1) << 5)); }
__host__ __device__ __forceinline__ void stage_rc(int b, int& R, int& C) { const int st = b / 1024, sb = b % 1024, swz = sb ^ (((sb >> 9) & 1) << 5); R = (st >> 1) * 16 + swz / 64; C = (st & 1) * 32 + (swz % 64) / 2; }
__host__ __device__ __forceinline__ int perm32(int rho) { const int n = rho >> 4, i = rho & 15; return 8 * (i >> 2) + 4 * n + (i & 3); }

struct Unit { int arow, brow, pm, pn, aux; };
struct Gemm { const bf16_t* A; const bf16_t* Bt; int K; const int* gather; };

struct StaticOrder {
    int nM, nN, nwg, G, c;
    __device__ void init(int M, int N, int G_, int c_) { nM = M / BM; nN = N / BM; nwg = nM * nN; G = G_; c = c_; }
    __device__ bool next(int i, Unit& u) const {
        const long L = (long)i * G + c; if (L >= nwg) return false;
        int wgid = (int)L; { const int q = nwg / NXCD, r = nwg % NXCD, xcd = wgid % NXCD, off = wgid / NXCD; wgid = (xcd < r ? xcd * (q + 1) : r * (q + 1) + (xcd - r) * q) + off; }
        const int nig = WGM * nN, gid = wgid / nig, fm = gid * WGM, gsz = (nM - fm) < WGM ? (nM - fm) : WGM;
        u.pm = fm + ((wgid % nig) % gsz); u.pn = (wgid % nig) / gsz; u.arow = u.pm * BM; u.brow = u.pn * BM; u.aux = 0; return true;
    }
};
struct BranchOrder {
    StaticOrder S0;
    __device__ bool next(int i, Unit& u) const {
        if (!S0.next(i >> 1, u)) return false;
        const int which = i & 1; u.arow += which * NT; u.brow += which * DM; u.aux = which; return true;
    }
};
struct TableOrder {
    const int4* tab; int n, G, c;
    __device__ bool next(int i, Unit& u) const {
        const int L = i * G + c; if (L >= n) return false;
        const int4 e = tab[L]; u.arow = __builtin_amdgcn_readfirstlane(e.x); u.brow = __builtin_amdgcn_readfirstlane(e.y); u.aux = __builtin_amdgcn_readfirstlane(e.z); u.pn = __builtin_amdgcn_readfirstlane(e.w); u.pm = 0; return true;
    }
};
__device__ __forceinline__ unsigned cvt_pk_bf16(float lo, float hi) { unsigned r; asm volatile("v_cvt_pk_bf16_f32 %0, %1, %2" : "=v"(r) : "v"(lo), "v"(hi)); return r; }

template <class Epi, class Sched>
__device__ __forceinline__ void gemm_phase(PG8_LAS unsigned char* lds, const Gemm g, const Sched& S, const Epi& E) {
    const int tid = otid(), wid = __builtin_amdgcn_readfirstlane(tid >> 6), lane = tid & 63, wr = wid >> 2, wc = wid & 3, fr = lane & 15, fq = lane >> 4;
    const int K = g.K, nt = K / BK;
    int RA0; unsigned cofA0, voffB0;
    { int R, C; stage_rc(tid * 16, R, C); const int Rb = Epi::PERM ? ((R & ~31) + perm32(R & 31)) : R; RA0 = R; cofA0 = (unsigned)C * 2u; voffB0 = (unsigned)(Rb * K + C) * 2u; }
    const size_t rstep64 = (size_t)64 * K * 2;
    const size_t kstep = (size_t)(BK * 2);
    const size_t hstep = (size_t)HALF * K * 2;
    const unsigned ldsw = (unsigned)wid * 1024u;
    const int aoff = lds_byte(wr * 64 + fr, fq * 8), boff = lds_byte(wc * 32 + fr, fq * 8);
#define PG8_SA(b, h) (((b) * 2 + (h)) * HTB)
#define PG8_SB(b, h) ((4 + (b) * 2 + (h)) * HTB)
#define PG8_STAGE_B(bufoff, gbase) do { _Pragma("unroll") for (int _i = 0; _i < 2; ++_i) \
        __builtin_amdgcn_global_load_lds((const unsigned*)((const char*)(gbase) + _i * rstep64 + voffB0), (PG8_LAS unsigned*)(lds + (bufoff) + ldsw + _i * 8192), 16, 0, 0); } while (0)
#define PG8_STAGE_A(bufoff, o2, kb) do { _Pragma("unroll") for (int _i = 0; _i < 2; ++_i) \
        __builtin_amdgcn_global_load_lds((const unsigned*)((const char*)g.A + (size_t)(o2)[_i] + (size_t)(kb)), (PG8_LAS unsigned*)(lds + (bufoff) + ldsw + _i * 8192), 16, 0, 0); } while (0)
#define PG8_LDA(dst, b, h) do { _Pragma("unroll") for (int m = 0; m < 4; ++m) _Pragma("unroll") for (int k = 0; k < 2; ++k) dst[m][k] = *(const PG8_LAS bf16x8*)(lds + PG8_SA(b, h) + aoff + m * 2048 + k * 1024); } while (0)
#define PG8_LDB(dst, b, h) do { _Pragma("unroll") for (int n = 0; n < 2; ++n) _Pragma("unroll") for (int k = 0; k < 2; ++k) dst[n][k] = *(const PG8_LAS bf16x8*)(lds + PG8_SB(b, h) + boff + n * 2048 + k * 1024); } while (0)
#define PG8_MMA(ai, bj, At, Bt) do { __builtin_amdgcn_s_setprio(1); _Pragma("unroll") for (int m = 0; m < 4; ++m) _Pragma("unroll") for (int n = 0; n < 2; ++n) _Pragma("unroll") for (int k = 0; k < 2; ++k) \
        acc[ai][bj][m][n] = __builtin_amdgcn_mfma_f32_16x16x32_bf16(Bt[n][k], At[m][k], acc[ai][bj][m][n], 0, 0, 0); __builtin_amdgcn_s_setprio(0); } while (0)
#define PG8_WAIT_V(n) asm volatile("s_waitcnt vmcnt(" #n ")" ::: "memory")
#define PG8_WAIT_L(n) asm volatile("s_waitcnt lgkmcnt(" #n ")" ::: "memory")
#define PG8_BAR __builtin_amdgcn_s_barrier()
#define PG8_SCHED __builtin_amdgcn_sched_barrier(0)
#define PG8_AOFFS(u, dst) do { _Pragma("unroll") for (int _h = 0; _h < 2; ++_h) _Pragma("unroll") for (int _i = 0; _i < 2; ++_i) { \
        const int _tr = (u).arow + _h * HALF + RA0 + 64 * _i; const unsigned _row = g.gather ? (unsigned)g.gather[_tr] : (unsigned)_tr; dst[_h][_i] = _row * (unsigned)(K * 2) + cofA0; } } while (0)
    Unit cur, nxt; int ui = 0;
    if (!S.next(0, cur)) return;
    f32x4 acc[2][2][4][2];
#pragma unroll
    for (int a = 0; a < 2; ++a)
#pragma unroll
        for (int b = 0; b < 2; ++b)
#pragma unroll
            for (int m = 0; m < 4; ++m)
#pragma unroll
                for (int n = 0; n < 2; ++n) acc[a][b][m][n] = (f32x4){0.f, 0.f, 0.f, 0.f};
    bf16x8 At[4][2], B0[2][2], B1[2][2];
    unsigned cof[2][2];
    PG8_AOFFS(cur, cof);
    const char* cB = (const char*)g.Bt + (size_t)cur.brow * K * 2;
    PG8_STAGE_B(PG8_SB(0, 0), cB); PG8_STAGE_B(PG8_SB(0, 1), cB + hstep); PG8_STAGE_A(PG8_SA(0, 0), cof[0], 0); PG8_STAGE_A(PG8_SA(0, 1), cof[1], 0);
    if (wr == 1) PG8_BAR;
    PG8_WAIT_V(2); PG8_BAR;
    PG8_STAGE_B(PG8_SB(1, 0), cB + kstep); PG8_STAGE_A(PG8_SA(1, 0), cof[0], kstep); PG8_STAGE_B(PG8_SB(1, 1), cB + hstep + kstep);
    PG8_WAIT_V(6); PG8_BAR;
    for (;;) {
        const bool has_next = S.next(ui + 1, nxt);
        if (!has_next) nxt = cur;
        const char* nB = (const char*)g.Bt + (size_t)nxt.brow * K * 2;
        for (int t = 0; t < nt; t += 2) {
            const bool last = (t == nt - 2);
            const size_t k1 = (size_t)(t + 1) * kstep;
            const size_t k2 = last ? 0 : (size_t)(t + 2) * kstep, k3 = k2 + kstep;
            const char* b2 = last ? nB : cB + (size_t)(t + 2) * kstep; const char* b3 = b2 + kstep;
            PG8_LDB(B0, 0, 0); PG8_LDB(B1, 0, 1); PG8_SCHED; PG8_LDA(At, 0, 0); PG8_STAGE_A(PG8_SA(1, 1), cof[1], k1);
            if (last) { PG8_AOFFS(nxt, cof); }
            PG8_WAIT_V(8); PG8_WAIT_L(0); PG8_BAR; PG8_MMA(0, 0, At, B0); PG8_MMA(0, 1, At, B1); PG8_BAR; PG8_SCHED;
            PG8_LDA(At, 0, 1); PG8_STAGE_B(PG8_SB(0, 0), b2); PG8_STAGE_B(PG8_SB(0, 1), b2 + hstep); PG8_STAGE_A(PG8_SA(0, 0), cof[0], k2);
            PG8_WAIT_V(8); PG8_WAIT_L(0); PG8_BAR; PG8_MMA(1, 0, At, B0); PG8_MMA(1, 1, At, B1); PG8_BAR; PG8_SCHED;
            PG8_LDB(B0, 1, 0); PG8_LDB(B1, 1, 1); PG8_SCHED; PG8_LDA(At, 1, 0); PG8_STAGE_A(PG8_SA(0, 1), cof[1], k2);
            PG8_WAIT_V(8); PG8_WAIT_L(0); PG8_BAR; PG8_MMA(0, 0, At, B0); PG8_MMA(0, 1, At, B1); PG8_BAR; PG8_SCHED;
            PG8_LDA(At, 1, 1); PG8_STAGE_B(PG8_SB(1, 0), b3); PG8_STAGE_B(PG8_SB(1, 1), b3 + hstep); PG8_STAGE_A(PG8_SA(1, 0), cof[0], k3);
            PG8_WAIT_V(8); PG8_WAIT_L(0); PG8_BAR; PG8_MMA(1, 0, At, B0); PG8_MMA(1, 1, At, B1); PG8_BAR; PG8_SCHED;
        }
        if (wr == 0) PG8_BAR;
        { const int l2 = otid() & 63; E(acc, cur, wr, wc, l2 & 15, l2 >> 4); }
        if (!has_next) break;
#pragma unroll
        for (int a = 0; a < 2; ++a)
#pragma unroll
            for (int b = 0; b < 2; ++b)
#pragma unroll
                for (int m = 0; m < 4; ++m)
#pragma unroll
                    for (int n = 0; n < 2; ++n) acc[a][b][m][n] = (f32x4){0.f, 0.f, 0.f, 0.f};
        cur = nxt; cB = nB; ++ui;
        if (wr == 1) PG8_BAR;
    }
    PG8_WAIT_V(0);
    PG8_BAR;
#undef PG8_SA
#undef PG8_SB
#undef PG8_STAGE_A
#undef PG8_STAGE_B
#undef PG8_LDA
#undef PG8_LDB
#undef PG8_MMA
#undef PG8_WAIT_V
#undef PG8_WAIT_L
#undef PG8_BAR
#undef PG8_SCHED
#undef PG8_AOFFS
}

#define PG8_FENCE asm volatile("" ::: "memory")
#define PG8_FOR_TILE(ai, m, bj) _Pragma("unroll") for (int ai = 0; ai < 2; ++ai) _Pragma("unroll") for (int m = 0; m < 4; ++m) _Pragma("unroll") for (int bj = 0; bj < 2; ++bj)
__device__ __forceinline__ u32x4 pack8(const f32x4& v0, const f32x4& v1) { u32x4 w; w.x = cvt_pk_bf16(v0[0], v0[1]); w.y = cvt_pk_bf16(v0[2], v0[3]); w.z = cvt_pk_bf16(v1[0], v1[1]); w.w = cvt_pk_bf16(v1[2], v1[3]); return w; }
__device__ __forceinline__ float sigm(float x) { return 1.f / (1.f + __expf(-x)); }
struct EpiInproj {
    static constexpr bool PERM = true;
    unsigned char* ws; bf16_t* gates;
    __device__ __forceinline__ void operator()(const f32x4 (&acc)[2][2][4][2], const Unit& u, int wr, int wc, int fr, int fq) const {
        PG8_FOR_TILE(ai, m, bj) { PG8_FENCE;
            int row = u.pm * BM + ai * HALF + wr * 64 + m * 16 + fr; asm volatile("" : "+v"(row)); const int col = u.pn * BM + bj * HALF + wc * 32 + 8 * fq;
            const f32x4 v0 = acc[ai][bj][m][0], v1 = acc[ai][bj][m][1];
            if (col < C_KV) *(u32x4*)((bf16_t*)(ws + WS_Q) + (size_t)row * AW + col) = pack8(v0, v1);
            else if (col < C_QI) {
                *(u32x4*)((bf16_t*)(ws + WS_KVN) + (size_t)row * KVL + (col - C_KV)) = pack8(v0, v1);
                float ss = (v0[0] * v0[0] + v0[1] * v0[1]) + (v0[2] * v0[2] + v0[3] * v0[3]) + (v1[0] * v1[0] + v1[1] * v1[1]) + (v1[2] * v1[2] + v1[3] * v1[3]);
                ss += __shfl_xor(ss, 16); ss += __shfl_xor(ss, 32);
                if (fq == 0) atomicAdd((float*)(ws + WS_RSS) + row, ss);
            }
            else if (col < C_PS) {
                if (col < 1056) {
                    typedef _Float16 h8 __attribute__((ext_vector_type(8)));
                    h8 hv; hv[0] = (_Float16)v0[0]; hv[1] = (_Float16)v0[1]; hv[2] = (_Float16)v0[2]; hv[3] = (_Float16)v0[3]; hv[4] = (_Float16)v1[0]; hv[5] = (_Float16)v1[1]; hv[6] = (_Float16)v1[2]; hv[7] = (_Float16)v1[3];
                    _Float16* d = (col < 1024) ? (_Float16*)(ws + WS_QI) + (size_t)row * 256 + (col - C_QI) : (_Float16*)(ws + WS_KI) + (size_t)row * 32 + (col - 1024);
                    *(h8*)d = hv;
                } else { const float sc_ = 0.17677669529663687f * 0.35355339059327373f; float* d = (float*)(ws + WS_WI) + (size_t)row * 8; *(f32x4*)d = v0 * sc_; *(f32x4*)(d + 4) = v1 * sc_; }
            }
            else if (col < C_GA) *(u32x4*)((bf16_t*)(ws + WS_PS) + (size_t)row * SHW + (col - C_PS)) = pack8(v0, v1);
            else if (col < INW) {
                f32x4 s0, s1;
#pragma unroll
                for (int e = 0; e < 4; ++e) { s0[e] = sigm(v0[e]); s1[e] = sigm(v1[e]); }
                bf16_t* d = (col < C_GR) ? gates + (size_t)row * DM + (col - C_GA) : gates + (size_t)NT * DM + (size_t)row * DM + (col - C_GR);
                *(u32x4*)d = pack8(s0, s1);
            }
        }
    }
};
struct EpiKV {
    static constexpr bool PERM = true;
    unsigned char* ws;
    __device__ __forceinline__ void operator()(const f32x4 (&acc)[2][2][4][2], const Unit& u, int wr, int wc, int fr, int fq) const {
        PG8_FOR_TILE(ai, m, bj) { PG8_FENCE;
            int row = u.pm * BM + ai * HALF + wr * 64 + m * 16 + fr; asm volatile("" : "+v"(row)); const int col = u.pn * BM + bj * HALF + wc * 32 + 8 * fq;
            const float rstd = rsqrtf(((const float*)(ws + WS_RSS))[row] * (1.f / KVL) + NORM_EPS);
            if (col < AW) *(u32x4*)((bf16_t*)(ws + WS_K) + (size_t)row * AW + col) = pack8(acc[ai][bj][m][0] * rstd, acc[ai][bj][m][1] * rstd);
            else {
                bf16_t* d = (bf16_t*)(ws + WS_V) + ((size_t)(row / SEQ) * 512 + (col - AW)) * SEQ + (row % SEQ);
#pragma unroll
                for (int e = 0; e < 4; ++e) { d[(size_t)e * SEQ] = f2bf(acc[ai][bj][m][0][e] * rstd); d[(size_t)(4 + e) * SEQ] = f2bf(acc[ai][bj][m][1][e] * rstd); }
            }
        }
    }
};
struct EpiMerge {
    static constexpr bool PERM = true;
    bf16_t* merged; const bf16_t* gates;
    __device__ __forceinline__ void operator()(const f32x4 (&acc)[2][2][4][2], const Unit& u, int wr, int wc, int fr, int fq) const {
        const bf16_t* gate = gates + (size_t)u.aux * NT * DM;
        PG8_FOR_TILE(ai, m, bj) { PG8_FENCE;
            int row = u.pm * BM + ai * HALF + wr * 64 + m * 16 + fr; asm volatile("" : "+v"(row)); const int col = u.pn * BM + bj * HALF + wc * 32 + 8 * fq;
            const u32x4 gw = *(const u32x4*)(gate + (size_t)row * DM + col);
            f32x4 v0 = acc[ai][bj][m][0], v1 = acc[ai][bj][m][1];
            v0[0] *= __uint_as_float(gw.x << 16); v0[1] *= __uint_as_float(gw.x & 0xffff0000u); v0[2] *= __uint_as_float(gw.y << 16); v0[3] *= __uint_as_float(gw.y & 0xffff0000u);
            v1[0] *= __uint_as_float(gw.z << 16); v1[1] *= __uint_as_float(gw.z & 0xffff0000u); v1[2] *= __uint_as_float(gw.w << 16); v1[3] *= __uint_as_float(gw.w & 0xffff0000u);
            u32x4* d = (u32x4*)(merged + (size_t)row * DM + col);
            if (u.aux) { const u32x4 pw = *d;
                v0[0] += __uint_as_float(pw.x << 16); v0[1] += __uint_as_float(pw.x & 0xffff0000u); v0[2] += __uint_as_float(pw.y << 16); v0[3] += __uint_as_float(pw.y & 0xffff0000u);
                v1[0] += __uint_as_float(pw.z << 16); v1[1] += __uint_as_float(pw.z & 0xffff0000u); v1[2] += __uint_as_float(pw.w << 16); v1[3] += __uint_as_float(pw.w & 0xffff0000u); }
            *d = pack8(v0, v1);
        }
    }
};
struct EpiOut {
    static constexpr bool PERM = false;
    const float* x; const float* mod; float* out;
    __device__ __forceinline__ void operator()(const f32x4 (&acc)[2][2][4][2], const Unit& u, int wr, int wc, int fr, int fq) const {
        PG8_FOR_TILE(ai, m, bj) { PG8_FENCE;
            int row = u.pm * BM + ai * HALF + wr * 64 + m * 16 + fr; asm volatile("" : "+v"(row)); const float* gt = mod + (row / SEQ) * 6 * DM + 2 * DM;
#pragma unroll
            for (int n = 0; n < 2; ++n) { const int col = u.pn * BM + bj * HALF + wc * 32 + 16 * n + 4 * fq;
                const f32x4 xv = *(const f32x4*)(x + (size_t)row * DM + col), gv = *(const f32x4*)(gt + col);
                *(f32x4*)(out + (size_t)row * DM + col) = xv + gv * acc[ai][bj][m][n]; }
        }
    }
};
struct EpiMoe1 {
    static constexpr bool PERM = true;
    bf16_t* hid; const float* lw;
    __device__ __forceinline__ void operator()(const f32x4 (&acc)[2][2][4][2], const Unit& u, int wr, int wc, int fr, int fq) const {
#pragma unroll
        for (int ai = 0; ai < 2; ++ai)
#pragma unroll
            for (int m = 0; m < 4; ++m) {
                const int tr = ai * HALF + wr * 64 + m * 16 + fr; PG8_FENCE;
                if (tr < u.aux) {
                    const float w = lw[u.arow + tr]; f32x4 h0, h1;
#pragma unroll
                    for (int e = 0; e < 4; ++e) { const float g0 = acc[ai][0][m][0][e], g1 = acc[ai][0][m][1][e];
                        h0[e] = w * (g0 / (1.f + __expf(-g0))) * acc[ai][1][m][0][e]; h1[e] = w * (g1 / (1.f + __expf(-g1))) * acc[ai][1][m][1][e]; }
                    *(u32x4*)(hid + (size_t)(u.arow + tr) * DE + u.pn * HALF + wc * 32 + 8 * fq) = pack8(h0, h1);
                }
            }
    }
};
struct EpiMoe2 {
    static constexpr bool PERM = false;
    const int* ltok; const float* mod; float* out;
    __device__ __forceinline__ void operator()(const f32x4 (&acc)[2][2][4][2], const Unit& u, int wr, int wc, int fr, int fq) const {
#pragma unroll
        for (int ai = 0; ai < 2; ++ai)
#pragma unroll
            for (int m = 0; m < 4; ++m) {
                const int tr = ai * HALF + wr * 64 + m * 16 + fr; PG8_FENCE;
                if (tr < u.aux) {
                    const int tok = ltok[u.arow + tr]; const float* gt = mod + (tok / SEQ) * 6 * DM + 5 * DM; float* orow = out + (size_t)tok * DM;
#pragma unroll
                    for (int bj = 0; bj < 2; ++bj)
#pragma unroll
                        for (int n = 0; n < 2; ++n) { const int col = u.pn * BM + bj * HALF + wc * 32 + 16 * n + 4 * fq;
                            const f32x4 gv = *(const f32x4*)(gt + col); f32x4* d = (f32x4*)(orow + col); *d = *d + gv * acc[ai][bj][m][n]; }
                }
            }
    }
};
}

__device__ __forceinline__ unsigned pk2(float lo, float hi) { return (unsigned)f2bf(lo) | ((unsigned)f2bf(hi) << 16); }
__device__ __forceinline__ void transpose_item(const float* W, int K, int N, bf16_t* WT, size_t drow0, int k0, int n0, float* scr, int lane, int Ksrc = 1 << 30, const float* kscale = nullptr) {
#pragma unroll 8
    for (int i = 0; i < 32; ++i) { const int kk = 2 * i + (lane >> 5), n = n0 + (lane & 31); float v_ = (n < N && k0 + kk < Ksrc) ? W[(size_t)(k0 + kk) * N + n] : 0.f; if (kscale) v_ *= kscale[k0 + kk]; scr[kk * 33 + (lane & 31)] = v_; }
    asm volatile("s_waitcnt lgkmcnt(0)" ::: "memory");
    const int c = lane & 7;
#pragma unroll
    for (int j = 0; j < 4; ++j) { const int n = (lane >> 3) + 8 * j; const float* s_ = scr + (8 * c) * 33 + n;
        uint4 o; o.x = pk2(s_[0 * 33], s_[1 * 33]); o.y = pk2(s_[2 * 33], s_[3 * 33]); o.z = pk2(s_[4 * 33], s_[5 * 33]); o.w = pk2(s_[6 * 33], s_[7 * 33]);
        *(uint4*)(WT + (drow0 + n) * K + k0 + 8 * c) = o; }
    asm volatile("s_waitcnt lgkmcnt(0)" ::: "memory");
}
__device__ void ph_convert_mixer_weights(const P& p, float* lds) {
    const int lane = otid() & 63, wv = otid() >> 6;
    float* scr = lds + wv * (64 * 33);
    const int gw = blockIdx.x * (NTHR / 64) + wv, nw = gridDim.x * (NTHR / 64);
    struct M { const float* W; int K, N, Npad; size_t dst; const float* ks; };
    const M ms[5] = { {p.in[5], DM, INW, 5120, WS_WIN, nullptr}, {p.in[7], KVL, 2 * AW, 2 * AW, WS_WKV, p.in[6]}, {p.in[21], AW, DM, DM, WS_WBA, nullptr}, {p.in[22], RW, DM, DM, WS_WBR, nullptr}, {p.in[23], DM, DM, DM, WS_WOUT, nullptr} };
    int base = 0;
#pragma unroll
    for (int q = 0; q < 5; ++q) {
        const int nkb = ms[q].K / 64, nnb = ms[q].Npad / 32, nitems = nkb * nnb;
        for (int it = gw; it < base + nitems; it += nw) { if (it < base) continue; const int r = it - base; const int kb = r / nnb, nb = r % nnb;
            transpose_item(ms[q].W, ms[q].K, ms[q].N, (bf16_t*)(p.ws + ms[q].dst), (size_t)nb * 32, kb * 64, nb * 32, scr, lane, 1 << 30, ms[q].ks); }
        base += nitems;
    }
}
__device__ void ph_convert_lora_weights(const P& p, float* lds) {
    const int lane = otid() & 63, wv = otid() >> 6;
    float* scr = lds + wv * (64 * 33);
    const int gw = blockIdx.x * (NTHR / 64) + wv, nw = gridDim.x * (NTHR / 64);
    for (int it = gw; it < 16 + 16 + 48; it += nw) {
        if (it < 16) transpose_item(p.in[12], 64, RW, (bf16_t*)(p.ws + WS_LW2T), (size_t)it * 32, 0, it * 32, scr, lane);
        else if (it < 32) transpose_item(p.in[14], 64, RW, (bf16_t*)(p.ws + WS_LA2T), (size_t)(it - 16) * 32, 0, (it - 16) * 32, scr, lane);
        else { const int r = it - 32, kb = r >> 4, nb = r & 15; transpose_item(p.in[15], 192, RW, (bf16_t*)(p.ws + WS_LG2T), (size_t)nb * 32, kb * 64, nb * 32, scr, lane, 160); }
    }
}
__device__ void ph_convert_expert_weights(const P& p, float* lds) {
    const int lane = otid() & 63, wv = otid() >> 6;
    float* scr = lds + wv * (64 * 33);
    const int gw = blockIdx.x * (NTHR / 64) + wv, nw = gridDim.x * (NTHR / 64);
    for (int it = gw; it < NE * 2 * 256; it += nw) { const int e = it >> 9, which = (it >> 8) & 1, r = it & 255, kb = r >> 4, nb = r & 15, n0 = nb * 32;
        transpose_item(p.in[28 + which] + (size_t)e * DM * DE, DM, DE, (bf16_t*)(p.ws + WS_WGU), (size_t)e * 1024 + (n0 >> 7) * 256 + which * 128 + (n0 & 127), kb * 64, n0, scr, lane); }
    for (int it = gw; it < NE * 256; it += nw) { const int e = it >> 8, r = it & 255, kb = r >> 5, nb = r & 31;
        transpose_item(p.in[30] + (size_t)e * DE * DM, DE, DM, (bf16_t*)(p.ws + WS_WDN), (size_t)e * 1024 + nb * 32, kb * 64, nb * 32, scr, lane); }
}

__device__ void ph_headnorm(bf16_t* X, const float* g) {
    const int lane = otid() & 63, wv = otid() >> 6;
    const int gw = blockIdx.x * (NTHR / 64) + wv, nw = gridDim.x * (NTHR / 64);
    for (int m = gw; m < NT; m += nw) {
        uint4 raw = *(const uint4*)(X + (size_t)m * AW + lane * 8);
        float v[8] = {bf2f(raw.x & 0xffff), bf2f(raw.x >> 16), bf2f(raw.y & 0xffff), bf2f(raw.y >> 16), bf2f(raw.z & 0xffff), bf2f(raw.z >> 16), bf2f(raw.w & 0xffff), bf2f(raw.w >> 16)};
        float ss = 0.f;
#pragma unroll
        for (int i = 0; i < 8; ++i) ss += v[i] * v[i];
        ss += __shfl_xor(ss, 1); ss += __shfl_xor(ss, 2); ss += __shfl_xor(ss, 4);
        const float rstd = rsqrtf(ss * (1.f / 64.f) + NORM_EPS);
        const int d0 = (lane & 7) * 8;
        unsigned o[4];
#pragma unroll
        for (int i = 0; i < 4; ++i) o[i] = (unsigned)f2bf(v[2 * i] * rstd * g[d0 + 2 * i]) | ((unsigned)f2bf(v[2 * i + 1] * rstd * g[d0 + 2 * i + 1]) << 16);
        *(uint4*)(X + (size_t)m * AW + lane * 8) = make_uint4(o[0], o[1], o[2], o[3]);
    }
}
__device__ void ph_kvnorm(bf16_t* X, const float* g) {
    const int lane = otid() & 63, wv = otid() >> 6;
    const int gw = blockIdx.x * (NTHR / 64) + wv, nw = gridDim.x * (NTHR / 64);
    for (int m = gw; m < NT; m += nw) {
        uint2 raw = *(const uint2*)(X + (size_t)m * KVL + lane * 4);
        float v[4] = {bf2f(raw.x & 0xffff), bf2f(raw.x >> 16), bf2f(raw.y & 0xffff), bf2f(raw.y >> 16)};
        float ss = wave_sum(v[0] * v[0] + v[1] * v[1] + v[2] * v[2] + v[3] * v[3]);
        const float rstd = rsqrtf(ss * (1.f / 256.f) + NORM_EPS);
        uint2 o; o.x = (unsigned)f2bf(v[0] * rstd * g[lane * 4]) | ((unsigned)f2bf(v[1] * rstd * g[lane * 4 + 1]) << 16);
        o.y = (unsigned)f2bf(v[2] * rstd * g[lane * 4 + 2]) | ((unsigned)f2bf(v[3] * rstd * g[lane * 4 + 3]) << 16);
        *(uint2*)(X + (size_t)m * KVL + lane * 4) = o;
    }
}

typedef _Float16 half8_t __attribute__((ext_vector_type(8)));
typedef float f32x16_t __attribute__((ext_vector_type(16)));
__device__ __forceinline__ unsigned f2key(float f) { unsigned u = __float_as_uint(f); return (u & 0x80000000u) ? ~u : (u | 0x80000000u); }
__device__ void ph_dsa_select(const P& p, float* ldsf) {
    const _Float16* QI = (const _Float16*)(p.ws + WS_QI); const _Float16* KI = (const _Float16*)(p.ws + WS_KI); const float* WI = (const float*)(p.ws + WS_WI);
    unsigned long long* MASK = (unsigned long long*)(p.ws + WS_MASK);
    unsigned* sc = (unsigned*)ldsf;
    unsigned* hist = sc + 4 * 8192;
    int* misc = (int*)(hist + 4 * 256);
    const int tid = otid(), lane = tid & 63, wv = tid >> 6, hh = lane >> 5, r32 = lane & 31;
    for (int item = blockIdx.x; item < NT / 4; item += gridDim.x) {
        const int tq0 = item * 4, b = tq0 / SEQ, t0 = tq0 % SEQ;
        __syncthreads();
        const int row = wv >> 1, wr = wv & 1;
        const int tr_ = t0 + row, nr = tr_ + 1;
        const int nwords = ((tr_ >> 8) + 1) * 4;
        unsigned long long* mrow = MASK + (size_t)(tq0 + row) * 128;
        if (t0 + 3 < TOPK) {
            for (int wi = wr; wi < nwords; wi += 2) { const int s_ = wi * 64 + lane; const unsigned long long mk = __ballot(s_ <= tr_); if (lane == 0) mrow[wi] = mk; }
            continue;
        }
        {
            const int tl_a = r32 >> 3, h_a = r32 & 7;
            half8_t a0 = *(const half8_t*)(QI + (size_t)(tq0 + tl_a) * 256 + h_a * 32 + 8 * hh), a1 = *(const half8_t*)(QI + (size_t)(tq0 + tl_a) * 256 + h_a * 32 + 16 + 8 * hh);
            float w[4][4];
#pragma unroll
            for (int tl = 0; tl < 4; ++tl) { const float4 wv4 = *(const float4*)(WI + (size_t)(tq0 + tl) * 8 + 4 * hh); w[tl][0] = wv4.x; w[tl][1] = wv4.y; w[tl][2] = wv4.z; w[tl][3] = wv4.w; }
            const int ntile = (t0 + 3) / 32 + 1;
            for (int tile = wv; tile < ntile; tile += 8) {
                const int key = tile * 32 + r32;
                const _Float16* kp = KI + (size_t)(b * SEQ + key) * 32 + 8 * hh;
                const half8_t b0 = *(const half8_t*)kp, b1 = *(const half8_t*)(kp + 16);
                f32x16_t c;
#pragma unroll
                for (int i = 0; i < 16; ++i) c[i] = 0.f;
                c = __builtin_amdgcn_mfma_f32_32x32x16_f16(a0, b0, c, 0, 0, 0);
                c = __builtin_amdgcn_mfma_f32_32x32x16_f16(a1, b1, c, 0, 0, 0);
                float x[4];
#pragma unroll
                for (int tl = 0; tl < 4; ++tl) { x[tl] = 0.f;
#pragma unroll
                    for (int e = 0; e < 4; ++e) x[tl] += w[tl][e] * fmaxf(c[4 * tl + e], 0.f); }
                const auto s01 = __builtin_amdgcn_permlane32_swap(__float_as_uint(x[0]), __float_as_uint(x[1]), false, false);
                const auto s23 = __builtin_amdgcn_permlane32_swap(__float_as_uint(x[2]), __float_as_uint(x[3]), false, false);
                const float v01 = __uint_as_float(s01[0]) + __uint_as_float(s01[1]);
                const float v23 = __uint_as_float(s23[0]) + __uint_as_float(s23[1]);
                sc[(hh) * 8192 + key] = (key <= t0 + hh) ? f2key(v01) : 0u;
                sc[(2 + hh) * 8192 + key] = (key <= t0 + 2 + hh) ? f2key(v23) : 0u;
            }
        }
        __syncthreads();
        unsigned prefix = 0; int remaining = TOPK, cnt_eq = 0;
        const int t128 = wr * 64 + lane;
        const unsigned* scr = sc + row * 8192; unsigned* hrow = hist + row * 256; int* mrw = misc + row * 8;
#pragma unroll 1
        for (int pass = 0; pass < 4; ++pass) {
            const int shift = 24 - 8 * pass;
            for (int i = t128; i < 256; i += 128) hrow[i] = 0u;
            __syncthreads();
            for (int s_ = t128; s_ < nr; s_ += 128) { const unsigned k = scr[s_]; if (pass == 0 || (k >> (shift + 8)) == (prefix >> (shift + 8))) atomicAdd(&hrow[(k >> shift) & 255u], 1u); }
            __syncthreads();
            if (wr == 0) {
                const unsigned h0 = hrow[4 * lane], h1 = hrow[4 * lane + 1], h2 = hrow[4 * lane + 2], h3 = hrow[4 * lane + 3];
                unsigned suf = h0 + h1 + h2 + h3;
#pragma unroll
                for (int o = 1; o < 64; o <<= 1) { const unsigned oth = __shfl_down(suf, o); if (lane + o < 64) suf += oth; }
                const unsigned above3 = suf - (h0 + h1 + h2 + h3);
                const unsigned ab[4] = {above3 + h3 + h2 + h1, above3 + h3 + h2, above3 + h3, above3}; const unsigned hv[4] = {h0, h1, h2, h3};
#pragma unroll
                for (int q = 0; q < 4; ++q) if ((int)ab[q] < remaining && remaining <= (int)(ab[q] + hv[q])) { mrw[0] = 4 * lane + q; mrw[1] = remaining - (int)ab[q]; mrw[2] = (int)hv[q]; }
            }
            __syncthreads();
            prefix |= ((unsigned)mrw[0]) << shift; remaining = mrw[1]; cnt_eq = mrw[2];
        }
        if (cnt_eq == remaining) {
            for (int wi = wr; wi < nwords; wi += 2) { const int s_ = wi * 64 + lane; const bool f = (s_ < nr) && (scr[s_ & 8191] >= prefix); const unsigned long long mk = __ballot(f); if (lane == 0) mrow[wi] = mk; }
        } else if (wr == 0) {
            int taken = 0;
            for (int wi = 0; wi < nwords; ++wi) { const int s_ = wi * 64 + lane; const unsigned k = (s_ < nr) ? scr[s_ & 8191] : 0u; const bool eq = (s_ < nr) && (k == prefix);
                const unsigned long long me = __ballot(eq); const int pre = __popcll(me & ((1ull << lane) - 1ull));
                const bool f = (s_ < nr) && (k > prefix || (eq && taken + pre < remaining));
                const unsigned long long mk = __ballot(f); if (lane == 0) mrow[wi] = mk; taken += __popcll(me); }
        }
    }
}

typedef unsigned u32x4_t __attribute__((ext_vector_type(4)));
typedef __bf16 bf2_t __attribute__((ext_vector_type(2)));
typedef float f2_t __attribute__((ext_vector_type(2)));
__device__ __forceinline__ unsigned pk_bf16(float lo, float hi) { const f2_t v = {lo, hi}; return __builtin_bit_cast(unsigned, __builtin_convertvector(v, bf2_t)); }
__device__ __forceinline__ bf16x8_t pack_step16(const f32x16_t& x, int s2) {
    u32x4_t pk;
    if (s2 == 0) { pk[0] = pk_bf16(x[0], x[1]); pk[1] = pk_bf16(x[2], x[3]); pk[2] = pk_bf16(x[4], x[5]); pk[3] = pk_bf16(x[6], x[7]); }
    else { pk[0] = pk_bf16(x[8], x[9]); pk[1] = pk_bf16(x[10], x[11]); pk[2] = pk_bf16(x[12], x[13]); pk[3] = pk_bf16(x[14], x[15]); }
    return __builtin_bit_cast(bf16x8_t, pk);
}
__device__ __forceinline__ float xhalf_max(float x) { const auto t = __builtin_amdgcn_permlane32_swap(__float_as_uint(x), __float_as_uint(x), false, false); return fmaxf(__uint_as_float(t[0]), __uint_as_float(t[1])); }
__device__ __forceinline__ float xhalf_sum(float x) { const auto t = __builtin_amdgcn_permlane32_swap(__float_as_uint(x), __float_as_uint(x), false, false); return __uint_as_float(t[0]) + __uint_as_float(t[1]); }
__device__ __forceinline__ short bf16_of_int(int v) { return (short)(__float_as_uint((float)v) >> 16); }
#define MFMA32(a, b, c) __builtin_amdgcn_mfma_f32_32x32x16_bf16((a), (b), (c), 0, 0, 0)
__device__ void ph_dsa_attn(const P& p, float* ldsf) {
    const unsigned long long* MASK = (const unsigned long long*)(p.ws + WS_MASK);
    const bf16_t* Q = (const bf16_t*)(p.ws + WS_Q); const bf16_t* Kg = (const bf16_t*)(p.ws + WS_K); const bf16_t* VT = (const bf16_t*)(p.ws + WS_V);
    bf16_t* O = (bf16_t*)(p.ws + WS_OATT);
    bf16_t* L = (bf16_t*)ldsf;
    const int tid = otid(), lane = tid & 63, wv = tid >> 6, hh = lane >> 5, r32 = lane & 31;
    const float CS = 0.125f * 1.4426950408889634f;
    const float NEG = -1e30f;
    const int skey = tid >> 3, sch = (tid & 7) * 8;
    const float* qg = p.in[8];
    float kgv[8]; { const float4 g0 = *(const float4*)(p.in[9] + sch), g1 = *(const float4*)(p.in[9] + sch + 4); kgv[0] = g0.x; kgv[1] = g0.y; kgv[2] = g0.z; kgv[3] = g0.w; kgv[4] = g1.x; kgv[5] = g1.y; kgv[6] = g1.z; kgv[7] = g1.w; }
    auto knorm = [&](uint4 kr) -> uint4 {
        const unsigned w[4] = {kr.x, kr.y, kr.z, kr.w}; float v[8]; float ss = 0.f;
#pragma unroll
        for (int e = 0; e < 8; ++e) { v[e] = (e & 1) ? __uint_as_float(w[e >> 1] & 0xffff0000u) : __uint_as_float(w[e >> 1] << 16); ss += v[e] * v[e]; }
        ss += __shfl_xor(ss, 1); ss += __shfl_xor(ss, 2); ss += __shfl_xor(ss, 4);
        const float rstd = rsqrtf(ss * (1.f / 64.f) + NORM_EPS);
        return make_uint4(pk_bf16(v[0] * rstd * kgv[0], v[1] * rstd * kgv[1]), pk_bf16(v[2] * rstd * kgv[2], v[3] * rstd * kgv[3]), pk_bf16(v[4] * rstd * kgv[4], v[5] * rstd * kgv[5]), pk_bf16(v[6] * rstd * kgv[6], v[7] * rstd * kgv[7]));
    };
    int* qhead = (int*)(p.ws + WS_CTL) + CT_Q; int* bcast = (int*)(L + 4 * SLOT);
    for (int tr_ = 0; tr_ < 8; ++tr_) {
        const int grp = (blockIdx.x + tr_) & 7;
        for (;;) {
            __syncthreads();
            if (tid == 0) *bcast = atomicAdd(qhead + grp, 1);
            __syncthreads();
            const int kq = *bcast;
            if (kq >= 64) break;
            const int bh = grp + 8 * (kq & 1), qb = 31 - (kq >> 1), b = bh >> 3, h = bh & 7;
            const bf16_t* Kbase = Kg + (size_t)b * SEQ * AW + h * 64; const bf16_t* Vbase = VT + (size_t)bh * 64 * SEQ;
            {
            const int q0 = qb * 256 + wv * 32, q = q0 + r32, ntile = 4 * (qb + 1);
            const size_t qrow = (size_t)b * SEQ + q;
            bf16x8_t bq[5];
#pragma unroll
            for (int s2 = 0; s2 < 4; ++s2) bq[s2] = *(const bf16x8_t*)(Q + qrow * AW + h * 64 + 16 * s2 + 8 * hh);
            {
                float ss = 0.f;
#pragma unroll
                for (int s2 = 0; s2 < 4; ++s2)
#pragma unroll
                    for (int j = 0; j < 8; ++j) { const float v = bf2f((bf16_t)bq[s2][j]); ss += v * v; }
                ss = xhalf_sum(ss);
                const float rstd = rsqrtf(ss * (1.f / 64.f) + NORM_EPS);
#pragma unroll
                for (int s2 = 0; s2 < 4; ++s2) { const float4 g0 = *(const float4*)(qg + 16 * s2 + 8 * hh), g1 = *(const float4*)(qg + 16 * s2 + 8 * hh + 4); const float gv[8] = {g0.x, g0.y, g0.z, g0.w, g1.x, g1.y, g1.z, g1.w};
                    u32x4_t w;
#pragma unroll
                    for (int j2 = 0; j2 < 4; ++j2) w[j2] = pk_bf16(bf2f((bf16_t)bq[s2][2 * j2]) * rstd * gv[2 * j2], bf2f((bf16_t)bq[s2][2 * j2 + 1]) * rstd * gv[2 * j2 + 1]);
                    bq[s2] = __builtin_bit_cast(bf16x8_t, w); }
            }
#pragma unroll
            for (int j = 0; j < 8; ++j) bq[4][j] = 0;
            if (hh == 0) { bq[4][0] = bf16_of_int(256 >> h); bq[4][1] = (short)(__float_as_uint(4.f / (float)(1 << h)) >> 16); }
            f32x16_t o0, o1;
#pragma unroll
            for (int i = 0; i < 16; ++i) { o0[i] = 0.f; o1[i] = 0.f; }
            float m_run = NEG, l_run = 0.f;
            __syncthreads();
            { const uint4 kr = *(const uint4*)(Kbase + (size_t)skey * AW + sch), vr = *(const uint4*)(Vbase + (size_t)skey * SEQ + sch);
              *(uint4*)(L + skey * LP + sch) = knorm(kr); *(uint4*)(L + 2 * SLOT + skey * LP + sch) = vr; }
            unsigned long long mw = MASK[qrow * 128];
            __syncthreads();
#pragma unroll 1
            for (int kt = 0; kt < ntile; ++kt) {
                const int buf = kt & 1; const bool more = kt + 1 < ntile;
                uint4 kr = make_uint4(0, 0, 0, 0), vr = make_uint4(0, 0, 0, 0); unsigned long long mwn = 0ull;
                if (more) { kr = *(const uint4*)(Kbase + (size_t)((kt + 1) * 64 + skey) * AW + sch); vr = *(const uint4*)(Vbase + (size_t)skey * SEQ + (kt + 1) * 64 + sch); mwn = MASK[qrow * 128 + kt + 1]; }
                if (kt * 64 <= q0 + 31) {
                    const bf16_t* Kl = L + buf * SLOT; const bf16_t* Vl = L + (2 + buf) * SLOT;
                    f32x16_t p0, p1;
#pragma unroll
                    for (int i = 0; i < 16; ++i) { p0[i] = 0.f; p1[i] = 0.f; }
#pragma unroll
                    for (int s2 = 0; s2 < 4; ++s2) {
                        const bf16x8_t a0 = *(const bf16x8_t*)(Kl + r32 * LP + 16 * s2 + 8 * hh), a1 = *(const bf16x8_t*)(Kl + (32 + r32) * LP + 16 * s2 + 8 * hh);
                        p0 = MFMA32(a0, bq[s2], p0); p1 = MFMA32(a1, bq[s2], p1);
                    }
                    { bf16x8_t g0, g1;
#pragma unroll
                      for (int j = 0; j < 8; ++j) { g0[j] = 0; g1[j] = 0; }
                      if (hh == 0) { g0[0] = bf16_of_int(kt); g0[1] = bf16_of_int(r32); g1[0] = g0[0]; g1[1] = bf16_of_int(32 + r32); }
                      p0 = MFMA32(g0, bq[4], p0); p1 = MFMA32(g1, bq[4], p1); }
                    const unsigned wl = (unsigned)mw >> (4 * hh), wh = (unsigned)(mw >> 32) >> (4 * hh);
                    float mx = NEG;
#pragma unroll
                    for (int i = 0; i < 16; ++i) { const int bp = (i & 3) + 8 * (i >> 2);
                        const int m0 = ((int)(wl << (31 - bp))) >> 31, m1 = ((int)(wh << (31 - bp))) >> 31;
                        p0[i] = __uint_as_float((__float_as_uint(p0[i]) & (unsigned)m0) | (__float_as_uint(NEG) & ~(unsigned)m0));
                        p1[i] = __uint_as_float((__float_as_uint(p1[i]) & (unsigned)m1) | (__float_as_uint(NEG) & ~(unsigned)m1));
                        mx = fmaxf(mx, fmaxf(p0[i], p1[i])); }
                    mx = xhalf_max(mx);
                    const float m_new = fmaxf(m_run, mx);
                    const float alpha = __builtin_amdgcn_exp2f((m_run - m_new) * CS);
                    m_run = m_new;
                    const float mc = fmaxf(m_new, -1e20f) * CS;
                    float rs = 0.f;
#pragma unroll
                    for (int i = 0; i < 16; ++i) { p0[i] = __builtin_amdgcn_exp2f(p0[i] * CS - mc); p1[i] = __builtin_amdgcn_exp2f(p1[i] * CS - mc); rs += p0[i] + p1[i]; }
                    l_run = l_run * alpha + rs;
#pragma unroll
                    for (int i = 0; i < 16; ++i) { o0[i] *= alpha; o1[i] *= alpha; }
                    bf16x8_t pb[4];
                    pb[0] = pack_step16(p0, 0); pb[1] = pack_step16(p0, 1); pb[2] = pack_step16(p1, 0); pb[3] = pack_step16(p1, 1);
#pragma unroll
                    for (int ks = 0; ks < 4; ++ks) {
                        const int kofs = 32 * (ks >> 1) + 16 * (ks & 1) + 4 * hh;
                        typedef short s16x4_t __attribute__((ext_vector_type(4)));
                        const s16x4_t v00 = *(const s16x4_t*)(Vl + r32 * LP + kofs), v01 = *(const s16x4_t*)(Vl + r32 * LP + kofs + 8);
                        const s16x4_t v10 = *(const s16x4_t*)(Vl + (32 + r32) * LP + kofs), v11 = *(const s16x4_t*)(Vl + (32 + r32) * LP + kofs + 8);
                        bf16x8_t av0, av1;
#pragma unroll
                        for (int j = 0; j < 4; ++j) { av0[j] = v00[j]; av0[4 + j] = v01[j]; av1[j] = v10[j]; av1[4 + j] = v11[j]; }
                        o0 = MFMA32(av0, pb[ks], o0); o1 = MFMA32(av1, pb[ks], o1);
                    }
                }
                if (more) { *(uint4*)(L + (buf ^ 1) * SLOT + skey * LP + sch) = knorm(kr); *(uint4*)(L + (2 + (buf ^ 1)) * SLOT + skey * LP + sch) = vr; }
                mw = mwn;
                __syncthreads();
            }
            const float inv = 1.f / xhalf_sum(l_run);
            bf16_t* orow = O + qrow * AW + h * 64 + 4 * hh;
#pragma unroll
            for (int g = 0; g < 4; ++g) {
                uint2 w0, w1;
                w0.x = (unsigned)f2bf(o0[4 * g] * inv) | ((unsigned)f2bf(o0[4 * g + 1] * inv) << 16); w0.y = (unsigned)f2bf(o0[4 * g + 2] * inv) | ((unsigned)f2bf(o0[4 * g + 3] * inv) << 16);
                w1.x = (unsigned)f2bf(o1[4 * g] * inv) | ((unsigned)f2bf(o1[4 * g + 1] * inv) << 16); w1.y = (unsigned)f2bf(o1[4 * g + 2] * inv) | ((unsigned)f2bf(o1[4 * g + 3] * inv) << 16);
                *(uint2*)(orow + 8 * g) = w0; *(uint2*)(orow + 32 + 8 * g) = w1;
            }
            }
        }
    }
}

constexpr int AP = 328, RP = 1544;
__device__ __forceinline__ f32x4_t mm16(const bf16_t* X, int xrs, const bf16_t* Y, int ycs, int nks, f32x4_t acc, int lane) {
    const int r = lane & 15, q = lane >> 4;
    for (int s2 = 0; s2 < nks; ++s2) {
        const bf16x8_t a = *(const bf16x8_t*)(X + r * xrs + 32 * s2 + 8 * q), b = *(const bf16x8_t*)(Y + r * ycs + 32 * s2 + 8 * q);
        acc = __builtin_amdgcn_mfma_f32_16x16x32_bf16(a, b, acc, 0, 0, 0);
    }
    return acc;
}
__device__ void ph_rwkv_prep(const P& p, float* ldsf, int blk_first, int blk_end, int blk_step) {
    const bf16_t* PS = (const bf16_t*)(p.ws + WS_PS);
    const float* mu = p.in[10]; const float* w0 = p.in[11]; const float* a0 = p.in[13]; const float* k_k = p.in[16]; const float* k_a = p.in[17];
    const bf16_t* W2T = (const bf16_t*)(p.ws + WS_LW2T); const bf16_t* A2T = (const bf16_t*)(p.ws + WS_LA2T); const bf16_t* G2T = (const bf16_t*)(p.ws + WS_LG2T);
    bf16_t* R = (bf16_t*)(p.ws + WS_R); bf16_t* K2 = (bf16_t*)(p.ws + WS_K2); bf16_t* VV = (bf16_t*)(p.ws + WS_VV); bf16_t* KK = (bf16_t*)(p.ws + WS_KK); bf16_t* BB = (bf16_t*)(p.ws + WS_BB);
    bf16_t* G = (bf16_t*)(p.ws + WS_G); float* DD = (float*)(p.ws + WS_DD);
    bf16_t* Amix = (bf16_t*)ldsf; bf16_t* RKV = Amix + 32 * AP;
    const int tid = otid(), lane = tid & 63, wv = tid >> 6, l15 = lane & 15, q4 = lane >> 4;
    for (int blk = blk_first; blk < blk_end; blk += blk_step) {
        const int m0 = blk * 32;
        __syncthreads();
        for (int ch = tid; ch < 32 * 228; ch += NTHR) {
            const int tk = ch / 228, c8 = (ch % 228) * 8, m = m0 + tk;
            const uint4 cu = *(const uint4*)(PS + (size_t)m * SHW + c8);
            uint4 pv = make_uint4(0, 0, 0, 0); if (m % SEQ) pv = *(const uint4*)(PS + (size_t)(m - 1) * SHW + c8);
            const unsigned cw[4] = {cu.x, cu.y, cu.z, cu.w}, pw[4] = {pv.x, pv.y, pv.z, pv.w};
            const float4 mu0 = *(const float4*)(mu + c8), mu1 = *(const float4*)(mu + c8 + 4); const float muv[8] = {mu0.x, mu0.y, mu0.z, mu0.w, mu1.x, mu1.y, mu1.z, mu1.w};
            float mx[8];
#pragma unroll
            for (int e = 0; e < 8; ++e) { const float c_ = (e & 1) ? __uint_as_float(cw[e >> 1] & 0xffff0000u) : __uint_as_float(cw[e >> 1] << 16), p_ = (e & 1) ? __uint_as_float(pw[e >> 1] & 0xffff0000u) : __uint_as_float(pw[e >> 1] << 16);
                mx[e] = c_ + (p_ - c_) * muv[e]; }
            bf16_t* dst;
            if (c8 < 1536) dst = RKV + tk * RP + c8;
            else { const int col = c8 - 1536; dst = Amix + tk * AP + col;
#pragma unroll
                for (int e = 0; e < 8; ++e) mx[e] = (col < 64) ? tanhf(mx[e]) : ((col < 128) ? mx[e] : sigmoidf_(mx[e])); }
            *(uint4*)dst = make_uint4(pk2(mx[0], mx[1]), pk2(mx[2], mx[3]), pk2(mx[4], mx[5]), pk2(mx[6], mx[7]));
        }
        if (tid < 128) *(uint4*)(Amix + (tid >> 2) * AP + 288 + (tid & 3) * 8) = make_uint4(0, 0, 0, 0);
        __syncthreads();
        const int h = wv;
#pragma unroll 1
        for (int rt = 0; rt < 2; ++rt) {
            f32x4_t aw[4], aa[4], ag[4];
            const f32x4_t z4 = {0.f, 0.f, 0.f, 0.f};
#pragma unroll
            for (int ct = 0; ct < 4; ++ct) { const int cb = 64 * h + 16 * ct;
                aw[ct] = mm16(Amix + 16 * rt * AP, AP, W2T + (size_t)cb * 64, 64, 2, z4, lane);
                aa[ct] = mm16(Amix + 16 * rt * AP + 64, AP, A2T + (size_t)cb * 64, 64, 2, z4, lane);
                ag[ct] = mm16(Amix + 16 * rt * AP + 128, AP, G2T + (size_t)cb * 192, 192, 6, z4, lane); }
            float ss[4] = {0.f, 0.f, 0.f, 0.f}; float kkr[4][4];
#pragma unroll
            for (int ct = 0; ct < 4; ++ct) { const int c = 64 * h + 16 * ct + l15; const float kkc = k_k[c];
#pragma unroll
                for (int e = 0; e < 4; ++e) { const float k = bf2f(RKV[(16 * rt + 4 * q4 + e) * RP + 512 + c]); kkr[ct][e] = k * kkc; ss[e] += kkr[ct][e] * kkr[ct][e]; } }
#pragma unroll
            for (int e = 0; e < 4; ++e) { ss[e] += __shfl_xor(ss[e], 1); ss[e] += __shfl_xor(ss[e], 2); ss[e] += __shfl_xor(ss[e], 4); ss[e] += __shfl_xor(ss[e], 8); ss[e] = 1.f / fmaxf(sqrtf(ss[e]), 1e-12f); }
#pragma unroll
            for (int ct = 0; ct < 4; ++ct) { const int c = 64 * h + 16 * ct + l15; const float w0c = w0[c], a0c = a0[c], kac = k_a[c];
#pragma unroll
                for (int e = 0; e < 4; ++e) { const int tk = 16 * rt + 4 * q4 + e;
                    const float r = bf2f(RKV[tk * RP + c]), k = bf2f(RKV[tk * RP + 512 + c]), v = bf2f(RKV[tk * RP + 1024 + c]);
                    const float xw = -(w0c + aw[ct][e]);
                    const float sp = fmaxf(xw, 0.f) + log1pf(__expf(-fabsf(xw)));
                    const float w = -sp - 0.5f;
                    const float a = sigmoidf_(a0c + aa[ct][e]);
                    const float kk = kkr[ct][e] * ss[e];
                    const size_t o = (size_t)(m0 + tk) * RW + c;
                    R[o] = f2bf(r); K2[o] = f2bf(k * (1.f + (a - 1.f) * kac)); VV[o] = f2bf(v); KK[o] = f2bf(kk); BB[o] = f2bf(kk * a); G[o] = f2bf(ag[ct][e]); DD[o] = -__expf(w);
                } }
        }
    }
}

template <bool XC, bool YC>
__device__ __forceinline__ f32x4_t mm_tile(const bf16_t* X, int xrs, int xcs, const bf16_t* Y, int yrs, int ycs, int tr, int tc, f32x4_t acc, int lane) {
    const int r = lane & 15, q = lane >> 4;
#pragma unroll
    for (int s2 = 0; s2 < 2; ++s2) {
        bf16x8_t a, b;
        const bf16_t* xp = X + (16 * tr + r) * xrs + (32 * s2 + 8 * q) * xcs;
        if (XC) a = *(const bf16x8_t*)xp; else {
#pragma unroll
            for (int j = 0; j < 8; ++j) a[j] = (short)xp[j * xcs]; }
        const bf16_t* yp = Y + (32 * s2 + 8 * q) * yrs + (16 * tc + r) * ycs;
        if (YC) b = *(const bf16x8_t*)yp; else {
#pragma unroll
            for (int j = 0; j < 8; ++j) b[j] = (short)yp[j * yrs]; }
        acc = __builtin_amdgcn_mfma_f32_16x16x32_bf16(a, b, acc, 0, 0, 0);
    }
    return acc;
}
__device__ __forceinline__ void st_tile(const f32x4_t& acc, bf16_t* D, int drs, int dcs, int tr, int tc, int lane) {
    const int row0 = 16 * tr + 4 * (lane >> 4), col = 16 * tc + (lane & 15);
#pragma unroll
    for (int e = 0; e < 4; ++e) D[(row0 + e) * drs + col * dcs] = f2bf(acc[e]);
}
__device__ __forceinline__ f32x4_t ld_tile(const bf16_t* D, int drs, int dcs, int tr, int tc, int lane) {
    const int row0 = 16 * tr + 4 * (lane >> 4), col = 16 * tc + (lane & 15); f32x4_t v;
#pragma unroll
    for (int e = 0; e < 4; ++e) v[e] = bf2f(D[(row0 + e) * drs + col * dcs]);
    return v;
}
template <bool STRICT> __device__ __forceinline__ void triu_tile(f32x4_t& acc, int tr, int tc, int lane) {
    const int row0 = 16 * tr + 4 * (lane >> 4), col = 16 * tc + (lane & 15);
#pragma unroll
    for (int e = 0; e < 4; ++e) { const bool keep = STRICT ? (row0 + e < col) : (row0 + e <= col); acc[e] = keep ? acc[e] : 0.f; }
}

__device__ void ph_rwkv_r1(const P& p, float* ldsf, int ch_first, int ch_end, int ch_step) {
    const bf16_t* R = (const bf16_t*)(p.ws + WS_R); const bf16_t* K2 = (const bf16_t*)(p.ws + WS_K2); const bf16_t* VV = (const bf16_t*)(p.ws + WS_VV);
    const bf16_t* KK = (const bf16_t*)(p.ws + WS_KK); const bf16_t* BB = (const bf16_t*)(p.ws + WS_BB); const float* DD = (const float*)(p.ws + WS_DD);
    bf16_t* L = (bf16_t*)ldsf;
    bf16_t* At = L + 0 * SLOT; bf16_t* Bt = L + 1 * SLOT; bf16_t* Kt = L + 2 * SLOT; bf16_t* Rt = L + 3 * SLOT; bf16_t* Vm = L + 4 * SLOT; bf16_t* Bh = L + 5 * SLOT; bf16_t* Kh = L + 6 * SLOT;
    bf16_t* S7 = L + 7 * SLOT; bf16_t* S8 = L + 8 * SLOT; bf16_t* S9 = L + 9 * SLOT; bf16_t* S10 = L + 10 * SLOT; bf16_t* S11 = L + 11 * SLOT;
    float* cs = (float*)(L + 12 * SLOT);
    float* segs = cs + 64 * 65;
    const int tid = otid(), lane = tid & 63, wv = tid >> 6;
    const int t0 = 2 * wv, t1 = 2 * wv + 1;
    for (int ch = ch_first; ch < ch_end; ch += ch_step) {
        const int bh = ch >> 7, c = ch & 127, b = bh >> 3, h = bh & 7;
        const size_t gbase = ((size_t)b * SEQ + (size_t)c * 64) * RW + h * 64;
        bf16_t* G1T = (bf16_t*)(p.ws + WS_KK) + gbase; bf16_t* PT = (bf16_t*)(p.ws + WS_BB) + gbase; bf16_t* G2T = (bf16_t*)(p.ws + WS_DD) + 2 * gbase; bf16_t* QT = G2T + 64;
        __syncthreads();
        const int st = tid >> 3, sj = (tid & 7) * 8;
        { const float4 l0 = *(const float4*)(DD + gbase + (size_t)st * RW + sj), l1 = *(const float4*)(DD + gbase + (size_t)st * RW + sj + 4);
          float* d = cs + st * 65 + sj; d[0] = l0.x; d[1] = l0.y; d[2] = l0.z; d[3] = l0.w; d[4] = l1.x; d[5] = l1.y; d[6] = l1.z; d[7] = l1.w; }
        __syncthreads();
        { const int j = tid & 63, sg = tid >> 6; float run = 0.f;
#pragma unroll
          for (int i = 0; i < 8; ++i) { run += cs[(sg * 8 + i) * 65 + j]; }
          segs[sg * 64 + j] = run; }
        __syncthreads();
        { const int j = tid & 63, sg = tid >> 6; float run = 0.f;
          for (int q = 0; q < sg; ++q) run += segs[q * 64 + j];
#pragma unroll
          for (int i = 0; i < 8; ++i) { run += cs[(sg * 8 + i) * 65 + j]; cs[(sg * 8 + i) * 65 + j] = run; } }
        __syncthreads();
        {
            const uint4 rr = *(const uint4*)(R + gbase + (size_t)st * RW + sj), kr = *(const uint4*)(K2 + gbase + (size_t)st * RW + sj), vr = *(const uint4*)(VV + gbase + (size_t)st * RW + sj);
            const uint4 kkr = *(const uint4*)(KK + gbase + (size_t)st * RW + sj), br = *(const uint4*)(BB + gbase + (size_t)st * RW + sj);
            const unsigned rw_[4] = {rr.x, rr.y, rr.z, rr.w}, kw_[4] = {kr.x, kr.y, kr.z, kr.w}, kkw_[4] = {kkr.x, kkr.y, kkr.z, kkr.w}, bw_[4] = {br.x, br.y, br.z, br.w};
            *(uint4*)(Vm + st * LP + sj) = vr;
            unsigned oa[4], ob[4], ok[4], orr[4], obh[4], okh[4];
#pragma unroll
            for (int e2 = 0; e2 < 4; ++e2) {
                float va[2], vb[2], vk[2], vr2[2], vbh[2], vkh[2];
#pragma unroll
                for (int hf = 0; hf < 2; ++hf) {
                    const int j = sj + 2 * e2 + hf;
                    const float lgI = cs[st * 65 + j], lgE = st ? cs[(st - 1) * 65 + j] : 0.f, gl = cs[63 * 65 + j];
                    const float rv = hf ? __uint_as_float(rw_[e2] & 0xffff0000u) : __uint_as_float(rw_[e2] << 16);
                    const float kv = hf ? __uint_as_float(kw_[e2] & 0xffff0000u) : __uint_as_float(kw_[e2] << 16);
                    const float kkv = hf ? __uint_as_float(kkw_[e2] & 0xffff0000u) : __uint_as_float(kkw_[e2] << 16);
                    const float bv = hf ? __uint_as_float(bw_[e2] & 0xffff0000u) : __uint_as_float(bw_[e2] << 16);
                    const float einv = __expf(-lgI), eh = __expf(gl - lgI);
                    va[hf] = -kkv * __expf(lgE); vb[hf] = bv * einv; vk[hf] = kv * einv; vr2[hf] = rv * __expf(lgI); vbh[hf] = bv * eh; vkh[hf] = kv * eh;
                }
                oa[e2] = (unsigned)f2bf(va[0]) | ((unsigned)f2bf(va[1]) << 16); ob[e2] = (unsigned)f2bf(vb[0]) | ((unsigned)f2bf(vb[1]) << 16);
                ok[e2] = (unsigned)f2bf(vk[0]) | ((unsigned)f2bf(vk[1]) << 16); orr[e2] = (unsigned)f2bf(vr2[0]) | ((unsigned)f2bf(vr2[1]) << 16);
                obh[e2] = (unsigned)f2bf(vbh[0]) | ((unsigned)f2bf(vbh[1]) << 16); okh[e2] = (unsigned)f2bf(vkh[0]) | ((unsigned)f2bf(vkh[1]) << 16);
            }
            *(uint4*)(At + st * LP + sj) = make_uint4(oa[0], oa[1], oa[2], oa[3]); *(uint4*)(Bt + st * LP + sj) = make_uint4(ob[0], ob[1], ob[2], ob[3]);
            *(uint4*)(Kt + st * LP + sj) = make_uint4(ok[0], ok[1], ok[2], ok[3]); *(uint4*)(Rt + st * LP + sj) = make_uint4(orr[0], orr[1], orr[2], orr[3]);
            *(uint4*)(Bh + st * LP + sj) = make_uint4(obh[0], obh[1], obh[2], obh[3]); *(uint4*)(Kh + st * LP + sj) = make_uint4(okh[0], okh[1], okh[2], okh[3]);
        }
        __syncthreads();
#define R1_FOR_TILES(idx, tr, tc) _Pragma("unroll") for (int _q = 0; _q < 2; ++_q) { const int idx = _q ? t1 : t0; const int tr = idx >> 2, tc = idx & 3;
#define R1_END }
        const f32x4_t zero4 = {0.f, 0.f, 0.f, 0.f};
        R1_FOR_TILES(idx, tr, tc)
            f32x4_t mab = mm_tile<true, true>(Bt, LP, 1, At, 1, LP, tr, tc, zero4, lane); triu_tile<true>(mab, tr, tc, lane); st_tile(mab, S7, LP, 1, tr, tc, lane);
            { f32x4_t tt = mab; const int row0 = 16 * tr + 4 * (lane >> 4), col = 16 * tc + (lane & 15);
#pragma unroll
              for (int e = 0; e < 4; ++e) tt[e] += (row0 + e == col) ? 1.f : 0.f;
              st_tile(tt, S11, LP, 1, tr, tc, lane); }
            f32x4_t mka = mm_tile<true, true>(Kt, LP, 1, At, 1, LP, tr, tc, zero4, lane); triu_tile<true>(mka, tr, tc, lane); st_tile(mka, S8, LP, 1, tr, tc, lane);
            f32x4_t nbr = mm_tile<true, true>(Bt, LP, 1, Rt, 1, LP, tr, tc, zero4, lane); triu_tile<false>(nbr, tr, tc, lane); st_tile(nbr, S9, LP, 1, tr, tc, lane);
            f32x4_t nkr = mm_tile<true, true>(Kt, LP, 1, Rt, 1, LP, tr, tc, zero4, lane); triu_tile<false>(nkr, tr, tc, lane); st_tile(nkr, S10, LP, 1, tr, tc, lane);
        R1_END
        __syncthreads();
        bf16_t* Pc = S7; bf16_t* Pn = Kt; bf16_t* Tc = S11; bf16_t* Tn = Bt;
#pragma unroll 1
        for (int lvl = 0; lvl < 5; ++lvl) {
            R1_FOR_TILES(idx, tr, tc)
                f32x4_t pp = mm_tile<true, false>(Pc, LP, 1, Pc, LP, 1, tr, tc, zero4, lane); st_tile(pp, Pn, LP, 1, tr, tc, lane);
            R1_END
            __syncthreads();
            R1_FOR_TILES(idx, tr, tc)
                f32x4_t tn = ld_tile(Tc, LP, 1, tr, tc, lane); tn = mm_tile<true, false>(Tc, LP, 1, Pn, LP, 1, tr, tc, tn, lane); st_tile(tn, Tn, LP, 1, tr, tc, lane);
            R1_END
            __syncthreads();
            bf16_t* x_ = Pc; Pc = Pn; Pn = x_; x_ = Tc; Tc = Tn; Tn = x_;
        }
        bf16_t* W1 = Pc; bf16_t* W2 = Pn; bf16_t* Qk = Tn;
        R1_FOR_TILES(idx, tr, tc)
            f32x4_t w1 = mm_tile<false, false>(At, 1, LP, Tc, LP, 1, tr, tc, zero4, lane); st_tile(w1, W1, LP, 1, tr, tc, lane);
            f32x4_t w2 = mm_tile<true, false>(S8, LP, 1, Tc, LP, 1, tr, tc, zero4, lane); st_tile(w2, W2, LP, 1, tr, tc, lane);
        R1_END
        __syncthreads();
        R1_FOR_TILES(idx, tr, tc)
            f32x4_t g1 = ld_tile(Rt, 1, LP, tr, tc, lane); g1 = mm_tile<true, false>(W1, LP, 1, S9, LP, 1, tr, tc, g1, lane); st_tile(g1, G1T, 1, RW, tr, tc, lane);
            f32x4_t g2 = ld_tile(S10, LP, 1, tr, tc, lane); g2 = mm_tile<true, false>(W2, LP, 1, S9, LP, 1, tr, tc, g2, lane); st_tile(g2, G2T, 1, 2 * RW, tr, tc, lane);
            f32x4_t pm = mm_tile<true, false>(W1, LP, 1, Bh, LP, 1, tr, tc, zero4, lane);
            { const int row0 = 16 * tr + 4 * (lane >> 4), col = 16 * tc + (lane & 15);
#pragma unroll
              for (int e = 0; e < 4; ++e) pm[e] += (row0 + e == col) ? __expf(cs[63 * 65 + col]) : 0.f; }
            st_tile(pm, PT, 1, RW, tr, tc, lane);
            f32x4_t qk = ld_tile(Kh, LP, 1, tr, tc, lane); qk = mm_tile<true, false>(W2, LP, 1, Bh, LP, 1, tr, tc, qk, lane); st_tile(qk, Qk, LP, 1, tr, tc, lane);
        R1_END
        __syncthreads();
        R1_FOR_TILES(idx, tr, tc)
            f32x4_t qt = mm_tile<false, false>(Qk, 1, LP, Vm, LP, 1, tr, tc, zero4, lane);
            { const int row0 = 16 * tr + 4 * (lane >> 4), col = 16 * tc + (lane & 15);
#pragma unroll
              for (int e = 0; e < 4; ++e) { const int jp = row0 + e; const int ci = ((jp >> 5) * 2 + (col >> 5)) * 64 + (col & 31) + 32 * ((jp >> 2) & 1);
                QT[(size_t)(ci >> 2) * (2 * RW) + (ci & 3) * 16 + (jp & 3) + 4 * ((jp & 31) >> 3)] = f2bf(qt[e]); } }
        R1_END
    }
}
__device__ void ph_rwkv_prep_r1(const P& p, float* ldsf) {
    for (int b64 = blockIdx.x; b64 < NT / 64; b64 += gridDim.x) {
        ph_rwkv_prep(p, ldsf, 2 * b64, 2 * b64 + 2, 1);
        __syncthreads();
        const int b = b64 >> 7, c = b64 & 127, ch0 = (b * 8) * 128 + c;
        ph_rwkv_r1(p, ldsf, ch0, ch0 + 8 * 128, 128);
    }
}
__device__ void ph_rwkv_r2(const P& p, int bh_first, int bh_end, int bh_step) {
    bf16_t* SX = (bf16_t*)(p.ws + WS_SX);
    const int tid = otid(), lane = tid & 63, wv = tid >> 6, hh = lane >> 5, r32 = lane & 31;
    typedef short s16x4_t __attribute__((ext_vector_type(4)));
    for (int bh = bh_first; bh < bh_end; bh += bh_step) {
        if (wv >= 2) continue;
        const int cb = wv;
        f32x16_t x0, x1;
#pragma unroll
        for (int i = 0; i < 16; ++i) { x0[i] = 0.f; x1[i] = 0.f; }
        bf16x8_t pa[2][4]; uint4 qa[2][2];
#define R2_LOAD(c_) do { const size_t gb_ = ((size_t)(bh >> 3) * SEQ + (size_t)(c_) * 64) * RW + (bh & 7) * 64; \
            const bf16_t* PT = (const bf16_t*)(p.ws + WS_BB) + gb_; const bf16_t* QT = (const bf16_t*)(p.ws + WS_DD) + 2 * gb_ + 64; \
            _Pragma("unroll") for (int rb = 0; rb < 2; ++rb) { \
                _Pragma("unroll") for (int ks = 0; ks < 4; ++ks) { const bf16_t* pp = PT + (size_t)(32 * rb + r32) * RW + 32 * (ks >> 1) + 16 * (ks & 1) + 4 * hh; \
                    const s16x4_t lo = *(const s16x4_t*)pp, hi = *(const s16x4_t*)(pp + 8); \
                    _Pragma("unroll") for (int j = 0; j < 4; ++j) { pa[rb][ks][j] = lo[j]; pa[rb][ks][4 + j] = hi[j]; } } \
                const int ci_ = (rb * 2 + cb) * 64 + lane; const uint4* qp = (const uint4*)(QT + (size_t)(ci_ >> 2) * (2 * RW) + (ci_ & 3) * 16); qa[rb][0] = qp[0]; qa[rb][1] = qp[1]; } } while (0)
        R2_LOAD(0);
#pragma unroll 1
        for (int c = 0; c < SEQ / 64; ++c) {
            const size_t ob_ = ((size_t)bh * 128 + c) * 4096;
            const bf16x8_t xb0 = pack_step16(x0, 0), xb1 = pack_step16(x0, 1), xb2 = pack_step16(x1, 0), xb3 = pack_step16(x1, 1);
            { bf16_t* sp = SX + ob_ + (size_t)(32 * cb + r32) * 64 + 4 * hh;
              const uint4 u0 = __builtin_bit_cast(uint4, xb0), u1 = __builtin_bit_cast(uint4, xb1), u2 = __builtin_bit_cast(uint4, xb2), u3 = __builtin_bit_cast(uint4, xb3);
              *(uint2*)(sp + 0) = make_uint2(u0.x, u0.y); *(uint2*)(sp + 8) = make_uint2(u0.z, u0.w); *(uint2*)(sp + 16) = make_uint2(u1.x, u1.y); *(uint2*)(sp + 24) = make_uint2(u1.z, u1.w);
              *(uint2*)(sp + 32) = make_uint2(u2.x, u2.y); *(uint2*)(sp + 40) = make_uint2(u2.z, u2.w); *(uint2*)(sp + 48) = make_uint2(u3.x, u3.y); *(uint2*)(sp + 56) = make_uint2(u3.z, u3.w); }
            f32x16_t n0, n1;
            { const unsigned qw0[8] = {qa[0][0].x, qa[0][0].y, qa[0][0].z, qa[0][0].w, qa[0][1].x, qa[0][1].y, qa[0][1].z, qa[0][1].w};
              const unsigned qw1[8] = {qa[1][0].x, qa[1][0].y, qa[1][0].z, qa[1][0].w, qa[1][1].x, qa[1][1].y, qa[1][1].z, qa[1][1].w};
#pragma unroll
              for (int i = 0; i < 8; ++i) { n0[2 * i] = __uint_as_float(qw0[i] << 16); n0[2 * i + 1] = __uint_as_float(qw0[i] & 0xffff0000u); n1[2 * i] = __uint_as_float(qw1[i] << 16); n1[2 * i + 1] = __uint_as_float(qw1[i] & 0xffff0000u); } }
            const bf16x8_t a00 = pa[0][0], a01 = pa[0][1], a02 = pa[0][2], a03 = pa[0][3], a10 = pa[1][0], a11 = pa[1][1], a12 = pa[1][2], a13 = pa[1][3];
            if (c + 1 < SEQ / 64) R2_LOAD(c + 1);
            n0 = MFMA32(a00, xb0, n0); n0 = MFMA32(a01, xb1, n0); n0 = MFMA32(a02, xb2, n0); n0 = MFMA32(a03, xb3, n0);
            n1 = MFMA32(a10, xb0, n1); n1 = MFMA32(a11, xb1, n1); n1 = MFMA32(a12, xb2, n1); n1 = MFMA32(a13, xb3, n1);
            x0 = n0; x1 = n1;
        }
#undef R2_LOAD
    }
}
__device__ void ph_rwkv_r3(const P& p, float* ldsf) {
    const bf16_t* VV = (const bf16_t*)(p.ws + WS_VV); const bf16_t* SX = (const bf16_t*)(p.ws + WS_SX);
    const bf16_t* Rg = (const bf16_t*)(p.ws + WS_R); const bf16_t* K2 = (const bf16_t*)(p.ws + WS_K2); const bf16_t* Gg = (const bf16_t*)(p.ws + WS_G); bf16_t* ORW = (bf16_t*)(p.ws + WS_ORW);
    const float* r_k = p.in[18]; const float* ln_w = p.in[19]; const float* ln_b = p.in[20];
    bf16_t* Vm = (bf16_t*)ldsf; float* Yl = (float*)(Vm + SLOT);
    const int tid = otid(), lane = tid & 63, wv = tid >> 6; const int t0 = 2 * wv, t1 = 2 * wv + 1;
    const int st = tid >> 3, sj = (tid & 7) * 8;
    for (int ch = blockIdx.x; ch < NB * 8 * (SEQ / 64); ch += gridDim.x) {
        const int bh = ch >> 7, c = ch & 127, b = bh >> 3, h = bh & 7;
        const size_t gbase = ((size_t)b * SEQ + (size_t)c * 64) * RW + h * 64, ob_ = (size_t)ch * 4096;
        const bf16_t* G1T = (const bf16_t*)(p.ws + WS_KK) + gbase; const bf16_t* G2T = (const bf16_t*)(p.ws + WS_DD) + 2 * gbase;
        __syncthreads();
        const uint4 vraw = *(const uint4*)(VV + gbase + (size_t)st * RW + sj);
        *(uint4*)(Vm + st * LP + sj) = vraw;
        __syncthreads();
        R1_FOR_TILES(idx, tr, tc)
            const f32x4_t zero4 = {0.f, 0.f, 0.f, 0.f};
            f32x4_t y = mm_tile<true, true>(SX + ob_, 64, 1, G1T, 1, RW, tr, tc, zero4, lane);
            y = mm_tile<false, true>(Vm, 1, LP, G2T, 1, 2 * RW, tr, tc, y, lane);
            const int i0 = 16 * tr + 4 * (lane >> 4), t = 16 * tc + (lane & 15);
#pragma unroll
            for (int e = 0; e < 4; ++e) Yl[t * 65 + i0 + e] = y[e];
        R1_END
        __syncthreads();
        {
            float y[8], s1 = 0.f;
#pragma unroll
            for (int e = 0; e < 8; ++e) { y[e] = Yl[st * 65 + sj + e]; s1 += y[e]; }
            s1 += __shfl_xor(s1, 1); s1 += __shfl_xor(s1, 2); s1 += __shfl_xor(s1, 4);
            const float mean = s1 * (1.f / 64.f); float s2 = 0.f;
#pragma unroll
            for (int e = 0; e < 8; ++e) { y[e] -= mean; s2 += y[e] * y[e]; }
            s2 += __shfl_xor(s2, 1); s2 += __shfl_xor(s2, 2); s2 += __shfl_xor(s2, 4);
            const float rstd = rsqrtf(s2 * (1.f / 64.f) + GN_EPS);
            const size_t o = gbase + (size_t)st * RW + sj;
            const uint4 rr = *(const uint4*)(Rg + o), kr = *(const uint4*)(K2 + o), gr = *(const uint4*)(Gg + o);
            const unsigned rw_[4] = {rr.x, rr.y, rr.z, rr.w}, kw_[4] = {kr.x, kr.y, kr.z, kr.w}, gw_[4] = {gr.x, gr.y, gr.z, gr.w}, vw_[4] = {vraw.x, vraw.y, vraw.z, vraw.w};
            float rk = 0.f;
#pragma unroll
            for (int e = 0; e < 8; ++e) { const float r_ = (e & 1) ? __uint_as_float(rw_[e >> 1] & 0xffff0000u) : __uint_as_float(rw_[e >> 1] << 16), k_ = (e & 1) ? __uint_as_float(kw_[e >> 1] & 0xffff0000u) : __uint_as_float(kw_[e >> 1] << 16);
                rk += r_ * k_ * r_k[h * 64 + sj + e]; }
            rk += __shfl_xor(rk, 1); rk += __shfl_xor(rk, 2); rk += __shfl_xor(rk, 4);
            float ov[8];
#pragma unroll
            for (int e = 0; e < 8; ++e) { const float v_ = (e & 1) ? __uint_as_float(vw_[e >> 1] & 0xffff0000u) : __uint_as_float(vw_[e >> 1] << 16), g_ = (e & 1) ? __uint_as_float(gw_[e >> 1] & 0xffff0000u) : __uint_as_float(gw_[e >> 1] << 16);
                ov[e] = (y[e] * rstd * ln_w[h * 64 + sj + e] + ln_b[h * 64 + sj + e] + rk * v_) * g_; }
            *(uint4*)(ORW + o) = make_uint4(pk2(ov[0], ov[1]), pk2(ov[2], ov[3]), pk2(ov[4], ov[5]), pk2(ov[6], ov[7]));
        }
    }
}
#undef R1_FOR_TILES
#undef R1_END

__device__ void ph_moe_lists(const P& p, float* ldsf) {
    int* ctl = (int*)(p.ws + WS_CTL); const int* cntB = ctl + CT_CNTB;
    int* ltok = (int*)(p.ws + WS_LTOK); float* lw = (float*)(p.ws + WS_LW);
    int* part = (int*)ldsf;
    int* tot = part + 1024; int* pre = tot + 64; int* offL = pre + 64; int* tp = offL + 64;
    const int tid = otid(), lane = tid & 63, wv = tid >> 6, G = gridDim.x;
    { int t_ = 0, p_ = 0;
      for (int b2 = wv; b2 < G; b2 += 8) { const int v = cntB[b2 * 64 + lane]; t_ += v; p_ += (b2 < (int)blockIdx.x) ? v : 0; }
      part[wv * 64 + lane] = t_; part[512 + wv * 64 + lane] = p_; }
    __syncthreads();
    if (tid < 64) { int t_ = 0, p_ = 0;
#pragma unroll
        for (int w2 = 0; w2 < 8; ++w2) { t_ += part[w2 * 64 + tid]; p_ += part[512 + w2 * 64 + tid]; }
        tot[tid] = t_; pre[tid] = p_;
        const int nt_ = (t_ + 255) >> 8; int incl = nt_;
#pragma unroll
        for (int o = 1; o < 64; o <<= 1) { const int oth = __shfl_up(incl, o); if (lane >= o) incl += oth; }
        tp[tid] = incl - nt_; offL[tid] = (incl - nt_) * 256; if (tid == 63) tp[64] = incl; }
    __syncthreads();
    const int TPB = NT / G;
    for (int i = tid; i < TPB; i += NTHR) { const int m = blockIdx.x * TPB + i; const int4 r = ((const int4*)(p.ws + WS_ROUTE))[m];
        const int l0 = r.x & 255, l1 = 32 + ((r.x >> 8) & 255), rk0 = r.y & 0xffff, rk1 = (r.y >> 16) & 0xffff;
        const int p0 = offL[l0] + pre[l0] + rk0, p1 = offL[l1] + pre[l1] + rk1;
        ltok[p0] = m; lw[p0] = __int_as_float(r.z); ltok[p1] = m; lw[p1] = __int_as_float(r.w); }
    for (int li = blockIdx.x; li < 64; li += G) {
        const int cnt = tot[li], off = offL[li], e = li & 31, nt_ = (cnt + 255) >> 8;
        int4* t1 = (int4*)(ctl + CT_TAB1) + tp[li] * 4;
        int4* t2 = (li < 32) ? (int4*)(ctl + CT_TAB2A) + tp[li] * 4 : (int4*)(ctl + CT_TAB2B) + (tp[li] - tp[32]) * 4;
        for (int i = tid; i < nt_ * 4; i += NTHR) { const int mt = i >> 2, nt = i & 3; const int4 ent = make_int4(off + mt * 256, e * 1024 + nt * 256, cnt - mt * 256, nt); t1[i] = ent; t2[i] = ent; }
        for (int r = cnt + tid; r < nt_ * 256; r += NTHR) ltok[off + r] = 0;
    }
    if (blockIdx.x == 0 && tid == 0) { ctl[CT_NU] = tp[64] * 4; ctl[CT_NU + 1] = tp[32] * 4; ctl[CT_NU + 2] = (tp[64] - tp[32]) * 4; }
}

template <int PH>
__device__ __forceinline__ void run_phase(const P& p, unsigned char* lds_raw) {
    float* lds = (float*)lds_raw; PG8_LAS unsigned char* ldsg = (PG8_LAS unsigned char*)lds_raw;
    const int G = gridDim.x, c = blockIdx.x;
    if constexpr (PH == 0) { ph_mod(p, lds); __syncthreads(); ph_convert_mixer_weights(p, lds); __syncthreads(); ph_convert_lora_weights(p, lds); }
    if constexpr (PH == 1) ph_norm(p, p.in[0], p.in[4], 0, (bf16_t*)(p.ws + WS_XN));
    if constexpr (PH == 2) { pg8::Gemm g{(const bf16_t*)(p.ws + WS_XN), (const bf16_t*)(p.ws + WS_WIN), DM, nullptr}; pg8::StaticOrder S; S.init(NT, 5120, G, c);
        pg8::EpiInproj E{p.ws, (bf16_t*)p.out}; pg8::gemm_phase(ldsg, g, S, E); }
    if constexpr (PH == 3) {
        { pg8::Gemm g{(const bf16_t*)(p.ws + WS_KVN), (const bf16_t*)(p.ws + WS_WKV), KVL, nullptr}; pg8::StaticOrder S; S.init(NT, 2 * AW, G, c);
          pg8::EpiKV E{p.ws}; pg8::gemm_phase(ldsg, g, S, E); }
        ph_rwkv_prep_r1(p, lds);
        ph_dsa_select(p, lds);
    }
    if constexpr (PH == 4) { ph_rwkv_r2(p, c, NB * 8, G); ph_dsa_attn(p, lds); }
    if constexpr (PH == 5) ph_rwkv_r3(p, lds);
    if constexpr (PH == 6) { pg8::Gemm g{(const bf16_t*)(p.ws + WS_OATT), (const bf16_t*)(p.ws + WS_WBA), AW, nullptr}; pg8::BranchOrder S; S.S0.init(NT, DM, G, c);
        pg8::EpiMerge E{(bf16_t*)(p.ws + WS_MERGED), (const bf16_t*)p.out}; pg8::gemm_phase(ldsg, g, S, E);
        ph_convert_expert_weights(p, lds); }
    if constexpr (PH == 7) { pg8::Gemm g{(const bf16_t*)(p.ws + WS_MERGED), (const bf16_t*)(p.ws + WS_WOUT), DM, nullptr}; pg8::StaticOrder S; S.init(NT, DM, G, c);
        pg8::EpiOut E{p.in[0], (const float*)(p.ws + WS_MOD), p.out}; pg8::gemm_phase(ldsg, g, S, E); }
    if constexpr (PH == 8) ph_norm_route(p, lds);
    if constexpr (PH == 9) ph_moe_lists(p, lds);
    if constexpr (PH == 10) { const int* ctl = (const int*)(p.ws + WS_CTL);
        pg8::Gemm g{(const bf16_t*)(p.ws + WS_XN2), (const bf16_t*)(p.ws + WS_WGU), DM, (const int*)(p.ws + WS_LTOK)}; pg8::TableOrder S{(const int4*)(ctl + CT_TAB1), ctl[CT_NU], G, c};
        pg8::EpiMoe1 E{(bf16_t*)(p.ws + WS_HID), (const float*)(p.ws + WS_LW)}; pg8::gemm_phase(ldsg, g, S, E); }
    if constexpr (PH == 11 || PH == 12) { const int* ctl = (const int*)(p.ws + WS_CTL);
        pg8::Gemm g{(const bf16_t*)(p.ws + WS_HID), (const bf16_t*)(p.ws + WS_WDN), DE, nullptr};
        pg8::TableOrder S{(const int4*)(ctl + (PH == 11 ? CT_TAB2A : CT_TAB2B)), ctl[CT_NU + (PH == 11 ? 1 : 2)], G, c};
        pg8::EpiMoe2 E{(const int*)(p.ws + WS_LTOK), (const float*)(p.ws + WS_MOD), p.out}; pg8::gemm_phase(ldsg, g, S, E); }
}
constexpr int LDS_BYTES = 147456;
constexpr int ORDER[] = {0, 1, 2, 3, 4, 5, 6, 7, 8, 9, 10, 11, 12};
constexpr int NPHASE = sizeof(ORDER) / sizeof(int);
constexpr int CT_BAR = 65536;
constexpr int LDS_ST = LDS_BYTES - 64;
template <int I> __device__ __forceinline__ void run_all(const P& p, unsigned char* lds, const XcdBarrier& bar) {
    run_phase<ORDER[I]>(p, lds);
    if constexpr (I + 1 < NPHASE) { xcd_barrier(bar); run_all<I + 1>(p, lds, bar); }
}
__global__ void __launch_bounds__(NTHR, 2) k_mega(P p) {
    extern __shared__ __attribute__((aligned(16))) unsigned char lds[];
    volatile LAS3 unsigned* st = (volatile LAS3 unsigned*)((LAS3 unsigned char*)lds + LDS_ST);
    if (otid() < 16) st[otid()] = 0u;
    __syncthreads();
    const XcdBarrier bar = xcd_barrier_post((unsigned*)(p.ws + WS_CTL) + CT_BAR, st);
    run_all<0>(p, lds, bar);
}
}

extern "C" void kernel_launch(void* const* d_in, const int* in_sizes, int n_in, void* d_out, int out_size, void* d_ws, size_t ws_size, hipStream_t stream) {
    if (n_in != 31 || out_size != NT * DM || ws_size < WS_END) { fprintf(stderr, "kernel_launch: unexpected shapes (n_in %d out %d ws %zu need %zu)\n", n_in, out_size, ws_size, (size_t)WS_END); return; }
    P p{};
    for (int i = 0; i < 31; ++i) p.in[i] = (const float*)d_in[i];
    p.out = (float*)d_out; p.ws = (unsigned char*)d_ws;
    (void)hipMemsetAsync((char*)d_ws + WS_CTL, 0, 1 * MiB, stream);
    static int grid_blocks = 0;
    if (!grid_blocks) {
        int dev = 0, cus = 0, per_cu = 0;
        (void)hipGetDevice(&dev);
        (void)hipDeviceGetAttribute(&cus, hipDeviceAttributeMultiprocessorCount, dev);
        (void)hipFuncSetAttribute((const void*)k_mega, hipFuncAttributeMaxDynamicSharedMemorySize, LDS_BYTES);
        (void)hipOccupancyMaxActiveBlocksPerMultiprocessor(&per_cu, (const void*)k_mega, NTHR, LDS_BYTES);
        if (per_cu < 1) per_cu = 1;
        if (per_cu > 1) per_cu = 1;
        grid_blocks = cus * per_cu;
        fprintf(stderr, "kernel_launch: cus %d per_cu %d grid %d\n", cus, per_cu, grid_blocks);
    }
    hipLaunchKernelGGL(k_mega, dim3(grid_blocks), dim3(NTHR), LDS_BYTES, stream, p);
}
```

```cpp
#include <hip/hip_runtime.h>
#include <cstdio>
#include <cstdint>

namespace {
constexpr int NB = 2, SEQ = 8192, DM = 1024, NT = NB * SEQ;
constexpr int AW = 512, KVL = 256, NIH = 8, IDD = 32, SHW = 1824, INW = 4936;
constexpr int C_KV = 512, C_QI = 768, C_PS = 1064, C_GA = 2888, C_GR = 3912;
constexpr int IDXW = 296;
constexpr int RW = 512, NE = 32, DE = 512;
constexpr int TOPK = 256;
constexpr float NORM_EPS = 1e-6f, GN_EPS = 64e-5f;
constexpr int NTHR = 512;

typedef unsigned short bf16_t;
__device__ __forceinline__ float bf2f(bf16_t v) { return __uint_as_float(((unsigned)v) << 16); }
__device__ __forceinline__ bf16_t f2bf(float f) { unsigned u = __float_as_uint(f); return (bf16_t)((u + 0x7fffu + ((u >> 16) & 1u)) >> 16); }

constexpr size_t MiB = 1u << 20;
constexpr size_t WS_CTL = 0;
constexpr size_t WS_MOD = 1 * MiB;
constexpr size_t WS_RSS = 128 * 1024;
constexpr size_t WS_LW2T = 512 * 1024, WS_LA2T = 576 * 1024, WS_LG2T = 640 * 1024;
constexpr size_t WS_WIN = 2 * MiB;
constexpr size_t WS_WKV = 12 * MiB;
constexpr size_t WS_WBA = 13 * MiB;
constexpr size_t WS_WBR = 14 * MiB;
constexpr size_t WS_WOUT = 15 * MiB;
constexpr size_t WS_XN = 17 * MiB;
constexpr size_t WS_K = 17 * MiB;
constexpr size_t WS_V = 33 * MiB;
constexpr size_t WS_Q = 49 * MiB;
constexpr size_t WS_KVN = 65 * MiB;
constexpr size_t WS_QI = 73 * MiB;
constexpr size_t WS_KI = 81 * MiB;
constexpr size_t WS_WI = 82 * MiB;
constexpr size_t WS_PS = 83 * MiB;
constexpr size_t WS_SX = 83 * MiB;
constexpr size_t WS_OATT = 99 * MiB;
constexpr size_t WS_ORW = 115 * MiB;
constexpr size_t WS_MASK = 140 * MiB;
constexpr size_t WS_R = 156 * MiB, WS_K2 = 172 * MiB, WS_VV = 188 * MiB;
constexpr size_t WS_KK = 204 * MiB;
constexpr size_t WS_BB = 220 * MiB;
constexpr size_t WS_DD = 236 * MiB;
constexpr size_t WS_G = 268 * MiB;
constexpr size_t WS_MERGED = 131 * MiB;
constexpr size_t WS_XN2 = 163 * MiB;
constexpr size_t WS_WGU = 195 * MiB;
constexpr size_t WS_WDN = 259 * MiB;
constexpr size_t WS_HID = 17 * MiB;
constexpr size_t WS_ROUTE = 65 * MiB;
constexpr size_t WS_LTOK = 66 * MiB;
constexpr size_t WS_LW = 67 * MiB;
constexpr size_t WS_END = 291 * MiB;
constexpr int HID_ROWS = 49152;
constexpr int CT_CNT = 0, CT_OFF = 64, CT_CUR = 128, CT_NU = 192, CT_Q = 256;
constexpr int CT_CNTB = 16384;
constexpr int CT_TAB1 = 1024, CT_TAB2A = 1024 + 4 * 1024, CT_TAB2B = 1024 + 8 * 1024;

struct P {
    const float* in[31];
    float* out;
    unsigned char* ws;
};

__device__ __forceinline__ int otid() { int t = threadIdx.x; asm volatile("" : "+v"(t)); return t; }
__device__ __forceinline__ float dpp_row_shr(float v, int n) {
    int iv = __builtin_bit_cast(int, v), r;
    switch (n) { case 1: r = __builtin_amdgcn_update_dpp(0, iv, 0x111, 0xf, 0xf, true); break; case 2: r = __builtin_amdgcn_update_dpp(0, iv, 0x112, 0xf, 0xf, true); break;
                 case 4: r = __builtin_amdgcn_update_dpp(0, iv, 0x114, 0xf, 0xf, true); break; default: r = __builtin_amdgcn_update_dpp(0, iv, 0x118, 0xf, 0xf, true); break; }
    return __builtin_bit_cast(float, r);
}
__device__ __forceinline__ float wave_sum(float v) {
    v += dpp_row_shr(v, 1); v += dpp_row_shr(v, 2); v += dpp_row_shr(v, 4); v += dpp_row_shr(v, 8);
    v += __builtin_bit_cast(float, __builtin_amdgcn_update_dpp(0, __builtin_bit_cast(int, v), 0x142, 0xa, 0xf, false));
    v += __builtin_bit_cast(float, __builtin_amdgcn_update_dpp(0, __builtin_bit_cast(int, v), 0x143, 0xc, 0xf, false));
    return __builtin_bit_cast(float, __builtin_amdgcn_readlane(__builtin_bit_cast(int, v), 63));
}
__device__ __forceinline__ float wave_max(float v) {
#pragma unroll
    for (int o = 32; o > 0; o >>= 1) v = fmaxf(v, __shfl_xor(v, o));
    return v;
}
typedef short bf16x8_t __attribute__((ext_vector_type(8)));
typedef float f32x4_t __attribute__((ext_vector_type(4)));
constexpr int LP = 72;
constexpr int SLOT = 64 * LP;
__device__ __forceinline__ float sigmoidf_(float x) { return 1.f / (1.f + __expf(-x)); }

#define XB_TMO      128
#define XB_XCNT(j)  (256  + 64 * (j))
#define XB_XSUB(j)  (1280 + 64 * (j))
#define XB_XGEN(j)  (2304 + 64 * (j))
#define XB_TOP      3328
#define XB_TOPGEN   3392
#define XCD_BAR_WORDS 3456
#define XB_SPIN_CAP (1u << 22)
#define LAS3 __attribute__((address_space(3)))
__device__ __forceinline__ unsigned xb_ld(unsigned* p)              { return __hip_atomic_load(p, __ATOMIC_RELAXED, __HIP_MEMORY_SCOPE_AGENT); }
__device__ __forceinline__ unsigned xb_add(unsigned* p, unsigned v) { return __hip_atomic_fetch_add(p, v, __ATOMIC_RELAXED, __HIP_MEMORY_SCOPE_AGENT); }
__device__ __forceinline__ unsigned xb_xcc_id() { return (unsigned)__builtin_amdgcn_s_getreg((3 << 11) | 20) & 0xFu; }
#define XB_SPIN(cond, bar) do { unsigned _sp = 0; while (cond) { __builtin_amdgcn_s_sleep(1); \
    if ((++_sp & 255u) == 0u) { if (xb_ld(&(bar)[XB_TMO])) break; if (_sp > XB_SPIN_CAP) { atomicAdd(&(bar)[XB_TMO], 1u); break; } } } } while (0)
struct XcdBarrier { unsigned* bar; unsigned x; volatile LAS3 unsigned* st; };
__device__ __forceinline__ XcdBarrier xcd_barrier_post(unsigned* bar, volatile LAS3 unsigned* st) {
    XcdBarrier b; b.bar = bar; b.x = xb_xcc_id(); b.st = st;
    if (otid() == 0) (void)xb_add(&bar[XB_XCNT(b.x)], 1u);
    return b;
}
__device__ __forceinline__ void xcd_barrier_complete(unsigned* bar, unsigned x, unsigned& nloc, unsigned& nx) {
    const unsigned G = gridDim.x * gridDim.y * gridDim.z;
    unsigned sum, cnt, mine, sp = 0u;
    for (;;) {
        sum = 0u; cnt = 0u; mine = 0u;
#pragma unroll
        for (unsigned j = 0; j < 16; ++j) { const unsigned c = xb_ld(&bar[XB_XCNT(j)]); sum += c; cnt += (c > 0u) ? 1u : 0u; mine = (j == x) ? c : mine; }
        if (sum == G) break;
        __builtin_amdgcn_s_sleep(1);
        if ((++sp & 255u) == 0u) { if (xb_ld(&bar[XB_TMO])) break; if (sp > XB_SPIN_CAP) { atomicAdd(&bar[XB_TMO], 1u); break; } }
    }
    nloc = mine > 0u ? mine : 1u; nx = cnt > 0u ? cnt : 1u;
}
__device__ __forceinline__ void xcd_barrier(const XcdBarrier& b) {
    asm volatile("s_waitcnt vmcnt(0)" ::: "memory");
    __syncthreads();
    if (otid() == 0) {
        unsigned* bar = b.bar;
        __builtin_amdgcn_s_waitcnt(0);
        unsigned nloc = b.st[0], nx = b.st[1];
        if (nloc == 0u) { xcd_barrier_complete(bar, b.x, nloc, nx); b.st[0] = nloc; b.st[1] = nx; }
        const unsigned old = xb_add(&bar[XB_XSUB(b.x)], 1u);
        const unsigned gen = old / nloc;
        if (old + 1u == (gen + 1u) * nloc) {
            __builtin_amdgcn_fence(__ATOMIC_RELEASE, "agent");
            asm volatile("s_waitcnt vmcnt(0)" ::: "memory");
            const unsigned og = xb_add(&bar[XB_TOP], 1u);
            const unsigned tg = og / nx;
            if (og + 1u == (tg + 1u) * nx) xb_add(&bar[XB_TOPGEN], 1u);
            else XB_SPIN(xb_ld(&bar[XB_TOPGEN]) == tg, bar);
            __builtin_amdgcn_fence(__ATOMIC_ACQUIRE, "agent");
            xb_add(&bar[XB_XGEN(b.x)], 1u);
            asm volatile("s_waitcnt vmcnt(0)" ::: "memory");
        } else {
            XB_SPIN(xb_ld(&bar[XB_XGEN(b.x)]) == gen, bar);
            __builtin_amdgcn_fence(__ATOMIC_ACQUIRE, "agent");
            asm volatile("s_waitcnt vmcnt(0)" ::: "memory");
        }
    }
    __syncthreads();
}

__device__ void ph_mod(const P& p, float* lds) {
    const float* c = p.in[1]; const float* W = p.in[2]; const float* bia = p.in[3];
    float* mod = (float*)(p.ws + WS_MOD);
    const int tid = otid(), lane = tid & 63, wv = tid >> 6;
    float* sil = lds; float* part = lds + NB * DM;
    for (int i = tid; i < NB * DM; i += NTHR) { const float v = c[i]; sil[i] = v / (1.f + __expf(-v)); }
    __syncthreads();
    const int cc = lane % 24, kk = lane / 24;
    for (int j0 = blockIdx.x * 24; j0 < 6 * DM; j0 += gridDim.x * 24) {
        float a0 = 0.f, a1 = 0.f;
        if (lane < 48) {
#pragma unroll 8
            for (int i = 0; i < 64; ++i) { const int k = 128 * wv + 2 * i + kk; const float w = W[(size_t)k * (6 * DM) + j0 + cc]; a0 += sil[k] * w; a1 += sil[DM + k] * w; }
        }
        a0 += __shfl(a0, (lane + 24) & 63); a1 += __shfl(a1, (lane + 24) & 63);
        if (lane < 24) { part[(wv * 2 + 0) * 24 + cc] = a0; part[(wv * 2 + 1) * 24 + cc] = a1; }
        __syncthreads();
        if (tid < 48) { const int bb = tid / 24, c2 = tid % 24; float sum = 0.f;
#pragma unroll
            for (int w2 = 0; w2 < 8; ++w2) sum += part[(w2 * 2 + bb) * 24 + c2];
            mod[bb * 6 * DM + j0 + c2] = sum + bia[j0 + c2]; }
        __syncthreads();
    }
}

__device__ void ph_norm(const P& p, const float* src, const float* g, int which, bf16_t* dst) {
    const float* mod = (const float*)(p.ws + WS_MOD);
    const int lane = otid() & 63, wv = otid() >> 6;
    const int gw = blockIdx.x * (NTHR / 64) + wv, nw = gridDim.x * (NTHR / 64);
    for (int m = gw; m < NT; m += nw) {
        const int b = m / SEQ;
        const float* sh = mod + b * 6 * DM + (which ? 3 * DM : 0);
        const float* sc = sh + DM;
        const float4* xr = (const float4*)(src + (size_t)m * DM);
        float4 v[4]; float ss = 0.f;
#pragma unroll
        for (int j = 0; j < 4; ++j) { v[j] = xr[lane + 64 * j]; ss += v[j].x * v[j].x + v[j].y * v[j].y + v[j].z * v[j].z + v[j].w * v[j].w; }
        ss = wave_sum(ss);
        const float rstd = rsqrtf(ss * (1.f / DM) + NORM_EPS);
        float o[16];
#pragma unroll
        for (int j = 0; j < 4; ++j) {
            int c0 = 4 * (lane + 64 * j); asm volatile("" : "+v"(c0));
            const float4 gg = *(const float4*)(g + c0), s1 = *(const float4*)(sc + c0), s0 = *(const float4*)(sh + c0);
            o[4 * j + 0] = v[j].x * rstd * gg.x * (1.f + s1.x) + s0.x; o[4 * j + 1] = v[j].y * rstd * gg.y * (1.f + s1.y) + s0.y;
            o[4 * j + 2] = v[j].z * rstd * gg.z * (1.f + s1.z) + s0.z; o[4 * j + 3] = v[j].w * rstd * gg.w * (1.f + s1.w) + s0.w;
            uint2 pk; pk.x = (unsigned)f2bf(o[4 * j]) | ((unsigned)f2bf(o[4 * j + 1]) << 16); pk.y = (unsigned)f2bf(o[4 * j + 2]) | ((unsigned)f2bf(o[4 * j + 3]) << 16);
            *(uint2*)(dst + (size_t)m * DM + c0) = pk;
        }
    }
}

__device__ void ph_norm_route(const P& p, float* lds) {
    const float* mod = (const float*)(p.ws + WS_MOD); const float* src = p.out; const float* g = p.in[24]; bf16_t* dst = (bf16_t*)(p.ws + WS_XN2);
    const float* wgr = p.in[25]; const float* wer = p.in[26]; const float* eb = p.in[27];
    const int tid = otid(), lane = tid & 63, wv = tid >> 6;
    float* sx = lds + wv * 4096;
    int* cntL = (int*)(lds + 8 * 4096);
    if (tid < 64) cntL[tid] = 0;
    __syncthreads();
    const int TPB = NT / gridDim.x;
    for (int m0 = blockIdx.x * TPB + wv * 4; m0 < (blockIdx.x + 1) * TPB; m0 += 8 * 4) {
        const int b = m0 / SEQ;
        const float* sh = mod + b * 6 * DM + 3 * DM; const float* sc = sh + DM;
#pragma unroll 1
        for (int tk = 0; tk < 4; ++tk) {
            const int m = m0 + tk;
            const float4* xr = (const float4*)(src + (size_t)m * DM);
            float4 v[4]; float ss = 0.f;
#pragma unroll
            for (int j = 0; j < 4; ++j) { v[j] = xr[lane + 64 * j]; ss += v[j].x * v[j].x + v[j].y * v[j].y + v[j].z * v[j].z + v[j].w * v[j].w; }
            ss = wave_sum(ss);
            const float rstd = rsqrtf(ss * (1.f / DM) + NORM_EPS);
#pragma unroll
            for (int j = 0; j < 4; ++j) {
                const int c0 = 4 * (lane + 64 * j);
                const float4 gg = *(const float4*)(g + c0), s1 = *(const float4*)(sc + c0), s0 = *(const float4*)(sh + c0);
                const float o0 = v[j].x * rstd * gg.x * (1.f + s1.x) + s0.x, o1 = v[j].y * rstd * gg.y * (1.f + s1.y) + s0.y;
                const float o2 = v[j].z * rstd * gg.z * (1.f + s1.z) + s0.z, o3 = v[j].w * rstd * gg.w * (1.f + s1.w) + s0.w;
                uint2 pk; pk.x = (unsigned)f2bf(o0) | ((unsigned)f2bf(o1) << 16); pk.y = (unsigned)f2bf(o2) | ((unsigned)f2bf(o3) << 16);
                *(uint2*)(dst + (size_t)m * DM + c0) = pk;
                sx[(c0 + 0) * 4 + tk] = o0; sx[(c0 + 1) * 4 + tk] = o1; sx[(c0 + 2) * 4 + tk] = o2; sx[(c0 + 3) * 4 + tk] = o3;
            }
        }
        __builtin_amdgcn_wave_barrier(); asm volatile("s_waitcnt lgkmcnt(0)" ::: "memory");
        float ae[4] = {0.f, 0.f, 0.f, 0.f}, ag[4] = {0.f, 0.f, 0.f, 0.f};
        { const int e = lane & 31, kb = (lane >> 5) * 512;
#pragma unroll 16
          for (int i = 0; i < 512; ++i) { const float w = wer[(size_t)(kb + i) * 32 + e]; const float4 xv = *(const float4*)(sx + (kb + i) * 4);
              ae[0] += xv.x * w; ae[1] += xv.y * w; ae[2] += xv.z * w; ae[3] += xv.w * w; } }
        { const int gq = lane & 3, kb = (lane >> 2) * 64;
#pragma unroll 16
          for (int i = 0; i < 64; ++i) { const float w = wgr[(size_t)(kb + i) * 4 + gq]; const float4 xv = *(const float4*)(sx + (kb + i) * 4);
              ag[0] += xv.x * w; ag[1] += xv.y * w; ag[2] += xv.z * w; ag[3] += xv.w * w; } }
#pragma unroll
        for (int tk = 0; tk < 4; ++tk) {
            ae[tk] += __shfl_xor(ae[tk], 32);
            ag[tk] += __shfl_xor(ag[tk], 4); ag[tk] += __shfl_xor(ag[tk], 8); ag[tk] += __shfl_xor(ag[tk], 16); ag[tk] += __shfl_xor(ag[tk], 32);
        }
#pragma unroll
        for (int tk = 0; tk < 4; ++tk) {
            float lg[4];
#pragma unroll
            for (int q = 0; q < 4; ++q) lg[q] = __shfl(ag[tk], q);
            int gs = 0; float mx = lg[0];
#pragma unroll
            for (int q = 1; q < 4; ++q) if (lg[q] > mx) { mx = lg[q]; gs = q; }
            float den = 0.f;
#pragma unroll
            for (int q = 0; q < 4; ++q) den += __expf(lg[q] - mx);
            const float pg = 1.f / den;
            float ev[8];
#pragma unroll
            for (int q = 0; q < 8; ++q) ev[q] = __shfl(ae[tk], gs * 8 + q) + eb[gs * 8 + q];
            int i0 = 0; float v0 = ev[0];
#pragma unroll
            for (int q = 1; q < 8; ++q) if (ev[q] > v0) { v0 = ev[q]; i0 = q; }
            int i1 = -1; float v1 = -INFINITY;
#pragma unroll
            for (int q = 0; q < 8; ++q) if (q != i0 && ev[q] > v1) { v1 = ev[q]; i1 = q; }
            if (lane == 0) {
                const float e1 = __expf(v1 - v0), w0 = pg / (1.f + e1), w1 = pg * e1 / (1.f + e1);
                const int x0 = gs * 8 + i0, x1 = gs * 8 + i1;
                const int rk0 = atomicAdd(&cntL[x0], 1), rk1 = atomicAdd(&cntL[32 + x1], 1);
                int4* route = (int4*)(p.ws + WS_ROUTE) + (size_t)(m0 + tk);
                *route = make_int4(x0 | (x1 << 8), rk0 | (rk1 << 16), __float_as_int(w0), __float_as_int(w1));
            }
        }
        __builtin_amdgcn_wave_barrier();
    }
    __syncthreads();
    if (tid < 64) ((int*)(p.ws + WS_CTL) + CT_CNTB)[blockIdx.x * 64 + tid] = cntL[tid];
}

namespace pg8 {
#define PG8_LAS __attribute__((address_space(3)))
typedef short bf16x8 __attribute__((ext_vector_type(8)));
typedef float f32x4 __attribute__((ext_vector_type(4)));
typedef unsigned u32x4 __attribute__((ext_vector_type(4)));
constexpr int BM = 256, BK = 64, HALF = 128, HTB = HALF * BK * 2, STAGE_BYTES = 8 * HTB, NXCD = 8, WGM = 8;
__host__ __device__ __forceinline__ int lds_byte(int r, int c) { const int st = (r >> 4) * 2 + (c >> 5), rr = r & 15, cc = c & 31, ob = rr * 64 + cc * 2; return st * 1024 + (ob ^ (((ob >> 9) & 1) << 5)); }
__host__ __device__ __forceinline__ void stage_rc(int b, int& R, int& C) { const int st = b / 1024, sb = b % 1024, swz = sb ^ (((sb >> 9) & 1) << 5); R = (st >> 1) * 16 + swz / 64; C = (st & 1) * 32 + (swz % 64) / 2; }
__host__ __device__ __forceinline__ int perm32(int rho) { const int n = rho >> 4, i = rho & 15; return 8 * (i >> 2) + 4 * n + (i & 3); }

struct Unit { int arow, brow, pm, pn, aux; };
struct Gemm { const bf16_t* A; const bf16_t* Bt; int K; const int* gather; };

struct StaticOrder {
    int nM, nN, nwg, G, c;
    __device__ void init(int M, int N, int G_, int c_) { nM = M / BM; nN = N / BM; nwg = nM * nN; G = G_; c = c_; }
    __device__ bool next(int i, Unit& u) const {
        const long L = (long)i * G + c; if (L >= nwg) return false;
        int wgid = (int)L; { const int q = nwg / NXCD, r = nwg % NXCD, xcd = wgid % NXCD, off = wgid / NXCD; wgid = (xcd < r ? xcd * (q + 1) : r * (q + 1) + (xcd - r) * q) + off; }
        const int nig = WGM * nN, gid = wgid / nig, fm = gid * WGM, gsz = (nM - fm) < WGM ? (nM - fm) : WGM;
        u.pm = fm + ((wgid % nig) % gsz); u.pn = (wgid % nig) / gsz; u.arow = u.pm * BM; u.brow = u.pn * BM; u.aux = 0; return true;
    }
};
struct BranchOrder {
    StaticOrder S0;
    __device__ bool next(int i, Unit& u) const {
        if (!S0.next(i >> 1, u)) return false;
        const int which = i & 1; u.arow += which * NT; u.brow += which * DM; u.aux = which; return true;
    }
};
struct TableOrder {
    const int4* tab; int n, G, c;
    __device__ bool next(int i, Unit& u) const {
        const int L = i * G + c; if (L >= n) return false;
        const int4 e = tab[L]; u.arow = __builtin_amdgcn_readfirstlane(e.x); u.brow = __builtin_amdgcn_readfirstlane(e.y); u.aux = __builtin_amdgcn_readfirstlane(e.z); u.pn = __builtin_amdgcn_readfirstlane(e.w); u.pm = 0; return true;
    }
};
__device__ __forceinline__ unsigned cvt_pk_bf16(float lo, float hi) { unsigned r; asm volatile("v_cvt_pk_bf16_f32 %0, %1, %2" : "=v"(r) : "v"(lo), "v"(hi)); return r; }

template <class Epi, class Sched>
__device__ __forceinline__ void gemm_phase(PG8_LAS unsigned char* lds, const Gemm g, const Sched& S, const Epi& E) {
    const int tid = otid(), wid = __builtin_amdgcn_readfirstlane(tid >> 6), lane = tid & 63, wr = wid >> 2, wc = wid & 3, fr = lane & 15, fq = lane >> 4;
    const int K = g.K, nt = K / BK;
    int RA0; unsigned cofA0, voffB0;
    { int R, C; stage_rc(tid * 16, R, C); const int Rb = Epi::PERM ? ((R & ~31) + perm32(R & 31)) : R; RA0 = R; cofA0 = (unsigned)C * 2u; voffB0 = (unsigned)(Rb * K + C) * 2u; }
    const size_t rstep64 = (size_t)64 * K * 2;
    const size_t kstep = (size_t)(BK * 2);
    const size_t hstep = (size_t)HALF * K * 2;
    const unsigned ldsw = (unsigned)wid * 1024u;
    const int aoff = lds_byte(wr * 64 + fr, fq * 8), boff = lds_byte(wc * 32 + fr, fq * 8);
#define PG8_SA(b, h) (((b) * 2 + (h)) * HTB)
#define PG8_SB(b, h) ((4 + (b) * 2 + (h)) * HTB)
#define PG8_STAGE_B(bufoff, gbase) do { _Pragma("unroll") for (int _i = 0; _i < 2; ++_i) \
        __builtin_amdgcn_global_load_lds((const unsigned*)((const char*)(gbase) + _i * rstep64 + voffB0), (PG8_LAS unsigned*)(lds + (bufoff) + ldsw + _i * 8192), 16, 0, 0); } while (0)
#define PG8_STAGE_A(bufoff, o2, kb) do { _Pragma("unroll") for (int _i = 0; _i < 2; ++_i) \
        __builtin_amdgcn_global_load_lds((const unsigned*)((const char*)g.A + (size_t)(o2)[_i] + (size_t)(kb)), (PG8_LAS unsigned*)(lds + (bufoff) + ldsw + _i * 8192), 16, 0, 0); } while (0)
#define PG8_LDA(dst, b, h) do { _Pragma("unroll") for (int m = 0; m < 4; ++m) _Pragma("unroll") for (int k = 0; k < 2; ++k) dst[m][k] = *(const PG8_LAS bf16x8*)(lds + PG8_SA(b, h) + aoff + m * 2048 + k * 1024); } while (0)
#define PG8_LDB(dst, b, h) do { _Pragma("unroll") for (int n = 0; n < 2; ++n) _Pragma("unroll") for (int k = 0; k < 2; ++k) dst[n][k] = *(const PG8_LAS bf16x8*)(lds + PG8_SB(b, h) + boff + n * 2048 + k * 1024); } while (0)
#define PG8_MMA(ai, bj, At, Bt) do { __builtin_amdgcn_s_setprio(1); _Pragma("unroll") for (int m = 0; m < 4; ++m) _Pragma("unroll") for (int n = 0; n < 2; ++n) _Pragma("unroll") for (int k = 0; k < 2; ++k) \
        acc[ai][bj][m][n] = __builtin_amdgcn_mfma_f32_16x16x32_bf16(Bt[n][k], At[m][k], acc[ai][bj][m][n], 0, 0, 0); __builtin_amdgcn_s_setprio(0); } while (0)
#define PG8_WAIT_V(n) asm volatile("s_waitcnt vmcnt(" #n ")" ::: "memory")
#define PG8_WAIT_L(n) asm volatile("s_waitcnt lgkmcnt(" #n ")" ::: "memory")
#define PG8_BAR __builtin_amdgcn_s_barrier()
#define PG8_SCHED __builtin_amdgcn_sched_barrier(0)
#define PG8_AOFFS(u, dst) do { _Pragma("unroll") for (int _h = 0; _h < 2; ++_h) _Pragma("unroll") for (int _i = 0; _i < 2; ++_i) { \
        const int _tr = (u).arow + _h * HALF + RA0 + 64 * _i; const unsigned _row = g.gather ? (unsigned)g.gather[_tr] : (unsigned)_tr; dst[_h][_i] = _row * (unsigned)(K * 2) + cofA0; } } while (0)
    Unit cur, nxt; int ui = 0;
    if (!S.next(0, cur)) return;
    f32x4 acc[2][2][4][2];
#pragma unroll
    for (int a = 0; a < 2; ++a)
#pragma unroll
        for (int b = 0; b < 2; ++b)
#pragma unroll
            for (int m = 0; m < 4; ++m)
#pragma unroll
                for (int n = 0; n < 2; ++n) acc[a][b][m][n] = (f32x4){0.f, 0.f, 0.f, 0.f};
    bf16x8 At[4][2], B0[2][2], B1[2][2];
    unsigned cof[2][2];
    PG8_AOFFS(cur, cof);
    const char* cB = (const char*)g.Bt + (size_t)cur.brow * K * 2;
    PG8_STAGE_B(PG8_SB(0, 0), cB); PG8_STAGE_B(PG8_SB(0, 1), cB + hstep); PG8_STAGE_A(PG8_SA(0, 0), cof[0], 0); PG8_STAGE_A(PG8_SA(0, 1), cof[1], 0);
    if (wr == 1) PG8_BAR;
    PG8_WAIT_V(2); PG8_BAR;
    PG8_STAGE_B(PG8_SB(1, 0), cB + kstep); PG8_STAGE_A(PG8_SA(1, 0), cof[0], kstep); PG8_STAGE_B(PG8_SB(1, 1), cB + hstep + kstep);
    PG8_WAIT_V(6); PG8_BAR;
    for (;;) {
        const bool has_next = S.next(ui + 1, nxt);
        if (!has_next) nxt = cur;
        const char* nB = (const char*)g.Bt + (size_t)nxt.brow * K * 2;
        for (int t = 0; t < nt; t += 2) {
            const bool last = (t == nt - 2);
            const size_t k1 = (size_t)(t + 1) * kstep;
            const size_t k2 = last ? 0 : (size_t)(t + 2) * kstep, k3 = k2 + kstep;
            const char* b2 = last ? nB : cB + (size_t)(t + 2) * kstep; const char* b3 = b2 + kstep;
            PG8_LDB(B0, 0, 0); PG8_LDB(B1, 0, 1); PG8_SCHED; PG8_LDA(At, 0, 0); PG8_STAGE_A(PG8_SA(1, 1), cof[1], k1);
            if (last) { PG8_AOFFS(nxt, cof); }
            PG8_WAIT_V(8); PG8_WAIT_L(0); PG8_BAR; PG8_MMA(0, 0, At, B0); PG8_MMA(0, 1, At, B1); PG8_BAR; PG8_SCHED;
            PG8_LDA(At, 0, 1); PG8_STAGE_B(PG8_SB(0, 0), b2); PG8_STAGE_B(PG8_SB(0, 1), b2 + hstep); PG8_STAGE_A(PG8_SA(0, 0), cof[0], k2);
            PG8_WAIT_V(8); PG8_WAIT_L(0); PG8_BAR; PG8_MMA(1, 0, At, B0); PG8_MMA(1, 1, At, B1); PG8_BAR; PG8_SCHED;
            PG8_LDB(B0, 1, 0); PG8_LDB(B1, 1, 1); PG8_SCHED; PG8_LDA(At, 1, 0); PG8_STAGE_A(PG8_SA(0, 1), cof[1], k2);
            PG8_WAIT_V(8); PG8_WAIT_L(0); PG8_BAR; PG8_MMA(0, 0, At, B0); PG8_MMA(0, 1, At, B1); PG8_BAR; PG8_SCHED;
            PG8_LDA(At, 1, 1); PG8_STAGE_B(PG8_SB(1, 0), b3); PG8_STAGE_B(PG8_SB(1, 1), b3 + hstep); PG8_STAGE_A(PG8_SA(1, 0), cof[0], k3);
            PG8_WAIT_V(8); PG8_WAIT_L(0); PG8_BAR; PG8_MMA(1, 0, At, B0); PG8_MMA(1, 1, At, B1); PG8_BAR; PG8_SCHED;
        }
        if (wr == 0) PG8_BAR;
        { const int l2 = otid() & 63; E(acc, cur, wr, wc, l2 & 15, l2 >> 4); }
        if (!has_next) break;
#pragma unroll
        for (int a = 0; a < 2; ++a)
#pragma unroll
            for (int b = 0; b < 2; ++b)
#pragma unroll
                for (int m = 0; m < 4; ++m)
#pragma unroll
                    for (int n = 0; n < 2; ++n) acc[a][b][m][n] = (f32x4){0.f, 0.f, 0.f, 0.f};
        cur = nxt; cB = nB; ++ui;
        if (wr == 1) PG8_BAR;
    }
    PG8_WAIT_V(0);
    PG8_BAR;
#undef PG8_SA
#undef PG8_SB
#undef PG8_STAGE_A
#undef PG8_STAGE_B
#undef PG8_LDA
#undef PG8_LDB
#undef PG8_MMA
#undef PG8_WAIT_V
#undef PG8_WAIT_L
#undef PG8_BAR
#undef PG8_SCHED
#undef PG8_AOFFS
}

#define PG8_FENCE asm volatile("" ::: "memory")
#define PG8_FOR_TILE(ai, m, bj) _Pragma("unroll") for (int ai = 0; ai < 2; ++ai) _Pragma("unroll") for (int m = 0; m < 4; ++m) _Pragma("unroll") for (int bj = 0; bj < 2; ++bj)
__device__ __forceinline__ u32x4 pack8(const f32x4& v0, const f32x4& v1) { u32x4 w; w.x = cvt_pk_bf16(v0[0], v0[1]); w.y = cvt_pk_bf16(v0[2], v0[3]); w.z = cvt_pk_bf16(v1[0], v1[1]); w.w = cvt_pk_bf16(v1[2], v1[3]); return w; }
__device__ __forceinline__ float sigm(float x) { return 1.f / (1.f + __expf(-x)); }
struct EpiInproj {
    static constexpr bool PERM = true;
    unsigned char* ws; bf16_t* gates;
    __device__ __forceinline__ void operator()(const f32x4 (&acc)[2][2][4][2], const Unit& u, int wr, int wc, int fr, int fq) const {
        PG8_FOR_TILE(ai, m, bj) { PG8_FENCE;
            int row = u.pm * BM + ai * HALF + wr * 64 + m * 16 + fr; asm volatile("" : "+v"(row)); const int col = u.pn * BM + bj * HALF + wc * 32 + 8 * fq;
            const f32x4 v0 = acc[ai][bj][m][0], v1 = acc[ai][bj][m][1];
            if (col < C_KV) *(u32x4*)((bf16_t*)(ws + WS_Q) + (size_t)row * AW + col) = pack8(v0, v1);
            else if (col < C_QI) {
                *(u32x4*)((bf16_t*)(ws + WS_KVN) + (size_t)row * KVL + (col - C_KV)) = pack8(v0, v1);
                float ss = (v0[0] * v0[0] + v0[1] * v0[1]) + (v0[2] * v0[2] + v0[3] * v0[3]) + (v1[0] * v1[0] + v1[1] * v1[1]) + (v1[2] * v1[2] + v1[3] * v1[3]);
                ss += __shfl_xor(ss, 16); ss += __shfl_xor(ss, 32);
                if (fq == 0) atomicAdd((float*)(ws + WS_RSS) + row, ss);
            }
            else if (col < C_PS) {
                if (col < 1056) {
                    typedef _Float16 h8 __attribute__((ext_vector_type(8)));
                    h8 hv; hv[0] = (_Float16)v0[0]; hv[1] = (_Float16)v0[1]; hv[2] = (_Float16)v0[2]; hv[3] = (_Float16)v0[3]; hv[4] = (_Float16)v1[0]; hv[5] = (_Float16)v1[1]; hv[6] = (_Float16)v1[2]; hv[7] = (_Float16)v1[3];
                    _Float16* d = (col < 1024) ? (_Float16*)(ws + WS_QI) + (size_t)row * 256 + (col - C_QI) : (_Float16*)(ws + WS_KI) + (size_t)row * 32 + (col - 1024);
                    *(h8*)d = hv;
                } else { const float sc_ = 0.17677669529663687f * 0.35355339059327373f; float* d = (float*)(ws + WS_WI) + (size_t)row * 8; *(f32x4*)d = v0 * sc_; *(f32x4*)(d + 4) = v1 * sc_; }
            }
            else if (col < C_GA) *(u32x4*)((bf16_t*)(ws + WS_PS) + (size_t)row * SHW + (col - C_PS)) = pack8(v0, v1);
            else if (col < INW) {
                f32x4 s0, s1;
#pragma unroll
                for (int e = 0; e < 4; ++e) { s0[e] = sigm(v0[e]); s1[e] = sigm(v1[e]); }
                bf16_t* d = (col < C_GR) ? gates + (size_t)row * DM + (col - C_GA) : gates + (size_t)NT * DM + (size_t)row * DM + (col - C_GR);
                *(u32x4*)d = pack8(s0, s1);
            }
        }
    }
};
struct EpiKV {
    static constexpr bool PERM = true;
    unsigned char* ws;
    __device__ __forceinline__ void operator()(const f32x4 (&acc)[2][2][4][2], const Unit& u, int wr, int wc, int fr, int fq) const {
        PG8_FOR_TILE(ai, m, bj) { PG8_FENCE;
            int row = u.pm * BM + ai * HALF + wr * 64 + m * 16 + fr; asm volatile("" : "+v"(row)); const int col = u.pn * BM + bj * HALF + wc * 32 + 8 * fq;
            const float rstd = rsqrtf(((const float*)(ws + WS_RSS))[row] * (1.f / KVL) + NORM_EPS);
            if (col < AW) *(u32x4*)((bf16_t*)(ws + WS_K) + (size_t)row * AW + col) = pack8(acc[ai][bj][m][0] * rstd, acc[ai][bj][m][1] * rstd);
            else {
                bf16_t* d = (bf16_t*)(ws + WS_V) + ((size_t)(row / SEQ) * 512 + (col - AW)) * SEQ + (row % SEQ);
#pragma unroll
                for (int e = 0; e < 4; ++e) { d[(size_t)e * SEQ] = f2bf(acc[ai][bj][m][0][e] * rstd); d[(size_t)(4 + e) * SEQ] = f2bf(acc[ai][bj][m][1][e] * rstd); }
            }
        }
    }
};
struct EpiMerge {
    static constexpr bool PERM = true;
    bf16_t* merged; const bf16_t* gates;
    __device__ __forceinline__ void operator()(const f32x4 (&acc)[2][2][4][2], const Unit& u, int wr, int wc, int fr, int fq) const {
        const bf16_t* gate = gates + (size_t)u.aux * NT * DM;
        PG8_FOR_TILE(ai, m, bj) { PG8_FENCE;
            int row = u.pm * BM + ai * HALF + wr * 64 + m * 16 + fr; asm volatile("" : "+v"(row)); const int col = u.pn * BM + bj * HALF + wc * 32 + 8 * fq;
            const u32x4 gw = *(const u32x4*)(gate + (size_t)row * DM + col);
            f32x4 v0 = acc[ai][bj][m][0], v1 = acc[ai][bj][m][1];
            v0[0] *= __uint_as_float(gw.x << 16); v0[1] *= __uint_as_float(gw.x & 0xffff0000u); v0[2] *= __uint_as_float(gw.y << 16); v0[3] *= __uint_as_float(gw.y & 0xffff0000u);
            v1[0] *= __uint_as_float(gw.z << 16); v1[1] *= __uint_as_float(gw.z & 0xffff0000u); v1[2] *= __uint_as_float(gw.w << 16); v1[3] *= __uint_as_float(gw.w & 0xffff0000u);
            u32x4* d = (u32x4*)(merged + (size_t)row * DM + col);
            if (u.aux) { const u32x4 pw = *d;
                v0[0] += __uint_as_float(pw.x << 16); v0[1] += __uint_as_float(pw.x & 0xffff0000u); v0[2] += __uint_as_float(pw.y << 16); v0[3] += __uint_as_float(pw.y & 0xffff0000u);
                v1[0] += __uint_as_float(pw.z << 16); v1[1] += __uint_as_float(pw.z & 0xffff0000u); v1[2] += __uint_as_float(pw.w << 16); v1[3] += __uint_as_float(pw.w & 0xffff0000u); }
            *d = pack8(v0, v1);
        }
    }
};
struct EpiOut {
    static constexpr bool PERM = false;
    const float* x; const float* mod; float* out;
    __device__ __forceinline__ void operator()(const f32x4 (&acc)[2][2][4][2], const Unit& u, int wr, int wc, int fr, int fq) const {
        PG8_FOR_TILE(ai, m, bj) { PG8_FENCE;
            int row = u.pm * BM + ai * HALF + wr * 64 + m * 16 + fr; asm volatile("" : "+v"(row)); const float* gt = mod + (row / SEQ) * 6 * DM + 2 * DM;
#pragma unroll
            for (int n = 0; n < 2; ++n) { const int col = u.pn * BM + bj * HALF + wc * 32 + 16 * n + 4 * fq;
                const f32x4 xv = *(const f32x4*)(x + (size_t)row * DM + col), gv = *(const f32x4*)(gt + col);
                *(f32x4*)(out + (size_t)row * DM + col) = xv + gv * acc[ai][bj][m][n]; }
        }
    }
};
struct EpiMoe1 {
    static constexpr bool PERM = true;
    bf16_t* hid; const float* lw;
    __device__ __forceinline__ void operator()(const f32x4 (&acc)[2][2][4][2], const Unit& u, int wr, int wc, int fr, int fq) const {
#pragma unroll
        for (int ai = 0; ai < 2; ++ai)
#pragma unroll
            for (int m = 0; m < 4; ++m) {
                const int tr = ai * HALF + wr * 64 + m * 16 + fr; PG8_FENCE;
                if (tr < u.aux) {
                    const float w = lw[u.arow + tr]; f32x4 h0, h1;
#pragma unroll
                    for (int e = 0; e < 4; ++e) { const float g0 = acc[ai][0][m][0][e], g1 = acc[ai][0][m][1][e];
                        h0[e] = w * (g0 / (1.f + __expf(-g0))) * acc[ai][1][m][0][e]; h1[e] = w * (g1 / (1.f + __expf(-g1))) * acc[ai][1][m][1][e]; }
                    *(u32x4*)(hid + (size_t)(u.arow + tr) * DE + u.pn * HALF + wc * 32 + 8 * fq) = pack8(h0, h1);
                }
            }
    }
};
struct EpiMoe2 {
    static constexpr bool PERM = false;
    const int* ltok; const float* mod; float* out;
    __device__ __forceinline__ void operator()(const f32x4 (&acc)[2][2][4][2], const Unit& u, int wr, int wc, int fr, int fq) const {
#pragma unroll
        for (int ai = 0; ai < 2; ++ai)
#pragma unroll
            for (int m = 0; m < 4; ++m) {
                const int tr = ai * HALF + wr * 64 + m * 16 + fr; PG8_FENCE;
                if (tr < u.aux) {
                    const int tok = ltok[u.arow + tr]; const float* gt = mod + (tok / SEQ) * 6 * DM + 5 * DM; float* orow = out + (size_t)tok * DM;
#pragma unroll
                    for (int bj = 0; bj < 2; ++bj)
#pragma unroll
                        for (int n = 0; n < 2; ++n) { const int col = u.pn * BM + bj * HALF + wc * 32 + 16 * n + 4 * fq;
                            const f32x4 gv = *(const f32x4*)(gt + col); f32x4* d = (f32x4*)(orow + col); *d = *d + gv * acc[ai][bj][m][n]; }
                }
            }
    }
};
}

__device__ __forceinline__ unsigned pk2(float lo, float hi) { return (unsigned)f2bf(lo) | ((unsigned)f2bf(hi) << 16); }
__device__ __forceinline__ void transpose_item(const float* W, int K, int N, bf16_t* WT, size_t drow0, int k0, int n0, float* scr, int lane, int Ksrc = 1 << 30, const float* kscale = nullptr) {
#pragma unroll 8
    for (int i = 0; i < 32; ++i) { const int kk = 2 * i + (lane >> 5), n = n0 + (lane & 31); float v_ = (n < N && k0 + kk < Ksrc) ? W[(size_t)(k0 + kk) * N + n] : 0.f; if (kscale) v_ *= kscale[k0 + kk]; scr[kk * 33 + (lane & 31)] = v_; }
    asm volatile("s_waitcnt lgkmcnt(0)" ::: "memory");
    const int c = lane & 7;
#pragma unroll
    for (int j = 0; j < 4; ++j) { const int n = (lane >> 3) + 8 * j; const float* s_ = scr + (8 * c) * 33 + n;
        uint4 o; o.x = pk2(s_[0 * 33], s_[1 * 33]); o.y = pk2(s_[2 * 33], s_[3 * 33]); o.z = pk2(s_[4 * 33], s_[5 * 33]); o.w = pk2(s_[6 * 33], s_[7 * 33]);
        *(uint4*)(WT + (drow0 + n) * K + k0 + 8 * c) = o; }
    asm volatile("s_waitcnt lgkmcnt(0)" ::: "memory");
}
__device__ void ph_convert_mixer_weights(const P& p, float* lds) {
    const int lane = otid() & 63, wv = otid() >> 6;
    float* scr = lds + wv * (64 * 33);
    const int gw = blockIdx.x * (NTHR / 64) + wv, nw = gridDim.x * (NTHR / 64);
    struct M { const float* W; int K, N, Npad; size_t dst; const float* ks; };
    const M ms[5] = { {p.in[5], DM, INW, 5120, WS_WIN, nullptr}, {p.in[7], KVL, 2 * AW, 2 * AW, WS_WKV, p.in[6]}, {p.in[21], AW, DM, DM, WS_WBA, nullptr}, {p.in[22], RW, DM, DM, WS_WBR, nullptr}, {p.in[23], DM, DM, DM, WS_WOUT, nullptr} };
    int base = 0;
#pragma unroll
    for (int q = 0; q < 5; ++q) {
        const int nkb = ms[q].K / 64, nnb = ms[q].Npad / 32, nitems = nkb * nnb;
        for (int it = gw; it < base + nitems; it += nw) { if (it < base) continue; const int r = it - base; const int kb = r / nnb, nb = r % nnb;
            transpose_item(ms[q].W, ms[q].K, ms[q].N, (bf16_t*)(p.ws + ms[q].dst), (size_t)nb * 32, kb * 64, nb * 32, scr, lane, 1 << 30, ms[q].ks); }
        base += nitems;
    }
}
__device__ void ph_convert_lora_weights(const P& p, float* lds) {
    const int lane = otid() & 63, wv = otid() >> 6;
    float* scr = lds + wv * (64 * 33);
    const int gw = blockIdx.x * (NTHR / 64) + wv, nw = gridDim.x * (NTHR / 64);
    for (int it = gw; it < 16 + 16 + 48; it += nw) {
        if (it < 16) transpose_item(p.in[12], 64, RW, (bf16_t*)(p.ws + WS_LW2T), (size_t)it * 32, 0, it * 32, scr, lane);
        else if (it < 32) transpose_item(p.in[14], 64, RW, (bf16_t*)(p.ws + WS_LA2T), (size_t)(it - 16) * 32, 0, (it - 16) * 32, scr, lane);
        else { const int r = it - 32, kb = r >> 4, nb = r & 15; transpose_item(p.in[15], 192, RW, (bf16_t*)(p.ws + WS_LG2T), (size_t)nb * 32, kb * 64, nb * 32, scr, lane, 160); }
    }
}
__device__ void ph_convert_expert_weights(const P& p, float* lds) {
    const int lane = otid() & 63, wv = otid() >> 6;
    float* scr = lds + wv * (64 * 33);
    const int gw = blockIdx.x * (NTHR / 64) + wv, nw = gridDim.x * (NTHR / 64);
    for (int it = gw; it < NE * 2 * 256; it += nw) { const int e = it >> 9, which = (it >> 8) & 1, r = it & 255, kb = r >> 4, nb = r & 15, n0 = nb * 32;
        transpose_item(p.in[28 + which] + (size_t)e * DM * DE, DM, DE, (bf16_t*)(p.ws + WS_WGU), (size_t)e * 1024 + (n0 >> 7) * 256 + which * 128 + (n0 & 127), kb * 64, n0, scr, lane); }
    for (int it = gw; it < NE * 256; it += nw) { const int e = it >> 8, r = it & 255, kb = r >> 5, nb = r & 31;
        transpose_item(p.in[30] + (size_t)e * DE * DM, DE, DM, (bf16_t*)(p.ws + WS_WDN), (size_t)e * 1024 + nb * 32, kb * 64, nb * 32, scr, lane); }
}

__device__ void ph_headnorm(bf16_t* X, const float* g) {
    const int lane = otid() & 63, wv = otid() >> 6;
    const int gw = blockIdx.x * (NTHR / 64) + wv, nw = gridDim.x * (NTHR / 64);
    for (int m = gw; m < NT; m += nw) {
        uint4 raw = *(const uint4*)(X + (size_t)m * AW + lane * 8);
        float v[8] = {bf2f(raw.x & 0xffff), bf2f(raw.x >> 16), bf2f(raw.y & 0xffff), bf2f(raw.y >> 16), bf2f(raw.z & 0xffff), bf2f(raw.z >> 16), bf2f(raw.w & 0xffff), bf2f(raw.w >> 16)};
        float ss = 0.f;
#pragma unroll
        for (int i = 0; i < 8; ++i) ss += v[i] * v[i];
        ss += __shfl_xor(ss, 1); ss += __shfl_xor(ss, 2); ss += __shfl_xor(ss, 4);
        const float rstd = rsqrtf(ss * (1.f / 64.f) + NORM_EPS);
        const int d0 = (lane & 7) * 8;
        unsigned o[4];
#pragma unroll
        for (int i = 0; i < 4; ++i) o[i] = (unsigned)f2bf(v[2 * i] * rstd * g[d0 + 2 * i]) | ((unsigned)f2bf(v[2 * i + 1] * rstd * g[d0 + 2 * i + 1]) << 16);
        *(uint4*)(X + (size_t)m * AW + lane * 8) = make_uint4(o[0], o[1], o[2], o[3]);
    }
}
__device__ void ph_kvnorm(bf16_t* X, const float* g) {
    const int lane = otid() & 63, wv = otid() >> 6;
    const int gw = blockIdx.x * (NTHR / 64) + wv, nw = gridDim.x * (NTHR / 64);
    for (int m = gw; m < NT; m += nw) {
        uint2 raw = *(const uint2*)(X + (size_t)m * KVL + lane * 4);
        float v[4] = {bf2f(raw.x & 0xffff), bf2f(raw.x >> 16), bf2f(raw.y & 0xffff), bf2f(raw.y >> 16)};
        float ss = wave_sum(v[0] * v[0] + v[1] * v[1] + v[2] * v[2] + v[3] * v[3]);
        const float rstd = rsqrtf(ss * (1.f / 256.f) + NORM_EPS);
        uint2 o; o.x = (unsigned)f2bf(v[0] * rstd * g[lane * 4]) | ((unsigned)f2bf(v[1] * rstd * g[lane * 4 + 1]) << 16);
        o.y = (unsigned)f2bf(v[2] * rstd * g[lane * 4 + 2]) | ((unsigned)f2bf(v[3] * rstd * g[lane * 4 + 3]) << 16);
        *(uint2*)(X + (size_t)m * KVL + lane * 4) = o;
    }
}

typedef _Float16 half8_t __attribute__((ext_vector_type(8)));
typedef float f32x16_t __attribute__((ext_vector_type(16)));
__device__ __forceinline__ unsigned f2key(float f) { unsigned u = __float_as_uint(f); return (u & 0x80000000u) ? ~u : (u | 0x80000000u); }
__device__ void ph_dsa_select(const P& p, float* ldsf) {
    const _Float16* QI = (const _Float16*)(p.ws + WS_QI); const _Float16* KI = (const _Float16*)(p.ws + WS_KI); const float* WI = (const float*)(p.ws + WS_WI);
    unsigned* MASK32 = (unsigned*)(p.ws + WS_MASK);
    unsigned* hist = (unsigned*)ldsf;
    uint2* cand = (uint2*)(hist + 8 * 2048);
    unsigned* maskl = (unsigned*)(cand + 8 * 1024);
    unsigned* h2 = hist;
    int* misc = (int*)(maskl + 8 * 256);
    constexpr int CCAP = 1024;
    const int tid = otid(), lane = tid & 63, wv = tid >> 6, hh = lane >> 5, r32 = lane & 31;
    for (int item = blockIdx.x; item < NT / 8; item += gridDim.x) {
        const int tq0 = item * 8, b = tq0 / SEQ, t0 = tq0 % SEQ;
        const int nwords = ((t0 >> 8) + 1) * 8;
        __syncthreads();
        if (t0 + 7 < TOPK) {
            for (int e = tid; e < 8 * nwords; e += NTHR) { const int row = e / nwords, w = e % nwords; const int tr_ = t0 + row; const int lo = 32 * w;
                const unsigned bits = (tr_ >= lo + 31) ? 0xffffffffu : ((tr_ < lo) ? 0u : ((2u << (tr_ - lo)) - 1u));
                MASK32[(size_t)(tq0 + row) * 256 + w] = bits; }
            continue;
        }
        for (int e = tid; e < 8 * 2048; e += NTHR) hist[e] = 0u;
        for (int e = tid; e < 8 * 256; e += NTHR) maskl[e] = 0u;
        if (tid < 64) misc[tid] = 0;
        half8_t a0[2], a1[2]; float w[2][4][4];
#pragma unroll
        for (int rg = 0; rg < 2; ++rg) { const int tl_a = r32 >> 3, h_a = r32 & 7; const _Float16* qp = QI + (size_t)(tq0 + 4 * rg + tl_a) * 256 + h_a * 32 + 8 * hh;
            a0[rg] = *(const half8_t*)qp; a1[rg] = *(const half8_t*)(qp + 16);
#pragma unroll
            for (int tl = 0; tl < 4; ++tl) { const float4 wv4 = *(const float4*)(WI + (size_t)(tq0 + 4 * rg + tl) * 8 + 4 * hh); w[rg][tl][0] = wv4.x; w[rg][tl][1] = wv4.y; w[rg][tl][2] = wv4.z; w[rg][tl][3] = wv4.w; } }
        const int ntile = (t0 + 7) / 32 + 1;
        __syncthreads();
        int thr_bin[8];
#pragma unroll 1
        for (int pass = 0; pass < 2; ++pass) {
            if (pass == 1) {
#pragma unroll
                for (int r = 0; r < 8; ++r) thr_bin[r] = misc[r * 8];
            }
            half8_t kb0[4], kb1[4], nk0[4], nk1[4];
#pragma unroll
            for (int q = 0; q < 4; ++q) { const int tl_ = min(4 * wv + q, ntile - 1); const _Float16* kp = KI + (size_t)(b * SEQ + tl_ * 32 + r32) * 32 + 8 * hh; nk0[q] = *(const half8_t*)kp; nk1[q] = *(const half8_t*)(kp + 16); }
            for (int tbase = 4 * wv; tbase < ntile; tbase += 32) {
#pragma unroll
                for (int q = 0; q < 4; ++q) { kb0[q] = nk0[q]; kb1[q] = nk1[q]; }
                if (tbase + 32 < ntile) {
#pragma unroll
                    for (int q = 0; q < 4; ++q) { const int tl_ = min(tbase + 32 + q, ntile - 1); const _Float16* kp = KI + (size_t)(b * SEQ + tl_ * 32 + r32) * 32 + 8 * hh; nk0[q] = *(const half8_t*)kp; nk1[q] = *(const half8_t*)(kp + 16); }
                }
#pragma unroll
                for (int q = 0; q < 4; ++q) {
                const int tile = tbase + q;
                if (tile < ntile) {
                const half8_t b0 = kb0[q], b1 = kb1[q];
                const int key = tile * 32 + r32;
#pragma unroll
                for (int rg = 0; rg < 2; ++rg) {
                    f32x16_t c;
#pragma unroll
                    for (int i = 0; i < 16; ++i) c[i] = 0.f;
                    c = __builtin_amdgcn_mfma_f32_32x32x16_f16(a0[rg], b0, c, 0, 0, 0);
                    c = __builtin_amdgcn_mfma_f32_32x32x16_f16(a1[rg], b1, c, 0, 0, 0);
                    float x[4];
#pragma unroll
                    for (int tl = 0; tl < 4; ++tl) { x[tl] = 0.f;
#pragma unroll
                        for (int e = 0; e < 4; ++e) x[tl] = __builtin_fmaf(w[rg][tl][e], __int_as_float(max(__float_as_int(c[4 * tl + e]), 0)), x[tl]); }
                    const auto s01 = __builtin_amdgcn_permlane32_swap(__float_as_uint(x[0]), __float_as_uint(x[1]), false, false);
                    const auto s23 = __builtin_amdgcn_permlane32_swap(__float_as_uint(x[2]), __float_as_uint(x[3]), false, false);
                    const unsigned k01 = f2key(__uint_as_float(s01[0]) + __uint_as_float(s01[1]));
                    const unsigned k23 = f2key(__uint_as_float(s23[0]) + __uint_as_float(s23[1]));
                    const int rowA = 4 * rg + hh, rowB = 4 * rg + 2 + hh;
                    const bool okA = key <= t0 + rowA, okB = key <= t0 + rowB;
                    if (pass == 0) {
                        atomicAdd(&hist[okA ? rowA * 2048 + (int)(k01 >> 21) : 8 * 2048 + 16384 + 2048 + 7], 1u << (16 * ((k01 >> 20) & 1u)));
                        atomicAdd(&hist[okB ? rowB * 2048 + (int)(k23 >> 21) : 8 * 2048 + 16384 + 2048 + 7], 1u << (16 * ((k23 >> 20) & 1u)));
                    } else {
                        const int tbA = hh ? thr_bin[4 * rg + 1] : thr_bin[4 * rg], tbB = hh ? thr_bin[4 * rg + 3] : thr_bin[4 * rg + 2];
                        const int binA = (int)(k01 >> 20), binB = (int)(k23 >> 20);
                        const unsigned long long mA = __ballot(okA && binA > tbA), mB = __ballot(okB && binB > tbB);
                        if (r32 == 0) { maskl[rowA * 256 + tile] = hh ? (unsigned)(mA >> 32) : (unsigned)mA; maskl[rowB * 256 + tile] = hh ? (unsigned)(mB >> 32) : (unsigned)mB; }
                        if (okA && binA == tbA) { const int pos = atomicAdd(&misc[rowA * 8 + 2], 1); if (pos < CCAP) cand[rowA * CCAP + pos] = make_uint2(k01, (unsigned)key); }
                        if (okB && binB == tbB) { const int pos = atomicAdd(&misc[rowB * 8 + 2], 1); if (pos < CCAP) cand[rowB * CCAP + pos] = make_uint2(k23, (unsigned)key); }
                    }
                }
                }
                }
            }
            __syncthreads();
            if (pass == 0) {
                const unsigned* hr = hist + wv * 2048 + 32 * lane; unsigned tot = 0;
#pragma unroll 8
                for (int i = 0; i < 32; ++i) { const unsigned v = hr[i]; tot += (v & 0xffffu) + (v >> 16); }
                unsigned suf = tot;
#pragma unroll
                for (int o = 1; o < 64; o <<= 1) { const unsigned oth = __shfl_down(suf, o); if (lane + o < 64) suf += oth; }
                unsigned above = suf - tot;
                if ((int)above < TOPK && TOPK <= (int)(above + tot)) {
                    int bsel = 0, need = 0;
                    for (int i = 31; i >= 0; --i) { const unsigned v = hr[i]; const unsigned chi = v >> 16, clo = v & 0xffffu;
                        if ((int)above < TOPK && TOPK <= (int)(above + chi)) { bsel = 64 * lane + 2 * i + 1; need = TOPK - (int)above; above = 0x7fffffffu; }
                        else if ((int)above < TOPK) above += chi;
                        if ((int)above < TOPK && TOPK <= (int)(above + clo)) { bsel = 64 * lane + 2 * i; need = TOPK - (int)above; above = 0x7fffffffu; }
                        else if ((int)above < TOPK) above += clo; }
                    misc[wv * 8] = bsel; misc[wv * 8 + 1] = need; }
                __syncthreads();
            }
        }
        {
            const int row = wv, need0 = misc[row * 8 + 1]; const int cn = min(misc[row * 8 + 2], CCAP);
            const uint2* cr = cand + row * CCAP; unsigned* hrow = h2 + row * 256;
            unsigned prefix = 0; int remaining = need0, cnt_eq = cn;
#pragma unroll 1
            for (int pass = 0; pass < 3; ++pass) {
                const int shift = (pass == 0) ? 12 : ((pass == 1) ? 4 : 0), nb = (pass == 2) ? 4 : 8;
                for (int i = lane; i < 256; i += 64) hrow[i] = 0u;
                __builtin_amdgcn_wave_barrier(); asm volatile("s_waitcnt lgkmcnt(0)" ::: "memory");
                for (int i = lane; i < cn; i += 64) { const unsigned k = cr[i].x & 0xfffffu; if (pass == 0 || (k >> (shift + nb)) == (prefix >> (shift + nb))) atomicAdd(&hrow[(k >> shift) & ((1u << nb) - 1u)], 1u); }
                __builtin_amdgcn_wave_barrier(); asm volatile("s_waitcnt lgkmcnt(0)" ::: "memory");
                const unsigned h0 = hrow[4 * lane], h1 = hrow[4 * lane + 1], h2_ = hrow[4 * lane + 2], h3 = hrow[4 * lane + 3];
                unsigned suf = h0 + h1 + h2_ + h3;
#pragma unroll
                for (int o = 1; o < 64; o <<= 1) { const unsigned oth = __shfl_down(suf, o); if (lane + o < 64) suf += oth; }
                const unsigned above3 = suf - (h0 + h1 + h2_ + h3);
                const unsigned ab[4] = {above3 + h3 + h2_ + h1, above3 + h3 + h2_, above3 + h3, above3}; const unsigned hv[4] = {h0, h1, h2_, h3};
                int selbin = -1, newrem = 0, neweq = 0;
#pragma unroll
                for (int q = 0; q < 4; ++q) if ((int)ab[q] < remaining && remaining <= (int)(ab[q] + hv[q])) { selbin = 4 * lane + q; newrem = remaining - (int)ab[q]; neweq = (int)hv[q]; }
                const unsigned long long has = __ballot(selbin >= 0); const int src = __ffsll((long long)has) - 1;
                selbin = __shfl(selbin, src); newrem = __shfl(newrem, src); neweq = __shfl(neweq, src);
                prefix |= ((unsigned)selbin) << shift; remaining = newrem; cnt_eq = neweq;
            }
            for (int i0 = 0; i0 < cn; i0 += 64) { const int i = i0 + lane; bool sel = false;
                if (i < cn) { const uint2 ce = cr[i]; const unsigned k = ce.x & 0xfffffu;
                    if (k > prefix) sel = true;
                    else if (k == prefix) { if (cnt_eq == remaining) sel = true; else { int rank = 0; for (int j = 0; j < cn; ++j) { const uint2 cj = cr[j]; rank += ((cj.x & 0xfffffu) == prefix && cj.y < ce.y) ? 1 : 0; } sel = rank < remaining; } }
                    if (sel) atomicOr(&maskl[row * 256 + (ce.y >> 5)], 1u << (ce.y & 31)); } }
        }
        __syncthreads();
        for (int e = tid; e < 8 * nwords; e += NTHR) { const int row = e / nwords, w2 = e % nwords; MASK32[(size_t)(tq0 + row) * 256 + w2] = maskl[row * 256 + w2]; }
    }
}

typedef unsigned u32x4_t __attribute__((ext_vector_type(4)));
typedef __bf16 bf2_t __attribute__((ext_vector_type(2)));
typedef float f2_t __attribute__((ext_vector_type(2)));
__device__ __forceinline__ unsigned pk_bf16(float lo, float hi) { const f2_t v = {lo, hi}; return __builtin_bit_cast(unsigned, __builtin_convertvector(v, bf2_t)); }
__device__ __forceinline__ bf16x8_t pack_step16(const f32x16_t& x, int s2) {
    u32x4_t pk;
    if (s2 == 0) { pk[0] = pk_bf16(x[0], x[1]); pk[1] = pk_bf16(x[2], x[3]); pk[2] = pk_bf16(x[4], x[5]); pk[3] = pk_bf16(x[6], x[7]); }
    else { pk[0] = pk_bf16(x[8], x[9]); pk[1] = pk_bf16(x[10], x[11]); pk[2] = pk_bf16(x[12], x[13]); pk[3] = pk_bf16(x[14], x[15]); }
    return __builtin_bit_cast(bf16x8_t, pk);
}
__device__ __forceinline__ float xhalf_max(float x) { const auto t = __builtin_amdgcn_permlane32_swap(__float_as_uint(x), __float_as_uint(x), false, false); return fmaxf(__uint_as_float(t[0]), __uint_as_float(t[1])); }
__device__ __forceinline__ float xhalf_sum(float x) { const auto t = __builtin_amdgcn_permlane32_swap(__float_as_uint(x), __float_as_uint(x), false, false); return __uint_as_float(t[0]) + __uint_as_float(t[1]); }
__device__ __forceinline__ short bf16_of_int(int v) { return (short)(__float_as_uint((float)v) >> 16); }
#define MFMA32(a, b, c) __builtin_amdgcn_mfma_f32_32x32x16_bf16((a), (b), (c), 0, 0, 0)
__device__ void ph_dsa_attn(const P& p, float* ldsf) {
    const unsigned long long* MASK = (const unsigned long long*)(p.ws + WS_MASK);
    const bf16_t* Q = (const bf16_t*)(p.ws + WS_Q); const bf16_t* Kg = (const bf16_t*)(p.ws + WS_K); const bf16_t* VT = (const bf16_t*)(p.ws + WS_V);
    bf16_t* O = (bf16_t*)(p.ws + WS_OATT);
    bf16_t* L = (bf16_t*)ldsf;
    const int tid = otid(), lane = tid & 63, wv = tid >> 6, hh = lane >> 5, r32 = lane & 31;
    const float CS = 0.125f * 1.4426950408889634f;
    const float NEG = -1e30f;
    const int skey = tid >> 3, sch = (tid & 7) * 8;
    const float* qg = p.in[8];
    float kgv[8]; { const float4 g0 = *(const float4*)(p.in[9] + sch), g1 = *(const float4*)(p.in[9] + sch + 4); kgv[0] = g0.x; kgv[1] = g0.y; kgv[2] = g0.z; kgv[3] = g0.w; kgv[4] = g1.x; kgv[5] = g1.y; kgv[6] = g1.z; kgv[7] = g1.w; }
    auto knorm = [&](uint4 kr) -> uint4 {
        const unsigned w[4] = {kr.x, kr.y, kr.z, kr.w}; float v[8]; float ss = 0.f;
#pragma unroll
        for (int e = 0; e < 8; ++e) { v[e] = (e & 1) ? __uint_as_float(w[e >> 1] & 0xffff0000u) : __uint_as_float(w[e >> 1] << 16); ss += v[e] * v[e]; }
        ss += __shfl_xor(ss, 1); ss += __shfl_xor(ss, 2); ss += __shfl_xor(ss, 4);
        const float rstd = rsqrtf(ss * (1.f / 64.f) + NORM_EPS);
        return make_uint4(pk_bf16(v[0] * rstd * kgv[0], v[1] * rstd * kgv[1]), pk_bf16(v[2] * rstd * kgv[2], v[3] * rstd * kgv[3]), pk_bf16(v[4] * rstd * kgv[4], v[5] * rstd * kgv[5]), pk_bf16(v[6] * rstd * kgv[6], v[7] * rstd * kgv[7]));
    };
    int* qhead = (int*)(p.ws + WS_CTL) + CT_Q; int* bcast = (int*)(L + 4 * SLOT);
    for (int tr_ = 0; tr_ < 8; ++tr_) {
        const int grp = (blockIdx.x + tr_) & 7;
        for (;;) {
            __syncthreads();
            if (tid == 0) *bcast = atomicAdd(qhead + grp, 1);
            __syncthreads();
            const int kq = *bcast;
            if (kq >= 64) break;
            const int bh = grp + 8 * (kq & 1), qb = 31 - (kq >> 1), b = bh >> 3, h = bh & 7;
            const bf16_t* Kbase = Kg + (size_t)b * SEQ * AW + h * 64; const bf16_t* Vbase = VT + (size_t)bh * 64 * SEQ;
            {
            const int q0 = qb * 256 + wv * 32, q = q0 + r32, ntile = 4 * (qb + 1);
            const size_t qrow = (size_t)b * SEQ + q;
            bf16x8_t bq[5];
#pragma unroll
            for (int s2 = 0; s2 < 4; ++s2) bq[s2] = *(const bf16x8_t*)(Q + qrow * AW + h * 64 + 16 * s2 + 8 * hh);
            {
                float ss = 0.f;
#pragma unroll
                for (int s2 = 0; s2 < 4; ++s2)
#pragma unroll
                    for (int j = 0; j < 8; ++j) { const float v = bf2f((bf16_t)bq[s2][j]); ss += v * v; }
                ss = xhalf_sum(ss);
                const float rstd = rsqrtf(ss * (1.f / 64.f) + NORM_EPS);
#pragma unroll
                for (int s2 = 0; s2 < 4; ++s2) { const float4 g0 = *(const float4*)(qg + 16 * s2 + 8 * hh), g1 = *(const float4*)(qg + 16 * s2 + 8 * hh + 4); const float gv[8] = {g0.x, g0.y, g0.z, g0.w, g1.x, g1.y, g1.z, g1.w};
                    u32x4_t w;
#pragma unroll
                    for (int j2 = 0; j2 < 4; ++j2) w[j2] = pk_bf16(bf2f((bf16_t)bq[s2][2 * j2]) * rstd * gv[2 * j2], bf2f((bf16_t)bq[s2][2 * j2 + 1]) * rstd * gv[2 * j2 + 1]);
                    bq[s2] = __builtin_bit_cast(bf16x8_t, w); }
            }
#pragma unroll
            for (int j = 0; j < 8; ++j) bq[4][j] = 0;
            if (hh == 0) { bq[4][0] = bf16_of_int(256 >> h); bq[4][1] = (short)(__float_as_uint(4.f / (float)(1 << h)) >> 16); }
            f32x16_t o0, o1;
#pragma unroll
            for (int i = 0; i < 16; ++i) { o0[i] = 0.f; o1[i] = 0.f; }
            float m_run = NEG, l_run = 0.f;
            __syncthreads();
            { const uint4 kr = *(const uint4*)(Kbase + (size_t)skey * AW + sch), vr = *(const uint4*)(Vbase + (size_t)skey * SEQ + sch);
              *(uint4*)(L + skey * LP + sch) = knorm(kr); *(uint4*)(L + 2 * SLOT + skey * LP + sch) = vr; }
            unsigned long long mw = MASK[qrow * 128];
            __syncthreads();
#pragma unroll 1
            for (int kt = 0; kt < ntile; ++kt) {
                const int buf = kt & 1; const bool more = kt + 1 < ntile;
                uint4 kr = make_uint4(0, 0, 0, 0), vr = make_uint4(0, 0, 0, 0); unsigned long long mwn = 0ull;
                if (more) { kr = *(const uint4*)(Kbase + (size_t)((kt + 1) * 64 + skey) * AW + sch); vr = *(const uint4*)(Vbase + (size_t)skey * SEQ + (kt + 1) * 64 + sch); mwn = MASK[qrow * 128 + kt + 1]; }
                if (kt * 64 <= q0 + 31) {
                    const bf16_t* Kl = L + buf * SLOT; const bf16_t* Vl = L + (2 + buf) * SLOT;
                    f32x16_t p0, p1;
#pragma unroll
                    for (int i = 0; i < 16; ++i) { p0[i] = 0.f; p1[i] = 0.f; }
#pragma unroll
                    for (int s2 = 0; s2 < 4; ++s2) {
                        const bf16x8_t a0 = *(const bf16x8_t*)(Kl + r32 * LP + 16 * s2 + 8 * hh), a1 = *(const bf16x8_t*)(Kl + (32 + r32) * LP + 16 * s2 + 8 * hh);
                        p0 = MFMA32(a0, bq[s2], p0); p1 = MFMA32(a1, bq[s2], p1);
                    }
                    { bf16x8_t g0, g1;
#pragma unroll
                      for (int j = 0; j < 8; ++j) { g0[j] = 0; g1[j] = 0; }
                      if (hh == 0) { g0[0] = bf16_of_int(kt); g0[1] = bf16_of_int(r32); g1[0] = g0[0]; g1[1] = bf16_of_int(32 + r32); }
                      p0 = MFMA32(g0, bq[4], p0); p1 = MFMA32(g1, bq[4], p1); }
                    const unsigned wl = (unsigned)mw >> (4 * hh), wh = (unsigned)(mw >> 32) >> (4 * hh);
                    float mx = NEG;
#pragma unroll
                    for (int i = 0; i < 16; ++i) { const int bp = (i & 3) + 8 * (i >> 2);
                        const int m0 = ((int)(wl << (31 - bp))) >> 31, m1 = ((int)(wh << (31 - bp))) >> 31;
                        p0[i] = __uint_as_float((__float_as_uint(p0[i]) & (unsigned)m0) | (__float_as_uint(NEG) & ~(unsigned)m0));
                        p1[i] = __uint_as_float((__float_as_uint(p1[i]) & (unsigned)m1) | (__float_as_uint(NEG) & ~(unsigned)m1));
                        mx = fmaxf(mx, fmaxf(p0[i], p1[i])); }
                    mx = xhalf_max(mx);
                    const float m_new = fmaxf(m_run, mx);
                    const float alpha = __builtin_amdgcn_exp2f((m_run - m_new) * CS);
                    m_run = m_new;
                    const float mc = fmaxf(m_new, -1e20f) * CS;
                    float rs = 0.f;
#pragma unroll
                    for (int i = 0; i < 16; ++i) { p0[i] = __builtin_amdgcn_exp2f(p0[i] * CS - mc); p1[i] = __builtin_amdgcn_exp2f(p1[i] * CS - mc); rs += p0[i] + p1[i]; }
                    l_run = l_run * alpha + rs;
#pragma unroll
                    for (int i = 0; i < 16; ++i) { o0[i] *= alpha; o1[i] *= alpha; }
                    bf16x8_t pb[4];
                    pb[0] = pack_step16(p0, 0); pb[1] = pack_step16(p0, 1); pb[2] = pack_step16(p1, 0); pb[3] = pack_step16(p1, 1);
#pragma unroll
                    for (int ks = 0; ks < 4; ++ks) {
                        const int kofs = 32 * (ks >> 1) + 16 * (ks & 1) + 4 * hh;
                        typedef short s16x4_t __attribute__((ext_vector_type(4)));
                        const s16x4_t v00 = *(const s16x4_t*)(Vl + r32 * LP + kofs), v01 = *(const s16x4_t*)(Vl + r32 * LP + kofs + 8);
                        const s16x4_t v10 = *(const s16x4_t*)(Vl + (32 + r32) * LP + kofs), v11 = *(const s16x4_t*)(Vl + (32 + r32) * LP + kofs + 8);
                        bf16x8_t av0, av1;
#pragma unroll
                        for (int j = 0; j < 4; ++j) { av0[j] = v00[j]; av0[4 + j] = v01[j]; av1[j] = v10[j]; av1[4 + j] = v11[j]; }
                        o0 = MFMA32(av0, pb[ks], o0); o1 = MFMA32(av1, pb[ks], o1);
                    }
                }
                if (more) { *(uint4*)(L + (buf ^ 1) * SLOT + skey * LP + sch) = knorm(kr); *(uint4*)(L + (2 + (buf ^ 1)) * SLOT + skey * LP + sch) = vr; }
                mw = mwn;
                __syncthreads();
            }
            const float inv = 1.f / xhalf_sum(l_run);
            bf16_t* orow = O + qrow * AW + h * 64 + 4 * hh;
#pragma unroll
            for (int g = 0; g < 4; ++g) {
                uint2 w0, w1;
                w0.x = (unsigned)f2bf(o0[4 * g] * inv) | ((unsigned)f2bf(o0[4 * g + 1] * inv) << 16); w0.y = (unsigned)f2bf(o0[4 * g + 2] * inv) | ((unsigned)f2bf(o0[4 * g + 3] * inv) << 16);
                w1.x = (unsigned)f2bf(o1[4 * g] * inv) | ((unsigned)f2bf(o1[4 * g + 1] * inv) << 16); w1.y = (unsigned)f2bf(o1[4 * g + 2] * inv) | ((unsigned)f2bf(o1[4 * g + 3] * inv) << 16);
                *(uint2*)(orow + 8 * g) = w0; *(uint2*)(orow + 32 + 8 * g) = w1;
            }
            }
        }
    }
}

constexpr int AP = 328, RP = 1544;
__device__ __forceinline__ f32x4_t mm16(const bf16_t* X, int xrs, const bf16_t* Y, int ycs, int nks, f32x4_t acc, int lane) {
    const int r = lane & 15, q = lane >> 4;
    for (int s2 = 0; s2 < nks; ++s2) {
        const bf16x8_t a = *(const bf16x8_t*)(X + r * xrs + 32 * s2 + 8 * q), b = *(const bf16x8_t*)(Y + r * ycs + 32 * s2 + 8 * q);
        acc = __builtin_amdgcn_mfma_f32_16x16x32_bf16(a, b, acc, 0, 0, 0);
    }
    return acc;
}
__device__ void ph_rwkv_prep(const P& p, float* ldsf, int blk_first, int blk_end, int blk_step) {
    const bf16_t* PS = (const bf16_t*)(p.ws + WS_PS);
    const float* mu = p.in[10]; const float* w0 = p.in[11]; const float* a0 = p.in[13]; const float* k_k = p.in[16]; const float* k_a = p.in[17];
    const bf16_t* W2T = (const bf16_t*)(p.ws + WS_LW2T); const bf16_t* A2T = (const bf16_t*)(p.ws + WS_LA2T); const bf16_t* G2T = (const bf16_t*)(p.ws + WS_LG2T);
    bf16_t* R = (bf16_t*)(p.ws + WS_R); bf16_t* K2 = (bf16_t*)(p.ws + WS_K2); bf16_t* VV = (bf16_t*)(p.ws + WS_VV); bf16_t* KK = (bf16_t*)(p.ws + WS_KK); bf16_t* BB = (bf16_t*)(p.ws + WS_BB);
    bf16_t* G = (bf16_t*)(p.ws + WS_G); float* DD = (float*)(p.ws + WS_DD);
    bf16_t* Amix = (bf16_t*)ldsf; bf16_t* RKV = Amix + 32 * AP;
    const int tid = otid(), lane = tid & 63, wv = tid >> 6, l15 = lane & 15, q4 = lane >> 4;
    for (int blk = blk_first; blk < blk_end; blk += blk_step) {
        const int m0 = blk * 32;
        __syncthreads();
#pragma unroll 3
        for (int ch = tid; ch < 32 * 228; ch += NTHR) {
            const int tk = ch / 228, c8 = (ch % 228) * 8, m = m0 + tk;
            const uint4 cu = *(const uint4*)(PS + (size_t)m * SHW + c8);
            uint4 pv = make_uint4(0, 0, 0, 0); if (m % SEQ) pv = *(const uint4*)(PS + (size_t)(m - 1) * SHW + c8);
            const unsigned cw[4] = {cu.x, cu.y, cu.z, cu.w}, pw[4] = {pv.x, pv.y, pv.z, pv.w};
            const float4 mu0 = *(const float4*)(mu + c8), mu1 = *(const float4*)(mu + c8 + 4); const float muv[8] = {mu0.x, mu0.y, mu0.z, mu0.w, mu1.x, mu1.y, mu1.z, mu1.w};
            float mx[8];
#pragma unroll
            for (int e = 0; e < 8; ++e) { const float c_ = (e & 1) ? __uint_as_float(cw[e >> 1] & 0xffff0000u) : __uint_as_float(cw[e >> 1] << 16), p_ = (e & 1) ? __uint_as_float(pw[e >> 1] & 0xffff0000u) : __uint_as_float(pw[e >> 1] << 16);
                mx[e] = c_ + (p_ - c_) * muv[e]; }
            bf16_t* dst;
            if (c8 < 1536) dst = RKV + tk * RP + c8;
            else { const int col = c8 - 1536; dst = Amix + tk * AP + col;
#pragma unroll
                for (int e = 0; e < 8; ++e) mx[e] = (col < 64) ? tanhf(mx[e]) : ((col < 128) ? mx[e] : sigmoidf_(mx[e])); }
            *(uint4*)dst = make_uint4(pk2(mx[0], mx[1]), pk2(mx[2], mx[3]), pk2(mx[4], mx[5]), pk2(mx[6], mx[7]));
        }
        if (tid < 128) *(uint4*)(Amix + (tid >> 2) * AP + 288 + (tid & 3) * 8) = make_uint4(0, 0, 0, 0);
        __syncthreads();
        const int h = wv;
#pragma unroll 1
        for (int rt = 0; rt < 2; ++rt) {
            f32x4_t aw[4], aa[4], ag[4];
            {
                const f32x4_t z4 = {0.f, 0.f, 0.f, 0.f};
                const bf16_t* xr = Amix + (16 * rt + l15) * AP + 8 * q4;
#pragma unroll
                for (int ct = 0; ct < 4; ++ct) { const int cb = 64 * h + 16 * ct;
                    bf16x8_t fw[2], fa[2], fg[6];
                    { const bf16_t* yw = W2T + (size_t)(cb + l15) * 64 + 8 * q4; const bf16_t* ya = A2T + (size_t)(cb + l15) * 64 + 8 * q4; const bf16_t* yg = G2T + (size_t)(cb + l15) * 192 + 8 * q4;
#pragma unroll
                      for (int s2 = 0; s2 < 2; ++s2) { fw[s2] = *(const bf16x8_t*)(yw + 32 * s2); fa[s2] = *(const bf16x8_t*)(ya + 32 * s2); }
#pragma unroll
                      for (int s2 = 0; s2 < 6; ++s2) fg[s2] = *(const bf16x8_t*)(yg + 32 * s2); }
                    f32x4_t cw = z4, ca = z4, cg = z4;
#pragma unroll
                    for (int s2 = 0; s2 < 2; ++s2) { cw = __builtin_amdgcn_mfma_f32_16x16x32_bf16(fw[s2], *(const bf16x8_t*)(xr + 32 * s2), cw, 0, 0, 0); ca = __builtin_amdgcn_mfma_f32_16x16x32_bf16(fa[s2], *(const bf16x8_t*)(xr + 64 + 32 * s2), ca, 0, 0, 0); }
#pragma unroll
                    for (int s2 = 0; s2 < 6; ++s2) cg = __builtin_amdgcn_mfma_f32_16x16x32_bf16(fg[s2], *(const bf16x8_t*)(xr + 128 + 32 * s2), cg, 0, 0, 0);
                    aw[ct] = cw; aa[ct] = ca; ag[ct] = cg; }
            }
            const int tk = 16 * rt + l15;
            float ss = 0.f; float kkr[4][4];
#pragma unroll
            for (int ct = 0; ct < 4; ++ct) { const int c0 = 64 * h + 16 * ct + 4 * q4; const float4 kkc = *(const float4*)(k_k + c0);
                const uint2 kw = *(const uint2*)(RKV + tk * RP + 512 + c0);
                kkr[ct][0] = __uint_as_float(kw.x << 16) * kkc.x; kkr[ct][1] = __uint_as_float(kw.x & 0xffff0000u) * kkc.y; kkr[ct][2] = __uint_as_float(kw.y << 16) * kkc.z; kkr[ct][3] = __uint_as_float(kw.y & 0xffff0000u) * kkc.w;
#pragma unroll
                for (int e = 0; e < 4; ++e) ss += kkr[ct][e] * kkr[ct][e]; }
            ss += __shfl_xor(ss, 16); ss += __shfl_xor(ss, 32);
            const float rn = 1.f / fmaxf(sqrtf(ss), 1e-12f);
#pragma unroll
            for (int ct = 0; ct < 4; ++ct) { const int c0 = 64 * h + 16 * ct + 4 * q4;
                const float4 w0c = *(const float4*)(w0 + c0), a0c = *(const float4*)(a0 + c0), kac = *(const float4*)(k_a + c0);
                const float w0v[4] = {w0c.x, w0c.y, w0c.z, w0c.w}, a0v[4] = {a0c.x, a0c.y, a0c.z, a0c.w}, kav[4] = {kac.x, kac.y, kac.z, kac.w};
                const uint2 rw2 = *(const uint2*)(RKV + tk * RP + c0), kw2 = *(const uint2*)(RKV + tk * RP + 512 + c0), vw2 = *(const uint2*)(RKV + tk * RP + 1024 + c0);
                const float kf[4] = {__uint_as_float(kw2.x << 16), __uint_as_float(kw2.x & 0xffff0000u), __uint_as_float(kw2.y << 16), __uint_as_float(kw2.y & 0xffff0000u)};
                float k2v[4], kkv[4], bbv[4], ddv[4];
#pragma unroll
                for (int e = 0; e < 4; ++e) {
                    const float xw = -(w0v[e] + aw[ct][e]);
                    const float sp = fmaxf(xw, 0.f) + log1pf(__expf(-fabsf(xw)));
                    const float w = -sp - 0.5f;
                    const float a = sigmoidf_(a0v[e] + aa[ct][e]);
                    kkv[e] = kkr[ct][e] * rn; bbv[e] = kkv[e] * a; k2v[e] = kf[e] * (1.f + (a - 1.f) * kav[e]); ddv[e] = -__expf(w);
                }
                const size_t o = (size_t)(m0 + tk) * RW + c0;
                *(uint2*)(R + o) = rw2; *(uint2*)(VV + o) = vw2;
                *(uint2*)(K2 + o) = make_uint2(pk2(k2v[0], k2v[1]), pk2(k2v[2], k2v[3])); *(uint2*)(KK + o) = make_uint2(pk2(kkv[0], kkv[1]), pk2(kkv[2], kkv[3]));
                *(uint2*)(BB + o) = make_uint2(pk2(bbv[0], bbv[1]), pk2(bbv[2], bbv[3])); *(uint2*)(G + o) = make_uint2(pk2(ag[ct][0], ag[ct][1]), pk2(ag[ct][2], ag[ct][3]));
                *(float4*)(DD + o) = make_float4(ddv[0], ddv[1], ddv[2], ddv[3]);
            }
        }
    }
}

template <bool XC, bool YC>
__device__ __forceinline__ f32x4_t mm_tile(const bf16_t* X, int xrs, int xcs, const bf16_t* Y, int yrs, int ycs, int tr, int tc, f32x4_t acc, int lane) {
    const int r = lane & 15, q = lane >> 4;
#pragma unroll
    for (int s2 = 0; s2 < 2; ++s2) {
        bf16x8_t a, b;
        const bf16_t* xp = X + (16 * tr + r) * xrs + (32 * s2 + 8 * q) * xcs;
        if (XC) a = *(const bf16x8_t*)xp; else {
#pragma unroll
            for (int j = 0; j < 8; ++j) a[j] = (short)xp[j * xcs]; }
        const bf16_t* yp = Y + (32 * s2 + 8 * q) * yrs + (16 * tc + r) * ycs;
        if (YC) b = *(const bf16x8_t*)yp; else {
#pragma unroll
            for (int j = 0; j < 8; ++j) b[j] = (short)yp[j * yrs]; }
        acc = __builtin_amdgcn_mfma_f32_16x16x32_bf16(a, b, acc, 0, 0, 0);
    }
    return acc;
}
__device__ __forceinline__ void st_tile(const f32x4_t& acc, bf16_t* D, int drs, int dcs, int tr, int tc, int lane) {
    const int row0 = 16 * tr + 4 * (lane >> 4), col = 16 * tc + (lane & 15);
#pragma unroll
    for (int e = 0; e < 4; ++e) D[(row0 + e) * drs + col * dcs] = f2bf(acc[e]);
}
__device__ __forceinline__ f32x4_t ld_tile(const bf16_t* D, int drs, int dcs, int tr, int tc, int lane) {
    const int row0 = 16 * tr + 4 * (lane >> 4), col = 16 * tc + (lane & 15); f32x4_t v;
#pragma unroll
    for (int e = 0; e < 4; ++e) v[e] = bf2f(D[(row0 + e) * drs + col * dcs]);
    return v;
}
template <bool STRICT> __device__ __forceinline__ void triu_tile(f32x4_t& acc, int tr, int tc, int lane) {
    const int row0 = 16 * tr + 4 * (lane >> 4), col = 16 * tc + (lane & 15);
#pragma unroll
    for (int e = 0; e < 4; ++e) { const bool keep = STRICT ? (row0 + e < col) : (row0 + e <= col); acc[e] = keep ? acc[e] : 0.f; }
}

__device__ void ph_rwkv_r1(const P& p, float* ldsf, int ch_first, int ch_end, int ch_step) {
    const bf16_t* R = (const bf16_t*)(p.ws + WS_R); const bf16_t* K2 = (const bf16_t*)(p.ws + WS_K2); const bf16_t* VV = (const bf16_t*)(p.ws + WS_VV);
    const bf16_t* KK = (const bf16_t*)(p.ws + WS_KK); const bf16_t* BB = (const bf16_t*)(p.ws + WS_BB); const float* DD = (const float*)(p.ws + WS_DD);
    bf16_t* L = (bf16_t*)ldsf;
    bf16_t* At = L + 0 * SLOT; bf16_t* AtT = L + 1 * SLOT; bf16_t* Bt = L + 2 * SLOT; bf16_t* Kt = L + 3 * SLOT; bf16_t* Rt = L + 4 * SLOT; bf16_t* BhT = L + 5 * SLOT; bf16_t* Kh = L + 6 * SLOT;
    bf16_t* S7 = L + 7 * SLOT; bf16_t* S8 = L + 8 * SLOT; bf16_t* S9 = L + 9 * SLOT; bf16_t* Mka = L + 10 * SLOT; bf16_t* NbrT = L + 11 * SLOT; bf16_t* Nkr = L + 12 * SLOT;
    float* cs = (float*)(L + 13 * SLOT);
    float* segs = cs + 64 * 64;
    float* gLs = segs + 8 * 64;
    const int tid = otid(), lane = tid & 63, wv = tid >> 6;
    const int t0 = 2 * wv, t1 = 2 * wv + 1;
    for (int ch = ch_first; ch < ch_end; ch += ch_step) {
        const int bh = ch >> 7, c = ch & 127, b = bh >> 3, h = bh & 7;
        const size_t gbase = ((size_t)b * SEQ + (size_t)c * 64) * RW + h * 64;
        bf16_t* G1T = (bf16_t*)(p.ws + WS_KK) + gbase; bf16_t* PT = (bf16_t*)(p.ws + WS_BB) + gbase; bf16_t* G2T = (bf16_t*)(p.ws + WS_DD) + 2 * gbase; bf16_t* QT = G2T + 64;
        __syncthreads();
        const int st = tid >> 3, sj = (tid & 7) * 8;
        { const float4 l0 = *(const float4*)(DD + gbase + (size_t)st * RW + sj), l1 = *(const float4*)(DD + gbase + (size_t)st * RW + sj + 4);
          float* d = cs + st * 64 + sj; *(float4*)d = l0; *(float4*)(d + 4) = l1; }
        __syncthreads();
        { const int j = tid & 63, sg = tid >> 6; float run = 0.f;
#pragma unroll
          for (int i = 0; i < 8; ++i) { run += cs[(sg * 8 + i) * 64 + j]; }
          segs[sg * 64 + j] = run; }
        __syncthreads();
        { const int j = tid & 63, sg = tid >> 6; float run = 0.f;
          for (int q = 0; q < sg; ++q) run += segs[q * 64 + j];
#pragma unroll
          for (int i = 0; i < 8; ++i) { run += cs[(sg * 8 + i) * 64 + j]; cs[(sg * 8 + i) * 64 + j] = run; }
          if (sg == 7) gLs[j] = __expf(run); }
        __syncthreads();
        const uint4 vraw = *(const uint4*)(VV + gbase + (size_t)st * RW + sj);
        {
            const uint4 rr = *(const uint4*)(R + gbase + (size_t)st * RW + sj), kr = *(const uint4*)(K2 + gbase + (size_t)st * RW + sj);
            const uint4 kkr = *(const uint4*)(KK + gbase + (size_t)st * RW + sj), br = *(const uint4*)(BB + gbase + (size_t)st * RW + sj);
            const unsigned rw_[4] = {rr.x, rr.y, rr.z, rr.w}, kw_[4] = {kr.x, kr.y, kr.z, kr.w}, kkw_[4] = {kkr.x, kkr.y, kkr.z, kkr.w}, bw_[4] = {br.x, br.y, br.z, br.w};
            unsigned oa[4], ob[4], ok[4], orr[4], okh[4];
#pragma unroll
            for (int e2 = 0; e2 < 4; ++e2) {
                float va[2], vb[2], vk[2], vr2[2], vbh[2], vkh[2];
#pragma unroll
                for (int hf = 0; hf < 2; ++hf) {
                    const int j = sj + 2 * e2 + hf;
                    const float lgI = cs[st * 64 + j], lgE = st ? cs[(st - 1) * 64 + j] : 0.f, gl = cs[63 * 64 + j];
                    const float rv = hf ? __uint_as_float(rw_[e2] & 0xffff0000u) : __uint_as_float(rw_[e2] << 16);
                    const float kv = hf ? __uint_as_float(kw_[e2] & 0xffff0000u) : __uint_as_float(kw_[e2] << 16);
                    const float kkv = hf ? __uint_as_float(kkw_[e2] & 0xffff0000u) : __uint_as_float(kkw_[e2] << 16);
                    const float bv = hf ? __uint_as_float(bw_[e2] & 0xffff0000u) : __uint_as_float(bw_[e2] << 16);
                    const float einv = __expf(-lgI), eh = __expf(gl - lgI);
                    va[hf] = -kkv * __expf(lgE); vb[hf] = bv * einv; vk[hf] = kv * einv; vr2[hf] = rv * __expf(lgI); vbh[hf] = bv * eh; vkh[hf] = kv * eh;
                    AtT[j * LP + st] = f2bf(va[hf]); BhT[j * LP + st] = f2bf(vbh[hf]);
                }
                oa[e2] = pk2(va[0], va[1]); ob[e2] = pk2(vb[0], vb[1]); ok[e2] = pk2(vk[0], vk[1]); orr[e2] = pk2(vr2[0], vr2[1]); okh[e2] = pk2(vkh[0], vkh[1]);
            }
            *(uint4*)(At + st * LP + sj) = make_uint4(oa[0], oa[1], oa[2], oa[3]); *(uint4*)(Bt + st * LP + sj) = make_uint4(ob[0], ob[1], ob[2], ob[3]);
            *(uint4*)(Kt + st * LP + sj) = make_uint4(ok[0], ok[1], ok[2], ok[3]); *(uint4*)(Rt + st * LP + sj) = make_uint4(orr[0], orr[1], orr[2], orr[3]);
            *(uint4*)(Kh + st * LP + sj) = make_uint4(okh[0], okh[1], okh[2], okh[3]);
        }
        __syncthreads();
#define R1_FOR_TILES(idx, tr, tc) _Pragma("unroll") for (int _q = 0; _q < 2; ++_q) { const int idx = _q ? t1 : t0; const int tr = idx >> 2, tc = idx & 3;
#define R1_END }
#define MMF(X, Y, acc) mm_tile<true, true>((X), LP, 1, (Y), 1, LP, tr, tc, (acc), lane)
        const f32x4_t zero4 = {0.f, 0.f, 0.f, 0.f};
        R1_FOR_TILES(idx, tr, tc)
            f32x4_t mab = MMF(Bt, At, zero4); triu_tile<true>(mab, tr, tc, lane); st_tile(mab, S7, LP, 1, tr, tc, lane); st_tile(mab, S8, 1, LP, tr, tc, lane);
            { f32x4_t tt = mab; const int row0 = 16 * tr + 4 * (lane >> 4), col = 16 * tc + (lane & 15);
#pragma unroll
              for (int e = 0; e < 4; ++e) tt[e] += (row0 + e == col) ? 1.f : 0.f;
              st_tile(tt, S9, LP, 1, tr, tc, lane); }
            f32x4_t mka = MMF(Kt, At, zero4); triu_tile<true>(mka, tr, tc, lane); st_tile(mka, Mka, LP, 1, tr, tc, lane);
            f32x4_t nbr = MMF(Bt, Rt, zero4); triu_tile<false>(nbr, tr, tc, lane); st_tile(nbr, NbrT, 1, LP, tr, tc, lane);
            f32x4_t nkr = MMF(Kt, Rt, zero4); triu_tile<false>(nkr, tr, tc, lane); st_tile(nkr, Nkr, LP, 1, tr, tc, lane);
        R1_END
        __syncthreads();
        bf16_t* VmT = At;
        { const unsigned vw_[4] = {vraw.x, vraw.y, vraw.z, vraw.w};
#pragma unroll
          for (int e = 0; e < 8; ++e) VmT[(sj + e) * LP + st] = (bf16_t)((e & 1) ? (vw_[e >> 1] >> 16) : (vw_[e >> 1] & 0xffffu)); }
        bf16_t* Pc = S7; bf16_t* PcT = S8; bf16_t* Pn = Bt; bf16_t* PnT = Kt; bf16_t* Tc = S9; bf16_t* Tn = (bf16_t*)cs; bf16_t* TT = nullptr;
#pragma unroll 1
        for (int k = 1; k <= 6; ++k) {
            R1_FOR_TILES(idx, tr, tc)
                if (k <= 5) { f32x4_t pp = MMF(Pc, PcT, zero4); st_tile(pp, Pn, LP, 1, tr, tc, lane); st_tile(pp, PnT, 1, LP, tr, tc, lane); }
                if (k >= 2) { f32x4_t tn = ld_tile(Tc, LP, 1, tr, tc, lane); tn = MMF(Tc, PcT, tn); st_tile(tn, Tn, LP, 1, tr, tc, lane);
                    if (k == 6) st_tile(tn, Pn, 1, LP, tr, tc, lane); }
            R1_END
            __syncthreads();
            if (k == 6) TT = Pn;
            if (k <= 5) { bf16_t* x_ = Pc; Pc = Pn; Pn = x_; x_ = PcT; PcT = PnT; PnT = x_; }
            if (k >= 2) { bf16_t* x_ = Tc; Tc = Tn; Tn = x_; }
        }
        bf16_t* W1 = Pc; bf16_t* W2 = PcT; bf16_t* QkT = PnT;
        bf16_t* Og1 = Tn; bf16_t* Og2 = Tc; bf16_t* Opt = TT; bf16_t* Oqt = W1;
        R1_FOR_TILES(idx, tr, tc)
            f32x4_t w1 = MMF(AtT, TT, zero4); st_tile(w1, W1, LP, 1, tr, tc, lane);
            f32x4_t w2 = MMF(Mka, TT, zero4); st_tile(w2, W2, LP, 1, tr, tc, lane);
        R1_END
        __syncthreads();
        R1_FOR_TILES(idx, tr, tc)
            f32x4_t g1 = ld_tile(Rt, 1, LP, tr, tc, lane); g1 = MMF(W1, NbrT, g1); st_tile(g1, Og1, 1, LP, tr, tc, lane);
            f32x4_t g2 = ld_tile(Nkr, LP, 1, tr, tc, lane); g2 = MMF(W2, NbrT, g2); st_tile(g2, Og2, 1, LP, tr, tc, lane);
            f32x4_t pm = MMF(W1, BhT, zero4);
            { const int row0 = 16 * tr + 4 * (lane >> 4), col = 16 * tc + (lane & 15);
#pragma unroll
              for (int e = 0; e < 4; ++e) pm[e] += (row0 + e == col) ? gLs[col] : 0.f; }
            st_tile(pm, Opt, 1, LP, tr, tc, lane);
            f32x4_t qk = ld_tile(Kh, LP, 1, tr, tc, lane); qk = MMF(W2, BhT, qk); st_tile(qk, QkT, 1, LP, tr, tc, lane);
        R1_END
        __syncthreads();
        {
            const int row = tid >> 3, ch8 = (tid & 7) * 8;
            *(uint4*)(G1T + (size_t)row * RW + ch8) = *(const uint4*)(Og1 + row * LP + ch8);
            *(uint4*)(G2T + (size_t)row * (2 * RW) + ch8) = *(const uint4*)(Og2 + row * LP + ch8);
            *(uint4*)(PT + (size_t)row * RW + ch8) = *(const uint4*)(Opt + row * LP + ch8);
        }
        R1_FOR_TILES(idx, tr, tc)
            f32x4_t qt = MMF(QkT, VmT, zero4);
            { const int row0 = 16 * tr + 4 * (lane >> 4), col = 16 * tc + (lane & 15);
#pragma unroll
              for (int e = 0; e < 4; ++e) { const int jp = row0 + e; const int ci = ((jp >> 5) * 2 + (col >> 5)) * 64 + (col & 31) + 32 * ((jp >> 2) & 1);
                Oqt[ci * 16 + (jp & 3) + 4 * ((jp & 31) >> 3)] = f2bf(qt[e]); } }
        R1_END
        __syncthreads();
        { const int ci = tid >> 1, hf = tid & 1;
          *(uint4*)(QT + (size_t)(ci >> 2) * (2 * RW) + (ci & 3) * 16 + hf * 8) = *(const uint4*)(Oqt + ci * 16 + hf * 8); }
#undef MMF
    }
}
__device__ void ph_rwkv_prep_r1(const P& p, float* ldsf) {
    for (int b64 = blockIdx.x; b64 < NT / 64; b64 += gridDim.x) {
        ph_rwkv_prep(p, ldsf, 2 * b64, 2 * b64 + 2, 1);
        __syncthreads();
        const int b = b64 >> 7, c = b64 & 127, ch0 = (b * 8) * 128 + c;
        ph_rwkv_r1(p, ldsf, ch0, ch0 + 8 * 128, 128);
    }
}
__device__ void ph_rwkv_r2(const P& p, int bh_first, int bh_end, int bh_step) {
    bf16_t* SX = (bf16_t*)(p.ws + WS_SX);
    const int tid = otid(), lane = tid & 63, wv = tid >> 6, hh = lane >> 5, r32 = lane & 31;
    typedef short s16x4_t __attribute__((ext_vector_type(4)));
    for (int bh = bh_first; bh < bh_end; bh += bh_step) {
        if (wv >= 2) continue;
        const int cb = wv;
        f32x16_t x0, x1;
#pragma unroll
        for (int i = 0; i < 16; ++i) { x0[i] = 0.f; x1[i] = 0.f; }
        bf16x8_t pa[2][4]; uint4 qa[2][2];
#define R2_LOAD(c_) do { const size_t gb_ = ((size_t)(bh >> 3) * SEQ + (size_t)(c_) * 64) * RW + (bh & 7) * 64; \
            const bf16_t* PT = (const bf16_t*)(p.ws + WS_BB) + gb_; const bf16_t* QT = (const bf16_t*)(p.ws + WS_DD) + 2 * gb_ + 64; \
            _Pragma("unroll") for (int rb = 0; rb < 2; ++rb) { \
                _Pragma("unroll") for (int ks = 0; ks < 4; ++ks) { const bf16_t* pp = PT + (size_t)(32 * rb + r32) * RW + 32 * (ks >> 1) + 16 * (ks & 1) + 4 * hh; \
                    const s16x4_t lo = *(const s16x4_t*)pp, hi = *(const s16x4_t*)(pp + 8); \
                    _Pragma("unroll") for (int j = 0; j < 4; ++j) { pa[rb][ks][j] = lo[j]; pa[rb][ks][4 + j] = hi[j]; } } \
                const int ci_ = (rb * 2 + cb) * 64 + lane; const uint4* qp = (const uint4*)(QT + (size_t)(ci_ >> 2) * (2 * RW) + (ci_ & 3) * 16); qa[rb][0] = qp[0]; qa[rb][1] = qp[1]; } } while (0)
        R2_LOAD(0);
#pragma unroll 1
        for (int c = 0; c < SEQ / 64; ++c) {
            const size_t ob_ = ((size_t)bh * 128 + c) * 4096;
            const bf16x8_t xb0 = pack_step16(x0, 0), xb1 = pack_step16(x0, 1), xb2 = pack_step16(x1, 0), xb3 = pack_step16(x1, 1);
            { bf16_t* sp = SX + ob_ + (size_t)(32 * cb + r32) * 64 + 4 * hh;
              const uint4 u0 = __builtin_bit_cast(uint4, xb0), u1 = __builtin_bit_cast(uint4, xb1), u2 = __builtin_bit_cast(uint4, xb2), u3 = __builtin_bit_cast(uint4, xb3);
              *(uint2*)(sp + 0) = make_uint2(u0.x, u0.y); *(uint2*)(sp + 8) = make_uint2(u0.z, u0.w); *(uint2*)(sp + 16) = make_uint2(u1.x, u1.y); *(uint2*)(sp + 24) = make_uint2(u1.z, u1.w);
              *(uint2*)(sp + 32) = make_uint2(u2.x, u2.y); *(uint2*)(sp + 40) = make_uint2(u2.z, u2.w); *(uint2*)(sp + 48) = make_uint2(u3.x, u3.y); *(uint2*)(sp + 56) = make_uint2(u3.z, u3.w); }
            f32x16_t n0, n1;
            { const unsigned qw0[8] = {qa[0][0].x, qa[0][0].y, qa[0][0].z, qa[0][0].w, qa[0][1].x, qa[0][1].y, qa[0][1].z, qa[0][1].w};
              const unsigned qw1[8] = {qa[1][0].x, qa[1][0].y, qa[1][0].z, qa[1][0].w, qa[1][1].x, qa[1][1].y, qa[1][1].z, qa[1][1].w};
#pragma unroll
              for (int i = 0; i < 8; ++i) { n0[2 * i] = __uint_as_float(qw0[i] << 16); n0[2 * i + 1] = __uint_as_float(qw0[i] & 0xffff0000u); n1[2 * i] = __uint_as_float(qw1[i] << 16); n1[2 * i + 1] = __uint_as_float(qw1[i] & 0xffff0000u); } }
            const bf16x8_t a00 = pa[0][0], a01 = pa[0][1], a02 = pa[0][2], a03 = pa[0][3], a10 = pa[1][0], a11 = pa[1][1], a12 = pa[1][2], a13 = pa[1][3];
            if (c + 1 < SEQ / 64) R2_LOAD(c + 1);
            n0 = MFMA32(a00, xb0, n0); n0 = MFMA32(a01, xb1, n0); n0 = MFMA32(a02, xb2, n0); n0 = MFMA32(a03, xb3, n0);
            n1 = MFMA32(a10, xb0, n1); n1 = MFMA32(a11, xb1, n1); n1 = MFMA32(a12, xb2, n1); n1 = MFMA32(a13, xb3, n1);
            x0 = n0; x1 = n1;
        }
#undef R2_LOAD
    }
}
__device__ void ph_rwkv_r3(const P& p, float* ldsf) {
    const bf16_t* VV = (const bf16_t*)(p.ws + WS_VV); const bf16_t* SX = (const bf16_t*)(p.ws + WS_SX);
    const bf16_t* Rg = (const bf16_t*)(p.ws + WS_R); const bf16_t* K2 = (const bf16_t*)(p.ws + WS_K2); const bf16_t* Gg = (const bf16_t*)(p.ws + WS_G); bf16_t* ORW = (bf16_t*)(p.ws + WS_ORW);
    const float* r_k = p.in[18]; const float* ln_w = p.in[19]; const float* ln_b = p.in[20];
    bf16_t* Vm = (bf16_t*)ldsf; float* Yl = (float*)(Vm + SLOT);
    const int tid = otid(), lane = tid & 63, wv = tid >> 6; const int t0 = 2 * wv, t1 = 2 * wv + 1;
    const int st = tid >> 3, sj = (tid & 7) * 8;
    for (int ch = blockIdx.x; ch < NB * 8 * (SEQ / 64); ch += gridDim.x) {
        const int bh = ch >> 7, c = ch & 127, b = bh >> 3, h = bh & 7;
        const size_t gbase = ((size_t)b * SEQ + (size_t)c * 64) * RW + h * 64, ob_ = (size_t)ch * 4096;
        const bf16_t* G1T = (const bf16_t*)(p.ws + WS_KK) + gbase; const bf16_t* G2T = (const bf16_t*)(p.ws + WS_DD) + 2 * gbase;
        __syncthreads();
        const uint4 vraw = *(const uint4*)(VV + gbase + (size_t)st * RW + sj);
        *(uint4*)(Vm + st * LP + sj) = vraw;
        __syncthreads();
        R1_FOR_TILES(idx, tr, tc)
            const f32x4_t zero4 = {0.f, 0.f, 0.f, 0.f};
            f32x4_t y = mm_tile<true, true>(SX + ob_, 64, 1, G1T, 1, RW, tr, tc, zero4, lane);
            y = mm_tile<false, true>(Vm, 1, LP, G2T, 1, 2 * RW, tr, tc, y, lane);
            const int i0 = 16 * tr + 4 * (lane >> 4), t = 16 * tc + (lane & 15);
#pragma unroll
            for (int e = 0; e < 4; ++e) Yl[t * 65 + i0 + e] = y[e];
        R1_END
        __syncthreads();
        {
            float y[8], s1 = 0.f;
#pragma unroll
            for (int e = 0; e < 8; ++e) { y[e] = Yl[st * 65 + sj + e]; s1 += y[e]; }
            s1 += __shfl_xor(s1, 1); s1 += __shfl_xor(s1, 2); s1 += __shfl_xor(s1, 4);
            const float mean = s1 * (1.f / 64.f); float s2 = 0.f;
#pragma unroll
            for (int e = 0; e < 8; ++e) { y[e] -= mean; s2 += y[e] * y[e]; }
            s2 += __shfl_xor(s2, 1); s2 += __shfl_xor(s2, 2); s2 += __shfl_xor(s2, 4);
            const float rstd = rsqrtf(s2 * (1.f / 64.f) + GN_EPS);
            const size_t o = gbase + (size_t)st * RW + sj;
            const uint4 rr = *(const uint4*)(Rg + o), kr = *(const uint4*)(K2 + o), gr = *(const uint4*)(Gg + o);
            const unsigned rw_[4] = {rr.x, rr.y, rr.z, rr.w}, kw_[4] = {kr.x, kr.y, kr.z, kr.w}, gw_[4] = {gr.x, gr.y, gr.z, gr.w}, vw_[4] = {vraw.x, vraw.y, vraw.z, vraw.w};
            float rk = 0.f;
#pragma unroll
            for (int e = 0; e < 8; ++e) { const float r_ = (e & 1) ? __uint_as_float(rw_[e >> 1] & 0xffff0000u) : __uint_as_float(rw_[e >> 1] << 16), k_ = (e & 1) ? __uint_as_float(kw_[e >> 1] & 0xffff0000u) : __uint_as_float(kw_[e >> 1] << 16);
                rk += r_ * k_ * r_k[h * 64 + sj + e]; }
            rk += __shfl_xor(rk, 1); rk += __shfl_xor(rk, 2); rk += __shfl_xor(rk, 4);
            float ov[8];
#pragma unroll
            for (int e = 0; e < 8; ++e) { const float v_ = (e & 1) ? __uint_as_float(vw_[e >> 1] & 0xffff0000u) : __uint_as_float(vw_[e >> 1] << 16), g_ = (e & 1) ? __uint_as_float(gw_[e >> 1] & 0xffff0000u) : __uint_as_float(gw_[e >> 1] << 16);
                ov[e] = (y[e] * rstd * ln_w[h * 64 + sj + e] + ln_b[h * 64 + sj + e] + rk * v_) * g_; }
            *(uint4*)(ORW + o) = make_uint4(pk2(ov[0], ov[1]), pk2(ov[2], ov[3]), pk2(ov[4], ov[5]), pk2(ov[6], ov[7]));
        }
    }
}
#undef R1_FOR_TILES
#undef R1_END

__device__ void ph_moe_lists(const P& p, float* ldsf) {
    int* ctl = (int*)(p.ws + WS_CTL); const int* cntB = ctl + CT_CNTB;
    int* ltok = (int*)(p.ws + WS_LTOK); float* lw = (float*)(p.ws + WS_LW);
    int* part = (int*)ldsf;
    int* tot = part + 1024; int* pre = tot + 64; int* offL = pre + 64; int* tp = offL + 64;
    const int tid = otid(), lane = tid & 63, wv = tid >> 6, G = gridDim.x;
    { int t_ = 0, p_ = 0;
      for (int b2 = wv; b2 < G; b2 += 8) { const int v = cntB[b2 * 64 + lane]; t_ += v; p_ += (b2 < (int)blockIdx.x) ? v : 0; }
      part[wv * 64 + lane] = t_; part[512 + wv * 64 + lane] = p_; }
    __syncthreads();
    if (tid < 64) { int t_ = 0, p_ = 0;
#pragma unroll
        for (int w2 = 0; w2 < 8; ++w2) { t_ += part[w2 * 64 + tid]; p_ += part[512 + w2 * 64 + tid]; }
        tot[tid] = t_; pre[tid] = p_;
        const int nt_ = (t_ + 255) >> 8; int incl = nt_;
#pragma unroll
        for (int o = 1; o < 64; o <<= 1) { const int oth = __shfl_up(incl, o); if (lane >= o) incl += oth; }
        tp[tid] = incl - nt_; offL[tid] = (incl - nt_) * 256; if (tid == 63) tp[64] = incl; }
    __syncthreads();
    const int TPB = NT / G;
    for (int i = tid; i < TPB; i += NTHR) { const int m = blockIdx.x * TPB + i; const int4 r = ((const int4*)(p.ws + WS_ROUTE))[m];
        const int l0 = r.x & 255, l1 = 32 + ((r.x >> 8) & 255), rk0 = r.y & 0xffff, rk1 = (r.y >> 16) & 0xffff;
        const int p0 = offL[l0] + pre[l0] + rk0, p1 = offL[l1] + pre[l1] + rk1;
        ltok[p0] = m; lw[p0] = __int_as_float(r.z); ltok[p1] = m; lw[p1] = __int_as_float(r.w); }
    for (int li = blockIdx.x; li < 64; li += G) {
        const int cnt = tot[li], off = offL[li], e = li & 31, nt_ = (cnt + 255) >> 8;
        int4* t1 = (int4*)(ctl + CT_TAB1) + tp[li] * 4;
        int4* t2 = (li < 32) ? (int4*)(ctl + CT_TAB2A) + tp[li] * 4 : (int4*)(ctl + CT_TAB2B) + (tp[li] - tp[32]) * 4;
        for (int i = tid; i < nt_ * 4; i += NTHR) { const int mt = i >> 2, nt = i & 3; const int4 ent = make_int4(off + mt * 256, e * 1024 + nt * 256, cnt - mt * 256, nt); t1[i] = ent; t2[i] = ent; }
        for (int r = cnt + tid; r < nt_ * 256; r += NTHR) ltok[off + r] = 0;
    }
    if (blockIdx.x == 0 && tid == 0) { ctl[CT_NU] = tp[64] * 4; ctl[CT_NU + 1] = tp[32] * 4; ctl[CT_NU + 2] = (tp[64] - tp[32]) * 4; }
}

template <int PH>
__device__ __forceinline__ void run_phase(const P& p, unsigned char* lds_raw) {
    float* lds = (float*)lds_raw; PG8_LAS unsigned char* ldsg = (PG8_LAS unsigned char*)lds_raw;
    const int G = gridDim.x, c = blockIdx.x;
    if constexpr (PH == 0) { ph_mod(p, lds); __syncthreads(); ph_convert_mixer_weights(p, lds); __syncthreads(); ph_convert_lora_weights(p, lds); }
    if constexpr (PH == 1) ph_norm(p, p.in[0], p.in[4], 0, (bf16_t*)(p.ws + WS_XN));
    if constexpr (PH == 2) { pg8::Gemm g{(const bf16_t*)(p.ws + WS_XN), (const bf16_t*)(p.ws + WS_WIN), DM, nullptr}; pg8::StaticOrder S; S.init(NT, 5120, G, c);
        pg8::EpiInproj E{p.ws, (bf16_t*)p.out}; pg8::gemm_phase(ldsg, g, S, E); }
    if constexpr (PH == 3) {
        { pg8::Gemm g{(const bf16_t*)(p.ws + WS_KVN), (const bf16_t*)(p.ws + WS_WKV), KVL, nullptr}; pg8::StaticOrder S; S.init(NT, 2 * AW, G, c);
          pg8::EpiKV E{p.ws}; pg8::gemm_phase(ldsg, g, S, E); }
        ph_rwkv_prep_r1(p, lds);
        ph_dsa_select(p, lds);
    }
    if constexpr (PH == 4) { ph_rwkv_r2(p, c, NB * 8, G); ph_dsa_attn(p, lds); }
    if constexpr (PH == 5) ph_rwkv_r3(p, lds);
    if constexpr (PH == 6) { pg8::Gemm g{(const bf16_t*)(p.ws + WS_OATT), (const bf16_t*)(p.ws + WS_WBA), AW, nullptr}; pg8::BranchOrder S; S.S0.init(NT, DM, G, c);
        pg8::EpiMerge E{(bf16_t*)(p.ws + WS_MERGED), (const bf16_t*)p.out}; pg8::gemm_phase(ldsg, g, S, E);
        ph_convert_expert_weights(p, lds); }
    if constexpr (PH == 7) { pg8::Gemm g{(const bf16_t*)(p.ws + WS_MERGED), (const bf16_t*)(p.ws + WS_WOUT), DM, nullptr}; pg8::StaticOrder S; S.init(NT, DM, G, c);
        pg8::EpiOut E{p.in[0], (const float*)(p.ws + WS_MOD), p.out}; pg8::gemm_phase(ldsg, g, S, E); }
    if constexpr (PH == 8) ph_norm_route(p, lds);
    if constexpr (PH == 9) ph_moe_lists(p, lds);
    if constexpr (PH == 10) { const int* ctl = (const int*)(p.ws + WS_CTL);
        pg8::Gemm g{(const bf16_t*)(p.ws + WS_XN2), (const bf16_t*)(p.ws + WS_WGU), DM, (const int*)(p.ws + WS_LTOK)}; pg8::TableOrder S{(const int4*)(ctl + CT_TAB1), ctl[CT_NU], G, c};
        pg8::EpiMoe1 E{(bf16_t*)(p.ws + WS_HID), (const float*)(p.ws + WS_LW)}; pg8::gemm_phase(ldsg, g, S, E); }
    if constexpr (PH == 11 || PH == 12) { const int* ctl = (const int*)(p.ws + WS_CTL);
        pg8::Gemm g{(const bf16_t*)(p.ws + WS_HID), (const bf16_t*)(p.ws + WS_WDN), DE, nullptr};
        pg8::TableOrder S{(const int4*)(ctl + (PH == 11 ? CT_TAB2A : CT_TAB2B)), ctl[CT_NU + (PH == 11 ? 1 : 2)], G, c};
        pg8::EpiMoe2 E{(const int*)(p.ws + WS_LTOK), (const float*)(p.ws + WS_MOD), p.out}; pg8::gemm_phase(ldsg, g, S, E); }
}
constexpr int LDS_BYTES = 147456;
constexpr int ORDER[] = {0, 1, 2, 3, 4, 5, 6, 7, 8, 9, 10, 11, 12};
constexpr int NPHASE = sizeof(ORDER) / sizeof(int);
constexpr int CT_BAR = 65536;
constexpr int LDS_ST = LDS_BYTES - 64;
template <int I> __device__ __forceinline__ void run_all(const P& p, unsigned char* lds, const XcdBarrier& bar) {
    run_phase<ORDER[I]>(p, lds);
    if constexpr (I + 1 < NPHASE) { xcd_barrier(bar); run_all<I + 1>(p, lds, bar); }
}
__global__ void __launch_bounds__(NTHR, 2) k_mega(P p) {
    extern __shared__ __attribute__((aligned(16))) unsigned char lds[];
    volatile LAS3 unsigned* st = (volatile LAS3 unsigned*)((LAS3 unsigned char*)lds + LDS_ST);
    if (otid() < 16) st[otid()] = 0u;
    __syncthreads();
    const XcdBarrier bar = xcd_barrier_post((unsigned*)(p.ws + WS_CTL) + CT_BAR, st);
    run_all<0>(p, lds, bar);
}
}

extern "C" void kernel_launch(void* const* d_in, const int* in_sizes, int n_in, void* d_out, int out_size, void* d_ws, size_t ws_size, hipStream_t stream) {
    if (n_in != 31 || out_size != NT * DM || ws_size < WS_END) { fprintf(stderr, "kernel_launch: unexpected shapes (n_in %d out %d ws %zu need %zu)\n", n_in, out_size, ws_size, (size_t)WS_END); return; }
    P p{};
    for (int i = 0; i < 31; ++i) p.in[i] = (const float*)d_in[i];
    p.out = (float*)d_out; p.ws = (unsigned char*)d_ws;
    (void)hipMemsetAsync((char*)d_ws + WS_CTL, 0, 1 * MiB, stream);
    static int grid_blocks = 0;
    if (!grid_blocks) {
        int dev = 0, cus = 0, per_cu = 0;
        (void)hipGetDevice(&dev);
        (void)hipDeviceGetAttribute(&cus, hipDeviceAttributeMultiprocessorCount, dev);
        (void)hipFuncSetAttribute((const void*)k_mega, hipFuncAttributeMaxDynamicSharedMemorySize, LDS_BYTES);
        (void)hipOccupancyMaxActiveBlocksPerMultiprocessor(&per_cu, (const void*)k_mega, NTHR, LDS_BYTES);
        if (per_cu < 1) per_cu = 1;
        if (per_cu > 1) per_cu = 1;
        grid_blocks = cus * per_cu;
        fprintf(stderr, "kernel_launch: cus %d per_cu %d grid %d\n", cus, per_cu, grid_blocks);
    }
    hipLaunchKernelGGL(k_mega, dim3(grid_blocks), dim3(NTHR), LDS_BYTES, stream, p);
}
```

```cpp
#include <hip/hip_runtime.h>
#include <cstdio>
#include <cstdint>

namespace {
constexpr int NB = 2, SEQ = 8192, DM = 1024, NT = NB * SEQ;
constexpr int AW = 512, KVL = 256, NIH = 8, IDD = 32, SHW = 1824, INW = 4936;
constexpr int C_KV = 512, C_QI = 768, C_PS = 1064, C_GA = 2888, C_GR = 3912;
constexpr int IDXW = 296;
constexpr int RW = 512, NE = 32, DE = 512;
constexpr int TOPK = 256;
constexpr float NORM_EPS = 1e-6f, GN_EPS = 64e-5f;
constexpr int NTHR = 512;

typedef unsigned short bf16_t;
__device__ __forceinline__ float bf2f(bf16_t v) { return __uint_as_float(((unsigned)v) << 16); }
__device__ __forceinline__ bf16_t f2bf(float f) { unsigned u = __float_as_uint(f); return (bf16_t)((u + 0x7fffu + ((u >> 16) & 1u)) >> 16); }

constexpr size_t MiB = 1u << 20;
constexpr size_t WS_CTL = 0;
constexpr size_t WS_MOD = 1 * MiB;
constexpr size_t WS_RSS = 128 * 1024;
constexpr size_t WS_LW2T = 512 * 1024, WS_LA2T = 576 * 1024, WS_LG2T = 640 * 1024;
constexpr size_t WS_WIN = 2 * MiB;
constexpr size_t WS_WKV = 12 * MiB;
constexpr size_t WS_WBA = 13 * MiB;
constexpr size_t WS_WBR = 14 * MiB;
constexpr size_t WS_WOUT = 15 * MiB;
constexpr size_t WS_XN = 17 * MiB;
constexpr size_t WS_K = 17 * MiB;
constexpr size_t WS_V = 33 * MiB;
constexpr size_t WS_Q = 49 * MiB;
constexpr size_t WS_KVN = 65 * MiB;
constexpr size_t WS_QI = 73 * MiB;
constexpr size_t WS_KI = 81 * MiB;
constexpr size_t WS_WI = 82 * MiB;
constexpr size_t WS_PS = 83 * MiB;
constexpr size_t WS_SX = 83 * MiB;
constexpr size_t WS_OATT = 99 * MiB;
constexpr size_t WS_ORW = 115 * MiB;
constexpr size_t WS_MASK = 140 * MiB;
constexpr size_t WS_R = 156 * MiB, WS_K2 = 172 * MiB, WS_VV = 188 * MiB;
constexpr size_t WS_KK = 204 * MiB;
constexpr size_t WS_BB = 220 * MiB;
constexpr size_t WS_DD = 236 * MiB;
constexpr size_t WS_G = 268 * MiB;
constexpr size_t WS_MERGED = 131 * MiB;
constexpr size_t WS_XN2 = 163 * MiB;
constexpr size_t WS_WGU = 195 * MiB;
constexpr size_t WS_WDN = 259 * MiB;
constexpr size_t WS_HID = 17 * MiB;
constexpr size_t WS_ROUTE = 65 * MiB;
constexpr size_t WS_LTOK = 66 * MiB;
constexpr size_t WS_LW = 67 * MiB;
constexpr size_t WS_END = 291 * MiB;
constexpr int HID_ROWS = 49152;
constexpr int CT_CNT = 0, CT_OFF = 64, CT_CUR = 128, CT_NU = 192, CT_Q = 256;
constexpr int CT_CNTB = 16384;
constexpr int CT_TAB1 = 1024, CT_TAB2A = 1024 + 4 * 1024, CT_TAB2B = 1024 + 8 * 1024;

struct P {
    const float* in[31];
    float* out;
    unsigned char* ws;
};

__device__ __forceinline__ int otid() { int t = threadIdx.x; asm volatile("" : "+v"(t)); return t; }
__device__ __forceinline__ float dpp_row_shr(float v, int n) {
    int iv = __builtin_bit_cast(int, v), r;
    switch (n) { case 1: r = __builtin_amdgcn_update_dpp(0, iv, 0x111, 0xf, 0xf, true); break; case 2: r = __builtin_amdgcn_update_dpp(0, iv, 0x112, 0xf, 0xf, true); break;
                 case 4: r = __builtin_amdgcn_update_dpp(0, iv, 0x114, 0xf, 0xf, true); break; default: r = __builtin_amdgcn_update_dpp(0, iv, 0x118, 0xf, 0xf, true); break; }
    return __builtin_bit_cast(float, r);
}
__device__ __forceinline__ float wave_sum(float v) {
    v += dpp_row_shr(v, 1); v += dpp_row_shr(v, 2); v += dpp_row_shr(v, 4); v += dpp_row_shr(v, 8);
    v += __builtin_bit_cast(float, __builtin_amdgcn_update_dpp(0, __builtin_bit_cast(int, v), 0x142, 0xa, 0xf, false));
    v += __builtin_bit_cast(float, __builtin_amdgcn_update_dpp(0, __builtin_bit_cast(int, v), 0x143, 0xc, 0xf, false));
    return __builtin_bit_cast(float, __builtin_amdgcn_readlane(__builtin_bit_cast(int, v), 63));
}
__device__ __forceinline__ float wave_max(float v) {
#pragma unroll
    for (int o = 32; o > 0; o >>= 1) v = fmaxf(v, __shfl_xor(v, o));
    return v;
}
typedef short bf16x8_t __attribute__((ext_vector_type(8)));
typedef float f32x4_t __attribute__((ext_vector_type(4)));
constexpr int LP = 72;
constexpr int SLOT = 64 * LP;
__device__ __forceinline__ float sigmoidf_(float x) { return 1.f / (1.f + __expf(-x)); }

#define XB_TMO      128
#define XB_XCNT(j)  (256  + 64 * (j))
#define XB_XSUB(j)  (1280 + 64 * (j))
#define XB_XGEN(j)  (2304 + 64 * (j))
#define XB_TOP      3328
#define XB_TOPGEN   3392
#define XCD_BAR_WORDS 3456
#define XB_SPIN_CAP (1u << 22)
#define LAS3 __attribute__((address_space(3)))
__device__ __forceinline__ unsigned xb_ld(unsigned* p)              { return __hip_atomic_load(p, __ATOMIC_RELAXED, __HIP_MEMORY_SCOPE_AGENT); }
__device__ __forceinline__ unsigned xb_add(unsigned* p, unsigned v) { return __hip_atomic_fetch_add(p, v, __ATOMIC_RELAXED, __HIP_MEMORY_SCOPE_AGENT); }
__device__ __forceinline__ unsigned xb_xcc_id() { return (unsigned)__builtin_amdgcn_s_getreg((3 << 11) | 20) & 0xFu; }
#define XB_SPIN(cond, bar) do { unsigned _sp = 0; while (cond) { __builtin_amdgcn_s_sleep(1); \
    if ((++_sp & 255u) == 0u) { if (xb_ld(&(bar)[XB_TMO])) break; if (_sp > XB_SPIN_CAP) { atomicAdd(&(bar)[XB_TMO], 1u); break; } } } } while (0)
struct XcdBarrier { unsigned* bar; unsigned x; volatile LAS3 unsigned* st; };
__device__ __forceinline__ XcdBarrier xcd_barrier_post(unsigned* bar, volatile LAS3 unsigned* st) {
    XcdBarrier b; b.bar = bar; b.x = xb_xcc_id(); b.st = st;
    if (otid() == 0) (void)xb_add(&bar[XB_XCNT(b.x)], 1u);
    return b;
}
__device__ __forceinline__ void xcd_barrier_complete(unsigned* bar, unsigned x, unsigned& nloc, unsigned& nx) {
    const unsigned G = gridDim.x * gridDim.y * gridDim.z;
    unsigned sum, cnt, mine, sp = 0u;
    for (;;) {
        sum = 0u; cnt = 0u; mine = 0u;
#pragma unroll
        for (unsigned j = 0; j < 16; ++j) { const unsigned c = xb_ld(&bar[XB_XCNT(j)]); sum += c; cnt += (c > 0u) ? 1u : 0u; mine = (j == x) ? c : mine; }
        if (sum == G) break;
        __builtin_amdgcn_s_sleep(1);
        if ((++sp & 255u) == 0u) { if (xb_ld(&bar[XB_TMO])) break; if (sp > XB_SPIN_CAP) { atomicAdd(&bar[XB_TMO], 1u); break; } }
    }
    nloc = mine > 0u ? mine : 1u; nx = cnt > 0u ? cnt : 1u;
}
__device__ __forceinline__ void xcd_barrier(const XcdBarrier& b) {
    asm volatile("s_waitcnt vmcnt(0)" ::: "memory");
    __syncthreads();
    if (otid() == 0) {
        unsigned* bar = b.bar;
        __builtin_amdgcn_s_waitcnt(0);
        unsigned nloc = b.st[0], nx = b.st[1];
        if (nloc == 0u) { xcd_barrier_complete(bar, b.x, nloc, nx); b.st[0] = nloc; b.st[1] = nx; }
        const unsigned old = xb_add(&bar[XB_XSUB(b.x)], 1u);
        const unsigned gen = old / nloc;
        if (old + 1u == (gen + 1u) * nloc) {
            __builtin_amdgcn_fence(__ATOMIC_RELEASE, "agent");
            asm volatile("s_waitcnt vmcnt(0)" ::: "memory");
            const unsigned og = xb_add(&bar[XB_TOP], 1u);
            const unsigned tg = og / nx;
            if (og + 1u == (tg + 1u) * nx) xb_add(&bar[XB_TOPGEN], 1u);
            else XB_SPIN(xb_ld(&bar[XB_TOPGEN]) == tg, bar);
            __builtin_amdgcn_fence(__ATOMIC_ACQUIRE, "agent");
            xb_add(&bar[XB_XGEN(b.x)], 1u);
            asm volatile("s_waitcnt vmcnt(0)" ::: "memory");
        } else {
            XB_SPIN(xb_ld(&bar[XB_XGEN(b.x)]) == gen, bar);
            __builtin_amdgcn_fence(__ATOMIC_ACQUIRE, "agent");
            asm volatile("s_waitcnt vmcnt(0)" ::: "memory");
        }
    }
    __syncthreads();
}

__device__ void ph_mod(const P& p, float* lds) {
    const float* c = p.in[1]; const float* W = p.in[2]; const float* bia = p.in[3];
    float* mod = (float*)(p.ws + WS_MOD);
    const int tid = otid(), lane = tid & 63, wv = tid >> 6;
    float* sil = lds; float* part = lds + NB * DM;
    for (int i = tid; i < NB * DM; i += NTHR) { const float v = c[i]; sil[i] = v / (1.f + __expf(-v)); }
    __syncthreads();
    const int cc = lane % 24, kk = lane / 24;
    for (int j0 = blockIdx.x * 24; j0 < 6 * DM; j0 += gridDim.x * 24) {
        float a0 = 0.f, a1 = 0.f;
        if (lane < 48) {
#pragma unroll 8
            for (int i = 0; i < 64; ++i) { const int k = 128 * wv + 2 * i + kk; const float w = W[(size_t)k * (6 * DM) + j0 + cc]; a0 += sil[k] * w; a1 += sil[DM + k] * w; }
        }
        a0 += __shfl(a0, (lane + 24) & 63); a1 += __shfl(a1, (lane + 24) & 63);
        if (lane < 24) { part[(wv * 2 + 0) * 24 + cc] = a0; part[(wv * 2 + 1) * 24 + cc] = a1; }
        __syncthreads();
        if (tid < 48) { const int bb = tid / 24, c2 = tid % 24; float sum = 0.f;
#pragma unroll
            for (int w2 = 0; w2 < 8; ++w2) sum += part[(w2 * 2 + bb) * 24 + c2];
            mod[bb * 6 * DM + j0 + c2] = sum + bia[j0 + c2]; }
        __syncthreads();
    }
}

__device__ void ph_norm(const P& p, const float* src, const float* g, int which, bf16_t* dst) {
    const float* mod = (const float*)(p.ws + WS_MOD);
    const int lane = otid() & 63, wv = otid() >> 6;
    const int gw = blockIdx.x * (NTHR / 64) + wv, nw = gridDim.x * (NTHR / 64);
    for (int m = gw; m < NT; m += nw) {
        const int b = m / SEQ;
        const float* sh = mod + b * 6 * DM + (which ? 3 * DM : 0);
        const float* sc = sh + DM;
        const float4* xr = (const float4*)(src + (size_t)m * DM);
        float4 v[4]; float ss = 0.f;
#pragma unroll
        for (int j = 0; j < 4; ++j) { v[j] = xr[lane + 64 * j]; ss += v[j].x * v[j].x + v[j].y * v[j].y + v[j].z * v[j].z + v[j].w * v[j].w; }
        ss = wave_sum(ss);
        const float rstd = rsqrtf(ss * (1.f / DM) + NORM_EPS);
        float o[16];
#pragma unroll
        for (int j = 0; j < 4; ++j) {
            int c0 = 4 * (lane + 64 * j); asm volatile("" : "+v"(c0));
            const float4 gg = *(const float4*)(g + c0), s1 = *(const float4*)(sc + c0), s0 = *(const float4*)(sh + c0);
            o[4 * j + 0] = v[j].x * rstd * gg.x * (1.f + s1.x) + s0.x; o[4 * j + 1] = v[j].y * rstd * gg.y * (1.f + s1.y) + s0.y;
            o[4 * j + 2] = v[j].z * rstd * gg.z * (1.f + s1.z) + s0.z; o[4 * j + 3] = v[j].w * rstd * gg.w * (1.f + s1.w) + s0.w;
            uint2 pk; pk.x = (unsigned)f2bf(o[4 * j]) | ((unsigned)f2bf(o[4 * j + 1]) << 16); pk.y = (unsigned)f2bf(o[4 * j + 2]) | ((unsigned)f2bf(o[4 * j + 3]) << 16);
            *(uint2*)(dst + (size_t)m * DM + c0) = pk;
        }
    }
}

__device__ void ph_norm_route(const P& p, float* lds) {
    const float* mod = (const float*)(p.ws + WS_MOD); const float* src = p.out; const float* g = p.in[24]; bf16_t* dst = (bf16_t*)(p.ws + WS_XN2);
    const float* wgr = p.in[25]; const float* wer = p.in[26]; const float* eb = p.in[27];
    const int tid = otid(), lane = tid & 63, wv = tid >> 6;
    float* sx = lds + wv * 4096;
    int* cntL = (int*)(lds + 8 * 4096);
    if (tid < 64) cntL[tid] = 0;
    __syncthreads();
    const int TPB = NT / gridDim.x;
    for (int m0 = blockIdx.x * TPB + wv * 4; m0 < (blockIdx.x + 1) * TPB; m0 += 8 * 4) {
        const int b = m0 / SEQ;
        const float* sh = mod + b * 6 * DM + 3 * DM; const float* sc = sh + DM;
#pragma unroll 1
        for (int tk = 0; tk < 4; ++tk) {
            const int m = m0 + tk;
            const float4* xr = (const float4*)(src + (size_t)m * DM);
            float4 v[4]; float ss = 0.f;
#pragma unroll
            for (int j = 0; j < 4; ++j) { v[j] = xr[lane + 64 * j]; ss += v[j].x * v[j].x + v[j].y * v[j].y + v[j].z * v[j].z + v[j].w * v[j].w; }
            ss = wave_sum(ss);
            const float rstd = rsqrtf(ss * (1.f / DM) + NORM_EPS);
#pragma unroll
            for (int j = 0; j < 4; ++j) {
                const int c0 = 4 * (lane + 64 * j);
                const float4 gg = *(const float4*)(g + c0), s1 = *(const float4*)(sc + c0), s0 = *(const float4*)(sh + c0);
                const float o0 = v[j].x * rstd * gg.x * (1.f + s1.x) + s0.x, o1 = v[j].y * rstd * gg.y * (1.f + s1.y) + s0.y;
                const float o2 = v[j].z * rstd * gg.z * (1.f + s1.z) + s0.z, o3 = v[j].w * rstd * gg.w * (1.f + s1.w) + s0.w;
                uint2 pk; pk.x = (unsigned)f2bf(o0) | ((unsigned)f2bf(o1) << 16); pk.y = (unsigned)f2bf(o2) | ((unsigned)f2bf(o3) << 16);
                *(uint2*)(dst + (size_t)m * DM + c0) = pk;
                sx[(c0 + 0) * 4 + tk] = o0; sx[(c0 + 1) * 4 + tk] = o1; sx[(c0 + 2) * 4 + tk] = o2; sx[(c0 + 3) * 4 + tk] = o3;
            }
        }
        __builtin_amdgcn_wave_barrier(); asm volatile("s_waitcnt lgkmcnt(0)" ::: "memory");
        float ae[4] = {0.f, 0.f, 0.f, 0.f}, ag[4] = {0.f, 0.f, 0.f, 0.f};
        { const int e = lane & 31, kb = (lane >> 5) * 512;
#pragma unroll 16
          for (int i = 0; i < 512; ++i) { const float w = wer[(size_t)(kb + i) * 32 + e]; const float4 xv = *(const float4*)(sx + (kb + i) * 4);
              ae[0] += xv.x * w; ae[1] += xv.y * w; ae[2] += xv.z * w; ae[3] += xv.w * w; } }
        { const int gq = lane & 3, kb = (lane >> 2) * 64;
#pragma unroll 16
          for (int i = 0; i < 64; ++i) { const float w = wgr[(size_t)(kb + i) * 4 + gq]; const float4 xv = *(const float4*)(sx + (kb + i) * 4);
              ag[0] += xv.x * w; ag[1] += xv.y * w; ag[2] += xv.z * w; ag[3] += xv.w * w; } }
#pragma unroll
        for (int tk = 0; tk < 4; ++tk) {
            ae[tk] += __shfl_xor(ae[tk], 32);
            ag[tk] += __shfl_xor(ag[tk], 4); ag[tk] += __shfl_xor(ag[tk], 8); ag[tk] += __shfl_xor(ag[tk], 16); ag[tk] += __shfl_xor(ag[tk], 32);
        }
#pragma unroll
        for (int tk = 0; tk < 4; ++tk) {
            float lg[4];
#pragma unroll
            for (int q = 0; q < 4; ++q) lg[q] = __shfl(ag[tk], q);
            int gs = 0; float mx = lg[0];
#pragma unroll
            for (int q = 1; q < 4; ++q) if (lg[q] > mx) { mx = lg[q]; gs = q; }
            float den = 0.f;
#pragma unroll
            for (int q = 0; q < 4; ++q) den += __expf(lg[q] - mx);
            const float pg = 1.f / den;
            float ev[8];
#pragma unroll
            for (int q = 0; q < 8; ++q) ev[q] = __shfl(ae[tk], gs * 8 + q) + eb[gs * 8 + q];
            int i0 = 0; float v0 = ev[0];
#pragma unroll
            for (int q = 1; q < 8; ++q) if (ev[q] > v0) { v0 = ev[q]; i0 = q; }
            int i1 = -1; float v1 = -INFINITY;
#pragma unroll
            for (int q = 0; q < 8; ++q) if (q != i0 && ev[q] > v1) { v1 = ev[q]; i1 = q; }
            if (lane == 0) {
                const float e1 = __expf(v1 - v0), w0 = pg / (1.f + e1), w1 = pg * e1 / (1.f + e1);
                const int x0 = gs * 8 + i0, x1 = gs * 8 + i1;
                const int rk0 = atomicAdd(&cntL[x0], 1), rk1 = atomicAdd(&cntL[32 + x1], 1);
                int4* route = (int4*)(p.ws + WS_ROUTE) + (size_t)(m0 + tk);
                *route = make_int4(x0 | (x1 << 8), rk0 | (rk1 << 16), __float_as_int(w0), __float_as_int(w1));
            }
        }
        __builtin_amdgcn_wave_barrier();
    }
    __syncthreads();
    if (tid < 64) ((int*)(p.ws + WS_CTL) + CT_CNTB)[blockIdx.x * 64 + tid] = cntL[tid];
}

namespace pg8 {
#define PG8_LAS __attribute__((address_space(3)))
typedef short bf16x8 __attribute__((ext_vector_type(8)));
typedef float f32x4 __attribute__((ext_vector_type(4)));
typedef unsigned u32x4 __attribute__((ext_vector_type(4)));
constexpr int BM = 256, BK = 64, HALF = 128, HTB = HALF * BK * 2, STAGE_BYTES = 8 * HTB, NXCD = 8, WGM = 8;
__host__ __device__ __forceinline__ int lds_byte(int r, int c) { const int st = (r >> 4) * 2 + (c >> 5), rr = r & 15, cc = c & 31, ob = rr * 64 + cc * 2; return st * 1024 + (ob ^ (((ob >> 9) & 1) << 5)); }
__host__ __device__ __forceinline__ void stage_rc(int b, int& R, int& C) { const int st = b / 1024, sb = b % 1024, swz = sb ^ (((sb >> 9) & 1) << 5); R = (st >> 1) * 16 + swz / 64; C = (st & 1) * 32 + (swz % 64) / 2; }
__host__ __device__ __forceinline__ int perm32(int rho) { const int n = rho >> 4, i = rho & 15; return 8 * (i >> 2) + 4 * n + (i & 3); }

struct Unit { int arow, brow, pm, pn, aux; };
struct Gemm { const bf16_t* A; const bf16_t* Bt; int K; const int* gather; };

struct StaticOrder {
    int nM, nN, nwg, G, c;
    __device__ void init(int M, int N, int G_, int c_) { nM = M / BM; nN = N / BM; nwg = nM * nN; G = G_; c = c_; }
    __device__ bool next(int i, Unit& u) const {
        const long L = (long)i * G + c; if (L >= nwg) return false;
        int wgid = (int)L; { const int q = nwg / NXCD, r = nwg % NXCD, xcd = wgid % NXCD, off = wgid / NXCD; wgid = (xcd < r ? xcd * (q + 1) : r * (q + 1) + (xcd - r) * q) + off; }
        const int nig = WGM * nN, gid = wgid / nig, fm = gid * WGM, gsz = (nM - fm) < WGM ? (nM - fm) : WGM;
        u.pm = fm + ((wgid % nig) % gsz); u.pn = (wgid % nig) / gsz; u.arow = u.pm * BM; u.brow = u.pn * BM; u.aux = 0; return true;
    }
};
struct BranchOrder {
    StaticOrder S0;
    __device__ bool next(int i, Unit& u) const {
        if (!S0.next(i >> 1, u)) return false;
        const int which = i & 1; u.arow += which * NT; u.brow += which * DM; u.aux = which; return true;
    }
};
struct TableOrder {
    const int4* tab; int n, G, c;
    __device__ bool next(int i, Unit& u) const {
        const int L = i * G + c; if (L >= n) return false;
        const int4 e = tab[L]; u.arow = __builtin_amdgcn_readfirstlane(e.x); u.brow = __builtin_amdgcn_readfirstlane(e.y); u.aux = __builtin_amdgcn_readfirstlane(e.z); u.pn = __builtin_amdgcn_readfirstlane(e.w); u.pm = 0; return true;
    }
};
__device__ __forceinline__ unsigned cvt_pk_bf16(float lo, float hi) { unsigned r; asm volatile("v_cvt_pk_bf16_f32 %0, %1, %2" : "=v"(r) : "v"(lo), "v"(hi)); return r; }

template <class Epi, class Sched>
__device__ __forceinline__ void gemm_phase(PG8_LAS unsigned char* lds, const Gemm g, const Sched& S, const Epi& E) {
    const int tid = otid(), wid = __builtin_amdgcn_readfirstlane(tid >> 6), lane = tid & 63, wr = wid >> 2, wc = wid & 3, fr = lane & 15, fq = lane >> 4;
    const int K = g.K, nt = K / BK;
    int RA0; unsigned cofA0, voffB0;
    { int R, C; stage_rc(tid * 16, R, C); const int Rb = Epi::PERM ? ((R & ~31) + perm32(R & 31)) : R; RA0 = R; cofA0 = (unsigned)C * 2u; voffB0 = (unsigned)(Rb * K + C) * 2u; }
    const size_t rstep64 = (size_t)64 * K * 2;
    const size_t kstep = (size_t)(BK * 2);
    const size_t hstep = (size_t)HALF * K * 2;
    const unsigned ldsw = (unsigned)wid * 1024u;
    const int aoff = lds_byte(wr * 64 + fr, fq * 8), boff = lds_byte(wc * 32 + fr, fq * 8);
#define PG8_SA(b, h) (((b) * 2 + (h)) * HTB)
#define PG8_SB(b, h) ((4 + (b) * 2 + (h)) * HTB)
#define PG8_STAGE_B(bufoff, gbase) do { _Pragma("unroll") for (int _i = 0; _i < 2; ++_i) \
        __builtin_amdgcn_global_load_lds((const unsigned*)((const char*)(gbase) + _i * rstep64 + voffB0), (PG8_LAS unsigned*)(lds + (bufoff) + ldsw + _i * 8192), 16, 0, 0); } while (0)
#define PG8_STAGE_A(bufoff, o2, kb) do { _Pragma("unroll") for (int _i = 0; _i < 2; ++_i) \
        __builtin_amdgcn_global_load_lds((const unsigned*)((const char*)g.A + (size_t)(o2)[_i] + (size_t)(kb)), (PG8_LAS unsigned*)(lds + (bufoff) + ldsw + _i * 8192), 16, 0, 0); } while (0)
#define PG8_LDA(dst, b, h) do { _Pragma("unroll") for (int m = 0; m < 4; ++m) _Pragma("unroll") for (int k = 0; k < 2; ++k) dst[m][k] = *(const PG8_LAS bf16x8*)(lds + PG8_SA(b, h) + aoff + m * 2048 + k * 1024); } while (0)
#define PG8_LDB(dst, b, h) do { _Pragma("unroll") for (int n = 0; n < 2; ++n) _Pragma("unroll") for (int k = 0; k < 2; ++k) dst[n][k] = *(const PG8_LAS bf16x8*)(lds + PG8_SB(b, h) + boff + n * 2048 + k * 1024); } while (0)
#define PG8_MMA(ai, bj, At, Bt) do { __builtin_amdgcn_s_setprio(1); _Pragma("unroll") for (int m = 0; m < 4; ++m) _Pragma("unroll") for (int n = 0; n < 2; ++n) _Pragma("unroll") for (int k = 0; k < 2; ++k) \
        acc[ai][bj][m][n] = __builtin_amdgcn_mfma_f32_16x16x32_bf16(Bt[n][k], At[m][k], acc[ai][bj][m][n], 0, 0, 0); __builtin_amdgcn_s_setprio(0); } while (0)
#define PG8_WAIT_V(n) asm volatile("s_waitcnt vmcnt(" #n ")" ::: "memory")
#define PG8_WAIT_L(n) asm volatile("s_waitcnt lgkmcnt(" #n ")" ::: "memory")
#define PG8_BAR __builtin_amdgcn_s_barrier()
#define PG8_SCHED __builtin_amdgcn_sched_barrier(0)
#define PG8_AOFFS(u, dst) do { _Pragma("unroll") for (int _h = 0; _h < 2; ++_h) _Pragma("unroll") for (int _i = 0; _i < 2; ++_i) { \
        const int _tr = (u).arow + _h * HALF + RA0 + 64 * _i; const unsigned _row = g.gather ? (unsigned)g.gather[_tr] : (unsigned)_tr; dst[_h][_i] = _row * (unsigned)(K * 2) + cofA0; } } while (0)
    Unit cur, nxt; int ui = 0;
    if (!S.next(0, cur)) return;
    f32x4 acc[2][2][4][2];
#pragma unroll
    for (int a = 0; a < 2; ++a)
#pragma unroll
        for (int b = 0; b < 2; ++b)
#pragma unroll
            for (int m = 0; m < 4; ++m)
#pragma unroll
                for (int n = 0; n < 2; ++n) acc[a][b][m][n] = (f32x4){0.f, 0.f, 0.f, 0.f};
    bf16x8 At[4][2], B0[2][2], B1[2][2];
    unsigned cof[2][2];
    PG8_AOFFS(cur, cof);
    const char* cB = (const char*)g.Bt + (size_t)cur.brow * K * 2;
    PG8_STAGE_B(PG8_SB(0, 0), cB); PG8_STAGE_B(PG8_SB(0, 1), cB + hstep); PG8_STAGE_A(PG8_SA(0, 0), cof[0], 0); PG8_STAGE_A(PG8_SA(0, 1), cof[1], 0);
    if (wr == 1) PG8_BAR;
    PG8_WAIT_V(2); PG8_BAR;
    PG8_STAGE_B(PG8_SB(1, 0), cB + kstep); PG8_STAGE_A(PG8_SA(1, 0), cof[0], kstep); PG8_STAGE_B(PG8_SB(1, 1), cB + hstep + kstep);
    PG8_WAIT_V(6); PG8_BAR;
    for (;;) {
        const bool has_next = S.next(ui + 1, nxt);
        if (!has_next) nxt = cur;
        const char* nB = (const char*)g.Bt + (size_t)nxt.brow * K * 2;
        for (int t = 0; t < nt; t += 2) {
            const bool last = (t == nt - 2);
            const size_t k1 = (size_t)(t + 1) * kstep;
            const size_t k2 = last ? 0 : (size_t)(t + 2) * kstep, k3 = k2 + kstep;
            const char* b2 = last ? nB : cB + (size_t)(t + 2) * kstep; const char* b3 = b2 + kstep;
            PG8_LDB(B0, 0, 0); PG8_LDB(B1, 0, 1); PG8_SCHED; PG8_LDA(At, 0, 0); PG8_STAGE_A(PG8_SA(1, 1), cof[1], k1);
            if (last) { PG8_AOFFS(nxt, cof); }
            PG8_WAIT_V(8); PG8_WAIT_L(0); PG8_BAR; PG8_MMA(0, 0, At, B0); PG8_MMA(0, 1, At, B1); PG8_BAR; PG8_SCHED;
            PG8_LDA(At, 0, 1); PG8_STAGE_B(PG8_SB(0, 0), b2); PG8_STAGE_B(PG8_SB(0, 1), b2 + hstep); PG8_STAGE_A(PG8_SA(0, 0), cof[0], k2);
            PG8_WAIT_V(8); PG8_WAIT_L(0); PG8_BAR; PG8_MMA(1, 0, At, B0); PG8_MMA(1, 1, At, B1); PG8_BAR; PG8_SCHED;
            PG8_LDB(B0, 1, 0); PG8_LDB(B1, 1, 1); PG8_SCHED; PG8_LDA(At, 1, 0); PG8_STAGE_A(PG8_SA(0, 1), cof[1], k2);
            PG8_WAIT_V(8); PG8_WAIT_L(0); PG8_BAR; PG8_MMA(0, 0, At, B0); PG8_MMA(0, 1, At, B1); PG8_BAR; PG8_SCHED;
            PG8_LDA(At, 1, 1); PG8_STAGE_B(PG8_SB(1, 0), b3); PG8_STAGE_B(PG8_SB(1, 1), b3 + hstep); PG8_STAGE_A(PG8_SA(1, 0), cof[0], k3);
            PG8_WAIT_V(8); PG8_WAIT_L(0); PG8_BAR; PG8_MMA(1, 0, At, B0); PG8_MMA(1, 1, At, B1); PG8_BAR; PG8_SCHED;
        }
        if (wr == 0) PG8_BAR;
        { const int l2 = otid() & 63; E(acc, cur, wr, wc, l2 & 15, l2 >> 4); }
        if (!has_next) break;
#pragma unroll
        for (int a = 0; a < 2; ++a)
#pragma unroll
            for (int b = 0; b < 2; ++b)
#pragma unroll
                for (int m = 0; m < 4; ++m)
#pragma unroll
                    for (int n = 0; n < 2; ++n) acc[a][b][m][n] = (f32x4){0.f, 0.f, 0.f, 0.f};
        cur = nxt; cB = nB; ++ui;
        if (wr == 1) PG8_BAR;
    }
    PG8_WAIT_V(0);
    PG8_BAR;
#undef PG8_SA
#undef PG8_SB
#undef PG8_STAGE_A
#undef PG8_STAGE_B
#undef PG8_LDA
#undef PG8_LDB
#undef PG8_MMA
#undef PG8_WAIT_V
#undef PG8_WAIT_L
#undef PG8_BAR
#undef PG8_SCHED
#undef PG8_AOFFS
}

#define PG8_FENCE asm volatile("" ::: "memory")
#define PG8_FOR_TILE(ai, m, bj) _Pragma("unroll") for (int ai = 0; ai < 2; ++ai) _Pragma("unroll") for (int m = 0; m < 4; ++m) _Pragma("unroll") for (int bj = 0; bj < 2; ++bj)
__device__ __forceinline__ u32x4 pack8(const f32x4& v0, const f32x4& v1) { u32x4 w; w.x = cvt_pk_bf16(v0[0], v0[1]); w.y = cvt_pk_bf16(v0[2], v0[3]); w.z = cvt_pk_bf16(v1[0], v1[1]); w.w = cvt_pk_bf16(v1[2], v1[3]); return w; }
__device__ __forceinline__ float sigm(float x) { return 1.f / (1.f + __expf(-x)); }
struct EpiInproj {
    static constexpr bool PERM = true;
    unsigned char* ws; bf16_t* gates;
    __device__ __forceinline__ void operator()(const f32x4 (&acc)[2][2][4][2], const Unit& u, int wr, int wc, int fr, int fq) const {
        PG8_FOR_TILE(ai, m, bj) { PG8_FENCE;
            int row = u.pm * BM + ai * HALF + wr * 64 + m * 16 + fr; asm volatile("" : "+v"(row)); const int col = u.pn * BM + bj * HALF + wc * 32 + 8 * fq;
            const f32x4 v0 = acc[ai][bj][m][0], v1 = acc[ai][bj][m][1];
            if (col < C_KV) *(u32x4*)((bf16_t*)(ws + WS_Q) + (size_t)row * AW + col) = pack8(v0, v1);
            else if (col < C_QI) {
                *(u32x4*)((bf16_t*)(ws + WS_KVN) + (size_t)row * KVL + (col - C_KV)) = pack8(v0, v1);
                float ss = (v0[0] * v0[0] + v0[1] * v0[1]) + (v0[2] * v0[2] + v0[3] * v0[3]) + (v1[0] * v1[0] + v1[1] * v1[1]) + (v1[2] * v1[2] + v1[3] * v1[3]);
                ss += __shfl_xor(ss, 16); ss += __shfl_xor(ss, 32);
                if (fq == 0) atomicAdd((float*)(ws + WS_RSS) + row, ss);
            }
            else if (col < C_PS) {
                if (col < 1056) {
                    typedef _Float16 h8 __attribute__((ext_vector_type(8)));
                    h8 hv; hv[0] = (_Float16)v0[0]; hv[1] = (_Float16)v0[1]; hv[2] = (_Float16)v0[2]; hv[3] = (_Float16)v0[3]; hv[4] = (_Float16)v1[0]; hv[5] = (_Float16)v1[1]; hv[6] = (_Float16)v1[2]; hv[7] = (_Float16)v1[3];
                    _Float16* d = (col < 1024) ? (_Float16*)(ws + WS_QI) + (size_t)row * 256 + (col - C_QI) : (_Float16*)(ws + WS_KI) + (size_t)row * 32 + (col - 1024);
                    *(h8*)d = hv;
                } else { const float sc_ = 0.17677669529663687f * 0.35355339059327373f; float* d = (float*)(ws + WS_WI) + (size_t)row * 8; *(f32x4*)d = v0 * sc_; *(f32x4*)(d + 4) = v1 * sc_; }
            }
            else if (col < C_GA) *(u32x4*)((bf16_t*)(ws + WS_PS) + (size_t)row * SHW + (col - C_PS)) = pack8(v0, v1);
            else if (col < INW) {
                f32x4 s0, s1;
#pragma unroll
                for (int e = 0; e < 4; ++e) { s0[e] = sigm(v0[e]); s1[e] = sigm(v1[e]); }
                bf16_t* d = (col < C_GR) ? gates + (size_t)row * DM + (col - C_GA) : gates + (size_t)NT * DM + (size_t)row * DM + (col - C_GR);
                *(u32x4*)d = pack8(s0, s1);
            }
        }
    }
};
struct EpiKV {
    static constexpr bool PERM = true;
    unsigned char* ws;
    __device__ __forceinline__ void operator()(const f32x4 (&acc)[2][2][4][2], const Unit& u, int wr, int wc, int fr, int fq) const {
        PG8_FOR_TILE(ai, m, bj) { PG8_FENCE;
            int row = u.pm * BM + ai * HALF + wr * 64 + m * 16 + fr; asm volatile("" : "+v"(row)); const int col = u.pn * BM + bj * HALF + wc * 32 + 8 * fq;
            const float rstd = rsqrtf(((const float*)(ws + WS_RSS))[row] * (1.f / KVL) + NORM_EPS);
            if (col < AW) *(u32x4*)((bf16_t*)(ws + WS_K) + (size_t)row * AW + col) = pack8(acc[ai][bj][m][0] * rstd, acc[ai][bj][m][1] * rstd);
            else {
                bf16_t* d = (bf16_t*)(ws + WS_V) + ((size_t)(row / SEQ) * 512 + (col - AW)) * SEQ + (row % SEQ);
#pragma unroll
                for (int e = 0; e < 4; ++e) { d[(size_t)e * SEQ] = f2bf(acc[ai][bj][m][0][e] * rstd); d[(size_t)(4 + e) * SEQ] = f2bf(acc[ai][bj][m][1][e] * rstd); }
            }
        }
    }
};
struct EpiMerge {
    static constexpr bool PERM = true;
    bf16_t* merged; const bf16_t* gates;
    __device__ __forceinline__ void operator()(const f32x4 (&acc)[2][2][4][2], const Unit& u, int wr, int wc, int fr, int fq) const {
        const bf16_t* gate = gates + (size_t)u.aux * NT * DM;
        PG8_FOR_TILE(ai, m, bj) { PG8_FENCE;
            int row = u.pm * BM + ai * HALF + wr * 64 + m * 16 + fr; asm volatile("" : "+v"(row)); const int col = u.pn * BM + bj * HALF + wc * 32 + 8 * fq;
            const u32x4 gw = *(const u32x4*)(gate + (size_t)row * DM + col);
            f32x4 v0 = acc[ai][bj][m][0], v1 = acc[ai][bj][m][1];
            v0[0] *= __uint_as_float(gw.x << 16); v0[1] *= __uint_as_float(gw.x & 0xffff0000u); v0[2] *= __uint_as_float(gw.y << 16); v0[3] *= __uint_as_float(gw.y & 0xffff0000u);
            v1[0] *= __uint_as_float(gw.z << 16); v1[1] *= __uint_as_float(gw.z & 0xffff0000u); v1[2] *= __uint_as_float(gw.w << 16); v1[3] *= __uint_as_float(gw.w & 0xffff0000u);
            u32x4* d = (u32x4*)(merged + (size_t)row * DM + col);
            if (u.aux) { const u32x4 pw = *d;
                v0[0] += __uint_as_float(pw.x << 16); v0[1] += __uint_as_float(pw.x & 0xffff0000u); v0[2] += __uint_as_float(pw.y << 16); v0[3] += __uint_as_float(pw.y & 0xffff0000u);
                v1[0] += __uint_as_float(pw.z << 16); v1[1] += __uint_as_float(pw.z & 0xffff0000u); v1[2] += __uint_as_float(pw.w << 16); v1[3] += __uint_as_float(pw.w & 0xffff0000u); }
            *d = pack8(v0, v1);
        }
    }
};
struct EpiOut {
    static constexpr bool PERM = false;
    const float* x; const float* mod; float* out;
    __device__ __forceinline__ void operator()(const f32x4 (&acc)[2][2][4][2], const Unit& u, int wr, int wc, int fr, int fq) const {
        PG8_FOR_TILE(ai, m, bj) { PG8_FENCE;
            int row = u.pm * BM + ai * HALF + wr * 64 + m * 16 + fr; asm volatile("" : "+v"(row)); const float* gt = mod + (row / SEQ) * 6 * DM + 2 * DM;
#pragma unroll
            for (int n = 0; n < 2; ++n) { const int col = u.pn * BM + bj * HALF + wc * 32 + 16 * n + 4 * fq;
                const f32x4 xv = *(const f32x4*)(x + (size_t)row * DM + col), gv = *(const f32x4*)(gt + col);
                *(f32x4*)(out + (size_t)row * DM + col) = xv + gv * acc[ai][bj][m][n]; }
        }
    }
};
struct EpiMoe1 {
    static constexpr bool PERM = true;
    bf16_t* hid; const float* lw;
    __device__ __forceinline__ void operator()(const f32x4 (&acc)[2][2][4][2], const Unit& u, int wr, int wc, int fr, int fq) const {
#pragma unroll
        for (int ai = 0; ai < 2; ++ai)
#pragma unroll
            for (int m = 0; m < 4; ++m) {
                const int tr = ai * HALF + wr * 64 + m * 16 + fr; PG8_FENCE;
                if (tr < u.aux) {
                    const float w = lw[u.arow + tr]; f32x4 h0, h1;
#pragma unroll
                    for (int e = 0; e < 4; ++e) { const float g0 = acc[ai][0][m][0][e], g1 = acc[ai][0][m][1][e];
                        h0[e] = w * (g0 / (1.f + __expf(-g0))) * acc[ai][1][m][0][e]; h1[e] = w * (g1 / (1.f + __expf(-g1))) * acc[ai][1][m][1][e]; }
                    *(u32x4*)(hid + (size_t)(u.arow + tr) * DE + u.pn * HALF + wc * 32 + 8 * fq) = pack8(h0, h1);
                }
            }
    }
};
struct EpiMoe2 {
    static constexpr bool PERM = false;
    const int* ltok; const float* mod; float* out;
    __device__ __forceinline__ void operator()(const f32x4 (&acc)[2][2][4][2], const Unit& u, int wr, int wc, int fr, int fq) const {
#pragma unroll
        for (int ai = 0; ai < 2; ++ai)
#pragma unroll
            for (int m = 0; m < 4; ++m) {
                const int tr = ai * HALF + wr * 64 + m * 16 + fr; PG8_FENCE;
                if (tr < u.aux) {
                    const int tok = ltok[u.arow + tr]; const float* gt = mod + (tok / SEQ) * 6 * DM + 5 * DM; float* orow = out + (size_t)tok * DM;
#pragma unroll
                    for (int bj = 0; bj < 2; ++bj)
#pragma unroll
                        for (int n = 0; n < 2; ++n) { const int col = u.pn * BM + bj * HALF + wc * 32 + 16 * n + 4 * fq;
                            const f32x4 gv = *(const f32x4*)(gt + col); f32x4* d = (f32x4*)(orow + col); *d = *d + gv * acc[ai][bj][m][n]; }
                }
            }
    }
};
}

__device__ __forceinline__ unsigned pk2(float lo, float hi) { return (unsigned)f2bf(lo) | ((unsigned)f2bf(hi) << 16); }
__device__ __forceinline__ void transpose_item(const float* W, int K, int N, bf16_t* WT, size_t drow0, int k0, int n0, float* scr, int lane, int Ksrc = 1 << 30, const float* kscale = nullptr) {
#pragma unroll 8
    for (int i = 0; i < 32; ++i) { const int kk = 2 * i + (lane >> 5), n = n0 + (lane & 31); float v_ = (n < N && k0 + kk < Ksrc) ? W[(size_t)(k0 + kk) * N + n] : 0.f; if (kscale) v_ *= kscale[k0 + kk]; scr[kk * 33 + (lane & 31)] = v_; }
    asm volatile("s_waitcnt lgkmcnt(0)" ::: "memory");
    const int c = lane & 7;
#pragma unroll
    for (int j = 0; j < 4; ++j) { const int n = (lane >> 3) + 8 * j; const float* s_ = scr + (8 * c) * 33 + n;
        uint4 o; o.x = pk2(s_[0 * 33], s_[1 * 33]); o.y = pk2(s_[2 * 33], s_[3 * 33]); o.z = pk2(s_[4 * 33], s_[5 * 33]); o.w = pk2(s_[6 * 33], s_[7 * 33]);
        *(uint4*)(WT + (drow0 + n) * K + k0 + 8 * c) = o; }
    asm volatile("s_waitcnt lgkmcnt(0)" ::: "memory");
}
__device__ void ph_convert_mixer_weights(const P& p, float* lds) {
    const int lane = otid() & 63, wv = otid() >> 6;
    float* scr = lds + wv * (64 * 33);
    const int gw = blockIdx.x * (NTHR / 64) + wv, nw = gridDim.x * (NTHR / 64);
    struct M { const float* W; int K, N, Npad; size_t dst; const float* ks; };
    const M ms[5] = { {p.in[5], DM, INW, 5120, WS_WIN, nullptr}, {p.in[7], KVL, 2 * AW, 2 * AW, WS_WKV, p.in[6]}, {p.in[21], AW, DM, DM, WS_WBA, nullptr}, {p.in[22], RW, DM, DM, WS_WBR, nullptr}, {p.in[23], DM, DM, DM, WS_WOUT, nullptr} };
    int base = 0;
#pragma unroll
    for (int q = 0; q < 5; ++q) {
        const int nkb = ms[q].K / 64, nnb = ms[q].Npad / 32, nitems = nkb * nnb;
        for (int it = gw; it < base + nitems; it += nw) { if (it < base) continue; const int r = it - base; const int kb = r / nnb, nb = r % nnb;
            transpose_item(ms[q].W, ms[q].K, ms[q].N, (bf16_t*)(p.ws + ms[q].dst), (size_t)nb * 32, kb * 64, nb * 32, scr, lane, 1 << 30, ms[q].ks); }
        base += nitems;
    }
}
__device__ void ph_convert_lora_weights(const P& p, float* lds) {
    const int lane = otid() & 63, wv = otid() >> 6;
    float* scr = lds + wv * (64 * 33);
    const int gw = blockIdx.x * (NTHR / 64) + wv, nw = gridDim.x * (NTHR / 64);
    for (int it = gw; it < 16 + 16 + 48; it += nw) {
        if (it < 16) transpose_item(p.in[12], 64, RW, (bf16_t*)(p.ws + WS_LW2T), (size_t)it * 32, 0, it * 32, scr, lane);
        else if (it < 32) transpose_item(p.in[14], 64, RW, (bf16_t*)(p.ws + WS_LA2T), (size_t)(it - 16) * 32, 0, (it - 16) * 32, scr, lane);
        else { const int r = it - 32, kb = r >> 4, nb = r & 15; transpose_item(p.in[15], 192, RW, (bf16_t*)(p.ws + WS_LG2T), (size_t)nb * 32, kb * 64, nb * 32, scr, lane, 160); }
    }
}
__device__ void ph_convert_expert_weights(const P& p, float* lds) {
    const int lane = otid() & 63, wv = otid() >> 6;
    float* scr = lds + wv * (64 * 33);
    const int gw = blockIdx.x * (NTHR / 64) + wv, nw = gridDim.x * (NTHR / 64);
    for (int it = gw; it < NE * 2 * 256; it += nw) { const int e = it >> 9, which = (it >> 8) & 1, r = it & 255, kb = r >> 4, nb = r & 15, n0 = nb * 32;
        transpose_item(p.in[28 + which] + (size_t)e * DM * DE, DM, DE, (bf16_t*)(p.ws + WS_WGU), (size_t)e * 1024 + (n0 >> 7) * 256 + which * 128 + (n0 & 127), kb * 64, n0, scr, lane); }
    for (int it = gw; it < NE * 256; it += nw) { const int e = it >> 8, r = it & 255, kb = r >> 5, nb = r & 31;
        transpose_item(p.in[30] + (size_t)e * DE * DM, DE, DM, (bf16_t*)(p.ws + WS_WDN), (size_t)e * 1024 + nb * 32, kb * 64, nb * 32, scr, lane); }
}

__device__ void ph_headnorm(bf16_t* X, const float* g) {
    const int lane = otid() & 63, wv = otid() >> 6;
    const int gw = blockIdx.x * (NTHR / 64) + wv, nw = gridDim.x * (NTHR / 64);
    for (int m = gw; m < NT; m += nw) {
        uint4 raw = *(const uint4*)(X + (size_t)m * AW + lane * 8);
        float v[8] = {bf2f(raw.x & 0xffff), bf2f(raw.x >> 16), bf2f(raw.y & 0xffff), bf2f(raw.y >> 16), bf2f(raw.z & 0xffff), bf2f(raw.z >> 16), bf2f(raw.w & 0xffff), bf2f(raw.w >> 16)};
        float ss = 0.f;
#pragma unroll
        for (int i = 0; i < 8; ++i) ss += v[i] * v[i];
        ss += __shfl_xor(ss, 1); ss += __shfl_xor(ss, 2); ss += __shfl_xor(ss, 4);
        const float rstd = rsqrtf(ss * (1.f / 64.f) + NORM_EPS);
        const int d0 = (lane & 7) * 8;
        unsigned o[4];
#pragma unroll
        for (int i = 0; i < 4; ++i) o[i] = (unsigned)f2bf(v[2 * i] * rstd * g[d0 + 2 * i]) | ((unsigned)f2bf(v[2 * i + 1] * rstd * g[d0 + 2 * i + 1]) << 16);
        *(uint4*)(X + (size_t)m * AW + lane * 8) = make_uint4(o[0], o[1], o[2], o[3]);
    }
}
__device__ void ph_kvnorm(bf16_t* X, const float* g) {
    const int lane = otid() & 63, wv = otid() >> 6;
    const int gw = blockIdx.x * (NTHR / 64) + wv, nw = gridDim.x * (NTHR / 64);
    for (int m = gw; m < NT; m += nw) {
        uint2 raw = *(const uint2*)(X + (size_t)m * KVL + lane * 4);
        float v[4] = {bf2f(raw.x & 0xffff), bf2f(raw.x >> 16), bf2f(raw.y & 0xffff), bf2f(raw.y >> 16)};
        float ss = wave_sum(v[0] * v[0] + v[1] * v[1] + v[2] * v[2] + v[3] * v[3]);
        const float rstd = rsqrtf(ss * (1.f / 256.f) + NORM_EPS);
        uint2 o; o.x = (unsigned)f2bf(v[0] * rstd * g[lane * 4]) | ((unsigned)f2bf(v[1] * rstd * g[lane * 4 + 1]) << 16);
        o.y = (unsigned)f2bf(v[2] * rstd * g[lane * 4 + 2]) | ((unsigned)f2bf(v[3] * rstd * g[lane * 4 + 3]) << 16);
        *(uint2*)(X + (size_t)m * KVL + lane * 4) = o;
    }
}

typedef _Float16 half8_t __attribute__((ext_vector_type(8)));
typedef float f32x16_t __attribute__((ext_vector_type(16)));
__device__ __forceinline__ unsigned f2key(float f) { unsigned u = __float_as_uint(f); return (u & 0x80000000u) ? ~u : (u | 0x80000000u); }
__device__ void ph_dsa_select(const P& p, float* ldsf) {
    const _Float16* QI = (const _Float16*)(p.ws + WS_QI); const _Float16* KI = (const _Float16*)(p.ws + WS_KI); const float* WI = (const float*)(p.ws + WS_WI);
    unsigned* MASK32 = (unsigned*)(p.ws + WS_MASK);
    unsigned* hist = (unsigned*)ldsf;
    uint2* cand = (uint2*)(hist + 8 * 2048);
    unsigned* maskl = (unsigned*)(cand + 8 * 1024);
    unsigned* h2 = hist;
    int* misc = (int*)(maskl + 8 * 256);
    constexpr int CCAP = 1024;
    const int tid = otid(), lane = tid & 63, wv = tid >> 6, hh = lane >> 5, r32 = lane & 31;
    const int nrnd = (NT / 8 + (int)gridDim.x - 1) / (int)gridDim.x;
#pragma unroll 1
    for (int rnd = 0; rnd < nrnd; ++rnd) {
        const int item = __builtin_amdgcn_readfirstlane(rnd * (int)gridDim.x + ((rnd & 1) ? (int)(gridDim.x - 1 - blockIdx.x) : (int)blockIdx.x));
        if (item >= NT / 8) continue;
        const int tq0 = item * 8, b = tq0 / SEQ, t0 = tq0 % SEQ;
        const int nwords = ((t0 >> 8) + 1) * 8;
        __syncthreads();
        if (t0 + 7 < TOPK) {
            for (int e = tid; e < 8 * nwords; e += NTHR) { const int row = e / nwords, w = e % nwords; const int tr_ = t0 + row; const int lo = 32 * w;
                const unsigned bits = (tr_ >= lo + 31) ? 0xffffffffu : ((tr_ < lo) ? 0u : ((2u << (tr_ - lo)) - 1u));
                MASK32[(size_t)(tq0 + row) * 256 + w] = bits; }
            continue;
        }
        for (int e = tid; e < 8 * 2048; e += NTHR) hist[e] = 0u;
        for (int e = tid; e < 8 * 256; e += NTHR) maskl[e] = 0u;
        if (tid < 64) misc[tid] = 0;
        half8_t a0[2], a1[2]; float w[2][4][4];
#pragma unroll
        for (int rg = 0; rg < 2; ++rg) { const int tl_a = r32 >> 3, h_a = r32 & 7; const _Float16* qp = QI + (size_t)(tq0 + 4 * rg + tl_a) * 256 + h_a * 32 + 8 * hh;
            a0[rg] = *(const half8_t*)qp; a1[rg] = *(const half8_t*)(qp + 16);
#pragma unroll
            for (int tl = 0; tl < 4; ++tl) { const float4 wv4 = *(const float4*)(WI + (size_t)(tq0 + 4 * rg + tl) * 8 + 4 * hh); w[rg][tl][0] = wv4.x; w[rg][tl][1] = wv4.y; w[rg][tl][2] = wv4.z; w[rg][tl][3] = wv4.w; } }
        const int ntile = (t0 + 7) / 32 + 1;
        __syncthreads();
        int thr_bin[8];
#pragma unroll 1
        for (int pass = 0; pass < 2; ++pass) {
            if (pass == 1) {
#pragma unroll
                for (int r = 0; r < 8; ++r) thr_bin[r] = misc[r * 8];
            }
            half8_t kb0[4], kb1[4], nk0[4], nk1[4];
#pragma unroll
            for (int q = 0; q < 4; ++q) { const int tl_ = min(4 * wv + q, ntile - 1); const _Float16* kp = KI + (size_t)(b * SEQ + tl_ * 32 + r32) * 32 + 8 * hh; nk0[q] = *(const half8_t*)kp; nk1[q] = *(const half8_t*)(kp + 16); }
            for (int tbase = 4 * wv; tbase < ntile; tbase += 32) {
#pragma unroll
                for (int q = 0; q < 4; ++q) { kb0[q] = nk0[q]; kb1[q] = nk1[q]; }
                if (tbase + 32 < ntile) {
#pragma unroll
                    for (int q = 0; q < 4; ++q) { const int tl_ = min(tbase + 32 + q, ntile - 1); const _Float16* kp = KI + (size_t)(b * SEQ + tl_ * 32 + r32) * 32 + 8 * hh; nk0[q] = *(const half8_t*)kp; nk1[q] = *(const half8_t*)(kp + 16); }
                }
#pragma unroll
                for (int q = 0; q < 4; ++q) {
                const int tile = tbase + q;
                if (tile < ntile) {
                const half8_t b0 = kb0[q], b1 = kb1[q];
                const int key = tile * 32 + r32;
#pragma unroll
                for (int rg = 0; rg < 2; ++rg) {
                    f32x16_t c;
#pragma unroll
                    for (int i = 0; i < 16; ++i) c[i] = 0.f;
                    c = __builtin_amdgcn_mfma_f32_32x32x16_f16(a0[rg], b0, c, 0, 0, 0);
                    c = __builtin_amdgcn_mfma_f32_32x32x16_f16(a1[rg], b1, c, 0, 0, 0);
                    float x[4];
#pragma unroll
                    for (int tl = 0; tl < 4; ++tl) { x[tl] = 0.f;
#pragma unroll
                        for (int e = 0; e < 4; ++e) x[tl] = __builtin_fmaf(w[rg][tl][e], __int_as_float(max(__float_as_int(c[4 * tl + e]), 0)), x[tl]); }
                    const auto s01 = __builtin_amdgcn_permlane32_swap(__float_as_uint(x[0]), __float_as_uint(x[1]), false, false);
                    const auto s23 = __builtin_amdgcn_permlane32_swap(__float_as_uint(x[2]), __float_as_uint(x[3]), false, false);
                    const unsigned k01 = f2key(__uint_as_float(s01[0]) + __uint_as_float(s01[1]));
                    const unsigned k23 = f2key(__uint_as_float(s23[0]) + __uint_as_float(s23[1]));
                    const int rowA = 4 * rg + hh, rowB = 4 * rg + 2 + hh;
                    const bool okA = key <= t0 + rowA, okB = key <= t0 + rowB;
                    if (pass == 0) {
                        atomicAdd(&hist[okA ? rowA * 2048 + (int)(k01 >> 21) : 8 * 2048 + 16384 + 2048 + 7], 1u << (16 * ((k01 >> 20) & 1u)));
                        atomicAdd(&hist[okB ? rowB * 2048 + (int)(k23 >> 21) : 8 * 2048 + 16384 + 2048 + 7], 1u << (16 * ((k23 >> 20) & 1u)));
                    } else {
                        const int tbA = hh ? thr_bin[4 * rg + 1] : thr_bin[4 * rg], tbB = hh ? thr_bin[4 * rg + 3] : thr_bin[4 * rg + 2];
                        const int binA = (int)(k01 >> 20), binB = (int)(k23 >> 20);
                        const unsigned long long mA = __ballot(okA && binA > tbA), mB = __ballot(okB && binB > tbB);
                        if (r32 == 0) { maskl[rowA * 256 + tile] = hh ? (unsigned)(mA >> 32) : (unsigned)mA; maskl[rowB * 256 + tile] = hh ? (unsigned)(mB >> 32) : (unsigned)mB; }
                        if (okA && binA == tbA) { const int pos = atomicAdd(&misc[rowA * 8 + 2], 1); if (pos < CCAP) cand[rowA * CCAP + pos] = make_uint2(k01, (unsigned)key); }
                        if (okB && binB == tbB) { const int pos = atomicAdd(&misc[rowB * 8 + 2], 1); if (pos < CCAP) cand[rowB * CCAP + pos] = make_uint2(k23, (unsigned)key); }
                    }
                }
                }
                }
            }
            __syncthreads();
            if (pass == 0) {
                const unsigned* hr = hist + wv * 2048 + 32 * lane; unsigned tot = 0;
#pragma unroll 8
                for (int i = 0; i < 32; ++i) { const unsigned v = hr[i]; tot += (v & 0xffffu) + (v >> 16); }
                unsigned suf = tot;
#pragma unroll
                for (int o = 1; o < 64; o <<= 1) { const unsigned oth = __shfl_down(suf, o); if (lane + o < 64) suf += oth; }
                unsigned above = suf - tot;
                if ((int)above < TOPK && TOPK <= (int)(above + tot)) {
                    int bsel = 0, need = 0;
                    for (int i = 31; i >= 0; --i) { const unsigned v = hr[i]; const unsigned chi = v >> 16, clo = v & 0xffffu;
                        if ((int)above < TOPK && TOPK <= (int)(above + chi)) { bsel = 64 * lane + 2 * i + 1; need = TOPK - (int)above; above = 0x7fffffffu; }
                        else if ((int)above < TOPK) above += chi;
                        if ((int)above < TOPK && TOPK <= (int)(above + clo)) { bsel = 64 * lane + 2 * i; need = TOPK - (int)above; above = 0x7fffffffu; }
                        else if ((int)above < TOPK) above += clo; }
                    misc[wv * 8] = bsel; misc[wv * 8 + 1] = need; }
                __syncthreads();
            }
        }
        {
            const int row = wv, need0 = misc[row * 8 + 1]; const int cn = min(misc[row * 8 + 2], CCAP);
            const uint2* cr = cand + row * CCAP; unsigned* hrow = h2 + row * 256;
            unsigned prefix = 0; int remaining = need0, cnt_eq = cn;
#pragma unroll 1
            for (int pass = 0; pass < 3; ++pass) {
                const int shift = (pass == 0) ? 12 : ((pass == 1) ? 4 : 0), nb = (pass == 2) ? 4 : 8;
                for (int i = lane; i < 256; i += 64) hrow[i] = 0u;
                __builtin_amdgcn_wave_barrier(); asm volatile("s_waitcnt lgkmcnt(0)" ::: "memory");
                for (int i = lane; i < cn; i += 64) { const unsigned k = cr[i].x & 0xfffffu; if (pass == 0 || (k >> (shift + nb)) == (prefix >> (shift + nb))) atomicAdd(&hrow[(k >> shift) & ((1u << nb) - 1u)], 1u); }
                __builtin_amdgcn_wave_barrier(); asm volatile("s_waitcnt lgkmcnt(0)" ::: "memory");
                const unsigned h0 = hrow[4 * lane], h1 = hrow[4 * lane + 1], h2_ = hrow[4 * lane + 2], h3 = hrow[4 * lane + 3];
                unsigned suf = h0 + h1 + h2_ + h3;
#pragma unroll
                for (int o = 1; o < 64; o <<= 1) { const unsigned oth = __shfl_down(suf, o); if (lane + o < 64) suf += oth; }
                const unsigned above3 = suf - (h0 + h1 + h2_ + h3);
                const unsigned ab[4] = {above3 + h3 + h2_ + h1, above3 + h3 + h2_, above3 + h3, above3}; const unsigned hv[4] = {h0, h1, h2_, h3};
                int selbin = -1, newrem = 0, neweq = 0;
#pragma unroll
                for (int q = 0; q < 4; ++q) if ((int)ab[q] < remaining && remaining <= (int)(ab[q] + hv[q])) { selbin = 4 * lane + q; newrem = remaining - (int)ab[q]; neweq = (int)hv[q]; }
                const unsigned long long has = __ballot(selbin >= 0); const int src = __ffsll((long long)has) - 1;
                selbin = __shfl(selbin, src); newrem = __shfl(newrem, src); neweq = __shfl(neweq, src);
                prefix |= ((unsigned)selbin) << shift; remaining = newrem; cnt_eq = neweq;
            }
            for (int i0 = 0; i0 < cn; i0 += 64) { const int i = i0 + lane; bool sel = false;
                if (i < cn) { const uint2 ce = cr[i]; const unsigned k = ce.x & 0xfffffu;
                    if (k > prefix) sel = true;
                    else if (k == prefix) { if (cnt_eq == remaining) sel = true; else { int rank = 0; for (int j = 0; j < cn; ++j) { const uint2 cj = cr[j]; rank += ((cj.x & 0xfffffu) == prefix && cj.y < ce.y) ? 1 : 0; } sel = rank < remaining; } }
                    if (sel) atomicOr(&maskl[row * 256 + (ce.y >> 5)], 1u << (ce.y & 31)); } }
        }
        __syncthreads();
        for (int e = tid; e < 8 * nwords; e += NTHR) { const int row = e / nwords, w2 = e % nwords; MASK32[(size_t)(tq0 + row) * 256 + w2] = maskl[row * 256 + w2]; }
    }
}

__device__ void knorm_tile(const P& p, int pm, int pn) {
    bf16_t* Kg = (bf16_t*)(p.ws + WS_K); const float* kg = p.in[9];
    const int tid = otid();
    for (int pr = tid; pr < 1024; pr += NTHR) {
        const int row = pm * 256 + (pr >> 2), head = pn * 4 + (pr & 3);
        uint4* ptr = (uint4*)(Kg + (size_t)row * AW + head * 64);
        uint4 v[8]; float ss = 0.f;
#pragma unroll
        for (int c = 0; c < 8; ++c) { v[c] = ptr[c]; const unsigned w[4] = {v[c].x, v[c].y, v[c].z, v[c].w};
#pragma unroll
            for (int e = 0; e < 4; ++e) { const float a = __uint_as_float(w[e] << 16), b2 = __uint_as_float(w[e] & 0xffff0000u); ss += a * a + b2 * b2; } }
        const float rstd = rsqrtf(ss * (1.f / 64.f) + NORM_EPS);
#pragma unroll
        for (int c = 0; c < 8; ++c) { const unsigned w[4] = {v[c].x, v[c].y, v[c].z, v[c].w}; unsigned o[4];
            const float4 g0 = *(const float4*)(kg + 8 * c), g1 = *(const float4*)(kg + 8 * c + 4); const float gv[8] = {g0.x, g0.y, g0.z, g0.w, g1.x, g1.y, g1.z, g1.w};
#pragma unroll
            for (int e = 0; e < 4; ++e) o[e] = pk2(__uint_as_float(w[e] << 16) * rstd * gv[2 * e], __uint_as_float(w[e] & 0xffff0000u) * rstd * gv[2 * e + 1]);
            ptr[c] = make_uint4(o[0], o[1], o[2], o[3]); }
    }
}
typedef unsigned u32x4_t __attribute__((ext_vector_type(4)));
typedef __bf16 bf2_t __attribute__((ext_vector_type(2)));
typedef float f2_t __attribute__((ext_vector_type(2)));
__device__ __forceinline__ unsigned pk_bf16(float lo, float hi) { const f2_t v = {lo, hi}; return __builtin_bit_cast(unsigned, __builtin_convertvector(v, bf2_t)); }
__device__ __forceinline__ bf16x8_t pack_step16(const f32x16_t& x, int s2) {
    u32x4_t pk;
    if (s2 == 0) { pk[0] = pk_bf16(x[0], x[1]); pk[1] = pk_bf16(x[2], x[3]); pk[2] = pk_bf16(x[4], x[5]); pk[3] = pk_bf16(x[6], x[7]); }
    else { pk[0] = pk_bf16(x[8], x[9]); pk[1] = pk_bf16(x[10], x[11]); pk[2] = pk_bf16(x[12], x[13]); pk[3] = pk_bf16(x[14], x[15]); }
    return __builtin_bit_cast(bf16x8_t, pk);
}
__device__ __forceinline__ float xhalf_max(float x) { const auto t = __builtin_amdgcn_permlane32_swap(__float_as_uint(x), __float_as_uint(x), false, false); return fmaxf(__uint_as_float(t[0]), __uint_as_float(t[1])); }
__device__ __forceinline__ float xhalf_sum(float x) { const auto t = __builtin_amdgcn_permlane32_swap(__float_as_uint(x), __float_as_uint(x), false, false); return __uint_as_float(t[0]) + __uint_as_float(t[1]); }
__device__ __forceinline__ short bf16_of_int(int v) { return (short)(__float_as_uint((float)v) >> 16); }
#define MFMA32(a, b, c) __builtin_amdgcn_mfma_f32_32x32x16_bf16((a), (b), (c), 0, 0, 0)
__device__ void ph_dsa_attn(const P& p, float* ldsf) {
    const unsigned long long* MASK = (const unsigned long long*)(p.ws + WS_MASK);
    const bf16_t* Q = (const bf16_t*)(p.ws + WS_Q); const bf16_t* Kg = (const bf16_t*)(p.ws + WS_K); const bf16_t* VT = (const bf16_t*)(p.ws + WS_V);
    bf16_t* O = (bf16_t*)(p.ws + WS_OATT);
    bf16_t* L = (bf16_t*)ldsf;
    const int tid = otid(), lane = tid & 63, wv = tid >> 6, hh = lane >> 5, r32 = lane & 31;
    const float CS = 0.125f * 1.4426950408889634f;
    const float NEG = -1e30f;
    const int skey = tid >> 3, sch = (tid & 7) * 8;
    const float* qg = p.in[8];
    int* qhead = (int*)(p.ws + WS_CTL) + CT_Q; int* bcast = (int*)(L + 4 * SLOT);
    for (int tr_ = 0; tr_ < 8; ++tr_) {
        const int grp = (blockIdx.x + tr_) & 7;
        for (;;) {
            __syncthreads();
            if (tid == 0) *bcast = atomicAdd(qhead + grp, 1);
            __syncthreads();
            const int kq = *bcast;
            if (kq >= 64) break;
            const int bh = grp + 8 * (kq & 1), qb = 31 - (kq >> 1), b = bh >> 3, h = bh & 7;
            const bf16_t* Kbase = Kg + (size_t)b * SEQ * AW + h * 64; const bf16_t* Vbase = VT + (size_t)bh * 64 * SEQ;
            {
            const int q0 = qb * 256 + wv * 32, q = q0 + r32, ntile = 4 * (qb + 1);
            const size_t qrow = (size_t)b * SEQ + q;
            bf16x8_t bq[5];
#pragma unroll
            for (int s2 = 0; s2 < 4; ++s2) bq[s2] = *(const bf16x8_t*)(Q + qrow * AW + h * 64 + 16 * s2 + 8 * hh);
            {
                float ss = 0.f;
#pragma unroll
                for (int s2 = 0; s2 < 4; ++s2)
#pragma unroll
                    for (int j = 0; j < 8; ++j) { const float v = bf2f((bf16_t)bq[s2][j]); ss += v * v; }
                ss = xhalf_sum(ss);
                const float rstd = rsqrtf(ss * (1.f / 64.f) + NORM_EPS);
#pragma unroll
                for (int s2 = 0; s2 < 4; ++s2) { const float4 g0 = *(const float4*)(qg + 16 * s2 + 8 * hh), g1 = *(const float4*)(qg + 16 * s2 + 8 * hh + 4); const float gv[8] = {g0.x, g0.y, g0.z, g0.w, g1.x, g1.y, g1.z, g1.w};
                    u32x4_t w;
#pragma unroll
                    for (int j2 = 0; j2 < 4; ++j2) w[j2] = pk_bf16(bf2f((bf16_t)bq[s2][2 * j2]) * rstd * gv[2 * j2], bf2f((bf16_t)bq[s2][2 * j2 + 1]) * rstd * gv[2 * j2 + 1]);
                    bq[s2] = __builtin_bit_cast(bf16x8_t, w); }
            }
#pragma unroll
            for (int j = 0; j < 8; ++j) bq[4][j] = 0;
            if (hh == 0) { bq[4][0] = bf16_of_int(256 >> h); bq[4][1] = (short)(__float_as_uint(4.f / (float)(1 << h)) >> 16); }
            f32x16_t o0, o1;
#pragma unroll
            for (int i = 0; i < 16; ++i) { o0[i] = 0.f; o1[i] = 0.f; }
            float m_run = NEG, l_run = 0.f;
            __syncthreads();
            { const uint4 kr = *(const uint4*)(Kbase + (size_t)skey * AW + sch), vr = *(const uint4*)(Vbase + (size_t)skey * SEQ + sch);
              *(uint4*)(L + skey * LP + sch) = kr; *(uint4*)(L + 2 * SLOT + skey * LP + sch) = vr; }
            unsigned long long mw = MASK[qrow * 128];
            __syncthreads();
#pragma unroll 1
            for (int kt = 0; kt < ntile; ++kt) {
                const int buf = kt & 1; const bool more = kt + 1 < ntile;
                uint4 kr = make_uint4(0, 0, 0, 0), vr = make_uint4(0, 0, 0, 0); unsigned long long mwn = 0ull;
                if (more) { kr = *(const uint4*)(Kbase + (size_t)((kt + 1) * 64 + skey) * AW + sch); vr = *(const uint4*)(Vbase + (size_t)skey * SEQ + (kt + 1) * 64 + sch); mwn = MASK[qrow * 128 + kt + 1]; }
                if (kt * 64 <= q0 + 31) {
                    const bf16_t* Kl = L + buf * SLOT; const bf16_t* Vl = L + (2 + buf) * SLOT;
                    f32x16_t p0, p1;
#pragma unroll
                    for (int i = 0; i < 16; ++i) { p0[i] = 0.f; p1[i] = 0.f; }
#pragma unroll
                    for (int s2 = 0; s2 < 4; ++s2) {
                        const bf16x8_t a0 = *(const bf16x8_t*)(Kl + r32 * LP + 16 * s2 + 8 * hh), a1 = *(const bf16x8_t*)(Kl + (32 + r32) * LP + 16 * s2 + 8 * hh);
                        p0 = MFMA32(a0, bq[s2], p0); p1 = MFMA32(a1, bq[s2], p1);
                    }
                    { bf16x8_t g0, g1;
#pragma unroll
                      for (int j = 0; j < 8; ++j) { g0[j] = 0; g1[j] = 0; }
                      if (hh == 0) { g0[0] = bf16_of_int(kt); g0[1] = bf16_of_int(r32); g1[0] = g0[0]; g1[1] = bf16_of_int(32 + r32); }
                      p0 = MFMA32(g0, bq[4], p0); p1 = MFMA32(g1, bq[4], p1); }
                    const unsigned wl = (unsigned)mw >> (4 * hh), wh = (unsigned)(mw >> 32) >> (4 * hh);
                    float mx = NEG;
#pragma unroll
                    for (int i = 0; i < 16; ++i) { const int bp = (i & 3) + 8 * (i >> 2);
                        const int m0 = __builtin_amdgcn_sbfe((int)wl, bp, 1), m1 = __builtin_amdgcn_sbfe((int)wh, bp, 1);
                        const float a_ = __uint_as_float((__float_as_uint(p0[i]) & (unsigned)m0) | (__float_as_uint(NEG) & ~(unsigned)m0));
                        const float b_ = __uint_as_float((__float_as_uint(p1[i]) & (unsigned)m1) | (__float_as_uint(NEG) & ~(unsigned)m1));
                        p0[i] = a_; p1[i] = b_;
                        mx = __builtin_fmaxf(mx, __builtin_fmaxf(a_, b_)); }
                    mx = xhalf_max(mx);
                    const float m_new = fmaxf(m_run, mx);
                    const float alpha = __builtin_amdgcn_exp2f((m_run - m_new) * CS);
                    m_run = m_new;
                    const float mc = fmaxf(m_new, -1e20f) * CS;
                    float rs = 0.f;
#pragma unroll
                    for (int i = 0; i < 16; ++i) { p0[i] = __builtin_amdgcn_exp2f(p0[i] * CS - mc); p1[i] = __builtin_amdgcn_exp2f(p1[i] * CS - mc); rs += p0[i] + p1[i]; }
                    l_run = l_run * alpha + rs;
#pragma unroll
                    for (int i = 0; i < 16; ++i) { o0[i] *= alpha; o1[i] *= alpha; }
                    bf16x8_t pb[4];
                    pb[0] = pack_step16(p0, 0); pb[1] = pack_step16(p0, 1); pb[2] = pack_step16(p1, 0); pb[3] = pack_step16(p1, 1);
#pragma unroll
                    for (int ks = 0; ks < 4; ++ks) {
                        const int kofs = 32 * (ks >> 1) + 16 * (ks & 1) + 4 * hh;
                        typedef short s16x4_t __attribute__((ext_vector_type(4)));
                        const s16x4_t v00 = *(const s16x4_t*)(Vl + r32 * LP + kofs), v01 = *(const s16x4_t*)(Vl + r32 * LP + kofs + 8);
                        const s16x4_t v10 = *(const s16x4_t*)(Vl + (32 + r32) * LP + kofs), v11 = *(const s16x4_t*)(Vl + (32 + r32) * LP + kofs + 8);
                        bf16x8_t av0, av1;
#pragma unroll
                        for (int j = 0; j < 4; ++j) { av0[j] = v00[j]; av0[4 + j] = v01[j]; av1[j] = v10[j]; av1[4 + j] = v11[j]; }
                        o0 = MFMA32(av0, pb[ks], o0); o1 = MFMA32(av1, pb[ks], o1);
                    }
                }
                if (more) { *(uint4*)(L + (buf ^ 1) * SLOT + skey * LP + sch) = kr; *(uint4*)(L + (2 + (buf ^ 1)) * SLOT + skey * LP + sch) = vr; }
                mw = mwn;
                __syncthreads();
            }
            const float inv = 1.f / xhalf_sum(l_run);
            bf16_t* orow = O + qrow * AW + h * 64 + 4 * hh;
#pragma unroll
            for (int g = 0; g < 4; ++g) {
                uint2 w0, w1;
                w0.x = (unsigned)f2bf(o0[4 * g] * inv) | ((unsigned)f2bf(o0[4 * g + 1] * inv) << 16); w0.y = (unsigned)f2bf(o0[4 * g + 2] * inv) | ((unsigned)f2bf(o0[4 * g + 3] * inv) << 16);
                w1.x = (unsigned)f2bf(o1[4 * g] * inv) | ((unsigned)f2bf(o1[4 * g + 1] * inv) << 16); w1.y = (unsigned)f2bf(o1[4 * g + 2] * inv) | ((unsigned)f2bf(o1[4 * g + 3] * inv) << 16);
                *(uint2*)(orow + 8 * g) = w0; *(uint2*)(orow + 32 + 8 * g) = w1;
            }
            }
        }
    }
}

constexpr int AP = 328, RP = 1544;
__device__ __forceinline__ f32x4_t mm16(const bf16_t* X, int xrs, const bf16_t* Y, int ycs, int nks, f32x4_t acc, int lane) {
    const int r = lane & 15, q = lane >> 4;
    for (int s2 = 0; s2 < nks; ++s2) {
        const bf16x8_t a = *(const bf16x8_t*)(X + r * xrs + 32 * s2 + 8 * q), b = *(const bf16x8_t*)(Y + r * ycs + 32 * s2 + 8 * q);
        acc = __builtin_amdgcn_mfma_f32_16x16x32_bf16(a, b, acc, 0, 0, 0);
    }
    return acc;
}
__device__ void ph_rwkv_prep(const P& p, float* ldsf, int blk_first, int blk_end, int blk_step) {
    const bf16_t* PS = (const bf16_t*)(p.ws + WS_PS);
    const float* mu = p.in[10]; const float* w0 = p.in[11]; const float* a0 = p.in[13]; const float* k_k = p.in[16]; const float* k_a = p.in[17];
    const bf16_t* W2T = (const bf16_t*)(p.ws + WS_LW2T); const bf16_t* A2T = (const bf16_t*)(p.ws + WS_LA2T); const bf16_t* G2T = (const bf16_t*)(p.ws + WS_LG2T);
    bf16_t* R = (bf16_t*)(p.ws + WS_R); bf16_t* K2 = (bf16_t*)(p.ws + WS_K2); bf16_t* VV = (bf16_t*)(p.ws + WS_VV); bf16_t* KK = (bf16_t*)(p.ws + WS_KK); bf16_t* BB = (bf16_t*)(p.ws + WS_BB);
    bf16_t* G = (bf16_t*)(p.ws + WS_G); float* DD = (float*)(p.ws + WS_DD);
    bf16_t* Amix = (bf16_t*)ldsf; bf16_t* RKV = Amix + 32 * AP;
    const int tid = otid(), lane = tid & 63, wv = tid >> 6, l15 = lane & 15, q4 = lane >> 4;
    for (int blk = blk_first; blk < blk_end; blk += blk_step) {
        const int m0 = blk * 32;
        __syncthreads();
#pragma unroll 3
        for (int ch = tid; ch < 32 * 228; ch += NTHR) {
            const int tk = ch / 228, c8 = (ch % 228) * 8, m = m0 + tk;
            const uint4 cu = *(const uint4*)(PS + (size_t)m * SHW + c8);
            uint4 pv = make_uint4(0, 0, 0, 0); if (m % SEQ) pv = *(const uint4*)(PS + (size_t)(m - 1) * SHW + c8);
            const unsigned cw[4] = {cu.x, cu.y, cu.z, cu.w}, pw[4] = {pv.x, pv.y, pv.z, pv.w};
            const float4 mu0 = *(const float4*)(mu + c8), mu1 = *(const float4*)(mu + c8 + 4); const float muv[8] = {mu0.x, mu0.y, mu0.z, mu0.w, mu1.x, mu1.y, mu1.z, mu1.w};
            float mx[8];
#pragma unroll
            for (int e = 0; e < 8; ++e) { const float c_ = (e & 1) ? __uint_as_float(cw[e >> 1] & 0xffff0000u) : __uint_as_float(cw[e >> 1] << 16), p_ = (e & 1) ? __uint_as_float(pw[e >> 1] & 0xffff0000u) : __uint_as_float(pw[e >> 1] << 16);
                mx[e] = c_ + (p_ - c_) * muv[e]; }
            bf16_t* dst;
            if (c8 < 1536) dst = RKV + tk * RP + c8;
            else { const int col = c8 - 1536; dst = Amix + tk * AP + col;
#pragma unroll
                for (int e = 0; e < 8; ++e) mx[e] = (col < 64) ? tanhf(mx[e]) : ((col < 128) ? mx[e] : sigmoidf_(mx[e])); }
            *(uint4*)dst = make_uint4(pk2(mx[0], mx[1]), pk2(mx[2], mx[3]), pk2(mx[4], mx[5]), pk2(mx[6], mx[7]));
        }
        if (tid < 128) *(uint4*)(Amix + (tid >> 2) * AP + 288 + (tid & 3) * 8) = make_uint4(0, 0, 0, 0);
        __syncthreads();
        const int h = wv;
#pragma unroll 1
        for (int rt = 0; rt < 2; ++rt) {
            f32x4_t aw[4], aa[4], ag[4];
            {
                const f32x4_t z4 = {0.f, 0.f, 0.f, 0.f};
                const bf16_t* xr = Amix + (16 * rt + l15) * AP + 8 * q4;
#pragma unroll
                for (int ct = 0; ct < 4; ++ct) { const int cb = 64 * h + 16 * ct;
                    bf16x8_t fw[2], fa[2], fg[6];
                    { const bf16_t* yw = W2T + (size_t)(cb + l15) * 64 + 8 * q4; const bf16_t* ya = A2T + (size_t)(cb + l15) * 64 + 8 * q4; const bf16_t* yg = G2T + (size_t)(cb + l15) * 192 + 8 * q4;
#pragma unroll
                      for (int s2 = 0; s2 < 2; ++s2) { fw[s2] = *(const bf16x8_t*)(yw + 32 * s2); fa[s2] = *(const bf16x8_t*)(ya + 32 * s2); }
#pragma unroll
                      for (int s2 = 0; s2 < 6; ++s2) fg[s2] = *(const bf16x8_t*)(yg + 32 * s2); }
                    f32x4_t cw = z4, ca = z4, cg = z4;
#pragma unroll
                    for (int s2 = 0; s2 < 2; ++s2) { cw = __builtin_amdgcn_mfma_f32_16x16x32_bf16(fw[s2], *(const bf16x8_t*)(xr + 32 * s2), cw, 0, 0, 0); ca = __builtin_amdgcn_mfma_f32_16x16x32_bf16(fa[s2], *(const bf16x8_t*)(xr + 64 + 32 * s2), ca, 0, 0, 0); }
#pragma unroll
                    for (int s2 = 0; s2 < 6; ++s2) cg = __builtin_amdgcn_mfma_f32_16x16x32_bf16(fg[s2], *(const bf16x8_t*)(xr + 128 + 32 * s2), cg, 0, 0, 0);
                    aw[ct] = cw; aa[ct] = ca; ag[ct] = cg; }
            }
            const int tk = 16 * rt + l15;
            float ss = 0.f; float kkr[4][4];
#pragma unroll
            for (int ct = 0; ct < 4; ++ct) { const int c0 = 64 * h + 16 * ct + 4 * q4; const float4 kkc = *(const float4*)(k_k + c0);
                const uint2 kw = *(const uint2*)(RKV + tk * RP + 512 + c0);
                kkr[ct][0] = __uint_as_float(kw.x << 16) * kkc.x; kkr[ct][1] = __uint_as_float(kw.x & 0xffff0000u) * kkc.y; kkr[ct][2] = __uint_as_float(kw.y << 16) * kkc.z; kkr[ct][3] = __uint_as_float(kw.y & 0xffff0000u) * kkc.w;
#pragma unroll
                for (int e = 0; e < 4; ++e) ss += kkr[ct][e] * kkr[ct][e]; }
            ss += __shfl_xor(ss, 16); ss += __shfl_xor(ss, 32);
            const float rn = 1.f / fmaxf(sqrtf(ss), 1e-12f);
#pragma unroll
            for (int ct = 0; ct < 4; ++ct) { const int c0 = 64 * h + 16 * ct + 4 * q4;
                const float4 w0c = *(const float4*)(w0 + c0), a0c = *(const float4*)(a0 + c0), kac = *(const float4*)(k_a + c0);
                const float w0v[4] = {w0c.x, w0c.y, w0c.z, w0c.w}, a0v[4] = {a0c.x, a0c.y, a0c.z, a0c.w}, kav[4] = {kac.x, kac.y, kac.z, kac.w};
                const uint2 rw2 = *(const uint2*)(RKV + tk * RP + c0), kw2 = *(const uint2*)(RKV + tk * RP + 512 + c0), vw2 = *(const uint2*)(RKV + tk * RP + 1024 + c0);
                const float kf[4] = {__uint_as_float(kw2.x << 16), __uint_as_float(kw2.x & 0xffff0000u), __uint_as_float(kw2.y << 16), __uint_as_float(kw2.y & 0xffff0000u)};
                float k2v[4], kkv[4], bbv[4], ddv[4];
#pragma unroll
                for (int e = 0; e < 4; ++e) {
                    const float xw = -(w0v[e] + aw[ct][e]);
                    const float sp = fmaxf(xw, 0.f) + log1pf(__expf(-fabsf(xw)));
                    const float w = -sp - 0.5f;
                    const float a = sigmoidf_(a0v[e] + aa[ct][e]);
                    kkv[e] = kkr[ct][e] * rn; bbv[e] = kkv[e] * a; k2v[e] = kf[e] * (1.f + (a - 1.f) * kav[e]); ddv[e] = -__expf(w);
                }
                const size_t o = (size_t)(m0 + tk) * RW + c0;
                *(uint2*)(R + o) = rw2; *(uint2*)(VV + o) = vw2;
                *(uint2*)(K2 + o) = make_uint2(pk2(k2v[0], k2v[1]), pk2(k2v[2], k2v[3])); *(uint2*)(KK + o) = make_uint2(pk2(kkv[0], kkv[1]), pk2(kkv[2], kkv[3]));
                *(uint2*)(BB + o) = make_uint2(pk2(bbv[0], bbv[1]), pk2(bbv[2], bbv[3])); *(uint2*)(G + o) = make_uint2(pk2(ag[ct][0], ag[ct][1]), pk2(ag[ct][2], ag[ct][3]));
                *(float4*)(DD + o) = make_float4(ddv[0], ddv[1], ddv[2], ddv[3]);
            }
        }
    }
}

template <bool XC, bool YC>
__device__ __forceinline__ f32x4_t mm_tile(const bf16_t* X, int xrs, int xcs, const bf16_t* Y, int yrs, int ycs, int tr, int tc, f32x4_t acc, int lane) {
    const int r = lane & 15, q = lane >> 4;
#pragma unroll
    for (int s2 = 0; s2 < 2; ++s2) {
        bf16x8_t a, b;
        const bf16_t* xp = X + (16 * tr + r) * xrs + (32 * s2 + 8 * q) * xcs;
        if (XC) a = *(const bf16x8_t*)xp; else {
#pragma unroll
            for (int j = 0; j < 8; ++j) a[j] = (short)xp[j * xcs]; }
        const bf16_t* yp = Y + (32 * s2 + 8 * q) * yrs + (16 * tc + r) * ycs;
        if (YC) b = *(const bf16x8_t*)yp; else {
#pragma unroll
            for (int j = 0; j < 8; ++j) b[j] = (short)yp[j * yrs]; }
        acc = __builtin_amdgcn_mfma_f32_16x16x32_bf16(a, b, acc, 0, 0, 0);
    }
    return acc;
}
__device__ __forceinline__ void st_tile(const f32x4_t& acc, bf16_t* D, int drs, int dcs, int tr, int tc, int lane) {
    const int row0 = 16 * tr + 4 * (lane >> 4), col = 16 * tc + (lane & 15);
#pragma unroll
    for (int e = 0; e < 4; ++e) D[(row0 + e) * drs + col * dcs] = f2bf(acc[e]);
}
__device__ __forceinline__ f32x4_t ld_tile(const bf16_t* D, int drs, int dcs, int tr, int tc, int lane) {
    const int row0 = 16 * tr + 4 * (lane >> 4), col = 16 * tc + (lane & 15); f32x4_t v;
#pragma unroll
    for (int e = 0; e < 4; ++e) v[e] = bf2f(D[(row0 + e) * drs + col * dcs]);
    return v;
}
template <bool STRICT> __device__ __forceinline__ void triu_tile(f32x4_t& acc, int tr, int tc, int lane) {
    const int row0 = 16 * tr + 4 * (lane >> 4), col = 16 * tc + (lane & 15);
#pragma unroll
    for (int e = 0; e < 4; ++e) { const bool keep = STRICT ? (row0 + e < col) : (row0 + e <= col); acc[e] = keep ? acc[e] : 0.f; }
}

__device__ void ph_rwkv_r1(const P& p, float* ldsf, int ch_first, int ch_end, int ch_step) {
    const bf16_t* R = (const bf16_t*)(p.ws + WS_R); const bf16_t* K2 = (const bf16_t*)(p.ws + WS_K2); const bf16_t* VV = (const bf16_t*)(p.ws + WS_VV);
    const bf16_t* KK = (const bf16_t*)(p.ws + WS_KK); const bf16_t* BB = (const bf16_t*)(p.ws + WS_BB); const float* DD = (const float*)(p.ws + WS_DD);
    bf16_t* L = (bf16_t*)ldsf;
    bf16_t* At = L + 0 * SLOT; bf16_t* AtT = L + 1 * SLOT; bf16_t* Bt = L + 2 * SLOT; bf16_t* Kt = L + 3 * SLOT; bf16_t* Rt = L + 4 * SLOT; bf16_t* BhT = L + 5 * SLOT; bf16_t* Kh = L + 6 * SLOT;
    bf16_t* S7 = L + 7 * SLOT; bf16_t* S8 = L + 8 * SLOT; bf16_t* S9 = L + 9 * SLOT; bf16_t* Mka = L + 10 * SLOT; bf16_t* NbrT = L + 11 * SLOT; bf16_t* Nkr = L + 12 * SLOT;
    float* cs = (float*)(L + 13 * SLOT);
    float* segs = cs + 64 * 64;
    float* gLs = segs + 8 * 64;
    const int tid = otid(), lane = tid & 63, wv = tid >> 6;
    const int t0 = 2 * wv, t1 = 2 * wv + 1;
    for (int ch = ch_first; ch < ch_end; ch += ch_step) {
        const int bh = ch >> 7, c = ch & 127, b = bh >> 3, h = bh & 7;
        const size_t gbase = ((size_t)b * SEQ + (size_t)c * 64) * RW + h * 64;
        bf16_t* G1T = (bf16_t*)(p.ws + WS_KK) + gbase; bf16_t* PT = (bf16_t*)(p.ws + WS_BB) + gbase; bf16_t* G2T = (bf16_t*)(p.ws + WS_DD) + 2 * gbase; bf16_t* QT = G2T + 64;
        __syncthreads();
        const int st = tid >> 3, sj = (tid & 7) * 8;
        { const float4 l0 = *(const float4*)(DD + gbase + (size_t)st * RW + sj), l1 = *(const float4*)(DD + gbase + (size_t)st * RW + sj + 4);
          float* d = cs + st * 64 + sj; *(float4*)d = l0; *(float4*)(d + 4) = l1; }
        __syncthreads();
        { const int j = tid & 63, sg = tid >> 6; float run = 0.f;
#pragma unroll
          for (int i = 0; i < 8; ++i) { run += cs[(sg * 8 + i) * 64 + j]; }
          segs[sg * 64 + j] = run; }
        __syncthreads();
        { const int j = tid & 63, sg = tid >> 6; float run = 0.f;
          for (int q = 0; q < sg; ++q) run += segs[q * 64 + j];
#pragma unroll
          for (int i = 0; i < 8; ++i) { run += cs[(sg * 8 + i) * 64 + j]; cs[(sg * 8 + i) * 64 + j] = run; }
          if (sg == 7) gLs[j] = __expf(run); }
        __syncthreads();
        const uint4 vraw = *(const uint4*)(VV + gbase + (size_t)st * RW + sj);
        {
            const uint4 rr = *(const uint4*)(R + gbase + (size_t)st * RW + sj), kr = *(const uint4*)(K2 + gbase + (size_t)st * RW + sj);
            const uint4 kkr = *(const uint4*)(KK + gbase + (size_t)st * RW + sj), br = *(const uint4*)(BB + gbase + (size_t)st * RW + sj);
            const unsigned rw_[4] = {rr.x, rr.y, rr.z, rr.w}, kw_[4] = {kr.x, kr.y, kr.z, kr.w}, kkw_[4] = {kkr.x, kkr.y, kkr.z, kkr.w}, bw_[4] = {br.x, br.y, br.z, br.w};
            unsigned oa[4], ob[4], ok[4], orr[4], okh[4];
#pragma unroll
            for (int e2 = 0; e2 < 4; ++e2) {
                float va[2], vb[2], vk[2], vr2[2], vbh[2], vkh[2];
#pragma unroll
                for (int hf = 0; hf < 2; ++hf) {
                    const int j = sj + 2 * e2 + hf;
                    const float lgI = cs[st * 64 + j], lgE = st ? cs[(st - 1) * 64 + j] : 0.f, gl = cs[63 * 64 + j];
                    const float rv = hf ? __uint_as_float(rw_[e2] & 0xffff0000u) : __uint_as_float(rw_[e2] << 16);
                    const float kv = hf ? __uint_as_float(kw_[e2] & 0xffff0000u) : __uint_as_float(kw_[e2] << 16);
                    const float kkv = hf ? __uint_as_float(kkw_[e2] & 0xffff0000u) : __uint_as_float(kkw_[e2] << 16);
                    const float bv = hf ? __uint_as_float(bw_[e2] & 0xffff0000u) : __uint_as_float(bw_[e2] << 16);
                    const float einv = __expf(-lgI), eh = __expf(gl - lgI);
                    va[hf] = -kkv * __expf(lgE); vb[hf] = bv * einv; vk[hf] = kv * einv; vr2[hf] = rv * __expf(lgI); vbh[hf] = bv * eh; vkh[hf] = kv * eh;
                    AtT[j * LP + st] = f2bf(va[hf]); BhT[j * LP + st] = f2bf(vbh[hf]);
                }
                oa[e2] = pk2(va[0], va[1]); ob[e2] = pk2(vb[0], vb[1]); ok[e2] = pk2(vk[0], vk[1]); orr[e2] = pk2(vr2[0], vr2[1]); okh[e2] = pk2(vkh[0], vkh[1]);
            }
            *(uint4*)(At + st * LP + sj) = make_uint4(oa[0], oa[1], oa[2], oa[3]); *(uint4*)(Bt + st * LP + sj) = make_uint4(ob[0], ob[1], ob[2], ob[3]);
            *(uint4*)(Kt + st * LP + sj) = make_uint4(ok[0], ok[1], ok[2], ok[3]); *(uint4*)(Rt + st * LP + sj) = make_uint4(orr[0], orr[1], orr[2], orr[3]);
            *(uint4*)(Kh + st * LP + sj) = make_uint4(okh[0], okh[1], okh[2], okh[3]);
        }
        __syncthreads();
#define R1_FOR_TILES(idx, tr, tc) _Pragma("unroll") for (int _q = 0; _q < 2; ++_q) { const int idx = _q ? t1 : t0; const int tr = idx >> 2, tc = idx & 3;
#define R1_END }
#define MMF(X, Y, acc) mm_tile<true, true>((X), LP, 1, (Y), 1, LP, tr, tc, (acc), lane)
        const f32x4_t zero4 = {0.f, 0.f, 0.f, 0.f};
        R1_FOR_TILES(idx, tr, tc)
            f32x4_t mab = MMF(Bt, At, zero4); triu_tile<true>(mab, tr, tc, lane); st_tile(mab, S7, LP, 1, tr, tc, lane); st_tile(mab, S8, 1, LP, tr, tc, lane);
            { f32x4_t tt = mab; const int row0 = 16 * tr + 4 * (lane >> 4), col = 16 * tc + (lane & 15);
#pragma unroll
              for (int e = 0; e < 4; ++e) tt[e] += (row0 + e == col) ? 1.f : 0.f;
              st_tile(tt, S9, LP, 1, tr, tc, lane); }
            f32x4_t mka = MMF(Kt, At, zero4); triu_tile<true>(mka, tr, tc, lane); st_tile(mka, Mka, LP, 1, tr, tc, lane);
            f32x4_t nbr = MMF(Bt, Rt, zero4); triu_tile<false>(nbr, tr, tc, lane); st_tile(nbr, NbrT, 1, LP, tr, tc, lane);
            f32x4_t nkr = MMF(Kt, Rt, zero4); triu_tile<false>(nkr, tr, tc, lane); st_tile(nkr, Nkr, LP, 1, tr, tc, lane);
        R1_END
        __syncthreads();
        bf16_t* VmT = At;
        { const unsigned vw_[4] = {vraw.x, vraw.y, vraw.z, vraw.w};
#pragma unroll
          for (int e = 0; e < 8; ++e) VmT[(sj + e) * LP + st] = (bf16_t)((e & 1) ? (vw_[e >> 1] >> 16) : (vw_[e >> 1] & 0xffffu)); }
        bf16_t* Pc = S7; bf16_t* PcT = S8; bf16_t* Pn = Bt; bf16_t* PnT = Kt; bf16_t* Tc = S9; bf16_t* Tn = (bf16_t*)cs; bf16_t* TT = nullptr;
#pragma unroll 1
        for (int k = 1; k <= 6; ++k) {
            R1_FOR_TILES(idx, tr, tc)
                if (k <= 5) { f32x4_t pp = MMF(Pc, PcT, zero4); st_tile(pp, Pn, LP, 1, tr, tc, lane); st_tile(pp, PnT, 1, LP, tr, tc, lane); }
                if (k >= 2) { f32x4_t tn = ld_tile(Tc, LP, 1, tr, tc, lane); tn = MMF(Tc, PcT, tn); st_tile(tn, Tn, LP, 1, tr, tc, lane);
                    if (k == 6) st_tile(tn, Pn, 1, LP, tr, tc, lane); }
            R1_END
            __syncthreads();
            if (k == 6) TT = Pn;
            if (k <= 5) { bf16_t* x_ = Pc; Pc = Pn; Pn = x_; x_ = PcT; PcT = PnT; PnT = x_; }
            if (k >= 2) { bf16_t* x_ = Tc; Tc = Tn; Tn = x_; }
        }
        bf16_t* W1 = Pc; bf16_t* W2 = PcT; bf16_t* QkT = PnT;
        bf16_t* Og1 = Tn; bf16_t* Og2 = Tc; bf16_t* Opt = TT; bf16_t* Oqt = W1;
        R1_FOR_TILES(idx, tr, tc)
            f32x4_t w1 = MMF(AtT, TT, zero4); st_tile(w1, W1, LP, 1, tr, tc, lane);
            f32x4_t w2 = MMF(Mka, TT, zero4); st_tile(w2, W2, LP, 1, tr, tc, lane);
        R1_END
        __syncthreads();
        R1_FOR_TILES(idx, tr, tc)
            f32x4_t g1 = ld_tile(Rt, 1, LP, tr, tc, lane); g1 = MMF(W1, NbrT, g1); st_tile(g1, Og1, 1, LP, tr, tc, lane);
            f32x4_t g2 = ld_tile(Nkr, LP, 1, tr, tc, lane); g2 = MMF(W2, NbrT, g2); st_tile(g2, Og2, 1, LP, tr, tc, lane);
            f32x4_t pm = MMF(W1, BhT, zero4);
            { const int row0 = 16 * tr + 4 * (lane >> 4), col = 16 * tc + (lane & 15);
#pragma unroll
              for (int e = 0; e < 4; ++e) pm[e] += (row0 + e == col) ? gLs[col] : 0.f; }
            st_tile(pm, Opt, 1, LP, tr, tc, lane);
            f32x4_t qk = ld_tile(Kh, LP, 1, tr, tc, lane); qk = MMF(W2, BhT, qk); st_tile(qk, QkT, 1, LP, tr, tc, lane);
        R1_END
        __syncthreads();
        {
            const int row = tid >> 3, ch8 = (tid & 7) * 8;
            *(uint4*)(G1T + (size_t)row * RW + ch8) = *(const uint4*)(Og1 + row * LP + ch8);
            *(uint4*)(G2T + (size_t)row * (2 * RW) + ch8) = *(const uint4*)(Og2 + row * LP + ch8);
            *(uint4*)(PT + (size_t)row * RW + ch8) = *(const uint4*)(Opt + row * LP + ch8);
        }
        R1_FOR_TILES(idx, tr, tc)
            f32x4_t qt = MMF(QkT, VmT, zero4);
            { const int row0 = 16 * tr + 4 * (lane >> 4), col = 16 * tc + (lane & 15);
#pragma unroll
              for (int e = 0; e < 4; ++e) { const int jp = row0 + e; const int ci = ((jp >> 5) * 2 + (col >> 5)) * 64 + (col & 31) + 32 * ((jp >> 2) & 1);
                Oqt[ci * 16 + (jp & 3) + 4 * ((jp & 31) >> 3)] = f2bf(qt[e]); } }
        R1_END
        __syncthreads();
        { const int ci = tid >> 1, hf = tid & 1;
          *(uint4*)(QT + (size_t)(ci >> 2) * (2 * RW) + (ci & 3) * 16 + hf * 8) = *(const uint4*)(Oqt + ci * 16 + hf * 8); }
#undef MMF
    }
}
__device__ void ph_rwkv_prep_r1(const P& p, float* ldsf) {
    for (int b64 = blockIdx.x; b64 < NT / 64; b64 += gridDim.x) {
        ph_rwkv_prep(p, ldsf, 2 * b64, 2 * b64 + 2, 1);
        __syncthreads();
        const int b = b64 >> 7, c = b64 & 127, ch0 = (b * 8) * 128 + c;
        ph_rwkv_r1(p, ldsf, ch0, ch0 + 8 * 128, 128);
    }
}
__device__ void ph_rwkv_r2(const P& p, int bh_first, int bh_end, int bh_step) {
    bf16_t* SX = (bf16_t*)(p.ws + WS_SX);
    const int tid = otid(), lane = tid & 63, wv = tid >> 6, hh = lane >> 5, r32 = lane & 31;
    typedef short s16x4_t __attribute__((ext_vector_type(4)));
    for (int bh = bh_first; bh < bh_end; bh += bh_step) {
        if (wv >= 2) continue;
        const int cb = wv;
        f32x16_t x0, x1;
#pragma unroll
        for (int i = 0; i < 16; ++i) { x0[i] = 0.f; x1[i] = 0.f; }
        bf16x8_t pa[2][4]; uint4 qa[2][2];
#define R2_LOAD(c_) do { const size_t gb_ = ((size_t)(bh >> 3) * SEQ + (size_t)(c_) * 64) * RW + (bh & 7) * 64; \
            const bf16_t* PT = (const bf16_t*)(p.ws + WS_BB) + gb_; const bf16_t* QT = (const bf16_t*)(p.ws + WS_DD) + 2 * gb_ + 64; \
            _Pragma("unroll") for (int rb = 0; rb < 2; ++rb) { \
                _Pragma("unroll") for (int ks = 0; ks < 4; ++ks) { const bf16_t* pp = PT + (size_t)(32 * rb + r32) * RW + 32 * (ks >> 1) + 16 * (ks & 1) + 4 * hh; \
                    const s16x4_t lo = *(const s16x4_t*)pp, hi = *(const s16x4_t*)(pp + 8); \
                    _Pragma("unroll") for (int j = 0; j < 4; ++j) { pa[rb][ks][j] = lo[j]; pa[rb][ks][4 + j] = hi[j]; } } \
                const int ci_ = (rb * 2 + cb) * 64 + lane; const uint4* qp = (const uint4*)(QT + (size_t)(ci_ >> 2) * (2 * RW) + (ci_ & 3) * 16); qa[rb][0] = qp[0]; qa[rb][1] = qp[1]; } } while (0)
        R2_LOAD(0);
#pragma unroll 1
        for (int c = 0; c < SEQ / 64; ++c) {
            const size_t ob_ = ((size_t)bh * 128 + c) * 4096;
            const bf16x8_t xb0 = pack_step16(x0, 0), xb1 = pack_step16(x0, 1), xb2 = pack_step16(x1, 0), xb3 = pack_step16(x1, 1);
            { bf16_t* sp = SX + ob_ + (size_t)(32 * cb + r32) * 64 + 4 * hh;
              const uint4 u0 = __builtin_bit_cast(uint4, xb0), u1 = __builtin_bit_cast(uint4, xb1), u2 = __builtin_bit_cast(uint4, xb2), u3 = __builtin_bit_cast(uint4, xb3);
              *(uint2*)(sp + 0) = make_uint2(u0.x, u0.y); *(uint2*)(sp + 8) = make_uint2(u0.z, u0.w); *(uint2*)(sp + 16) = make_uint2(u1.x, u1.y); *(uint2*)(sp + 24) = make_uint2(u1.z, u1.w);
              *(uint2*)(sp + 32) = make_uint2(u2.x, u2.y); *(uint2*)(sp + 40) = make_uint2(u2.z, u2.w); *(uint2*)(sp + 48) = make_uint2(u3.x, u3.y); *(uint2*)(sp + 56) = make_uint2(u3.z, u3.w); }
            f32x16_t n0, n1;
            { const unsigned qw0[8] = {qa[0][0].x, qa[0][0].y, qa[0][0].z, qa[0][0].w, qa[0][1].x, qa[0][1].y, qa[0][1].z, qa[0][1].w};
              const unsigned qw1[8] = {qa[1][0].x, qa[1][0].y, qa[1][0].z, qa[1][0].w, qa[1][1].x, qa[1][1].y, qa[1][1].z, qa[1][1].w};
#pragma unroll
              for (int i = 0; i < 8; ++i) { n0[2 * i] = __uint_as_float(qw0[i] << 16); n0[2 * i + 1] = __uint_as_float(qw0[i] & 0xffff0000u); n1[2 * i] = __uint_as_float(qw1[i] << 16); n1[2 * i + 1] = __uint_as_float(qw1[i] & 0xffff0000u); } }
            const bf16x8_t a00 = pa[0][0], a01 = pa[0][1], a02 = pa[0][2], a03 = pa[0][3], a10 = pa[1][0], a11 = pa[1][1], a12 = pa[1][2], a13 = pa[1][3];
            if (c + 1 < SEQ / 64) R2_LOAD(c + 1);
            n0 = MFMA32(a00, xb0, n0); n0 = MFMA32(a01, xb1, n0); n0 = MFMA32(a02, xb2, n0); n0 = MFMA32(a03, xb3, n0);
            n1 = MFMA32(a10, xb0, n1); n1 = MFMA32(a11, xb1, n1); n1 = MFMA32(a12, xb2, n1); n1 = MFMA32(a13, xb3, n1);
            x0 = n0; x1 = n1;
        }
#undef R2_LOAD
    }
}
__device__ void ph_rwkv_r3(const P& p, float* ldsf) {
    const bf16_t* VV = (const bf16_t*)(p.ws + WS_VV); const bf16_t* SX = (const bf16_t*)(p.ws + WS_SX);
    const bf16_t* Rg = (const bf16_t*)(p.ws + WS_R); const bf16_t* K2 = (const bf16_t*)(p.ws + WS_K2); const bf16_t* Gg = (const bf16_t*)(p.ws + WS_G); bf16_t* ORW = (bf16_t*)(p.ws + WS_ORW);
    const float* r_k = p.in[18]; const float* ln_w = p.in[19]; const float* ln_b = p.in[20];
    bf16_t* Vm = (bf16_t*)ldsf; float* Yl = (float*)(Vm + SLOT);
    const int tid = otid(), lane = tid & 63, wv = tid >> 6; const int t0 = 2 * wv, t1 = 2 * wv + 1;
    const int st = tid >> 3, sj = (tid & 7) * 8;
    for (int ch = blockIdx.x; ch < NB * 8 * (SEQ / 64); ch += gridDim.x) {
        const int bh = ch >> 7, c = ch & 127, b = bh >> 3, h = bh & 7;
        const size_t gbase = ((size_t)b * SEQ + (size_t)c * 64) * RW + h * 64, ob_ = (size_t)ch * 4096;
        const bf16_t* G1T = (const bf16_t*)(p.ws + WS_KK) + gbase; const bf16_t* G2T = (const bf16_t*)(p.ws + WS_DD) + 2 * gbase;
        __syncthreads();
        const uint4 vraw = *(const uint4*)(VV + gbase + (size_t)st * RW + sj);
        *(uint4*)(Vm + st * LP + sj) = vraw;
        __syncthreads();
        R1_FOR_TILES(idx, tr, tc)
            const f32x4_t zero4 = {0.f, 0.f, 0.f, 0.f};
            f32x4_t y = mm_tile<true, true>(SX + ob_, 64, 1, G1T, 1, RW, tr, tc, zero4, lane);
            y = mm_tile<false, true>(Vm, 1, LP, G2T, 1, 2 * RW, tr, tc, y, lane);
            const int i0 = 16 * tr + 4 * (lane >> 4), t = 16 * tc + (lane & 15);
#pragma unroll
            for (int e = 0; e < 4; ++e) Yl[t * 65 + i0 + e] = y[e];
        R1_END
        __syncthreads();
        {
            float y[8], s1 = 0.f;
#pragma unroll
            for (int e = 0; e < 8; ++e) { y[e] = Yl[st * 65 + sj + e]; s1 += y[e]; }
            s1 += __shfl_xor(s1, 1); s1 += __shfl_xor(s1, 2); s1 += __shfl_xor(s1, 4);
            const float mean = s1 * (1.f / 64.f); float s2 = 0.f;
#pragma unroll
            for (int e = 0; e < 8; ++e) { y[e] -= mean; s2 += y[e] * y[e]; }
            s2 += __shfl_xor(s2, 1); s2 += __shfl_xor(s2, 2); s2 += __shfl_xor(s2, 4);
            const float rstd = rsqrtf(s2 * (1.f / 64.f) + GN_EPS);
            const size_t o = gbase + (size_t)st * RW + sj;
            const uint4 rr = *(const uint4*)(Rg + o), kr = *(const uint4*)(K2 + o), gr = *(const uint4*)(Gg + o);
            const unsigned rw_[4] = {rr.x, rr.y, rr.z, rr.w}, kw_[4] = {kr.x, kr.y, kr.z, kr.w}, gw_[4] = {gr.x, gr.y, gr.z, gr.w}, vw_[4] = {vraw.x, vraw.y, vraw.z, vraw.w};
            float rk = 0.f;
#pragma unroll
            for (int e = 0; e < 8; ++e) { const float r_ = (e & 1) ? __uint_as_float(rw_[e >> 1] & 0xffff0000u) : __uint_as_float(rw_[e >> 1] << 16), k_ = (e & 1) ? __uint_as_float(kw_[e >> 1] & 0xffff0000u) : __uint_as_float(kw_[e >> 1] << 16);
                rk += r_ * k_ * r_k[h * 64 + sj + e]; }
            rk += __shfl_xor(rk, 1); rk += __shfl_xor(rk, 2); rk += __shfl_xor(rk, 4);
            float ov[8];
#pragma unroll
            for (int e = 0; e < 8; ++e) { const float v_ = (e & 1) ? __uint_as_float(vw_[e >> 1] & 0xffff0000u) : __uint_as_float(vw_[e >> 1] << 16), g_ = (e & 1) ? __uint_as_float(gw_[e >> 1] & 0xffff0000u) : __uint_as_float(gw_[e >> 1] << 16);
                ov[e] = (y[e] * rstd * ln_w[h * 64 + sj + e] + ln_b[h * 64 + sj + e] + rk * v_) * g_; }
            *(uint4*)(ORW + o) = make_uint4(pk2(ov[0], ov[1]), pk2(ov[2], ov[3]), pk2(ov[4], ov[5]), pk2(ov[6], ov[7]));
        }
    }
}
#undef R1_FOR_TILES
#undef R1_END

__device__ void ph_moe_lists(const P& p, float* ldsf) {
    int* ctl = (int*)(p.ws + WS_CTL); const int* cntB = ctl + CT_CNTB;
    int* ltok = (int*)(p.ws + WS_LTOK); float* lw = (float*)(p.ws + WS_LW);
    int* part = (int*)ldsf;
    int* tot = part + 1024; int* pre = tot + 64; int* offL = pre + 64; int* tp = offL + 64;
    const int tid = otid(), lane = tid & 63, wv = tid >> 6, G = gridDim.x;
    { int t_ = 0, p_ = 0;
      for (int b2 = wv; b2 < G; b2 += 8) { const int v = cntB[b2 * 64 + lane]; t_ += v; p_ += (b2 < (int)blockIdx.x) ? v : 0; }
      part[wv * 64 + lane] = t_; part[512 + wv * 64 + lane] = p_; }
    __syncthreads();
    if (tid < 64) { int t_ = 0, p_ = 0;
#pragma unroll
        for (int w2 = 0; w2 < 8; ++w2) { t_ += part[w2 * 64 + tid]; p_ += part[512 + w2 * 64 + tid]; }
        tot[tid] = t_; pre[tid] = p_;
        const int nt_ = (t_ + 255) >> 8; int incl = nt_;
#pragma unroll
        for (int o = 1; o < 64; o <<= 1) { const int oth = __shfl_up(incl, o); if (lane >= o) incl += oth; }
        tp[tid] = incl - nt_; offL[tid] = (incl - nt_) * 256; if (tid == 63) tp[64] = incl; }
    __syncthreads();
    const int TPB = NT / G;
    for (int i = tid; i < TPB; i += NTHR) { const int m = blockIdx.x * TPB + i; const int4 r = ((const int4*)(p.ws + WS_ROUTE))[m];
        const int l0 = r.x & 255, l1 = 32 + ((r.x >> 8) & 255), rk0 = r.y & 0xffff, rk1 = (r.y >> 16) & 0xffff;
        const int p0 = offL[l0] + pre[l0] + rk0, p1 = offL[l1] + pre[l1] + rk1;
        ltok[p0] = m; lw[p0] = __int_as_float(r.z); ltok[p1] = m; lw[p1] = __int_as_float(r.w); }
    for (int li = blockIdx.x; li < 64; li += G) {
        const int cnt = tot[li], off = offL[li], e = li & 31, nt_ = (cnt + 255) >> 8;
        int4* t1 = (int4*)(ctl + CT_TAB1) + tp[li] * 4;
        int4* t2 = (li < 32) ? (int4*)(ctl + CT_TAB2A) + tp[li] * 4 : (int4*)(ctl + CT_TAB2B) + (tp[li] - tp[32]) * 4;
        for (int i = tid; i < nt_ * 4; i += NTHR) { const int mt = i >> 2, nt = i & 3; const int4 ent = make_int4(off + mt * 256, e * 1024 + nt * 256, cnt - mt * 256, nt); t1[i] = ent; t2[i] = ent; }
        for (int r = cnt + tid; r < nt_ * 256; r += NTHR) ltok[off + r] = 0;
    }
    if (blockIdx.x == 0 && tid == 0) { ctl[CT_NU] = tp[64] * 4; ctl[CT_NU + 1] = tp[32] * 4; ctl[CT_NU + 2] = (tp[64] - tp[32]) * 4; }
}

template <int PH>
__device__ __forceinline__ void run_phase(const P& p, unsigned char* lds_raw) {
    float* lds = (float*)lds_raw; PG8_LAS unsigned char* ldsg = (PG8_LAS unsigned char*)lds_raw;
    const int G = gridDim.x, c = blockIdx.x;
    if constexpr (PH == 0) { ph_mod(p, lds); __syncthreads(); ph_convert_mixer_weights(p, lds); __syncthreads(); ph_convert_lora_weights(p, lds); }
    if constexpr (PH == 1) ph_norm(p, p.in[0], p.in[4], 0, (bf16_t*)(p.ws + WS_XN));
    if constexpr (PH == 2) { pg8::Gemm g{(const bf16_t*)(p.ws + WS_XN), (const bf16_t*)(p.ws + WS_WIN), DM, nullptr}; pg8::StaticOrder S; S.init(NT, 5120, G, c);
        pg8::EpiInproj E{p.ws, (bf16_t*)p.out}; pg8::gemm_phase(ldsg, g, S, E); }
    if constexpr (PH == 3) {
        { pg8::Gemm g{(const bf16_t*)(p.ws + WS_KVN), (const bf16_t*)(p.ws + WS_WKV), KVL, nullptr}; pg8::StaticOrder S; S.init(NT, 2 * AW, G, c);
          pg8::EpiKV E{p.ws}; pg8::gemm_phase(ldsg, g, S, E);
          pg8::Unit u;
          for (int i = 0; S.next(i, u); ++i) if (u.pn < 2) { __syncthreads(); knorm_tile(p, u.pm, u.pn); } }
        ph_rwkv_prep_r1(p, lds);
        ph_dsa_select(p, lds);
    }
    if constexpr (PH == 4) { ph_rwkv_r2(p, c, NB * 8, G); ph_dsa_attn(p, lds); }
    if constexpr (PH == 5) ph_rwkv_r3(p, lds);
    if constexpr (PH == 6) { pg8::Gemm g{(const bf16_t*)(p.ws + WS_OATT), (const bf16_t*)(p.ws + WS_WBA), AW, nullptr}; pg8::BranchOrder S; S.S0.init(NT, DM, G, c);
        pg8::EpiMerge E{(bf16_t*)(p.ws + WS_MERGED), (const bf16_t*)p.out}; pg8::gemm_phase(ldsg, g, S, E);
        ph_convert_expert_weights(p, lds); }
    if constexpr (PH == 7) { pg8::Gemm g{(const bf16_t*)(p.ws + WS_MERGED), (const bf16_t*)(p.ws + WS_WOUT), DM, nullptr}; pg8::StaticOrder S; S.init(NT, DM, G, c);
        pg8::EpiOut E{p.in[0], (const float*)(p.ws + WS_MOD), p.out}; pg8::gemm_phase(ldsg, g, S, E); }
    if constexpr (PH == 8) ph_norm_route(p, lds);
    if constexpr (PH == 9) ph_moe_lists(p, lds);
    if constexpr (PH == 10) { const int* ctl = (const int*)(p.ws + WS_CTL);
        pg8::Gemm g{(const bf16_t*)(p.ws + WS_XN2), (const bf16_t*)(p.ws + WS_WGU), DM, (const int*)(p.ws + WS_LTOK)}; pg8::TableOrder S{(const int4*)(ctl + CT_TAB1), ctl[CT_NU], G, c};
        pg8::EpiMoe1 E{(bf16_t*)(p.ws + WS_HID), (const float*)(p.ws + WS_LW)}; pg8::gemm_phase(ldsg, g, S, E); }
    if constexpr (PH == 11 || PH == 12) { const int* ctl = (const int*)(p.ws + WS_CTL);
        pg8::Gemm g{(const bf16_t*)(p.ws + WS_HID), (const bf16_t*)(p.ws + WS_WDN), DE, nullptr};
        pg8::TableOrder S{(const int4*)(ctl + (PH == 11 ? CT_TAB2A : CT_TAB2B)), ctl[CT_NU + (PH == 11 ? 1 : 2)], G, c};
        pg8::EpiMoe2 E{(const int*)(p.ws + WS_LTOK), (const float*)(p.ws + WS_MOD), p.out}; pg8::gemm_phase(ldsg, g, S, E); }
}
constexpr int LDS_BYTES = 147456;
constexpr int ORDER[] = {0, 1, 2, 3, 4, 5, 6, 7, 8, 9, 10, 11, 12};
constexpr int NPHASE = sizeof(ORDER) / sizeof(int);
constexpr int CT_BAR = 65536;
constexpr int LDS_ST = LDS_BYTES - 64;
template <int I> __device__ __forceinline__ void run_all(const P& p, unsigned char* lds, const XcdBarrier& bar) {
    run_phase<ORDER[I]>(p, lds);
    if constexpr (I + 1 < NPHASE) { xcd_barrier(bar); run_all<I + 1>(p, lds, bar); }
}
__global__ void __launch_bounds__(NTHR, 2) k_mega(P p) {
    extern __shared__ __attribute__((aligned(16))) unsigned char lds[];
    volatile LAS3 unsigned* st = (volatile LAS3 unsigned*)((LAS3 unsigned char*)lds + LDS_ST);
    if (otid() < 16) st[otid()] = 0u;
    __syncthreads();
    const XcdBarrier bar = xcd_barrier_post((unsigned*)(p.ws + WS_CTL) + CT_BAR, st);
    run_all<0>(p, lds, bar);
}
}

extern "C" void kernel_launch(void* const* d_in, const int* in_sizes, int n_in, void* d_out, int out_size, void* d_ws, size_t ws_size, hipStream_t stream) {
    if (n_in != 31 || out_size != NT * DM || ws_size < WS_END) { fprintf(stderr, "kernel_launch: unexpected shapes (n_in %d out %d ws %zu need %zu)\n", n_in, out_size, ws_size, (size_t)WS_END); return; }
    P p{};
    for (int i = 0; i < 31; ++i) p.in[i] = (const float*)d_in[i];
    p.out = (float*)d_out; p.ws = (unsigned char*)d_ws;
    (void)hipMemsetAsync((char*)d_ws + WS_CTL, 0, 1 * MiB, stream);
    static int grid_blocks = 0;
    if (!grid_blocks) {
        int dev = 0, cus = 0, per_cu = 0;
        (void)hipGetDevice(&dev);
        (void)hipDeviceGetAttribute(&cus, hipDeviceAttributeMultiprocessorCount, dev);
        (void)hipFuncSetAttribute((const void*)k_mega, hipFuncAttributeMaxDynamicSharedMemorySize, LDS_BYTES);
        (void)hipOccupancyMaxActiveBlocksPerMultiprocessor(&per_cu, (const void*)k_mega, NTHR, LDS_BYTES);
        if (per_cu < 1) per_cu = 1;
        if (per_cu > 1) per_cu = 1;
        grid_blocks = cus * per_cu;
        fprintf(stderr, "kernel_launch: cus %d per_cu %d grid %d\n", cus, per_cu, grid_blocks);
    }
    hipLaunchKernelGGL(k_mega, dim3(grid_blocks), dim3(NTHR), LDS_BYTES, stream, p);
}
```

```cpp
#include <hip/hip_runtime.h>
#include <cstdio>
#include <cstdint>

namespace {
constexpr int NB = 2, SEQ = 8192, DM = 1024, NT = NB * SEQ;
constexpr int AW = 512, KVL = 256, NIH = 8, IDD = 32, SHW = 1824, INW = 4936;
constexpr int C_KV = 512, C_QI = 768, C_PS = 1064, C_GA = 2888, C_GR = 3912;
constexpr int IDXW = 296;
constexpr int RW = 512, NE = 32, DE = 512;
constexpr int TOPK = 256;
constexpr float NORM_EPS = 1e-6f, GN_EPS = 64e-5f;
constexpr int NTHR = 512;

typedef unsigned short bf16_t;
__device__ __forceinline__ float bf2f(bf16_t v) { return __uint_as_float(((unsigned)v) << 16); }
__device__ __forceinline__ bf16_t f2bf(float f) { unsigned u = __float_as_uint(f); return (bf16_t)((u + 0x7fffu + ((u >> 16) & 1u)) >> 16); }

constexpr size_t MiB = 1u << 20;
constexpr size_t WS_CTL = 0;
constexpr size_t WS_MOD = 1 * MiB;
constexpr size_t WS_RSS = 82 * MiB + 512 * 1024;
constexpr size_t WS_LW2T = 512 * 1024, WS_LA2T = 576 * 1024, WS_LG2T = 640 * 1024;
constexpr size_t WS_WIN = 2 * MiB;
constexpr size_t WS_WKV = 12 * MiB;
constexpr size_t WS_WBA = 13 * MiB;
constexpr size_t WS_WBR = 14 * MiB;
constexpr size_t WS_WOUT = 15 * MiB;
constexpr size_t WS_XN = 17 * MiB;
constexpr size_t WS_K = 17 * MiB;
constexpr size_t WS_V = 33 * MiB;
constexpr size_t WS_Q = 49 * MiB;
constexpr size_t WS_KVN = 65 * MiB;
constexpr size_t WS_QI = 73 * MiB;
constexpr size_t WS_KI = 81 * MiB;
constexpr size_t WS_WI = 82 * MiB;
constexpr size_t WS_PS = 83 * MiB;
constexpr size_t WS_SX = 83 * MiB;
constexpr size_t WS_OATT = 99 * MiB;
constexpr size_t WS_ORW = 115 * MiB;
constexpr size_t WS_MASK = 140 * MiB;
constexpr size_t WS_R = 156 * MiB, WS_K2 = 172 * MiB, WS_VV = 188 * MiB;
constexpr size_t WS_KK = 204 * MiB;
constexpr size_t WS_BB = 220 * MiB;
constexpr size_t WS_DD = 236 * MiB;
constexpr size_t WS_G = 268 * MiB;
constexpr size_t WS_MERGED = 131 * MiB;
constexpr size_t WS_XN2 = 163 * MiB;
constexpr size_t WS_WGU = 195 * MiB;
constexpr size_t WS_WDN = 259 * MiB;
constexpr size_t WS_HID = 17 * MiB;
constexpr size_t WS_ROUTE = 65 * MiB;
constexpr size_t WS_LTOK = 66 * MiB;
constexpr size_t WS_LW = 67 * MiB;
constexpr size_t WS_END = 291 * MiB;
constexpr int HID_ROWS = 49152;
constexpr int CT_CNT = 0, CT_OFF = 64, CT_CUR = 128, CT_NU = 192, CT_Q = 256;
constexpr int CT_CNTB = 16384;
constexpr int CT_TAB1 = 1024, CT_TAB2A = 1024 + 4 * 1024, CT_TAB2B = 1024 + 8 * 1024;

struct P {
    const float* in[31];
    float* out;
    unsigned char* ws;
};

__device__ __forceinline__ int otid() { int t = threadIdx.x; asm volatile("" : "+v"(t)); return t; }
__device__ __forceinline__ float dpp_row_shr(float v, int n) {
    int iv = __builtin_bit_cast(int, v), r;
    switch (n) { case 1: r = __builtin_amdgcn_update_dpp(0, iv, 0x111, 0xf, 0xf, true); break; case 2: r = __builtin_amdgcn_update_dpp(0, iv, 0x112, 0xf, 0xf, true); break;
                 case 4: r = __builtin_amdgcn_update_dpp(0, iv, 0x114, 0xf, 0xf, true); break; default: r = __builtin_amdgcn_update_dpp(0, iv, 0x118, 0xf, 0xf, true); break; }
    return __builtin_bit_cast(float, r);
}
__device__ __forceinline__ float wave_sum(float v) {
    v += dpp_row_shr(v, 1); v += dpp_row_shr(v, 2); v += dpp_row_shr(v, 4); v += dpp_row_shr(v, 8);
    v += __builtin_bit_cast(float, __builtin_amdgcn_update_dpp(0, __builtin_bit_cast(int, v), 0x142, 0xa, 0xf, false));
    v += __builtin_bit_cast(float, __builtin_amdgcn_update_dpp(0, __builtin_bit_cast(int, v), 0x143, 0xc, 0xf, false));
    return __builtin_bit_cast(float, __builtin_amdgcn_readlane(__builtin_bit_cast(int, v), 63));
}
__device__ __forceinline__ float wave_max(float v) {
#pragma unroll
    for (int o = 32; o > 0; o >>= 1) v = fmaxf(v, __shfl_xor(v, o));
    return v;
}
typedef short bf16x8_t __attribute__((ext_vector_type(8)));
typedef float f32x4_t __attribute__((ext_vector_type(4)));
constexpr int LP = 72;
constexpr int SLOT = 64 * LP;
typedef __bf16 bf2_t __attribute__((ext_vector_type(2)));
typedef float f2_t __attribute__((ext_vector_type(2)));
__device__ __forceinline__ unsigned pk_bf16(float lo, float hi) { const f2_t v = {lo, hi}; return __builtin_bit_cast(unsigned, __builtin_convertvector(v, bf2_t)); }
__device__ __forceinline__ float sigmoidf_(float x) { return __builtin_amdgcn_rcpf(1.f + __expf(-x)); }

#define XB_TMO      128
#define XB_XCNT(j)  (256  + 64 * (j))
#define XB_XSUB(j)  (1280 + 64 * (j))
#define XB_XGEN(j)  (2304 + 64 * (j))
#define XB_TOP      3328
#define XB_TOPGEN   3392
#define XCD_BAR_WORDS 3456
#define XB_SPIN_CAP (1u << 22)
#define LAS3 __attribute__((address_space(3)))
__device__ __forceinline__ unsigned xb_ld(unsigned* p)              { return __hip_atomic_load(p, __ATOMIC_RELAXED, __HIP_MEMORY_SCOPE_AGENT); }
__device__ __forceinline__ unsigned xb_add(unsigned* p, unsigned v) { return __hip_atomic_fetch_add(p, v, __ATOMIC_RELAXED, __HIP_MEMORY_SCOPE_AGENT); }
__device__ __forceinline__ unsigned xb_xcc_id() { return (unsigned)__builtin_amdgcn_s_getreg((3 << 11) | 20) & 0xFu; }
#define XB_SPIN(cond, bar) do { unsigned _sp = 0; while (cond) { __builtin_amdgcn_s_sleep(1); \
    if ((++_sp & 255u) == 0u) { if (xb_ld(&(bar)[XB_TMO])) break; if (_sp > XB_SPIN_CAP) { atomicAdd(&(bar)[XB_TMO], 1u); break; } } } } while (0)
struct XcdBarrier { unsigned* bar; unsigned x; volatile LAS3 unsigned* st; };
__device__ __forceinline__ XcdBarrier xcd_barrier_post(unsigned* bar, volatile LAS3 unsigned* st) {
    XcdBarrier b; b.bar = bar; b.x = xb_xcc_id(); b.st = st;
    if (otid() == 0) (void)xb_add(&bar[XB_XCNT(b.x)], 1u);
    return b;
}
__device__ __forceinline__ void xcd_barrier_complete(unsigned* bar, unsigned x, unsigned& nloc, unsigned& nx) {
    const unsigned G = gridDim.x * gridDim.y * gridDim.z;
    unsigned sum, cnt, mine, sp = 0u;
    for (;;) {
        sum = 0u; cnt = 0u; mine = 0u;
#pragma unroll
        for (unsigned j = 0; j < 16; ++j) { const unsigned c = xb_ld(&bar[XB_XCNT(j)]); sum += c; cnt += (c > 0u) ? 1u : 0u; mine = (j == x) ? c : mine; }
        if (sum == G) break;
        __builtin_amdgcn_s_sleep(1);
        if ((++sp & 255u) == 0u) { if (xb_ld(&bar[XB_TMO])) break; if (sp > XB_SPIN_CAP) { atomicAdd(&bar[XB_TMO], 1u); break; } }
    }
    nloc = mine > 0u ? mine : 1u; nx = cnt > 0u ? cnt : 1u;
}
__device__ __forceinline__ void xcd_barrier(const XcdBarrier& b) {
    asm volatile("s_waitcnt vmcnt(0)" ::: "memory");
    __syncthreads();
    if (otid() == 0) {
        unsigned* bar = b.bar;
        __builtin_amdgcn_s_waitcnt(0);
        unsigned nloc = b.st[0], nx = b.st[1];
        if (nloc == 0u) { xcd_barrier_complete(bar, b.x, nloc, nx); b.st[0] = nloc; b.st[1] = nx; }
        const unsigned old = xb_add(&bar[XB_XSUB(b.x)], 1u);
        const unsigned gen = old / nloc;
        if (old + 1u == (gen + 1u) * nloc) {
            __builtin_amdgcn_fence(__ATOMIC_RELEASE, "agent");
            asm volatile("s_waitcnt vmcnt(0)" ::: "memory");
            const unsigned og = xb_add(&bar[XB_TOP], 1u);
            const unsigned tg = og / nx;
            if (og + 1u == (tg + 1u) * nx) xb_add(&bar[XB_TOPGEN], 1u);
            else XB_SPIN(xb_ld(&bar[XB_TOPGEN]) == tg, bar);
            __builtin_amdgcn_fence(__ATOMIC_ACQUIRE, "agent");
            xb_add(&bar[XB_XGEN(b.x)], 1u);
            asm volatile("s_waitcnt vmcnt(0)" ::: "memory");
        } else {
            XB_SPIN(xb_ld(&bar[XB_XGEN(b.x)]) == gen, bar);
            __builtin_amdgcn_fence(__ATOMIC_ACQUIRE, "agent");
            asm volatile("s_waitcnt vmcnt(0)" ::: "memory");
        }
    }
    __syncthreads();
}

__device__ void ph_mod(const P& p, float* lds) {
    const float* c = p.in[1]; const float* W = p.in[2]; const float* bia = p.in[3];
    float* mod = (float*)(p.ws + WS_MOD);
    const int tid = otid(), lane = tid & 63, wv = tid >> 6;
    float* sil = lds; float* part = lds + NB * DM;
    for (int i = tid; i < NB * DM; i += NTHR) { const float v = c[i]; sil[i] = v / (1.f + __expf(-v)); }
    __syncthreads();
    const int cc = lane % 24, kk = lane / 24;
    for (int j0 = blockIdx.x * 24; j0 < 6 * DM; j0 += gridDim.x * 24) {
        float a0 = 0.f, a1 = 0.f;
        if (lane < 48) {
#pragma unroll 8
            for (int i = 0; i < 64; ++i) { const int k = 128 * wv + 2 * i + kk; const float w = W[(size_t)k * (6 * DM) + j0 + cc]; a0 += sil[k] * w; a1 += sil[DM + k] * w; }
        }
        a0 += __shfl(a0, (lane + 24) & 63); a1 += __shfl(a1, (lane + 24) & 63);
        if (lane < 24) { part[(wv * 2 + 0) * 24 + cc] = a0; part[(wv * 2 + 1) * 24 + cc] = a1; }
        __syncthreads();
        if (tid < 48) { const int bb = tid / 24, c2 = tid % 24; float sum = 0.f;
#pragma unroll
            for (int w2 = 0; w2 < 8; ++w2) sum += part[(w2 * 2 + bb) * 24 + c2];
            mod[bb * 6 * DM + j0 + c2] = sum + bia[j0 + c2]; }
        __syncthreads();
    }
}

__device__ void ph_norm(const P& p, const float* src, const float* g, int which, bf16_t* dst) {
    const float* mod = (const float*)(p.ws + WS_MOD);
    const int lane = otid() & 63, wv = otid() >> 6;
    const int gw = blockIdx.x * (NTHR / 64) + wv, nw = gridDim.x * (NTHR / 64);
    for (int m = gw; m < NT; m += nw) {
        const int b = m / SEQ;
        const float* sh = mod + b * 6 * DM + (which ? 3 * DM : 0);
        const float* sc = sh + DM;
        const float4* xr = (const float4*)(src + (size_t)m * DM);
        float4 v[4]; float ss = 0.f;
#pragma unroll
        for (int j = 0; j < 4; ++j) { v[j] = xr[lane + 64 * j]; ss += v[j].x * v[j].x + v[j].y * v[j].y + v[j].z * v[j].z + v[j].w * v[j].w; }
        ss = wave_sum(ss);
        const float rstd = rsqrtf(ss * (1.f / DM) + NORM_EPS);
        float o[16];
#pragma unroll
        for (int j = 0; j < 4; ++j) {
            int c0 = 4 * (lane + 64 * j); asm volatile("" : "+v"(c0));
            const float4 gg = *(const float4*)(g + c0), s1 = *(const float4*)(sc + c0), s0 = *(const float4*)(sh + c0);
            o[4 * j + 0] = v[j].x * rstd * gg.x * (1.f + s1.x) + s0.x; o[4 * j + 1] = v[j].y * rstd * gg.y * (1.f + s1.y) + s0.y;
            o[4 * j + 2] = v[j].z * rstd * gg.z * (1.f + s1.z) + s0.z; o[4 * j + 3] = v[j].w * rstd * gg.w * (1.f + s1.w) + s0.w;
            uint2 pk; pk.x = (unsigned)f2bf(o[4 * j]) | ((unsigned)f2bf(o[4 * j + 1]) << 16); pk.y = (unsigned)f2bf(o[4 * j + 2]) | ((unsigned)f2bf(o[4 * j + 3]) << 16);
            *(uint2*)(dst + (size_t)m * DM + c0) = pk;
        }
    }
}

__device__ void ph_norm_route(const P& p, float* lds) {
    const float* mod = (const float*)(p.ws + WS_MOD); const float* src = p.out; const float* g = p.in[24]; bf16_t* dst = (bf16_t*)(p.ws + WS_XN2);
    const float* wgr = p.in[25]; const float* wer = p.in[26]; const float* eb = p.in[27];
    const int tid = otid(), lane = tid & 63, wv = tid >> 6;
    float* sx = lds + wv * 4096;
    int* cntL = (int*)(lds + 8 * 4096);
    if (tid < 64) cntL[tid] = 0;
    __syncthreads();
    const int TPB = NT / gridDim.x;
    for (int m0 = blockIdx.x * TPB + wv * 4; m0 < (blockIdx.x + 1) * TPB; m0 += 8 * 4) {
        const int b = m0 / SEQ;
        const float* sh = mod + b * 6 * DM + 3 * DM; const float* sc = sh + DM;
#pragma unroll 1
        for (int tk = 0; tk < 4; ++tk) {
            const int m = m0 + tk;
            const float4* xr = (const float4*)(src + (size_t)m * DM);
            float4 v[4]; float ss = 0.f;
#pragma unroll
            for (int j = 0; j < 4; ++j) { v[j] = xr[lane + 64 * j]; ss += v[j].x * v[j].x + v[j].y * v[j].y + v[j].z * v[j].z + v[j].w * v[j].w; }
            ss = wave_sum(ss);
            const float rstd = rsqrtf(ss * (1.f / DM) + NORM_EPS);
#pragma unroll
            for (int j = 0; j < 4; ++j) {
                const int c0 = 4 * (lane + 64 * j);
                const float4 gg = *(const float4*)(g + c0), s1 = *(const float4*)(sc + c0), s0 = *(const float4*)(sh + c0);
                const float o0 = v[j].x * rstd * gg.x * (1.f + s1.x) + s0.x, o1 = v[j].y * rstd * gg.y * (1.f + s1.y) + s0.y;
                const float o2 = v[j].z * rstd * gg.z * (1.f + s1.z) + s0.z, o3 = v[j].w * rstd * gg.w * (1.f + s1.w) + s0.w;
                uint2 pk; pk.x = (unsigned)f2bf(o0) | ((unsigned)f2bf(o1) << 16); pk.y = (unsigned)f2bf(o2) | ((unsigned)f2bf(o3) << 16);
                *(uint2*)(dst + (size_t)m * DM + c0) = pk;
                sx[(c0 + 0) * 4 + tk] = o0; sx[(c0 + 1) * 4 + tk] = o1; sx[(c0 + 2) * 4 + tk] = o2; sx[(c0 + 3) * 4 + tk] = o3;
            }
        }
        __builtin_amdgcn_wave_barrier(); asm volatile("s_waitcnt lgkmcnt(0)" ::: "memory");
        float ae[4] = {0.f, 0.f, 0.f, 0.f}, ag[4] = {0.f, 0.f, 0.f, 0.f};
        { const int e = lane & 31, kb = (lane >> 5) * 512;
#pragma unroll 16
          for (int i = 0; i < 512; ++i) { const float w = wer[(size_t)(kb + i) * 32 + e]; const float4 xv = *(const float4*)(sx + (kb + i) * 4);
              ae[0] += xv.x * w; ae[1] += xv.y * w; ae[2] += xv.z * w; ae[3] += xv.w * w; } }
        { const int gq = lane & 3, kb = (lane >> 2) * 64;
#pragma unroll 16
          for (int i = 0; i < 64; ++i) { const float w = wgr[(size_t)(kb + i) * 4 + gq]; const float4 xv = *(const float4*)(sx + (kb + i) * 4);
              ag[0] += xv.x * w; ag[1] += xv.y * w; ag[2] += xv.z * w; ag[3] += xv.w * w; } }
#pragma unroll
        for (int tk = 0; tk < 4; ++tk) {
            ae[tk] += __shfl_xor(ae[tk], 32);
            ag[tk] += __shfl_xor(ag[tk], 4); ag[tk] += __shfl_xor(ag[tk], 8); ag[tk] += __shfl_xor(ag[tk], 16); ag[tk] += __shfl_xor(ag[tk], 32);
        }
#pragma unroll
        for (int tk = 0; tk < 4; ++tk) {
            float lg[4];
#pragma unroll
            for (int q = 0; q < 4; ++q) lg[q] = __shfl(ag[tk], q);
            int gs = 0; float mx = lg[0];
#pragma unroll
            for (int q = 1; q < 4; ++q) if (lg[q] > mx) { mx = lg[q]; gs = q; }
            float den = 0.f;
#pragma unroll
            for (int q = 0; q < 4; ++q) den += __expf(lg[q] - mx);
            const float pg = 1.f / den;
            float ev[8];
#pragma unroll
            for (int q = 0; q < 8; ++q) ev[q] = __shfl(ae[tk], gs * 8 + q) + eb[gs * 8 + q];
            int i0 = 0; float v0 = ev[0];
#pragma unroll
            for (int q = 1; q < 8; ++q) if (ev[q] > v0) { v0 = ev[q]; i0 = q; }
            int i1 = -1; float v1 = -INFINITY;
#pragma unroll
            for (int q = 0; q < 8; ++q) if (q != i0 && ev[q] > v1) { v1 = ev[q]; i1 = q; }
            if (lane == 0) {
                const float e1 = __expf(v1 - v0), w0 = pg / (1.f + e1), w1 = pg * e1 / (1.f + e1);
                const int x0 = gs * 8 + i0, x1 = gs * 8 + i1;
                const int rk0 = atomicAdd(&cntL[x0], 1), rk1 = atomicAdd(&cntL[32 + x1], 1);
                int4* route = (int4*)(p.ws + WS_ROUTE) + (size_t)(m0 + tk);
                *route = make_int4(x0 | (x1 << 8), rk0 | (rk1 << 16), __float_as_int(w0), __float_as_int(w1));
            }
        }
        __builtin_amdgcn_wave_barrier();
    }
    __syncthreads();
    if (tid < 64) ((int*)(p.ws + WS_CTL) + CT_CNTB)[blockIdx.x * 64 + tid] = cntL[tid];
}

namespace pg8 {
#define PG8_LAS __attribute__((address_space(3)))
typedef short bf16x8 __attribute__((ext_vector_type(8)));
typedef float f32x4 __attribute__((ext_vector_type(4)));
typedef unsigned u32x4 __attribute__((ext_vector_type(4)));
constexpr int BM = 256, BK = 64, HALF = 128, HTB = HALF * BK * 2, STAGE_BYTES = 8 * HTB, NXCD = 8, WGM = 8;
__host__ __device__ __forceinline__ int lds_byte(int r, int c) { const int st = (r >> 4) * 2 + (c >> 5), rr = r & 15, cc = c & 31, ob = rr * 64 + cc * 2; return st * 1024 + (ob ^ (((ob >> 9) & 1) << 5)); }
__host__ __device__ __forceinline__ void stage_rc(int b, int& R, int& C) { const int st = b / 1024, sb = b % 1024, swz = sb ^ (((sb >> 9) & 1) << 5); R = (st >> 1) * 16 + swz / 64; C = (st & 1) * 32 + (swz % 64) / 2; }
__host__ __device__ __forceinline__ int perm32(int rho) { const int n = rho >> 4, i = rho & 15; return 8 * (i >> 2) + 4 * n + (i & 3); }

struct Unit { int arow, brow, pm, pn, aux; };
struct Gemm { const bf16_t* A; const bf16_t* Bt; int K; const int* gather; };

struct StaticOrder {
    int nM, nN, nwg, G, c;
    __device__ void init(int M, int N, int G_, int c_) { nM = M / BM; nN = N / BM; nwg = nM * nN; G = G_; c = c_; }
    __device__ bool next(int i, Unit& u) const {
        const long L = (long)i * G + c; if (L >= nwg) return false;
        int wgid = (int)L; { const int q = nwg / NXCD, r = nwg % NXCD, xcd = wgid % NXCD, off = wgid / NXCD; wgid = (xcd < r ? xcd * (q + 1) : r * (q + 1) + (xcd - r) * q) + off; }
        const int nig = WGM * nN, gid = wgid / nig, fm = gid * WGM, gsz = (nM - fm) < WGM ? (nM - fm) : WGM;
        u.pm = fm + ((wgid % nig) % gsz); u.pn = (wgid % nig) / gsz; u.arow = u.pm * BM; u.brow = u.pn * BM; u.aux = 0; return true;
    }
};
struct BranchOrder {
    StaticOrder S0;
    __device__ bool next(int i, Unit& u) const {
        if (!S0.next(i >> 1, u)) return false;
        const int which = i & 1; u.arow += which * NT; u.brow += which * DM; u.aux = which; return true;
    }
};
struct TableOrder {
    const int4* tab; int n, G, c;
    __device__ bool next(int i, Unit& u) const {
        const int L = i * G + c; if (L >= n) return false;
        const int4 e = tab[L]; u.arow = __builtin_amdgcn_readfirstlane(e.x); u.brow = __builtin_amdgcn_readfirstlane(e.y); u.aux = __builtin_amdgcn_readfirstlane(e.z); u.pn = __builtin_amdgcn_readfirstlane(e.w); u.pm = 0; return true;
    }
};
__device__ __forceinline__ unsigned cvt_pk_bf16(float lo, float hi) { return pk_bf16(lo, hi); }

template <class Epi, class Sched>
__device__ __forceinline__ void gemm_phase(PG8_LAS unsigned char* lds, const Gemm g, const Sched& S, const Epi& E) {
    const int tid = otid(), wid = __builtin_amdgcn_readfirstlane(tid >> 6), lane = tid & 63, wr = wid >> 2, wc = wid & 3, fr = lane & 15, fq = lane >> 4;
    const int K = g.K, nt = K / BK;
    int RA0; unsigned cofA0, voffB0;
    { int R, C; stage_rc(tid * 16, R, C); const int Rb = Epi::PERM ? ((R & ~31) + perm32(R & 31)) : R; RA0 = R; cofA0 = (unsigned)C * 2u; voffB0 = (unsigned)(Rb * K + C) * 2u; }
    const size_t rstep64 = (size_t)64 * K * 2;
    const size_t kstep = (size_t)(BK * 2);
    const size_t hstep = (size_t)HALF * K * 2;
    const unsigned ldsw = (unsigned)wid * 1024u;
    const int aoff = lds_byte(wr * 64 + fr, fq * 8), boff = lds_byte(wc * 32 + fr, fq * 8);
#define PG8_SA(b, h) (((b) * 2 + (h)) * HTB)
#define PG8_SB(b, h) ((4 + (b) * 2 + (h)) * HTB)
#define PG8_STAGE_B(bufoff, gbase) do { _Pragma("unroll") for (int _i = 0; _i < 2; ++_i) \
        __builtin_amdgcn_global_load_lds((const unsigned*)((const char*)(gbase) + _i * rstep64 + voffB0), (PG8_LAS unsigned*)(lds + (bufoff) + ldsw + _i * 8192), 16, 0, 0); } while (0)
#define PG8_STAGE_A(bufoff, o2, kb) do { _Pragma("unroll") for (int _i = 0; _i < 2; ++_i) \
        __builtin_amdgcn_global_load_lds((const unsigned*)((const char*)g.A + (size_t)(o2)[_i] + (size_t)(kb)), (PG8_LAS unsigned*)(lds + (bufoff) + ldsw + _i * 8192), 16, 0, 0); } while (0)
#define PG8_LDA(dst, b, h) do { _Pragma("unroll") for (int m = 0; m < 4; ++m) _Pragma("unroll") for (int k = 0; k < 2; ++k) dst[m][k] = *(const PG8_LAS bf16x8*)(lds + PG8_SA(b, h) + aoff + m * 2048 + k * 1024); } while (0)
#define PG8_LDB(dst, b, h) do { _Pragma("unroll") for (int n = 0; n < 2; ++n) _Pragma("unroll") for (int k = 0; k < 2; ++k) dst[n][k] = *(const PG8_LAS bf16x8*)(lds + PG8_SB(b, h) + boff + n * 2048 + k * 1024); } while (0)
#define PG8_MMA(ai, bj, At, Bt) do { __builtin_amdgcn_s_setprio(1); _Pragma("unroll") for (int m = 0; m < 4; ++m) _Pragma("unroll") for (int n = 0; n < 2; ++n) _Pragma("unroll") for (int k = 0; k < 2; ++k) \
        acc[ai][bj][m][n] = __builtin_amdgcn_mfma_f32_16x16x32_bf16(Bt[n][k], At[m][k], acc[ai][bj][m][n], 0, 0, 0); __builtin_amdgcn_s_setprio(0); } while (0)
#define PG8_WAIT_V(n) asm volatile("s_waitcnt vmcnt(" #n ")" ::: "memory")
#define PG8_WAIT_L(n) asm volatile("s_waitcnt lgkmcnt(" #n ")" ::: "memory")
#define PG8_BAR __builtin_amdgcn_s_barrier()
#define PG8_SCHED __builtin_amdgcn_sched_barrier(0)
#define PG8_AOFFS(u, dst) do { _Pragma("unroll") for (int _h = 0; _h < 2; ++_h) _Pragma("unroll") for (int _i = 0; _i < 2; ++_i) { \
        const int _tr = (u).arow + _h * HALF + RA0 + 64 * _i; const unsigned _row = g.gather ? (unsigned)g.gather[_tr] : (unsigned)_tr; dst[_h][_i] = _row * (unsigned)(K * 2) + cofA0; } } while (0)
    Unit cur, nxt; int ui = 0;
    if (!S.next(0, cur)) return;
    f32x4 acc[2][2][4][2];
#pragma unroll
    for (int a = 0; a < 2; ++a)
#pragma unroll
        for (int b = 0; b < 2; ++b)
#pragma unroll
            for (int m = 0; m < 4; ++m)
#pragma unroll
                for (int n = 0; n < 2; ++n) acc[a][b][m][n] = (f32x4){0.f, 0.f, 0.f, 0.f};
    bf16x8 At[4][2], B0[2][2], B1[2][2];
    unsigned cof[2][2];
    PG8_AOFFS(cur, cof);
    const char* cB = (const char*)g.Bt + (size_t)cur.brow * K * 2;
    PG8_STAGE_B(PG8_SB(0, 0), cB); PG8_STAGE_B(PG8_SB(0, 1), cB + hstep); PG8_STAGE_A(PG8_SA(0, 0), cof[0], 0); PG8_STAGE_A(PG8_SA(0, 1), cof[1], 0);
    if (wr == 1) PG8_BAR;
    PG8_WAIT_V(2); PG8_BAR;
    PG8_STAGE_B(PG8_SB(1, 0), cB + kstep); PG8_STAGE_A(PG8_SA(1, 0), cof[0], kstep); PG8_STAGE_B(PG8_SB(1, 1), cB + hstep + kstep);
    PG8_WAIT_V(6); PG8_BAR;
    for (;;) {
        const bool has_next = S.next(ui + 1, nxt);
        if (!has_next) nxt = cur;
        const char* nB = (const char*)g.Bt + (size_t)nxt.brow * K * 2;
        for (int t = 0; t < nt; t += 2) {
            const bool last = (t == nt - 2);
            const size_t k1 = (size_t)(t + 1) * kstep;
            const size_t k2 = last ? 0 : (size_t)(t + 2) * kstep, k3 = k2 + kstep;
            const char* b2 = last ? nB : cB + (size_t)(t + 2) * kstep; const char* b3 = b2 + kstep;
            PG8_LDB(B0, 0, 0); PG8_LDB(B1, 0, 1); PG8_SCHED; PG8_LDA(At, 0, 0); PG8_STAGE_A(PG8_SA(1, 1), cof[1], k1);
            if (last) { PG8_AOFFS(nxt, cof); }
            PG8_WAIT_V(8); PG8_WAIT_L(0); PG8_BAR; PG8_MMA(0, 0, At, B0); PG8_MMA(0, 1, At, B1); PG8_BAR; PG8_SCHED;
            PG8_LDA(At, 0, 1); PG8_STAGE_B(PG8_SB(0, 0), b2); PG8_STAGE_B(PG8_SB(0, 1), b2 + hstep); PG8_STAGE_A(PG8_SA(0, 0), cof[0], k2);
            PG8_WAIT_V(8); PG8_WAIT_L(0); PG8_BAR; PG8_MMA(1, 0, At, B0); PG8_MMA(1, 1, At, B1); PG8_BAR; PG8_SCHED;
            PG8_LDB(B0, 1, 0); PG8_LDB(B1, 1, 1); PG8_SCHED; PG8_LDA(At, 1, 0); PG8_STAGE_A(PG8_SA(0, 1), cof[1], k2);
            PG8_WAIT_V(8); PG8_WAIT_L(0); PG8_BAR; PG8_MMA(0, 0, At, B0); PG8_MMA(0, 1, At, B1); PG8_BAR; PG8_SCHED;
            PG8_LDA(At, 1, 1); PG8_STAGE_B(PG8_SB(1, 0), b3); PG8_STAGE_B(PG8_SB(1, 1), b3 + hstep); PG8_STAGE_A(PG8_SA(1, 0), cof[0], k3);
            PG8_WAIT_V(8); PG8_WAIT_L(0); PG8_BAR; PG8_MMA(1, 0, At, B0); PG8_MMA(1, 1, At, B1); PG8_BAR; PG8_SCHED;
        }
        if (wr == 0) PG8_BAR;
        { const int l2 = otid() & 63; E(acc, cur, wr, wc, l2 & 15, l2 >> 4); }
        if (!has_next) break;
#pragma unroll
        for (int a = 0; a < 2; ++a)
#pragma unroll
            for (int b = 0; b < 2; ++b)
#pragma unroll
                for (int m = 0; m < 4; ++m)
#pragma unroll
                    for (int n = 0; n < 2; ++n) acc[a][b][m][n] = (f32x4){0.f, 0.f, 0.f, 0.f};
        cur = nxt; cB = nB; ++ui;
        if (wr == 1) PG8_BAR;
    }
    PG8_WAIT_V(0);
    PG8_BAR;
#undef PG8_SA
#undef PG8_SB
#undef PG8_STAGE_A
#undef PG8_STAGE_B
#undef PG8_LDA
#undef PG8_LDB
#undef PG8_MMA
#undef PG8_WAIT_V
#undef PG8_WAIT_L
#undef PG8_BAR
#undef PG8_SCHED
#undef PG8_AOFFS
}

#define PG8_FENCE asm volatile("" ::: "memory")
#define PG8_FOR_TILE(ai, m, bj) _Pragma("unroll") for (int ai = 0; ai < 2; ++ai) _Pragma("unroll") for (int m = 0; m < 4; ++m) _Pragma("unroll") for (int bj = 0; bj < 2; ++bj)
__device__ __forceinline__ u32x4 pack8(const f32x4& v0, const f32x4& v1) { u32x4 w; w.x = cvt_pk_bf16(v0[0], v0[1]); w.y = cvt_pk_bf16(v0[2], v0[3]); w.z = cvt_pk_bf16(v1[0], v1[1]); w.w = cvt_pk_bf16(v1[2], v1[3]); return w; }
__device__ __forceinline__ float sigm(float x) { return __builtin_amdgcn_rcpf(1.f + __expf(-x)); }
struct EpiInproj {
    static constexpr bool PERM = true;
    unsigned char* ws; bf16_t* gates;
    __device__ __forceinline__ void operator()(const f32x4 (&acc)[2][2][4][2], const Unit& u, int wr, int wc, int fr, int fq) const {
        PG8_FOR_TILE(ai, m, bj) { PG8_FENCE;
            int row = u.pm * BM + ai * HALF + wr * 64 + m * 16 + fr; asm volatile("" : "+v"(row)); const int col = u.pn * BM + bj * HALF + wc * 32 + 8 * fq;
            const f32x4 v0 = acc[ai][bj][m][0], v1 = acc[ai][bj][m][1];
            if (col < C_KV) *(u32x4*)((bf16_t*)(ws + WS_Q) + (size_t)row * AW + col) = pack8(v0, v1);
            else if (col < C_QI) {
                *(u32x4*)((bf16_t*)(ws + WS_KVN) + (size_t)row * KVL + (col - C_KV)) = pack8(v0, v1);
                float ss = (v0[0] * v0[0] + v0[1] * v0[1]) + (v0[2] * v0[2] + v0[3] * v0[3]) + (v1[0] * v1[0] + v1[1] * v1[1]) + (v1[2] * v1[2] + v1[3] * v1[3]);
                ss += __shfl_xor(ss, 16); ss += __shfl_xor(ss, 32);
                if (fq == 0) ((float*)(ws + WS_RSS))[(size_t)row * 8 + bj * 4 + wc] = ss;
            }
            else if (col < C_PS) {
                if (col < 1056) {
                    typedef _Float16 h8 __attribute__((ext_vector_type(8)));
                    h8 hv; hv[0] = (_Float16)v0[0]; hv[1] = (_Float16)v0[1]; hv[2] = (_Float16)v0[2]; hv[3] = (_Float16)v0[3]; hv[4] = (_Float16)v1[0]; hv[5] = (_Float16)v1[1]; hv[6] = (_Float16)v1[2]; hv[7] = (_Float16)v1[3];
                    _Float16* d = (col < 1024) ? (_Float16*)(ws + WS_QI) + (size_t)row * 256 + (col - C_QI) : (_Float16*)(ws + WS_KI) + (size_t)row * 32 + (col - 1024);
                    *(h8*)d = hv;
                } else { const float sc_ = 0.17677669529663687f * 0.35355339059327373f; float* d = (float*)(ws + WS_WI) + (size_t)row * 8; *(f32x4*)d = v0 * sc_; *(f32x4*)(d + 4) = v1 * sc_; }
            }
            else if (col < C_GA) *(u32x4*)((bf16_t*)(ws + WS_PS) + (size_t)row * SHW + (col - C_PS)) = pack8(v0, v1);
            else if (col < INW) {
                f32x4 s0, s1;
#pragma unroll
                for (int e = 0; e < 4; ++e) { s0[e] = sigm(v0[e]); s1[e] = sigm(v1[e]); }
                bf16_t* d = (col < C_GR) ? gates + (size_t)row * DM + (col - C_GA) : gates + (size_t)NT * DM + (size_t)row * DM + (col - C_GR);
                *(u32x4*)d = pack8(s0, s1);
            }
        }
    }
};
struct EpiKV {
    static constexpr bool PERM = true;
    unsigned char* ws;
    __device__ __forceinline__ void operator()(const f32x4 (&acc)[2][2][4][2], const Unit& u, int wr, int wc, int fr, int fq) const {
        PG8_FOR_TILE(ai, m, bj) { PG8_FENCE;
            int row = u.pm * BM + ai * HALF + wr * 64 + m * 16 + fr; asm volatile("" : "+v"(row)); const int col = u.pn * BM + bj * HALF + wc * 32 + 8 * fq;
            const f32x4 ra = *(const f32x4*)((const float*)(ws + WS_RSS) + (size_t)row * 8), rb = *(const f32x4*)((const float*)(ws + WS_RSS) + (size_t)row * 8 + 4);
            const float rstd = rsqrtf((((ra[0] + ra[1]) + (ra[2] + ra[3])) + ((rb[0] + rb[1]) + (rb[2] + rb[3]))) * (1.f / KVL) + NORM_EPS);
            if (col < AW) *(u32x4*)((bf16_t*)(ws + WS_K) + (size_t)row * AW + col) = pack8(acc[ai][bj][m][0] * rstd, acc[ai][bj][m][1] * rstd);
            else {
                bf16_t* d = (bf16_t*)(ws + WS_V) + ((size_t)(row / SEQ) * 512 + (col - AW)) * SEQ + (row % SEQ);
#pragma unroll
                for (int e = 0; e < 4; ++e) { d[(size_t)e * SEQ] = f2bf(acc[ai][bj][m][0][e] * rstd); d[(size_t)(4 + e) * SEQ] = f2bf(acc[ai][bj][m][1][e] * rstd); }
            }
        }
    }
};
struct EpiMerge {
    static constexpr bool PERM = true;
    bf16_t* merged; const bf16_t* gates;
    __device__ __forceinline__ void operator()(const f32x4 (&acc)[2][2][4][2], const Unit& u, int wr, int wc, int fr, int fq) const {
        const bf16_t* gate = gates + (size_t)u.aux * NT * DM;
        PG8_FOR_TILE(ai, m, bj) { PG8_FENCE;
            int row = u.pm * BM + ai * HALF + wr * 64 + m * 16 + fr; asm volatile("" : "+v"(row)); const int col = u.pn * BM + bj * HALF + wc * 32 + 8 * fq;
            const u32x4 gw = *(const u32x4*)(gate + (size_t)row * DM + col);
            f32x4 v0 = acc[ai][bj][m][0], v1 = acc[ai][bj][m][1];
            v0[0] *= __uint_as_float(gw.x << 16); v0[1] *= __uint_as_float(gw.x & 0xffff0000u); v0[2] *= __uint_as_float(gw.y << 16); v0[3] *= __uint_as_float(gw.y & 0xffff0000u);
            v1[0] *= __uint_as_float(gw.z << 16); v1[1] *= __uint_as_float(gw.z & 0xffff0000u); v1[2] *= __uint_as_float(gw.w << 16); v1[3] *= __uint_as_float(gw.w & 0xffff0000u);
            u32x4* d = (u32x4*)(merged + (size_t)row * DM + col);
            if (u.aux) { const u32x4 pw = *d;
                v0[0] += __uint_as_float(pw.x << 16); v0[1] += __uint_as_float(pw.x & 0xffff0000u); v0[2] += __uint_as_float(pw.y << 16); v0[3] += __uint_as_float(pw.y & 0xffff0000u);
                v1[0] += __uint_as_float(pw.z << 16); v1[1] += __uint_as_float(pw.z & 0xffff0000u); v1[2] += __uint_as_float(pw.w << 16); v1[3] += __uint_as_float(pw.w & 0xffff0000u); }
            *d = pack8(v0, v1);
        }
    }
};
struct EpiOut {
    static constexpr bool PERM = false;
    const float* x; const float* mod; float* out;
    __device__ __forceinline__ void operator()(const f32x4 (&acc)[2][2][4][2], const Unit& u, int wr, int wc, int fr, int fq) const {
        PG8_FOR_TILE(ai, m, bj) { PG8_FENCE;
            int row = u.pm * BM + ai * HALF + wr * 64 + m * 16 + fr; asm volatile("" : "+v"(row)); const float* gt = mod + (row / SEQ) * 6 * DM + 2 * DM;
#pragma unroll
            for (int n = 0; n < 2; ++n) { const int col = u.pn * BM + bj * HALF + wc * 32 + 16 * n + 4 * fq;
                const f32x4 xv = *(const f32x4*)(x + (size_t)row * DM + col), gv = *(const f32x4*)(gt + col);
                *(f32x4*)(out + (size_t)row * DM + col) = xv + gv * acc[ai][bj][m][n]; }
        }
    }
};
struct EpiMoe1 {
    static constexpr bool PERM = true;
    bf16_t* hid; const float* lw;
    __device__ __forceinline__ void operator()(const f32x4 (&acc)[2][2][4][2], const Unit& u, int wr, int wc, int fr, int fq) const {
#pragma unroll
        for (int ai = 0; ai < 2; ++ai)
#pragma unroll
            for (int m = 0; m < 4; ++m) {
                const int tr = ai * HALF + wr * 64 + m * 16 + fr; PG8_FENCE;
                if (tr < u.aux) {
                    const float w = lw[u.arow + tr]; f32x4 h0, h1;
#pragma unroll
                    for (int e = 0; e < 4; ++e) { const float g0 = acc[ai][0][m][0][e], g1 = acc[ai][0][m][1][e];
                        h0[e] = w * (g0 * __builtin_amdgcn_rcpf(1.f + __expf(-g0))) * acc[ai][1][m][0][e]; h1[e] = w * (g1 * __builtin_amdgcn_rcpf(1.f + __expf(-g1))) * acc[ai][1][m][1][e]; }
                    *(u32x4*)(hid + (size_t)(u.arow + tr) * DE + u.pn * HALF + wc * 32 + 8 * fq) = pack8(h0, h1);
                }
            }
    }
};
struct EpiMoe2 {
    static constexpr bool PERM = false;
    const int* ltok; const float* mod; float* out;
    __device__ __forceinline__ void operator()(const f32x4 (&acc)[2][2][4][2], const Unit& u, int wr, int wc, int fr, int fq) const {
#pragma unroll
        for (int ai = 0; ai < 2; ++ai)
#pragma unroll
            for (int m = 0; m < 4; ++m) {
                const int tr = ai * HALF + wr * 64 + m * 16 + fr; PG8_FENCE;
                if (tr < u.aux) {
                    const int tok = ltok[u.arow + tr]; const float* gt = mod + (tok / SEQ) * 6 * DM + 5 * DM; float* orow = out + (size_t)tok * DM;
#pragma unroll
                    for (int bj = 0; bj < 2; ++bj)
#pragma unroll
                        for (int n = 0; n < 2; ++n) { const int col = u.pn * BM + bj * HALF + wc * 32 + 16 * n + 4 * fq;
                            const f32x4 gv = *(const f32x4*)(gt + col); f32x4* d = (f32x4*)(orow + col); *d = *d + gv * acc[ai][bj][m][n]; }
                }
            }
    }
};
}

__device__ __forceinline__ unsigned pk2(float lo, float hi) { return (unsigned)f2bf(lo) | ((unsigned)f2bf(hi) << 16); }
__device__ __forceinline__ void transpose_item(const float* W, int K, int N, bf16_t* WT, size_t drow0, int k0, int n0, float* scr, int lane, int Ksrc = 1 << 30, const float* kscale = nullptr) {
#pragma unroll 8
    for (int i = 0; i < 32; ++i) { const int kk = 2 * i + (lane >> 5), n = n0 + (lane & 31); float v_ = (n < N && k0 + kk < Ksrc) ? W[(size_t)(k0 + kk) * N + n] : 0.f; if (kscale) v_ *= kscale[k0 + kk]; scr[kk * 33 + (lane & 31)] = v_; }
    asm volatile("s_waitcnt lgkmcnt(0)" ::: "memory");
    const int c = lane & 7;
#pragma unroll
    for (int j = 0; j < 4; ++j) { const int n = (lane >> 3) + 8 * j; const float* s_ = scr + (8 * c) * 33 + n;
        uint4 o; o.x = pk2(s_[0 * 33], s_[1 * 33]); o.y = pk2(s_[2 * 33], s_[3 * 33]); o.z = pk2(s_[4 * 33], s_[5 * 33]); o.w = pk2(s_[6 * 33], s_[7 * 33]);
        *(uint4*)(WT + (drow0 + n) * K + k0 + 8 * c) = o; }
    asm volatile("s_waitcnt lgkmcnt(0)" ::: "memory");
}
__device__ void ph_convert_mixer_weights(const P& p, float* lds) {
    const int lane = otid() & 63, wv = otid() >> 6;
    float* scr = lds + wv * (64 * 33);
    const int gw = blockIdx.x * (NTHR / 64) + wv, nw = gridDim.x * (NTHR / 64);
    struct M { const float* W; int K, N, Npad; size_t dst; const float* ks; };
    const M ms[5] = { {p.in[5], DM, INW, 5120, WS_WIN, nullptr}, {p.in[7], KVL, 2 * AW, 2 * AW, WS_WKV, p.in[6]}, {p.in[21], AW, DM, DM, WS_WBA, nullptr}, {p.in[22], RW, DM, DM, WS_WBR, nullptr}, {p.in[23], DM, DM, DM, WS_WOUT, nullptr} };
    int base = 0;
#pragma unroll
    for (int q = 0; q < 5; ++q) {
        const int nkb = ms[q].K / 64, nnb = ms[q].Npad / 32, nitems = nkb * nnb;
        for (int it = gw; it < base + nitems; it += nw) { if (it < base) continue; const int r = it - base; const int kb = r / nnb, nb = r % nnb;
            transpose_item(ms[q].W, ms[q].K, ms[q].N, (bf16_t*)(p.ws + ms[q].dst), (size_t)nb * 32, kb * 64, nb * 32, scr, lane, 1 << 30, ms[q].ks); }
        base += nitems;
    }
}
__device__ void ph_convert_lora_weights(const P& p, float* lds) {
    const int lane = otid() & 63, wv = otid() >> 6;
    float* scr = lds + wv * (64 * 33);
    const int gw = blockIdx.x * (NTHR / 64) + wv, nw = gridDim.x * (NTHR / 64);
    for (int it = gw; it < 16 + 16 + 48; it += nw) {
        if (it < 16) transpose_item(p.in[12], 64, RW, (bf16_t*)(p.ws + WS_LW2T), (size_t)it * 32, 0, it * 32, scr, lane);
        else if (it < 32) transpose_item(p.in[14], 64, RW, (bf16_t*)(p.ws + WS_LA2T), (size_t)(it - 16) * 32, 0, (it - 16) * 32, scr, lane);
        else { const int r = it - 32, kb = r >> 4, nb = r & 15; transpose_item(p.in[15], 192, RW, (bf16_t*)(p.ws + WS_LG2T), (size_t)nb * 32, kb * 64, nb * 32, scr, lane, 160); }
    }
}
__device__ void ph_convert_expert_weights(const P& p, float* lds) {
    const int lane = otid() & 63, wv = otid() >> 6;
    float* scr = lds + wv * (64 * 33);
    const int gw = blockIdx.x * (NTHR / 64) + wv, nw = gridDim.x * (NTHR / 64);
    for (int it = gw; it < NE * 2 * 256; it += nw) { const int e = it >> 9, which = (it >> 8) & 1, r = it & 255, kb = r >> 4, nb = r & 15, n0 = nb * 32;
        transpose_item(p.in[28 + which] + (size_t)e * DM * DE, DM, DE, (bf16_t*)(p.ws + WS_WGU), (size_t)e * 1024 + (n0 >> 7) * 256 + which * 128 + (n0 & 127), kb * 64, n0, scr, lane); }
    for (int it = gw; it < NE * 256; it += nw) { const int e = it >> 8, r = it & 255, kb = r >> 5, nb = r & 31;
        transpose_item(p.in[30] + (size_t)e * DE * DM, DE, DM, (bf16_t*)(p.ws + WS_WDN), (size_t)e * 1024 + nb * 32, kb * 64, nb * 32, scr, lane); }
}

__device__ void ph_headnorm(bf16_t* X, const float* g) {
    const int lane = otid() & 63, wv = otid() >> 6;
    const int gw = blockIdx.x * (NTHR / 64) + wv, nw = gridDim.x * (NTHR / 64);
    for (int m = gw; m < NT; m += nw) {
        uint4 raw = *(const uint4*)(X + (size_t)m * AW + lane * 8);
        float v[8] = {bf2f(raw.x & 0xffff), bf2f(raw.x >> 16), bf2f(raw.y & 0xffff), bf2f(raw.y >> 16), bf2f(raw.z & 0xffff), bf2f(raw.z >> 16), bf2f(raw.w & 0xffff), bf2f(raw.w >> 16)};
        float ss = 0.f;
#pragma unroll
        for (int i = 0; i < 8; ++i) ss += v[i] * v[i];
        ss += __shfl_xor(ss, 1); ss += __shfl_xor(ss, 2); ss += __shfl_xor(ss, 4);
        const float rstd = rsqrtf(ss * (1.f / 64.f) + NORM_EPS);
        const int d0 = (lane & 7) * 8;
        unsigned o[4];
#pragma unroll
        for (int i = 0; i < 4; ++i) o[i] = (unsigned)f2bf(v[2 * i] * rstd * g[d0 + 2 * i]) | ((unsigned)f2bf(v[2 * i + 1] * rstd * g[d0 + 2 * i + 1]) << 16);
        *(uint4*)(X + (size_t)m * AW + lane * 8) = make_uint4(o[0], o[1], o[2], o[3]);
    }
}
__device__ void ph_kvnorm(bf16_t* X, const float* g) {
    const int lane = otid() & 63, wv = otid() >> 6;
    const int gw = blockIdx.x * (NTHR / 64) + wv, nw = gridDim.x * (NTHR / 64);
    for (int m = gw; m < NT; m += nw) {
        uint2 raw = *(const uint2*)(X + (size_t)m * KVL + lane * 4);
        float v[4] = {bf2f(raw.x & 0xffff), bf2f(raw.x >> 16), bf2f(raw.y & 0xffff), bf2f(raw.y >> 16)};
        float ss = wave_sum(v[0] * v[0] + v[1] * v[1] + v[2] * v[2] + v[3] * v[3]);
        const float rstd = rsqrtf(ss * (1.f / 256.f) + NORM_EPS);
        uint2 o; o.x = (unsigned)f2bf(v[0] * rstd * g[lane * 4]) | ((unsigned)f2bf(v[1] * rstd * g[lane * 4 + 1]) << 16);
        o.y = (unsigned)f2bf(v[2] * rstd * g[lane * 4 + 2]) | ((unsigned)f2bf(v[3] * rstd * g[lane * 4 + 3]) << 16);
        *(uint2*)(X + (size_t)m * KVL + lane * 4) = o;
    }
}

typedef _Float16 half8_t __attribute__((ext_vector_type(8)));
typedef float f32x16_t __attribute__((ext_vector_type(16)));
__device__ __forceinline__ unsigned f2key(float f) { unsigned u = __float_as_uint(f); return (u & 0x80000000u) ? ~u : (u | 0x80000000u); }
__device__ void ph_dsa_select(const P& p, float* ldsf) {
    const _Float16* QI = (const _Float16*)(p.ws + WS_QI); const _Float16* KI = (const _Float16*)(p.ws + WS_KI); const float* WI = (const float*)(p.ws + WS_WI);
    unsigned* MASK32 = (unsigned*)(p.ws + WS_MASK);
    unsigned* hist = (unsigned*)ldsf;
    uint2* cand = (uint2*)(hist + 8 * 2048);
    unsigned* maskl = (unsigned*)(cand + 8 * 1024);
    unsigned* h2 = hist;
    int* misc = (int*)(maskl + 8 * 256);
    constexpr int CCAP = 1024;
    const int tid = otid(), lane = tid & 63, wv = tid >> 6, hh = lane >> 5, r32 = lane & 31;
    const int nrnd = (NT / 8 + (int)gridDim.x - 1) / (int)gridDim.x;
#pragma unroll 1
    for (int rnd = 0; rnd < nrnd; ++rnd) {
        const int item = __builtin_amdgcn_readfirstlane(rnd * (int)gridDim.x + ((rnd & 1) ? (int)(gridDim.x - 1 - blockIdx.x) : (int)blockIdx.x));
        if (item >= NT / 8) continue;
        const int tq0 = item * 8, b = tq0 / SEQ, t0 = tq0 % SEQ;
        const int nwords = ((t0 >> 8) + 1) * 8;
        __syncthreads();
        if (t0 + 7 < TOPK) {
            for (int e = tid; e < 8 * nwords; e += NTHR) { const int row = e / nwords, w = e % nwords; const int tr_ = t0 + row; const int lo = 32 * w;
                const unsigned bits = (tr_ >= lo + 31) ? 0xffffffffu : ((tr_ < lo) ? 0u : ((2u << (tr_ - lo)) - 1u));
                MASK32[(size_t)(tq0 + row) * 256 + w] = bits; }
            continue;
        }
        for (int e = tid; e < 8 * 2048; e += NTHR) hist[e] = 0u;
        for (int e = tid; e < 8 * 256; e += NTHR) maskl[e] = 0u;
        if (tid < 64) misc[tid] = 0;
        half8_t a0[2], a1[2]; float w[2][4][4];
#pragma unroll
        for (int rg = 0; rg < 2; ++rg) { const int tl_a = r32 >> 3, h_a = r32 & 7; const _Float16* qp = QI + (size_t)(tq0 + 4 * rg + tl_a) * 256 + h_a * 32 + 8 * hh;
            a0[rg] = *(const half8_t*)qp; a1[rg] = *(const half8_t*)(qp + 16);
#pragma unroll
            for (int tl = 0; tl < 4; ++tl) { const float4 wv4 = *(const float4*)(WI + (size_t)(tq0 + 4 * rg + tl) * 8 + 4 * hh); w[rg][tl][0] = wv4.x; w[rg][tl][1] = wv4.y; w[rg][tl][2] = wv4.z; w[rg][tl][3] = wv4.w; } }
        const int ntile = (t0 + 7) / 32 + 1;
        __syncthreads();
        int thr_bin[8];
#pragma unroll 1
        for (int pass = 0; pass < 2; ++pass) {
            if (pass == 1) {
#pragma unroll
                for (int r = 0; r < 8; ++r) thr_bin[r] = misc[r * 8];
            }
            half8_t kb0[4], kb1[4], nk0[4], nk1[4];
#pragma unroll
            for (int q = 0; q < 4; ++q) { const int tl_ = min(4 * wv + q, ntile - 1); const _Float16* kp = KI + (size_t)(b * SEQ + tl_ * 32 + r32) * 32 + 8 * hh; nk0[q] = *(const half8_t*)kp; nk1[q] = *(const half8_t*)(kp + 16); }
            for (int tbase = 4 * wv; tbase < ntile; tbase += 32) {
#pragma unroll
                for (int q = 0; q < 4; ++q) { kb0[q] = nk0[q]; kb1[q] = nk1[q]; }
                if (tbase + 32 < ntile) {
#pragma unroll
                    for (int q = 0; q < 4; ++q) { const int tl_ = min(tbase + 32 + q, ntile - 1); const _Float16* kp = KI + (size_t)(b * SEQ + tl_ * 32 + r32) * 32 + 8 * hh; nk0[q] = *(const half8_t*)kp; nk1[q] = *(const half8_t*)(kp + 16); }
                }
#pragma unroll
                for (int q = 0; q < 4; ++q) {
                const int tile = tbase + q;
                if (tile < ntile) {
                const half8_t b0 = kb0[q], b1 = kb1[q];
                const int key = tile * 32 + r32;
#pragma unroll
                for (int rg = 0; rg < 2; ++rg) {
                    f32x16_t c;
#pragma unroll
                    for (int i = 0; i < 16; ++i) c[i] = 0.f;
                    c = __builtin_amdgcn_mfma_f32_32x32x16_f16(a0[rg], b0, c, 0, 0, 0);
                    c = __builtin_amdgcn_mfma_f32_32x32x16_f16(a1[rg], b1, c, 0, 0, 0);
                    float x[4];
#pragma unroll
                    for (int tl = 0; tl < 4; ++tl) { x[tl] = 0.f;
#pragma unroll
                        for (int e = 0; e < 4; ++e) x[tl] = __builtin_fmaf(w[rg][tl][e], __int_as_float(max(__float_as_int(c[4 * tl + e]), 0)), x[tl]); }
                    const auto s01 = __builtin_amdgcn_permlane32_swap(__float_as_uint(x[0]), __float_as_uint(x[1]), false, false);
                    const auto s23 = __builtin_amdgcn_permlane32_swap(__float_as_uint(x[2]), __float_as_uint(x[3]), false, false);
                    const unsigned k01 = f2key(__uint_as_float(s01[0]) + __uint_as_float(s01[1]));
                    const unsigned k23 = f2key(__uint_as_float(s23[0]) + __uint_as_float(s23[1]));
                    const int rowA = 4 * rg + hh, rowB = 4 * rg + 2 + hh;
                    const bool okA = key <= t0 + rowA, okB = key <= t0 + rowB;
                    if (pass == 0) {
                        atomicAdd(&hist[okA ? rowA * 2048 + (int)(k01 >> 21) : 8 * 2048 + 16384 + 2048 + 7], 1u << (16 * ((k01 >> 20) & 1u)));
                        atomicAdd(&hist[okB ? rowB * 2048 + (int)(k23 >> 21) : 8 * 2048 + 16384 + 2048 + 7], 1u << (16 * ((k23 >> 20) & 1u)));
                    } else {
                        const int tbA = hh ? thr_bin[4 * rg + 1] : thr_bin[4 * rg], tbB = hh ? thr_bin[4 * rg + 3] : thr_bin[4 * rg + 2];
                        const int binA = (int)(k01 >> 20), binB = (int)(k23 >> 20);
                        const unsigned long long mA = __ballot(okA && binA > tbA), mB = __ballot(okB && binB > tbB);
                        if (r32 == 0) { maskl[rowA * 256 + tile] = hh ? (unsigned)(mA >> 32) : (unsigned)mA; maskl[rowB * 256 + tile] = hh ? (unsigned)(mB >> 32) : (unsigned)mB; }
                        if (okA && binA == tbA) { const int pos = atomicAdd(&misc[rowA * 8 + 2], 1); if (pos < CCAP) cand[rowA * CCAP + pos] = make_uint2(k01, (unsigned)key); }
                        if (okB && binB == tbB) { const int pos = atomicAdd(&misc[rowB * 8 + 2], 1); if (pos < CCAP) cand[rowB * CCAP + pos] = make_uint2(k23, (unsigned)key); }
                    }
                }
                }
                }
            }
            __syncthreads();
            if (pass == 0) {
                const unsigned* hr = hist + wv * 2048 + 32 * lane; unsigned tot = 0;
#pragma unroll 8
                for (int i = 0; i < 32; ++i) { const unsigned v = hr[i]; tot += (v & 0xffffu) + (v >> 16); }
                unsigned suf = tot;
#pragma unroll
                for (int o = 1; o < 64; o <<= 1) { const unsigned oth = __shfl_down(suf, o); if (lane + o < 64) suf += oth; }
                unsigned above = suf - tot;
                if ((int)above < TOPK && TOPK <= (int)(above + tot)) {
                    int bsel = 0, need = 0;
                    for (int i = 31; i >= 0; --i) { const unsigned v = hr[i]; const unsigned chi = v >> 16, clo = v & 0xffffu;
                        if ((int)above < TOPK && TOPK <= (int)(above + chi)) { bsel = 64 * lane + 2 * i + 1; need = TOPK - (int)above; above = 0x7fffffffu; }
                        else if ((int)above < TOPK) above += chi;
                        if ((int)above < TOPK && TOPK <= (int)(above + clo)) { bsel = 64 * lane + 2 * i; need = TOPK - (int)above; above = 0x7fffffffu; }
                        else if ((int)above < TOPK) above += clo; }
                    misc[wv * 8] = bsel; misc[wv * 8 + 1] = need; }
                __syncthreads();
            }
        }
        {
            const int row = wv, need0 = misc[row * 8 + 1]; const int cn = min(misc[row * 8 + 2], CCAP);
            const uint2* cr = cand + row * CCAP; unsigned* hrow = h2 + row * 256;
            unsigned prefix = 0; int remaining = need0, cnt_eq = cn;
#pragma unroll 1
            for (int pass = 0; pass < 3; ++pass) {
                const int shift = (pass == 0) ? 12 : ((pass == 1) ? 4 : 0), nb = (pass == 2) ? 4 : 8;
                for (int i = lane; i < 256; i += 64) hrow[i] = 0u;
                __builtin_amdgcn_wave_barrier(); asm volatile("s_waitcnt lgkmcnt(0)" ::: "memory");
                for (int i = lane; i < cn; i += 64) { const unsigned k = cr[i].x & 0xfffffu; if (pass == 0 || (k >> (shift + nb)) == (prefix >> (shift + nb))) atomicAdd(&hrow[(k >> shift) & ((1u << nb) - 1u)], 1u); }
                __builtin_amdgcn_wave_barrier(); asm volatile("s_waitcnt lgkmcnt(0)" ::: "memory");
                const unsigned h0 = hrow[4 * lane], h1 = hrow[4 * lane + 1], h2_ = hrow[4 * lane + 2], h3 = hrow[4 * lane + 3];
                unsigned suf = h0 + h1 + h2_ + h3;
#pragma unroll
                for (int o = 1; o < 64; o <<= 1) { const unsigned oth = __shfl_down(suf, o); if (lane + o < 64) suf += oth; }
                const unsigned above3 = suf - (h0 + h1 + h2_ + h3);
                const unsigned ab[4] = {above3 + h3 + h2_ + h1, above3 + h3 + h2_, above3 + h3, above3}; const unsigned hv[4] = {h0, h1, h2_, h3};
                int selbin = -1, newrem = 0, neweq = 0;
#pragma unroll
                for (int q = 0; q < 4; ++q) if ((int)ab[q] < remaining && remaining <= (int)(ab[q] + hv[q])) { selbin = 4 * lane + q; newrem = remaining - (int)ab[q]; neweq = (int)hv[q]; }
                const unsigned long long has = __ballot(selbin >= 0); const int src = __ffsll((long long)has) - 1;
                selbin = __shfl(selbin, src); newrem = __shfl(newrem, src); neweq = __shfl(neweq, src);
                prefix |= ((unsigned)selbin) << shift; remaining = newrem; cnt_eq = neweq;
            }
            for (int i0 = 0; i0 < cn; i0 += 64) { const int i = i0 + lane; bool sel = false;
                if (i < cn) { const uint2 ce = cr[i]; const unsigned k = ce.x & 0xfffffu;
                    if (k > prefix) sel = true;
                    else if (k == prefix) { if (cnt_eq == remaining) sel = true; else { int rank = 0; for (int j = 0; j < cn; ++j) { const uint2 cj = cr[j]; rank += ((cj.x & 0xfffffu) == prefix && cj.y < ce.y) ? 1 : 0; } sel = rank < remaining; } }
                    if (sel) atomicOr(&maskl[row * 256 + (ce.y >> 5)], 1u << (ce.y & 31)); } }
        }
        __syncthreads();
        for (int e = tid; e < 8 * nwords; e += NTHR) { const int row = e / nwords, w2 = e % nwords; MASK32[(size_t)(tq0 + row) * 256 + w2] = maskl[row * 256 + w2]; }
    }
}

__device__ void knorm_tile(const P& p, int pm, int pn) {
    bf16_t* Kg = (bf16_t*)(p.ws + WS_K); const float* kg = p.in[9];
    const int tid = otid();
    for (int pr = tid; pr < 1024; pr += NTHR) {
        const int row = pm * 256 + (pr >> 2), head = pn * 4 + (pr & 3);
        uint4* ptr = (uint4*)(Kg + (size_t)row * AW + head * 64);
        uint4 v[8]; float ss = 0.f;
#pragma unroll
        for (int c = 0; c < 8; ++c) { v[c] = ptr[c]; const unsigned w[4] = {v[c].x, v[c].y, v[c].z, v[c].w};
#pragma unroll
            for (int e = 0; e < 4; ++e) { const float a = __uint_as_float(w[e] << 16), b2 = __uint_as_float(w[e] & 0xffff0000u); ss += a * a + b2 * b2; } }
        const float rstd = rsqrtf(ss * (1.f / 64.f) + NORM_EPS);
#pragma unroll
        for (int c = 0; c < 8; ++c) { const unsigned w[4] = {v[c].x, v[c].y, v[c].z, v[c].w}; unsigned o[4];
            const float4 g0 = *(const float4*)(kg + 8 * c), g1 = *(const float4*)(kg + 8 * c + 4); const float gv[8] = {g0.x, g0.y, g0.z, g0.w, g1.x, g1.y, g1.z, g1.w};
#pragma unroll
            for (int e = 0; e < 4; ++e) o[e] = pk2(__uint_as_float(w[e] << 16) * rstd * gv[2 * e], __uint_as_float(w[e] & 0xffff0000u) * rstd * gv[2 * e + 1]);
            ptr[c] = make_uint4(o[0], o[1], o[2], o[3]); }
    }
}
typedef unsigned u32x4_t __attribute__((ext_vector_type(4)));
__device__ __forceinline__ bf16x8_t pack_step16(const f32x16_t& x, int s2) {
    u32x4_t pk;
    if (s2 == 0) { pk[0] = pk_bf16(x[0], x[1]); pk[1] = pk_bf16(x[2], x[3]); pk[2] = pk_bf16(x[4], x[5]); pk[3] = pk_bf16(x[6], x[7]); }
    else { pk[0] = pk_bf16(x[8], x[9]); pk[1] = pk_bf16(x[10], x[11]); pk[2] = pk_bf16(x[12], x[13]); pk[3] = pk_bf16(x[14], x[15]); }
    return __builtin_bit_cast(bf16x8_t, pk);
}
__device__ __forceinline__ float xhalf_max(float x) { const auto t = __builtin_amdgcn_permlane32_swap(__float_as_uint(x), __float_as_uint(x), false, false); return fmaxf(__uint_as_float(t[0]), __uint_as_float(t[1])); }
__device__ __forceinline__ float xhalf_sum(float x) { const auto t = __builtin_amdgcn_permlane32_swap(__float_as_uint(x), __float_as_uint(x), false, false); return __uint_as_float(t[0]) + __uint_as_float(t[1]); }
__device__ __forceinline__ short bf16_of_int(int v) { return (short)(__float_as_uint((float)v) >> 16); }
#define MFMA32(a, b, c) __builtin_amdgcn_mfma_f32_32x32x16_bf16((a), (b), (c), 0, 0, 0)
__device__ void ph_dsa_attn(const P& p, float* ldsf) {
    const unsigned long long* MASK = (const unsigned long long*)(p.ws + WS_MASK);
    const bf16_t* Q = (const bf16_t*)(p.ws + WS_Q); const bf16_t* Kg = (const bf16_t*)(p.ws + WS_K); const bf16_t* VT = (const bf16_t*)(p.ws + WS_V);
    bf16_t* O = (bf16_t*)(p.ws + WS_OATT);
    bf16_t* L = (bf16_t*)ldsf;
    const int tid = otid(), lane = tid & 63, wv = tid >> 6, hh = lane >> 5, r32 = lane & 31;
    const float CS = 0.125f * 1.4426950408889634f;
    const float NEG = -1e30f;
    const int skey = tid >> 3, sch = (tid & 7) * 8;
    const float* qg = p.in[8];
    int* qhead = (int*)(p.ws + WS_CTL) + CT_Q; int* bcast = (int*)(L + 4 * SLOT);
    for (int tr_ = 0; tr_ < 8; ++tr_) {
        const int grp = (blockIdx.x + tr_) & 7;
        for (;;) {
            __syncthreads();
            if (tid == 0) *bcast = atomicAdd(qhead + grp, 1);
            __syncthreads();
            const int kq = *bcast;
            if (kq >= 64) break;
            const int bh = grp + 8 * (kq & 1), qb = 31 - (kq >> 1), b = bh >> 3, h = bh & 7;
            const bf16_t* Kbase = Kg + (size_t)b * SEQ * AW + h * 64; const bf16_t* Vbase = VT + (size_t)bh * 64 * SEQ;
            {
            const int q0 = qb * 256 + wv * 32, q = q0 + r32, ntile = 4 * (qb + 1);
            const size_t qrow = (size_t)b * SEQ + q;
            bf16x8_t bq[5];
#pragma unroll
            for (int s2 = 0; s2 < 4; ++s2) bq[s2] = *(const bf16x8_t*)(Q + qrow * AW + h * 64 + 16 * s2 + 8 * hh);
            {
                float ss = 0.f;
#pragma unroll
                for (int s2 = 0; s2 < 4; ++s2)
#pragma unroll
                    for (int j = 0; j < 8; ++j) { const float v = bf2f((bf16_t)bq[s2][j]); ss += v * v; }
                ss = xhalf_sum(ss);
                const float rstd = rsqrtf(ss * (1.f / 64.f) + NORM_EPS);
#pragma unroll
                for (int s2 = 0; s2 < 4; ++s2) { const float4 g0 = *(const float4*)(qg + 16 * s2 + 8 * hh), g1 = *(const float4*)(qg + 16 * s2 + 8 * hh + 4); const float gv[8] = {g0.x, g0.y, g0.z, g0.w, g1.x, g1.y, g1.z, g1.w};
                    u32x4_t w;
#pragma unroll
                    for (int j2 = 0; j2 < 4; ++j2) w[j2] = pk_bf16(bf2f((bf16_t)bq[s2][2 * j2]) * rstd * gv[2 * j2], bf2f((bf16_t)bq[s2][2 * j2 + 1]) * rstd * gv[2 * j2 + 1]);
                    bq[s2] = __builtin_bit_cast(bf16x8_t, w); }
            }
#pragma unroll
            for (int j = 0; j < 8; ++j) bq[4][j] = 0;
            if (hh == 0) { bq[4][0] = bf16_of_int(256 >> h); bq[4][1] = (short)(__float_as_uint(4.f / (float)(1 << h)) >> 16); }
            f32x16_t o0, o1;
#pragma unroll
            for (int i = 0; i < 16; ++i) { o0[i] = 0.f; o1[i] = 0.f; }
            float m_run = NEG, l_run = 0.f;
            __syncthreads();
            { const uint4 kr = *(const uint4*)(Kbase + (size_t)skey * AW + sch), vr = *(const uint4*)(Vbase + (size_t)skey * SEQ + sch);
              *(uint4*)(L + skey * LP + sch) = kr; *(uint4*)(L + 2 * SLOT + skey * LP + sch) = vr; }
            unsigned long long mw = MASK[qrow * 128];
            __syncthreads();
#pragma unroll 1
            for (int kt = 0; kt < ntile; ++kt) {
                const int buf = kt & 1; const bool more = kt + 1 < ntile;
                uint4 kr = make_uint4(0, 0, 0, 0), vr = make_uint4(0, 0, 0, 0); unsigned long long mwn = 0ull;
                if (more) { kr = *(const uint4*)(Kbase + (size_t)((kt + 1) * 64 + skey) * AW + sch); vr = *(const uint4*)(Vbase + (size_t)skey * SEQ + (kt + 1) * 64 + sch); mwn = MASK[qrow * 128 + kt + 1]; }
                if (kt * 64 <= q0 + 31) {
                    const bf16_t* Kl = L + buf * SLOT; const bf16_t* Vl = L + (2 + buf) * SLOT;
                    f32x16_t p0, p1;
#pragma unroll
                    for (int i = 0; i < 16; ++i) { p0[i] = 0.f; p1[i] = 0.f; }
#pragma unroll
                    for (int s2 = 0; s2 < 4; ++s2) {
                        const bf16x8_t a0 = *(const bf16x8_t*)(Kl + r32 * LP + 16 * s2 + 8 * hh), a1 = *(const bf16x8_t*)(Kl + (32 + r32) * LP + 16 * s2 + 8 * hh);
                        p0 = MFMA32(a0, bq[s2], p0); p1 = MFMA32(a1, bq[s2], p1);
                    }
                    { bf16x8_t g0, g1;
#pragma unroll
                      for (int j = 0; j < 8; ++j) { g0[j] = 0; g1[j] = 0; }
                      if (hh == 0) { g0[0] = bf16_of_int(kt); g0[1] = bf16_of_int(r32); g1[0] = g0[0]; g1[1] = bf16_of_int(32 + r32); }
                      p0 = MFMA32(g0, bq[4], p0); p1 = MFMA32(g1, bq[4], p1); }
                    const unsigned wl = (unsigned)mw >> (4 * hh), wh = (unsigned)(mw >> 32) >> (4 * hh);
                    float mx = NEG;
#pragma unroll
                    for (int i = 0; i < 16; ++i) { const int bp = (i & 3) + 8 * (i >> 2);
                        const int m0 = __builtin_amdgcn_sbfe((int)wl, bp, 1), m1 = __builtin_amdgcn_sbfe((int)wh, bp, 1);
                        const float a_ = __uint_as_float((__float_as_uint(p0[i]) & (unsigned)m0) | (__float_as_uint(NEG) & ~(unsigned)m0));
                        const float b_ = __uint_as_float((__float_as_uint(p1[i]) & (unsigned)m1) | (__float_as_uint(NEG) & ~(unsigned)m1));
                        p0[i] = a_; p1[i] = b_;
                        mx = __builtin_fmaxf(mx, __builtin_fmaxf(a_, b_)); }
                    mx = xhalf_max(mx);
                    const float m_new = fmaxf(m_run, mx);
                    const float alpha = __builtin_amdgcn_exp2f((m_run - m_new) * CS);
                    m_run = m_new;
                    const float mc = fmaxf(m_new, -1e20f) * CS;
                    float rs = 0.f;
#pragma unroll
                    for (int i = 0; i < 16; ++i) { p0[i] = __builtin_amdgcn_exp2f(p0[i] * CS - mc); p1[i] = __builtin_amdgcn_exp2f(p1[i] * CS - mc); rs += p0[i] + p1[i]; }
                    l_run = l_run * alpha + rs;
#pragma unroll
                    for (int i = 0; i < 16; ++i) { o0[i] *= alpha; o1[i] *= alpha; }
                    bf16x8_t pb[4];
                    pb[0] = pack_step16(p0, 0); pb[1] = pack_step16(p0, 1); pb[2] = pack_step16(p1, 0); pb[3] = pack_step16(p1, 1);
#pragma unroll
                    for (int ks = 0; ks < 4; ++ks) {
                        const int kofs = 32 * (ks >> 1) + 16 * (ks & 1) + 4 * hh;
                        typedef short s16x4_t __attribute__((ext_vector_type(4)));
                        const s16x4_t v00 = *(const s16x4_t*)(Vl + r32 * LP + kofs), v01 = *(const s16x4_t*)(Vl + r32 * LP + kofs + 8);
                        const s16x4_t v10 = *(const s16x4_t*)(Vl + (32 + r32) * LP + kofs), v11 = *(const s16x4_t*)(Vl + (32 + r32) * LP + kofs + 8);
                        bf16x8_t av0, av1;
#pragma unroll
                        for (int j = 0; j < 4; ++j) { av0[j] = v00[j]; av0[4 + j] = v01[j]; av1[j] = v10[j]; av1[4 + j] = v11[j]; }
                        o0 = MFMA32(av0, pb[ks], o0); o1 = MFMA32(av1, pb[ks], o1);
                    }
                }
                if (more) { *(uint4*)(L + (buf ^ 1) * SLOT + skey * LP + sch) = kr; *(uint4*)(L + (2 + (buf ^ 1)) * SLOT + skey * LP + sch) = vr; }
                mw = mwn;
                __syncthreads();
            }
            const float inv = 1.f / xhalf_sum(l_run);
            bf16_t* orow = O + qrow * AW + h * 64 + 4 * hh;
#pragma unroll
            for (int g = 0; g < 4; ++g) {
                uint2 w0, w1;
                w0.x = (unsigned)f2bf(o0[4 * g] * inv) | ((unsigned)f2bf(o0[4 * g + 1] * inv) << 16); w0.y = (unsigned)f2bf(o0[4 * g + 2] * inv) | ((unsigned)f2bf(o0[4 * g + 3] * inv) << 16);
                w1.x = (unsigned)f2bf(o1[4 * g] * inv) | ((unsigned)f2bf(o1[4 * g + 1] * inv) << 16); w1.y = (unsigned)f2bf(o1[4 * g + 2] * inv) | ((unsigned)f2bf(o1[4 * g + 3] * inv) << 16);
                *(uint2*)(orow + 8 * g) = w0; *(uint2*)(orow + 32 + 8 * g) = w1;
            }
            }
        }
    }
}

constexpr int AP = 328, RP = 1544;
__device__ __forceinline__ f32x4_t mm16(const bf16_t* X, int xrs, const bf16_t* Y, int ycs, int nks, f32x4_t acc, int lane) {
    const int r = lane & 15, q = lane >> 4;
    for (int s2 = 0; s2 < nks; ++s2) {
        const bf16x8_t a = *(const bf16x8_t*)(X + r * xrs + 32 * s2 + 8 * q), b = *(const bf16x8_t*)(Y + r * ycs + 32 * s2 + 8 * q);
        acc = __builtin_amdgcn_mfma_f32_16x16x32_bf16(a, b, acc, 0, 0, 0);
    }
    return acc;
}
__device__ void ph_rwkv_prep(const P& p, float* ldsf, int blk_first, int blk_end, int blk_step) {
    const bf16_t* PS = (const bf16_t*)(p.ws + WS_PS);
    const float* mu = p.in[10]; const float* w0 = p.in[11]; const float* a0 = p.in[13]; const float* k_k = p.in[16]; const float* k_a = p.in[17];
    const bf16_t* W2T = (const bf16_t*)(p.ws + WS_LW2T); const bf16_t* A2T = (const bf16_t*)(p.ws + WS_LA2T); const bf16_t* G2T = (const bf16_t*)(p.ws + WS_LG2T);
    bf16_t* R = (bf16_t*)(p.ws + WS_R); bf16_t* K2 = (bf16_t*)(p.ws + WS_K2); bf16_t* VV = (bf16_t*)(p.ws + WS_VV); bf16_t* KK = (bf16_t*)(p.ws + WS_KK); bf16_t* BB = (bf16_t*)(p.ws + WS_BB);
    bf16_t* G = (bf16_t*)(p.ws + WS_G); float* DD = (float*)(p.ws + WS_DD);
    bf16_t* Amix = (bf16_t*)ldsf; bf16_t* RKV = Amix + 32 * AP;
    const int tid = otid(), lane = tid & 63, wv = tid >> 6, l15 = lane & 15, q4 = lane >> 4;
    for (int blk = blk_first; blk < blk_end; blk += blk_step) {
        const int m0 = blk * 32;
        __syncthreads();
#pragma unroll 3
        for (int ch = tid; ch < 32 * 228; ch += NTHR) {
            const int tk = ch / 228, c8 = (ch % 228) * 8, m = m0 + tk;
            const uint4 cu = *(const uint4*)(PS + (size_t)m * SHW + c8);
            uint4 pv = make_uint4(0, 0, 0, 0); if (m % SEQ) pv = *(const uint4*)(PS + (size_t)(m - 1) * SHW + c8);
            const unsigned cw[4] = {cu.x, cu.y, cu.z, cu.w}, pw[4] = {pv.x, pv.y, pv.z, pv.w};
            const float4 mu0 = *(const float4*)(mu + c8), mu1 = *(const float4*)(mu + c8 + 4); const float muv[8] = {mu0.x, mu0.y, mu0.z, mu0.w, mu1.x, mu1.y, mu1.z, mu1.w};
            float mx[8];
#pragma unroll
            for (int e = 0; e < 8; ++e) { const float c_ = (e & 1) ? __uint_as_float(cw[e >> 1] & 0xffff0000u) : __uint_as_float(cw[e >> 1] << 16), p_ = (e & 1) ? __uint_as_float(pw[e >> 1] & 0xffff0000u) : __uint_as_float(pw[e >> 1] << 16);
                mx[e] = c_ + (p_ - c_) * muv[e]; }
            bf16_t* dst;
            if (c8 < 1536) dst = RKV + tk * RP + c8;
            else { const int col = c8 - 1536; dst = Amix + tk * AP + col;
#pragma unroll
                for (int e = 0; e < 8; ++e) mx[e] = (col < 64) ? (1.f - 2.f * __builtin_amdgcn_rcpf(__expf(2.f * mx[e]) + 1.f)) : ((col < 128) ? mx[e] : sigmoidf_(mx[e])); }
            *(uint4*)dst = make_uint4(pk2(mx[0], mx[1]), pk2(mx[2], mx[3]), pk2(mx[4], mx[5]), pk2(mx[6], mx[7]));
        }
        if (tid < 128) *(uint4*)(Amix + (tid >> 2) * AP + 288 + (tid & 3) * 8) = make_uint4(0, 0, 0, 0);
        __syncthreads();
        const int h = wv;
#pragma unroll 1
        for (int rt = 0; rt < 2; ++rt) {
            f32x4_t aw[4], aa[4], ag[4];
            {
                const f32x4_t z4 = {0.f, 0.f, 0.f, 0.f};
                const bf16_t* xr = Amix + (16 * rt + l15) * AP + 8 * q4;
#pragma unroll
                for (int ct = 0; ct < 4; ++ct) { const int cb = 64 * h + 16 * ct;
                    bf16x8_t fw[2], fa[2], fg[6];
                    { const bf16_t* yw = W2T + (size_t)(cb + l15) * 64 + 8 * q4; const bf16_t* ya = A2T + (size_t)(cb + l15) * 64 + 8 * q4; const bf16_t* yg = G2T + (size_t)(cb + l15) * 192 + 8 * q4;
#pragma unroll
                      for (int s2 = 0; s2 < 2; ++s2) { fw[s2] = *(const bf16x8_t*)(yw + 32 * s2); fa[s2] = *(const bf16x8_t*)(ya + 32 * s2); }
#pragma unroll
                      for (int s2 = 0; s2 < 6; ++s2) fg[s2] = *(const bf16x8_t*)(yg + 32 * s2); }
                    f32x4_t cw = z4, ca = z4, cg = z4;
#pragma unroll
                    for (int s2 = 0; s2 < 2; ++s2) { cw = __builtin_amdgcn_mfma_f32_16x16x32_bf16(fw[s2], *(const bf16x8_t*)(xr + 32 * s2), cw, 0, 0, 0); ca = __builtin_amdgcn_mfma_f32_16x16x32_bf16(fa[s2], *(const bf16x8_t*)(xr + 64 + 32 * s2), ca, 0, 0, 0); }
#pragma unroll
                    for (int s2 = 0; s2 < 6; ++s2) cg = __builtin_amdgcn_mfma_f32_16x16x32_bf16(fg[s2], *(const bf16x8_t*)(xr + 128 + 32 * s2), cg, 0, 0, 0);
                    aw[ct] = cw; aa[ct] = ca; ag[ct] = cg; }
            }
            const int tk = 16 * rt + l15;
            float ss = 0.f; float kkr[4][4];
#pragma unroll
            for (int ct = 0; ct < 4; ++ct) { const int c0 = 64 * h + 16 * ct + 4 * q4; const float4 kkc = *(const float4*)(k_k + c0);
                const uint2 kw = *(const uint2*)(RKV + tk * RP + 512 + c0);
                kkr[ct][0] = __uint_as_float(kw.x << 16) * kkc.x; kkr[ct][1] = __uint_as_float(kw.x & 0xffff0000u) * kkc.y; kkr[ct][2] = __uint_as_float(kw.y << 16) * kkc.z; kkr[ct][3] = __uint_as_float(kw.y & 0xffff0000u) * kkc.w;
#pragma unroll
                for (int e = 0; e < 4; ++e) ss += kkr[ct][e] * kkr[ct][e]; }
            ss += __shfl_xor(ss, 16); ss += __shfl_xor(ss, 32);
            const float rn = __builtin_amdgcn_rcpf(fmaxf(sqrtf(ss), 1e-12f));
#pragma unroll
            for (int ct = 0; ct < 4; ++ct) { const int c0 = 64 * h + 16 * ct + 4 * q4;
                const float4 w0c = *(const float4*)(w0 + c0), a0c = *(const float4*)(a0 + c0), kac = *(const float4*)(k_a + c0);
                const float w0v[4] = {w0c.x, w0c.y, w0c.z, w0c.w}, a0v[4] = {a0c.x, a0c.y, a0c.z, a0c.w}, kav[4] = {kac.x, kac.y, kac.z, kac.w};
                const uint2 rw2 = *(const uint2*)(RKV + tk * RP + c0), kw2 = *(const uint2*)(RKV + tk * RP + 512 + c0), vw2 = *(const uint2*)(RKV + tk * RP + 1024 + c0);
                const float kf[4] = {__uint_as_float(kw2.x << 16), __uint_as_float(kw2.x & 0xffff0000u), __uint_as_float(kw2.y << 16), __uint_as_float(kw2.y & 0xffff0000u)};
                float k2v[4], kkv[4], bbv[4], ddv[4];
#pragma unroll
                for (int e = 0; e < 4; ++e) {
                    const float xw = -(w0v[e] + aw[ct][e]);
                    const float sp = fmaxf(xw, 0.f) + __logf(1.f + __expf(-fabsf(xw)));
                    const float w = -sp - 0.5f;
                    const float a = sigmoidf_(a0v[e] + aa[ct][e]);
                    kkv[e] = kkr[ct][e] * rn; bbv[e] = kkv[e] * a; k2v[e] = kf[e] * (1.f + (a - 1.f) * kav[e]); ddv[e] = -__expf(w);
                }
                const size_t o = (size_t)(m0 + tk) * RW + c0;
                *(uint2*)(R + o) = rw2; *(uint2*)(VV + o) = vw2;
                *(uint2*)(K2 + o) = make_uint2(pk2(k2v[0], k2v[1]), pk2(k2v[2], k2v[3])); *(uint2*)(KK + o) = make_uint2(pk2(kkv[0], kkv[1]), pk2(kkv[2], kkv[3]));
                *(uint2*)(BB + o) = make_uint2(pk2(bbv[0], bbv[1]), pk2(bbv[2], bbv[3])); *(uint2*)(G + o) = make_uint2(pk2(ag[ct][0], ag[ct][1]), pk2(ag[ct][2], ag[ct][3]));
                *(float4*)(DD + o) = make_float4(ddv[0], ddv[1], ddv[2], ddv[3]);
            }
        }
    }
}

template <bool XC, bool YC>
__device__ __forceinline__ f32x4_t mm_tile(const bf16_t* X, int xrs, int xcs, const bf16_t* Y, int yrs, int ycs, int tr, int tc, f32x4_t acc, int lane) {
    const int r = lane & 15, q = lane >> 4;
#pragma unroll
    for (int s2 = 0; s2 < 2; ++s2) {
        bf16x8_t a, b;
        const bf16_t* xp = X + (16 * tr + r) * xrs + (32 * s2 + 8 * q) * xcs;
        if (XC) a = *(const bf16x8_t*)xp; else {
#pragma unroll
            for (int j = 0; j < 8; ++j) a[j] = (short)xp[j * xcs]; }
        const bf16_t* yp = Y + (32 * s2 + 8 * q) * yrs + (16 * tc + r) * ycs;
        if (YC) b = *(const bf16x8_t*)yp; else {
#pragma unroll
            for (int j = 0; j < 8; ++j) b[j] = (short)yp[j * yrs]; }
        acc = __builtin_amdgcn_mfma_f32_16x16x32_bf16(a, b, acc, 0, 0, 0);
    }
    return acc;
}
__device__ __forceinline__ void st_tile(const f32x4_t& acc, bf16_t* D, int drs, int dcs, int tr, int tc, int lane) {
    const int row0 = 16 * tr + 4 * (lane >> 4), col = 16 * tc + (lane & 15);
#pragma unroll
    for (int e = 0; e < 4; ++e) D[(row0 + e) * drs + col * dcs] = f2bf(acc[e]);
}
__device__ __forceinline__ f32x4_t ld_tile(const bf16_t* D, int drs, int dcs, int tr, int tc, int lane) {
    const int row0 = 16 * tr + 4 * (lane >> 4), col = 16 * tc + (lane & 15); f32x4_t v;
#pragma unroll
    for (int e = 0; e < 4; ++e) v[e] = bf2f(D[(row0 + e) * drs + col * dcs]);
    return v;
}
template <bool STRICT> __device__ __forceinline__ void triu_tile(f32x4_t& acc, int tr, int tc, int lane) {
    const int row0 = 16 * tr + 4 * (lane >> 4), col = 16 * tc + (lane & 15);
#pragma unroll
    for (int e = 0; e < 4; ++e) { const bool keep = STRICT ? (row0 + e < col) : (row0 + e <= col); acc[e] = keep ? acc[e] : 0.f; }
}

__device__ void ph_rwkv_r1(const P& p, float* ldsf, int ch_first, int ch_end, int ch_step) {
    const bf16_t* R = (const bf16_t*)(p.ws + WS_R); const bf16_t* K2 = (const bf16_t*)(p.ws + WS_K2); const bf16_t* VV = (const bf16_t*)(p.ws + WS_VV);
    const bf16_t* KK = (const bf16_t*)(p.ws + WS_KK); const bf16_t* BB = (const bf16_t*)(p.ws + WS_BB); const float* DD = (const float*)(p.ws + WS_DD);
    bf16_t* L = (bf16_t*)ldsf;
    bf16_t* At = L + 0 * SLOT; bf16_t* AtT = L + 1 * SLOT; bf16_t* Bt = L + 2 * SLOT; bf16_t* Kt = L + 3 * SLOT; bf16_t* Rt = L + 4 * SLOT; bf16_t* BhT = L + 5 * SLOT; bf16_t* Kh = L + 6 * SLOT;
    bf16_t* S7 = L + 7 * SLOT; bf16_t* S8 = L + 8 * SLOT; bf16_t* S9 = L + 9 * SLOT; bf16_t* Mka = L + 10 * SLOT; bf16_t* NbrT = L + 11 * SLOT; bf16_t* Nkr = L + 12 * SLOT;
    float* cs = (float*)(L + 13 * SLOT);
    float* segs = cs + 64 * 64;
    float* gLs = segs + 8 * 64;
    const int tid = otid(), lane = tid & 63, wv = tid >> 6;
    const int t0 = 2 * wv, t1 = 2 * wv + 1;
    for (int ch = ch_first; ch < ch_end; ch += ch_step) {
        const int bh = ch >> 7, c = ch & 127, b = bh >> 3, h = bh & 7;
        const size_t gbase = ((size_t)b * SEQ + (size_t)c * 64) * RW + h * 64;
        bf16_t* G1T = (bf16_t*)(p.ws + WS_KK) + gbase; bf16_t* PT = (bf16_t*)(p.ws + WS_BB) + gbase; bf16_t* G2T = (bf16_t*)(p.ws + WS_DD) + 2 * gbase; bf16_t* QT = G2T + 64;
        __syncthreads();
        const int st = tid >> 3, sj = (tid & 7) * 8;
        const uint4 vraw = *(const uint4*)(VV + gbase + (size_t)st * RW + sj);
        const uint4 rr = *(const uint4*)(R + gbase + (size_t)st * RW + sj), kr = *(const uint4*)(K2 + gbase + (size_t)st * RW + sj);
        const uint4 kkr = *(const uint4*)(KK + gbase + (size_t)st * RW + sj), br = *(const uint4*)(BB + gbase + (size_t)st * RW + sj);
        { const float4 l0 = *(const float4*)(DD + gbase + (size_t)st * RW + sj), l1 = *(const float4*)(DD + gbase + (size_t)st * RW + sj + 4);
          float* d = cs + st * 64 + sj; *(float4*)d = l0; *(float4*)(d + 4) = l1; }
        __syncthreads();
        { const int j = tid & 63, sg = tid >> 6; float run = 0.f;
#pragma unroll
          for (int i = 0; i < 8; ++i) { run += cs[(sg * 8 + i) * 64 + j]; }
          segs[sg * 64 + j] = run; }
        __syncthreads();
        { const int j = tid & 63, sg = tid >> 6; float run = 0.f;
          for (int q = 0; q < sg; ++q) run += segs[q * 64 + j];
#pragma unroll
          for (int i = 0; i < 8; ++i) { run += cs[(sg * 8 + i) * 64 + j]; cs[(sg * 8 + i) * 64 + j] = run; }
          if (sg == 7) gLs[j] = __expf(run); }
        __syncthreads();
        {
            const unsigned rw_[4] = {rr.x, rr.y, rr.z, rr.w}, kw_[4] = {kr.x, kr.y, kr.z, kr.w}, kkw_[4] = {kkr.x, kkr.y, kkr.z, kkr.w}, bw_[4] = {br.x, br.y, br.z, br.w};
            unsigned oa[4], ob[4], ok[4], orr[4], okh[4];
#pragma unroll
            for (int e2 = 0; e2 < 4; ++e2) {
                float va[2], vb[2], vk[2], vr2[2], vbh[2], vkh[2];
#pragma unroll
                for (int hf = 0; hf < 2; ++hf) {
                    const int j = sj + 2 * e2 + hf;
                    const float lgI = cs[st * 64 + j], lgE = st ? cs[(st - 1) * 64 + j] : 0.f, gl = cs[63 * 64 + j];
                    const float rv = hf ? __uint_as_float(rw_[e2] & 0xffff0000u) : __uint_as_float(rw_[e2] << 16);
                    const float kv = hf ? __uint_as_float(kw_[e2] & 0xffff0000u) : __uint_as_float(kw_[e2] << 16);
                    const float kkv = hf ? __uint_as_float(kkw_[e2] & 0xffff0000u) : __uint_as_float(kkw_[e2] << 16);
                    const float bv = hf ? __uint_as_float(bw_[e2] & 0xffff0000u) : __uint_as_float(bw_[e2] << 16);
                    const float einv = __expf(-lgI), eh = __expf(gl - lgI);
                    va[hf] = -kkv * __expf(lgE); vb[hf] = bv * einv; vk[hf] = kv * einv; vr2[hf] = rv * __expf(lgI); vbh[hf] = bv * eh; vkh[hf] = kv * eh;
                    AtT[j * LP + st] = f2bf(va[hf]); BhT[j * LP + st] = f2bf(vbh[hf]);
                }
                oa[e2] = pk2(va[0], va[1]); ob[e2] = pk2(vb[0], vb[1]); ok[e2] = pk2(vk[0], vk[1]); orr[e2] = pk2(vr2[0], vr2[1]); okh[e2] = pk2(vkh[0], vkh[1]);
            }
            *(uint4*)(At + st * LP + sj) = make_uint4(oa[0], oa[1], oa[2], oa[3]); *(uint4*)(Bt + st * LP + sj) = make_uint4(ob[0], ob[1], ob[2], ob[3]);
            *(uint4*)(Kt + st * LP + sj) = make_uint4(ok[0], ok[1], ok[2], ok[3]); *(uint4*)(Rt + st * LP + sj) = make_uint4(orr[0], orr[1], orr[2], orr[3]);
            *(uint4*)(Kh + st * LP + sj) = make_uint4(okh[0], okh[1], okh[2], okh[3]);
        }
        __syncthreads();
#define R1_FOR_TILES(idx, tr, tc) _Pragma("unroll") for (int _q = 0; _q < 2; ++_q) { const int idx = _q ? t1 : t0; const int tr = idx >> 2, tc = idx & 3;
#define R1_END }
#define MMF(X, Y, acc) mm_tile<true, true>((X), LP, 1, (Y), 1, LP, tr, tc, (acc), lane)
        const f32x4_t zero4 = {0.f, 0.f, 0.f, 0.f};
        R1_FOR_TILES(idx, tr, tc)
            f32x4_t mab = MMF(Bt, At, zero4); triu_tile<true>(mab, tr, tc, lane); st_tile(mab, S7, LP, 1, tr, tc, lane); st_tile(mab, S8, 1, LP, tr, tc, lane);
            { f32x4_t tt = mab; const int row0 = 16 * tr + 4 * (lane >> 4), col = 16 * tc + (lane & 15);
#pragma unroll
              for (int e = 0; e < 4; ++e) tt[e] += (row0 + e == col) ? 1.f : 0.f;
              st_tile(tt, S9, LP, 1, tr, tc, lane); }
            f32x4_t mka = MMF(Kt, At, zero4); triu_tile<true>(mka, tr, tc, lane); st_tile(mka, Mka, LP, 1, tr, tc, lane);
            f32x4_t nbr = MMF(Bt, Rt, zero4); triu_tile<false>(nbr, tr, tc, lane); st_tile(nbr, NbrT, 1, LP, tr, tc, lane);
            f32x4_t nkr = MMF(Kt, Rt, zero4); triu_tile<false>(nkr, tr, tc, lane); st_tile(nkr, Nkr, LP, 1, tr, tc, lane);
        R1_END
        __syncthreads();
        bf16_t* VmT = At;
        { const unsigned vw_[4] = {vraw.x, vraw.y, vraw.z, vraw.w};
#pragma unroll
          for (int e = 0; e < 8; ++e) VmT[(sj + e) * LP + st] = (bf16_t)((e & 1) ? (vw_[e >> 1] >> 16) : (vw_[e >> 1] & 0xffffu)); }
        bf16_t* Pc = S7; bf16_t* PcT = S8; bf16_t* Pn = Bt; bf16_t* PnT = Kt; bf16_t* Tc = S9; bf16_t* Tn = (bf16_t*)cs; bf16_t* TT = nullptr;
#pragma unroll 1
        for (int k = 1; k <= 6; ++k) {
            R1_FOR_TILES(idx, tr, tc)
                if (k <= 5) { f32x4_t pp = MMF(Pc, PcT, zero4); st_tile(pp, Pn, LP, 1, tr, tc, lane); st_tile(pp, PnT, 1, LP, tr, tc, lane); }
                if (k >= 2) { f32x4_t tn = ld_tile(Tc, LP, 1, tr, tc, lane); tn = MMF(Tc, PcT, tn); st_tile(tn, Tn, LP, 1, tr, tc, lane);
                    if (k == 6) st_tile(tn, Pn, 1, LP, tr, tc, lane); }
            R1_END
            __syncthreads();
            if (k == 6) TT = Pn;
            if (k <= 5) { bf16_t* x_ = Pc; Pc = Pn; Pn = x_; x_ = PcT; PcT = PnT; PnT = x_; }
            if (k >= 2) { bf16_t* x_ = Tc; Tc = Tn; Tn = x_; }
        }
        bf16_t* W1 = Pc; bf16_t* W2 = PcT; bf16_t* QkT = PnT;
        bf16_t* Og1 = Tn; bf16_t* Og2 = Tc; bf16_t* Opt = TT; bf16_t* Oqt = W1;
        R1_FOR_TILES(idx, tr, tc)
            f32x4_t w1 = MMF(AtT, TT, zero4); st_tile(w1, W1, LP, 1, tr, tc, lane);
            f32x4_t w2 = MMF(Mka, TT, zero4); st_tile(w2, W2, LP, 1, tr, tc, lane);
        R1_END
        __syncthreads();
        R1_FOR_TILES(idx, tr, tc)
            f32x4_t g1 = ld_tile(Rt, 1, LP, tr, tc, lane); g1 = MMF(W1, NbrT, g1); st_tile(g1, Og1, 1, LP, tr, tc, lane);
            f32x4_t g2 = ld_tile(Nkr, LP, 1, tr, tc, lane); g2 = MMF(W2, NbrT, g2); st_tile(g2, Og2, 1, LP, tr, tc, lane);
            f32x4_t pm = MMF(W1, BhT, zero4);
            { const int row0 = 16 * tr + 4 * (lane >> 4), col = 16 * tc + (lane & 15);
#pragma unroll
              for (int e = 0; e < 4; ++e) pm[e] += (row0 + e == col) ? gLs[col] : 0.f; }
            st_tile(pm, Opt, 1, LP, tr, tc, lane);
            f32x4_t qk = ld_tile(Kh, LP, 1, tr, tc, lane); qk = MMF(W2, BhT, qk); st_tile(qk, QkT, 1, LP, tr, tc, lane);
        R1_END
        __syncthreads();
        {
            const int row = tid >> 3, ch8 = (tid & 7) * 8;
            *(uint4*)(G1T + (size_t)row * RW + ch8) = *(const uint4*)(Og1 + row * LP + ch8);
            *(uint4*)(G2T + (size_t)row * (2 * RW) + ch8) = *(const uint4*)(Og2 + row * LP + ch8);
            *(uint4*)(PT + (size_t)row * RW + ch8) = *(const uint4*)(Opt + row * LP + ch8);
        }
        R1_FOR_TILES(idx, tr, tc)
            f32x4_t qt = MMF(QkT, VmT, zero4);
            { const int row0 = 16 * tr + 4 * (lane >> 4), col = 16 * tc + (lane & 15);
#pragma unroll
              for (int e = 0; e < 4; ++e) { const int jp = row0 + e; const int ci = ((jp >> 5) * 2 + (col >> 5)) * 64 + (col & 31) + 32 * ((jp >> 2) & 1);
                Oqt[ci * 16 + (jp & 3) + 4 * ((jp & 31) >> 3)] = f2bf(qt[e]); } }
        R1_END
        __syncthreads();
        { const int ci = tid >> 1, hf = tid & 1;
          *(uint4*)(QT + (size_t)(ci >> 2) * (2 * RW) + (ci & 3) * 16 + hf * 8) = *(const uint4*)(Oqt + ci * 16 + hf * 8); }
#undef MMF
    }
}
__device__ void ph_rwkv_prep_r1(const P& p, float* ldsf) {
    for (int b64 = blockIdx.x; b64 < NT / 64; b64 += gridDim.x) {
        ph_rwkv_prep(p, ldsf, 2 * b64, 2 * b64 + 2, 1);
        __syncthreads();
        const int b = b64 >> 7, c = b64 & 127, ch0 = (b * 8) * 128 + c;
        ph_rwkv_r1(p, ldsf, ch0, ch0 + 8 * 128, 128);
    }
}
__device__ void ph_rwkv_r2(const P& p, int bh_first, int bh_end, int bh_step) {
    bf16_t* SX = (bf16_t*)(p.ws + WS_SX);
    const int tid = otid(), lane = tid & 63, wv = tid >> 6, hh = lane >> 5, r32 = lane & 31;
    typedef short s16x4_t __attribute__((ext_vector_type(4)));
    for (int bh = bh_first; bh < bh_end; bh += bh_step) {
        if (wv >= 2) continue;
        const int cb = wv;
        f32x16_t x0, x1;
#pragma unroll
        for (int i = 0; i < 16; ++i) { x0[i] = 0.f; x1[i] = 0.f; }
        bf16x8_t pa[2][4]; uint4 qa[2][2];
#define R2_LOAD(c_) do { const size_t gb_ = ((size_t)(bh >> 3) * SEQ + (size_t)(c_) * 64) * RW + (bh & 7) * 64; \
            const bf16_t* PT = (const bf16_t*)(p.ws + WS_BB) + gb_; const bf16_t* QT = (const bf16_t*)(p.ws + WS_DD) + 2 * gb_ + 64; \
            _Pragma("unroll") for (int rb = 0; rb < 2; ++rb) { \
                _Pragma("unroll") for (int ks = 0; ks < 4; ++ks) { const bf16_t* pp = PT + (size_t)(32 * rb + r32) * RW + 32 * (ks >> 1) + 16 * (ks & 1) + 4 * hh; \
                    const s16x4_t lo = *(const s16x4_t*)pp, hi = *(const s16x4_t*)(pp + 8); \
                    _Pragma("unroll") for (int j = 0; j < 4; ++j) { pa[rb][ks][j] = lo[j]; pa[rb][ks][4 + j] = hi[j]; } } \
                const int ci_ = (rb * 2 + cb) * 64 + lane; const uint4* qp = (const uint4*)(QT + (size_t)(ci_ >> 2) * (2 * RW) + (ci_ & 3) * 16); qa[rb][0] = qp[0]; qa[rb][1] = qp[1]; } } while (0)
        R2_LOAD(0);
#pragma unroll 1
        for (int c = 0; c < SEQ / 64; ++c) {
            const size_t ob_ = ((size_t)bh * 128 + c) * 4096;
            const bf16x8_t xb0 = pack_step16(x0, 0), xb1 = pack_step16(x0, 1), xb2 = pack_step16(x1, 0), xb3 = pack_step16(x1, 1);
            { bf16_t* sp = SX + ob_ + (size_t)(32 * cb + r32) * 64 + 4 * hh;
              const uint4 u0 = __builtin_bit_cast(uint4, xb0), u1 = __builtin_bit_cast(uint4, xb1), u2 = __builtin_bit_cast(uint4, xb2), u3 = __builtin_bit_cast(uint4, xb3);
              *(uint2*)(sp + 0) = make_uint2(u0.x, u0.y); *(uint2*)(sp + 8) = make_uint2(u0.z, u0.w); *(uint2*)(sp + 16) = make_uint2(u1.x, u1.y); *(uint2*)(sp + 24) = make_uint2(u1.z, u1.w);
              *(uint2*)(sp + 32) = make_uint2(u2.x, u2.y); *(uint2*)(sp + 40) = make_uint2(u2.z, u2.w); *(uint2*)(sp + 48) = make_uint2(u3.x, u3.y); *(uint2*)(sp + 56) = make_uint2(u3.z, u3.w); }
            f32x16_t n0, n1;
            { const unsigned qw0[8] = {qa[0][0].x, qa[0][0].y, qa[0][0].z, qa[0][0].w, qa[0][1].x, qa[0][1].y, qa[0][1].z, qa[0][1].w};
              const unsigned qw1[8] = {qa[1][0].x, qa[1][0].y, qa[1][0].z, qa[1][0].w, qa[1][1].x, qa[1][1].y, qa[1][1].z, qa[1][1].w};
#pragma unroll
              for (int i = 0; i < 8; ++i) { n0[2 * i] = __uint_as_float(qw0[i] << 16); n0[2 * i + 1] = __uint_as_float(qw0[i] & 0xffff0000u); n1[2 * i] = __uint_as_float(qw1[i] << 16); n1[2 * i + 1] = __uint_as_float(qw1[i] & 0xffff0000u); } }
            const bf16x8_t a00 = pa[0][0], a01 = pa[0][1], a02 = pa[0][2], a03 = pa[0][3], a10 = pa[1][0], a11 = pa[1][1], a12 = pa[1][2], a13 = pa[1][3];
            if (c + 1 < SEQ / 64) R2_LOAD(c + 1);
            n0 = MFMA32(a00, xb0, n0); n0 = MFMA32(a01, xb1, n0); n0 = MFMA32(a02, xb2, n0); n0 = MFMA32(a03, xb3, n0);
            n1 = MFMA32(a10, xb0, n1); n1 = MFMA32(a11, xb1, n1); n1 = MFMA32(a12, xb2, n1); n1 = MFMA32(a13, xb3, n1);
            x0 = n0; x1 = n1;
        }
#undef R2_LOAD
    }
}
__device__ void ph_rwkv_r3(const P& p, float* ldsf) {
    const bf16_t* VV = (const bf16_t*)(p.ws + WS_VV); const bf16_t* SX = (const bf16_t*)(p.ws + WS_SX);
    const bf16_t* Rg = (const bf16_t*)(p.ws + WS_R); const bf16_t* K2 = (const bf16_t*)(p.ws + WS_K2); const bf16_t* Gg = (const bf16_t*)(p.ws + WS_G); bf16_t* ORW = (bf16_t*)(p.ws + WS_ORW);
    const float* r_k = p.in[18]; const float* ln_w = p.in[19]; const float* ln_b = p.in[20];
    bf16_t* Vm = (bf16_t*)ldsf; float* Yl = (float*)(Vm + SLOT);
    const int tid = otid(), lane = tid & 63, wv = tid >> 6; const int t0 = 2 * wv, t1 = 2 * wv + 1;
    const int st = tid >> 3, sj = (tid & 7) * 8;
    for (int ch = blockIdx.x; ch < NB * 8 * (SEQ / 64); ch += gridDim.x) {
        const int bh = ch >> 7, c = ch & 127, b = bh >> 3, h = bh & 7;
        const size_t gbase = ((size_t)b * SEQ + (size_t)c * 64) * RW + h * 64, ob_ = (size_t)ch * 4096;
        const bf16_t* G1T = (const bf16_t*)(p.ws + WS_KK) + gbase; const bf16_t* G2T = (const bf16_t*)(p.ws + WS_DD) + 2 * gbase;
        __syncthreads();
        const uint4 vraw = *(const uint4*)(VV + gbase + (size_t)st * RW + sj);
        *(uint4*)(Vm + st * LP + sj) = vraw;
        __syncthreads();
        R1_FOR_TILES(idx, tr, tc)
            const f32x4_t zero4 = {0.f, 0.f, 0.f, 0.f};
            f32x4_t y = mm_tile<true, true>(SX + ob_, 64, 1, G1T, 1, RW, tr, tc, zero4, lane);
            y = mm_tile<false, true>(Vm, 1, LP, G2T, 1, 2 * RW, tr, tc, y, lane);
            const int i0 = 16 * tr + 4 * (lane >> 4), t = 16 * tc + (lane & 15);
#pragma unroll
            for (int e = 0; e < 4; ++e) Yl[t * 65 + i0 + e] = y[e];
        R1_END
        __syncthreads();
        {
            float y[8], s1 = 0.f;
#pragma unroll
            for (int e = 0; e < 8; ++e) { y[e] = Yl[st * 65 + sj + e]; s1 += y[e]; }
            s1 += __shfl_xor(s1, 1); s1 += __shfl_xor(s1, 2); s1 += __shfl_xor(s1, 4);
            const float mean = s1 * (1.f / 64.f); float s2 = 0.f;
#pragma unroll
            for (int e = 0; e < 8; ++e) { y[e] -= mean; s2 += y[e] * y[e]; }
            s2 += __shfl_xor(s2, 1); s2 += __shfl_xor(s2, 2); s2 += __shfl_xor(s2, 4);
            const float rstd = rsqrtf(s2 * (1.f / 64.f) + GN_EPS);
            const size_t o = gbase + (size_t)st * RW + sj;
            const uint4 rr = *(const uint4*)(Rg + o), kr = *(const uint4*)(K2 + o), gr = *(const uint4*)(Gg + o);
            const unsigned rw_[4] = {rr.x, rr.y, rr.z, rr.w}, kw_[4] = {kr.x, kr.y, kr.z, kr.w}, gw_[4] = {gr.x, gr.y, gr.z, gr.w}, vw_[4] = {vraw.x, vraw.y, vraw.z, vraw.w};
            float rk = 0.f;
#pragma unroll
            for (int e = 0; e < 8; ++e) { const float r_ = (e & 1) ? __uint_as_float(rw_[e >> 1] & 0xffff0000u) : __uint_as_float(rw_[e >> 1] << 16), k_ = (e & 1) ? __uint_as_float(kw_[e >> 1] & 0xffff0000u) : __uint_as_float(kw_[e >> 1] << 16);
                rk += r_ * k_ * r_k[h * 64 + sj + e]; }
            rk += __shfl_xor(rk, 1); rk += __shfl_xor(rk, 2); rk += __shfl_xor(rk, 4);
            float ov[8];
#pragma unroll
            for (int e = 0; e < 8; ++e) { const float v_ = (e & 1) ? __uint_as_float(vw_[e >> 1] & 0xffff0000u) : __uint_as_float(vw_[e >> 1] << 16), g_ = (e & 1) ? __uint_as_float(gw_[e >> 1] & 0xffff0000u) : __uint_as_float(gw_[e >> 1] << 16);
                ov[e] = (y[e] * rstd * ln_w[h * 64 + sj + e] + ln_b[h * 64 + sj + e] + rk * v_) * g_; }
            *(uint4*)(ORW + o) = make_uint4(pk2(ov[0], ov[1]), pk2(ov[2], ov[3]), pk2(ov[4], ov[5]), pk2(ov[6], ov[7]));
        }
    }
}
#undef R1_FOR_TILES
#undef R1_END

__device__ void ph_moe_lists(const P& p, float* ldsf) {
    int* ctl = (int*)(p.ws + WS_CTL); const int* cntB = ctl + CT_CNTB;
    int* ltok = (int*)(p.ws + WS_LTOK); float* lw = (float*)(p.ws + WS_LW);
    int* part = (int*)ldsf;
    int* tot = part + 1024; int* pre = tot + 64; int* offL = pre + 64; int* tp = offL + 64;
    const int tid = otid(), lane = tid & 63, wv = tid >> 6, G = gridDim.x;
    { int t_ = 0, p_ = 0;
      for (int b2 = wv; b2 < G; b2 += 8) { const int v = cntB[b2 * 64 + lane]; t_ += v; p_ += (b2 < (int)blockIdx.x) ? v : 0; }
      part[wv * 64 + lane] = t_; part[512 + wv * 64 + lane] = p_; }
    __syncthreads();
    if (tid < 64) { int t_ = 0, p_ = 0;
#pragma unroll
        for (int w2 = 0; w2 < 8; ++w2) { t_ += part[w2 * 64 + tid]; p_ += part[512 + w2 * 64 + tid]; }
        tot[tid] = t_; pre[tid] = p_;
        const int nt_ = (t_ + 255) >> 8; int incl = nt_;
#pragma unroll
        for (int o = 1; o < 64; o <<= 1) { const int oth = __shfl_up(incl, o); if (lane >= o) incl += oth; }
        tp[tid] = incl - nt_; offL[tid] = (incl - nt_) * 256; if (tid == 63) tp[64] = incl; }
    __syncthreads();
    const int TPB = NT / G;
    for (int i = tid; i < TPB; i += NTHR) { const int m = blockIdx.x * TPB + i; const int4 r = ((const int4*)(p.ws + WS_ROUTE))[m];
        const int l0 = r.x & 255, l1 = 32 + ((r.x >> 8) & 255), rk0 = r.y & 0xffff, rk1 = (r.y >> 16) & 0xffff;
        const int p0 = offL[l0] + pre[l0] + rk0, p1 = offL[l1] + pre[l1] + rk1;
        ltok[p0] = m; lw[p0] = __int_as_float(r.z); ltok[p1] = m; lw[p1] = __int_as_float(r.w); }
    for (int li = blockIdx.x; li < 64; li += G) {
        const int cnt = tot[li], off = offL[li], e = li & 31, nt_ = (cnt + 255) >> 8;
        int4* t1 = (int4*)(ctl + CT_TAB1) + tp[li] * 4;
        int4* t2 = (li < 32) ? (int4*)(ctl + CT_TAB2A) + tp[li] * 4 : (int4*)(ctl + CT_TAB2B) + (tp[li] - tp[32]) * 4;
        for (int i = tid; i < nt_ * 4; i += NTHR) { const int mt = i >> 2, nt = i & 3; const int4 ent = make_int4(off + mt * 256, e * 1024 + nt * 256, cnt - mt * 256, nt); t1[i] = ent; t2[i] = ent; }
        for (int r = cnt + tid; r < nt_ * 256; r += NTHR) ltok[off + r] = 0;
    }
    if (blockIdx.x == 0 && tid == 0) { ctl[CT_NU] = tp[64] * 4; ctl[CT_NU + 1] = tp[32] * 4; ctl[CT_NU + 2] = (tp[64] - tp[32]) * 4; }
}

template <int PH>
__device__ __forceinline__ void run_phase(const P& p, unsigned char* lds_raw) {
    float* lds = (float*)lds_raw; PG8_LAS unsigned char* ldsg = (PG8_LAS unsigned char*)lds_raw;
    const int G = gridDim.x, c = blockIdx.x;
    if constexpr (PH == 0) { ph_mod(p, lds); __syncthreads(); ph_convert_mixer_weights(p, lds); __syncthreads(); ph_convert_lora_weights(p, lds); }
    if constexpr (PH == 1) ph_norm(p, p.in[0], p.in[4], 0, (bf16_t*)(p.ws + WS_XN));
    if constexpr (PH == 2) { pg8::Gemm g{(const bf16_t*)(p.ws + WS_XN), (const bf16_t*)(p.ws + WS_WIN), DM, nullptr}; pg8::StaticOrder S; S.init(NT, 5120, G, c);
        pg8::EpiInproj E{p.ws, (bf16_t*)p.out}; pg8::gemm_phase(ldsg, g, S, E); }
    if constexpr (PH == 3) {
        { pg8::Gemm g{(const bf16_t*)(p.ws + WS_KVN), (const bf16_t*)(p.ws + WS_WKV), KVL, nullptr}; pg8::StaticOrder S; S.init(NT, 2 * AW, G, c);
          pg8::EpiKV E{p.ws}; pg8::gemm_phase(ldsg, g, S, E);
          pg8::Unit u;
          for (int i = 0; S.next(i, u); ++i) if (u.pn < 2) { __syncthreads(); knorm_tile(p, u.pm, u.pn); } }
        ph_rwkv_prep_r1(p, lds);
        ph_dsa_select(p, lds);
    }
    if constexpr (PH == 4) { ph_rwkv_r2(p, c, NB * 8, G); ph_dsa_attn(p, lds); }
    if constexpr (PH == 5) ph_rwkv_r3(p, lds);
    if constexpr (PH == 6) { pg8::Gemm g{(const bf16_t*)(p.ws + WS_OATT), (const bf16_t*)(p.ws + WS_WBA), AW, nullptr}; pg8::BranchOrder S; S.S0.init(NT, DM, G, c);
        pg8::EpiMerge E{(bf16_t*)(p.ws + WS_MERGED), (const bf16_t*)p.out}; pg8::gemm_phase(ldsg, g, S, E);
        ph_convert_expert_weights(p, lds); }
    if constexpr (PH == 7) { pg8::Gemm g{(const bf16_t*)(p.ws + WS_MERGED), (const bf16_t*)(p.ws + WS_WOUT), DM, nullptr}; pg8::StaticOrder S; S.init(NT, DM, G, c);
        pg8::EpiOut E{p.in[0], (const float*)(p.ws + WS_MOD), p.out}; pg8::gemm_phase(ldsg, g, S, E); }
    if constexpr (PH == 8) ph_norm_route(p, lds);
    if constexpr (PH == 9) ph_moe_lists(p, lds);
    if constexpr (PH == 10) { const int* ctl = (const int*)(p.ws + WS_CTL);
        pg8::Gemm g{(const bf16_t*)(p.ws + WS_XN2), (const bf16_t*)(p.ws + WS_WGU), DM, (const int*)(p.ws + WS_LTOK)}; pg8::TableOrder S{(const int4*)(ctl + CT_TAB1), ctl[CT_NU], G, c};
        pg8::EpiMoe1 E{(bf16_t*)(p.ws + WS_HID), (const float*)(p.ws + WS_LW)}; pg8::gemm_phase(ldsg, g, S, E); }
    if constexpr (PH == 11 || PH == 12) { const int* ctl = (const int*)(p.ws + WS_CTL);
        pg8::Gemm g{(const bf16_t*)(p.ws + WS_HID), (const bf16_t*)(p.ws + WS_WDN), DE, nullptr};
        pg8::TableOrder S{(const int4*)(ctl + (PH == 11 ? CT_TAB2A : CT_TAB2B)), ctl[CT_NU + (PH == 11 ? 1 : 2)], G, c};
        pg8::EpiMoe2 E{(const int*)(p.ws + WS_LTOK), (const float*)(p.ws + WS_MOD), p.out}; pg8::gemm_phase(ldsg, g, S, E); }
}
constexpr int LDS_BYTES = 147456;
constexpr int ORDER[] = {0, 1, 2, 3, 4, 5, 6, 7, 8, 9, 10, 11, 12};
constexpr int NPHASE = sizeof(ORDER) / sizeof(int);
constexpr int CT_BAR = 65536;
constexpr int LDS_ST = LDS_BYTES - 64;
template <int I> __device__ __forceinline__ void run_all(const P& p, unsigned char* lds, const XcdBarrier& bar) {
    run_phase<ORDER[I]>(p, lds);
    if constexpr (I + 1 < NPHASE) { xcd_barrier(bar); run_all<I + 1>(p, lds, bar); }
}
__global__ void __launch_bounds__(NTHR, 2) k_mega(P p) {
    extern __shared__ __attribute__((aligned(16))) unsigned char lds[];
    volatile LAS3 unsigned* st = (volatile LAS3 unsigned*)((LAS3 unsigned char*)lds + LDS_ST);
    if (otid() < 16) st[otid()] = 0u;
    __syncthreads();
    const XcdBarrier bar = xcd_barrier_post((unsigned*)(p.ws + WS_CTL) + CT_BAR, st);
    run_all<0>(p, lds, bar);
}
}

extern "C" void kernel_launch(void* const* d_in, const int* in_sizes, int n_in, void* d_out, int out_size, void* d_ws, size_t ws_size, hipStream_t stream) {
    if (n_in != 31 || out_size != NT * DM || ws_size < WS_END) { fprintf(stderr, "kernel_launch: unexpected shapes (n_in %d out %d ws %zu need %zu)\n", n_in, out_size, ws_size, (size_t)WS_END); return; }
    P p{};
    for (int i = 0; i < 31; ++i) p.in[i] = (const float*)d_in[i];
    p.out = (float*)d_out; p.ws = (unsigned char*)d_ws;
    (void)hipMemsetAsync((char*)d_ws + WS_CTL, 0, 1 * MiB, stream);
    static int grid_blocks = 0;
    if (!grid_blocks) {
        int dev = 0, cus = 0, per_cu = 0;
        (void)hipGetDevice(&dev);
        (void)hipDeviceGetAttribute(&cus, hipDeviceAttributeMultiprocessorCount, dev);
        (void)hipFuncSetAttribute((const void*)k_mega, hipFuncAttributeMaxDynamicSharedMemorySize, LDS_BYTES);
        (void)hipOccupancyMaxActiveBlocksPerMultiprocessor(&per_cu, (const void*)k_mega, NTHR, LDS_BYTES);
        if (per_cu < 1) per_cu = 1;
        if (per_cu > 1) per_cu = 1;
        grid_blocks = cus * per_cu;
        fprintf(stderr, "kernel_launch: cus %d per_cu %d grid %d\n", cus, per_cu, grid_blocks);
    }
    hipLaunchKernelGGL(k_mega, dim3(grid_blocks), dim3(NTHR), LDS_BYTES, stream, p);
}
```

```cpp
#include <hip/hip_runtime.h>
#include <cstdio>
#include <cstdint>

namespace {
constexpr int NB = 2, SEQ = 8192, DM = 1024, NT = NB * SEQ;
constexpr int AW = 512, KVL = 256, NIH = 8, IDD = 32, SHW = 1824, INW = 4936;
constexpr int C_KV = 512, C_QI = 768, C_PS = 1064, C_GA = 2888, C_GR = 3912;
constexpr int IDXW = 296;
constexpr int RW = 512, NE = 32, DE = 512;
constexpr int TOPK = 256;
constexpr float NORM_EPS = 1e-6f, GN_EPS = 64e-5f;
constexpr int NTHR = 512;

typedef unsigned short bf16_t;
__device__ __forceinline__ float bf2f(bf16_t v) { return __uint_as_float(((unsigned)v) << 16); }
__device__ __forceinline__ bf16_t f2bf(float f) { unsigned u = __float_as_uint(f); return (bf16_t)((u + 0x7fffu + ((u >> 16) & 1u)) >> 16); }

constexpr size_t MiB = 1u << 20;
constexpr size_t WS_CTL = 0;
constexpr size_t WS_MOD = 1 * MiB;
constexpr size_t WS_RSS = 82 * MiB + 512 * 1024;
constexpr size_t WS_LW2T = 512 * 1024, WS_LA2T = 576 * 1024, WS_LG2T = 640 * 1024;
constexpr size_t WS_WIN = 2 * MiB;
constexpr size_t WS_WKV = 12 * MiB;
constexpr size_t WS_WBA = 13 * MiB;
constexpr size_t WS_WBR = 14 * MiB;
constexpr size_t WS_WOUT = 15 * MiB;
constexpr size_t WS_XN = 17 * MiB;
constexpr size_t WS_K = 17 * MiB;
constexpr size_t WS_V = 33 * MiB;
constexpr size_t WS_Q = 49 * MiB;
constexpr size_t WS_KVN = 65 * MiB;
constexpr size_t WS_QI = 73 * MiB;
constexpr size_t WS_KI = 81 * MiB;
constexpr size_t WS_WI = 82 * MiB;
constexpr size_t WS_PS = 83 * MiB;
constexpr size_t WS_SX = 83 * MiB;
constexpr size_t WS_OATT = 99 * MiB;
constexpr size_t WS_ORW = 115 * MiB;
constexpr size_t WS_MASK = 140 * MiB;
constexpr size_t WS_R = 156 * MiB, WS_K2 = 172 * MiB, WS_VV = 188 * MiB;
constexpr size_t WS_KK = 204 * MiB;
constexpr size_t WS_BB = 220 * MiB;
constexpr size_t WS_DD = 236 * MiB;
constexpr size_t WS_G = 268 * MiB;
constexpr size_t WS_MERGED = 131 * MiB;
constexpr size_t WS_XN2 = 163 * MiB;
constexpr size_t WS_WGU = 195 * MiB;
constexpr size_t WS_WDN = 259 * MiB;
constexpr size_t WS_HID = 17 * MiB;
constexpr size_t WS_ROUTE = 65 * MiB;
constexpr size_t WS_LTOK = 66 * MiB;
constexpr size_t WS_LW = 67 * MiB;
constexpr size_t WS_END = 291 * MiB;
constexpr int HID_ROWS = 49152;
constexpr int CT_CNT = 0, CT_OFF = 64, CT_CUR = 128, CT_NU = 192, CT_Q = 256;
constexpr int CT_CNTB = 16384;
constexpr int CT_TAB1 = 1024, CT_TAB2A = 1024 + 4 * 1024, CT_TAB2B = 1024 + 8 * 1024;

struct P {
    const float* in[31];
    float* out;
    unsigned char* ws;
};

__device__ __forceinline__ int otid() { int t = threadIdx.x; asm volatile("" : "+v"(t)); return t; }
__device__ __forceinline__ float dpp_row_shr(float v, int n) {
    int iv = __builtin_bit_cast(int, v), r;
    switch (n) { case 1: r = __builtin_amdgcn_update_dpp(0, iv, 0x111, 0xf, 0xf, true); break; case 2: r = __builtin_amdgcn_update_dpp(0, iv, 0x112, 0xf, 0xf, true); break;
                 case 4: r = __builtin_amdgcn_update_dpp(0, iv, 0x114, 0xf, 0xf, true); break; default: r = __builtin_amdgcn_update_dpp(0, iv, 0x118, 0xf, 0xf, true); break; }
    return __builtin_bit_cast(float, r);
}
__device__ __forceinline__ float wave_sum(float v) {
    v += dpp_row_shr(v, 1); v += dpp_row_shr(v, 2); v += dpp_row_shr(v, 4); v += dpp_row_shr(v, 8);
    v += __builtin_bit_cast(float, __builtin_amdgcn_update_dpp(0, __builtin_bit_cast(int, v), 0x142, 0xa, 0xf, false));
    v += __builtin_bit_cast(float, __builtin_amdgcn_update_dpp(0, __builtin_bit_cast(int, v), 0x143, 0xc, 0xf, false));
    return __builtin_bit_cast(float, __builtin_amdgcn_readlane(__builtin_bit_cast(int, v), 63));
}
__device__ __forceinline__ float wave_max(float v) {
#pragma unroll
    for (int o = 32; o > 0; o >>= 1) v = fmaxf(v, __shfl_xor(v, o));
    return v;
}
typedef short bf16x8_t __attribute__((ext_vector_type(8)));
typedef float f32x4_t __attribute__((ext_vector_type(4)));
constexpr int LP = 72;
constexpr int SLOT = 64 * LP;
typedef __bf16 bf2_t __attribute__((ext_vector_type(2)));
typedef float f2_t __attribute__((ext_vector_type(2)));
__device__ __forceinline__ unsigned pk_bf16(float lo, float hi) { const f2_t v = {lo, hi}; return __builtin_bit_cast(unsigned, __builtin_convertvector(v, bf2_t)); }
__device__ __forceinline__ float sigmoidf_(float x) { return __builtin_amdgcn_rcpf(1.f + __expf(-x)); }

#define XB_TMO      128
#define XB_XCNT(j)  (256  + 64 * (j))
#define XB_XSUB(j)  (1280 + 64 * (j))
#define XB_XGEN(j)  (2304 + 64 * (j))
#define XB_TOP      3328
#define XB_TOPGEN   3392
#define XCD_BAR_WORDS 3456
#define XB_SPIN_CAP (1u << 22)
#define LAS3 __attribute__((address_space(3)))
__device__ __forceinline__ unsigned xb_ld(unsigned* p)              { return __hip_atomic_load(p, __ATOMIC_RELAXED, __HIP_MEMORY_SCOPE_AGENT); }
__device__ __forceinline__ unsigned xb_add(unsigned* p, unsigned v) { return __hip_atomic_fetch_add(p, v, __ATOMIC_RELAXED, __HIP_MEMORY_SCOPE_AGENT); }
__device__ __forceinline__ unsigned xb_xcc_id() { return (unsigned)__builtin_amdgcn_s_getreg((3 << 11) | 20) & 0xFu; }
#define XB_SPIN(cond, bar) do { unsigned _sp = 0; while (cond) { __builtin_amdgcn_s_sleep(1); \
    if ((++_sp & 255u) == 0u) { if (xb_ld(&(bar)[XB_TMO])) break; if (_sp > XB_SPIN_CAP) { atomicAdd(&(bar)[XB_TMO], 1u); break; } } } } while (0)
struct XcdBarrier { unsigned* bar; unsigned x; volatile LAS3 unsigned* st; };
__device__ __forceinline__ XcdBarrier xcd_barrier_post(unsigned* bar, volatile LAS3 unsigned* st) {
    XcdBarrier b; b.bar = bar; b.x = xb_xcc_id(); b.st = st;
    if (otid() == 0) (void)xb_add(&bar[XB_XCNT(b.x)], 1u);
    return b;
}
__device__ __forceinline__ void xcd_barrier_complete(unsigned* bar, unsigned x, unsigned& nloc, unsigned& nx) {
    const unsigned G = gridDim.x * gridDim.y * gridDim.z;
    unsigned sum, cnt, mine, sp = 0u;
    for (;;) {
        sum = 0u; cnt = 0u; mine = 0u;
#pragma unroll
        for (unsigned j = 0; j < 16; ++j) { const unsigned c = xb_ld(&bar[XB_XCNT(j)]); sum += c; cnt += (c > 0u) ? 1u : 0u; mine = (j == x) ? c : mine; }
        if (sum == G) break;
        __builtin_amdgcn_s_sleep(1);
        if ((++sp & 255u) == 0u) { if (xb_ld(&bar[XB_TMO])) break; if (sp > XB_SPIN_CAP) { atomicAdd(&bar[XB_TMO], 1u); break; } }
    }
    nloc = mine > 0u ? mine : 1u; nx = cnt > 0u ? cnt : 1u;
}
__device__ __forceinline__ void xcd_barrier(const XcdBarrier& b) {
    asm volatile("s_waitcnt vmcnt(0)" ::: "memory");
    __syncthreads();
    if (otid() == 0) {
        unsigned* bar = b.bar;
        __builtin_amdgcn_s_waitcnt(0);
        unsigned nloc = b.st[0], nx = b.st[1];
        if (nloc == 0u) { xcd_barrier_complete(bar, b.x, nloc, nx); b.st[0] = nloc; b.st[1] = nx; }
        const unsigned old = xb_add(&bar[XB_XSUB(b.x)], 1u);
        const unsigned gen = old / nloc;
        if (old + 1u == (gen + 1u) * nloc) {
            __builtin_amdgcn_fence(__ATOMIC_RELEASE, "agent");
            asm volatile("s_waitcnt vmcnt(0)" ::: "memory");
            const unsigned og = xb_add(&bar[XB_TOP], 1u);
            const unsigned tg = og / nx;
            if (og + 1u == (tg + 1u) * nx) xb_add(&bar[XB_TOPGEN], 1u);
            else XB_SPIN(xb_ld(&bar[XB_TOPGEN]) == tg, bar);
            __builtin_amdgcn_fence(__ATOMIC_ACQUIRE, "agent");
            xb_add(&bar[XB_XGEN(b.x)], 1u);
            asm volatile("s_waitcnt vmcnt(0)" ::: "memory");
        } else {
            XB_SPIN(xb_ld(&bar[XB_XGEN(b.x)]) == gen, bar);
            __builtin_amdgcn_fence(__ATOMIC_ACQUIRE, "agent");
            asm volatile("s_waitcnt vmcnt(0)" ::: "memory");
        }
    }
    __syncthreads();
}

__device__ void ph_mod(const P& p, float* lds) {
    const float* c = p.in[1]; const float* W = p.in[2]; const float* bia = p.in[3];
    float* mod = (float*)(p.ws + WS_MOD);
    const int tid = otid(), lane = tid & 63, wv = tid >> 6;
    float* sil = lds; float* part = lds + NB * DM;
    for (int i = tid; i < NB * DM; i += NTHR) { const float v = c[i]; sil[i] = v / (1.f + __expf(-v)); }
    __syncthreads();
    const int cc = lane % 24, kk = lane / 24;
    for (int j0 = blockIdx.x * 24; j0 < 6 * DM; j0 += gridDim.x * 24) {
        float a0 = 0.f, a1 = 0.f;
        if (lane < 48) {
#pragma unroll 8
            for (int i = 0; i < 64; ++i) { const int k = 128 * wv + 2 * i + kk; const float w = W[(size_t)k * (6 * DM) + j0 + cc]; a0 += sil[k] * w; a1 += sil[DM + k] * w; }
        }
        a0 += __shfl(a0, (lane + 24) & 63); a1 += __shfl(a1, (lane + 24) & 63);
        if (lane < 24) { part[(wv * 2 + 0) * 24 + cc] = a0; part[(wv * 2 + 1) * 24 + cc] = a1; }
        __syncthreads();
        if (tid < 48) { const int bb = tid / 24, c2 = tid % 24; float sum = 0.f;
#pragma unroll
            for (int w2 = 0; w2 < 8; ++w2) sum += part[(w2 * 2 + bb) * 24 + c2];
            mod[bb * 6 * DM + j0 + c2] = sum + bia[j0 + c2]; }
        __syncthreads();
    }
}

__device__ void ph_norm(const P& p, const float* src, const float* g, int which, bf16_t* dst) {
    const float* mod = (const float*)(p.ws + WS_MOD);
    const int lane = otid() & 63, wv = otid() >> 6;
    const int gw = blockIdx.x * (NTHR / 64) + wv, nw = gridDim.x * (NTHR / 64);
    for (int m = gw; m < NT; m += nw) {
        const int b = m / SEQ;
        const float* sh = mod + b * 6 * DM + (which ? 3 * DM : 0);
        const float* sc = sh + DM;
        const float4* xr = (const float4*)(src + (size_t)m * DM);
        float4 v[4]; float ss = 0.f;
#pragma unroll
        for (int j = 0; j < 4; ++j) { v[j] = xr[lane + 64 * j]; ss += v[j].x * v[j].x + v[j].y * v[j].y + v[j].z * v[j].z + v[j].w * v[j].w; }
        ss = wave_sum(ss);
        const float rstd = rsqrtf(ss * (1.f / DM) + NORM_EPS);
        float o[16];
#pragma unroll
        for (int j = 0; j < 4; ++j) {
            int c0 = 4 * (lane + 64 * j); asm volatile("" : "+v"(c0));
            const float4 gg = *(const float4*)(g + c0), s1 = *(const float4*)(sc + c0), s0 = *(const float4*)(sh + c0);
            o[4 * j + 0] = v[j].x * rstd * gg.x * (1.f + s1.x) + s0.x; o[4 * j + 1] = v[j].y * rstd * gg.y * (1.f + s1.y) + s0.y;
            o[4 * j + 2] = v[j].z * rstd * gg.z * (1.f + s1.z) + s0.z; o[4 * j + 3] = v[j].w * rstd * gg.w * (1.f + s1.w) + s0.w;
            uint2 pk; pk.x = (unsigned)f2bf(o[4 * j]) | ((unsigned)f2bf(o[4 * j + 1]) << 16); pk.y = (unsigned)f2bf(o[4 * j + 2]) | ((unsigned)f2bf(o[4 * j + 3]) << 16);
            *(uint2*)(dst + (size_t)m * DM + c0) = pk;
        }
    }
}

__device__ void ph_norm_route(const P& p, float* lds) {
    const float* mod = (const float*)(p.ws + WS_MOD); const float* src = p.out; const float* g = p.in[24]; bf16_t* dst = (bf16_t*)(p.ws + WS_XN2);
    const float* wgr = p.in[25]; const float* wer = p.in[26]; const float* eb = p.in[27];
    const int tid = otid(), lane = tid & 63, wv = tid >> 6;
    float* sx = lds + wv * 4096;
    int* cntL = (int*)(lds + 8 * 4096);
    if (tid < 64) cntL[tid] = 0;
    __syncthreads();
    const int TPB = NT / gridDim.x;
    for (int m0 = blockIdx.x * TPB + wv * 4; m0 < (blockIdx.x + 1) * TPB; m0 += 8 * 4) {
        const int b = m0 / SEQ;
        const float* sh = mod + b * 6 * DM + 3 * DM; const float* sc = sh + DM;
#pragma unroll 1
        for (int tk = 0; tk < 4; ++tk) {
            const int m = m0 + tk;
            const float4* xr = (const float4*)(src + (size_t)m * DM);
            float4 v[4]; float ss = 0.f;
#pragma unroll
            for (int j = 0; j < 4; ++j) { v[j] = xr[lane + 64 * j]; ss += v[j].x * v[j].x + v[j].y * v[j].y + v[j].z * v[j].z + v[j].w * v[j].w; }
            ss = wave_sum(ss);
            const float rstd = rsqrtf(ss * (1.f / DM) + NORM_EPS);
#pragma unroll
            for (int j = 0; j < 4; ++j) {
                const int c0 = 4 * (lane + 64 * j);
                const float4 gg = *(const float4*)(g + c0), s1 = *(const float4*)(sc + c0), s0 = *(const float4*)(sh + c0);
                const float o0 = v[j].x * rstd * gg.x * (1.f + s1.x) + s0.x, o1 = v[j].y * rstd * gg.y * (1.f + s1.y) + s0.y;
                const float o2 = v[j].z * rstd * gg.z * (1.f + s1.z) + s0.z, o3 = v[j].w * rstd * gg.w * (1.f + s1.w) + s0.w;
                uint2 pk; pk.x = (unsigned)f2bf(o0) | ((unsigned)f2bf(o1) << 16); pk.y = (unsigned)f2bf(o2) | ((unsigned)f2bf(o3) << 16);
                *(uint2*)(dst + (size_t)m * DM + c0) = pk;
                sx[(c0 + 0) * 4 + tk] = o0; sx[(c0 + 1) * 4 + tk] = o1; sx[(c0 + 2) * 4 + tk] = o2; sx[(c0 + 3) * 4 + tk] = o3;
            }
        }
        __builtin_amdgcn_wave_barrier(); asm volatile("s_waitcnt lgkmcnt(0)" ::: "memory");
        float ae[4], ag[4];
        {
            float pe[4][4];
#pragma unroll
            for (int t_ = 0; t_ < 4; ++t_)
#pragma unroll
                for (int q = 0; q < 4; ++q) pe[t_][q] = 0.f;
            const int eq = lane & 7, kb = (lane >> 3) * 128;
#pragma unroll 16
            for (int i = 0; i < 128; ++i) { const float4 w = *(const float4*)(wer + (size_t)(kb + i) * 32 + 4 * eq); const float4 xv = *(const float4*)(sx + (kb + i) * 4);
                pe[0][0] += xv.x * w.x; pe[0][1] += xv.x * w.y; pe[0][2] += xv.x * w.z; pe[0][3] += xv.x * w.w;
                pe[1][0] += xv.y * w.x; pe[1][1] += xv.y * w.y; pe[1][2] += xv.y * w.z; pe[1][3] += xv.y * w.w;
                pe[2][0] += xv.z * w.x; pe[2][1] += xv.z * w.y; pe[2][2] += xv.z * w.z; pe[2][3] += xv.z * w.w;
                pe[3][0] += xv.w * w.x; pe[3][1] += xv.w * w.y; pe[3][2] += xv.w * w.z; pe[3][3] += xv.w * w.w; }
#pragma unroll
            for (int t_ = 0; t_ < 4; ++t_)
#pragma unroll
                for (int q = 0; q < 4; ++q) { float v = pe[t_][q]; v += __shfl_xor(v, 8); v += __shfl_xor(v, 16); v += __shfl_xor(v, 32); pe[t_][q] = v; }
#pragma unroll
            for (int t_ = 0; t_ < 4; ++t_) { const int srcl = (lane & 31) >> 2; const float v0 = __shfl(pe[t_][0], srcl), v1 = __shfl(pe[t_][1], srcl), v2 = __shfl(pe[t_][2], srcl), v3 = __shfl(pe[t_][3], srcl);
                const int cq = lane & 3; ae[t_] = cq == 0 ? v0 : (cq == 1 ? v1 : (cq == 2 ? v2 : v3)); }
            float pg_[4][4];
#pragma unroll
            for (int t_ = 0; t_ < 4; ++t_)
#pragma unroll
                for (int q = 0; q < 4; ++q) pg_[t_][q] = 0.f;
            const int kg = lane * 16;
#pragma unroll
            for (int i = 0; i < 16; ++i) { const float4 w = *(const float4*)(wgr + (size_t)(kg + i) * 4); const float4 xv = *(const float4*)(sx + (kg + i) * 4);
                pg_[0][0] += xv.x * w.x; pg_[0][1] += xv.x * w.y; pg_[0][2] += xv.x * w.z; pg_[0][3] += xv.x * w.w;
                pg_[1][0] += xv.y * w.x; pg_[1][1] += xv.y * w.y; pg_[1][2] += xv.y * w.z; pg_[1][3] += xv.y * w.w;
                pg_[2][0] += xv.z * w.x; pg_[2][1] += xv.z * w.y; pg_[2][2] += xv.z * w.z; pg_[2][3] += xv.z * w.w;
                pg_[3][0] += xv.w * w.x; pg_[3][1] += xv.w * w.y; pg_[3][2] += xv.w * w.z; pg_[3][3] += xv.w * w.w; }
#pragma unroll
            for (int t_ = 0; t_ < 4; ++t_) {
#pragma unroll
                for (int q = 0; q < 4; ++q) pg_[t_][q] = wave_sum(pg_[t_][q]);
                const int cq = lane & 3; ag[t_] = cq == 0 ? pg_[t_][0] : (cq == 1 ? pg_[t_][1] : (cq == 2 ? pg_[t_][2] : pg_[t_][3])); }
        }
#pragma unroll
        for (int tk = 0; tk < 4; ++tk) {
            float lg[4];
#pragma unroll
            for (int q = 0; q < 4; ++q) lg[q] = __shfl(ag[tk], q);
            int gs = 0; float mx = lg[0];
#pragma unroll
            for (int q = 1; q < 4; ++q) if (lg[q] > mx) { mx = lg[q]; gs = q; }
            float den = 0.f;
#pragma unroll
            for (int q = 0; q < 4; ++q) den += __expf(lg[q] - mx);
            const float pg = 1.f / den;
            float ev[8];
#pragma unroll
            for (int q = 0; q < 8; ++q) ev[q] = __shfl(ae[tk], gs * 8 + q) + eb[gs * 8 + q];
            int i0 = 0; float v0 = ev[0];
#pragma unroll
            for (int q = 1; q < 8; ++q) if (ev[q] > v0) { v0 = ev[q]; i0 = q; }
            int i1 = -1; float v1 = -INFINITY;
#pragma unroll
            for (int q = 0; q < 8; ++q) if (q != i0 && ev[q] > v1) { v1 = ev[q]; i1 = q; }
            if (lane == 0) {
                const float e1 = __expf(v1 - v0), w0 = pg / (1.f + e1), w1 = pg * e1 / (1.f + e1);
                const int x0 = gs * 8 + i0, x1 = gs * 8 + i1;
                const int rk0 = atomicAdd(&cntL[x0], 1), rk1 = atomicAdd(&cntL[32 + x1], 1);
                int4* route = (int4*)(p.ws + WS_ROUTE) + (size_t)(m0 + tk);
                *route = make_int4(x0 | (x1 << 8), rk0 | (rk1 << 16), __float_as_int(w0), __float_as_int(w1));
            }
        }
        __builtin_amdgcn_wave_barrier();
    }
    __syncthreads();
    if (tid < 64) ((int*)(p.ws + WS_CTL) + CT_CNTB)[blockIdx.x * 64 + tid] = cntL[tid];
}

namespace pg8 {
#define PG8_LAS __attribute__((address_space(3)))
typedef short bf16x8 __attribute__((ext_vector_type(8)));
typedef float f32x4 __attribute__((ext_vector_type(4)));
typedef unsigned u32x4 __attribute__((ext_vector_type(4)));
constexpr int BM = 256, BK = 64, HALF = 128, HTB = HALF * BK * 2, STAGE_BYTES = 8 * HTB, NXCD = 8, WGM = 8;
__host__ __device__ __forceinline__ int lds_byte(int r, int c) { const int st = (r >> 4) * 2 + (c >> 5), rr = r & 15, cc = c & 31, ob = rr * 64 + cc * 2; return st * 1024 + (ob ^ (((ob >> 9) & 1) << 5)); }
__host__ __device__ __forceinline__ void stage_rc(int b, int& R, int& C) { const int st = b / 1024, sb = b % 1024, swz = sb ^ (((sb >> 9) & 1) << 5); R = (st >> 1) * 16 + swz / 64; C = (st & 1) * 32 + (swz % 64) / 2; }
__host__ __device__ __forceinline__ int perm32(int rho) { const int n = rho >> 4, i = rho & 15; return 8 * (i >> 2) + 4 * n + (i & 3); }

struct Unit { int arow, brow, pm, pn, aux; };
struct Gemm { const bf16_t* A; const bf16_t* Bt; int K; const int* gather; };

struct StaticOrder {
    int nM, nN, nwg, G, c;
    __device__ void init(int M, int N, int G_, int c_) { nM = M / BM; nN = N / BM; nwg = nM * nN; G = G_; c = c_; }
    __device__ bool next(int i, Unit& u) const {
        const long L = (long)i * G + c; if (L >= nwg) return false;
        int wgid = (int)L; { const int q = nwg / NXCD, r = nwg % NXCD, xcd = wgid % NXCD, off = wgid / NXCD; wgid = (xcd < r ? xcd * (q + 1) : r * (q + 1) + (xcd - r) * q) + off; }
        const int nig = WGM * nN, gid = wgid / nig, fm = gid * WGM, gsz = (nM - fm) < WGM ? (nM - fm) : WGM;
        u.pm = fm + ((wgid % nig) % gsz); u.pn = (wgid % nig) / gsz; u.arow = u.pm * BM; u.brow = u.pn * BM; u.aux = 0; return true;
    }
};
struct BranchOrder {
    StaticOrder S0;
    __device__ bool next(int i, Unit& u) const {
        if (!S0.next(i >> 1, u)) return false;
        const int which = i & 1; u.arow += which * NT; u.brow += which * DM; u.aux = which; return true;
    }
};
struct TableOrder {
    const int4* tab; int n, G, c;
    __device__ bool next(int i, Unit& u) const {
        const int L = i * G + c; if (L >= n) return false;
        const int4 e = tab[L]; u.arow = __builtin_amdgcn_readfirstlane(e.x); u.brow = __builtin_amdgcn_readfirstlane(e.y); u.aux = __builtin_amdgcn_readfirstlane(e.z); u.pn = __builtin_amdgcn_readfirstlane(e.w); u.pm = 0; return true;
    }
};
__device__ __forceinline__ unsigned cvt_pk_bf16(float lo, float hi) { return pk_bf16(lo, hi); }

template <class Epi, class Sched>
__device__ __forceinline__ void gemm_phase(PG8_LAS unsigned char* lds, const Gemm g, const Sched& S, const Epi& E) {
    const int tid = otid(), wid = __builtin_amdgcn_readfirstlane(tid >> 6), lane = tid & 63, wr = wid >> 2, wc = wid & 3, fr = lane & 15, fq = lane >> 4;
    const int K = g.K, nt = K / BK;
    int RA0; unsigned cofA0, voffB0;
    { int R, C; stage_rc(tid * 16, R, C); const int Rb = Epi::PERM ? ((R & ~31) + perm32(R & 31)) : R; RA0 = R; cofA0 = (unsigned)C * 2u; voffB0 = (unsigned)(Rb * K + C) * 2u; }
    const size_t rstep64 = (size_t)64 * K * 2;
    const size_t kstep = (size_t)(BK * 2);
    const size_t hstep = (size_t)HALF * K * 2;
    const unsigned ldsw = (unsigned)wid * 1024u;
    const int aoff = lds_byte(wr * 64 + fr, fq * 8), boff = lds_byte(wc * 32 + fr, fq * 8);
#define PG8_SA(b, h) (((b) * 2 + (h)) * HTB)
#define PG8_SB(b, h) ((4 + (b) * 2 + (h)) * HTB)
#define PG8_STAGE_B(bufoff, gbase) do { _Pragma("unroll") for (int _i = 0; _i < 2; ++_i) \
        __builtin_amdgcn_global_load_lds((const unsigned*)((const char*)(gbase) + _i * rstep64 + voffB0), (PG8_LAS unsigned*)(lds + (bufoff) + ldsw + _i * 8192), 16, 0, 0); } while (0)
#define PG8_STAGE_A(bufoff, o2, kb) do { _Pragma("unroll") for (int _i = 0; _i < 2; ++_i) \
        __builtin_amdgcn_global_load_lds((const unsigned*)((const char*)g.A + (size_t)(o2)[_i] + (size_t)(kb)), (PG8_LAS unsigned*)(lds + (bufoff) + ldsw + _i * 8192), 16, 0, 0); } while (0)
#define PG8_LDA(dst, b, h) do { _Pragma("unroll") for (int m = 0; m < 4; ++m) _Pragma("unroll") for (int k = 0; k < 2; ++k) dst[m][k] = *(const PG8_LAS bf16x8*)(lds + PG8_SA(b, h) + aoff + m * 2048 + k * 1024); } while (0)
#define PG8_LDB(dst, b, h) do { _Pragma("unroll") for (int n = 0; n < 2; ++n) _Pragma("unroll") for (int k = 0; k < 2; ++k) dst[n][k] = *(const PG8_LAS bf16x8*)(lds + PG8_SB(b, h) + boff + n * 2048 + k * 1024); } while (0)
#define PG8_MMA(ai, bj, At, Bt) do { __builtin_amdgcn_s_setprio(1); _Pragma("unroll") for (int m = 0; m < 4; ++m) _Pragma("unroll") for (int n = 0; n < 2; ++n) _Pragma("unroll") for (int k = 0; k < 2; ++k) \
        acc[ai][bj][m][n] = __builtin_amdgcn_mfma_f32_16x16x32_bf16(Bt[n][k], At[m][k], acc[ai][bj][m][n], 0, 0, 0); __builtin_amdgcn_s_setprio(0); } while (0)
#define PG8_WAIT_V(n) asm volatile("s_waitcnt vmcnt(" #n ")" ::: "memory")
#define PG8_WAIT_L(n) asm volatile("s_waitcnt lgkmcnt(" #n ")" ::: "memory")
#define PG8_BAR __builtin_amdgcn_s_barrier()
#define PG8_SCHED __builtin_amdgcn_sched_barrier(0)
#define PG8_AOFFS(u, dst) do { _Pragma("unroll") for (int _h = 0; _h < 2; ++_h) _Pragma("unroll") for (int _i = 0; _i < 2; ++_i) { \
        const int _tr = (u).arow + _h * HALF + RA0 + 64 * _i; const unsigned _row = g.gather ? (unsigned)g.gather[_tr] : (unsigned)_tr; dst[_h][_i] = _row * (unsigned)(K * 2) + cofA0; } } while (0)
    Unit cur, nxt; int ui = 0;
    if (!S.next(0, cur)) return;
    f32x4 acc[2][2][4][2];
#pragma unroll
    for (int a = 0; a < 2; ++a)
#pragma unroll
        for (int b = 0; b < 2; ++b)
#pragma unroll
            for (int m = 0; m < 4; ++m)
#pragma unroll
                for (int n = 0; n < 2; ++n) acc[a][b][m][n] = (f32x4){0.f, 0.f, 0.f, 0.f};
    bf16x8 At[4][2], B0[2][2], B1[2][2];
    unsigned cof[2][2];
    PG8_AOFFS(cur, cof);
    const char* cB = (const char*)g.Bt + (size_t)cur.brow * K * 2;
    PG8_STAGE_B(PG8_SB(0, 0), cB); PG8_STAGE_B(PG8_SB(0, 1), cB + hstep); PG8_STAGE_A(PG8_SA(0, 0), cof[0], 0); PG8_STAGE_A(PG8_SA(0, 1), cof[1], 0);
    if (wr == 1) PG8_BAR;
    PG8_WAIT_V(2); PG8_BAR;
    PG8_STAGE_B(PG8_SB(1, 0), cB + kstep); PG8_STAGE_A(PG8_SA(1, 0), cof[0], kstep); PG8_STAGE_B(PG8_SB(1, 1), cB + hstep + kstep);
    PG8_WAIT_V(6); PG8_BAR;
    for (;;) {
        const bool has_next = S.next(ui + 1, nxt);
        if (!has_next) nxt = cur;
        const char* nB = (const char*)g.Bt + (size_t)nxt.brow * K * 2;
        for (int t = 0; t < nt; t += 2) {
            const bool last = (t == nt - 2);
            const size_t k1 = (size_t)(t + 1) * kstep;
            const size_t k2 = last ? 0 : (size_t)(t + 2) * kstep, k3 = k2 + kstep;
            const char* b2 = last ? nB : cB + (size_t)(t + 2) * kstep; const char* b3 = b2 + kstep;
            PG8_LDB(B0, 0, 0); PG8_LDB(B1, 0, 1); PG8_SCHED; PG8_LDA(At, 0, 0); PG8_STAGE_A(PG8_SA(1, 1), cof[1], k1);
            if (last) { PG8_AOFFS(nxt, cof); }
            PG8_WAIT_V(8); PG8_WAIT_L(0); PG8_BAR; PG8_MMA(0, 0, At, B0); PG8_MMA(0, 1, At, B1); PG8_BAR; PG8_SCHED;
            PG8_LDA(At, 0, 1); PG8_STAGE_B(PG8_SB(0, 0), b2); PG8_STAGE_B(PG8_SB(0, 1), b2 + hstep); PG8_STAGE_A(PG8_SA(0, 0), cof[0], k2);
            PG8_WAIT_V(8); PG8_WAIT_L(0); PG8_BAR; PG8_MMA(1, 0, At, B0); PG8_MMA(1, 1, At, B1); PG8_BAR; PG8_SCHED;
            PG8_LDB(B0, 1, 0); PG8_LDB(B1, 1, 1); PG8_SCHED; PG8_LDA(At, 1, 0); PG8_STAGE_A(PG8_SA(0, 1), cof[1], k2);
            PG8_WAIT_V(8); PG8_WAIT_L(0); PG8_BAR; PG8_MMA(0, 0, At, B0); PG8_MMA(0, 1, At, B1); PG8_BAR; PG8_SCHED;
            PG8_LDA(At, 1, 1); PG8_STAGE_B(PG8_SB(1, 0), b3); PG8_STAGE_B(PG8_SB(1, 1), b3 + hstep); PG8_STAGE_A(PG8_SA(1, 0), cof[0], k3);
            PG8_WAIT_V(8); PG8_WAIT_L(0); PG8_BAR; PG8_MMA(1, 0, At, B0); PG8_MMA(1, 1, At, B1); PG8_BAR; PG8_SCHED;
        }
        if (wr == 0) PG8_BAR;
        { const int l2 = otid() & 63; E(acc, cur, wr, wc, l2 & 15, l2 >> 4); }
        if (!has_next) break;
#pragma unroll
        for (int a = 0; a < 2; ++a)
#pragma unroll
            for (int b = 0; b < 2; ++b)
#pragma unroll
                for (int m = 0; m < 4; ++m)
#pragma unroll
                    for (int n = 0; n < 2; ++n) acc[a][b][m][n] = (f32x4){0.f, 0.f, 0.f, 0.f};
        cur = nxt; cB = nB; ++ui;
        if (wr == 1) PG8_BAR;
    }
    PG8_WAIT_V(0);
    PG8_BAR;
#undef PG8_SA
#undef PG8_SB
#undef PG8_STAGE_A
#undef PG8_STAGE_B
#undef PG8_LDA
#undef PG8_LDB
#undef PG8_MMA
#undef PG8_WAIT_V
#undef PG8_WAIT_L
#undef PG8_BAR
#undef PG8_SCHED
#undef PG8_AOFFS
}

#define PG8_FENCE asm volatile("" ::: "memory")
#define PG8_FOR_TILE(ai, m, bj) _Pragma("unroll") for (int ai = 0; ai < 2; ++ai) _Pragma("unroll") for (int m = 0; m < 4; ++m) _Pragma("unroll") for (int bj = 0; bj < 2; ++bj)
__device__ __forceinline__ u32x4 pack8(const f32x4& v0, const f32x4& v1) { u32x4 w; w.x = cvt_pk_bf16(v0[0], v0[1]); w.y = cvt_pk_bf16(v0[2], v0[3]); w.z = cvt_pk_bf16(v1[0], v1[1]); w.w = cvt_pk_bf16(v1[2], v1[3]); return w; }
__device__ __forceinline__ float sigm(float x) { return __builtin_amdgcn_rcpf(1.f + __expf(-x)); }
struct EpiInproj {
    static constexpr bool PERM = true;
    unsigned char* ws; bf16_t* gates;
    __device__ __forceinline__ void operator()(const f32x4 (&acc)[2][2][4][2], const Unit& u, int wr, int wc, int fr, int fq) const {
        PG8_FOR_TILE(ai, m, bj) { PG8_FENCE;
            int row = u.pm * BM + ai * HALF + wr * 64 + m * 16 + fr; asm volatile("" : "+v"(row)); const int col = u.pn * BM + bj * HALF + wc * 32 + 8 * fq;
            const f32x4 v0 = acc[ai][bj][m][0], v1 = acc[ai][bj][m][1];
            if (col < C_KV) *(u32x4*)((bf16_t*)(ws + WS_Q) + (size_t)row * AW + col) = pack8(v0, v1);
            else if (col < C_QI) {
                *(u32x4*)((bf16_t*)(ws + WS_KVN) + (size_t)row * KVL + (col - C_KV)) = pack8(v0, v1);
                float ss = (v0[0] * v0[0] + v0[1] * v0[1]) + (v0[2] * v0[2] + v0[3] * v0[3]) + (v1[0] * v1[0] + v1[1] * v1[1]) + (v1[2] * v1[2] + v1[3] * v1[3]);
                ss += __shfl_xor(ss, 16); ss += __shfl_xor(ss, 32);
                if (fq == 0) ((float*)(ws + WS_RSS))[(size_t)row * 8 + bj * 4 + wc] = ss;
            }
            else if (col < C_PS) {
                if (col < 1056) {
                    typedef _Float16 h8 __attribute__((ext_vector_type(8)));
                    h8 hv; hv[0] = (_Float16)v0[0]; hv[1] = (_Float16)v0[1]; hv[2] = (_Float16)v0[2]; hv[3] = (_Float16)v0[3]; hv[4] = (_Float16)v1[0]; hv[5] = (_Float16)v1[1]; hv[6] = (_Float16)v1[2]; hv[7] = (_Float16)v1[3];
                    _Float16* d = (col < 1024) ? (_Float16*)(ws + WS_QI) + (size_t)row * 256 + (col - C_QI) : (_Float16*)(ws + WS_KI) + (size_t)row * 32 + (col - 1024);
                    *(h8*)d = hv;
                } else { const float sc_ = 0.17677669529663687f * 0.35355339059327373f; float* d = (float*)(ws + WS_WI) + (size_t)row * 8; *(f32x4*)d = v0 * sc_; *(f32x4*)(d + 4) = v1 * sc_; }
            }
            else if (col < C_GA) *(u32x4*)((bf16_t*)(ws + WS_PS) + (size_t)row * SHW + (col - C_PS)) = pack8(v0, v1);
            else if (col < INW) {
                f32x4 s0, s1;
#pragma unroll
                for (int e = 0; e < 4; ++e) { s0[e] = sigm(v0[e]); s1[e] = sigm(v1[e]); }
                bf16_t* d = (col < C_GR) ? gates + (size_t)row * DM + (col - C_GA) : gates + (size_t)NT * DM + (size_t)row * DM + (col - C_GR);
                *(u32x4*)d = pack8(s0, s1);
            }
        }
    }
};
struct EpiKV {
    static constexpr bool PERM = true;
    unsigned char* ws;
    __device__ __forceinline__ void operator()(const f32x4 (&acc)[2][2][4][2], const Unit& u, int wr, int wc, int fr, int fq) const {
        PG8_FOR_TILE(ai, m, bj) { PG8_FENCE;
            int row = u.pm * BM + ai * HALF + wr * 64 + m * 16 + fr; asm volatile("" : "+v"(row)); const int col = u.pn * BM + bj * HALF + wc * 32 + 8 * fq;
            const f32x4 ra = *(const f32x4*)((const float*)(ws + WS_RSS) + (size_t)row * 8), rb = *(const f32x4*)((const float*)(ws + WS_RSS) + (size_t)row * 8 + 4);
            const float rstd = rsqrtf((((ra[0] + ra[1]) + (ra[2] + ra[3])) + ((rb[0] + rb[1]) + (rb[2] + rb[3]))) * (1.f / KVL) + NORM_EPS);
            if (col < AW) *(u32x4*)((bf16_t*)(ws + WS_K) + (size_t)row * AW + col) = pack8(acc[ai][bj][m][0] * rstd, acc[ai][bj][m][1] * rstd);
            else {
                bf16_t* d = (bf16_t*)(ws + WS_V) + ((size_t)(row / SEQ) * 512 + (col - AW)) * SEQ + (row % SEQ);
#pragma unroll
                for (int e = 0; e < 4; ++e) { d[(size_t)e * SEQ] = f2bf(acc[ai][bj][m][0][e] * rstd); d[(size_t)(4 + e) * SEQ] = f2bf(acc[ai][bj][m][1][e] * rstd); }
            }
        }
    }
};
struct EpiMerge {
    static constexpr bool PERM = true;
    bf16_t* merged; const bf16_t* gates;
    __device__ __forceinline__ void operator()(const f32x4 (&acc)[2][2][4][2], const Unit& u, int wr, int wc, int fr, int fq) const {
        const bf16_t* gate = gates + (size_t)u.aux * NT * DM;
        PG8_FOR_TILE(ai, m, bj) { PG8_FENCE;
            int row = u.pm * BM + ai * HALF + wr * 64 + m * 16 + fr; asm volatile("" : "+v"(row)); const int col = u.pn * BM + bj * HALF + wc * 32 + 8 * fq;
            const u32x4 gw = *(const u32x4*)(gate + (size_t)row * DM + col);
            f32x4 v0 = acc[ai][bj][m][0], v1 = acc[ai][bj][m][1];
            v0[0] *= __uint_as_float(gw.x << 16); v0[1] *= __uint_as_float(gw.x & 0xffff0000u); v0[2] *= __uint_as_float(gw.y << 16); v0[3] *= __uint_as_float(gw.y & 0xffff0000u);
            v1[0] *= __uint_as_float(gw.z << 16); v1[1] *= __uint_as_float(gw.z & 0xffff0000u); v1[2] *= __uint_as_float(gw.w << 16); v1[3] *= __uint_as_float(gw.w & 0xffff0000u);
            u32x4* d = (u32x4*)(merged + (size_t)row * DM + col);
            if (u.aux) { const u32x4 pw = *d;
                v0[0] += __uint_as_float(pw.x << 16); v0[1] += __uint_as_float(pw.x & 0xffff0000u); v0[2] += __uint_as_float(pw.y << 16); v0[3] += __uint_as_float(pw.y & 0xffff0000u);
                v1[0] += __uint_as_float(pw.z << 16); v1[1] += __uint_as_float(pw.z & 0xffff0000u); v1[2] += __uint_as_float(pw.w << 16); v1[3] += __uint_as_float(pw.w & 0xffff0000u); }
            *d = pack8(v0, v1);
        }
    }
};
struct EpiOut {
    static constexpr bool PERM = false;
    const float* x; const float* mod; float* out;
    __device__ __forceinline__ void operator()(const f32x4 (&acc)[2][2][4][2], const Unit& u, int wr, int wc, int fr, int fq) const {
        PG8_FOR_TILE(ai, m, bj) { PG8_FENCE;
            int row = u.pm * BM + ai * HALF + wr * 64 + m * 16 + fr; asm volatile("" : "+v"(row)); const float* gt = mod + (row / SEQ) * 6 * DM + 2 * DM;
#pragma unroll
            for (int n = 0; n < 2; ++n) { const int col = u.pn * BM + bj * HALF + wc * 32 + 16 * n + 4 * fq;
                const f32x4 xv = *(const f32x4*)(x + (size_t)row * DM + col), gv = *(const f32x4*)(gt + col);
                *(f32x4*)(out + (size_t)row * DM + col) = xv + gv * acc[ai][bj][m][n]; }
        }
    }
};
struct EpiMoe1 {
    static constexpr bool PERM = true;
    bf16_t* hid; const float* lw;
    __device__ __forceinline__ void operator()(const f32x4 (&acc)[2][2][4][2], const Unit& u, int wr, int wc, int fr, int fq) const {
#pragma unroll
        for (int ai = 0; ai < 2; ++ai)
#pragma unroll
            for (int m = 0; m < 4; ++m) {
                const int tr = ai * HALF + wr * 64 + m * 16 + fr; PG8_FENCE;
                if (tr < u.aux) {
                    const float w = lw[u.arow + tr]; f32x4 h0, h1;
#pragma unroll
                    for (int e = 0; e < 4; ++e) { const float g0 = acc[ai][0][m][0][e], g1 = acc[ai][0][m][1][e];
                        h0[e] = w * (g0 * __builtin_amdgcn_rcpf(1.f + __expf(-g0))) * acc[ai][1][m][0][e]; h1[e] = w * (g1 * __builtin_amdgcn_rcpf(1.f + __expf(-g1))) * acc[ai][1][m][1][e]; }
                    *(u32x4*)(hid + (size_t)(u.arow + tr) * DE + u.pn * HALF + wc * 32 + 8 * fq) = pack8(h0, h1);
                }
            }
    }
};
struct EpiMoe2 {
    static constexpr bool PERM = false;
    const int* ltok; const float* mod; float* out;
    __device__ __forceinline__ void operator()(const f32x4 (&acc)[2][2][4][2], const Unit& u, int wr, int wc, int fr, int fq) const {
#pragma unroll
        for (int ai = 0; ai < 2; ++ai)
#pragma unroll
            for (int m = 0; m < 4; ++m) {
                const int tr = ai * HALF + wr * 64 + m * 16 + fr; PG8_FENCE;
                if (tr < u.aux) {
                    const int tok = ltok[u.arow + tr]; const float* gt = mod + (tok / SEQ) * 6 * DM + 5 * DM; float* orow = out + (size_t)tok * DM;
#pragma unroll
                    for (int bj = 0; bj < 2; ++bj)
#pragma unroll
                        for (int n = 0; n < 2; ++n) { const int col = u.pn * BM + bj * HALF + wc * 32 + 16 * n + 4 * fq;
                            const f32x4 gv = *(const f32x4*)(gt + col); f32x4* d = (f32x4*)(orow + col); *d = *d + gv * acc[ai][bj][m][n]; }
                }
            }
    }
};
}

__device__ __forceinline__ unsigned pk2(float lo, float hi) { return (unsigned)f2bf(lo) | ((unsigned)f2bf(hi) << 16); }
__device__ __forceinline__ void transpose_item(const float* W, int K, int N, bf16_t* WT, size_t drow0, int k0, int n0, float* scr, int lane, int Ksrc = 1 << 30, const float* kscale = nullptr) {
#pragma unroll 8
    for (int i = 0; i < 32; ++i) { const int kk = 2 * i + (lane >> 5), n = n0 + (lane & 31); float v_ = (n < N && k0 + kk < Ksrc) ? W[(size_t)(k0 + kk) * N + n] : 0.f; if (kscale) v_ *= kscale[k0 + kk]; scr[kk * 33 + (lane & 31)] = v_; }
    asm volatile("s_waitcnt lgkmcnt(0)" ::: "memory");
    const int c = lane & 7;
#pragma unroll
    for (int j = 0; j < 4; ++j) { const int n = (lane >> 3) + 8 * j; const float* s_ = scr + (8 * c) * 33 + n;
        uint4 o; o.x = pk2(s_[0 * 33], s_[1 * 33]); o.y = pk2(s_[2 * 33], s_[3 * 33]); o.z = pk2(s_[4 * 33], s_[5 * 33]); o.w = pk2(s_[6 * 33], s_[7 * 33]);
        *(uint4*)(WT + (drow0 + n) * K + k0 + 8 * c) = o; }
    asm volatile("s_waitcnt lgkmcnt(0)" ::: "memory");
}
__device__ void ph_convert_mixer_weights(const P& p, float* lds) {
    const int lane = otid() & 63, wv = otid() >> 6;
    float* scr = lds + wv * (64 * 33);
    const int gw = blockIdx.x * (NTHR / 64) + wv, nw = gridDim.x * (NTHR / 64);
    struct M { const float* W; int K, N, Npad; size_t dst; const float* ks; };
    const M ms[5] = { {p.in[5], DM, INW, 5120, WS_WIN, nullptr}, {p.in[7], KVL, 2 * AW, 2 * AW, WS_WKV, p.in[6]}, {p.in[21], AW, DM, DM, WS_WBA, nullptr}, {p.in[22], RW, DM, DM, WS_WBR, nullptr}, {p.in[23], DM, DM, DM, WS_WOUT, nullptr} };
    int base = 0;
#pragma unroll
    for (int q = 0; q < 5; ++q) {
        const int nkb = ms[q].K / 64, nnb = ms[q].Npad / 32, nitems = nkb * nnb;
        for (int it = gw; it < base + nitems; it += nw) { if (it < base) continue; const int r = it - base; const int kb = r / nnb, nb = r % nnb;
            transpose_item(ms[q].W, ms[q].K, ms[q].N, (bf16_t*)(p.ws + ms[q].dst), (size_t)nb * 32, kb * 64, nb * 32, scr, lane, 1 << 30, ms[q].ks); }
        base += nitems;
    }
}
__device__ void ph_convert_lora_weights(const P& p, float* lds) {
    const int lane = otid() & 63, wv = otid() >> 6;
    float* scr = lds + wv * (64 * 33);
    const int gw = blockIdx.x * (NTHR / 64) + wv, nw = gridDim.x * (NTHR / 64);
    for (int it = gw; it < 16 + 16 + 48; it += nw) {
        if (it < 16) transpose_item(p.in[12], 64, RW, (bf16_t*)(p.ws + WS_LW2T), (size_t)it * 32, 0, it * 32, scr, lane);
        else if (it < 32) transpose_item(p.in[14], 64, RW, (bf16_t*)(p.ws + WS_LA2T), (size_t)(it - 16) * 32, 0, (it - 16) * 32, scr, lane);
        else { const int r = it - 32, kb = r >> 4, nb = r & 15; transpose_item(p.in[15], 192, RW, (bf16_t*)(p.ws + WS_LG2T), (size_t)nb * 32, kb * 64, nb * 32, scr, lane, 160); }
    }
}
__device__ void ph_convert_expert_weights(const P& p, float* lds) {
    const int lane = otid() & 63, wv = otid() >> 6;
    float* scr = lds + wv * (64 * 33);
    const int gw = blockIdx.x * (NTHR / 64) + wv, nw = gridDim.x * (NTHR / 64);
    for (int it = gw; it < NE * 2 * 256; it += nw) { const int e = it >> 9, which = (it >> 8) & 1, r = it & 255, kb = r >> 4, nb = r & 15, n0 = nb * 32;
        transpose_item(p.in[28 + which] + (size_t)e * DM * DE, DM, DE, (bf16_t*)(p.ws + WS_WGU), (size_t)e * 1024 + (n0 >> 7) * 256 + which * 128 + (n0 & 127), kb * 64, n0, scr, lane); }
    for (int it = gw; it < NE * 256; it += nw) { const int e = it >> 8, r = it & 255, kb = r >> 5, nb = r & 31;
        transpose_item(p.in[30] + (size_t)e * DE * DM, DE, DM, (bf16_t*)(p.ws + WS_WDN), (size_t)e * 1024 + nb * 32, kb * 64, nb * 32, scr, lane); }
}

__device__ void ph_headnorm(bf16_t* X, const float* g) {
    const int lane = otid() & 63, wv = otid() >> 6;
    const int gw = blockIdx.x * (NTHR / 64) + wv, nw = gridDim.x * (NTHR / 64);
    for (int m = gw; m < NT; m += nw) {
        uint4 raw = *(const uint4*)(X + (size_t)m * AW + lane * 8);
        float v[8] = {bf2f(raw.x & 0xffff), bf2f(raw.x >> 16), bf2f(raw.y & 0xffff), bf2f(raw.y >> 16), bf2f(raw.z & 0xffff), bf2f(raw.z >> 16), bf2f(raw.w & 0xffff), bf2f(raw.w >> 16)};
        float ss = 0.f;
#pragma unroll
        for (int i = 0; i < 8; ++i) ss += v[i] * v[i];
        ss += __shfl_xor(ss, 1); ss += __shfl_xor(ss, 2); ss += __shfl_xor(ss, 4);
        const float rstd = rsqrtf(ss * (1.f / 64.f) + NORM_EPS);
        const int d0 = (lane & 7) * 8;
        unsigned o[4];
#pragma unroll
        for (int i = 0; i < 4; ++i) o[i] = (unsigned)f2bf(v[2 * i] * rstd * g[d0 + 2 * i]) | ((unsigned)f2bf(v[2 * i + 1] * rstd * g[d0 + 2 * i + 1]) << 16);
        *(uint4*)(X + (size_t)m * AW + lane * 8) = make_uint4(o[0], o[1], o[2], o[3]);
    }
}
__device__ void ph_kvnorm(bf16_t* X, const float* g) {
    const int lane = otid() & 63, wv = otid() >> 6;
    const int gw = blockIdx.x * (NTHR / 64) + wv, nw = gridDim.x * (NTHR / 64);
    for (int m = gw; m < NT; m += nw) {
        uint2 raw = *(const uint2*)(X + (size_t)m * KVL + lane * 4);
        float v[4] = {bf2f(raw.x & 0xffff), bf2f(raw.x >> 16), bf2f(raw.y & 0xffff), bf2f(raw.y >> 16)};
        float ss = wave_sum(v[0] * v[0] + v[1] * v[1] + v[2] * v[2] + v[3] * v[3]);
        const float rstd = rsqrtf(ss * (1.f / 256.f) + NORM_EPS);
        uint2 o; o.x = (unsigned)f2bf(v[0] * rstd * g[lane * 4]) | ((unsigned)f2bf(v[1] * rstd * g[lane * 4 + 1]) << 16);
        o.y = (unsigned)f2bf(v[2] * rstd * g[lane * 4 + 2]) | ((unsigned)f2bf(v[3] * rstd * g[lane * 4 + 3]) << 16);
        *(uint2*)(X + (size_t)m * KVL + lane * 4) = o;
    }
}

typedef _Float16 half8_t __attribute__((ext_vector_type(8)));
typedef float f32x16_t __attribute__((ext_vector_type(16)));
__device__ __forceinline__ unsigned f2key(float f) { unsigned u = __float_as_uint(f); return (u & 0x80000000u) ? ~u : (u | 0x80000000u); }
template <bool PASS1, bool FULL>
__device__ __forceinline__ void d1_unit(const half8_t& a0, const half8_t& a1, const half8_t& b0, const half8_t& b1, const float (&w)[4][4], int rg, int hh, int r32, int tile, int t0,
                                        unsigned* hist, unsigned* maskl, int* misc, uint2* cand, int tbA, int tbB) {
    constexpr int CCAP = 1024;
    f32x16_t c;
#pragma unroll
    for (int i = 0; i < 16; ++i) c[i] = 0.f;
    c = __builtin_amdgcn_mfma_f32_32x32x16_f16(a0, b0, c, 0, 0, 0);
    c = __builtin_amdgcn_mfma_f32_32x32x16_f16(a1, b1, c, 0, 0, 0);
    float x[4];
#pragma unroll
    for (int tl = 0; tl < 4; ++tl) { x[tl] = 0.f;
#pragma unroll
        for (int e = 0; e < 4; ++e) x[tl] = __builtin_fmaf(w[tl][e], __int_as_float(max(__float_as_int(c[4 * tl + e]), 0)), x[tl]); }
    const auto s01 = __builtin_amdgcn_permlane32_swap(__float_as_uint(x[0]), __float_as_uint(x[1]), false, false);
    const auto s23 = __builtin_amdgcn_permlane32_swap(__float_as_uint(x[2]), __float_as_uint(x[3]), false, false);
    const unsigned k01 = f2key(__uint_as_float(s01[0]) + __uint_as_float(s01[1]));
    const unsigned k23 = f2key(__uint_as_float(s23[0]) + __uint_as_float(s23[1]));
    const int rowA = 4 * rg + hh, rowB = rowA + 2, key = tile * 32 + r32;
    const bool okA = FULL || key <= t0 + rowA, okB = FULL || key <= t0 + rowB;
    if (!PASS1) {
        atomicAdd(&hist[okA ? rowA * 2048 + (int)(k01 >> 21) : 8 * 2048 + 16384 + 2048 + 7], 1u << (16 * ((k01 >> 20) & 1u)));
        atomicAdd(&hist[okB ? rowB * 2048 + (int)(k23 >> 21) : 8 * 2048 + 16384 + 2048 + 7], 1u << (16 * ((k23 >> 20) & 1u)));
    } else {
        const int binA = (int)(k01 >> 20), binB = (int)(k23 >> 20);
        const unsigned long long mA = __ballot(okA && binA > tbA), mB = __ballot(okB && binB > tbB);
        if (r32 == 0) { maskl[rowA * 256 + tile] = hh ? (unsigned)(mA >> 32) : (unsigned)mA; maskl[rowB * 256 + tile] = hh ? (unsigned)(mB >> 32) : (unsigned)mB; }
        if (okA && binA == tbA) { const int pos = atomicAdd(&misc[rowA * 8 + 2], 1); if (pos < CCAP) cand[rowA * CCAP + pos] = make_uint2(k01, (unsigned)key); }
        if (okB && binB == tbB) { const int pos = atomicAdd(&misc[rowB * 8 + 2], 1); if (pos < CCAP) cand[rowB * CCAP + pos] = make_uint2(k23, (unsigned)key); }
    }
}
__device__ void ph_dsa_select(const P& p, float* ldsf) {
    const _Float16* QI = (const _Float16*)(p.ws + WS_QI); const _Float16* KI = (const _Float16*)(p.ws + WS_KI); const float* WI = (const float*)(p.ws + WS_WI);
    unsigned* MASK32 = (unsigned*)(p.ws + WS_MASK);
    unsigned* hist = (unsigned*)ldsf;
    uint2* cand = (uint2*)(hist + 8 * 2048);
    unsigned* maskl = (unsigned*)(cand + 8 * 1024);
    unsigned* h2 = hist;
    int* misc = (int*)(maskl + 8 * 256);
    constexpr int CCAP = 1024;
    const int tid = otid(), lane = tid & 63, wv = tid >> 6, hh = lane >> 5, r32 = lane & 31;
    const int nrnd = (NT / 8 + (int)gridDim.x - 1) / (int)gridDim.x;
#pragma unroll 1
    for (int rnd = 0; rnd < nrnd; ++rnd) {
        const int item = __builtin_amdgcn_readfirstlane(rnd * (int)gridDim.x + ((rnd & 1) ? (int)(gridDim.x - 1 - blockIdx.x) : (int)blockIdx.x));
        if (item >= NT / 8) continue;
        const int tq0 = item * 8, b = tq0 / SEQ, t0 = tq0 % SEQ;
        const int nwords = ((t0 >> 8) + 1) * 8;
        __syncthreads();
        if (t0 + 7 < TOPK) {
            for (int e = tid; e < 8 * nwords; e += NTHR) { const int row = e / nwords, w = e % nwords; const int tr_ = t0 + row; const int lo = 32 * w;
                const unsigned bits = (tr_ >= lo + 31) ? 0xffffffffu : ((tr_ < lo) ? 0u : ((2u << (tr_ - lo)) - 1u));
                MASK32[(size_t)(tq0 + row) * 256 + w] = bits; }
            continue;
        }
        for (int e = tid; e < 8 * 2048; e += NTHR) hist[e] = 0u;
        for (int e = tid; e < 8 * 256; e += NTHR) maskl[e] = 0u;
        if (tid < 64) misc[tid] = 0;
        half8_t a0[2], a1[2]; float w[2][4][4];
#pragma unroll
        for (int rg = 0; rg < 2; ++rg) { const int tl_a = r32 >> 3, h_a = r32 & 7; const _Float16* qp = QI + (size_t)(tq0 + 4 * rg + tl_a) * 256 + h_a * 32 + 8 * hh;
            a0[rg] = *(const half8_t*)qp; a1[rg] = *(const half8_t*)(qp + 16);
#pragma unroll
            for (int tl = 0; tl < 4; ++tl) { const float4 wv4 = *(const float4*)(WI + (size_t)(tq0 + 4 * rg + tl) * 8 + 4 * hh); w[rg][tl][0] = wv4.x; w[rg][tl][1] = wv4.y; w[rg][tl][2] = wv4.z; w[rg][tl][3] = wv4.w; } }
        const int ntile = (t0 + 7) / 32 + 1;
        __syncthreads();
        int thr_bin[8];
#pragma unroll 1
        for (int pass = 0; pass < 2; ++pass) {
            if (pass == 1) {
#pragma unroll
                for (int r = 0; r < 8; ++r) thr_bin[r] = misc[r * 8];
            }
            half8_t kb0[4], kb1[4], nk0[4], nk1[4];
#pragma unroll
            for (int q = 0; q < 4; ++q) { const int tl_ = min(4 * wv + q, ntile - 1); const _Float16* kp = KI + (size_t)(b * SEQ + tl_ * 32 + r32) * 32 + 8 * hh; nk0[q] = *(const half8_t*)kp; nk1[q] = *(const half8_t*)(kp + 16); }
            for (int tbase = 4 * wv; tbase < ntile; tbase += 32) {
#pragma unroll
                for (int q = 0; q < 4; ++q) { kb0[q] = nk0[q]; kb1[q] = nk1[q]; }
                if (tbase + 32 < ntile) {
#pragma unroll
                    for (int q = 0; q < 4; ++q) { const int tl_ = min(tbase + 32 + q, ntile - 1); const _Float16* kp = KI + (size_t)(b * SEQ + tl_ * 32 + r32) * 32 + 8 * hh; nk0[q] = *(const half8_t*)kp; nk1[q] = *(const half8_t*)(kp + 16); }
                }
#pragma unroll
                for (int q = 0; q < 4; ++q) {
                const int tile = tbase + q;
                if (tile < ntile) {
                const half8_t b0 = kb0[q], b1 = kb1[q];
                const bool full = tile * 32 + 31 <= t0;
#pragma unroll
                for (int rg = 0; rg < 2; ++rg) {
                    const int tbA = hh ? thr_bin[4 * rg + 1] : thr_bin[4 * rg], tbB = hh ? thr_bin[4 * rg + 3] : thr_bin[4 * rg + 2];
                    if (pass == 0) { if (full) d1_unit<false, true>(a0[rg], a1[rg], b0, b1, w[rg], rg, hh, r32, tile, t0, hist, maskl, misc, cand, 0, 0);
                                     else d1_unit<false, false>(a0[rg], a1[rg], b0, b1, w[rg], rg, hh, r32, tile, t0, hist, maskl, misc, cand, 0, 0); }
                    else { if (full) d1_unit<true, true>(a0[rg], a1[rg], b0, b1, w[rg], rg, hh, r32, tile, t0, hist, maskl, misc, cand, tbA, tbB);
                           else d1_unit<true, false>(a0[rg], a1[rg], b0, b1, w[rg], rg, hh, r32, tile, t0, hist, maskl, misc, cand, tbA, tbB); }
                }
                }
                }
            }
            __syncthreads();
            if (pass == 0) {
                const unsigned* hrw = hist + wv * 2048; unsigned tot = 0;
                { const uint4* h4 = (const uint4*)(hrw + 32 * lane);
#pragma unroll
                  for (int i = 0; i < 8; ++i) { const uint4 v = h4[i]; tot += (v.x & 0xffffu) + (v.x >> 16) + (v.y & 0xffffu) + (v.y >> 16) + (v.z & 0xffffu) + (v.z >> 16) + (v.w & 0xffffu) + (v.w >> 16); } }
                unsigned suf = tot;
#pragma unroll
                for (int o = 1; o < 64; o <<= 1) { const unsigned oth = __shfl_down(suf, o); if (lane + o < 64) suf += oth; }
                const unsigned above = suf - tot;
                const unsigned long long hit = __ballot((int)above < TOPK && TOPK <= (int)(above + tot));
                const int lsel = __ffsll((long long)hit) - 1; const unsigned above_g = __shfl(above, lsel);
                const unsigned wd = hrw[32 * lsel + (lane >> 1)]; const unsigned cnt = (lane & 1) ? (wd >> 16) : (wd & 0xffffu);
                unsigned s2 = cnt;
#pragma unroll
                for (int o = 1; o < 64; o <<= 1) { const unsigned oth = __shfl_down(s2, o); if (lane + o < 64) s2 += oth; }
                const unsigned ab2 = above_g + s2 - cnt;
                if ((int)ab2 < TOPK && TOPK <= (int)(ab2 + cnt)) { misc[wv * 8] = 64 * lsel + lane; misc[wv * 8 + 1] = TOPK - (int)ab2; }
                __syncthreads();
            }
        }
        {
            const int row = wv, need0 = misc[row * 8 + 1]; const int cn = min(misc[row * 8 + 2], CCAP);
            const uint2* cr = cand + row * CCAP; unsigned* hrow = h2 + row * 256;
            unsigned prefix = 0; int remaining = need0, cnt_eq = cn;
#pragma unroll 1
            for (int pass = 0; pass < 3; ++pass) {
                const int shift = (pass == 0) ? 12 : ((pass == 1) ? 4 : 0), nb = (pass == 2) ? 4 : 8;
                for (int i = lane; i < 256; i += 64) hrow[i] = 0u;
                __builtin_amdgcn_wave_barrier(); asm volatile("s_waitcnt lgkmcnt(0)" ::: "memory");
                for (int i = lane; i < cn; i += 64) { const unsigned k = cr[i].x & 0xfffffu; if (pass == 0 || (k >> (shift + nb)) == (prefix >> (shift + nb))) atomicAdd(&hrow[(k >> shift) & ((1u << nb) - 1u)], 1u); }
                __builtin_amdgcn_wave_barrier(); asm volatile("s_waitcnt lgkmcnt(0)" ::: "memory");
                const unsigned h0 = hrow[4 * lane], h1 = hrow[4 * lane + 1], h2_ = hrow[4 * lane + 2], h3 = hrow[4 * lane + 3];
                unsigned suf = h0 + h1 + h2_ + h3;
#pragma unroll
                for (int o = 1; o < 64; o <<= 1) { const unsigned oth = __shfl_down(suf, o); if (lane + o < 64) suf += oth; }
                const unsigned above3 = suf - (h0 + h1 + h2_ + h3);
                const unsigned ab[4] = {above3 + h3 + h2_ + h1, above3 + h3 + h2_, above3 + h3, above3}; const unsigned hv[4] = {h0, h1, h2_, h3};
                int selbin = -1, newrem = 0, neweq = 0;
#pragma unroll
                for (int q = 0; q < 4; ++q) if ((int)ab[q] < remaining && remaining <= (int)(ab[q] + hv[q])) { selbin = 4 * lane + q; newrem = remaining - (int)ab[q]; neweq = (int)hv[q]; }
                const unsigned long long has = __ballot(selbin >= 0); const int src = __ffsll((long long)has) - 1;
                selbin = __shfl(selbin, src); newrem = __shfl(newrem, src); neweq = __shfl(neweq, src);
                prefix |= ((unsigned)selbin) << shift; remaining = newrem; cnt_eq = neweq;
            }
            for (int i0 = 0; i0 < cn; i0 += 64) { const int i = i0 + lane; bool sel = false;
                if (i < cn) { const uint2 ce = cr[i]; const unsigned k = ce.x & 0xfffffu;
                    if (k > prefix) sel = true;
                    else if (k == prefix) { if (cnt_eq == remaining) sel = true; else { int rank = 0; for (int j = 0; j < cn; ++j) { const uint2 cj = cr[j]; rank += ((cj.x & 0xfffffu) == prefix && cj.y < ce.y) ? 1 : 0; } sel = rank < remaining; } }
                    if (sel) atomicOr(&maskl[row * 256 + (ce.y >> 5)], 1u << (ce.y & 31)); } }
        }
        __syncthreads();
        for (int e = tid; e < 8 * nwords; e += NTHR) { const int row = e / nwords, w2 = e % nwords; MASK32[(size_t)(tq0 + row) * 256 + w2] = maskl[row * 256 + w2]; }
    }
}

__device__ void knorm_tile(const P& p, int pm, int pn) {
    bf16_t* Kg = (bf16_t*)(p.ws + WS_K); const float* kg = p.in[9];
    const int tid = otid();
    for (int pr = tid; pr < 1024; pr += NTHR) {
        const int row = pm * 256 + (pr >> 2), head = pn * 4 + (pr & 3);
        uint4* ptr = (uint4*)(Kg + (size_t)row * AW + head * 64);
        uint4 v[8]; float ss = 0.f;
#pragma unroll
        for (int c = 0; c < 8; ++c) { v[c] = ptr[c]; const unsigned w[4] = {v[c].x, v[c].y, v[c].z, v[c].w};
#pragma unroll
            for (int e = 0; e < 4; ++e) { const float a = __uint_as_float(w[e] << 16), b2 = __uint_as_float(w[e] & 0xffff0000u); ss += a * a + b2 * b2; } }
        const float rstd = rsqrtf(ss * (1.f / 64.f) + NORM_EPS);
#pragma unroll
        for (int c = 0; c < 8; ++c) { const unsigned w[4] = {v[c].x, v[c].y, v[c].z, v[c].w}; unsigned o[4];
            const float4 g0 = *(const float4*)(kg + 8 * c), g1 = *(const float4*)(kg + 8 * c + 4); const float gv[8] = {g0.x, g0.y, g0.z, g0.w, g1.x, g1.y, g1.z, g1.w};
#pragma unroll
            for (int e = 0; e < 4; ++e) o[e] = pk2(__uint_as_float(w[e] << 16) * rstd * gv[2 * e], __uint_as_float(w[e] & 0xffff0000u) * rstd * gv[2 * e + 1]);
            ptr[c] = make_uint4(o[0], o[1], o[2], o[3]); }
    }
}
typedef unsigned u32x4_t __attribute__((ext_vector_type(4)));
__device__ __forceinline__ bf16x8_t pack_step16(const f32x16_t& x, int s2) {
    u32x4_t pk;
    if (s2 == 0) { pk[0] = pk_bf16(x[0], x[1]); pk[1] = pk_bf16(x[2], x[3]); pk[2] = pk_bf16(x[4], x[5]); pk[3] = pk_bf16(x[6], x[7]); }
    else { pk[0] = pk_bf16(x[8], x[9]); pk[1] = pk_bf16(x[10], x[11]); pk[2] = pk_bf16(x[12], x[13]); pk[3] = pk_bf16(x[14], x[15]); }
    return __builtin_bit_cast(bf16x8_t, pk);
}
__device__ __forceinline__ float xhalf_max(float x) { const auto t = __builtin_amdgcn_permlane32_swap(__float_as_uint(x), __float_as_uint(x), false, false); return fmaxf(__uint_as_float(t[0]), __uint_as_float(t[1])); }
__device__ __forceinline__ float xhalf_sum(float x) { const auto t = __builtin_amdgcn_permlane32_swap(__float_as_uint(x), __float_as_uint(x), false, false); return __uint_as_float(t[0]) + __uint_as_float(t[1]); }
__device__ __forceinline__ short bf16_of_int(int v) { return (short)(__float_as_uint((float)v) >> 16); }
#define MFMA32(a, b, c) __builtin_amdgcn_mfma_f32_32x32x16_bf16((a), (b), (c), 0, 0, 0)
__device__ void ph_dsa_attn(const P& p, float* ldsf) {
    const unsigned long long* MASK = (const unsigned long long*)(p.ws + WS_MASK);
    const bf16_t* Q = (const bf16_t*)(p.ws + WS_Q); const bf16_t* Kg = (const bf16_t*)(p.ws + WS_K); const bf16_t* VT = (const bf16_t*)(p.ws + WS_V);
    bf16_t* O = (bf16_t*)(p.ws + WS_OATT);
    bf16_t* L = (bf16_t*)ldsf;
    const int tid = otid(), lane = tid & 63, wv = tid >> 6, hh = lane >> 5, r32 = lane & 31;
    const float CS = 0.125f * 1.4426950408889634f;
    const float NEG = -1e30f;
    const int skey = tid >> 3, sch = (tid & 7) * 8;
    const float* qg = p.in[8];
    float kgmax; { const float v = fabsf(p.in[9][lane]); kgmax = wave_max(v); }
    int* qhead = (int*)(p.ws + WS_CTL) + CT_Q; int* bcast = (int*)(L + 4 * SLOT); int* sflag = bcast + 4;
    for (int tr_ = 0; tr_ < 8; ++tr_) {
        const int grp = (blockIdx.x + tr_) & 7;
        for (;;) {
            __syncthreads();
            if (tid == 0) *bcast = atomicAdd(qhead + grp, 1);
            __syncthreads();
            const int kq = *bcast;
            if (kq >= 64) break;
            const int bh = grp + 8 * (kq & 1), qb = 31 - (kq >> 1), b = bh >> 3, h = bh & 7;
            const bf16_t* Kbase = Kg + (size_t)b * SEQ * AW + h * 64; const bf16_t* Vbase = VT + (size_t)bh * 64 * SEQ;
            {
            const int q0 = qb * 256 + wv * 32, q = q0 + r32, ntile = 4 * (qb + 1);
            const size_t qrow = (size_t)b * SEQ + q;
            bf16x8_t bq[5]; float qk_bound;
#pragma unroll
            for (int s2 = 0; s2 < 4; ++s2) bq[s2] = *(const bf16x8_t*)(Q + qrow * AW + h * 64 + 16 * s2 + 8 * hh);
            {
                float ss = 0.f;
#pragma unroll
                for (int s2 = 0; s2 < 4; ++s2)
#pragma unroll
                    for (int j = 0; j < 8; ++j) { const float v = bf2f((bf16_t)bq[s2][j]); ss += v * v; }
                ss = xhalf_sum(ss);
                const float rstd = rsqrtf(ss * (1.f / 64.f) + NORM_EPS);
                float qq = 0.f;
#pragma unroll
                for (int s2 = 0; s2 < 4; ++s2) { const float4 g0 = *(const float4*)(qg + 16 * s2 + 8 * hh), g1 = *(const float4*)(qg + 16 * s2 + 8 * hh + 4); const float gv[8] = {g0.x, g0.y, g0.z, g0.w, g1.x, g1.y, g1.z, g1.w};
                    u32x4_t w;
#pragma unroll
                    for (int j2 = 0; j2 < 4; ++j2) { const float e0 = bf2f((bf16_t)bq[s2][2 * j2]) * rstd * gv[2 * j2], e1 = bf2f((bf16_t)bq[s2][2 * j2 + 1]) * rstd * gv[2 * j2 + 1]; qq += e0 * e0 + e1 * e1; w[j2] = pk_bf16(e0, e1); }
                    bq[s2] = __builtin_bit_cast(bf16x8_t, w); }
                qk_bound = sqrtf(xhalf_sum(qq)) * kgmax * 1.03f;
            }
#pragma unroll
            for (int j = 0; j < 8; ++j) bq[4][j] = 0;
            if (hh == 0) { bq[4][0] = bf16_of_int(256 >> h); bq[4][1] = (short)(__float_as_uint(4.f / (float)(1 << h)) >> 16); }
            f32x16_t o0, o1;
#pragma unroll
            for (int i = 0; i < 16; ++i) { o0[i] = 0.f; o1[i] = 0.f; }
            float m_run = NEG, l_run = 0.f;
            __syncthreads();
            const float slope_l2 = 1.4426950408889634f / (float)(2 << h);
            { const int kt0 = ntile - 1; const uint4 kr = *(const uint4*)(Kbase + (size_t)(kt0 * 64 + skey) * AW + sch), vr = *(const uint4*)(Vbase + (size_t)skey * SEQ + kt0 * 64 + sch);
              *(uint4*)(L + (kt0 & 1) * SLOT + skey * LP + sch) = kr; *(uint4*)(L + (2 + (kt0 & 1)) * SLOT + skey * LP + sch) = vr; }
            unsigned long long mw = MASK[qrow * 128 + ntile - 1];
            if (tid < 16) sflag[tid] = 0;
            __syncthreads();
#pragma unroll 1
            for (int kt = ntile - 1; kt >= 0; --kt) {
                const int buf = kt & 1; const bool more = kt > 0;
                if (kt < ntile - 1) { int alld = 1;
#pragma unroll
                    for (int w2 = 0; w2 < 8; ++w2) alld &= sflag[((kt + 1) & 1) * 8 + w2];
                    if (alld) break; }
                uint4 kr = make_uint4(0, 0, 0, 0), vr = make_uint4(0, 0, 0, 0); unsigned long long mwn = 0ull;
                if (more) { kr = *(const uint4*)(Kbase + (size_t)((kt - 1) * 64 + skey) * AW + sch); vr = *(const uint4*)(Vbase + (size_t)skey * SEQ + (kt - 1) * 64 + sch); mwn = MASK[qrow * 128 + kt - 1]; }
                if (kt * 64 <= q0 + 31) {
                    const bf16_t* Kl = L + buf * SLOT; const bf16_t* Vl = L + (2 + buf) * SLOT;
                    f32x16_t p0, p1;
#pragma unroll
                    for (int i = 0; i < 16; ++i) { p0[i] = 0.f; p1[i] = 0.f; }
#pragma unroll
                    for (int s2 = 0; s2 < 4; ++s2) {
                        const bf16x8_t a0 = *(const bf16x8_t*)(Kl + r32 * LP + 16 * s2 + 8 * hh), a1 = *(const bf16x8_t*)(Kl + (32 + r32) * LP + 16 * s2 + 8 * hh);
                        p0 = MFMA32(a0, bq[s2], p0); p1 = MFMA32(a1, bq[s2], p1);
                    }
                    { bf16x8_t g0, g1;
#pragma unroll
                      for (int j = 0; j < 8; ++j) { g0[j] = 0; g1[j] = 0; }
                      if (hh == 0) { g0[0] = bf16_of_int(kt); g0[1] = bf16_of_int(r32); g1[0] = g0[0]; g1[1] = bf16_of_int(32 + r32); }
                      p0 = MFMA32(g0, bq[4], p0); p1 = MFMA32(g1, bq[4], p1); }
                    const unsigned wl = (unsigned)mw >> (4 * hh), wh = (unsigned)(mw >> 32) >> (4 * hh);
                    float mx = NEG;
#pragma unroll
                    for (int i = 0; i < 16; ++i) { const int bp = (i & 3) + 8 * (i >> 2);
                        const int m0 = __builtin_amdgcn_sbfe((int)wl, bp, 1), m1 = __builtin_amdgcn_sbfe((int)wh, bp, 1);
                        const float a_ = __uint_as_float((__float_as_uint(p0[i]) & (unsigned)m0) | (__float_as_uint(NEG) & ~(unsigned)m0));
                        const float b_ = __uint_as_float((__float_as_uint(p1[i]) & (unsigned)m1) | (__float_as_uint(NEG) & ~(unsigned)m1));
                        p0[i] = a_; p1[i] = b_;
                        mx = __builtin_fmaxf(mx, __builtin_fmaxf(a_, b_)); }
                    mx = xhalf_max(mx);
                    const float m_new = fmaxf(m_run, mx);
                    const float alpha = __builtin_amdgcn_exp2f((m_run - m_new) * CS);
                    m_run = m_new;
                    const float mc = fmaxf(m_new, -1e20f) * CS;
                    float rs = 0.f;
#pragma unroll
                    for (int i = 0; i < 16; ++i) { p0[i] = __builtin_amdgcn_exp2f(p0[i] * CS - mc); p1[i] = __builtin_amdgcn_exp2f(p1[i] * CS - mc); rs += p0[i] + p1[i]; }
                    l_run = l_run * alpha + rs;
#pragma unroll
                    for (int i = 0; i < 16; ++i) { o0[i] *= alpha; o1[i] *= alpha; }
                    bf16x8_t pb[4];
                    pb[0] = pack_step16(p0, 0); pb[1] = pack_step16(p0, 1); pb[2] = pack_step16(p1, 0); pb[3] = pack_step16(p1, 1);
#pragma unroll
                    for (int ks = 0; ks < 4; ++ks) {
                        const int kofs = 32 * (ks >> 1) + 16 * (ks & 1) + 4 * hh;
                        typedef short s16x4_t __attribute__((ext_vector_type(4)));
                        const s16x4_t v00 = *(const s16x4_t*)(Vl + r32 * LP + kofs), v01 = *(const s16x4_t*)(Vl + r32 * LP + kofs + 8);
                        const s16x4_t v10 = *(const s16x4_t*)(Vl + (32 + r32) * LP + kofs), v11 = *(const s16x4_t*)(Vl + (32 + r32) * LP + kofs + 8);
                        bf16x8_t av0, av1;
#pragma unroll
                        for (int j = 0; j < 4; ++j) { av0[j] = v00[j]; av0[4 + j] = v01[j]; av1[j] = v10[j]; av1[4 + j] = v11[j]; }
                        o0 = MFMA32(av0, pb[ks], o0); o1 = MFMA32(av1, pb[ks], o1);
                    }
                }
                if (more) { *(uint4*)(L + (buf ^ 1) * SLOT + skey * LP + sch) = kr; *(uint4*)(L + (2 + (buf ^ 1)) * SLOT + skey * LP + sch) = vr; }
                mw = mwn;
                {
                    const bool row_done = (qk_bound * 1.4426950408889634f + slope_l2 * (float)(64 * kt - 1)) < m_run * CS - 150.f;
                    const int wdone = __all(row_done) ? 1 : 0;
                    if (lane == 0) sflag[(kt & 1) * 8 + wv] = wdone;
                }
                __syncthreads();
            }
            const float inv = 1.f / xhalf_sum(l_run);
            bf16_t* orow = O + qrow * AW + h * 64 + 4 * hh;
#pragma unroll
            for (int g = 0; g < 4; ++g) {
                uint2 w0, w1;
                w0.x = (unsigned)f2bf(o0[4 * g] * inv) | ((unsigned)f2bf(o0[4 * g + 1] * inv) << 16); w0.y = (unsigned)f2bf(o0[4 * g + 2] * inv) | ((unsigned)f2bf(o0[4 * g + 3] * inv) << 16);
                w1.x = (unsigned)f2bf(o1[4 * g] * inv) | ((unsigned)f2bf(o1[4 * g + 1] * inv) << 16); w1.y = (unsigned)f2bf(o1[4 * g + 2] * inv) | ((unsigned)f2bf(o1[4 * g + 3] * inv) << 16);
                *(uint2*)(orow + 8 * g) = w0; *(uint2*)(orow + 32 + 8 * g) = w1;
            }
            }
        }
    }
}

constexpr int AP = 328, RP = 1544;
__device__ __forceinline__ f32x4_t mm16(const bf16_t* X, int xrs, const bf16_t* Y, int ycs, int nks, f32x4_t acc, int lane) {
    const int r = lane & 15, q = lane >> 4;
    for (int s2 = 0; s2 < nks; ++s2) {
        const bf16x8_t a = *(const bf16x8_t*)(X + r * xrs + 32 * s2 + 8 * q), b = *(const bf16x8_t*)(Y + r * ycs + 32 * s2 + 8 * q);
        acc = __builtin_amdgcn_mfma_f32_16x16x32_bf16(a, b, acc, 0, 0, 0);
    }
    return acc;
}
__device__ void ph_rwkv_prep(const P& p, float* ldsf, int blk_first, int blk_end, int blk_step) {
    const bf16_t* PS = (const bf16_t*)(p.ws + WS_PS);
    const float* mu = p.in[10]; const float* w0 = p.in[11]; const float* a0 = p.in[13]; const float* k_k = p.in[16]; const float* k_a = p.in[17];
    const bf16_t* W2T = (const bf16_t*)(p.ws + WS_LW2T); const bf16_t* A2T = (const bf16_t*)(p.ws + WS_LA2T); const bf16_t* G2T = (const bf16_t*)(p.ws + WS_LG2T);
    bf16_t* R = (bf16_t*)(p.ws + WS_R); bf16_t* K2 = (bf16_t*)(p.ws + WS_K2); bf16_t* VV = (bf16_t*)(p.ws + WS_VV); bf16_t* KK = (bf16_t*)(p.ws + WS_KK); bf16_t* BB = (bf16_t*)(p.ws + WS_BB);
    bf16_t* G = (bf16_t*)(p.ws + WS_G); float* DD = (float*)(p.ws + WS_DD);
    bf16_t* Amix = (bf16_t*)ldsf; bf16_t* RKV = Amix + 32 * AP;
    const int tid = otid(), lane = tid & 63, wv = tid >> 6, l15 = lane & 15, q4 = lane >> 4;
    for (int blk = blk_first; blk < blk_end; blk += blk_step) {
        const int m0 = blk * 32;
        __syncthreads();
#pragma unroll 3
        for (int ch = tid; ch < 32 * 228; ch += NTHR) {
            const int tk = ch / 228, c8 = (ch % 228) * 8, m = m0 + tk;
            const uint4 cu = *(const uint4*)(PS + (size_t)m * SHW + c8);
            uint4 pv = make_uint4(0, 0, 0, 0); if (m % SEQ) pv = *(const uint4*)(PS + (size_t)(m - 1) * SHW + c8);
            const unsigned cw[4] = {cu.x, cu.y, cu.z, cu.w}, pw[4] = {pv.x, pv.y, pv.z, pv.w};
            const float4 mu0 = *(const float4*)(mu + c8), mu1 = *(const float4*)(mu + c8 + 4); const float muv[8] = {mu0.x, mu0.y, mu0.z, mu0.w, mu1.x, mu1.y, mu1.z, mu1.w};
            float mx[8];
#pragma unroll
            for (int e = 0; e < 8; ++e) { const float c_ = (e & 1) ? __uint_as_float(cw[e >> 1] & 0xffff0000u) : __uint_as_float(cw[e >> 1] << 16), p_ = (e & 1) ? __uint_as_float(pw[e >> 1] & 0xffff0000u) : __uint_as_float(pw[e >> 1] << 16);
                mx[e] = c_ + (p_ - c_) * muv[e]; }
            bf16_t* dst;
            if (c8 < 1536) dst = RKV + tk * RP + c8;
            else { const int col = c8 - 1536; dst = Amix + tk * AP + col;
#pragma unroll
                for (int e = 0; e < 8; ++e) mx[e] = (col < 64) ? (1.f - 2.f * __builtin_amdgcn_rcpf(__expf(2.f * mx[e]) + 1.f)) : ((col < 128) ? mx[e] : sigmoidf_(mx[e])); }
            *(uint4*)dst = make_uint4(pk2(mx[0], mx[1]), pk2(mx[2], mx[3]), pk2(mx[4], mx[5]), pk2(mx[6], mx[7]));
        }
        if (tid < 128) *(uint4*)(Amix + (tid >> 2) * AP + 288 + (tid & 3) * 8) = make_uint4(0, 0, 0, 0);
        __syncthreads();
        const int h = wv;
        float rn[2];
#pragma unroll
        for (int rt = 0; rt < 2; ++rt) { const int tk = 16 * rt + l15; float ss = 0.f;
#pragma unroll
            for (int ct = 0; ct < 4; ++ct) { const int c0 = 64 * h + 16 * ct + 4 * q4; const float4 kkc = *(const float4*)(k_k + c0); const uint2 kw = *(const uint2*)(RKV + tk * RP + 512 + c0);
                const float e0 = __uint_as_float(kw.x << 16) * kkc.x, e1 = __uint_as_float(kw.x & 0xffff0000u) * kkc.y, e2 = __uint_as_float(kw.y << 16) * kkc.z, e3 = __uint_as_float(kw.y & 0xffff0000u) * kkc.w;
                ss += (e0 * e0 + e1 * e1) + (e2 * e2 + e3 * e3); }
            ss += __shfl_xor(ss, 16); ss += __shfl_xor(ss, 32);
            rn[rt] = __builtin_amdgcn_rcpf(fmaxf(sqrtf(ss), 1e-12f)); }
        bf16x8_t fw[1][2], fa[1][2], fg[1][6]; float4 cw0[1], ca0[1], cka[1], ckk[1];
#define PREP_LOAD(B_, ct_) do { const int cb_ = 64 * h + 16 * (ct_); \
            const bf16_t* yw = W2T + (size_t)(cb_ + l15) * 64 + 8 * q4; const bf16_t* ya = A2T + (size_t)(cb_ + l15) * 64 + 8 * q4; const bf16_t* yg = G2T + (size_t)(cb_ + l15) * 192 + 8 * q4; \
            _Pragma("unroll") for (int s2 = 0; s2 < 2; ++s2) { fw[B_][s2] = *(const bf16x8_t*)(yw + 32 * s2); fa[B_][s2] = *(const bf16x8_t*)(ya + 32 * s2); } \
            _Pragma("unroll") for (int s2 = 0; s2 < 6; ++s2) fg[B_][s2] = *(const bf16x8_t*)(yg + 32 * s2); \
            cw0[B_] = *(const float4*)(w0 + cb_ + 4 * q4); ca0[B_] = *(const float4*)(a0 + cb_ + 4 * q4); cka[B_] = *(const float4*)(k_a + cb_ + 4 * q4); ckk[B_] = *(const float4*)(k_k + cb_ + 4 * q4); } while (0)
#define PREP_TILE(B_, ct_) do { const int c0 = 64 * h + 16 * (ct_) + 4 * q4; \
            const float w0v[4] = {cw0[B_].x, cw0[B_].y, cw0[B_].z, cw0[B_].w}, a0v[4] = {ca0[B_].x, ca0[B_].y, ca0[B_].z, ca0[B_].w}, kav[4] = {cka[B_].x, cka[B_].y, cka[B_].z, cka[B_].w}, kkc[4] = {ckk[B_].x, ckk[B_].y, ckk[B_].z, ckk[B_].w}; \
            _Pragma("unroll") for (int rt = 0; rt < 2; ++rt) { const int tk = 16 * rt + l15; const bf16_t* xr = Amix + tk * AP + 8 * q4; \
                f32x4_t cw = {0.f, 0.f, 0.f, 0.f}, ca = cw, cg = cw; \
                _Pragma("unroll") for (int s2 = 0; s2 < 2; ++s2) { cw = __builtin_amdgcn_mfma_f32_16x16x32_bf16(fw[B_][s2], *(const bf16x8_t*)(xr + 32 * s2), cw, 0, 0, 0); ca = __builtin_amdgcn_mfma_f32_16x16x32_bf16(fa[B_][s2], *(const bf16x8_t*)(xr + 64 + 32 * s2), ca, 0, 0, 0); } \
                _Pragma("unroll") for (int s2 = 0; s2 < 6; ++s2) cg = __builtin_amdgcn_mfma_f32_16x16x32_bf16(fg[B_][s2], *(const bf16x8_t*)(xr + 128 + 32 * s2), cg, 0, 0, 0); \
                const uint2 rw2 = *(const uint2*)(RKV + tk * RP + c0), kw2 = *(const uint2*)(RKV + tk * RP + 512 + c0), vw2 = *(const uint2*)(RKV + tk * RP + 1024 + c0); \
                const float kf[4] = {__uint_as_float(kw2.x << 16), __uint_as_float(kw2.x & 0xffff0000u), __uint_as_float(kw2.y << 16), __uint_as_float(kw2.y & 0xffff0000u)}; \
                float k2v[4], kkv[4], bbv[4], ddv[4]; \
                _Pragma("unroll") for (int e = 0; e < 4; ++e) { \
                    const float xw = -(w0v[e] + cw[e]); \
                    const float sp = fmaxf(xw, 0.f) + __logf(1.f + __expf(-fabsf(xw)));        \
                    const float w = -sp - 0.5f; \
                    const float a = sigmoidf_(a0v[e] + ca[e]); \
                    kkv[e] = kf[e] * kkc[e] * rn[rt]; bbv[e] = kkv[e] * a; k2v[e] = kf[e] * (1.f + (a - 1.f) * kav[e]); ddv[e] = -__expf(w); } \
                const size_t o = (size_t)(m0 + tk) * RW + c0; \
                *(uint2*)(R + o) = rw2; *(uint2*)(VV + o) = vw2; \
                *(uint2*)(K2 + o) = make_uint2(pk2(k2v[0], k2v[1]), pk2(k2v[2], k2v[3])); *(uint2*)(KK + o) = make_uint2(pk2(kkv[0], kkv[1]), pk2(kkv[2], kkv[3])); \
                *(uint2*)(BB + o) = make_uint2(pk2(bbv[0], bbv[1]), pk2(bbv[2], bbv[3])); *(uint2*)(G + o) = make_uint2(pk2(cg[0], cg[1]), pk2(cg[2], cg[3])); \
                *(float4*)(DD + o) = make_float4(ddv[0], ddv[1], ddv[2], ddv[3]); } } while (0)
#pragma unroll 1
        for (int ct = 0; ct < 4; ++ct) { PREP_LOAD(0, ct); PREP_TILE(0, ct); }
#undef PREP_LOAD
#undef PREP_TILE
    }
}

template <bool XC, bool YC>
__device__ __forceinline__ f32x4_t mm_tile(const bf16_t* X, int xrs, int xcs, const bf16_t* Y, int yrs, int ycs, int tr, int tc, f32x4_t acc, int lane) {
    const int r = lane & 15, q = lane >> 4;
#pragma unroll
    for (int s2 = 0; s2 < 2; ++s2) {
        bf16x8_t a, b;
        const bf16_t* xp = X + (16 * tr + r) * xrs + (32 * s2 + 8 * q) * xcs;
        if (XC) a = *(const bf16x8_t*)xp; else {
#pragma unroll
            for (int j = 0; j < 8; ++j) a[j] = (short)xp[j * xcs]; }
        const bf16_t* yp = Y + (32 * s2 + 8 * q) * yrs + (16 * tc + r) * ycs;
        if (YC) b = *(const bf16x8_t*)yp; else {
#pragma unroll
            for (int j = 0; j < 8; ++j) b[j] = (short)yp[j * yrs]; }
        acc = __builtin_amdgcn_mfma_f32_16x16x32_bf16(a, b, acc, 0, 0, 0);
    }
    return acc;
}
__device__ __forceinline__ void st_tile(const f32x4_t& acc, bf16_t* D, int drs, int dcs, int tr, int tc, int lane) {
    const int row0 = 16 * tr + 4 * (lane >> 4), col = 16 * tc + (lane & 15);
#pragma unroll
    for (int e = 0; e < 4; ++e) D[(row0 + e) * drs + col * dcs] = f2bf(acc[e]);
}
__device__ __forceinline__ f32x4_t ld_tile(const bf16_t* D, int drs, int dcs, int tr, int tc, int lane) {
    const int row0 = 16 * tr + 4 * (lane >> 4), col = 16 * tc + (lane & 15); f32x4_t v;
#pragma unroll
    for (int e = 0; e < 4; ++e) v[e] = bf2f(D[(row0 + e) * drs + col * dcs]);
    return v;
}
template <bool STRICT> __device__ __forceinline__ void triu_tile(f32x4_t& acc, int tr, int tc, int lane) {
    const int row0 = 16 * tr + 4 * (lane >> 4), col = 16 * tc + (lane & 15);
#pragma unroll
    for (int e = 0; e < 4; ++e) { const bool keep = STRICT ? (row0 + e < col) : (row0 + e <= col); acc[e] = keep ? acc[e] : 0.f; }
}

__device__ void ph_rwkv_r1(const P& p, float* ldsf, int ch_first, int ch_end, int ch_step) {
    const bf16_t* R = (const bf16_t*)(p.ws + WS_R); const bf16_t* K2 = (const bf16_t*)(p.ws + WS_K2); const bf16_t* VV = (const bf16_t*)(p.ws + WS_VV);
    const bf16_t* KK = (const bf16_t*)(p.ws + WS_KK); const bf16_t* BB = (const bf16_t*)(p.ws + WS_BB); const float* DD = (const float*)(p.ws + WS_DD);
    bf16_t* L = (bf16_t*)ldsf;
    bf16_t* At = L + 0 * SLOT; bf16_t* AtT = L + 1 * SLOT; bf16_t* Bt = L + 2 * SLOT; bf16_t* Kt = L + 3 * SLOT; bf16_t* Rt = L + 4 * SLOT; bf16_t* BhT = L + 5 * SLOT; bf16_t* Kh = L + 6 * SLOT;
    bf16_t* S7 = L + 7 * SLOT; bf16_t* S8 = L + 8 * SLOT; bf16_t* S9 = L + 9 * SLOT; bf16_t* Mka = L + 10 * SLOT; bf16_t* NbrT = L + 11 * SLOT; bf16_t* Nkr = L + 12 * SLOT;
    float* cs = (float*)(L + 13 * SLOT);
    float* segs = cs + 64 * 64;
    float* gLs = segs + 8 * 64;
    const int tid = otid(), lane = tid & 63, wv = tid >> 6;
    const int t0 = 2 * wv, t1 = 2 * wv + 1;
    for (int ch = ch_first; ch < ch_end; ch += ch_step) {
        const int bh = ch >> 7, c = ch & 127, b = bh >> 3, h = bh & 7;
        const size_t gbase = ((size_t)b * SEQ + (size_t)c * 64) * RW + h * 64;
        bf16_t* G1T = (bf16_t*)(p.ws + WS_KK) + gbase; bf16_t* PT = (bf16_t*)(p.ws + WS_BB) + gbase; bf16_t* G2T = (bf16_t*)(p.ws + WS_DD) + 2 * gbase; bf16_t* QT = G2T + 64;
        __syncthreads();
        const int st = tid >> 3, sj = (tid & 7) * 8;
        const uint4 vraw = *(const uint4*)(VV + gbase + (size_t)st * RW + sj);
        const uint4 rr = *(const uint4*)(R + gbase + (size_t)st * RW + sj), kr = *(const uint4*)(K2 + gbase + (size_t)st * RW + sj);
        const uint4 kkr = *(const uint4*)(KK + gbase + (size_t)st * RW + sj), br = *(const uint4*)(BB + gbase + (size_t)st * RW + sj);
        { const float4 l0 = *(const float4*)(DD + gbase + (size_t)st * RW + sj), l1 = *(const float4*)(DD + gbase + (size_t)st * RW + sj + 4);
          float* d = cs + st * 64 + sj; *(float4*)d = l0; *(float4*)(d + 4) = l1; }
        __syncthreads();
        { const int j = tid & 63, sg = tid >> 6; float run = 0.f;
#pragma unroll
          for (int i = 0; i < 8; ++i) { run += cs[(sg * 8 + i) * 64 + j]; }
          segs[sg * 64 + j] = run; }
        __syncthreads();
        { const int j = tid & 63, sg = tid >> 6; float run = 0.f;
          for (int q = 0; q < sg; ++q) run += segs[q * 64 + j];
#pragma unroll
          for (int i = 0; i < 8; ++i) { run += cs[(sg * 8 + i) * 64 + j]; cs[(sg * 8 + i) * 64 + j] = run; }
          if (sg == 7) gLs[j] = __expf(run); }
        __syncthreads();
        {
            const unsigned rw_[4] = {rr.x, rr.y, rr.z, rr.w}, kw_[4] = {kr.x, kr.y, kr.z, kr.w}, kkw_[4] = {kkr.x, kkr.y, kkr.z, kkr.w}, bw_[4] = {br.x, br.y, br.z, br.w};
            unsigned oa[4], ob[4], ok[4], orr[4], okh[4];
#pragma unroll
            for (int e2 = 0; e2 < 4; ++e2) {
                float va[2], vb[2], vk[2], vr2[2], vbh[2], vkh[2];
#pragma unroll
                for (int hf = 0; hf < 2; ++hf) {
                    const int j = sj + 2 * e2 + hf;
                    const float lgI = cs[st * 64 + j], lgE = st ? cs[(st - 1) * 64 + j] : 0.f, gl = cs[63 * 64 + j];
                    const float rv = hf ? __uint_as_float(rw_[e2] & 0xffff0000u) : __uint_as_float(rw_[e2] << 16);
                    const float kv = hf ? __uint_as_float(kw_[e2] & 0xffff0000u) : __uint_as_float(kw_[e2] << 16);
                    const float kkv = hf ? __uint_as_float(kkw_[e2] & 0xffff0000u) : __uint_as_float(kkw_[e2] << 16);
                    const float bv = hf ? __uint_as_float(bw_[e2] & 0xffff0000u) : __uint_as_float(bw_[e2] << 16);
                    const float einv = __expf(-lgI), eh = __expf(gl - lgI);
                    va[hf] = -kkv * __expf(lgE); vb[hf] = bv * einv; vk[hf] = kv * einv; vr2[hf] = rv * __expf(lgI); vbh[hf] = bv * eh; vkh[hf] = kv * eh;
                    AtT[j * LP + st] = f2bf(va[hf]); BhT[j * LP + st] = f2bf(vbh[hf]);
                }
                oa[e2] = pk2(va[0], va[1]); ob[e2] = pk2(vb[0], vb[1]); ok[e2] = pk2(vk[0], vk[1]); orr[e2] = pk2(vr2[0], vr2[1]); okh[e2] = pk2(vkh[0], vkh[1]);
            }
            *(uint4*)(At + st * LP + sj) = make_uint4(oa[0], oa[1], oa[2], oa[3]); *(uint4*)(Bt + st * LP + sj) = make_uint4(ob[0], ob[1], ob[2], ob[3]);
            *(uint4*)(Kt + st * LP + sj) = make_uint4(ok[0], ok[1], ok[2], ok[3]); *(uint4*)(Rt + st * LP + sj) = make_uint4(orr[0], orr[1], orr[2], orr[3]);
            *(uint4*)(Kh + st * LP + sj) = make_uint4(okh[0], okh[1], okh[2], okh[3]);
        }
        __syncthreads();
#define R1_FOR_TILES(idx, tr, tc) _Pragma("unroll") for (int _q = 0; _q < 2; ++_q) { const int idx = _q ? t1 : t0; const int tr = idx >> 2, tc = idx & 3;
#define R1_END }
#define MMF(X, Y, acc) mm_tile<true, true>((X), LP, 1, (Y), 1, LP, tr, tc, (acc), lane)
        const f32x4_t zero4 = {0.f, 0.f, 0.f, 0.f};
        R1_FOR_TILES(idx, tr, tc)
            f32x4_t mab = MMF(Bt, At, zero4); triu_tile<true>(mab, tr, tc, lane); st_tile(mab, S7, LP, 1, tr, tc, lane); st_tile(mab, S8, 1, LP, tr, tc, lane);
            { f32x4_t tt = mab; const int row0 = 16 * tr + 4 * (lane >> 4), col = 16 * tc + (lane & 15);
#pragma unroll
              for (int e = 0; e < 4; ++e) tt[e] += (row0 + e == col) ? 1.f : 0.f;
              st_tile(tt, S9, LP, 1, tr, tc, lane); }
            f32x4_t mka = MMF(Kt, At, zero4); triu_tile<true>(mka, tr, tc, lane); st_tile(mka, Mka, LP, 1, tr, tc, lane);
            f32x4_t nbr = MMF(Bt, Rt, zero4); triu_tile<false>(nbr, tr, tc, lane); st_tile(nbr, NbrT, 1, LP, tr, tc, lane);
            f32x4_t nkr = MMF(Kt, Rt, zero4); triu_tile<false>(nkr, tr, tc, lane); st_tile(nkr, Nkr, LP, 1, tr, tc, lane);
        R1_END
        __syncthreads();
        bf16_t* VmT = At;
        { const unsigned vw_[4] = {vraw.x, vraw.y, vraw.z, vraw.w};
#pragma unroll
          for (int e = 0; e < 8; ++e) VmT[(sj + e) * LP + st] = (bf16_t)((e & 1) ? (vw_[e >> 1] >> 16) : (vw_[e >> 1] & 0xffffu)); }
        bf16_t* Pc = S7; bf16_t* PcT = S8; bf16_t* Pn = Bt; bf16_t* PnT = Kt; bf16_t* Tc = S9; bf16_t* Tn = (bf16_t*)cs; bf16_t* TT = nullptr;
#pragma unroll 1
        for (int k = 1; k <= 6; ++k) {
            R1_FOR_TILES(idx, tr, tc)
                if (k <= 5) { f32x4_t pp = MMF(Pc, PcT, zero4); st_tile(pp, Pn, LP, 1, tr, tc, lane); st_tile(pp, PnT, 1, LP, tr, tc, lane); }
                if (k >= 2) { f32x4_t tn = ld_tile(Tc, LP, 1, tr, tc, lane); tn = MMF(Tc, PcT, tn); st_tile(tn, Tn, LP, 1, tr, tc, lane);
                    if (k == 6) st_tile(tn, Pn, 1, LP, tr, tc, lane); }
            R1_END
            __syncthreads();
            if (k == 6) TT = Pn;
            if (k <= 5) { bf16_t* x_ = Pc; Pc = Pn; Pn = x_; x_ = PcT; PcT = PnT; PnT = x_; }
            if (k >= 2) { bf16_t* x_ = Tc; Tc = Tn; Tn = x_; }
        }
        bf16_t* W1 = Pc; bf16_t* W2 = PcT; bf16_t* QkT = PnT;
        bf16_t* Og1 = Tn; bf16_t* Og2 = Tc; bf16_t* Opt = TT; bf16_t* Oqt = W1;
        R1_FOR_TILES(idx, tr, tc)
            f32x4_t w1 = MMF(AtT, TT, zero4); st_tile(w1, W1, LP, 1, tr, tc, lane);
            f32x4_t w2 = MMF(Mka, TT, zero4); st_tile(w2, W2, LP, 1, tr, tc, lane);
        R1_END
        __syncthreads();
        R1_FOR_TILES(idx, tr, tc)
            f32x4_t g1 = ld_tile(Rt, 1, LP, tr, tc, lane); g1 = MMF(W1, NbrT, g1); st_tile(g1, Og1, 1, LP, tr, tc, lane);
            f32x4_t g2 = ld_tile(Nkr, LP, 1, tr, tc, lane); g2 = MMF(W2, NbrT, g2); st_tile(g2, Og2, 1, LP, tr, tc, lane);
            f32x4_t pm = MMF(W1, BhT, zero4);
            { const int row0 = 16 * tr + 4 * (lane >> 4), col = 16 * tc + (lane & 15);
#pragma unroll
              for (int e = 0; e < 4; ++e) pm[e] += (row0 + e == col) ? gLs[col] : 0.f; }
            { const int row0 = 16 * tr + 4 * (lane >> 4), col = 16 * tc + (lane & 15);
#pragma unroll
              for (int e = 0; e < 4; ++e) { const int j = row0 + e; const int frag = (col >> 5) * 4 + 2 * (j >> 5) + ((j & 31) >> 4);
                Opt[(frag * 64 + (col & 31) + 32 * ((j >> 2) & 1)) * 8 + 4 * ((j >> 3) & 1) + (j & 3)] = f2bf(pm[e]); } }
            f32x4_t qk = ld_tile(Kh, LP, 1, tr, tc, lane); qk = MMF(W2, BhT, qk); st_tile(qk, QkT, 1, LP, tr, tc, lane);
        R1_END
        __syncthreads();
        {
            const int row = tid >> 3, ch8 = (tid & 7) * 8;
            *(uint4*)(G1T + (size_t)row * RW + ch8) = *(const uint4*)(Og1 + row * LP + ch8);
            *(uint4*)(G2T + (size_t)row * (2 * RW) + ch8) = *(const uint4*)(Og2 + row * LP + ch8);
            *(uint4*)(PT + (size_t)row * RW + ch8) = *(const uint4*)(Opt + row * 64 + ch8);
        }
        R1_FOR_TILES(idx, tr, tc)
            f32x4_t qt = MMF(QkT, VmT, zero4);
            { const int row0 = 16 * tr + 4 * (lane >> 4), col = 16 * tc + (lane & 15);
#pragma unroll
              for (int e = 0; e < 4; ++e) { const int jp = row0 + e; const int ci = ((jp >> 5) * 2 + (col >> 5)) * 64 + (col & 31) + 32 * ((jp >> 2) & 1);
                Oqt[ci * 16 + (jp & 3) + 4 * ((jp & 31) >> 3)] = f2bf(qt[e]); } }
        R1_END
        __syncthreads();
        { const int ci = tid >> 1, hf = tid & 1;
          *(uint4*)(QT + (size_t)(ci >> 2) * (2 * RW) + (ci & 3) * 16 + hf * 8) = *(const uint4*)(Oqt + ci * 16 + hf * 8); }
#undef MMF
    }
}
__device__ void ph_rwkv_prep_r1(const P& p, float* ldsf) {
    for (int b64 = blockIdx.x; b64 < NT / 64; b64 += gridDim.x) {
        ph_rwkv_prep(p, ldsf, 2 * b64, 2 * b64 + 2, 1);
        __syncthreads();
        const int b = b64 >> 7, c = b64 & 127, ch0 = (b * 8) * 128 + c;
        ph_rwkv_r1(p, ldsf, ch0, ch0 + 8 * 128, 128);
    }
}
__device__ void ph_rwkv_r2(const P& p, int bh_first, int bh_end, int bh_step) {
    bf16_t* SX = (bf16_t*)(p.ws + WS_SX);
    const int tid = otid(), lane = tid & 63, wv = tid >> 6, hh = lane >> 5, r32 = lane & 31;
    typedef short s16x4_t __attribute__((ext_vector_type(4)));
    for (int bh = bh_first; bh < bh_end; bh += bh_step) {
        if (wv >= 2) continue;
        const int cb = wv;
        f32x16_t x0, x1;
#pragma unroll
        for (int i = 0; i < 16; ++i) { x0[i] = 0.f; x1[i] = 0.f; }
        bf16x8_t pa[3][2][4]; uint4 qa[3][2][2];
#define R2_LOAD(S_, c_) do { const size_t gb_ = ((size_t)(bh >> 3) * SEQ + (size_t)(c_) * 64) * RW + (bh & 7) * 64; \
            const bf16_t* PT = (const bf16_t*)(p.ws + WS_BB) + gb_; const bf16_t* QT = (const bf16_t*)(p.ws + WS_DD) + 2 * gb_ + 64; \
            _Pragma("unroll") for (int rb = 0; rb < 2; ++rb) { \
                _Pragma("unroll") for (int ks = 0; ks < 4; ++ks) { const int o_ = ((rb * 4 + ks) * 64 + lane) * 8;        \
                    pa[S_][rb][ks] = *(const bf16x8_t*)(PT + (size_t)(o_ >> 6) * RW + (o_ & 63)); } \
                const int ci_ = (rb * 2 + cb) * 64 + lane; const uint4* qp = (const uint4*)(QT + (size_t)(ci_ >> 2) * (2 * RW) + (ci_ & 3) * 16); qa[S_][rb][0] = qp[0]; qa[S_][rb][1] = qp[1]; } } while (0)
#define R2_STEP(S_, c_) do { const int cc_ = (c_); const size_t ob_ = ((size_t)bh * 128 + cc_) * 4096; \
              \
            const bf16x8_t xb0 = pack_step16(x0, 0), xb1 = pack_step16(x0, 1), xb2 = pack_step16(x1, 0), xb3 = pack_step16(x1, 1); \
            { bf16x8_t* sp = (bf16x8_t*)(SX + ob_) + (cb * 4) * 64 + lane;        \
              sp[0] = xb0; sp[64] = xb1; sp[128] = xb2; sp[192] = xb3; } \
            f32x16_t n0, n1; \
            { const unsigned qw0[8] = {qa[S_][0][0].x, qa[S_][0][0].y, qa[S_][0][0].z, qa[S_][0][0].w, qa[S_][0][1].x, qa[S_][0][1].y, qa[S_][0][1].z, qa[S_][0][1].w}; \
              const unsigned qw1[8] = {qa[S_][1][0].x, qa[S_][1][0].y, qa[S_][1][0].z, qa[S_][1][0].w, qa[S_][1][1].x, qa[S_][1][1].y, qa[S_][1][1].z, qa[S_][1][1].w}; \
              _Pragma("unroll") for (int i = 0; i < 8; ++i) { n0[2 * i] = __uint_as_float(qw0[i] << 16); n0[2 * i + 1] = __uint_as_float(qw0[i] & 0xffff0000u); n1[2 * i] = __uint_as_float(qw1[i] << 16); n1[2 * i + 1] = __uint_as_float(qw1[i] & 0xffff0000u); } } \
            n0 = MFMA32(pa[S_][0][0], xb0, n0); n0 = MFMA32(pa[S_][0][1], xb1, n0); n0 = MFMA32(pa[S_][0][2], xb2, n0); n0 = MFMA32(pa[S_][0][3], xb3, n0); \
            n1 = MFMA32(pa[S_][1][0], xb0, n1); n1 = MFMA32(pa[S_][1][1], xb1, n1); n1 = MFMA32(pa[S_][1][2], xb2, n1); n1 = MFMA32(pa[S_][1][3], xb3, n1); \
            x0 = n0; x1 = n1; \
            if (cc_ + 3 < SEQ / 64) R2_LOAD(S_, cc_ + 3); } while (0)
        R2_LOAD(0, 0); R2_LOAD(1, 1); R2_LOAD(2, 2);
#pragma unroll 1
        for (int c = 0; c + 2 < SEQ / 64; c += 3) { R2_STEP(0, c); R2_STEP(1, c + 1); R2_STEP(2, c + 2); }
        R2_STEP(0, SEQ / 64 - 2); R2_STEP(1, SEQ / 64 - 1);
#undef R2_STEP
#undef R2_LOAD
    }
}
__device__ void ph_rwkv_r3(const P& p, float* ldsf) {
    const bf16_t* VV = (const bf16_t*)(p.ws + WS_VV); const bf16_t* SX = (const bf16_t*)(p.ws + WS_SX);
    const bf16_t* Rg = (const bf16_t*)(p.ws + WS_R); const bf16_t* K2 = (const bf16_t*)(p.ws + WS_K2); const bf16_t* Gg = (const bf16_t*)(p.ws + WS_G); bf16_t* ORW = (bf16_t*)(p.ws + WS_ORW);
    const float* r_k = p.in[18]; const float* ln_w = p.in[19]; const float* ln_b = p.in[20];
    bf16_t* Vm = (bf16_t*)ldsf; float* Yl = (float*)(Vm + SLOT);
    const int tid = otid(), lane = tid & 63, wv = tid >> 6; const int t0 = 2 * wv, t1 = 2 * wv + 1;
    const int st = tid >> 3, sj = (tid & 7) * 8;
    for (int ch = blockIdx.x; ch < NB * 8 * (SEQ / 64); ch += gridDim.x) {
        const int bh = ch >> 7, c = ch & 127, b = bh >> 3, h = bh & 7;
        const size_t gbase = ((size_t)b * SEQ + (size_t)c * 64) * RW + h * 64, ob_ = (size_t)ch * 4096;
        const bf16_t* G1T = (const bf16_t*)(p.ws + WS_KK) + gbase; const bf16_t* G2T = (const bf16_t*)(p.ws + WS_DD) + 2 * gbase;
        __syncthreads();
        const uint4 vraw = *(const uint4*)(VV + gbase + (size_t)st * RW + sj);
        *(uint4*)(Vm + st * LP + sj) = vraw;
        __syncthreads();
        R1_FOR_TILES(idx, tr, tc)
            const f32x4_t zero4 = {0.f, 0.f, 0.f, 0.f};
            f32x4_t y = zero4;
            {
                const int i_ = 16 * tr + (lane & 15), q_ = lane >> 4; typedef short s16x4_t __attribute__((ext_vector_type(4)));
#pragma unroll
                for (int s2 = 0; s2 < 2; ++s2) { const int j0 = 32 * s2 + 8 * q_;
                    const int frag = (i_ >> 5) * 4 + 2 * (j0 >> 5) + ((j0 & 31) >> 4); const bf16_t* fp = SX + ob_ + ((size_t)frag * 64 + (i_ & 31)) * 8 + 4 * ((j0 >> 3) & 1);
                    const s16x4_t lo = *(const s16x4_t*)fp, hi = *(const s16x4_t*)(fp + 32 * 8);
                    bf16x8_t a; a[0] = lo[0]; a[1] = lo[1]; a[2] = lo[2]; a[3] = lo[3]; a[4] = hi[0]; a[5] = hi[1]; a[6] = hi[2]; a[7] = hi[3];
                    const bf16x8_t b = *(const bf16x8_t*)(G1T + (size_t)(16 * tc + (lane & 15)) * RW + 32 * s2 + 8 * q_);
                    y = __builtin_amdgcn_mfma_f32_16x16x32_bf16(a, b, y, 0, 0, 0); }
            }
            y = mm_tile<false, true>(Vm, 1, LP, G2T, 1, 2 * RW, tr, tc, y, lane);
            const int i0 = 16 * tr + 4 * (lane >> 4), t = 16 * tc + (lane & 15);
#pragma unroll
            for (int e = 0; e < 4; ++e) Yl[t * 65 + i0 + e] = y[e];
        R1_END
        __syncthreads();
        {
            float y[8], s1 = 0.f;
#pragma unroll
            for (int e = 0; e < 8; ++e) { y[e] = Yl[st * 65 + sj + e]; s1 += y[e]; }
            s1 += __shfl_xor(s1, 1); s1 += __shfl_xor(s1, 2); s1 += __shfl_xor(s1, 4);
            const float mean = s1 * (1.f / 64.f); float s2 = 0.f;
#pragma unroll
            for (int e = 0; e < 8; ++e) { y[e] -= mean; s2 += y[e] * y[e]; }
            s2 += __shfl_xor(s2, 1); s2 += __shfl_xor(s2, 2); s2 += __shfl_xor(s2, 4);
            const float rstd = rsqrtf(s2 * (1.f / 64.f) + GN_EPS);
            const size_t o = gbase + (size_t)st * RW + sj;
            const uint4 rr = *(const uint4*)(Rg + o), kr = *(const uint4*)(K2 + o), gr = *(const uint4*)(Gg + o);
            const unsigned rw_[4] = {rr.x, rr.y, rr.z, rr.w}, kw_[4] = {kr.x, kr.y, kr.z, kr.w}, gw_[4] = {gr.x, gr.y, gr.z, gr.w}, vw_[4] = {vraw.x, vraw.y, vraw.z, vraw.w};
            float rk = 0.f;
#pragma unroll
            for (int e = 0; e < 8; ++e) { const float r_ = (e & 1) ? __uint_as_float(rw_[e >> 1] & 0xffff0000u) : __uint_as_float(rw_[e >> 1] << 16), k_ = (e & 1) ? __uint_as_float(kw_[e >> 1] & 0xffff0000u) : __uint_as_float(kw_[e >> 1] << 16);
                rk += r_ * k_ * r_k[h * 64 + sj + e]; }
            rk += __shfl_xor(rk, 1); rk += __shfl_xor(rk, 2); rk += __shfl_xor(rk, 4);
            float ov[8];
#pragma unroll
            for (int e = 0; e < 8; ++e) { const float v_ = (e & 1) ? __uint_as_float(vw_[e >> 1] & 0xffff0000u) : __uint_as_float(vw_[e >> 1] << 16), g_ = (e & 1) ? __uint_as_float(gw_[e >> 1] & 0xffff0000u) : __uint_as_float(gw_[e >> 1] << 16);
                ov[e] = (y[e] * rstd * ln_w[h * 64 + sj + e] + ln_b[h * 64 + sj + e] + rk * v_) * g_; }
            *(uint4*)(ORW + o) = make_uint4(pk2(ov[0], ov[1]), pk2(ov[2], ov[3]), pk2(ov[4], ov[5]), pk2(ov[6], ov[7]));
        }
    }
}
#undef R1_FOR_TILES
#undef R1_END

__device__ void ph_moe_lists(const P& p, float* ldsf) {
    int* ctl = (int*)(p.ws + WS_CTL); const int* cntB = ctl + CT_CNTB;
    int* ltok = (int*)(p.ws + WS_LTOK); float* lw = (float*)(p.ws + WS_LW);
    int* part = (int*)ldsf;
    int* tot = part + 1024; int* pre = tot + 64; int* offL = pre + 64; int* tp = offL + 64;
    const int tid = otid(), lane = tid & 63, wv = tid >> 6, G = gridDim.x;
    { int t_ = 0, p_ = 0;
      for (int b2 = wv; b2 < G; b2 += 8) { const int v = cntB[b2 * 64 + lane]; t_ += v; p_ += (b2 < (int)blockIdx.x) ? v : 0; }
      part[wv * 64 + lane] = t_; part[512 + wv * 64 + lane] = p_; }
    __syncthreads();
    if (tid < 64) { int t_ = 0, p_ = 0;
#pragma unroll
        for (int w2 = 0; w2 < 8; ++w2) { t_ += part[w2 * 64 + tid]; p_ += part[512 + w2 * 64 + tid]; }
        tot[tid] = t_; pre[tid] = p_;
        const int nt_ = (t_ + 255) >> 8; int incl = nt_;
#pragma unroll
        for (int o = 1; o < 64; o <<= 1) { const int oth = __shfl_up(incl, o); if (lane >= o) incl += oth; }
        tp[tid] = incl - nt_; offL[tid] = (incl - nt_) * 256; if (tid == 63) tp[64] = incl; }
    __syncthreads();
    const int TPB = NT / G;
    for (int i = tid; i < TPB; i += NTHR) { const int m = blockIdx.x * TPB + i; const int4 r = ((const int4*)(p.ws + WS_ROUTE))[m];
        const int l0 = r.x & 255, l1 = 32 + ((r.x >> 8) & 255), rk0 = r.y & 0xffff, rk1 = (r.y >> 16) & 0xffff;
        const int p0 = offL[l0] + pre[l0] + rk0, p1 = offL[l1] + pre[l1] + rk1;
        ltok[p0] = m; lw[p0] = __int_as_float(r.z); ltok[p1] = m; lw[p1] = __int_as_float(r.w); }
    for (int li = blockIdx.x; li < 64; li += G) {
        const int cnt = tot[li], off = offL[li], e = li & 31, nt_ = (cnt + 255) >> 8;
        int4* t1 = (int4*)(ctl + CT_TAB1) + tp[li] * 4;
        int4* t2 = (li < 32) ? (int4*)(ctl + CT_TAB2A) + tp[li] * 4 : (int4*)(ctl + CT_TAB2B) + (tp[li] - tp[32]) * 4;
        for (int i = tid; i < nt_ * 4; i += NTHR) { const int mt = i >> 2, nt = i & 3; const int4 ent = make_int4(off + mt * 256, e * 1024 + nt * 256, cnt - mt * 256, nt); t1[i] = ent; t2[i] = ent; }
        for (int r = cnt + tid; r < nt_ * 256; r += NTHR) ltok[off + r] = 0;
    }
    if (blockIdx.x == 0 && tid == 0) { ctl[CT_NU] = tp[64] * 4; ctl[CT_NU + 1] = tp[32] * 4; ctl[CT_NU + 2] = (tp[64] - tp[32]) * 4; }
}

template <int PH>
__device__ __forceinline__ void run_phase(const P& p, unsigned char* lds_raw) {
    float* lds = (float*)lds_raw; PG8_LAS unsigned char* ldsg = (PG8_LAS unsigned char*)lds_raw;
    const int G = gridDim.x, c = blockIdx.x;
    if constexpr (PH == 0) { ph_mod(p, lds); __syncthreads(); ph_convert_mixer_weights(p, lds); __syncthreads(); ph_convert_lora_weights(p, lds); }
    if constexpr (PH == 1) ph_norm(p, p.in[0], p.in[4], 0, (bf16_t*)(p.ws + WS_XN));
    if constexpr (PH == 2) { pg8::Gemm g{(const bf16_t*)(p.ws + WS_XN), (const bf16_t*)(p.ws + WS_WIN), DM, nullptr}; pg8::StaticOrder S; S.init(NT, 5120, G, c);
        pg8::EpiInproj E{p.ws, (bf16_t*)p.out}; pg8::gemm_phase(ldsg, g, S, E); }
    if constexpr (PH == 3) {
        { pg8::Gemm g{(const bf16_t*)(p.ws + WS_KVN), (const bf16_t*)(p.ws + WS_WKV), KVL, nullptr}; pg8::StaticOrder S; S.init(NT, 2 * AW, G, c);
          pg8::EpiKV E{p.ws}; pg8::gemm_phase(ldsg, g, S, E);
          pg8::Unit u;
          for (int i = 0; S.next(i, u); ++i) if (u.pn < 2) { __syncthreads(); knorm_tile(p, u.pm, u.pn); } }
        ph_rwkv_prep_r1(p, lds);
        ph_dsa_select(p, lds);
    }
    if constexpr (PH == 4) { ph_rwkv_r2(p, c, NB * 8, G); ph_dsa_attn(p, lds); }
    if constexpr (PH == 5) ph_rwkv_r3(p, lds);
    if constexpr (PH == 6) { pg8::Gemm g{(const bf16_t*)(p.ws + WS_OATT), (const bf16_t*)(p.ws + WS_WBA), AW, nullptr}; pg8::BranchOrder S; S.S0.init(NT, DM, G, c);
        pg8::EpiMerge E{(bf16_t*)(p.ws + WS_MERGED), (const bf16_t*)p.out}; pg8::gemm_phase(ldsg, g, S, E);
        ph_convert_expert_weights(p, lds); }
    if constexpr (PH == 7) { pg8::Gemm g{(const bf16_t*)(p.ws + WS_MERGED), (const bf16_t*)(p.ws + WS_WOUT), DM, nullptr}; pg8::StaticOrder S; S.init(NT, DM, G, c);
        pg8::EpiOut E{p.in[0], (const float*)(p.ws + WS_MOD), p.out}; pg8::gemm_phase(ldsg, g, S, E); }
    if constexpr (PH == 8) ph_norm_route(p, lds);
    if constexpr (PH == 9) ph_moe_lists(p, lds);
    if constexpr (PH == 10) { const int* ctl = (const int*)(p.ws + WS_CTL);
        pg8::Gemm g{(const bf16_t*)(p.ws + WS_XN2), (const bf16_t*)(p.ws + WS_WGU), DM, (const int*)(p.ws + WS_LTOK)}; pg8::TableOrder S{(const int4*)(ctl + CT_TAB1), ctl[CT_NU], G, c};
        pg8::EpiMoe1 E{(bf16_t*)(p.ws + WS_HID), (const float*)(p.ws + WS_LW)}; pg8::gemm_phase(ldsg, g, S, E); }
    if constexpr (PH == 11 || PH == 12) { const int* ctl = (const int*)(p.ws + WS_CTL);
        pg8::Gemm g{(const bf16_t*)(p.ws + WS_HID), (const bf16_t*)(p.ws + WS_WDN), DE, nullptr};
        pg8::TableOrder S{(const int4*)(ctl + (PH == 11 ? CT_TAB2A : CT_TAB2B)), ctl[CT_NU + (PH == 11 ? 1 : 2)], G, c};
        pg8::EpiMoe2 E{(const int*)(p.ws + WS_LTOK), (const float*)(p.ws + WS_MOD), p.out}; pg8::gemm_phase(ldsg, g, S, E); }
}
constexpr int LDS_BYTES = 147456;
constexpr int ORDER[] = {0, 1, 2, 3, 4, 5, 6, 7, 8, 9, 10, 11, 12};
constexpr int NPHASE = sizeof(ORDER) / sizeof(int);
constexpr int CT_BAR = 65536;
constexpr int LDS_ST = LDS_BYTES - 64;
template <int I> __device__ __forceinline__ void run_all(const P& p, unsigned char* lds, const XcdBarrier& bar) {
    run_phase<ORDER[I]>(p, lds);
    if constexpr (I + 1 < NPHASE) { xcd_barrier(bar); run_all<I + 1>(p, lds, bar); }
}
__global__ void __launch_bounds__(NTHR, 2) k_mega(P p) {
    extern __shared__ __attribute__((aligned(16))) unsigned char lds[];
    volatile LAS3 unsigned* st = (volatile LAS3 unsigned*)((LAS3 unsigned char*)lds + LDS_ST);
    if (otid() < 16) st[otid()] = 0u;
    __syncthreads();
    const XcdBarrier bar = xcd_barrier_post((unsigned*)(p.ws + WS_CTL) + CT_BAR, st);
    run_all<0>(p, lds, bar);
}
}

extern "C" void kernel_launch(void* const* d_in, const int* in_sizes, int n_in, void* d_out, int out_size, void* d_ws, size_t ws_size, hipStream_t stream) {
    if (n_in != 31 || out_size != NT * DM || ws_size < WS_END) { fprintf(stderr, "kernel_launch: unexpected shapes (n_in %d out %d ws %zu need %zu)\n", n_in, out_size, ws_size, (size_t)WS_END); return; }
    P p{};
    for (int i = 0; i < 31; ++i) p.in[i] = (const float*)d_in[i];
    p.out = (float*)d_out; p.ws = (unsigned char*)d_ws;
    (void)hipMemsetAsync((char*)d_ws + WS_CTL, 0, 1 * MiB, stream);
    static int grid_blocks = 0;
    if (!grid_blocks) {
        int dev = 0, cus = 0, per_cu = 0;
        (void)hipGetDevice(&dev);
        (void)hipDeviceGetAttribute(&cus, hipDeviceAttributeMultiprocessorCount, dev);
        (void)hipFuncSetAttribute((const void*)k_mega, hipFuncAttributeMaxDynamicSharedMemorySize, LDS_BYTES);
        (void)hipOccupancyMaxActiveBlocksPerMultiprocessor(&per_cu, (const void*)k_mega, NTHR, LDS_BYTES);
        if (per_cu < 1) per_cu = 1;
        if (per_cu > 1) per_cu = 1;
        grid_blocks = cus * per_cu;
        fprintf(stderr, "kernel_launch: cus %d per_cu %d grid %d\n", cus, per_cu, grid_blocks);
    }
    hipLaunchKernelGGL(k_mega, dim3(grid_blocks), dim3(NTHR), LDS_BYTES, stream, p);
}
```

```cpp
#include <hip/hip_runtime.h>
#include <cstdio>
#include <cstdint>

namespace {
constexpr int NB = 2, SEQ = 8192, DM = 1024, NT = NB * SEQ;
constexpr int AW = 512, KVL = 256, NIH = 8, IDD = 32, SHW = 1824, INW = 4936;
constexpr int C_KV = 512, C_QI = 768, C_PS = 1064, C_GA = 2888, C_GR = 3912;
constexpr int IDXW = 296;
constexpr int RW = 512, NE = 32, DE = 512;
constexpr int TOPK = 256;
constexpr float NORM_EPS = 1e-6f, GN_EPS = 64e-5f;
constexpr int NTHR = 512;

typedef unsigned short bf16_t;
__device__ __forceinline__ float bf2f(bf16_t v) { return __uint_as_float(((unsigned)v) << 16); }
__device__ __forceinline__ bf16_t f2bf(float f) { unsigned u = __float_as_uint(f); return (bf16_t)((u + 0x7fffu + ((u >> 16) & 1u)) >> 16); }

constexpr size_t MiB = 1u << 20;
constexpr size_t WS_CTL = 0;
constexpr size_t WS_MOD = 1 * MiB;
constexpr size_t WS_RSS = 82 * MiB + 512 * 1024;
constexpr size_t WS_LW2T = 512 * 1024, WS_LA2T = 576 * 1024, WS_LG2T = 640 * 1024;
constexpr size_t WS_WIN = 2 * MiB;
constexpr size_t WS_WKV = 12 * MiB;
constexpr size_t WS_WBA = 13 * MiB;
constexpr size_t WS_WBR = 14 * MiB;
constexpr size_t WS_WOUT = 15 * MiB;
constexpr size_t WS_XN = 17 * MiB;
constexpr size_t WS_K = 17 * MiB;
constexpr size_t WS_V = 33 * MiB;
constexpr size_t WS_Q = 49 * MiB;
constexpr size_t WS_KVN = 65 * MiB;
constexpr size_t WS_QI = 73 * MiB;
constexpr size_t WS_KI = 81 * MiB;
constexpr size_t WS_WI = 82 * MiB;
constexpr size_t WS_PS = 83 * MiB;
constexpr size_t WS_SX = 83 * MiB;
constexpr size_t WS_OATT = 99 * MiB;
constexpr size_t WS_ORW = 115 * MiB;
constexpr size_t WS_MASK = 140 * MiB;
constexpr size_t WS_R = 156 * MiB, WS_K2 = 172 * MiB, WS_VV = 188 * MiB;
constexpr size_t WS_KK = 204 * MiB;
constexpr size_t WS_BB = 220 * MiB;
constexpr size_t WS_DD = 236 * MiB;
constexpr size_t WS_G = 268 * MiB;
constexpr size_t WS_MERGED = 131 * MiB;
constexpr size_t WS_XN2 = 163 * MiB;
constexpr size_t WS_WGU = 195 * MiB;
constexpr size_t WS_WDN = 259 * MiB;
constexpr size_t WS_HID = 17 * MiB;
constexpr size_t WS_ROUTE = 65 * MiB;
constexpr size_t WS_LTOK = 66 * MiB;
constexpr size_t WS_LW = 67 * MiB;
constexpr size_t WS_END = 291 * MiB;
constexpr int HID_ROWS = 49152;
constexpr int CT_CNT = 0, CT_OFF = 64, CT_CUR = 128, CT_NU = 192, CT_Q = 256;
constexpr int CT_CNTB = 16384;
constexpr int CT_TAB1 = 1024, CT_TAB2A = 1024 + 4 * 1024, CT_TAB2B = 1024 + 8 * 1024;

struct P {
    const float* in[31];
    float* out;
    unsigned char* ws;
};

__device__ __forceinline__ int otid() { int t = threadIdx.x; asm volatile("" : "+v"(t)); return t; }
__device__ __forceinline__ float dpp_row_shr(float v, int n) {
    int iv = __builtin_bit_cast(int, v), r;
    switch (n) { case 1: r = __builtin_amdgcn_update_dpp(0, iv, 0x111, 0xf, 0xf, true); break; case 2: r = __builtin_amdgcn_update_dpp(0, iv, 0x112, 0xf, 0xf, true); break;
                 case 4: r = __builtin_amdgcn_update_dpp(0, iv, 0x114, 0xf, 0xf, true); break; default: r = __builtin_amdgcn_update_dpp(0, iv, 0x118, 0xf, 0xf, true); break; }
    return __builtin_bit_cast(float, r);
}
__device__ __forceinline__ float wave_sum(float v) {
    v += dpp_row_shr(v, 1); v += dpp_row_shr(v, 2); v += dpp_row_shr(v, 4); v += dpp_row_shr(v, 8);
    v += __builtin_bit_cast(float, __builtin_amdgcn_update_dpp(0, __builtin_bit_cast(int, v), 0x142, 0xa, 0xf, false));
    v += __builtin_bit_cast(float, __builtin_amdgcn_update_dpp(0, __builtin_bit_cast(int, v), 0x143, 0xc, 0xf, false));
    return __builtin_bit_cast(float, __builtin_amdgcn_readlane(__builtin_bit_cast(int, v), 63));
}
__device__ __forceinline__ float wave_max(float v) {
#pragma unroll
    for (int o = 32; o > 0; o >>= 1) v = fmaxf(v, __shfl_xor(v, o));
    return v;
}
typedef short bf16x8_t __attribute__((ext_vector_type(8)));
typedef float f32x4_t __attribute__((ext_vector_type(4)));
constexpr int LP = 72;
constexpr int SLOT = 64 * LP;
typedef __bf16 bf2_t __attribute__((ext_vector_type(2)));
typedef float f2_t __attribute__((ext_vector_type(2)));
__device__ __forceinline__ unsigned pk_bf16(float lo, float hi) { const f2_t v = {lo, hi}; return __builtin_bit_cast(unsigned, __builtin_convertvector(v, bf2_t)); }
__device__ __forceinline__ float sigmoidf_(float x) { return __builtin_amdgcn_rcpf(1.f + __expf(-x)); }

#define XB_TMO      128
#define XB_XCNT(j)  (256  + 64 * (j))
#define XB_XSUB(j)  (1280 + 64 * (j))
#define XB_XGEN(j)  (2304 + 64 * (j))
#define XB_TOP      3328
#define XB_TOPGEN   3392
#define XCD_BAR_WORDS 3456
#define XB_SPIN_CAP (1u << 22)
#define LAS3 __attribute__((address_space(3)))
__device__ __forceinline__ unsigned xb_ld(unsigned* p)              { return __hip_atomic_load(p, __ATOMIC_RELAXED, __HIP_MEMORY_SCOPE_AGENT); }
__device__ __forceinline__ unsigned xb_add(unsigned* p, unsigned v) { return __hip_atomic_fetch_add(p, v, __ATOMIC_RELAXED, __HIP_MEMORY_SCOPE_AGENT); }
__device__ __forceinline__ unsigned xb_xcc_id() { return (unsigned)__builtin_amdgcn_s_getreg((3 << 11) | 20) & 0xFu; }
#define XB_SPIN(cond, bar) do { unsigned _sp = 0; while (cond) { __builtin_amdgcn_s_sleep(1); \
    if ((++_sp & 255u) == 0u) { if (xb_ld(&(bar)[XB_TMO])) break; if (_sp > XB_SPIN_CAP) { atomicAdd(&(bar)[XB_TMO], 1u); break; } } } } while (0)
struct XcdBarrier { unsigned* bar; unsigned x; volatile LAS3 unsigned* st; };
__device__ __forceinline__ XcdBarrier xcd_barrier_post(unsigned* bar, volatile LAS3 unsigned* st) {
    XcdBarrier b; b.bar = bar; b.x = xb_xcc_id(); b.st = st;
    if (otid() == 0) (void)xb_add(&bar[XB_XCNT(b.x)], 1u);
    return b;
}
__device__ __forceinline__ void xcd_barrier_complete(unsigned* bar, unsigned x, unsigned& nloc, unsigned& nx) {
    const unsigned G = gridDim.x * gridDim.y * gridDim.z;
    unsigned sum, cnt, mine, sp = 0u;
    for (;;) {
        sum = 0u; cnt = 0u; mine = 0u;
#pragma unroll
        for (unsigned j = 0; j < 16; ++j) { const unsigned c = xb_ld(&bar[XB_XCNT(j)]); sum += c; cnt += (c > 0u) ? 1u : 0u; mine = (j == x) ? c : mine; }
        if (sum == G) break;
        __builtin_amdgcn_s_sleep(1);
        if ((++sp & 255u) == 0u) { if (xb_ld(&bar[XB_TMO])) break; if (sp > XB_SPIN_CAP) { atomicAdd(&bar[XB_TMO], 1u); break; } }
    }
    nloc = mine > 0u ? mine : 1u; nx = cnt > 0u ? cnt : 1u;
}
__device__ __forceinline__ void xcd_barrier(const XcdBarrier& b) {
    asm volatile("s_waitcnt vmcnt(0)" ::: "memory");
    __syncthreads();
    if (otid() == 0) {
        unsigned* bar = b.bar;
        __builtin_amdgcn_s_waitcnt(0);
        unsigned nloc = b.st[0], nx = b.st[1];
        if (nloc == 0u) { xcd_barrier_complete(bar, b.x, nloc, nx); b.st[0] = nloc; b.st[1] = nx; }
        const unsigned old = xb_add(&bar[XB_XSUB(b.x)], 1u);
        const unsigned gen = old / nloc;
        if (old + 1u == (gen + 1u) * nloc) {
            __builtin_amdgcn_fence(__ATOMIC_RELEASE, "agent");
            asm volatile("s_waitcnt vmcnt(0)" ::: "memory");
            const unsigned og = xb_add(&bar[XB_TOP], 1u);
            const unsigned tg = og / nx;
            if (og + 1u == (tg + 1u) * nx) xb_add(&bar[XB_TOPGEN], 1u);
            else XB_SPIN(xb_ld(&bar[XB_TOPGEN]) == tg, bar);
            __builtin_amdgcn_fence(__ATOMIC_ACQUIRE, "agent");
            xb_add(&bar[XB_XGEN(b.x)], 1u);
            asm volatile("s_waitcnt vmcnt(0)" ::: "memory");
        } else {
            XB_SPIN(xb_ld(&bar[XB_XGEN(b.x)]) == gen, bar);
            __builtin_amdgcn_fence(__ATOMIC_ACQUIRE, "agent");
            asm volatile("s_waitcnt vmcnt(0)" ::: "memory");
        }
    }
    __syncthreads();
}

__device__ void ph_mod(const P& p, float* lds) {
    const float* c = p.in[1]; const float* W = p.in[2]; const float* bia = p.in[3];
    float* mod = (float*)(p.ws + WS_MOD);
    const int tid = otid(), lane = tid & 63, wv = tid >> 6;
    float* sil = lds; float* part = lds + NB * DM;
    for (int i = tid; i < NB * DM; i += NTHR) { const float v = c[i]; sil[i] = v / (1.f + __expf(-v)); }
    __syncthreads();
    const int cc = lane % 24, kk = lane / 24;
    for (int j0 = blockIdx.x * 24; j0 < 6 * DM; j0 += gridDim.x * 24) {
        float a0 = 0.f, a1 = 0.f;
        if (lane < 48) {
#pragma unroll 32
            for (int i = 0; i < 64; ++i) { const int k = 128 * wv + 2 * i + kk; const float w = W[(size_t)k * (6 * DM) + j0 + cc]; a0 += sil[k] * w; a1 += sil[DM + k] * w; }
        }
        a0 += __shfl(a0, (lane + 24) & 63); a1 += __shfl(a1, (lane + 24) & 63);
        if (lane < 24) { part[(wv * 2 + 0) * 24 + cc] = a0; part[(wv * 2 + 1) * 24 + cc] = a1; }
        __syncthreads();
        if (tid < 48) { const int bb = tid / 24, c2 = tid % 24; float sum = 0.f;
#pragma unroll
            for (int w2 = 0; w2 < 8; ++w2) sum += part[(w2 * 2 + bb) * 24 + c2];
            mod[bb * 6 * DM + j0 + c2] = sum + bia[j0 + c2]; }
        __syncthreads();
    }
}

__device__ void ph_norm(const P& p, const float* src, const float* g, int which, bf16_t* dst) {
    const float* mod = (const float*)(p.ws + WS_MOD);
    const int lane = otid() & 63, wv = otid() >> 6;
    const int gw = blockIdx.x * (NTHR / 64) + wv, nw = gridDim.x * (NTHR / 64);
    for (int m = gw; m < NT; m += nw) {
        const int b = m / SEQ;
        const float* sh = mod + b * 6 * DM + (which ? 3 * DM : 0);
        const float* sc = sh + DM;
        const float4* xr = (const float4*)(src + (size_t)m * DM);
        float4 v[4]; float ss = 0.f;
#pragma unroll
        for (int j = 0; j < 4; ++j) { v[j] = xr[lane + 64 * j]; ss += v[j].x * v[j].x + v[j].y * v[j].y + v[j].z * v[j].z + v[j].w * v[j].w; }
        ss = wave_sum(ss);
        const float rstd = rsqrtf(ss * (1.f / DM) + NORM_EPS);
        float o[16];
#pragma unroll
        for (int j = 0; j < 4; ++j) {
            int c0 = 4 * (lane + 64 * j); asm volatile("" : "+v"(c0));
            const float4 gg = *(const float4*)(g + c0), s1 = *(const float4*)(sc + c0), s0 = *(const float4*)(sh + c0);
            o[4 * j + 0] = v[j].x * rstd * gg.x * (1.f + s1.x) + s0.x; o[4 * j + 1] = v[j].y * rstd * gg.y * (1.f + s1.y) + s0.y;
            o[4 * j + 2] = v[j].z * rstd * gg.z * (1.f + s1.z) + s0.z; o[4 * j + 3] = v[j].w * rstd * gg.w * (1.f + s1.w) + s0.w;
            uint2 pk; pk.x = (unsigned)f2bf(o[4 * j]) | ((unsigned)f2bf(o[4 * j + 1]) << 16); pk.y = (unsigned)f2bf(o[4 * j + 2]) | ((unsigned)f2bf(o[4 * j + 3]) << 16);
            *(uint2*)(dst + (size_t)m * DM + c0) = pk;
        }
    }
}

__device__ void ph_norm_route(const P& p, float* lds) {
    const float* mod = (const float*)(p.ws + WS_MOD); const float* src = p.out; const float* g = p.in[24]; bf16_t* dst = (bf16_t*)(p.ws + WS_XN2);
    const float* wgr = p.in[25]; const float* wer = p.in[26]; const float* eb = p.in[27];
    const int tid = otid(), lane = tid & 63, wv = tid >> 6;
    float* sx = lds + wv * 4096;
    int* cntL = (int*)(lds + 8 * 4096);
    if (tid < 64) cntL[tid] = 0;
    __syncthreads();
    const int TPB = NT / gridDim.x;
    for (int m0 = blockIdx.x * TPB + wv * 4; m0 < (blockIdx.x + 1) * TPB; m0 += 8 * 4) {
        const int b = m0 / SEQ;
        const float* sh = mod + b * 6 * DM + 3 * DM; const float* sc = sh + DM;
#pragma unroll 1
        for (int tk = 0; tk < 4; ++tk) {
            const int m = m0 + tk;
            const float4* xr = (const float4*)(src + (size_t)m * DM);
            float4 v[4]; float ss = 0.f;
#pragma unroll
            for (int j = 0; j < 4; ++j) { v[j] = xr[lane + 64 * j]; ss += v[j].x * v[j].x + v[j].y * v[j].y + v[j].z * v[j].z + v[j].w * v[j].w; }
            ss = wave_sum(ss);
            const float rstd = rsqrtf(ss * (1.f / DM) + NORM_EPS);
#pragma unroll
            for (int j = 0; j < 4; ++j) {
                const int c0 = 4 * (lane + 64 * j);
                const float4 gg = *(const float4*)(g + c0), s1 = *(const float4*)(sc + c0), s0 = *(const float4*)(sh + c0);
                const float o0 = v[j].x * rstd * gg.x * (1.f + s1.x) + s0.x, o1 = v[j].y * rstd * gg.y * (1.f + s1.y) + s0.y;
                const float o2 = v[j].z * rstd * gg.z * (1.f + s1.z) + s0.z, o3 = v[j].w * rstd * gg.w * (1.f + s1.w) + s0.w;
                uint2 pk; pk.x = (unsigned)f2bf(o0) | ((unsigned)f2bf(o1) << 16); pk.y = (unsigned)f2bf(o2) | ((unsigned)f2bf(o3) << 16);
                *(uint2*)(dst + (size_t)m * DM + c0) = pk;
                sx[(c0 + 0) * 4 + tk] = o0; sx[(c0 + 1) * 4 + tk] = o1; sx[(c0 + 2) * 4 + tk] = o2; sx[(c0 + 3) * 4 + tk] = o3;
            }
        }
        __builtin_amdgcn_wave_barrier(); asm volatile("s_waitcnt lgkmcnt(0)" ::: "memory");
        float ae[4], ag[4];
        {
            float pe[4][4];
#pragma unroll
            for (int t_ = 0; t_ < 4; ++t_)
#pragma unroll
                for (int q = 0; q < 4; ++q) pe[t_][q] = 0.f;
            const int eq = lane & 7, kb = (lane >> 3) * 128;
#pragma unroll 16
            for (int i = 0; i < 128; ++i) { const float4 w = *(const float4*)(wer + (size_t)(kb + i) * 32 + 4 * eq); const float4 xv = *(const float4*)(sx + (kb + i) * 4);
                pe[0][0] += xv.x * w.x; pe[0][1] += xv.x * w.y; pe[0][2] += xv.x * w.z; pe[0][3] += xv.x * w.w;
                pe[1][0] += xv.y * w.x; pe[1][1] += xv.y * w.y; pe[1][2] += xv.y * w.z; pe[1][3] += xv.y * w.w;
                pe[2][0] += xv.z * w.x; pe[2][1] += xv.z * w.y; pe[2][2] += xv.z * w.z; pe[2][3] += xv.z * w.w;
                pe[3][0] += xv.w * w.x; pe[3][1] += xv.w * w.y; pe[3][2] += xv.w * w.z; pe[3][3] += xv.w * w.w; }
#pragma unroll
            for (int t_ = 0; t_ < 4; ++t_)
#pragma unroll
                for (int q = 0; q < 4; ++q) { float v = pe[t_][q]; v += __shfl_xor(v, 8); v += __shfl_xor(v, 16); v += __shfl_xor(v, 32); pe[t_][q] = v; }
#pragma unroll
            for (int t_ = 0; t_ < 4; ++t_) { const int srcl = (lane & 31) >> 2; const float v0 = __shfl(pe[t_][0], srcl), v1 = __shfl(pe[t_][1], srcl), v2 = __shfl(pe[t_][2], srcl), v3 = __shfl(pe[t_][3], srcl);
                const int cq = lane & 3; ae[t_] = cq == 0 ? v0 : (cq == 1 ? v1 : (cq == 2 ? v2 : v3)); }
            float pg_[4][4];
#pragma unroll
            for (int t_ = 0; t_ < 4; ++t_)
#pragma unroll
                for (int q = 0; q < 4; ++q) pg_[t_][q] = 0.f;
            const int kg = lane * 16;
#pragma unroll
            for (int i = 0; i < 16; ++i) { const float4 w = *(const float4*)(wgr + (size_t)(kg + i) * 4); const float4 xv = *(const float4*)(sx + (kg + i) * 4);
                pg_[0][0] += xv.x * w.x; pg_[0][1] += xv.x * w.y; pg_[0][2] += xv.x * w.z; pg_[0][3] += xv.x * w.w;
                pg_[1][0] += xv.y * w.x; pg_[1][1] += xv.y * w.y; pg_[1][2] += xv.y * w.z; pg_[1][3] += xv.y * w.w;
                pg_[2][0] += xv.z * w.x; pg_[2][1] += xv.z * w.y; pg_[2][2] += xv.z * w.z; pg_[2][3] += xv.z * w.w;
                pg_[3][0] += xv.w * w.x; pg_[3][1] += xv.w * w.y; pg_[3][2] += xv.w * w.z; pg_[3][3] += xv.w * w.w; }
#pragma unroll
            for (int t_ = 0; t_ < 4; ++t_) {
#pragma unroll
                for (int q = 0; q < 4; ++q) pg_[t_][q] = wave_sum(pg_[t_][q]);
                const int cq = lane & 3; ag[t_] = cq == 0 ? pg_[t_][0] : (cq == 1 ? pg_[t_][1] : (cq == 2 ? pg_[t_][2] : pg_[t_][3])); }
        }
#pragma unroll
        for (int tk = 0; tk < 4; ++tk) {
            float lg[4];
#pragma unroll
            for (int q = 0; q < 4; ++q) lg[q] = __shfl(ag[tk], q);
            int gs = 0; float mx = lg[0];
#pragma unroll
            for (int q = 1; q < 4; ++q) if (lg[q] > mx) { mx = lg[q]; gs = q; }
            float den = 0.f;
#pragma unroll
            for (int q = 0; q < 4; ++q) den += __expf(lg[q] - mx);
            const float pg = 1.f / den;
            float ev[8];
#pragma unroll
            for (int q = 0; q < 8; ++q) ev[q] = __shfl(ae[tk], gs * 8 + q) + eb[gs * 8 + q];
            int i0 = 0; float v0 = ev[0];
#pragma unroll
            for (int q = 1; q < 8; ++q) if (ev[q] > v0) { v0 = ev[q]; i0 = q; }
            int i1 = -1; float v1 = -INFINITY;
#pragma unroll
            for (int q = 0; q < 8; ++q) if (q != i0 && ev[q] > v1) { v1 = ev[q]; i1 = q; }
            if (lane == 0) {
                const float e1 = __expf(v1 - v0), w0 = pg / (1.f + e1), w1 = pg * e1 / (1.f + e1);
                const int x0 = gs * 8 + i0, x1 = gs * 8 + i1;
                const int rk0 = atomicAdd(&cntL[x0], 1), rk1 = atomicAdd(&cntL[32 + x1], 1);
                int4* route = (int4*)(p.ws + WS_ROUTE) + (size_t)(m0 + tk);
                *route = make_int4(x0 | (x1 << 8), rk0 | (rk1 << 16), __float_as_int(w0), __float_as_int(w1));
            }
        }
        __builtin_amdgcn_wave_barrier();
    }
    __syncthreads();
    if (tid < 64) ((int*)(p.ws + WS_CTL) + CT_CNTB)[blockIdx.x * 64 + tid] = cntL[tid];
}

namespace pg8 {
#define PG8_LAS __attribute__((address_space(3)))
typedef short bf16x8 __attribute__((ext_vector_type(8)));
typedef float f32x4 __attribute__((ext_vector_type(4)));
typedef unsigned u32x4 __attribute__((ext_vector_type(4)));
constexpr int BM = 256, BK = 64, HALF = 128, HTB = HALF * BK * 2, STAGE_BYTES = 8 * HTB, NXCD = 8, WGM = 8;
__host__ __device__ __forceinline__ int lds_byte(int r, int c) { const int st = (r >> 4) * 2 + (c >> 5), rr = r & 15, cc = c & 31, ob = rr * 64 + cc * 2; return st * 1024 + (ob ^ (((ob >> 9) & 1) << 5)); }
__host__ __device__ __forceinline__ void stage_rc(int b, int& R, int& C) { const int st = b / 1024, sb = b % 1024, swz = sb ^ (((sb >> 9) & 1) << 5); R = (st >> 1) * 16 + swz / 64; C = (st & 1) * 32 + (swz % 64) / 2; }
__host__ __device__ __forceinline__ int perm32(int rho) { const int n = rho >> 4, i = rho & 15; return 8 * (i >> 2) + 4 * n + (i & 3); }

struct Unit { int arow, brow, pm, pn, aux; };
struct Gemm { const bf16_t* A; const bf16_t* Bt; int K; const int* gather; };

struct StaticOrder {
    int nM, nN, nwg, G, c;
    __device__ void init(int M, int N, int G_, int c_) { nM = M / BM; nN = N / BM; nwg = nM * nN; G = G_; c = c_; }
    __device__ bool next(int i, Unit& u) const {
        const long L = (long)i * G + c; if (L >= nwg) return false;
        int wgid = (int)L; { const int q = nwg / NXCD, r = nwg % NXCD, xcd = wgid % NXCD, off = wgid / NXCD; wgid = (xcd < r ? xcd * (q + 1) : r * (q + 1) + (xcd - r) * q) + off; }
        const int nig = WGM * nN, gid = wgid / nig, fm = gid * WGM, gsz = (nM - fm) < WGM ? (nM - fm) : WGM;
        u.pm = fm + ((wgid % nig) % gsz); u.pn = (wgid % nig) / gsz; u.arow = u.pm * BM; u.brow = u.pn * BM; u.aux = 0; return true;
    }
};
struct BranchOrder {
    StaticOrder S0;
    __device__ bool next(int i, Unit& u) const {
        if (!S0.next(i >> 1, u)) return false;
        const int which = i & 1; u.arow += which * NT; u.brow += which * DM; u.aux = which; return true;
    }
};
struct TableOrder {
    const int4* tab; int n, G, c;
    __device__ bool next(int i, Unit& u) const {
        const int L = i * G + c; if (L >= n) return false;
        const int4 e = tab[L]; u.arow = __builtin_amdgcn_readfirstlane(e.x); u.brow = __builtin_amdgcn_readfirstlane(e.y); u.aux = __builtin_amdgcn_readfirstlane(e.z); u.pn = __builtin_amdgcn_readfirstlane(e.w); u.pm = 0; return true;
    }
};
__device__ __forceinline__ unsigned cvt_pk_bf16(float lo, float hi) { return pk_bf16(lo, hi); }

template <class Epi, class Sched>
__device__ __forceinline__ void gemm_phase(PG8_LAS unsigned char* lds, const Gemm g, const Sched& S, const Epi& E) {
    const int tid = otid(), wid = __builtin_amdgcn_readfirstlane(tid >> 6), lane = tid & 63, wr = wid >> 2, wc = wid & 3, fr = lane & 15, fq = lane >> 4;
    const int K = g.K, nt = K / BK;
    int RA0; unsigned cofA0, voffB0;
    { int R, C; stage_rc(tid * 16, R, C); const int Rb = Epi::PERM ? ((R & ~31) + perm32(R & 31)) : R; RA0 = R; cofA0 = (unsigned)C * 2u; voffB0 = (unsigned)(Rb * K + C) * 2u; }
    const size_t rstep64 = (size_t)64 * K * 2;
    const size_t kstep = (size_t)(BK * 2);
    const size_t hstep = (size_t)HALF * K * 2;
    const unsigned ldsw = (unsigned)wid * 1024u;
    const int aoff = lds_byte(wr * 64 + fr, fq * 8), boff = lds_byte(wc * 32 + fr, fq * 8);
#define PG8_SA(b, h) (((b) * 2 + (h)) * HTB)
#define PG8_SB(b, h) ((4 + (b) * 2 + (h)) * HTB)
#define PG8_STAGE_B(bufoff, gbase) do { _Pragma("unroll") for (int _i = 0; _i < 2; ++_i) \
        __builtin_amdgcn_global_load_lds((const unsigned*)((const char*)(gbase) + _i * rstep64 + voffB0), (PG8_LAS unsigned*)(lds + (bufoff) + ldsw + _i * 8192), 16, 0, 0); } while (0)
#define PG8_STAGE_A(bufoff, o2, kb) do { _Pragma("unroll") for (int _i = 0; _i < 2; ++_i) \
        __builtin_amdgcn_global_load_lds((const unsigned*)((const char*)g.A + (size_t)(o2)[_i] + (size_t)(kb)), (PG8_LAS unsigned*)(lds + (bufoff) + ldsw + _i * 8192), 16, 0, 0); } while (0)
#define PG8_LDA(dst, b, h) do { _Pragma("unroll") for (int m = 0; m < 4; ++m) _Pragma("unroll") for (int k = 0; k < 2; ++k) dst[m][k] = *(const PG8_LAS bf16x8*)(lds + PG8_SA(b, h) + aoff + m * 2048 + k * 1024); } while (0)
#define PG8_LDB(dst, b, h) do { _Pragma("unroll") for (int n = 0; n < 2; ++n) _Pragma("unroll") for (int k = 0; k < 2; ++k) dst[n][k] = *(const PG8_LAS bf16x8*)(lds + PG8_SB(b, h) + boff + n * 2048 + k * 1024); } while (0)
#define PG8_MMA(ai, bj, At, Bt) do { __builtin_amdgcn_s_setprio(1); _Pragma("unroll") for (int m = 0; m < 4; ++m) _Pragma("unroll") for (int n = 0; n < 2; ++n) _Pragma("unroll") for (int k = 0; k < 2; ++k) \
        acc[ai][bj][m][n] = __builtin_amdgcn_mfma_f32_16x16x32_bf16(Bt[n][k], At[m][k], acc[ai][bj][m][n], 0, 0, 0); __builtin_amdgcn_s_setprio(0); } while (0)
#define PG8_WAIT_V(n) asm volatile("s_waitcnt vmcnt(" #n ")" ::: "memory")
#define PG8_WAIT_L(n) asm volatile("s_waitcnt lgkmcnt(" #n ")" ::: "memory")
#define PG8_BAR __builtin_amdgcn_s_barrier()
#define PG8_SCHED __builtin_amdgcn_sched_barrier(0)
#define PG8_AOFFS(u, dst) do { _Pragma("unroll") for (int _h = 0; _h < 2; ++_h) _Pragma("unroll") for (int _i = 0; _i < 2; ++_i) { \
        const int _tr = (u).arow + _h * HALF + RA0 + 64 * _i; const unsigned _row = g.gather ? (unsigned)g.gather[_tr] : (unsigned)_tr; dst[_h][_i] = _row * (unsigned)(K * 2) + cofA0; } } while (0)
    Unit cur, nxt; int ui = 0;
    if (!S.next(0, cur)) return;
    f32x4 acc[2][2][4][2];
#pragma unroll
    for (int a = 0; a < 2; ++a)
#pragma unroll
        for (int b = 0; b < 2; ++b)
#pragma unroll
            for (int m = 0; m < 4; ++m)
#pragma unroll
                for (int n = 0; n < 2; ++n) acc[a][b][m][n] = (f32x4){0.f, 0.f, 0.f, 0.f};
    bf16x8 At[4][2], B0[2][2], B1[2][2];
    unsigned cof[2][2];
    PG8_AOFFS(cur, cof);
    const char* cB = (const char*)g.Bt + (size_t)cur.brow * K * 2;
    PG8_STAGE_B(PG8_SB(0, 0), cB); PG8_STAGE_B(PG8_SB(0, 1), cB + hstep); PG8_STAGE_A(PG8_SA(0, 0), cof[0], 0); PG8_STAGE_A(PG8_SA(0, 1), cof[1], 0);
    if (wr == 1) PG8_BAR;
    PG8_WAIT_V(2); PG8_BAR;
    PG8_STAGE_B(PG8_SB(1, 0), cB + kstep); PG8_STAGE_A(PG8_SA(1, 0), cof[0], kstep); PG8_STAGE_B(PG8_SB(1, 1), cB + hstep + kstep);
    PG8_WAIT_V(6); PG8_BAR;
    for (;;) {
        const bool has_next = S.next(ui + 1, nxt);
        if (!has_next) nxt = cur;
        const char* nB = (const char*)g.Bt + (size_t)nxt.brow * K * 2;
        for (int t = 0; t < nt; t += 2) {
            const bool last = (t == nt - 2);
            const size_t k1 = (size_t)(t + 1) * kstep;
            const size_t k2 = last ? 0 : (size_t)(t + 2) * kstep, k3 = k2 + kstep;
            const char* b2 = last ? nB : cB + (size_t)(t + 2) * kstep; const char* b3 = b2 + kstep;
            PG8_LDB(B0, 0, 0); PG8_LDB(B1, 0, 1); PG8_SCHED; PG8_LDA(At, 0, 0); PG8_STAGE_A(PG8_SA(1, 1), cof[1], k1);
            if (last) { PG8_AOFFS(nxt, cof); }
            PG8_WAIT_V(8); PG8_WAIT_L(0); PG8_BAR; PG8_MMA(0, 0, At, B0); PG8_MMA(0, 1, At, B1); PG8_BAR; PG8_SCHED;
            PG8_LDA(At, 0, 1); PG8_STAGE_B(PG8_SB(0, 0), b2); PG8_STAGE_B(PG8_SB(0, 1), b2 + hstep); PG8_STAGE_A(PG8_SA(0, 0), cof[0], k2);
            PG8_WAIT_V(8); PG8_WAIT_L(0); PG8_BAR; PG8_MMA(1, 0, At, B0); PG8_MMA(1, 1, At, B1); PG8_BAR; PG8_SCHED;
            PG8_LDB(B0, 1, 0); PG8_LDB(B1, 1, 1); PG8_SCHED; PG8_LDA(At, 1, 0); PG8_STAGE_A(PG8_SA(0, 1), cof[1], k2);
            PG8_WAIT_V(8); PG8_WAIT_L(0); PG8_BAR; PG8_MMA(0, 0, At, B0); PG8_MMA(0, 1, At, B1); PG8_BAR; PG8_SCHED;
            PG8_LDA(At, 1, 1); PG8_STAGE_B(PG8_SB(1, 0), b3); PG8_STAGE_B(PG8_SB(1, 1), b3 + hstep); PG8_STAGE_A(PG8_SA(1, 0), cof[0], k3);
            PG8_WAIT_V(8); PG8_WAIT_L(0); PG8_BAR; PG8_MMA(1, 0, At, B0); PG8_MMA(1, 1, At, B1); PG8_BAR; PG8_SCHED;
        }
        if (wr == 0) PG8_BAR;
        { const int l2 = otid() & 63; E(acc, cur, wr, wc, l2 & 15, l2 >> 4); }
        if (!has_next) break;
#pragma unroll
        for (int a = 0; a < 2; ++a)
#pragma unroll
            for (int b = 0; b < 2; ++b)
#pragma unroll
                for (int m = 0; m < 4; ++m)
#pragma unroll
                    for (int n = 0; n < 2; ++n) acc[a][b][m][n] = (f32x4){0.f, 0.f, 0.f, 0.f};
        cur = nxt; cB = nB; ++ui;
        if (wr == 1) PG8_BAR;
    }
    PG8_WAIT_V(0);
    PG8_BAR;
#undef PG8_SA
#undef PG8_SB
#undef PG8_STAGE_A
#undef PG8_STAGE_B
#undef PG8_LDA
#undef PG8_LDB
#undef PG8_MMA
#undef PG8_WAIT_V
#undef PG8_WAIT_L
#undef PG8_BAR
#undef PG8_SCHED
#undef PG8_AOFFS
}

#define PG8_FENCE asm volatile("" ::: "memory")
#define PG8_FOR_TILE(ai, m, bj) _Pragma("unroll") for (int ai = 0; ai < 2; ++ai) _Pragma("unroll") for (int m = 0; m < 4; ++m) _Pragma("unroll") for (int bj = 0; bj < 2; ++bj)
__device__ __forceinline__ u32x4 pack8(const f32x4& v0, const f32x4& v1) { u32x4 w; w.x = cvt_pk_bf16(v0[0], v0[1]); w.y = cvt_pk_bf16(v0[2], v0[3]); w.z = cvt_pk_bf16(v1[0], v1[1]); w.w = cvt_pk_bf16(v1[2], v1[3]); return w; }
__device__ __forceinline__ float sigm(float x) { return __builtin_amdgcn_rcpf(1.f + __expf(-x)); }
struct EpiInproj {
    static constexpr bool PERM = true;
    unsigned char* ws; bf16_t* gates;
    __device__ __forceinline__ void operator()(const f32x4 (&acc)[2][2][4][2], const Unit& u, int wr, int wc, int fr, int fq) const {
        PG8_FOR_TILE(ai, m, bj) { PG8_FENCE;
            int row = u.pm * BM + ai * HALF + wr * 64 + m * 16 + fr; asm volatile("" : "+v"(row)); const int col = u.pn * BM + bj * HALF + wc * 32 + 8 * fq;
            const f32x4 v0 = acc[ai][bj][m][0], v1 = acc[ai][bj][m][1];
            if (col < C_KV) *(u32x4*)((bf16_t*)(ws + WS_Q) + (size_t)row * AW + col) = pack8(v0, v1);
            else if (col < C_QI) {
                *(u32x4*)((bf16_t*)(ws + WS_KVN) + (size_t)row * KVL + (col - C_KV)) = pack8(v0, v1);
                float ss = (v0[0] * v0[0] + v0[1] * v0[1]) + (v0[2] * v0[2] + v0[3] * v0[3]) + (v1[0] * v1[0] + v1[1] * v1[1]) + (v1[2] * v1[2] + v1[3] * v1[3]);
                ss += __shfl_xor(ss, 16); ss += __shfl_xor(ss, 32);
                if (fq == 0) ((float*)(ws + WS_RSS))[(size_t)row * 8 + bj * 4 + wc] = ss;
            }
            else if (col < C_PS) {
                if (col < 1056) {
                    typedef _Float16 h8 __attribute__((ext_vector_type(8)));
                    h8 hv; hv[0] = (_Float16)v0[0]; hv[1] = (_Float16)v0[1]; hv[2] = (_Float16)v0[2]; hv[3] = (_Float16)v0[3]; hv[4] = (_Float16)v1[0]; hv[5] = (_Float16)v1[1]; hv[6] = (_Float16)v1[2]; hv[7] = (_Float16)v1[3];
                    _Float16* d = (col < 1024) ? (_Float16*)(ws + WS_QI) + (size_t)row * 256 + (col - C_QI) : (_Float16*)(ws + WS_KI) + (size_t)row * 32 + (col - 1024);
                    *(h8*)d = hv;
                } else { const float sc_ = 0.17677669529663687f * 0.35355339059327373f; float* d = (float*)(ws + WS_WI) + (size_t)row * 8; *(f32x4*)d = v0 * sc_; *(f32x4*)(d + 4) = v1 * sc_; }
            }
            else if (col < C_GA) *(u32x4*)((bf16_t*)(ws + WS_PS) + (size_t)row * SHW + (col - C_PS)) = pack8(v0, v1);
            else if (col < INW) {
                f32x4 s0, s1;
#pragma unroll
                for (int e = 0; e < 4; ++e) { s0[e] = sigm(v0[e]); s1[e] = sigm(v1[e]); }
                bf16_t* d = (col < C_GR) ? gates + (size_t)row * DM + (col - C_GA) : gates + (size_t)NT * DM + (size_t)row * DM + (col - C_GR);
                *(u32x4*)d = pack8(s0, s1);
            }
        }
    }
};
struct EpiKV {
    static constexpr bool PERM = true;
    unsigned char* ws;
    __device__ __forceinline__ void operator()(const f32x4 (&acc)[2][2][4][2], const Unit& u, int wr, int wc, int fr, int fq) const {
        PG8_FOR_TILE(ai, m, bj) { PG8_FENCE;
            int row = u.pm * BM + ai * HALF + wr * 64 + m * 16 + fr; asm volatile("" : "+v"(row)); const int col = u.pn * BM + bj * HALF + wc * 32 + 8 * fq;
            const f32x4 ra = *(const f32x4*)((const float*)(ws + WS_RSS) + (size_t)row * 8), rb = *(const f32x4*)((const float*)(ws + WS_RSS) + (size_t)row * 8 + 4);
            const float rstd = rsqrtf((((ra[0] + ra[1]) + (ra[2] + ra[3])) + ((rb[0] + rb[1]) + (rb[2] + rb[3]))) * (1.f / KVL) + NORM_EPS);
            if (col < AW) *(u32x4*)((bf16_t*)(ws + WS_K) + (size_t)row * AW + col) = pack8(acc[ai][bj][m][0] * rstd, acc[ai][bj][m][1] * rstd);
            else {
                bf16_t* d = (bf16_t*)(ws + WS_V) + ((size_t)(row / SEQ) * 512 + (col - AW)) * SEQ + (row % SEQ);
#pragma unroll
                for (int e = 0; e < 4; ++e) { d[(size_t)e * SEQ] = f2bf(acc[ai][bj][m][0][e] * rstd); d[(size_t)(4 + e) * SEQ] = f2bf(acc[ai][bj][m][1][e] * rstd); }
            }
        }
    }
};
struct EpiMerge {
    static constexpr bool PERM = true;
    bf16_t* merged; const bf16_t* gates;
    __device__ __forceinline__ void operator()(const f32x4 (&acc)[2][2][4][2], const Unit& u, int wr, int wc, int fr, int fq) const {
        const bf16_t* gate = gates + (size_t)u.aux * NT * DM;
        PG8_FOR_TILE(ai, m, bj) { PG8_FENCE;
            int row = u.pm * BM + ai * HALF + wr * 64 + m * 16 + fr; asm volatile("" : "+v"(row)); const int col = u.pn * BM + bj * HALF + wc * 32 + 8 * fq;
            const u32x4 gw = *(const u32x4*)(gate + (size_t)row * DM + col);
            f32x4 v0 = acc[ai][bj][m][0], v1 = acc[ai][bj][m][1];
            v0[0] *= __uint_as_float(gw.x << 16); v0[1] *= __uint_as_float(gw.x & 0xffff0000u); v0[2] *= __uint_as_float(gw.y << 16); v0[3] *= __uint_as_float(gw.y & 0xffff0000u);
            v1[0] *= __uint_as_float(gw.z << 16); v1[1] *= __uint_as_float(gw.z & 0xffff0000u); v1[2] *= __uint_as_float(gw.w << 16); v1[3] *= __uint_as_float(gw.w & 0xffff0000u);
            u32x4* d = (u32x4*)(merged + (size_t)row * DM + col);
            if (u.aux) { const u32x4 pw = *d;
                v0[0] += __uint_as_float(pw.x << 16); v0[1] += __uint_as_float(pw.x & 0xffff0000u); v0[2] += __uint_as_float(pw.y << 16); v0[3] += __uint_as_float(pw.y & 0xffff0000u);
                v1[0] += __uint_as_float(pw.z << 16); v1[1] += __uint_as_float(pw.z & 0xffff0000u); v1[2] += __uint_as_float(pw.w << 16); v1[3] += __uint_as_float(pw.w & 0xffff0000u); }
            *d = pack8(v0, v1);
        }
    }
};
struct EpiOut {
    static constexpr bool PERM = false;
    const float* x; const float* mod; float* out;
    __device__ __forceinline__ void operator()(const f32x4 (&acc)[2][2][4][2], const Unit& u, int wr, int wc, int fr, int fq) const {
        PG8_FOR_TILE(ai, m, bj) { PG8_FENCE;
            int row = u.pm * BM + ai * HALF + wr * 64 + m * 16 + fr; asm volatile("" : "+v"(row)); const float* gt = mod + (row / SEQ) * 6 * DM + 2 * DM;
#pragma unroll
            for (int n = 0; n < 2; ++n) { const int col = u.pn * BM + bj * HALF + wc * 32 + 16 * n + 4 * fq;
                const f32x4 xv = *(const f32x4*)(x + (size_t)row * DM + col), gv = *(const f32x4*)(gt + col);
                *(f32x4*)(out + (size_t)row * DM + col) = xv + gv * acc[ai][bj][m][n]; }
        }
    }
};
struct EpiMoe1 {
    static constexpr bool PERM = true;
    bf16_t* hid; const float* lw;
    __device__ __forceinline__ void operator()(const f32x4 (&acc)[2][2][4][2], const Unit& u, int wr, int wc, int fr, int fq) const {
#pragma unroll
        for (int ai = 0; ai < 2; ++ai)
#pragma unroll
            for (int m = 0; m < 4; ++m) {
                const int tr = ai * HALF + wr * 64 + m * 16 + fr; PG8_FENCE;
                if (tr < u.aux) {
                    const float w = lw[u.arow + tr]; f32x4 h0, h1;
#pragma unroll
                    for (int e = 0; e < 4; ++e) { const float g0 = acc[ai][0][m][0][e], g1 = acc[ai][0][m][1][e];
                        h0[e] = w * (g0 * __builtin_amdgcn_rcpf(1.f + __expf(-g0))) * acc[ai][1][m][0][e]; h1[e] = w * (g1 * __builtin_amdgcn_rcpf(1.f + __expf(-g1))) * acc[ai][1][m][1][e]; }
                    *(u32x4*)(hid + (size_t)(u.arow + tr) * DE + u.pn * HALF + wc * 32 + 8 * fq) = pack8(h0, h1);
                }
            }
    }
};
struct EpiMoe2 {
    static constexpr bool PERM = false;
    const int* ltok; const float* mod; float* out;
    __device__ __forceinline__ void operator()(const f32x4 (&acc)[2][2][4][2], const Unit& u, int wr, int wc, int fr, int fq) const {
#pragma unroll
        for (int ai = 0; ai < 2; ++ai)
#pragma unroll
            for (int m = 0; m < 4; ++m) {
                const int tr = ai * HALF + wr * 64 + m * 16 + fr; PG8_FENCE;
                if (tr < u.aux) {
                    const int tok = ltok[u.arow + tr]; const float* gt = mod + (tok / SEQ) * 6 * DM + 5 * DM; float* orow = out + (size_t)tok * DM;
#pragma unroll
                    for (int bj = 0; bj < 2; ++bj)
#pragma unroll
                        for (int n = 0; n < 2; ++n) { const int col = u.pn * BM + bj * HALF + wc * 32 + 16 * n + 4 * fq;
                            const f32x4 gv = *(const f32x4*)(gt + col); f32x4* d = (f32x4*)(orow + col); *d = *d + gv * acc[ai][bj][m][n]; }
                }
            }
    }
};
}

__device__ __forceinline__ unsigned pk2(float lo, float hi) { return (unsigned)f2bf(lo) | ((unsigned)f2bf(hi) << 16); }
__device__ __forceinline__ void transpose_item(const float* W, int K, int N, bf16_t* WT, size_t drow0, int k0, int n0, float* scr, int lane, int Ksrc = 1 << 30, const float* kscale = nullptr) {
#pragma unroll 8
    for (int i = 0; i < 32; ++i) { const int kk = 2 * i + (lane >> 5), n = n0 + (lane & 31); float v_ = (n < N && k0 + kk < Ksrc) ? W[(size_t)(k0 + kk) * N + n] : 0.f; if (kscale) v_ *= kscale[k0 + kk]; scr[kk * 33 + (lane & 31)] = v_; }
    asm volatile("s_waitcnt lgkmcnt(0)" ::: "memory");
    const int c = lane & 7;
#pragma unroll
    for (int j = 0; j < 4; ++j) { const int n = (lane >> 3) + 8 * j; const float* s_ = scr + (8 * c) * 33 + n;
        uint4 o; o.x = pk2(s_[0 * 33], s_[1 * 33]); o.y = pk2(s_[2 * 33], s_[3 * 33]); o.z = pk2(s_[4 * 33], s_[5 * 33]); o.w = pk2(s_[6 * 33], s_[7 * 33]);
        *(uint4*)(WT + (drow0 + n) * K + k0 + 8 * c) = o; }
    asm volatile("s_waitcnt lgkmcnt(0)" ::: "memory");
}
__device__ __forceinline__ void transpose_item64(const float* W, int K, int N, bf16_t* WT, size_t drow0, int k0, int n0, float* scr, int lane, const float* kscale = nullptr) {
    const int r_ = lane >> 4, c4 = (lane & 15) * 4, n = n0 + c4;
    float4 v[16];
#pragma unroll
    for (int i = 0; i < 16; ++i) { v[i] = make_float4(0.f, 0.f, 0.f, 0.f); if (n < N) v[i] = *(const float4*)(W + (size_t)(k0 + r_ + 4 * i) * N + n); }
#pragma unroll
    for (int i = 0; i < 16; ++i) { const int kk = r_ + 4 * i; float4 x = v[i]; if (kscale) { const float s_ = kscale[k0 + kk]; x.x *= s_; x.y *= s_; x.z *= s_; x.w *= s_; }
        float* d_ = scr + kk * 65 + c4; d_[0] = x.x; d_[1] = x.y; d_[2] = x.z; d_[3] = x.w; }
    asm volatile("s_waitcnt lgkmcnt(0)" ::: "memory");
    const int c = lane & 7;
#pragma unroll
    for (int j = 0; j < 8; ++j) { const int nn = (lane >> 3) + 8 * j; const float* s_ = scr + (8 * c) * 65 + nn;
        uint4 o; o.x = pk2(s_[0 * 65], s_[1 * 65]); o.y = pk2(s_[2 * 65], s_[3 * 65]); o.z = pk2(s_[4 * 65], s_[5 * 65]); o.w = pk2(s_[6 * 65], s_[7 * 65]);
        *(uint4*)(WT + (drow0 + nn) * K + k0 + 8 * c) = o; }
    asm volatile("s_waitcnt lgkmcnt(0)" ::: "memory");
}
__device__ void ph_convert_mixer_weights(const P& p, float* lds) {
    const int lane = otid() & 63, wv = otid() >> 6;
    float* scr = lds + wv * (64 * 65);
    const int gw = blockIdx.x * (NTHR / 64) + wv, nw = gridDim.x * (NTHR / 64);
    struct M { const float* W; int K, N, Npad; size_t dst; const float* ks; };
    const M ms[5] = { {p.in[5], DM, INW, 5120, WS_WIN, nullptr}, {p.in[7], KVL, 2 * AW, 2 * AW, WS_WKV, p.in[6]}, {p.in[21], AW, DM, DM, WS_WBA, nullptr}, {p.in[22], RW, DM, DM, WS_WBR, nullptr}, {p.in[23], DM, DM, DM, WS_WOUT, nullptr} };
    int base = 0;
#pragma unroll
    for (int q = 0; q < 5; ++q) {
        const int nkb = ms[q].K / 64, nnb = ms[q].Npad / 64, nitems = nkb * nnb;
        for (int it = gw; it < base + nitems; it += nw) { if (it < base) continue; const int r = it - base; const int kb = r / nnb, nb = r % nnb;
            transpose_item64(ms[q].W, ms[q].K, ms[q].N, (bf16_t*)(p.ws + ms[q].dst), (size_t)nb * 64, kb * 64, nb * 64, scr, lane, ms[q].ks); }
        base += nitems;
    }
}
__device__ void ph_convert_lora_weights(const P& p, float* lds) {
    const int lane = otid() & 63, wv = otid() >> 6;
    float* scr = lds + wv * (64 * 33);
    const int gw = blockIdx.x * (NTHR / 64) + wv, nw = gridDim.x * (NTHR / 64);
    for (int it = gw; it < 16 + 16 + 48; it += nw) {
        if (it < 16) transpose_item(p.in[12], 64, RW, (bf16_t*)(p.ws + WS_LW2T), (size_t)it * 32, 0, it * 32, scr, lane);
        else if (it < 32) transpose_item(p.in[14], 64, RW, (bf16_t*)(p.ws + WS_LA2T), (size_t)(it - 16) * 32, 0, (it - 16) * 32, scr, lane);
        else { const int r = it - 32, kb = r >> 4, nb = r & 15; transpose_item(p.in[15], 192, RW, (bf16_t*)(p.ws + WS_LG2T), (size_t)nb * 32, kb * 64, nb * 32, scr, lane, 160); }
    }
}
__device__ void ph_convert_expert_weights(const P& p, float* lds) {
    const int lane = otid() & 63, wv = otid() >> 6;
    float* scr = lds + wv * (64 * 65);
    const int gw = blockIdx.x * (NTHR / 64) + wv, nw = gridDim.x * (NTHR / 64);
    for (int it = gw; it < NE * 2 * 128; it += nw) { const int e = it >> 8, which = (it >> 7) & 1, r = it & 127, kb = r >> 3, nb = r & 7, n0 = nb * 64;
        transpose_item64(p.in[28 + which] + (size_t)e * DM * DE, DM, DE, (bf16_t*)(p.ws + WS_WGU), (size_t)e * 1024 + (n0 >> 7) * 256 + which * 128 + (n0 & 127), kb * 64, n0, scr, lane); }
    for (int it = gw; it < NE * 128; it += nw) { const int e = it >> 7, r = it & 127, kb = r >> 4, nb = r & 15;
        transpose_item64(p.in[30] + (size_t)e * DE * DM, DE, DM, (bf16_t*)(p.ws + WS_WDN), (size_t)e * 1024 + nb * 64, kb * 64, nb * 64, scr, lane); }
}

__device__ void ph_headnorm(bf16_t* X, const float* g) {
    const int lane = otid() & 63, wv = otid() >> 6;
    const int gw = blockIdx.x * (NTHR / 64) + wv, nw = gridDim.x * (NTHR / 64);
    for (int m = gw; m < NT; m += nw) {
        uint4 raw = *(const uint4*)(X + (size_t)m * AW + lane * 8);
        float v[8] = {bf2f(raw.x & 0xffff), bf2f(raw.x >> 16), bf2f(raw.y & 0xffff), bf2f(raw.y >> 16), bf2f(raw.z & 0xffff), bf2f(raw.z >> 16), bf2f(raw.w & 0xffff), bf2f(raw.w >> 16)};
        float ss = 0.f;
#pragma unroll
        for (int i = 0; i < 8; ++i) ss += v[i] * v[i];
        ss += __shfl_xor(ss, 1); ss += __shfl_xor(ss, 2); ss += __shfl_xor(ss, 4);
        const float rstd = rsqrtf(ss * (1.f / 64.f) + NORM_EPS);
        const int d0 = (lane & 7) * 8;
        unsigned o[4];
#pragma unroll
        for (int i = 0; i < 4; ++i) o[i] = (unsigned)f2bf(v[2 * i] * rstd * g[d0 + 2 * i]) | ((unsigned)f2bf(v[2 * i + 1] * rstd * g[d0 + 2 * i + 1]) << 16);
        *(uint4*)(X + (size_t)m * AW + lane * 8) = make_uint4(o[0], o[1], o[2], o[3]);
    }
}
__device__ void ph_kvnorm(bf16_t* X, const float* g) {
    const int lane = otid() & 63, wv = otid() >> 6;
    const int gw = blockIdx.x * (NTHR / 64) + wv, nw = gridDim.x * (NTHR / 64);
    for (int m = gw; m < NT; m += nw) {
        uint2 raw = *(const uint2*)(X + (size_t)m * KVL + lane * 4);
        float v[4] = {bf2f(raw.x & 0xffff), bf2f(raw.x >> 16), bf2f(raw.y & 0xffff), bf2f(raw.y >> 16)};
        float ss = wave_sum(v[0] * v[0] + v[1] * v[1] + v[2] * v[2] + v[3] * v[3]);
        const float rstd = rsqrtf(ss * (1.f / 256.f) + NORM_EPS);
        uint2 o; o.x = (unsigned)f2bf(v[0] * rstd * g[lane * 4]) | ((unsigned)f2bf(v[1] * rstd * g[lane * 4 + 1]) << 16);
        o.y = (unsigned)f2bf(v[2] * rstd * g[lane * 4 + 2]) | ((unsigned)f2bf(v[3] * rstd * g[lane * 4 + 3]) << 16);
        *(uint2*)(X + (size_t)m * KVL + lane * 4) = o;
    }
}

typedef _Float16 half8_t __attribute__((ext_vector_type(8)));
typedef float f32x16_t __attribute__((ext_vector_type(16)));
__device__ __forceinline__ unsigned f2key(float f) { unsigned u = __float_as_uint(f); return (u & 0x80000000u) ? ~u : (u | 0x80000000u); }
template <bool PASS1, bool FULL>
__device__ __forceinline__ void d1_unit(const half8_t& a0, const half8_t& a1, const half8_t& b0, const half8_t& b1, const float (&w)[4][4], int rg, int hh, int r32, int tile, int t0,
                                        unsigned* hist, unsigned* maskl, int* misc, uint2* cand, int tbA, int tbB) {
    constexpr int CCAP = 1024;
    f32x16_t c;
#pragma unroll
    for (int i = 0; i < 16; ++i) c[i] = 0.f;
    c = __builtin_amdgcn_mfma_f32_32x32x16_f16(a0, b0, c, 0, 0, 0);
    c = __builtin_amdgcn_mfma_f32_32x32x16_f16(a1, b1, c, 0, 0, 0);
    float x[4];
#pragma unroll
    for (int tl = 0; tl < 4; ++tl) { x[tl] = 0.f;
#pragma unroll
        for (int e = 0; e < 4; ++e) x[tl] = __builtin_fmaf(w[tl][e], __int_as_float(max(__float_as_int(c[4 * tl + e]), 0)), x[tl]); }
    const auto s01 = __builtin_amdgcn_permlane32_swap(__float_as_uint(x[0]), __float_as_uint(x[1]), false, false);
    const auto s23 = __builtin_amdgcn_permlane32_swap(__float_as_uint(x[2]), __float_as_uint(x[3]), false, false);
    const unsigned k01 = f2key(__uint_as_float(s01[0]) + __uint_as_float(s01[1]));
    const unsigned k23 = f2key(__uint_as_float(s23[0]) + __uint_as_float(s23[1]));
    const int rowA = 4 * rg + hh, rowB = rowA + 2, key = tile * 32 + r32;
    const bool okA = FULL || key <= t0 + rowA, okB = FULL || key <= t0 + rowB;
    if (!PASS1) {
        atomicAdd(&hist[okA ? rowA * 2048 + (int)(k01 >> 21) : 8 * 2048 + 16384 + 2048 + 7], 1u << (16 * ((k01 >> 20) & 1u)));
        atomicAdd(&hist[okB ? rowB * 2048 + (int)(k23 >> 21) : 8 * 2048 + 16384 + 2048 + 7], 1u << (16 * ((k23 >> 20) & 1u)));
    } else {
        const int binA = (int)(k01 >> 20), binB = (int)(k23 >> 20);
        const unsigned long long mA = __ballot(okA && binA > tbA), mB = __ballot(okB && binB > tbB);
        if (r32 == 0) { maskl[rowA * 256 + tile] = hh ? (unsigned)(mA >> 32) : (unsigned)mA; maskl[rowB * 256 + tile] = hh ? (unsigned)(mB >> 32) : (unsigned)mB; }
        if (okA && binA == tbA) { const int pos = atomicAdd(&misc[rowA * 8 + 2], 1); if (pos < CCAP) cand[rowA * CCAP + pos] = make_uint2(k01, (unsigned)key); }
        if (okB && binB == tbB) { const int pos = atomicAdd(&misc[rowB * 8 + 2], 1); if (pos < CCAP) cand[rowB * CCAP + pos] = make_uint2(k23, (unsigned)key); }
    }
}
__device__ void ph_dsa_select(const P& p, float* ldsf) {
    const _Float16* QI = (const _Float16*)(p.ws + WS_QI); const _Float16* KI = (const _Float16*)(p.ws + WS_KI); const float* WI = (const float*)(p.ws + WS_WI);
    unsigned* MASK32 = (unsigned*)(p.ws + WS_MASK);
    unsigned* hist = (unsigned*)ldsf;
    uint2* cand = (uint2*)(hist + 8 * 2048);
    unsigned* maskl = (unsigned*)(cand + 8 * 1024);
    unsigned* h2 = hist;
    int* misc = (int*)(maskl + 8 * 256);
    constexpr int CCAP = 1024;
    const int tid = otid(), lane = tid & 63, wv = tid >> 6, hh = lane >> 5, r32 = lane & 31;
    const int nrnd = (NT / 8 + (int)gridDim.x - 1) / (int)gridDim.x;
#pragma unroll 1
    for (int rnd = 0; rnd < nrnd; ++rnd) {
        const int item = __builtin_amdgcn_readfirstlane(rnd * (int)gridDim.x + ((rnd & 1) ? (int)(gridDim.x - 1 - blockIdx.x) : (int)blockIdx.x));
        if (item >= NT / 8) continue;
        const int tq0 = item * 8, b = tq0 / SEQ, t0 = tq0 % SEQ;
        const int nwords = ((t0 >> 8) + 1) * 8;
        __syncthreads();
        if (t0 + 7 < TOPK) {
            for (int e = tid; e < 8 * nwords; e += NTHR) { const int row = e / nwords, w = e % nwords; const int tr_ = t0 + row; const int lo = 32 * w;
                const unsigned bits = (tr_ >= lo + 31) ? 0xffffffffu : ((tr_ < lo) ? 0u : ((2u << (tr_ - lo)) - 1u));
                MASK32[(size_t)(tq0 + row) * 256 + w] = bits; }
            continue;
        }
        for (int e = tid; e < 8 * 2048; e += NTHR) hist[e] = 0u;
        for (int e = tid; e < 8 * 256; e += NTHR) maskl[e] = 0u;
        if (tid < 64) misc[tid] = 0;
        half8_t a0[2], a1[2]; float w[2][4][4];
#pragma unroll
        for (int rg = 0; rg < 2; ++rg) { const int tl_a = r32 >> 3, h_a = r32 & 7; const _Float16* qp = QI + (size_t)(tq0 + 4 * rg + tl_a) * 256 + h_a * 32 + 8 * hh;
            a0[rg] = *(const half8_t*)qp; a1[rg] = *(const half8_t*)(qp + 16);
#pragma unroll
            for (int tl = 0; tl < 4; ++tl) { const float4 wv4 = *(const float4*)(WI + (size_t)(tq0 + 4 * rg + tl) * 8 + 4 * hh); w[rg][tl][0] = wv4.x; w[rg][tl][1] = wv4.y; w[rg][tl][2] = wv4.z; w[rg][tl][3] = wv4.w; } }
        const int ntile = (t0 + 7) / 32 + 1;
        __syncthreads();
        int thr_bin[8];
#pragma unroll 1
        for (int pass = 0; pass < 2; ++pass) {
            if (pass == 1) {
#pragma unroll
                for (int r = 0; r < 8; ++r) thr_bin[r] = misc[r * 8];
            }
            half8_t kb0[4], kb1[4], nk0[4], nk1[4];
#pragma unroll
            for (int q = 0; q < 4; ++q) { const int tl_ = min(4 * wv + q, ntile - 1); const _Float16* kp = KI + (size_t)(b * SEQ + tl_ * 32 + r32) * 32 + 8 * hh; nk0[q] = *(const half8_t*)kp; nk1[q] = *(const half8_t*)(kp + 16); }
            for (int tbase = 4 * wv; tbase < ntile; tbase += 32) {
#pragma unroll
                for (int q = 0; q < 4; ++q) { kb0[q] = nk0[q]; kb1[q] = nk1[q]; }
                if (tbase + 32 < ntile) {
#pragma unroll
                    for (int q = 0; q < 4; ++q) { const int tl_ = min(tbase + 32 + q, ntile - 1); const _Float16* kp = KI + (size_t)(b * SEQ + tl_ * 32 + r32) * 32 + 8 * hh; nk0[q] = *(const half8_t*)kp; nk1[q] = *(const half8_t*)(kp + 16); }
                }
#pragma unroll
                for (int q = 0; q < 4; ++q) {
                const int tile = tbase + q;
                if (tile < ntile) {
                const half8_t b0 = kb0[q], b1 = kb1[q];
                const bool full = tile * 32 + 31 <= t0;
#pragma unroll
                for (int rg = 0; rg < 2; ++rg) {
                    const int tbA = hh ? thr_bin[4 * rg + 1] : thr_bin[4 * rg], tbB = hh ? thr_bin[4 * rg + 3] : thr_bin[4 * rg + 2];
                    if (pass == 0) { if (full) d1_unit<false, true>(a0[rg], a1[rg], b0, b1, w[rg], rg, hh, r32, tile, t0, hist, maskl, misc, cand, 0, 0);
                                     else d1_unit<false, false>(a0[rg], a1[rg], b0, b1, w[rg], rg, hh, r32, tile, t0, hist, maskl, misc, cand, 0, 0); }
                    else { if (full) d1_unit<true, true>(a0[rg], a1[rg], b0, b1, w[rg], rg, hh, r32, tile, t0, hist, maskl, misc, cand, tbA, tbB);
                           else d1_unit<true, false>(a0[rg], a1[rg], b0, b1, w[rg], rg, hh, r32, tile, t0, hist, maskl, misc, cand, tbA, tbB); }
                }
                }
                }
            }
            __syncthreads();
            if (pass == 0) {
                const unsigned* hrw = hist + wv * 2048; unsigned tot = 0;
                { const uint4* h4 = (const uint4*)(hrw + 32 * lane);
#pragma unroll
                  for (int i = 0; i < 8; ++i) { const uint4 v = h4[i]; tot += (v.x & 0xffffu) + (v.x >> 16) + (v.y & 0xffffu) + (v.y >> 16) + (v.z & 0xffffu) + (v.z >> 16) + (v.w & 0xffffu) + (v.w >> 16); } }
                unsigned suf = tot;
#pragma unroll
                for (int o = 1; o < 64; o <<= 1) { const unsigned oth = __shfl_down(suf, o); if (lane + o < 64) suf += oth; }
                const unsigned above = suf - tot;
                const unsigned long long hit = __ballot((int)above < TOPK && TOPK <= (int)(above + tot));
                const int lsel = __ffsll((long long)hit) - 1; const unsigned above_g = __shfl(above, lsel);
                const unsigned wd = hrw[32 * lsel + (lane >> 1)]; const unsigned cnt = (lane & 1) ? (wd >> 16) : (wd & 0xffffu);
                unsigned s2 = cnt;
#pragma unroll
                for (int o = 1; o < 64; o <<= 1) { const unsigned oth = __shfl_down(s2, o); if (lane + o < 64) s2 += oth; }
                const unsigned ab2 = above_g + s2 - cnt;
                if ((int)ab2 < TOPK && TOPK <= (int)(ab2 + cnt)) { misc[wv * 8] = 64 * lsel + lane; misc[wv * 8 + 1] = TOPK - (int)ab2; }
                __syncthreads();
            }
        }
        {
            const int row = wv, need0 = misc[row * 8 + 1]; const int cn = min(misc[row * 8 + 2], CCAP);
            const uint2* cr = cand + row * CCAP; unsigned* hrow = h2 + row * 256;
            unsigned prefix = 0; int remaining = need0, cnt_eq = cn;
#pragma unroll 1
            for (int pass = 0; pass < 3; ++pass) {
                const int shift = (pass == 0) ? 12 : ((pass == 1) ? 4 : 0), nb = (pass == 2) ? 4 : 8;
                for (int i = lane; i < 256; i += 64) hrow[i] = 0u;
                __builtin_amdgcn_wave_barrier(); asm volatile("s_waitcnt lgkmcnt(0)" ::: "memory");
                for (int i = lane; i < cn; i += 64) { const unsigned k = cr[i].x & 0xfffffu; if (pass == 0 || (k >> (shift + nb)) == (prefix >> (shift + nb))) atomicAdd(&hrow[(k >> shift) & ((1u << nb) - 1u)], 1u); }
                __builtin_amdgcn_wave_barrier(); asm volatile("s_waitcnt lgkmcnt(0)" ::: "memory");
                const unsigned h0 = hrow[4 * lane], h1 = hrow[4 * lane + 1], h2_ = hrow[4 * lane + 2], h3 = hrow[4 * lane + 3];
                unsigned suf = h0 + h1 + h2_ + h3;
#pragma unroll
                for (int o = 1; o < 64; o <<= 1) { const unsigned oth = __shfl_down(suf, o); if (lane + o < 64) suf += oth; }
                const unsigned above3 = suf - (h0 + h1 + h2_ + h3);
                const unsigned ab[4] = {above3 + h3 + h2_ + h1, above3 + h3 + h2_, above3 + h3, above3}; const unsigned hv[4] = {h0, h1, h2_, h3};
                int selbin = -1, newrem = 0, neweq = 0;
#pragma unroll
                for (int q = 0; q < 4; ++q) if ((int)ab[q] < remaining && remaining <= (int)(ab[q] + hv[q])) { selbin = 4 * lane + q; newrem = remaining - (int)ab[q]; neweq = (int)hv[q]; }
                const unsigned long long has = __ballot(selbin >= 0); const int src = __ffsll((long long)has) - 1;
                selbin = __shfl(selbin, src); newrem = __shfl(newrem, src); neweq = __shfl(neweq, src);
                prefix |= ((unsigned)selbin) << shift; remaining = newrem; cnt_eq = neweq;
            }
            for (int i0 = 0; i0 < cn; i0 += 64) { const int i = i0 + lane; bool sel = false;
                if (i < cn) { const uint2 ce = cr[i]; const unsigned k = ce.x & 0xfffffu;
                    if (k > prefix) sel = true;
                    else if (k == prefix) { if (cnt_eq == remaining) sel = true; else { int rank = 0; for (int j = 0; j < cn; ++j) { const uint2 cj = cr[j]; rank += ((cj.x & 0xfffffu) == prefix && cj.y < ce.y) ? 1 : 0; } sel = rank < remaining; } }
                    if (sel) atomicOr(&maskl[row * 256 + (ce.y >> 5)], 1u << (ce.y & 31)); } }
        }
        __syncthreads();
        for (int e = tid; e < 8 * nwords; e += NTHR) { const int row = e / nwords, w2 = e % nwords; MASK32[(size_t)(tq0 + row) * 256 + w2] = maskl[row * 256 + w2]; }
    }
}

__device__ void knorm_tile(const P& p, int pm, int pn) {
    bf16_t* Kg = (bf16_t*)(p.ws + WS_K); const float* kg = p.in[9];
    const int tid = otid();
    for (int pr = tid; pr < 1024; pr += NTHR) {
        const int row = pm * 256 + (pr >> 2), head = pn * 4 + (pr & 3);
        uint4* ptr = (uint4*)(Kg + (size_t)row * AW + head * 64);
        uint4 v[8]; float ss = 0.f;
#pragma unroll
        for (int c = 0; c < 8; ++c) { v[c] = ptr[c]; const unsigned w[4] = {v[c].x, v[c].y, v[c].z, v[c].w};
#pragma unroll
            for (int e = 0; e < 4; ++e) { const float a = __uint_as_float(w[e] << 16), b2 = __uint_as_float(w[e] & 0xffff0000u); ss += a * a + b2 * b2; } }
        const float rstd = rsqrtf(ss * (1.f / 64.f) + NORM_EPS);
#pragma unroll
        for (int c = 0; c < 8; ++c) { const unsigned w[4] = {v[c].x, v[c].y, v[c].z, v[c].w}; unsigned o[4];
            const float4 g0 = *(const float4*)(kg + 8 * c), g1 = *(const float4*)(kg + 8 * c + 4); const float gv[8] = {g0.x, g0.y, g0.z, g0.w, g1.x, g1.y, g1.z, g1.w};
#pragma unroll
            for (int e = 0; e < 4; ++e) o[e] = pk2(__uint_as_float(w[e] << 16) * rstd * gv[2 * e], __uint_as_float(w[e] & 0xffff0000u) * rstd * gv[2 * e + 1]);
            ptr[c] = make_uint4(o[0], o[1], o[2], o[3]); }
    }
}
typedef unsigned u32x4_t __attribute__((ext_vector_type(4)));
__device__ __forceinline__ bf16x8_t pack_step16(const f32x16_t& x, int s2) {
    u32x4_t pk;
    if (s2 == 0) { pk[0] = pk_bf16(x[0], x[1]); pk[1] = pk_bf16(x[2], x[3]); pk[2] = pk_bf16(x[4], x[5]); pk[3] = pk_bf16(x[6], x[7]); }
    else { pk[0] = pk_bf16(x[8], x[9]); pk[1] = pk_bf16(x[10], x[11]); pk[2] = pk_bf16(x[12], x[13]); pk[3] = pk_bf16(x[14], x[15]); }
    return __builtin_bit_cast(bf16x8_t, pk);
}
__device__ __forceinline__ float xhalf_max(float x) { const auto t = __builtin_amdgcn_permlane32_swap(__float_as_uint(x), __float_as_uint(x), false, false); return fmaxf(__uint_as_float(t[0]), __uint_as_float(t[1])); }
__device__ __forceinline__ float xhalf_sum(float x) { const auto t = __builtin_amdgcn_permlane32_swap(__float_as_uint(x), __float_as_uint(x), false, false); return __uint_as_float(t[0]) + __uint_as_float(t[1]); }
__device__ __forceinline__ short bf16_of_int(int v) { return (short)(__float_as_uint((float)v) >> 16); }
#define MFMA32(a, b, c) __builtin_amdgcn_mfma_f32_32x32x16_bf16((a), (b), (c), 0, 0, 0)
__device__ void ph_dsa_attn(const P& p, float* ldsf) {
    const unsigned long long* MASK = (const unsigned long long*)(p.ws + WS_MASK);
    const bf16_t* Q = (const bf16_t*)(p.ws + WS_Q); const bf16_t* Kg = (const bf16_t*)(p.ws + WS_K); const bf16_t* VT = (const bf16_t*)(p.ws + WS_V);
    bf16_t* O = (bf16_t*)(p.ws + WS_OATT);
    bf16_t* L = (bf16_t*)ldsf;
    const int tid = otid(), lane = tid & 63, wv = tid >> 6, hh = lane >> 5, r32 = lane & 31;
    const float CS = 0.125f * 1.4426950408889634f;
    const float NEG = -1e30f;
    const int skey = tid >> 3, sch = (tid & 7) * 8;
    const float* qg = p.in[8];
    float kgmax; { const float v = fabsf(p.in[9][lane]); kgmax = wave_max(v); }
    int* qhead = (int*)(p.ws + WS_CTL) + CT_Q; int* bcast = (int*)(L + 4 * SLOT); int* sflag = bcast + 4;
    for (int tr_ = 0; tr_ < 8; ++tr_) {
        const int grp = (blockIdx.x + tr_) & 7;
        for (;;) {
            __syncthreads();
            if (tid == 0) *bcast = atomicAdd(qhead + grp, 1);
            __syncthreads();
            const int kq = *bcast;
            if (kq >= 64) break;
            const int bh = grp + 8 * (kq & 1), qb = 31 - (kq >> 1), b = bh >> 3, h = bh & 7;
            const bf16_t* Kbase = Kg + (size_t)b * SEQ * AW + h * 64; const bf16_t* Vbase = VT + (size_t)bh * 64 * SEQ;
            {
            const int q0 = qb * 256 + wv * 32, q = q0 + r32, ntile = 4 * (qb + 1);
            const size_t qrow = (size_t)b * SEQ + q;
            bf16x8_t bq[5]; float qk_bound;
#pragma unroll
            for (int s2 = 0; s2 < 4; ++s2) bq[s2] = *(const bf16x8_t*)(Q + qrow * AW + h * 64 + 16 * s2 + 8 * hh);
            {
                float ss = 0.f;
#pragma unroll
                for (int s2 = 0; s2 < 4; ++s2)
#pragma unroll
                    for (int j = 0; j < 8; ++j) { const float v = bf2f((bf16_t)bq[s2][j]); ss += v * v; }
                ss = xhalf_sum(ss);
                const float rstd = rsqrtf(ss * (1.f / 64.f) + NORM_EPS);
                float qq = 0.f;
#pragma unroll
                for (int s2 = 0; s2 < 4; ++s2) { const float4 g0 = *(const float4*)(qg + 16 * s2 + 8 * hh), g1 = *(const float4*)(qg + 16 * s2 + 8 * hh + 4); const float gv[8] = {g0.x, g0.y, g0.z, g0.w, g1.x, g1.y, g1.z, g1.w};
                    u32x4_t w;
#pragma unroll
                    for (int j2 = 0; j2 < 4; ++j2) { const float e0 = bf2f((bf16_t)bq[s2][2 * j2]) * rstd * gv[2 * j2], e1 = bf2f((bf16_t)bq[s2][2 * j2 + 1]) * rstd * gv[2 * j2 + 1]; qq += e0 * e0 + e1 * e1; w[j2] = pk_bf16(e0, e1); }
                    bq[s2] = __builtin_bit_cast(bf16x8_t, w); }
                qk_bound = sqrtf(xhalf_sum(qq)) * kgmax * 1.03f;
            }
#pragma unroll
            for (int j = 0; j < 8; ++j) bq[4][j] = 0;
            if (hh == 0) { bq[4][0] = bf16_of_int(256 >> h); bq[4][1] = (short)(__float_as_uint(4.f / (float)(1 << h)) >> 16); }
            f32x16_t o0, o1;
#pragma unroll
            for (int i = 0; i < 16; ++i) { o0[i] = 0.f; o1[i] = 0.f; }
            float m_run = NEG, l_run = 0.f;
            __syncthreads();
            const float slope_l2 = 1.4426950408889634f / (float)(2 << h);
            { const int kt0 = ntile - 1; const uint4 kr = *(const uint4*)(Kbase + (size_t)(kt0 * 64 + skey) * AW + sch), vr = *(const uint4*)(Vbase + (size_t)skey * SEQ + kt0 * 64 + sch);
              *(uint4*)(L + (kt0 & 1) * SLOT + skey * LP + sch) = kr; *(uint4*)(L + (2 + (kt0 & 1)) * SLOT + skey * LP + sch) = vr; }
            unsigned long long mw = MASK[qrow * 128 + ntile - 1];
            if (tid < 16) sflag[tid] = 0;
            __syncthreads();
#pragma unroll 1
            for (int kt = ntile - 1; kt >= 0; --kt) {
                const int buf = kt & 1; const bool more = kt > 0;
                if (kt < ntile - 1) { int alld = 1;
#pragma unroll
                    for (int w2 = 0; w2 < 8; ++w2) alld &= sflag[((kt + 1) & 1) * 8 + w2];
                    if (alld) break; }
                uint4 kr = make_uint4(0, 0, 0, 0), vr = make_uint4(0, 0, 0, 0); unsigned long long mwn = 0ull;
                if (more) { kr = *(const uint4*)(Kbase + (size_t)((kt - 1) * 64 + skey) * AW + sch); vr = *(const uint4*)(Vbase + (size_t)skey * SEQ + (kt - 1) * 64 + sch); mwn = MASK[qrow * 128 + kt - 1]; }
                if (kt * 64 <= q0 + 31) {
                    const bf16_t* Kl = L + buf * SLOT; const bf16_t* Vl = L + (2 + buf) * SLOT;
                    f32x16_t p0, p1;
#pragma unroll
                    for (int i = 0; i < 16; ++i) { p0[i] = 0.f; p1[i] = 0.f; }
#pragma unroll
                    for (int s2 = 0; s2 < 4; ++s2) {
                        const bf16x8_t a0 = *(const bf16x8_t*)(Kl + r32 * LP + 16 * s2 + 8 * hh), a1 = *(const bf16x8_t*)(Kl + (32 + r32) * LP + 16 * s2 + 8 * hh);
                        p0 = MFMA32(a0, bq[s2], p0); p1 = MFMA32(a1, bq[s2], p1);
                    }
                    { bf16x8_t g0, g1;
#pragma unroll
                      for (int j = 0; j < 8; ++j) { g0[j] = 0; g1[j] = 0; }
                      if (hh == 0) { g0[0] = bf16_of_int(kt); g0[1] = bf16_of_int(r32); g1[0] = g0[0]; g1[1] = bf16_of_int(32 + r32); }
                      p0 = MFMA32(g0, bq[4], p0); p1 = MFMA32(g1, bq[4], p1); }
                    const unsigned wl = (unsigned)mw >> (4 * hh), wh = (unsigned)(mw >> 32) >> (4 * hh);
                    float mx = NEG;
#pragma unroll
                    for (int i = 0; i < 16; ++i) { const int bp = (i & 3) + 8 * (i >> 2);
                        const int m0 = __builtin_amdgcn_sbfe((int)wl, bp, 1), m1 = __builtin_amdgcn_sbfe((int)wh, bp, 1);
                        const float a_ = __uint_as_float((__float_as_uint(p0[i]) & (unsigned)m0) | (__float_as_uint(NEG) & ~(unsigned)m0));
                        const float b_ = __uint_as_float((__float_as_uint(p1[i]) & (unsigned)m1) | (__float_as_uint(NEG) & ~(unsigned)m1));
                        p0[i] = a_; p1[i] = b_;
                        mx = __builtin_fmaxf(mx, __builtin_fmaxf(a_, b_)); }
                    mx = xhalf_max(mx);
                    const float m_new = fmaxf(m_run, mx);
                    const float alpha = __builtin_amdgcn_exp2f((m_run - m_new) * CS);
                    m_run = m_new;
                    const float mc = fmaxf(m_new, -1e20f) * CS;
                    float rs = 0.f;
#pragma unroll
                    for (int i = 0; i < 16; ++i) { p0[i] = __builtin_amdgcn_exp2f(p0[i] * CS - mc); p1[i] = __builtin_amdgcn_exp2f(p1[i] * CS - mc); rs += p0[i] + p1[i]; }
                    l_run = l_run * alpha + rs;
#pragma unroll
                    for (int i = 0; i < 16; ++i) { o0[i] *= alpha; o1[i] *= alpha; }
                    bf16x8_t pb[4];
                    pb[0] = pack_step16(p0, 0); pb[1] = pack_step16(p0, 1); pb[2] = pack_step16(p1, 0); pb[3] = pack_step16(p1, 1);
#pragma unroll
                    for (int ks = 0; ks < 4; ++ks) {
                        const int kofs = 32 * (ks >> 1) + 16 * (ks & 1) + 4 * hh;
                        typedef short s16x4_t __attribute__((ext_vector_type(4)));
                        const s16x4_t v00 = *(const s16x4_t*)(Vl + r32 * LP + kofs), v01 = *(const s16x4_t*)(Vl + r32 * LP + kofs + 8);
                        const s16x4_t v10 = *(const s16x4_t*)(Vl + (32 + r32) * LP + kofs), v11 = *(const s16x4_t*)(Vl + (32 + r32) * LP + kofs + 8);
                        bf16x8_t av0, av1;
#pragma unroll
                        for (int j = 0; j < 4; ++j) { av0[j] = v00[j]; av0[4 + j] = v01[j]; av1[j] = v10[j]; av1[4 + j] = v11[j]; }
                        o0 = MFMA32(av0, pb[ks], o0); o1 = MFMA32(av1, pb[ks], o1);
                    }
                }
                if (more) { *(uint4*)(L + (buf ^ 1) * SLOT + skey * LP + sch) = kr; *(uint4*)(L + (2 + (buf ^ 1)) * SLOT + skey * LP + sch) = vr; }
                mw = mwn;
                {
                    const bool row_done = (qk_bound * 1.4426950408889634f + slope_l2 * (float)(64 * kt - 1)) < m_run * CS - 150.f;
                    const int wdone = __all(row_done) ? 1 : 0;
                    if (lane == 0) sflag[(kt & 1) * 8 + wv] = wdone;
                }
                __syncthreads();
            }
            const float inv = 1.f / xhalf_sum(l_run);
            bf16_t* orow = O + qrow * AW + h * 64 + 4 * hh;
#pragma unroll
            for (int g = 0; g < 4; ++g) {
                uint2 w0, w1;
                w0.x = (unsigned)f2bf(o0[4 * g] * inv) | ((unsigned)f2bf(o0[4 * g + 1] * inv) << 16); w0.y = (unsigned)f2bf(o0[4 * g + 2] * inv) | ((unsigned)f2bf(o0[4 * g + 3] * inv) << 16);
                w1.x = (unsigned)f2bf(o1[4 * g] * inv) | ((unsigned)f2bf(o1[4 * g + 1] * inv) << 16); w1.y = (unsigned)f2bf(o1[4 * g + 2] * inv) | ((unsigned)f2bf(o1[4 * g + 3] * inv) << 16);
                *(uint2*)(orow + 8 * g) = w0; *(uint2*)(orow + 32 + 8 * g) = w1;
            }
            }
        }
    }
}

constexpr int AP = 328, KP = 520, OBP = 72, ODP = 68;
__device__ __forceinline__ f32x4_t mm16(const bf16_t* X, int xrs, const bf16_t* Y, int ycs, int nks, f32x4_t acc, int lane) {
    const int r = lane & 15, q = lane >> 4;
    for (int s2 = 0; s2 < nks; ++s2) {
        const bf16x8_t a = *(const bf16x8_t*)(X + r * xrs + 32 * s2 + 8 * q), b = *(const bf16x8_t*)(Y + r * ycs + 32 * s2 + 8 * q);
        acc = __builtin_amdgcn_mfma_f32_16x16x32_bf16(a, b, acc, 0, 0, 0);
    }
    return acc;
}
__device__ void ph_rwkv_prep(const P& p, float* ldsf, int blk_first, int blk_end, int blk_step) {
    const bf16_t* PS = (const bf16_t*)(p.ws + WS_PS);
    const float* mu = p.in[10]; const float* w0 = p.in[11]; const float* a0 = p.in[13]; const float* k_k = p.in[16]; const float* k_a = p.in[17];
    const bf16_t* W2T = (const bf16_t*)(p.ws + WS_LW2T); const bf16_t* A2T = (const bf16_t*)(p.ws + WS_LA2T); const bf16_t* G2T = (const bf16_t*)(p.ws + WS_LG2T);
    bf16_t* R = (bf16_t*)(p.ws + WS_R); bf16_t* K2 = (bf16_t*)(p.ws + WS_K2); bf16_t* VV = (bf16_t*)(p.ws + WS_VV); bf16_t* KK = (bf16_t*)(p.ws + WS_KK); bf16_t* BB = (bf16_t*)(p.ws + WS_BB);
    bf16_t* G = (bf16_t*)(p.ws + WS_G); float* DD = (float*)(p.ws + WS_DD);
    const int tid = otid(), lane = tid & 63, wv = tid >> 6, l15 = lane & 15, q4 = lane >> 4;
    bf16_t* Amix = (bf16_t*)ldsf; bf16_t* Kbuf = Amix + 32 * AP;
    bf16_t* KKo = Kbuf + 32 * KP + wv * (3 * 16 * OBP + 2 * 16 * ODP); bf16_t* BBo = KKo + 16 * OBP; bf16_t* Go = BBo + 16 * OBP; float* DDo = (float*)(Go + 16 * OBP);
    for (int blk = blk_first; blk < blk_end; blk += blk_step) {
        const int m0 = blk * 32;
        __syncthreads();
        if (tid < 456) {
            const int cc = tid % 228, th = tid / 228, c8 = cc * 8;
            const float4 mu0 = *(const float4*)(mu + c8), mu1 = *(const float4*)(mu + c8 + 4); const float muv[8] = {mu0.x, mu0.y, mu0.z, mu0.w, mu1.x, mu1.y, mu1.z, mu1.w};
            const bf16_t* src = PS + (size_t)(m0 + 16 * th) * SHW + c8;
            uint4 pv = make_uint4(0, 0, 0, 0); if ((m0 + 16 * th) % SEQ) pv = *(const uint4*)(src - SHW);
#pragma unroll 1
            for (int bt = 0; bt < 2; ++bt) {
                uint4 cu[8];
#pragma unroll
                for (int i = 0; i < 8; ++i) cu[i] = *(const uint4*)(src + (size_t)(8 * bt + i) * SHW);
#pragma unroll
                for (int i = 0; i < 8; ++i) {
                    const int tk = 16 * th + 8 * bt + i;
                    const unsigned cw[4] = {cu[i].x, cu[i].y, cu[i].z, cu[i].w}, pw[4] = {pv.x, pv.y, pv.z, pv.w};
                    float mx[8];
#pragma unroll
                    for (int e = 0; e < 8; ++e) { const float c_ = (e & 1) ? __uint_as_float(cw[e >> 1] & 0xffff0000u) : __uint_as_float(cw[e >> 1] << 16), p_ = (e & 1) ? __uint_as_float(pw[e >> 1] & 0xffff0000u) : __uint_as_float(pw[e >> 1] << 16);
                        mx[e] = c_ + (p_ - c_) * muv[e]; }
                    pv = cu[i];
                    if (cc >= 192) { const int col = c8 - 1536;
#pragma unroll
                        for (int e = 0; e < 8; ++e) mx[e] = (col < 64) ? (1.f - 2.f * __builtin_amdgcn_rcpf(__expf(2.f * mx[e]) + 1.f)) : ((col < 128) ? mx[e] : sigmoidf_(mx[e])); }
                    const uint4 o = make_uint4(pk2(mx[0], mx[1]), pk2(mx[2], mx[3]), pk2(mx[4], mx[5]), pk2(mx[6], mx[7]));
                    if (cc < 64) *(uint4*)(R + (size_t)(m0 + tk) * RW + c8) = o;
                    else if (cc < 128) *(uint4*)(Kbuf + tk * KP + (c8 - 512)) = o;
                    else if (cc < 192) *(uint4*)(VV + (size_t)(m0 + tk) * RW + (c8 - 1024)) = o;
                    else *(uint4*)(Amix + tk * AP + (c8 - 1536)) = o;
                }
            }
        }
        if (tid < 128) *(uint4*)(Amix + (tid >> 2) * AP + 288 + (tid & 3) * 8) = make_uint4(0, 0, 0, 0);
        __syncthreads();
        const int h = wv;
        float rn[2];
#pragma unroll
        for (int rt = 0; rt < 2; ++rt) { const int tk = 16 * rt + l15; float ss = 0.f;
#pragma unroll
            for (int ct = 0; ct < 4; ++ct) { const int c0 = 64 * h + 16 * ct + 4 * q4; const float4 kkc = *(const float4*)(k_k + c0); const uint2 kw = *(const uint2*)(Kbuf + tk * KP + c0);
                const float e0 = __uint_as_float(kw.x << 16) * kkc.x, e1 = __uint_as_float(kw.x & 0xffff0000u) * kkc.y, e2 = __uint_as_float(kw.y << 16) * kkc.z, e3 = __uint_as_float(kw.y & 0xffff0000u) * kkc.w;
                ss += (e0 * e0 + e1 * e1) + (e2 * e2 + e3 * e3); }
            ss += __shfl_xor(ss, 16); ss += __shfl_xor(ss, 32);
            rn[rt] = __builtin_amdgcn_rcpf(fmaxf(sqrtf(ss), 1e-12f)); }
#pragma unroll 1
        for (int rt = 0; rt < 2; ++rt) {
            const int tk = 16 * rt + l15; const bf16_t* xr = Amix + tk * AP + 8 * q4; const float rnv = rt ? rn[1] : rn[0];
#pragma unroll 1
            for (int ct = 0; ct < 4; ++ct) {
                const int cb = 64 * h + 16 * ct, c0 = cb + 4 * q4;
                const bf16_t* yw = W2T + (size_t)(cb + l15) * 64 + 8 * q4; const bf16_t* ya = A2T + (size_t)(cb + l15) * 64 + 8 * q4; const bf16_t* yg = G2T + (size_t)(cb + l15) * 192 + 8 * q4;
                bf16x8_t fw[2], fa[2], fg[6];
#pragma unroll
                for (int s2 = 0; s2 < 2; ++s2) { fw[s2] = *(const bf16x8_t*)(yw + 32 * s2); fa[s2] = *(const bf16x8_t*)(ya + 32 * s2); }
#pragma unroll
                for (int s2 = 0; s2 < 6; ++s2) fg[s2] = *(const bf16x8_t*)(yg + 32 * s2);
                const float4 cw0 = *(const float4*)(w0 + c0), ca0 = *(const float4*)(a0 + c0), cka = *(const float4*)(k_a + c0), ckk = *(const float4*)(k_k + c0);
                const float w0v[4] = {cw0.x, cw0.y, cw0.z, cw0.w}, a0v[4] = {ca0.x, ca0.y, ca0.z, ca0.w}, kav[4] = {cka.x, cka.y, cka.z, cka.w}, kkc[4] = {ckk.x, ckk.y, ckk.z, ckk.w};
                f32x4_t cw = {0.f, 0.f, 0.f, 0.f}, ca = cw, cg = cw;
#pragma unroll
                for (int s2 = 0; s2 < 2; ++s2) { cw = __builtin_amdgcn_mfma_f32_16x16x32_bf16(fw[s2], *(const bf16x8_t*)(xr + 32 * s2), cw, 0, 0, 0); ca = __builtin_amdgcn_mfma_f32_16x16x32_bf16(fa[s2], *(const bf16x8_t*)(xr + 64 + 32 * s2), ca, 0, 0, 0); }
#pragma unroll
                for (int s2 = 0; s2 < 6; ++s2) cg = __builtin_amdgcn_mfma_f32_16x16x32_bf16(fg[s2], *(const bf16x8_t*)(xr + 128 + 32 * s2), cg, 0, 0, 0);
                bf16_t* kp = Kbuf + tk * KP + c0;
                const uint2 kw2 = *(const uint2*)kp;
                const float kf[4] = {__uint_as_float(kw2.x << 16), __uint_as_float(kw2.x & 0xffff0000u), __uint_as_float(kw2.y << 16), __uint_as_float(kw2.y & 0xffff0000u)};
                float k2v[4], kkv[4], bbv[4], ddv[4];
#pragma unroll
                for (int e = 0; e < 4; ++e) {
                    const float xw = -(w0v[e] + cw[e]);
                    const float sp = fmaxf(xw, 0.f) + __logf(1.f + __expf(-fabsf(xw)));
                    const float w = -sp - 0.5f;
                    const float a = sigmoidf_(a0v[e] + ca[e]);
                    kkv[e] = kf[e] * kkc[e] * rnv; bbv[e] = kkv[e] * a; k2v[e] = kf[e] * (1.f + (a - 1.f) * kav[e]); ddv[e] = -__expf(w); }
                *(uint2*)kp = make_uint2(pk2(k2v[0], k2v[1]), pk2(k2v[2], k2v[3]));
                *(uint2*)(KKo + l15 * OBP + 16 * ct + 4 * q4) = make_uint2(pk2(kkv[0], kkv[1]), pk2(kkv[2], kkv[3]));
                *(uint2*)(BBo + l15 * OBP + 16 * ct + 4 * q4) = make_uint2(pk2(bbv[0], bbv[1]), pk2(bbv[2], bbv[3]));
                *(uint2*)(Go + l15 * OBP + 16 * ct + 4 * q4) = make_uint2(pk2(cg[0], cg[1]), pk2(cg[2], cg[3]));
                *(float4*)(DDo + l15 * ODP + 16 * ct + 4 * q4) = make_float4(ddv[0], ddv[1], ddv[2], ddv[3]);
            }
            __builtin_amdgcn_fence(__ATOMIC_ACQ_REL, "wavefront"); __builtin_amdgcn_wave_barrier();
            {
                const int rb = lane >> 3, cb8 = (lane & 7) * 8;
#pragma unroll
                for (int i = 0; i < 2; ++i) { const int row = rb + 8 * i; const size_t o = (size_t)(m0 + 16 * rt + row) * RW + 64 * h + cb8;
                    *(uint4*)(K2 + o) = *(const uint4*)(Kbuf + (16 * rt + row) * KP + 64 * h + cb8);
                    *(uint4*)(KK + o) = *(const uint4*)(KKo + row * OBP + cb8);
                    *(uint4*)(BB + o) = *(const uint4*)(BBo + row * OBP + cb8);
                    *(uint4*)(G + o) = *(const uint4*)(Go + row * OBP + cb8); }
                const int rd = lane >> 4, cd4 = (lane & 15) * 4;
#pragma unroll
                for (int i = 0; i < 4; ++i) { const int row = rd + 4 * i;
                    *(float4*)(DD + (size_t)(m0 + 16 * rt + row) * RW + 64 * h + cd4) = *(const float4*)(DDo + row * ODP + cd4); }
            }
            __builtin_amdgcn_fence(__ATOMIC_ACQ_REL, "wavefront"); __builtin_amdgcn_wave_barrier();
        }
    }
}

template <bool XC, bool YC>
__device__ __forceinline__ f32x4_t mm_tile(const bf16_t* X, int xrs, int xcs, const bf16_t* Y, int yrs, int ycs, int tr, int tc, f32x4_t acc, int lane) {
    const int r = lane & 15, q = lane >> 4;
#pragma unroll
    for (int s2 = 0; s2 < 2; ++s2) {
        bf16x8_t a, b;
        const bf16_t* xp = X + (16 * tr + r) * xrs + (32 * s2 + 8 * q) * xcs;
        if (XC) a = *(const bf16x8_t*)xp; else {
#pragma unroll
            for (int j = 0; j < 8; ++j) a[j] = (short)xp[j * xcs]; }
        const bf16_t* yp = Y + (32 * s2 + 8 * q) * yrs + (16 * tc + r) * ycs;
        if (YC) b = *(const bf16x8_t*)yp; else {
#pragma unroll
            for (int j = 0; j < 8; ++j) b[j] = (short)yp[j * yrs]; }
        acc = __builtin_amdgcn_mfma_f32_16x16x32_bf16(a, b, acc, 0, 0, 0);
    }
    return acc;
}
__device__ __forceinline__ void st_tile(const f32x4_t& acc, bf16_t* D, int drs, int dcs, int tr, int tc, int lane) {
    const int row0 = 16 * tr + 4 * (lane >> 4), col = 16 * tc + (lane & 15);
#pragma unroll
    for (int e = 0; e < 4; ++e) D[(row0 + e) * drs + col * dcs] = f2bf(acc[e]);
}
__device__ __forceinline__ f32x4_t ld_tile(const bf16_t* D, int drs, int dcs, int tr, int tc, int lane) {
    const int row0 = 16 * tr + 4 * (lane >> 4), col = 16 * tc + (lane & 15); f32x4_t v;
#pragma unroll
    for (int e = 0; e < 4; ++e) v[e] = bf2f(D[(row0 + e) * drs + col * dcs]);
    return v;
}
template <bool STRICT> __device__ __forceinline__ void triu_tile(f32x4_t& acc, int tr, int tc, int lane) {
    const int row0 = 16 * tr + 4 * (lane >> 4), col = 16 * tc + (lane & 15);
#pragma unroll
    for (int e = 0; e < 4; ++e) { const bool keep = STRICT ? (row0 + e < col) : (row0 + e <= col); acc[e] = keep ? acc[e] : 0.f; }
}

__device__ void ph_rwkv_r1(const P& p, float* ldsf, int ch_first, int ch_end, int ch_step) {
    const bf16_t* R = (const bf16_t*)(p.ws + WS_R); const bf16_t* K2 = (const bf16_t*)(p.ws + WS_K2); const bf16_t* VV = (const bf16_t*)(p.ws + WS_VV);
    const bf16_t* KK = (const bf16_t*)(p.ws + WS_KK); const bf16_t* BB = (const bf16_t*)(p.ws + WS_BB); const float* DD = (const float*)(p.ws + WS_DD);
    bf16_t* L = (bf16_t*)ldsf;
    bf16_t* At = L + 0 * SLOT; bf16_t* AtT = L + 1 * SLOT; bf16_t* Bt = L + 2 * SLOT; bf16_t* Kt = L + 3 * SLOT; bf16_t* Rt = L + 4 * SLOT; bf16_t* BhT = L + 5 * SLOT; bf16_t* Kh = L + 6 * SLOT;
    bf16_t* S7 = L + 7 * SLOT; bf16_t* S8 = L + 8 * SLOT; bf16_t* S9 = L + 9 * SLOT; bf16_t* Mka = L + 10 * SLOT; bf16_t* NbrT = L + 11 * SLOT; bf16_t* Nkr = L + 12 * SLOT;
    float* cs = (float*)(L + 13 * SLOT);
    float* segs = cs + 64 * 64;
    float* gLs = segs + 8 * 64;
    const int tid = otid(), lane = tid & 63, wv = tid >> 6;
    const int t0 = 2 * wv, t1 = 2 * wv + 1;
    for (int ch = ch_first; ch < ch_end; ch += ch_step) {
        const int bh = ch >> 7, c = ch & 127, b = bh >> 3, h = bh & 7;
        const size_t gbase = ((size_t)b * SEQ + (size_t)c * 64) * RW + h * 64;
        bf16_t* G1T = (bf16_t*)(p.ws + WS_KK) + gbase; bf16_t* PT = (bf16_t*)(p.ws + WS_BB) + gbase; bf16_t* G2T = (bf16_t*)(p.ws + WS_DD) + 2 * gbase; bf16_t* QT = G2T + 64;
        __syncthreads();
        const int st = tid >> 3, sj = (tid & 7) * 8;
        const uint4 vraw = *(const uint4*)(VV + gbase + (size_t)st * RW + sj);
        const uint4 rr = *(const uint4*)(R + gbase + (size_t)st * RW + sj), kr = *(const uint4*)(K2 + gbase + (size_t)st * RW + sj);
        const uint4 kkr = *(const uint4*)(KK + gbase + (size_t)st * RW + sj), br = *(const uint4*)(BB + gbase + (size_t)st * RW + sj);
        { const float4 l0 = *(const float4*)(DD + gbase + (size_t)st * RW + sj), l1 = *(const float4*)(DD + gbase + (size_t)st * RW + sj + 4);
          float* d = cs + st * 64 + sj; *(float4*)d = l0; *(float4*)(d + 4) = l1; }
        __syncthreads();
        { const int j = tid & 63, sg = tid >> 6; float run = 0.f;
#pragma unroll
          for (int i = 0; i < 8; ++i) { run += cs[(sg * 8 + i) * 64 + j]; }
          segs[sg * 64 + j] = run; }
        __syncthreads();
        { const int j = tid & 63, sg = tid >> 6; float run = 0.f;
          for (int q = 0; q < sg; ++q) run += segs[q * 64 + j];
#pragma unroll
          for (int i = 0; i < 8; ++i) { run += cs[(sg * 8 + i) * 64 + j]; cs[(sg * 8 + i) * 64 + j] = run; }
          if (sg == 7) gLs[j] = __expf(run); }
        __syncthreads();
        {
            const unsigned rw_[4] = {rr.x, rr.y, rr.z, rr.w}, kw_[4] = {kr.x, kr.y, kr.z, kr.w}, kkw_[4] = {kkr.x, kkr.y, kkr.z, kkr.w}, bw_[4] = {br.x, br.y, br.z, br.w};
            unsigned oa[4], ob[4], ok[4], orr[4], okh[4];
#pragma unroll
            for (int e2 = 0; e2 < 4; ++e2) {
                float va[2], vb[2], vk[2], vr2[2], vbh[2], vkh[2];
#pragma unroll
                for (int hf = 0; hf < 2; ++hf) {
                    const int j = sj + 2 * e2 + hf;
                    const float lgI = cs[st * 64 + j], lgE = st ? cs[(st - 1) * 64 + j] : 0.f, gl = cs[63 * 64 + j];
                    const float rv = hf ? __uint_as_float(rw_[e2] & 0xffff0000u) : __uint_as_float(rw_[e2] << 16);
                    const float kv = hf ? __uint_as_float(kw_[e2] & 0xffff0000u) : __uint_as_float(kw_[e2] << 16);
                    const float kkv = hf ? __uint_as_float(kkw_[e2] & 0xffff0000u) : __uint_as_float(kkw_[e2] << 16);
                    const float bv = hf ? __uint_as_float(bw_[e2] & 0xffff0000u) : __uint_as_float(bw_[e2] << 16);
                    const float einv = __expf(-lgI), eh = __expf(gl - lgI);
                    va[hf] = -kkv * __expf(lgE); vb[hf] = bv * einv; vk[hf] = kv * einv; vr2[hf] = rv * __expf(lgI); vbh[hf] = bv * eh; vkh[hf] = kv * eh;
                    AtT[j * LP + st] = f2bf(va[hf]); BhT[j * LP + st] = f2bf(vbh[hf]);
                }
                oa[e2] = pk2(va[0], va[1]); ob[e2] = pk2(vb[0], vb[1]); ok[e2] = pk2(vk[0], vk[1]); orr[e2] = pk2(vr2[0], vr2[1]); okh[e2] = pk2(vkh[0], vkh[1]);
            }
            *(uint4*)(At + st * LP + sj) = make_uint4(oa[0], oa[1], oa[2], oa[3]); *(uint4*)(Bt + st * LP + sj) = make_uint4(ob[0], ob[1], ob[2], ob[3]);
            *(uint4*)(Kt + st * LP + sj) = make_uint4(ok[0], ok[1], ok[2], ok[3]); *(uint4*)(Rt + st * LP + sj) = make_uint4(orr[0], orr[1], orr[2], orr[3]);
            *(uint4*)(Kh + st * LP + sj) = make_uint4(okh[0], okh[1], okh[2], okh[3]);
        }
        __syncthreads();
#define R1_FOR_TILES(idx, tr, tc) _Pragma("unroll") for (int _q = 0; _q < 2; ++_q) { const int idx = _q ? t1 : t0; const int tr = idx >> 2, tc = idx & 3;
#define R1_END }
#define MMF(X, Y, acc) mm_tile<true, true>((X), LP, 1, (Y), 1, LP, tr, tc, (acc), lane)
        const f32x4_t zero4 = {0.f, 0.f, 0.f, 0.f};
        R1_FOR_TILES(idx, tr, tc)
            f32x4_t mab = MMF(Bt, At, zero4); triu_tile<true>(mab, tr, tc, lane); st_tile(mab, S7, LP, 1, tr, tc, lane); st_tile(mab, S8, 1, LP, tr, tc, lane);
            { f32x4_t tt = mab; const int row0 = 16 * tr + 4 * (lane >> 4), col = 16 * tc + (lane & 15);
#pragma unroll
              for (int e = 0; e < 4; ++e) tt[e] += (row0 + e == col) ? 1.f : 0.f;
              st_tile(tt, S9, LP, 1, tr, tc, lane); }
            f32x4_t mka = MMF(Kt, At, zero4); triu_tile<true>(mka, tr, tc, lane); st_tile(mka, Mka, LP, 1, tr, tc, lane);
            f32x4_t nbr = MMF(Bt, Rt, zero4); triu_tile<false>(nbr, tr, tc, lane); st_tile(nbr, NbrT, 1, LP, tr, tc, lane);
            f32x4_t nkr = MMF(Kt, Rt, zero4); triu_tile<false>(nkr, tr, tc, lane); st_tile(nkr, Nkr, LP, 1, tr, tc, lane);
        R1_END
        __syncthreads();
        bf16_t* VmT = At;
        { const unsigned vw_[4] = {vraw.x, vraw.y, vraw.z, vraw.w};
#pragma unroll
          for (int e = 0; e < 8; ++e) VmT[(sj + e) * LP + st] = (bf16_t)((e & 1) ? (vw_[e >> 1] >> 16) : (vw_[e >> 1] & 0xffffu)); }
        bf16_t* Pc = S7; bf16_t* PcT = S8; bf16_t* Pn = Bt; bf16_t* PnT = Kt; bf16_t* Tc = S9; bf16_t* Tn = (bf16_t*)cs; bf16_t* TT = nullptr;
#pragma unroll 1
        for (int k = 1; k <= 6; ++k) {
            R1_FOR_TILES(idx, tr, tc)
                if (k <= 5) { f32x4_t pp = MMF(Pc, PcT, zero4); st_tile(pp, Pn, LP, 1, tr, tc, lane); st_tile(pp, PnT, 1, LP, tr, tc, lane); }
                if (k >= 2) { f32x4_t tn = ld_tile(Tc, LP, 1, tr, tc, lane); tn = MMF(Tc, PcT, tn); st_tile(tn, Tn, LP, 1, tr, tc, lane);
                    if (k == 6) st_tile(tn, Pn, 1, LP, tr, tc, lane); }
            R1_END
            __syncthreads();
            if (k == 6) TT = Pn;
            if (k <= 5) { bf16_t* x_ = Pc; Pc = Pn; Pn = x_; x_ = PcT; PcT = PnT; PnT = x_; }
            if (k >= 2) { bf16_t* x_ = Tc; Tc = Tn; Tn = x_; }
        }
        bf16_t* W1 = Pc; bf16_t* W2 = PcT; bf16_t* QkT = PnT;
        bf16_t* Og1 = Tn; bf16_t* Og2 = Tc; bf16_t* Opt = TT; bf16_t* Oqt = W1;
        R1_FOR_TILES(idx, tr, tc)
            f32x4_t w1 = MMF(AtT, TT, zero4); st_tile(w1, W1, LP, 1, tr, tc, lane);
            f32x4_t w2 = MMF(Mka, TT, zero4); st_tile(w2, W2, LP, 1, tr, tc, lane);
        R1_END
        __syncthreads();
        R1_FOR_TILES(idx, tr, tc)
            f32x4_t g1 = ld_tile(Rt, 1, LP, tr, tc, lane); g1 = MMF(W1, NbrT, g1); st_tile(g1, Og1, 1, LP, tr, tc, lane);
            f32x4_t g2 = ld_tile(Nkr, LP, 1, tr, tc, lane); g2 = MMF(W2, NbrT, g2); st_tile(g2, Og2, 1, LP, tr, tc, lane);
            f32x4_t pm = MMF(W1, BhT, zero4);
            { const int row0 = 16 * tr + 4 * (lane >> 4), col = 16 * tc + (lane & 15);
#pragma unroll
              for (int e = 0; e < 4; ++e) pm[e] += (row0 + e == col) ? gLs[col] : 0.f; }
            { const int row0 = 16 * tr + 4 * (lane >> 4), col = 16 * tc + (lane & 15);
#pragma unroll
              for (int e = 0; e < 4; ++e) { const int j = row0 + e; const int frag = (col >> 5) * 4 + 2 * (j >> 5) + ((j & 31) >> 4);
                Opt[(frag * 64 + (col & 31) + 32 * ((j >> 2) & 1)) * 8 + 4 * ((j >> 3) & 1) + (j & 3)] = f2bf(pm[e]); } }
            f32x4_t qk = ld_tile(Kh, LP, 1, tr, tc, lane); qk = MMF(W2, BhT, qk); st_tile(qk, QkT, 1, LP, tr, tc, lane);
        R1_END
        __syncthreads();
        {
            const int row = tid >> 3, ch8 = (tid & 7) * 8;
            *(uint4*)(G1T + (size_t)row * RW + ch8) = *(const uint4*)(Og1 + row * LP + ch8);
            *(uint4*)(G2T + (size_t)row * (2 * RW) + ch8) = *(const uint4*)(Og2 + row * LP + ch8);
            *(uint4*)(PT + (size_t)row * RW + ch8) = *(const uint4*)(Opt + row * 64 + ch8);
        }
        R1_FOR_TILES(idx, tr, tc)
            f32x4_t qt = MMF(QkT, VmT, zero4);
            { const int row0 = 16 * tr + 4 * (lane >> 4), col = 16 * tc + (lane & 15);
#pragma unroll
              for (int e = 0; e < 4; ++e) { const int jp = row0 + e; const int ci = ((jp >> 5) * 2 + (col >> 5)) * 64 + (col & 31) + 32 * ((jp >> 2) & 1);
                Oqt[ci * 16 + (jp & 3) + 4 * ((jp & 31) >> 3)] = f2bf(qt[e]); } }
        R1_END
        __syncthreads();
        { const int ci = tid >> 1, hf = tid & 1;
          *(uint4*)(QT + (size_t)(ci >> 2) * (2 * RW) + (ci & 3) * 16 + hf * 8) = *(const uint4*)(Oqt + ci * 16 + hf * 8); }
#undef MMF
    }
}
__device__ void ph_rwkv_prep_r1(const P& p, float* ldsf) {
    for (int b64 = blockIdx.x; b64 < NT / 64; b64 += gridDim.x) {
        ph_rwkv_prep(p, ldsf, 2 * b64, 2 * b64 + 2, 1);
        __syncthreads();
        const int b = b64 >> 7, c = b64 & 127, ch0 = (b * 8) * 128 + c;
        ph_rwkv_r1(p, ldsf, ch0, ch0 + 8 * 128, 128);
    }
}
__device__ void ph_rwkv_r2(const P& p, int bh_first, int bh_end, int bh_step) {
    bf16_t* SX = (bf16_t*)(p.ws + WS_SX);
    const int tid = otid(), lane = tid & 63, wv = tid >> 6, hh = lane >> 5, r32 = lane & 31;
    typedef short s16x4_t __attribute__((ext_vector_type(4)));
    for (int bh = bh_first; bh < bh_end; bh += bh_step) {
        if (wv >= 2) continue;
        const int cb = wv;
        f32x16_t x0, x1;
#pragma unroll
        for (int i = 0; i < 16; ++i) { x0[i] = 0.f; x1[i] = 0.f; }
        bf16x8_t pa[3][2][4]; uint4 qa[3][2][2];
#define R2_LOAD(S_, c_) do { const size_t gb_ = ((size_t)(bh >> 3) * SEQ + (size_t)(c_) * 64) * RW + (bh & 7) * 64; \
            const bf16_t* PT = (const bf16_t*)(p.ws + WS_BB) + gb_; const bf16_t* QT = (const bf16_t*)(p.ws + WS_DD) + 2 * gb_ + 64; \
            _Pragma("unroll") for (int rb = 0; rb < 2; ++rb) { \
                _Pragma("unroll") for (int ks = 0; ks < 4; ++ks) { const int o_ = ((rb * 4 + ks) * 64 + lane) * 8;        \
                    pa[S_][rb][ks] = *(const bf16x8_t*)(PT + (size_t)(o_ >> 6) * RW + (o_ & 63)); } \
                const int ci_ = (rb * 2 + cb) * 64 + lane; const uint4* qp = (const uint4*)(QT + (size_t)(ci_ >> 2) * (2 * RW) + (ci_ & 3) * 16); qa[S_][rb][0] = qp[0]; qa[S_][rb][1] = qp[1]; } } while (0)
#define R2_STEP(S_, c_) do { const int cc_ = (c_); const size_t ob_ = ((size_t)bh * 128 + cc_) * 4096; \
              \
            const bf16x8_t xb0 = pack_step16(x0, 0), xb1 = pack_step16(x0, 1), xb2 = pack_step16(x1, 0), xb3 = pack_step16(x1, 1); \
            { bf16x8_t* sp = (bf16x8_t*)(SX + ob_) + (cb * 4) * 64 + lane;        \
              sp[0] = xb0; sp[64] = xb1; sp[128] = xb2; sp[192] = xb3; } \
            f32x16_t n0, n1; \
            { const unsigned qw0[8] = {qa[S_][0][0].x, qa[S_][0][0].y, qa[S_][0][0].z, qa[S_][0][0].w, qa[S_][0][1].x, qa[S_][0][1].y, qa[S_][0][1].z, qa[S_][0][1].w}; \
              const unsigned qw1[8] = {qa[S_][1][0].x, qa[S_][1][0].y, qa[S_][1][0].z, qa[S_][1][0].w, qa[S_][1][1].x, qa[S_][1][1].y, qa[S_][1][1].z, qa[S_][1][1].w}; \
              _Pragma("unroll") for (int i = 0; i < 8; ++i) { n0[2 * i] = __uint_as_float(qw0[i] << 16); n0[2 * i + 1] = __uint_as_float(qw0[i] & 0xffff0000u); n1[2 * i] = __uint_as_float(qw1[i] << 16); n1[2 * i + 1] = __uint_as_float(qw1[i] & 0xffff0000u); } } \
            n0 = MFMA32(pa[S_][0][0], xb0, n0); n0 = MFMA32(pa[S_][0][1], xb1, n0); n0 = MFMA32(pa[S_][0][2], xb2, n0); n0 = MFMA32(pa[S_][0][3], xb3, n0); \
            n1 = MFMA32(pa[S_][1][0], xb0, n1); n1 = MFMA32(pa[S_][1][1], xb1, n1); n1 = MFMA32(pa[S_][1][2], xb2, n1); n1 = MFMA32(pa[S_][1][3], xb3, n1); \
            x0 = n0; x1 = n1; \
            if (cc_ + 3 < SEQ / 64) R2_LOAD(S_, cc_ + 3); } while (0)
        R2_LOAD(0, 0); R2_LOAD(1, 1); R2_LOAD(2, 2);
#pragma unroll 1
        for (int c = 0; c + 2 < SEQ / 64; c += 3) { R2_STEP(0, c); R2_STEP(1, c + 1); R2_STEP(2, c + 2); }
        R2_STEP(0, SEQ / 64 - 2); R2_STEP(1, SEQ / 64 - 1);
#undef R2_STEP
#undef R2_LOAD
    }
}
__device__ void ph_rwkv_r3(const P& p, float* ldsf) {
    const bf16_t* VV = (const bf16_t*)(p.ws + WS_VV); const bf16_t* SX = (const bf16_t*)(p.ws + WS_SX);
    const bf16_t* Rg = (const bf16_t*)(p.ws + WS_R); const bf16_t* K2 = (const bf16_t*)(p.ws + WS_K2); const bf16_t* Gg = (const bf16_t*)(p.ws + WS_G); bf16_t* ORW = (bf16_t*)(p.ws + WS_ORW);
    const float* r_k = p.in[18]; const float* ln_w = p.in[19]; const float* ln_b = p.in[20];
    bf16_t* Vm = (bf16_t*)ldsf; float* Yl = (float*)(Vm + SLOT);
    const int tid = otid(), lane = tid & 63, wv = tid >> 6; const int t0 = 2 * wv, t1 = 2 * wv + 1;
    const int st = tid >> 3, sj = (tid & 7) * 8;
    for (int ch = blockIdx.x; ch < NB * 8 * (SEQ / 64); ch += gridDim.x) {
        const int bh = ch >> 7, c = ch & 127, b = bh >> 3, h = bh & 7;
        const size_t gbase = ((size_t)b * SEQ + (size_t)c * 64) * RW + h * 64, ob_ = (size_t)ch * 4096;
        const bf16_t* G1T = (const bf16_t*)(p.ws + WS_KK) + gbase; const bf16_t* G2T = (const bf16_t*)(p.ws + WS_DD) + 2 * gbase;
        __syncthreads();
        const uint4 vraw = *(const uint4*)(VV + gbase + (size_t)st * RW + sj);
        *(uint4*)(Vm + st * LP + sj) = vraw;
        __syncthreads();
        R1_FOR_TILES(idx, tr, tc)
            const f32x4_t zero4 = {0.f, 0.f, 0.f, 0.f};
            f32x4_t y = zero4;
            {
                const int i_ = 16 * tr + (lane & 15), q_ = lane >> 4; typedef short s16x4_t __attribute__((ext_vector_type(4)));
#pragma unroll
                for (int s2 = 0; s2 < 2; ++s2) { const int j0 = 32 * s2 + 8 * q_;
                    const int frag = (i_ >> 5) * 4 + 2 * (j0 >> 5) + ((j0 & 31) >> 4); const bf16_t* fp = SX + ob_ + ((size_t)frag * 64 + (i_ & 31)) * 8 + 4 * ((j0 >> 3) & 1);
                    const s16x4_t lo = *(const s16x4_t*)fp, hi = *(const s16x4_t*)(fp + 32 * 8);
                    bf16x8_t a; a[0] = lo[0]; a[1] = lo[1]; a[2] = lo[2]; a[3] = lo[3]; a[4] = hi[0]; a[5] = hi[1]; a[6] = hi[2]; a[7] = hi[3];
                    const bf16x8_t b = *(const bf16x8_t*)(G1T + (size_t)(16 * tc + (lane & 15)) * RW + 32 * s2 + 8 * q_);
                    y = __builtin_amdgcn_mfma_f32_16x16x32_bf16(a, b, y, 0, 0, 0); }
            }
            y = mm_tile<false, true>(Vm, 1, LP, G2T, 1, 2 * RW, tr, tc, y, lane);
            const int i0 = 16 * tr + 4 * (lane >> 4), t = 16 * tc + (lane & 15);
#pragma unroll
            for (int e = 0; e < 4; ++e) Yl[t * 65 + i0 + e] = y[e];
        R1_END
        __syncthreads();
        {
            float y[8], s1 = 0.f;
#pragma unroll
            for (int e = 0; e < 8; ++e) { y[e] = Yl[st * 65 + sj + e]; s1 += y[e]; }
            s1 += __shfl_xor(s1, 1); s1 += __shfl_xor(s1, 2); s1 += __shfl_xor(s1, 4);
            const float mean = s1 * (1.f / 64.f); float s2 = 0.f;
#pragma unroll
            for (int e = 0; e < 8; ++e) { y[e] -= mean; s2 += y[e] * y[e]; }
            s2 += __shfl_xor(s2, 1); s2 += __shfl_xor(s2, 2); s2 += __shfl_xor(s2, 4);
            const float rstd = rsqrtf(s2 * (1.f / 64.f) + GN_EPS);
            const size_t o = gbase + (size_t)st * RW + sj;
            const uint4 rr = *(const uint4*)(Rg + o), kr = *(const uint4*)(K2 + o), gr = *(const uint4*)(Gg + o);
            const unsigned rw_[4] = {rr.x, rr.y, rr.z, rr.w}, kw_[4] = {kr.x, kr.y, kr.z, kr.w}, gw_[4] = {gr.x, gr.y, gr.z, gr.w}, vw_[4] = {vraw.x, vraw.y, vraw.z, vraw.w};
            float rk = 0.f;
#pragma unroll
            for (int e = 0; e < 8; ++e) { const float r_ = (e & 1) ? __uint_as_float(rw_[e >> 1] & 0xffff0000u) : __uint_as_float(rw_[e >> 1] << 16), k_ = (e & 1) ? __uint_as_float(kw_[e >> 1] & 0xffff0000u) : __uint_as_float(kw_[e >> 1] << 16);
                rk += r_ * k_ * r_k[h * 64 + sj + e]; }
            rk += __shfl_xor(rk, 1); rk += __shfl_xor(rk, 2); rk += __shfl_xor(rk, 4);
            float ov[8];
#pragma unroll
            for (int e = 0; e < 8; ++e) { const float v_ = (e & 1) ? __uint_as_float(vw_[e >> 1] & 0xffff0000u) : __uint_as_float(vw_[e >> 1] << 16), g_ = (e & 1) ? __uint_as_float(gw_[e >> 1] & 0xffff0000u) : __uint_as_float(gw_[e >> 1] << 16);
                ov[e] = (y[e] * rstd * ln_w[h * 64 + sj + e] + ln_b[h * 64 + sj + e] + rk * v_) * g_; }
            *(uint4*)(ORW + o) = make_uint4(pk2(ov[0], ov[1]), pk2(ov[2], ov[3]), pk2(ov[4], ov[5]), pk2(ov[6], ov[7]));
        }
    }
}
#undef R1_FOR_TILES
#undef R1_END

__device__ void ph_moe_lists(const P& p, float* ldsf) {
    int* ctl = (int*)(p.ws + WS_CTL); const int* cntB = ctl + CT_CNTB;
    int* ltok = (int*)(p.ws + WS_LTOK); float* lw = (float*)(p.ws + WS_LW);
    int* part = (int*)ldsf;
    int* tot = part + 1024; int* pre = tot + 64; int* offL = pre + 64; int* tp = offL + 64;
    const int tid = otid(), lane = tid & 63, wv = tid >> 6, G = gridDim.x;
    { int t_ = 0, p_ = 0;
      for (int b2 = wv; b2 < G; b2 += 8) { const int v = cntB[b2 * 64 + lane]; t_ += v; p_ += (b2 < (int)blockIdx.x) ? v : 0; }
      part[wv * 64 + lane] = t_; part[512 + wv * 64 + lane] = p_; }
    __syncthreads();
    if (tid < 64) { int t_ = 0, p_ = 0;
#pragma unroll
        for (int w2 = 0; w2 < 8; ++w2) { t_ += part[w2 * 64 + tid]; p_ += part[512 + w2 * 64 + tid]; }
        tot[tid] = t_; pre[tid] = p_;
        const int nt_ = (t_ + 255) >> 8; int incl = nt_;
#pragma unroll
        for (int o = 1; o < 64; o <<= 1) { const int oth = __shfl_up(incl, o); if (lane >= o) incl += oth; }
        tp[tid] = incl - nt_; offL[tid] = (incl - nt_) * 256; if (tid == 63) tp[64] = incl; }
    __syncthreads();
    const int TPB = NT / G;
    for (int i = tid; i < TPB; i += NTHR) { const int m = blockIdx.x * TPB + i; const int4 r = ((const int4*)(p.ws + WS_ROUTE))[m];
        const int l0 = r.x & 255, l1 = 32 + ((r.x >> 8) & 255), rk0 = r.y & 0xffff, rk1 = (r.y >> 16) & 0xffff;
        const int p0 = offL[l0] + pre[l0] + rk0, p1 = offL[l1] + pre[l1] + rk1;
        ltok[p0] = m; lw[p0] = __int_as_float(r.z); ltok[p1] = m; lw[p1] = __int_as_float(r.w); }
    for (int li = blockIdx.x; li < 64; li += G) {
        const int cnt = tot[li], off = offL[li], e = li & 31, nt_ = (cnt + 255) >> 8;
        int4* t1 = (int4*)(ctl + CT_TAB1) + tp[li] * 4;
        int4* t2 = (li < 32) ? (int4*)(ctl + CT_TAB2A) + tp[li] * 4 : (int4*)(ctl + CT_TAB2B) + (tp[li] - tp[32]) * 4;
        for (int i = tid; i < nt_ * 4; i += NTHR) { const int mt = i >> 2, nt = i & 3; const int4 ent = make_int4(off + mt * 256, e * 1024 + nt * 256, cnt - mt * 256, nt); t1[i] = ent; t2[i] = ent; }
        for (int r = cnt + tid; r < nt_ * 256; r += NTHR) ltok[off + r] = 0;
    }
    if (blockIdx.x == 0 && tid == 0) { ctl[CT_NU] = tp[64] * 4; ctl[CT_NU + 1] = tp[32] * 4; ctl[CT_NU + 2] = (tp[64] - tp[32]) * 4; }
}

template <int PH>
__device__ __forceinline__ void run_phase(const P& p, unsigned char* lds_raw) {
    float* lds = (float*)lds_raw; PG8_LAS unsigned char* ldsg = (PG8_LAS unsigned char*)lds_raw;
    const int G = gridDim.x, c = blockIdx.x;
    if constexpr (PH == 0) { ph_mod(p, lds); __syncthreads(); ph_convert_mixer_weights(p, lds); __syncthreads(); ph_convert_lora_weights(p, lds); }
    if constexpr (PH == 1) ph_norm(p, p.in[0], p.in[4], 0, (bf16_t*)(p.ws + WS_XN));
    if constexpr (PH == 2) { pg8::Gemm g{(const bf16_t*)(p.ws + WS_XN), (const bf16_t*)(p.ws + WS_WIN), DM, nullptr}; pg8::StaticOrder S; S.init(NT, 5120, G, c);
        pg8::EpiInproj E{p.ws, (bf16_t*)p.out}; pg8::gemm_phase(ldsg, g, S, E); }
    if constexpr (PH == 3) {
        { pg8::Gemm g{(const bf16_t*)(p.ws + WS_KVN), (const bf16_t*)(p.ws + WS_WKV), KVL, nullptr}; pg8::StaticOrder S; S.init(NT, 2 * AW, G, c);
          pg8::EpiKV E{p.ws}; pg8::gemm_phase(ldsg, g, S, E);
          pg8::Unit u;
          for (int i = 0; S.next(i, u); ++i) if (u.pn < 2) { __syncthreads(); knorm_tile(p, u.pm, u.pn); } }
        ph_rwkv_prep_r1(p, lds);
        ph_dsa_select(p, lds);
    }
    if constexpr (PH == 4) { ph_rwkv_r2(p, c, NB * 8, G); ph_dsa_attn(p, lds); }
    if constexpr (PH == 5) ph_rwkv_r3(p, lds);
    if constexpr (PH == 6) { pg8::Gemm g{(const bf16_t*)(p.ws + WS_OATT), (const bf16_t*)(p.ws + WS_WBA), AW, nullptr}; pg8::BranchOrder S; S.S0.init(NT, DM, G, c);
        pg8::EpiMerge E{(bf16_t*)(p.ws + WS_MERGED), (const bf16_t*)p.out}; pg8::gemm_phase(ldsg, g, S, E);
        ph_convert_expert_weights(p, lds); }
    if constexpr (PH == 7) { pg8::Gemm g{(const bf16_t*)(p.ws + WS_MERGED), (const bf16_t*)(p.ws + WS_WOUT), DM, nullptr}; pg8::StaticOrder S; S.init(NT, DM, G, c);
        pg8::EpiOut E{p.in[0], (const float*)(p.ws + WS_MOD), p.out}; pg8::gemm_phase(ldsg, g, S, E); }
    if constexpr (PH == 8) ph_norm_route(p, lds);
    if constexpr (PH == 9) ph_moe_lists(p, lds);
    if constexpr (PH == 10) { const int* ctl = (const int*)(p.ws + WS_CTL);
        pg8::Gemm g{(const bf16_t*)(p.ws + WS_XN2), (const bf16_t*)(p.ws + WS_WGU), DM, (const int*)(p.ws + WS_LTOK)}; pg8::TableOrder S{(const int4*)(ctl + CT_TAB1), ctl[CT_NU], G, c};
        pg8::EpiMoe1 E{(bf16_t*)(p.ws + WS_HID), (const float*)(p.ws + WS_LW)}; pg8::gemm_phase(ldsg, g, S, E); }
    if constexpr (PH == 11 || PH == 12) { const int* ctl = (const int*)(p.ws + WS_CTL);
        pg8::Gemm g{(const bf16_t*)(p.ws + WS_HID), (const bf16_t*)(p.ws + WS_WDN), DE, nullptr};
        pg8::TableOrder S{(const int4*)(ctl + (PH == 11 ? CT_TAB2A : CT_TAB2B)), ctl[CT_NU + (PH == 11 ? 1 : 2)], G, c};
        pg8::EpiMoe2 E{(const int*)(p.ws + WS_LTOK), (const float*)(p.ws + WS_MOD), p.out}; pg8::gemm_phase(ldsg, g, S, E); }
}
constexpr int LDS_BYTES = 147456;
constexpr int ORDER[] = {0, 1, 2, 3, 4, 5, 6, 7, 8, 9, 10, 11, 12};
constexpr int NPHASE = sizeof(ORDER) / sizeof(int);
constexpr int CT_BAR = 65536;
constexpr int LDS_ST = LDS_BYTES - 64;
template <int I> __device__ __forceinline__ void run_all(const P& p, unsigned char* lds, const XcdBarrier& bar) {
    run_phase<ORDER[I]>(p, lds);
    if constexpr (I + 1 < NPHASE) { xcd_barrier(bar); run_all<I + 1>(p, lds, bar); }
}
__global__ void __launch_bounds__(NTHR, 2) k_mega(P p) {
    extern __shared__ __attribute__((aligned(16))) unsigned char lds[];
    volatile LAS3 unsigned* st = (volatile LAS3 unsigned*)((LAS3 unsigned char*)lds + LDS_ST);
    if (otid() < 16) st[otid()] = 0u;
    __syncthreads();
    const XcdBarrier bar = xcd_barrier_post((unsigned*)(p.ws + WS_CTL) + CT_BAR, st);
    run_all<0>(p, lds, bar);
}
}

extern "C" void kernel_launch(void* const* d_in, const int* in_sizes, int n_in, void* d_out, int out_size, void* d_ws, size_t ws_size, hipStream_t stream) {
    if (n_in != 31 || out_size != NT * DM || ws_size < WS_END) { fprintf(stderr, "kernel_launch: unexpected shapes (n_in %d out %d ws %zu need %zu)\n", n_in, out_size, ws_size, (size_t)WS_END); return; }
    P p{};
    for (int i = 0; i < 31; ++i) p.in[i] = (const float*)d_in[i];
    p.out = (float*)d_out; p.ws = (unsigned char*)d_ws;
    (void)hipMemsetAsync((char*)d_ws + WS_CTL, 0, 1 * MiB, stream);
    static int grid_blocks = 0;
    if (!grid_blocks) {
        int dev = 0, cus = 0, per_cu = 0;
        (void)hipGetDevice(&dev);
        (void)hipDeviceGetAttribute(&cus, hipDeviceAttributeMultiprocessorCount, dev);
        (void)hipFuncSetAttribute((const void*)k_mega, hipFuncAttributeMaxDynamicSharedMemorySize, LDS_BYTES);
        (void)hipOccupancyMaxActiveBlocksPerMultiprocessor(&per_cu, (const void*)k_mega, NTHR, LDS_BYTES);
        if (per_cu < 1) per_cu = 1;
        if (per_cu > 1) per_cu = 1;
        grid_blocks = cus * per_cu;
        fprintf(stderr, "kernel_launch: cus %d per_cu %d grid %d\n", cus, per_cu, grid_blocks);
    }
    hipLaunchKernelGGL(k_mega, dim3(grid_blocks), dim3(NTHR), LDS_BYTES, stream, p);
}
```

```cpp
#include <hip/hip_runtime.h>
#include <cstdio>
#include <cstdint>

namespace {
constexpr int NB = 2, SEQ = 8192, DM = 1024, NT = NB * SEQ;
constexpr int AW = 512, KVL = 256, NIH = 8, IDD = 32, SHW = 1824, INW = 4936;
constexpr int C_KV = 512, C_QI = 768, C_PS = 1064, C_GA = 2888, C_GR = 3912;
constexpr int IDXW = 296;
constexpr int RW = 512, NE = 32, DE = 512;
constexpr int TOPK = 256;
constexpr float NORM_EPS = 1e-6f, GN_EPS = 64e-5f;
constexpr int NTHR = 512;

typedef unsigned short bf16_t;
__device__ __forceinline__ float bf2f(bf16_t v) { return __uint_as_float(((unsigned)v) << 16); }
__device__ __forceinline__ bf16_t f2bf(float f) { unsigned u = __float_as_uint(f); return (bf16_t)((u + 0x7fffu + ((u >> 16) & 1u)) >> 16); }

constexpr size_t MiB = 1u << 20;
constexpr size_t WS_CTL = 0;
constexpr size_t WS_MOD = 1 * MiB;
constexpr size_t WS_RSS = 82 * MiB + 512 * 1024;
constexpr size_t WS_LW2T = 512 * 1024, WS_LA2T = 576 * 1024, WS_LG2T = 640 * 1024;
constexpr size_t WS_WIN = 2 * MiB;
constexpr size_t WS_WKV = 12 * MiB;
constexpr size_t WS_WBA = 13 * MiB;
constexpr size_t WS_WBR = 14 * MiB;
constexpr size_t WS_WOUT = 15 * MiB;
constexpr size_t WS_XN = 17 * MiB;
constexpr size_t WS_K = 17 * MiB;
constexpr size_t WS_V = 33 * MiB;
constexpr size_t WS_Q = 49 * MiB;
constexpr size_t WS_KVN = 65 * MiB;
constexpr size_t WS_QI = 73 * MiB;
constexpr size_t WS_KI = 81 * MiB;
constexpr size_t WS_WI = 82 * MiB;
constexpr size_t WS_PS = 83 * MiB;
constexpr size_t WS_SX = 83 * MiB;
constexpr size_t WS_OATT = 99 * MiB;
constexpr size_t WS_ORW = 115 * MiB;
constexpr size_t WS_MASK = 140 * MiB;
constexpr size_t WS_R = 156 * MiB, WS_K2 = 172 * MiB, WS_VV = 188 * MiB;
constexpr size_t WS_KK = 204 * MiB;
constexpr size_t WS_BB = 220 * MiB;
constexpr size_t WS_DD = 236 * MiB;
constexpr size_t WS_G = 268 * MiB;
constexpr size_t WS_MERGED = 131 * MiB;
constexpr size_t WS_XN2 = 163 * MiB;
constexpr size_t WS_WGU = 195 * MiB;
constexpr size_t WS_WDN = 259 * MiB;
constexpr size_t WS_HID = 17 * MiB;
constexpr size_t WS_ROUTE = 65 * MiB;
constexpr size_t WS_LTOK = 66 * MiB;
constexpr size_t WS_LW = 67 * MiB;
constexpr size_t WS_OFAR = 65 * MiB;
constexpr size_t WS_AML = 67 * MiB;
constexpr size_t WS_END = 291 * MiB;
constexpr int HID_ROWS = 49152;
constexpr int CT_CNT = 0, CT_OFF = 64, CT_CUR = 128, CT_NU = 192, CT_Q = 256;
constexpr int CT_CNTB = 16384;
constexpr int CT_TAB1 = 1024, CT_TAB2A = 1024 + 4 * 1024, CT_TAB2B = 1024 + 8 * 1024;

struct P {
    const float* in[31];
    float* out;
    unsigned char* ws;
};

__device__ __forceinline__ int otid() { int t = threadIdx.x; asm volatile("" : "+v"(t)); return t; }
__device__ __forceinline__ float dpp_row_shr(float v, int n) {
    int iv = __builtin_bit_cast(int, v), r;
    switch (n) { case 1: r = __builtin_amdgcn_update_dpp(0, iv, 0x111, 0xf, 0xf, true); break; case 2: r = __builtin_amdgcn_update_dpp(0, iv, 0x112, 0xf, 0xf, true); break;
                 case 4: r = __builtin_amdgcn_update_dpp(0, iv, 0x114, 0xf, 0xf, true); break; default: r = __builtin_amdgcn_update_dpp(0, iv, 0x118, 0xf, 0xf, true); break; }
    return __builtin_bit_cast(float, r);
}
__device__ __forceinline__ float wave_sum(float v) {
    v += dpp_row_shr(v, 1); v += dpp_row_shr(v, 2); v += dpp_row_shr(v, 4); v += dpp_row_shr(v, 8);
    v += __builtin_bit_cast(float, __builtin_amdgcn_update_dpp(0, __builtin_bit_cast(int, v), 0x142, 0xa, 0xf, false));
    v += __builtin_bit_cast(float, __builtin_amdgcn_update_dpp(0, __builtin_bit_cast(int, v), 0x143, 0xc, 0xf, false));
    return __builtin_bit_cast(float, __builtin_amdgcn_readlane(__builtin_bit_cast(int, v), 63));
}
__device__ __forceinline__ float wave_max(float v) {
#pragma unroll
    for (int o = 32; o > 0; o >>= 1) v = fmaxf(v, __shfl_xor(v, o));
    return v;
}
typedef short bf16x8_t __attribute__((ext_vector_type(8)));
typedef float f32x4_t __attribute__((ext_vector_type(4)));
constexpr int LP = 72;
constexpr int SLOT = 64 * LP;
typedef __bf16 bf2_t __attribute__((ext_vector_type(2)));
typedef float f2_t __attribute__((ext_vector_type(2)));
__device__ __forceinline__ unsigned pk_bf16(float lo, float hi) { const f2_t v = {lo, hi}; return __builtin_bit_cast(unsigned, __builtin_convertvector(v, bf2_t)); }
__device__ __forceinline__ float sigmoidf_(float x) { return __builtin_amdgcn_rcpf(1.f + __expf(-x)); }

#define XB_TMO      128
#define XB_XCNT(j)  (256  + 64 * (j))
#define XB_XSUB(j)  (1280 + 64 * (j))
#define XB_XGEN(j)  (2304 + 64 * (j))
#define XB_TOP      3328
#define XB_TOPGEN   3392
#define XCD_BAR_WORDS 3456
#define XB_SPIN_CAP (1u << 22)
#define LAS3 __attribute__((address_space(3)))
__device__ __forceinline__ unsigned xb_ld(unsigned* p)              { return __hip_atomic_load(p, __ATOMIC_RELAXED, __HIP_MEMORY_SCOPE_AGENT); }
__device__ __forceinline__ unsigned xb_add(unsigned* p, unsigned v) { return __hip_atomic_fetch_add(p, v, __ATOMIC_RELAXED, __HIP_MEMORY_SCOPE_AGENT); }
__device__ __forceinline__ unsigned xb_xcc_id() { return (unsigned)__builtin_amdgcn_s_getreg((3 << 11) | 20) & 0xFu; }
#define XB_SPIN(cond, bar) do { unsigned _sp = 0; while (cond) { __builtin_amdgcn_s_sleep(1); \
    if ((++_sp & 255u) == 0u) { if (xb_ld(&(bar)[XB_TMO])) break; if (_sp > XB_SPIN_CAP) { atomicAdd(&(bar)[XB_TMO], 1u); break; } } } } while (0)
struct XcdBarrier { unsigned* bar; unsigned x; volatile LAS3 unsigned* st; };
__device__ __forceinline__ XcdBarrier xcd_barrier_post(unsigned* bar, volatile LAS3 unsigned* st) {
    XcdBarrier b; b.bar = bar; b.x = xb_xcc_id(); b.st = st;
    if (otid() == 0) (void)xb_add(&bar[XB_XCNT(b.x)], 1u);
    return b;
}
__device__ __forceinline__ void xcd_barrier_complete(unsigned* bar, unsigned x, unsigned& nloc, unsigned& nx) {
    const unsigned G = gridDim.x * gridDim.y * gridDim.z;
    unsigned sum, cnt, mine, sp = 0u;
    for (;;) {
        sum = 0u; cnt = 0u; mine = 0u;
#pragma unroll
        for (unsigned j = 0; j < 16; ++j) { const unsigned c = xb_ld(&bar[XB_XCNT(j)]); sum += c; cnt += (c > 0u) ? 1u : 0u; mine = (j == x) ? c : mine; }
        if (sum == G) break;
        __builtin_amdgcn_s_sleep(1);
        if ((++sp & 255u) == 0u) { if (xb_ld(&bar[XB_TMO])) break; if (sp > XB_SPIN_CAP) { atomicAdd(&bar[XB_TMO], 1u); break; } }
    }
    nloc = mine > 0u ? mine : 1u; nx = cnt > 0u ? cnt : 1u;
}
__device__ __forceinline__ void xcd_barrier(const XcdBarrier& b) {
    asm volatile("s_waitcnt vmcnt(0)" ::: "memory");
    __syncthreads();
    if (otid() == 0) {
        unsigned* bar = b.bar;
        __builtin_amdgcn_s_waitcnt(0);
        unsigned nloc = b.st[0], nx = b.st[1];
        if (nloc == 0u) { xcd_barrier_complete(bar, b.x, nloc, nx); b.st[0] = nloc; b.st[1] = nx; }
        const unsigned old = xb_add(&bar[XB_XSUB(b.x)], 1u);
        const unsigned gen = old / nloc;
        if (old + 1u == (gen + 1u) * nloc) {
            __builtin_amdgcn_fence(__ATOMIC_RELEASE, "agent");
            asm volatile("s_waitcnt vmcnt(0)" ::: "memory");
            const unsigned og = xb_add(&bar[XB_TOP], 1u);
            const unsigned tg = og / nx;
            if (og + 1u == (tg + 1u) * nx) xb_add(&bar[XB_TOPGEN], 1u);
            else XB_SPIN(xb_ld(&bar[XB_TOPGEN]) == tg, bar);
            __builtin_amdgcn_fence(__ATOMIC_ACQUIRE, "agent");
            xb_add(&bar[XB_XGEN(b.x)], 1u);
            asm volatile("s_waitcnt vmcnt(0)" ::: "memory");
        } else {
            XB_SPIN(xb_ld(&bar[XB_XGEN(b.x)]) == gen, bar);
            __builtin_amdgcn_fence(__ATOMIC_ACQUIRE, "agent");
            asm volatile("s_waitcnt vmcnt(0)" ::: "memory");
        }
    }
    __syncthreads();
}

__device__ void ph_mod(const P& p, float* lds) {
    const float* c = p.in[1]; const float* W = p.in[2]; const float* bia = p.in[3];
    float* mod = (float*)(p.ws + WS_MOD);
    const int tid = otid(), lane = tid & 63, wv = tid >> 6;
    float* sil = lds; float* part = lds + NB * DM;
    for (int i = tid; i < NB * DM; i += NTHR) { const float v = c[i]; sil[i] = v / (1.f + __expf(-v)); }
    __syncthreads();
    const int cc = lane % 24, kk = lane / 24;
    for (int j0 = blockIdx.x * 24; j0 < 6 * DM; j0 += gridDim.x * 24) {
        float a0 = 0.f, a1 = 0.f;
        if (lane < 48) {
#pragma unroll 32
            for (int i = 0; i < 64; ++i) { const int k = 128 * wv + 2 * i + kk; const float w = W[(size_t)k * (6 * DM) + j0 + cc]; a0 += sil[k] * w; a1 += sil[DM + k] * w; }
        }
        a0 += __shfl(a0, (lane + 24) & 63); a1 += __shfl(a1, (lane + 24) & 63);
        if (lane < 24) { part[(wv * 2 + 0) * 24 + cc] = a0; part[(wv * 2 + 1) * 24 + cc] = a1; }
        __syncthreads();
        if (tid < 48) { const int bb = tid / 24, c2 = tid % 24; float sum = 0.f;
#pragma unroll
            for (int w2 = 0; w2 < 8; ++w2) sum += part[(w2 * 2 + bb) * 24 + c2];
            mod[bb * 6 * DM + j0 + c2] = sum + bia[j0 + c2]; }
        __syncthreads();
    }
}

__device__ void ph_norm(const P& p, const float* src, const float* g, int which, bf16_t* dst) {
    const float* mod = (const float*)(p.ws + WS_MOD);
    const int lane = otid() & 63, wv = otid() >> 6;
    const int gw = blockIdx.x * (NTHR / 64) + wv, nw = gridDim.x * (NTHR / 64);
    for (int m = gw; m < NT; m += nw) {
        const int b = m / SEQ;
        const float* sh = mod + b * 6 * DM + (which ? 3 * DM : 0);
        const float* sc = sh + DM;
        const float4* xr = (const float4*)(src + (size_t)m * DM);
        float4 v[4]; float ss = 0.f;
#pragma unroll
        for (int j = 0; j < 4; ++j) { v[j] = xr[lane + 64 * j]; ss += v[j].x * v[j].x + v[j].y * v[j].y + v[j].z * v[j].z + v[j].w * v[j].w; }
        ss = wave_sum(ss);
        const float rstd = rsqrtf(ss * (1.f / DM) + NORM_EPS);
        float o[16];
#pragma unroll
        for (int j = 0; j < 4; ++j) {
            int c0 = 4 * (lane + 64 * j); asm volatile("" : "+v"(c0));
            const float4 gg = *(const float4*)(g + c0), s1 = *(const float4*)(sc + c0), s0 = *(const float4*)(sh + c0);
            o[4 * j + 0] = v[j].x * rstd * gg.x * (1.f + s1.x) + s0.x; o[4 * j + 1] = v[j].y * rstd * gg.y * (1.f + s1.y) + s0.y;
            o[4 * j + 2] = v[j].z * rstd * gg.z * (1.f + s1.z) + s0.z; o[4 * j + 3] = v[j].w * rstd * gg.w * (1.f + s1.w) + s0.w;
            uint2 pk; pk.x = (unsigned)f2bf(o[4 * j]) | ((unsigned)f2bf(o[4 * j + 1]) << 16); pk.y = (unsigned)f2bf(o[4 * j + 2]) | ((unsigned)f2bf(o[4 * j + 3]) << 16);
            *(uint2*)(dst + (size_t)m * DM + c0) = pk;
        }
    }
}

__device__ void ph_norm_route(const P& p, float* lds) {
    const float* mod = (const float*)(p.ws + WS_MOD); const float* src = p.out; const float* g = p.in[24]; bf16_t* dst = (bf16_t*)(p.ws + WS_XN2);
    const float* wgr = p.in[25]; const float* wer = p.in[26]; const float* eb = p.in[27];
    const int tid = otid(), lane = tid & 63, wv = tid >> 6;
    float* sx = lds + wv * 4096;
    int* cntL = (int*)(lds + 8 * 4096);
    if (tid < 64) cntL[tid] = 0;
    __syncthreads();
    const int TPB = NT / gridDim.x;
    for (int m0 = blockIdx.x * TPB + wv * 4; m0 < (blockIdx.x + 1) * TPB; m0 += 8 * 4) {
        const int b = m0 / SEQ;
        const float* sh = mod + b * 6 * DM + 3 * DM; const float* sc = sh + DM;
#pragma unroll 1
        for (int tk = 0; tk < 4; ++tk) {
            const int m = m0 + tk;
            const float4* xr = (const float4*)(src + (size_t)m * DM);
            float4 v[4]; float ss = 0.f;
#pragma unroll
            for (int j = 0; j < 4; ++j) { v[j] = xr[lane + 64 * j]; ss += v[j].x * v[j].x + v[j].y * v[j].y + v[j].z * v[j].z + v[j].w * v[j].w; }
            ss = wave_sum(ss);
            const float rstd = rsqrtf(ss * (1.f / DM) + NORM_EPS);
#pragma unroll
            for (int j = 0; j < 4; ++j) {
                const int c0 = 4 * (lane + 64 * j);
                const float4 gg = *(const float4*)(g + c0), s1 = *(const float4*)(sc + c0), s0 = *(const float4*)(sh + c0);
                const float o0 = v[j].x * rstd * gg.x * (1.f + s1.x) + s0.x, o1 = v[j].y * rstd * gg.y * (1.f + s1.y) + s0.y;
                const float o2 = v[j].z * rstd * gg.z * (1.f + s1.z) + s0.z, o3 = v[j].w * rstd * gg.w * (1.f + s1.w) + s0.w;
                uint2 pk; pk.x = (unsigned)f2bf(o0) | ((unsigned)f2bf(o1) << 16); pk.y = (unsigned)f2bf(o2) | ((unsigned)f2bf(o3) << 16);
                *(uint2*)(dst + (size_t)m * DM + c0) = pk;
                sx[(c0 + 0) * 4 + tk] = o0; sx[(c0 + 1) * 4 + tk] = o1; sx[(c0 + 2) * 4 + tk] = o2; sx[(c0 + 3) * 4 + tk] = o3;
            }
        }
        __builtin_amdgcn_wave_barrier(); asm volatile("s_waitcnt lgkmcnt(0)" ::: "memory");
        float ae[4], ag[4];
        {
            float pe[4][4];
#pragma unroll
            for (int t_ = 0; t_ < 4; ++t_)
#pragma unroll
                for (int q = 0; q < 4; ++q) pe[t_][q] = 0.f;
            const int eq = lane & 7, kb = (lane >> 3) * 128;
#pragma unroll 16
            for (int i = 0; i < 128; ++i) { const float4 w = *(const float4*)(wer + (size_t)(kb + i) * 32 + 4 * eq); const float4 xv = *(const float4*)(sx + (kb + i) * 4);
                pe[0][0] += xv.x * w.x; pe[0][1] += xv.x * w.y; pe[0][2] += xv.x * w.z; pe[0][3] += xv.x * w.w;
                pe[1][0] += xv.y * w.x; pe[1][1] += xv.y * w.y; pe[1][2] += xv.y * w.z; pe[1][3] += xv.y * w.w;
                pe[2][0] += xv.z * w.x; pe[2][1] += xv.z * w.y; pe[2][2] += xv.z * w.z; pe[2][3] += xv.z * w.w;
                pe[3][0] += xv.w * w.x; pe[3][1] += xv.w * w.y; pe[3][2] += xv.w * w.z; pe[3][3] += xv.w * w.w; }
#pragma unroll
            for (int t_ = 0; t_ < 4; ++t_)
#pragma unroll
                for (int q = 0; q < 4; ++q) { float v = pe[t_][q]; v += __shfl_xor(v, 8); v += __shfl_xor(v, 16); v += __shfl_xor(v, 32); pe[t_][q] = v; }
#pragma unroll
            for (int t_ = 0; t_ < 4; ++t_) { const int srcl = (lane & 31) >> 2; const float v0 = __shfl(pe[t_][0], srcl), v1 = __shfl(pe[t_][1], srcl), v2 = __shfl(pe[t_][2], srcl), v3 = __shfl(pe[t_][3], srcl);
                const int cq = lane & 3; ae[t_] = cq == 0 ? v0 : (cq == 1 ? v1 : (cq == 2 ? v2 : v3)); }
            float pg_[4][4];
#pragma unroll
            for (int t_ = 0; t_ < 4; ++t_)
#pragma unroll
                for (int q = 0; q < 4; ++q) pg_[t_][q] = 0.f;
            const int kg = lane * 16;
#pragma unroll
            for (int i = 0; i < 16; ++i) { const float4 w = *(const float4*)(wgr + (size_t)(kg + i) * 4); const float4 xv = *(const float4*)(sx + (kg + i) * 4);
                pg_[0][0] += xv.x * w.x; pg_[0][1] += xv.x * w.y; pg_[0][2] += xv.x * w.z; pg_[0][3] += xv.x * w.w;
                pg_[1][0] += xv.y * w.x; pg_[1][1] += xv.y * w.y; pg_[1][2] += xv.y * w.z; pg_[1][3] += xv.y * w.w;
                pg_[2][0] += xv.z * w.x; pg_[2][1] += xv.z * w.y; pg_[2][2] += xv.z * w.z; pg_[2][3] += xv.z * w.w;
                pg_[3][0] += xv.w * w.x; pg_[3][1] += xv.w * w.y; pg_[3][2] += xv.w * w.z; pg_[3][3] += xv.w * w.w; }
#pragma unroll
            for (int t_ = 0; t_ < 4; ++t_) {
#pragma unroll
                for (int q = 0; q < 4; ++q) pg_[t_][q] = wave_sum(pg_[t_][q]);
                const int cq = lane & 3; ag[t_] = cq == 0 ? pg_[t_][0] : (cq == 1 ? pg_[t_][1] : (cq == 2 ? pg_[t_][2] : pg_[t_][3])); }
        }
#pragma unroll
        for (int tk = 0; tk < 4; ++tk) {
            float lg[4];
#pragma unroll
            for (int q = 0; q < 4; ++q) lg[q] = __shfl(ag[tk], q);
            int gs = 0; float mx = lg[0];
#pragma unroll
            for (int q = 1; q < 4; ++q) if (lg[q] > mx) { mx = lg[q]; gs = q; }
            float den = 0.f;
#pragma unroll
            for (int q = 0; q < 4; ++q) den += __expf(lg[q] - mx);
            const float pg = 1.f / den;
            float ev[8];
#pragma unroll
            for (int q = 0; q < 8; ++q) ev[q] = __shfl(ae[tk], gs * 8 + q) + eb[gs * 8 + q];
            int i0 = 0; float v0 = ev[0];
#pragma unroll
            for (int q = 1; q < 8; ++q) if (ev[q] > v0) { v0 = ev[q]; i0 = q; }
            int i1 = -1; float v1 = -INFINITY;
#pragma unroll
            for (int q = 0; q < 8; ++q) if (q != i0 && ev[q] > v1) { v1 = ev[q]; i1 = q; }
            if (lane == 0) {
                const float e1 = __expf(v1 - v0), w0 = pg / (1.f + e1), w1 = pg * e1 / (1.f + e1);
                const int x0 = gs * 8 + i0, x1 = gs * 8 + i1;
                const int rk0 = atomicAdd(&cntL[x0], 1), rk1 = atomicAdd(&cntL[32 + x1], 1);
                int4* route = (int4*)(p.ws + WS_ROUTE) + (size_t)(m0 + tk);
                *route = make_int4(x0 | (x1 << 8), rk0 | (rk1 << 16), __float_as_int(w0), __float_as_int(w1));
            }
        }
        __builtin_amdgcn_wave_barrier();
    }
    __syncthreads();
    if (tid < 64) ((int*)(p.ws + WS_CTL) + CT_CNTB)[blockIdx.x * 64 + tid] = cntL[tid];
}

namespace pg8 {
#define PG8_LAS __attribute__((address_space(3)))
typedef short bf16x8 __attribute__((ext_vector_type(8)));
typedef float f32x4 __attribute__((ext_vector_type(4)));
typedef unsigned u32x4 __attribute__((ext_vector_type(4)));
constexpr int BM = 256, BK = 64, HALF = 128, HTB = HALF * BK * 2, STAGE_BYTES = 8 * HTB, NXCD = 8, WGM = 8;
__host__ __device__ __forceinline__ int lds_byte(int r, int c) { const int st = (r >> 4) * 2 + (c >> 5), rr = r & 15, cc = c & 31, ob = rr * 64 + cc * 2; return st * 1024 + (ob ^ (((ob >> 9) & 1) << 5)); }
__host__ __device__ __forceinline__ void stage_rc(int b, int& R, int& C) { const int st = b / 1024, sb = b % 1024, swz = sb ^ (((sb >> 9) & 1) << 5); R = (st >> 1) * 16 + swz / 64; C = (st & 1) * 32 + (swz % 64) / 2; }
__host__ __device__ __forceinline__ int perm32(int rho) { const int n = rho >> 4, i = rho & 15; return 8 * (i >> 2) + 4 * n + (i & 3); }

struct Unit { int arow, brow, pm, pn, aux; };
struct Gemm { const bf16_t* A; const bf16_t* Bt; int K; const int* gather; };

struct StaticOrder {
    int nM, nN, nwg, G, c;
    __device__ void init(int M, int N, int G_, int c_) { nM = M / BM; nN = N / BM; nwg = nM * nN; G = G_; c = c_; }
    __device__ bool next(int i, Unit& u) const {
        const long L = (long)i * G + c; if (L >= nwg) return false;
        int wgid = (int)L; { const int q = nwg / NXCD, r = nwg % NXCD, xcd = wgid % NXCD, off = wgid / NXCD; wgid = (xcd < r ? xcd * (q + 1) : r * (q + 1) + (xcd - r) * q) + off; }
        const int nig = WGM * nN, gid = wgid / nig, fm = gid * WGM, gsz = (nM - fm) < WGM ? (nM - fm) : WGM;
        u.pm = fm + ((wgid % nig) % gsz); u.pn = (wgid % nig) / gsz; u.arow = u.pm * BM; u.brow = u.pn * BM; u.aux = 0; return true;
    }
};
struct BranchOrder {
    StaticOrder S0;
    __device__ bool next(int i, Unit& u) const {
        if (!S0.next(i >> 1, u)) return false;
        const int which = i & 1; u.arow += which * NT; u.brow += which * DM; u.aux = which; return true;
    }
};
struct TableOrder {
    const int4* tab; int n, G, c;
    __device__ bool next(int i, Unit& u) const {
        const int L = i * G + c; if (L >= n) return false;
        const int4 e = tab[L]; u.arow = __builtin_amdgcn_readfirstlane(e.x); u.brow = __builtin_amdgcn_readfirstlane(e.y); u.aux = __builtin_amdgcn_readfirstlane(e.z); u.pn = __builtin_amdgcn_readfirstlane(e.w); u.pm = 0; return true;
    }
};
__device__ __forceinline__ unsigned cvt_pk_bf16(float lo, float hi) { return pk_bf16(lo, hi); }

template <class Epi, class Sched>
__device__ __forceinline__ void gemm_phase(PG8_LAS unsigned char* lds, const Gemm g, const Sched& S, const Epi& E) {
    const int tid = otid(), wid = __builtin_amdgcn_readfirstlane(tid >> 6), lane = tid & 63, wr = wid >> 2, wc = wid & 3, fr = lane & 15, fq = lane >> 4;
    const int K = g.K, nt = K / BK;
    int RA0; unsigned cofA0, voffB0;
    { int R, C; stage_rc(tid * 16, R, C); const int Rb = Epi::PERM ? ((R & ~31) + perm32(R & 31)) : R; RA0 = R; cofA0 = (unsigned)C * 2u; voffB0 = (unsigned)(Rb * K + C) * 2u; }
    const size_t rstep64 = (size_t)64 * K * 2;
    const size_t kstep = (size_t)(BK * 2);
    const size_t hstep = (size_t)HALF * K * 2;
    const unsigned ldsw = (unsigned)wid * 1024u;
    const int aoff = lds_byte(wr * 64 + fr, fq * 8), boff = lds_byte(wc * 32 + fr, fq * 8);
#define PG8_SA(b, h) (((b) * 2 + (h)) * HTB)
#define PG8_SB(b, h) ((4 + (b) * 2 + (h)) * HTB)
#define PG8_STAGE_B(bufoff, gbase) do { _Pragma("unroll") for (int _i = 0; _i < 2; ++_i) \
        __builtin_amdgcn_global_load_lds((const unsigned*)((const char*)(gbase) + _i * rstep64 + voffB0), (PG8_LAS unsigned*)(lds + (bufoff) + ldsw + _i * 8192), 16, 0, 0); } while (0)
#define PG8_STAGE_A(bufoff, o2, kb) do { _Pragma("unroll") for (int _i = 0; _i < 2; ++_i) \
        __builtin_amdgcn_global_load_lds((const unsigned*)((const char*)g.A + (size_t)(o2)[_i] + (size_t)(kb)), (PG8_LAS unsigned*)(lds + (bufoff) + ldsw + _i * 8192), 16, 0, 0); } while (0)
#define PG8_LDA(dst, b, h) do { _Pragma("unroll") for (int m = 0; m < 4; ++m) _Pragma("unroll") for (int k = 0; k < 2; ++k) dst[m][k] = *(const PG8_LAS bf16x8*)(lds + PG8_SA(b, h) + aoff + m * 2048 + k * 1024); } while (0)
#define PG8_LDB(dst, b, h) do { _Pragma("unroll") for (int n = 0; n < 2; ++n) _Pragma("unroll") for (int k = 0; k < 2; ++k) dst[n][k] = *(const PG8_LAS bf16x8*)(lds + PG8_SB(b, h) + boff + n * 2048 + k * 1024); } while (0)
#define PG8_MMA(ai, bj, At, Bt) do { __builtin_amdgcn_s_setprio(1); _Pragma("unroll") for (int m = 0; m < 4; ++m) _Pragma("unroll") for (int n = 0; n < 2; ++n) _Pragma("unroll") for (int k = 0; k < 2; ++k) \
        acc[ai][bj][m][n] = __builtin_amdgcn_mfma_f32_16x16x32_bf16(Bt[n][k], At[m][k], acc[ai][bj][m][n], 0, 0, 0); __builtin_amdgcn_s_setprio(0); } while (0)
#define PG8_WAIT_V(n) asm volatile("s_waitcnt vmcnt(" #n ")" ::: "memory")
#define PG8_WAIT_L(n) asm volatile("s_waitcnt lgkmcnt(" #n ")" ::: "memory")
#define PG8_BAR __builtin_amdgcn_s_barrier()
#define PG8_SCHED __builtin_amdgcn_sched_barrier(0)
#define PG8_AOFFS(u, dst) do { _Pragma("unroll") for (int _h = 0; _h < 2; ++_h) _Pragma("unroll") for (int _i = 0; _i < 2; ++_i) { \
        const int _tr = (u).arow + _h * HALF + RA0 + 64 * _i; const unsigned _row = g.gather ? (unsigned)g.gather[_tr] : (unsigned)_tr; dst[_h][_i] = _row * (unsigned)(K * 2) + cofA0; } } while (0)
    Unit cur, nxt; int ui = 0;
    if (!S.next(0, cur)) return;
    f32x4 acc[2][2][4][2];
#pragma unroll
    for (int a = 0; a < 2; ++a)
#pragma unroll
        for (int b = 0; b < 2; ++b)
#pragma unroll
            for (int m = 0; m < 4; ++m)
#pragma unroll
                for (int n = 0; n < 2; ++n) acc[a][b][m][n] = (f32x4){0.f, 0.f, 0.f, 0.f};
    bf16x8 At[4][2], B0[2][2], B1[2][2];
    unsigned cof[2][2];
    PG8_AOFFS(cur, cof);
    const char* cB = (const char*)g.Bt + (size_t)cur.brow * K * 2;
    PG8_STAGE_B(PG8_SB(0, 0), cB); PG8_STAGE_B(PG8_SB(0, 1), cB + hstep); PG8_STAGE_A(PG8_SA(0, 0), cof[0], 0); PG8_STAGE_A(PG8_SA(0, 1), cof[1], 0);
    if (wr == 1) PG8_BAR;
    PG8_WAIT_V(2); PG8_BAR;
    PG8_STAGE_B(PG8_SB(1, 0), cB + kstep); PG8_STAGE_A(PG8_SA(1, 0), cof[0], kstep); PG8_STAGE_B(PG8_SB(1, 1), cB + hstep + kstep);
    PG8_WAIT_V(6); PG8_BAR;
    for (;;) {
        const bool has_next = S.next(ui + 1, nxt);
        if (!has_next) nxt = cur;
        const char* nB = (const char*)g.Bt + (size_t)nxt.brow * K * 2;
        for (int t = 0; t < nt; t += 2) {
            const bool last = (t == nt - 2);
            const size_t k1 = (size_t)(t + 1) * kstep;
            const size_t k2 = last ? 0 : (size_t)(t + 2) * kstep, k3 = k2 + kstep;
            const char* b2 = last ? nB : cB + (size_t)(t + 2) * kstep; const char* b3 = b2 + kstep;
            PG8_LDB(B0, 0, 0); PG8_LDB(B1, 0, 1); PG8_SCHED; PG8_LDA(At, 0, 0); PG8_STAGE_A(PG8_SA(1, 1), cof[1], k1);
            if (last) { PG8_AOFFS(nxt, cof); }
            PG8_WAIT_V(8); PG8_WAIT_L(0); PG8_BAR; PG8_MMA(0, 0, At, B0); PG8_MMA(0, 1, At, B1); PG8_BAR; PG8_SCHED;
            PG8_LDA(At, 0, 1); PG8_STAGE_B(PG8_SB(0, 0), b2); PG8_STAGE_B(PG8_SB(0, 1), b2 + hstep); PG8_STAGE_A(PG8_SA(0, 0), cof[0], k2);
            PG8_WAIT_V(8); PG8_WAIT_L(0); PG8_BAR; PG8_MMA(1, 0, At, B0); PG8_MMA(1, 1, At, B1); PG8_BAR; PG8_SCHED;
            PG8_LDB(B0, 1, 0); PG8_LDB(B1, 1, 1); PG8_SCHED; PG8_LDA(At, 1, 0); PG8_STAGE_A(PG8_SA(0, 1), cof[1], k2);
            PG8_WAIT_V(8); PG8_WAIT_L(0); PG8_BAR; PG8_MMA(0, 0, At, B0); PG8_MMA(0, 1, At, B1); PG8_BAR; PG8_SCHED;
            PG8_LDA(At, 1, 1); PG8_STAGE_B(PG8_SB(1, 0), b3); PG8_STAGE_B(PG8_SB(1, 1), b3 + hstep); PG8_STAGE_A(PG8_SA(1, 0), cof[0], k3);
            PG8_WAIT_V(8); PG8_WAIT_L(0); PG8_BAR; PG8_MMA(1, 0, At, B0); PG8_MMA(1, 1, At, B1); PG8_BAR; PG8_SCHED;
        }
        if (wr == 0) PG8_BAR;
        { const int l2 = otid() & 63; E(acc, cur, wr, wc, l2 & 15, l2 >> 4); }
        if (!has_next) break;
#pragma unroll
        for (int a = 0; a < 2; ++a)
#pragma unroll
            for (int b = 0; b < 2; ++b)
#pragma unroll
                for (int m = 0; m < 4; ++m)
#pragma unroll
                    for (int n = 0; n < 2; ++n) acc[a][b][m][n] = (f32x4){0.f, 0.f, 0.f, 0.f};
        cur = nxt; cB = nB; ++ui;
        if (wr == 1) PG8_BAR;
    }
    PG8_WAIT_V(0);
    PG8_BAR;
#undef PG8_SA
#undef PG8_SB
#undef PG8_STAGE_A
#undef PG8_STAGE_B
#undef PG8_LDA
#undef PG8_LDB
#undef PG8_MMA
#undef PG8_WAIT_V
#undef PG8_WAIT_L
#undef PG8_BAR
#undef PG8_SCHED
#undef PG8_AOFFS
}

#define PG8_FENCE asm volatile("" ::: "memory")
#define PG8_FOR_TILE(ai, m, bj) _Pragma("unroll") for (int ai = 0; ai < 2; ++ai) _Pragma("unroll") for (int m = 0; m < 4; ++m) _Pragma("unroll") for (int bj = 0; bj < 2; ++bj)
__device__ __forceinline__ u32x4 pack8(const f32x4& v0, const f32x4& v1) { u32x4 w; w.x = cvt_pk_bf16(v0[0], v0[1]); w.y = cvt_pk_bf16(v0[2], v0[3]); w.z = cvt_pk_bf16(v1[0], v1[1]); w.w = cvt_pk_bf16(v1[2], v1[3]); return w; }
__device__ __forceinline__ float sigm(float x) { return __builtin_amdgcn_rcpf(1.f + __expf(-x)); }
struct EpiInproj {
    static constexpr bool PERM = true;
    unsigned char* ws; bf16_t* gates;
    __device__ __forceinline__ void operator()(const f32x4 (&acc)[2][2][4][2], const Unit& u, int wr, int wc, int fr, int fq) const {
        PG8_FOR_TILE(ai, m, bj) { PG8_FENCE;
            int row = u.pm * BM + ai * HALF + wr * 64 + m * 16 + fr; asm volatile("" : "+v"(row)); const int col = u.pn * BM + bj * HALF + wc * 32 + 8 * fq;
            const f32x4 v0 = acc[ai][bj][m][0], v1 = acc[ai][bj][m][1];
            if (col < C_KV) *(u32x4*)((bf16_t*)(ws + WS_Q) + (size_t)row * AW + col) = pack8(v0, v1);
            else if (col < C_QI) {
                *(u32x4*)((bf16_t*)(ws + WS_KVN) + (size_t)row * KVL + (col - C_KV)) = pack8(v0, v1);
                float ss = (v0[0] * v0[0] + v0[1] * v0[1]) + (v0[2] * v0[2] + v0[3] * v0[3]) + (v1[0] * v1[0] + v1[1] * v1[1]) + (v1[2] * v1[2] + v1[3] * v1[3]);
                ss += __shfl_xor(ss, 16); ss += __shfl_xor(ss, 32);
                if (fq == 0) ((float*)(ws + WS_RSS))[(size_t)row * 8 + bj * 4 + wc] = ss;
            }
            else if (col < C_PS) {
                if (col < 1056) {
                    typedef _Float16 h8 __attribute__((ext_vector_type(8)));
                    h8 hv; hv[0] = (_Float16)v0[0]; hv[1] = (_Float16)v0[1]; hv[2] = (_Float16)v0[2]; hv[3] = (_Float16)v0[3]; hv[4] = (_Float16)v1[0]; hv[5] = (_Float16)v1[1]; hv[6] = (_Float16)v1[2]; hv[7] = (_Float16)v1[3];
                    _Float16* d = (col < 1024) ? (_Float16*)(ws + WS_QI) + (size_t)row * 256 + (col - C_QI) : (_Float16*)(ws + WS_KI) + (size_t)row * 32 + (col - 1024);
                    *(h8*)d = hv;
                } else { const float sc_ = 0.17677669529663687f * 0.35355339059327373f; float* d = (float*)(ws + WS_WI) + (size_t)row * 8; *(f32x4*)d = v0 * sc_; *(f32x4*)(d + 4) = v1 * sc_; }
            }
            else if (col < C_GA) *(u32x4*)((bf16_t*)(ws + WS_PS) + (size_t)row * SHW + (col - C_PS)) = pack8(v0, v1);
            else if (col < INW) {
                f32x4 s0, s1;
#pragma unroll
                for (int e = 0; e < 4; ++e) { s0[e] = sigm(v0[e]); s1[e] = sigm(v1[e]); }
                bf16_t* d = (col < C_GR) ? gates + (size_t)row * DM + (col - C_GA) : gates + (size_t)NT * DM + (size_t)row * DM + (col - C_GR);
                *(u32x4*)d = pack8(s0, s1);
            }
        }
    }
};
struct EpiKV {
    static constexpr bool PERM = true;
    unsigned char* ws;
    __device__ __forceinline__ void operator()(const f32x4 (&acc)[2][2][4][2], const Unit& u, int wr, int wc, int fr, int fq) const {
        PG8_FOR_TILE(ai, m, bj) { PG8_FENCE;
            int row = u.pm * BM + ai * HALF + wr * 64 + m * 16 + fr; asm volatile("" : "+v"(row)); const int col = u.pn * BM + bj * HALF + wc * 32 + 8 * fq;
            const f32x4 ra = *(const f32x4*)((const float*)(ws + WS_RSS) + (size_t)row * 8), rb = *(const f32x4*)((const float*)(ws + WS_RSS) + (size_t)row * 8 + 4);
            const float rstd = rsqrtf((((ra[0] + ra[1]) + (ra[2] + ra[3])) + ((rb[0] + rb[1]) + (rb[2] + rb[3]))) * (1.f / KVL) + NORM_EPS);
            if (col < AW) *(u32x4*)((bf16_t*)(ws + WS_K) + (size_t)row * AW + col) = pack8(acc[ai][bj][m][0] * rstd, acc[ai][bj][m][1] * rstd);
            else {
                bf16_t* d = (bf16_t*)(ws + WS_V) + ((size_t)(row / SEQ) * 512 + (col - AW)) * SEQ + (row % SEQ);
#pragma unroll
                for (int e = 0; e < 4; ++e) { d[(size_t)e * SEQ] = f2bf(acc[ai][bj][m][0][e] * rstd); d[(size_t)(4 + e) * SEQ] = f2bf(acc[ai][bj][m][1][e] * rstd); }
            }
        }
    }
};
struct EpiMerge {
    static constexpr bool PERM = true;
    bf16_t* merged; const bf16_t* gates;
    __device__ __forceinline__ void operator()(const f32x4 (&acc)[2][2][4][2], const Unit& u, int wr, int wc, int fr, int fq) const {
        const bf16_t* gate = gates + (size_t)u.aux * NT * DM;
        PG8_FOR_TILE(ai, m, bj) { PG8_FENCE;
            int row = u.pm * BM + ai * HALF + wr * 64 + m * 16 + fr; asm volatile("" : "+v"(row)); const int col = u.pn * BM + bj * HALF + wc * 32 + 8 * fq;
            const u32x4 gw = *(const u32x4*)(gate + (size_t)row * DM + col);
            f32x4 v0 = acc[ai][bj][m][0], v1 = acc[ai][bj][m][1];
            v0[0] *= __uint_as_float(gw.x << 16); v0[1] *= __uint_as_float(gw.x & 0xffff0000u); v0[2] *= __uint_as_float(gw.y << 16); v0[3] *= __uint_as_float(gw.y & 0xffff0000u);
            v1[0] *= __uint_as_float(gw.z << 16); v1[1] *= __uint_as_float(gw.z & 0xffff0000u); v1[2] *= __uint_as_float(gw.w << 16); v1[3] *= __uint_as_float(gw.w & 0xffff0000u);
            u32x4* d = (u32x4*)(merged + (size_t)row * DM + col);
            if (u.aux) { const u32x4 pw = *d;
                v0[0] += __uint_as_float(pw.x << 16); v0[1] += __uint_as_float(pw.x & 0xffff0000u); v0[2] += __uint_as_float(pw.y << 16); v0[3] += __uint_as_float(pw.y & 0xffff0000u);
                v1[0] += __uint_as_float(pw.z << 16); v1[1] += __uint_as_float(pw.z & 0xffff0000u); v1[2] += __uint_as_float(pw.w << 16); v1[3] += __uint_as_float(pw.w & 0xffff0000u); }
            *d = pack8(v0, v1);
        }
    }
};
struct EpiOut {
    static constexpr bool PERM = false;
    const float* x; const float* mod; float* out;
    __device__ __forceinline__ void operator()(const f32x4 (&acc)[2][2][4][2], const Unit& u, int wr, int wc, int fr, int fq) const {
        PG8_FOR_TILE(ai, m, bj) { PG8_FENCE;
            int row = u.pm * BM + ai * HALF + wr * 64 + m * 16 + fr; asm volatile("" : "+v"(row)); const float* gt = mod + (row / SEQ) * 6 * DM + 2 * DM;
#pragma unroll
            for (int n = 0; n < 2; ++n) { const int col = u.pn * BM + bj * HALF + wc * 32 + 16 * n + 4 * fq;
                const f32x4 xv = *(const f32x4*)(x + (size_t)row * DM + col), gv = *(const f32x4*)(gt + col);
                *(f32x4*)(out + (size_t)row * DM + col) = xv + gv * acc[ai][bj][m][n]; }
        }
    }
};
struct EpiMoe1 {
    static constexpr bool PERM = true;
    bf16_t* hid; const float* lw;
    __device__ __forceinline__ void operator()(const f32x4 (&acc)[2][2][4][2], const Unit& u, int wr, int wc, int fr, int fq) const {
#pragma unroll
        for (int ai = 0; ai < 2; ++ai)
#pragma unroll
            for (int m = 0; m < 4; ++m) {
                const int tr = ai * HALF + wr * 64 + m * 16 + fr; PG8_FENCE;
                if (tr < u.aux) {
                    const float w = lw[u.arow + tr]; f32x4 h0, h1;
#pragma unroll
                    for (int e = 0; e < 4; ++e) { const float g0 = acc[ai][0][m][0][e], g1 = acc[ai][0][m][1][e];
                        h0[e] = w * (g0 * __builtin_amdgcn_rcpf(1.f + __expf(-g0))) * acc[ai][1][m][0][e]; h1[e] = w * (g1 * __builtin_amdgcn_rcpf(1.f + __expf(-g1))) * acc[ai][1][m][1][e]; }
                    *(u32x4*)(hid + (size_t)(u.arow + tr) * DE + u.pn * HALF + wc * 32 + 8 * fq) = pack8(h0, h1);
                }
            }
    }
};
struct EpiMoe2 {
    static constexpr bool PERM = false;
    const int* ltok; const float* mod; float* out;
    __device__ __forceinline__ void operator()(const f32x4 (&acc)[2][2][4][2], const Unit& u, int wr, int wc, int fr, int fq) const {
#pragma unroll
        for (int ai = 0; ai < 2; ++ai)
#pragma unroll
            for (int m = 0; m < 4; ++m) {
                const int tr = ai * HALF + wr * 64 + m * 16 + fr; PG8_FENCE;
                if (tr < u.aux) {
                    const int tok = ltok[u.arow + tr]; const float* gt = mod + (tok / SEQ) * 6 * DM + 5 * DM; float* orow = out + (size_t)tok * DM;
#pragma unroll
                    for (int bj = 0; bj < 2; ++bj)
#pragma unroll
                        for (int n = 0; n < 2; ++n) { const int col = u.pn * BM + bj * HALF + wc * 32 + 16 * n + 4 * fq;
                            const f32x4 gv = *(const f32x4*)(gt + col); f32x4* d = (f32x4*)(orow + col); *d = *d + gv * acc[ai][bj][m][n]; }
                }
            }
    }
};
}

__device__ __forceinline__ unsigned pk2(float lo, float hi) { return (unsigned)f2bf(lo) | ((unsigned)f2bf(hi) << 16); }
__device__ __forceinline__ void transpose_item(const float* W, int K, int N, bf16_t* WT, size_t drow0, int k0, int n0, float* scr, int lane, int Ksrc = 1 << 30, const float* kscale = nullptr) {
#pragma unroll 8
    for (int i = 0; i < 32; ++i) { const int kk = 2 * i + (lane >> 5), n = n0 + (lane & 31); float v_ = (n < N && k0 + kk < Ksrc) ? W[(size_t)(k0 + kk) * N + n] : 0.f; if (kscale) v_ *= kscale[k0 + kk]; scr[kk * 33 + (lane & 31)] = v_; }
    asm volatile("s_waitcnt lgkmcnt(0)" ::: "memory");
    const int c = lane & 7;
#pragma unroll
    for (int j = 0; j < 4; ++j) { const int n = (lane >> 3) + 8 * j; const float* s_ = scr + (8 * c) * 33 + n;
        uint4 o; o.x = pk2(s_[0 * 33], s_[1 * 33]); o.y = pk2(s_[2 * 33], s_[3 * 33]); o.z = pk2(s_[4 * 33], s_[5 * 33]); o.w = pk2(s_[6 * 33], s_[7 * 33]);
        *(uint4*)(WT + (drow0 + n) * K + k0 + 8 * c) = o; }
    asm volatile("s_waitcnt lgkmcnt(0)" ::: "memory");
}
__device__ __forceinline__ void transpose_item64(const float* W, int K, int N, bf16_t* WT, size_t drow0, int k0, int n0, float* scr, int lane, const float* kscale = nullptr) {
    const int r_ = lane >> 4, c4 = (lane & 15) * 4, n = n0 + c4;
    float4 v[16];
#pragma unroll
    for (int i = 0; i < 16; ++i) { v[i] = make_float4(0.f, 0.f, 0.f, 0.f); if (n < N) v[i] = *(const float4*)(W + (size_t)(k0 + r_ + 4 * i) * N + n); }
#pragma unroll
    for (int i = 0; i < 16; ++i) { const int kk = r_ + 4 * i; float4 x = v[i]; if (kscale) { const float s_ = kscale[k0 + kk]; x.x *= s_; x.y *= s_; x.z *= s_; x.w *= s_; }
        float* d_ = scr + kk * 65 + c4; d_[0] = x.x; d_[1] = x.y; d_[2] = x.z; d_[3] = x.w; }
    asm volatile("s_waitcnt lgkmcnt(0)" ::: "memory");
    const int c = lane & 7;
#pragma unroll
    for (int j = 0; j < 8; ++j) { const int nn = (lane >> 3) + 8 * j; const float* s_ = scr + (8 * c) * 65 + nn;
        uint4 o; o.x = pk2(s_[0 * 65], s_[1 * 65]); o.y = pk2(s_[2 * 65], s_[3 * 65]); o.z = pk2(s_[4 * 65], s_[5 * 65]); o.w = pk2(s_[6 * 65], s_[7 * 65]);
        *(uint4*)(WT + (drow0 + nn) * K + k0 + 8 * c) = o; }
    asm volatile("s_waitcnt lgkmcnt(0)" ::: "memory");
}
__device__ void ph_convert_mixer_weights(const P& p, float* lds) {
    const int lane = otid() & 63, wv = otid() >> 6;
    float* scr = lds + wv * (64 * 65);
    const int gw = blockIdx.x * (NTHR / 64) + wv, nw = gridDim.x * (NTHR / 64);
    struct M { const float* W; int K, N, Npad; size_t dst; const float* ks; };
    const M ms[5] = { {p.in[5], DM, INW, 5120, WS_WIN, nullptr}, {p.in[7], KVL, 2 * AW, 2 * AW, WS_WKV, p.in[6]}, {p.in[21], AW, DM, DM, WS_WBA, nullptr}, {p.in[22], RW, DM, DM, WS_WBR, nullptr}, {p.in[23], DM, DM, DM, WS_WOUT, nullptr} };
    int base = 0;
#pragma unroll
    for (int q = 0; q < 5; ++q) {
        const int nkb = ms[q].K / 64, nnb = ms[q].Npad / 64, nitems = nkb * nnb;
        for (int it = gw; it < base + nitems; it += nw) { if (it < base) continue; const int r = it - base; const int kb = r / nnb, nb = r % nnb;
            transpose_item64(ms[q].W, ms[q].K, ms[q].N, (bf16_t*)(p.ws + ms[q].dst), (size_t)nb * 64, kb * 64, nb * 64, scr, lane, ms[q].ks); }
        base += nitems;
    }
}
__device__ void ph_convert_lora_weights(const P& p, float* lds) {
    const int lane = otid() & 63, wv = otid() >> 6;
    float* scr = lds + wv * (64 * 33);
    const int gw = blockIdx.x * (NTHR / 64) + wv, nw = gridDim.x * (NTHR / 64);
    for (int it = gw; it < 16 + 16 + 48; it += nw) {
        if (it < 16) transpose_item(p.in[12], 64, RW, (bf16_t*)(p.ws + WS_LW2T), (size_t)it * 32, 0, it * 32, scr, lane);
        else if (it < 32) transpose_item(p.in[14], 64, RW, (bf16_t*)(p.ws + WS_LA2T), (size_t)(it - 16) * 32, 0, (it - 16) * 32, scr, lane);
        else { const int r = it - 32, kb = r >> 4, nb = r & 15; transpose_item(p.in[15], 192, RW, (bf16_t*)(p.ws + WS_LG2T), (size_t)nb * 32, kb * 64, nb * 32, scr, lane, 160); }
    }
}
__device__ void ph_convert_expert_weights(const P& p, float* lds) {
    const int lane = otid() & 63, wv = otid() >> 6;
    float* scr = lds + wv * (64 * 65);
    const int gw = blockIdx.x * (NTHR / 64) + wv, nw = gridDim.x * (NTHR / 64);
    for (int it = gw; it < NE * 2 * 128; it += nw) { const int e = it >> 8, which = (it >> 7) & 1, r = it & 127, kb = r >> 3, nb = r & 7, n0 = nb * 64;
        transpose_item64(p.in[28 + which] + (size_t)e * DM * DE, DM, DE, (bf16_t*)(p.ws + WS_WGU), (size_t)e * 1024 + (n0 >> 7) * 256 + which * 128 + (n0 & 127), kb * 64, n0, scr, lane); }
    for (int it = gw; it < NE * 128; it += nw) { const int e = it >> 7, r = it & 127, kb = r >> 4, nb = r & 15;
        transpose_item64(p.in[30] + (size_t)e * DE * DM, DE, DM, (bf16_t*)(p.ws + WS_WDN), (size_t)e * 1024 + nb * 64, kb * 64, nb * 64, scr, lane); }
}

__device__ void ph_headnorm(bf16_t* X, const float* g) {
    const int lane = otid() & 63, wv = otid() >> 6;
    const int gw = blockIdx.x * (NTHR / 64) + wv, nw = gridDim.x * (NTHR / 64);
    for (int m = gw; m < NT; m += nw) {
        uint4 raw = *(const uint4*)(X + (size_t)m * AW + lane * 8);
        float v[8] = {bf2f(raw.x & 0xffff), bf2f(raw.x >> 16), bf2f(raw.y & 0xffff), bf2f(raw.y >> 16), bf2f(raw.z & 0xffff), bf2f(raw.z >> 16), bf2f(raw.w & 0xffff), bf2f(raw.w >> 16)};
        float ss = 0.f;
#pragma unroll
        for (int i = 0; i < 8; ++i) ss += v[i] * v[i];
        ss += __shfl_xor(ss, 1); ss += __shfl_xor(ss, 2); ss += __shfl_xor(ss, 4);
        const float rstd = rsqrtf(ss * (1.f / 64.f) + NORM_EPS);
        const int d0 = (lane & 7) * 8;
        unsigned o[4];
#pragma unroll
        for (int i = 0; i < 4; ++i) o[i] = (unsigned)f2bf(v[2 * i] * rstd * g[d0 + 2 * i]) | ((unsigned)f2bf(v[2 * i + 1] * rstd * g[d0 + 2 * i + 1]) << 16);
        *(uint4*)(X + (size_t)m * AW + lane * 8) = make_uint4(o[0], o[1], o[2], o[3]);
    }
}
__device__ void ph_kvnorm(bf16_t* X, const float* g) {
    const int lane = otid() & 63, wv = otid() >> 6;
    const int gw = blockIdx.x * (NTHR / 64) + wv, nw = gridDim.x * (NTHR / 64);
    for (int m = gw; m < NT; m += nw) {
        uint2 raw = *(const uint2*)(X + (size_t)m * KVL + lane * 4);
        float v[4] = {bf2f(raw.x & 0xffff), bf2f(raw.x >> 16), bf2f(raw.y & 0xffff), bf2f(raw.y >> 16)};
        float ss = wave_sum(v[0] * v[0] + v[1] * v[1] + v[2] * v[2] + v[3] * v[3]);
        const float rstd = rsqrtf(ss * (1.f / 256.f) + NORM_EPS);
        uint2 o; o.x = (unsigned)f2bf(v[0] * rstd * g[lane * 4]) | ((unsigned)f2bf(v[1] * rstd * g[lane * 4 + 1]) << 16);
        o.y = (unsigned)f2bf(v[2] * rstd * g[lane * 4 + 2]) | ((unsigned)f2bf(v[3] * rstd * g[lane * 4 + 3]) << 16);
        *(uint2*)(X + (size_t)m * KVL + lane * 4) = o;
    }
}

typedef _Float16 half8_t __attribute__((ext_vector_type(8)));
typedef float f32x16_t __attribute__((ext_vector_type(16)));
__device__ __forceinline__ unsigned f2key(float f) { unsigned u = __float_as_uint(f); return (u & 0x80000000u) ? ~u : (u | 0x80000000u); }
template <bool PASS1, bool FULL>
__device__ __forceinline__ void d1_unit(const half8_t& a0, const half8_t& a1, const half8_t& b0, const half8_t& b1, const float (&w)[4][4], int rg, int hh, int r32, int tile, int t0,
                                        unsigned* hist, unsigned* maskl, int* misc, uint2* cand, int tbA, int tbB) {
    constexpr int CCAP = 1024;
    f32x16_t c;
#pragma unroll
    for (int i = 0; i < 16; ++i) c[i] = 0.f;
    c = __builtin_amdgcn_mfma_f32_32x32x16_f16(a0, b0, c, 0, 0, 0);
    c = __builtin_amdgcn_mfma_f32_32x32x16_f16(a1, b1, c, 0, 0, 0);
    float x[4];
#pragma unroll
    for (int tl = 0; tl < 4; ++tl) { x[tl] = 0.f;
#pragma unroll
        for (int e = 0; e < 4; ++e) x[tl] = __builtin_fmaf(w[tl][e], __int_as_float(max(__float_as_int(c[4 * tl + e]), 0)), x[tl]); }
    const auto s01 = __builtin_amdgcn_permlane32_swap(__float_as_uint(x[0]), __float_as_uint(x[1]), false, false);
    const auto s23 = __builtin_amdgcn_permlane32_swap(__float_as_uint(x[2]), __float_as_uint(x[3]), false, false);
    const unsigned k01 = f2key(__uint_as_float(s01[0]) + __uint_as_float(s01[1]));
    const unsigned k23 = f2key(__uint_as_float(s23[0]) + __uint_as_float(s23[1]));
    const int rowA = 4 * rg + hh, rowB = rowA + 2, key = tile * 32 + r32;
    const bool okA = FULL || key <= t0 + rowA, okB = FULL || key <= t0 + rowB;
    if (!PASS1) {
        atomicAdd(&hist[okA ? rowA * 2048 + (int)(k01 >> 21) : 8 * 2048 + 16384 + 2048 + 7], 1u << (16 * ((k01 >> 20) & 1u)));
        atomicAdd(&hist[okB ? rowB * 2048 + (int)(k23 >> 21) : 8 * 2048 + 16384 + 2048 + 7], 1u << (16 * ((k23 >> 20) & 1u)));
    } else {
        const int binA = (int)(k01 >> 20), binB = (int)(k23 >> 20);
        const unsigned long long mA = __ballot(okA && binA > tbA), mB = __ballot(okB && binB > tbB);
        if (r32 == 0) { maskl[rowA * 256 + tile] = hh ? (unsigned)(mA >> 32) : (unsigned)mA; maskl[rowB * 256 + tile] = hh ? (unsigned)(mB >> 32) : (unsigned)mB; }
        if (okA && binA == tbA) { const int pos = atomicAdd(&misc[rowA * 8 + 2], 1); if (pos < CCAP) cand[rowA * CCAP + pos] = make_uint2(k01, (unsigned)key); }
        if (okB && binB == tbB) { const int pos = atomicAdd(&misc[rowB * 8 + 2], 1); if (pos < CCAP) cand[rowB * CCAP + pos] = make_uint2(k23, (unsigned)key); }
    }
}
__device__ void ph_dsa_select(const P& p, float* ldsf) {
    const _Float16* QI = (const _Float16*)(p.ws + WS_QI); const _Float16* KI = (const _Float16*)(p.ws + WS_KI); const float* WI = (const float*)(p.ws + WS_WI);
    unsigned* MASK32 = (unsigned*)(p.ws + WS_MASK);
    unsigned* hist = (unsigned*)ldsf;
    uint2* cand = (uint2*)(hist + 8 * 2048);
    unsigned* maskl = (unsigned*)(cand + 8 * 1024);
    unsigned* h2 = hist;
    int* misc = (int*)(maskl + 8 * 256);
    constexpr int CCAP = 1024;
    const int tid = otid(), lane = tid & 63, wv = tid >> 6, hh = lane >> 5, r32 = lane & 31;
    int* qhead = (int*)(p.ws + WS_CTL) + CT_Q + 16; int* qslot = misc + 64;
    __syncthreads();
    if (tid == 0) qslot[0] = atomicAdd(qhead, 1);
#pragma unroll 1
    for (int it = 0;; ++it) {
        __syncthreads();
        const int kq = __builtin_amdgcn_readfirstlane(qslot[it & 1]);
        if (kq >= NT / 8) break;
        const int item = (kq & 1) * (SEQ / 8) + (SEQ / 8 - 1 - (kq >> 1));
        const int tq0 = item * 8, b = tq0 / SEQ, t0 = tq0 % SEQ;
        const int nwords = ((t0 >> 8) + 1) * 8;
        int nxt = 0;
        if (t0 + 7 < TOPK) {
            if (tid == 0) nxt = atomicAdd(qhead, 1);
            for (int e = tid; e < 8 * nwords; e += NTHR) { const int row = e / nwords, w = e % nwords; const int tr_ = t0 + row; const int lo = 32 * w;
                const unsigned bits = (tr_ >= lo + 31) ? 0xffffffffu : ((tr_ < lo) ? 0u : ((2u << (tr_ - lo)) - 1u));
                MASK32[(size_t)(tq0 + row) * 256 + w] = bits; }
            if (tid == 0) qslot[(it & 1) ^ 1] = nxt;
            continue;
        }
        for (int e = tid; e < 8 * 2048; e += NTHR) hist[e] = 0u;
        for (int e = tid; e < 8 * 256; e += NTHR) maskl[e] = 0u;
        if (tid < 64) misc[tid] = 0;
        half8_t a0[2], a1[2]; float w[2][4][4];
#pragma unroll
        for (int rg = 0; rg < 2; ++rg) { const int tl_a = r32 >> 3, h_a = r32 & 7; const _Float16* qp = QI + (size_t)(tq0 + 4 * rg + tl_a) * 256 + h_a * 32 + 8 * hh;
            a0[rg] = *(const half8_t*)qp; a1[rg] = *(const half8_t*)(qp + 16);
#pragma unroll
            for (int tl = 0; tl < 4; ++tl) { const float4 wv4 = *(const float4*)(WI + (size_t)(tq0 + 4 * rg + tl) * 8 + 4 * hh); w[rg][tl][0] = wv4.x; w[rg][tl][1] = wv4.y; w[rg][tl][2] = wv4.z; w[rg][tl][3] = wv4.w; } }
        const int ntile = (t0 + 7) / 32 + 1;
        __syncthreads();
        int thr_bin[8];
#pragma unroll 1
        for (int pass = 0; pass < 2; ++pass) {
            if (pass == 1) {
#pragma unroll
                for (int r = 0; r < 8; ++r) thr_bin[r] = misc[r * 8];
            }
            half8_t kb0[4], kb1[4], nk0[4], nk1[4];
#pragma unroll
            for (int q = 0; q < 4; ++q) { const int tl_ = min(4 * wv + q, ntile - 1); const _Float16* kp = KI + (size_t)(b * SEQ + tl_ * 32 + r32) * 32 + 8 * hh; nk0[q] = *(const half8_t*)kp; nk1[q] = *(const half8_t*)(kp + 16); }
            for (int tbase = 4 * wv; tbase < ntile; tbase += 32) {
#pragma unroll
                for (int q = 0; q < 4; ++q) { kb0[q] = nk0[q]; kb1[q] = nk1[q]; }
                if (tbase + 32 < ntile) {
#pragma unroll
                    for (int q = 0; q < 4; ++q) { const int tl_ = min(tbase + 32 + q, ntile - 1); const _Float16* kp = KI + (size_t)(b * SEQ + tl_ * 32 + r32) * 32 + 8 * hh; nk0[q] = *(const half8_t*)kp; nk1[q] = *(const half8_t*)(kp + 16); }
                }
#pragma unroll
                for (int q = 0; q < 4; ++q) {
                const int tile = tbase + q;
                if (tile < ntile) {
                const half8_t b0 = kb0[q], b1 = kb1[q];
                const bool full = tile * 32 + 31 <= t0;
#pragma unroll
                for (int rg = 0; rg < 2; ++rg) {
                    const int tbA = hh ? thr_bin[4 * rg + 1] : thr_bin[4 * rg], tbB = hh ? thr_bin[4 * rg + 3] : thr_bin[4 * rg + 2];
                    if (pass == 0) { if (full) d1_unit<false, true>(a0[rg], a1[rg], b0, b1, w[rg], rg, hh, r32, tile, t0, hist, maskl, misc, cand, 0, 0);
                                     else d1_unit<false, false>(a0[rg], a1[rg], b0, b1, w[rg], rg, hh, r32, tile, t0, hist, maskl, misc, cand, 0, 0); }
                    else { if (full) d1_unit<true, true>(a0[rg], a1[rg], b0, b1, w[rg], rg, hh, r32, tile, t0, hist, maskl, misc, cand, tbA, tbB);
                           else d1_unit<true, false>(a0[rg], a1[rg], b0, b1, w[rg], rg, hh, r32, tile, t0, hist, maskl, misc, cand, tbA, tbB); }
                }
                }
                }
            }
            __syncthreads();
            if (pass == 0) {
                const unsigned* hrw = hist + wv * 2048; unsigned tot = 0;
                { const uint4* h4 = (const uint4*)(hrw + 32 * lane);
#pragma unroll
                  for (int i = 0; i < 8; ++i) { const uint4 v = h4[i]; tot += (v.x & 0xffffu) + (v.x >> 16) + (v.y & 0xffffu) + (v.y >> 16) + (v.z & 0xffffu) + (v.z >> 16) + (v.w & 0xffffu) + (v.w >> 16); } }
                unsigned suf = tot;
#pragma unroll
                for (int o = 1; o < 64; o <<= 1) { const unsigned oth = __shfl_down(suf, o); if (lane + o < 64) suf += oth; }
                const unsigned above = suf - tot;
                const unsigned long long hit = __ballot((int)above < TOPK && TOPK <= (int)(above + tot));
                const int lsel = __ffsll((long long)hit) - 1; const unsigned above_g = __shfl(above, lsel);
                const unsigned wd = hrw[32 * lsel + (lane >> 1)]; const unsigned cnt = (lane & 1) ? (wd >> 16) : (wd & 0xffffu);
                unsigned s2 = cnt;
#pragma unroll
                for (int o = 1; o < 64; o <<= 1) { const unsigned oth = __shfl_down(s2, o); if (lane + o < 64) s2 += oth; }
                const unsigned ab2 = above_g + s2 - cnt;
                if ((int)ab2 < TOPK && TOPK <= (int)(ab2 + cnt)) { misc[wv * 8] = 64 * lsel + lane; misc[wv * 8 + 1] = TOPK - (int)ab2; }
                __syncthreads();
            }
        }
        if (tid == 0) nxt = atomicAdd(qhead, 1);
        {
            const int row = wv, need0 = misc[row * 8 + 1]; const int cn = min(misc[row * 8 + 2], CCAP);
            const uint2* cr = cand + row * CCAP; unsigned* hrow = h2 + row * 256;
            unsigned prefix = 0; int remaining = need0, cnt_eq = cn;
#pragma unroll 1
            for (int pass = 0; pass < 3; ++pass) {
                const int shift = (pass == 0) ? 12 : ((pass == 1) ? 4 : 0), nb = (pass == 2) ? 4 : 8;
                for (int i = lane; i < 256; i += 64) hrow[i] = 0u;
                __builtin_amdgcn_wave_barrier(); asm volatile("s_waitcnt lgkmcnt(0)" ::: "memory");
                for (int i = lane; i < cn; i += 64) { const unsigned k = cr[i].x & 0xfffffu; if (pass == 0 || (k >> (shift + nb)) == (prefix >> (shift + nb))) atomicAdd(&hrow[(k >> shift) & ((1u << nb) - 1u)], 1u); }
                __builtin_amdgcn_wave_barrier(); asm volatile("s_waitcnt lgkmcnt(0)" ::: "memory");
                const unsigned h0 = hrow[4 * lane], h1 = hrow[4 * lane + 1], h2_ = hrow[4 * lane + 2], h3 = hrow[4 * lane + 3];
                unsigned suf = h0 + h1 + h2_ + h3;
#pragma unroll
                for (int o = 1; o < 64; o <<= 1) { const unsigned oth = __shfl_down(suf, o); if (lane + o < 64) suf += oth; }
                const unsigned above3 = suf - (h0 + h1 + h2_ + h3);
                const unsigned ab[4] = {above3 + h3 + h2_ + h1, above3 + h3 + h2_, above3 + h3, above3}; const unsigned hv[4] = {h0, h1, h2_, h3};
                int selbin = -1, newrem = 0, neweq = 0;
#pragma unroll
                for (int q = 0; q < 4; ++q) if ((int)ab[q] < remaining && remaining <= (int)(ab[q] + hv[q])) { selbin = 4 * lane + q; newrem = remaining - (int)ab[q]; neweq = (int)hv[q]; }
                const unsigned long long has = __ballot(selbin >= 0); const int src = __ffsll((long long)has) - 1;
                selbin = __shfl(selbin, src); newrem = __shfl(newrem, src); neweq = __shfl(neweq, src);
                prefix |= ((unsigned)selbin) << shift; remaining = newrem; cnt_eq = neweq;
            }
            for (int i0 = 0; i0 < cn; i0 += 64) { const int i = i0 + lane; bool sel = false;
                if (i < cn) { const uint2 ce = cr[i]; const unsigned k = ce.x & 0xfffffu;
                    if (k > prefix) sel = true;
                    else if (k == prefix) { if (cnt_eq == remaining) sel = true; else { int rank = 0; for (int j = 0; j < cn; ++j) { const uint2 cj = cr[j]; rank += ((cj.x & 0xfffffu) == prefix && cj.y < ce.y) ? 1 : 0; } sel = rank < remaining; } }
                    if (sel) atomicOr(&maskl[row * 256 + (ce.y >> 5)], 1u << (ce.y & 31)); } }
        }
        __syncthreads();
        for (int e = tid; e < 8 * nwords; e += NTHR) { const int row = e / nwords, w2 = e % nwords; MASK32[(size_t)(tq0 + row) * 256 + w2] = maskl[row * 256 + w2]; }
        if (tid == 0) qslot[(it & 1) ^ 1] = nxt;
    }
}

__device__ void knorm_tile(const P& p, int pm, int pn) {
    bf16_t* Kg = (bf16_t*)(p.ws + WS_K); const float* kg = p.in[9];
    const int tid = otid();
    for (int pr = tid; pr < 1024; pr += NTHR) {
        const int row = pm * 256 + (pr >> 2), head = pn * 4 + (pr & 3);
        uint4* ptr = (uint4*)(Kg + (size_t)row * AW + head * 64);
        uint4 v[8]; float ss = 0.f;
#pragma unroll
        for (int c = 0; c < 8; ++c) { v[c] = ptr[c]; const unsigned w[4] = {v[c].x, v[c].y, v[c].z, v[c].w};
#pragma unroll
            for (int e = 0; e < 4; ++e) { const float a = __uint_as_float(w[e] << 16), b2 = __uint_as_float(w[e] & 0xffff0000u); ss += a * a + b2 * b2; } }
        const float rstd = rsqrtf(ss * (1.f / 64.f) + NORM_EPS);
#pragma unroll
        for (int c = 0; c < 8; ++c) { const unsigned w[4] = {v[c].x, v[c].y, v[c].z, v[c].w}; unsigned o[4];
            const float4 g0 = *(const float4*)(kg + 8 * c), g1 = *(const float4*)(kg + 8 * c + 4); const float gv[8] = {g0.x, g0.y, g0.z, g0.w, g1.x, g1.y, g1.z, g1.w};
#pragma unroll
            for (int e = 0; e < 4; ++e) o[e] = pk2(__uint_as_float(w[e] << 16) * rstd * gv[2 * e], __uint_as_float(w[e] & 0xffff0000u) * rstd * gv[2 * e + 1]);
            ptr[c] = make_uint4(o[0], o[1], o[2], o[3]); }
    }
}
typedef unsigned u32x4_t __attribute__((ext_vector_type(4)));
__device__ __forceinline__ bf16x8_t pack_step16(const f32x16_t& x, int s2) {
    u32x4_t pk;
    if (s2 == 0) { pk[0] = pk_bf16(x[0], x[1]); pk[1] = pk_bf16(x[2], x[3]); pk[2] = pk_bf16(x[4], x[5]); pk[3] = pk_bf16(x[6], x[7]); }
    else { pk[0] = pk_bf16(x[8], x[9]); pk[1] = pk_bf16(x[10], x[11]); pk[2] = pk_bf16(x[12], x[13]); pk[3] = pk_bf16(x[14], x[15]); }
    return __builtin_bit_cast(bf16x8_t, pk);
}
__device__ __forceinline__ float xhalf_max(float x) { const auto t = __builtin_amdgcn_permlane32_swap(__float_as_uint(x), __float_as_uint(x), false, false); return fmaxf(__uint_as_float(t[0]), __uint_as_float(t[1])); }
__device__ __forceinline__ float xhalf_sum(float x) { const auto t = __builtin_amdgcn_permlane32_swap(__float_as_uint(x), __float_as_uint(x), false, false); return __uint_as_float(t[0]) + __uint_as_float(t[1]); }
__device__ __forceinline__ short bf16_of_int(int v) { return (short)(__float_as_uint((float)v) >> 16); }
#define MFMA32(a, b, c) __builtin_amdgcn_mfma_f32_32x32x16_bf16((a), (b), (c), 0, 0, 0)
__device__ void ph_dsa_attn(const P& p, float* ldsf) {
    const unsigned long long* MASK = (const unsigned long long*)(p.ws + WS_MASK);
    const bf16_t* Q = (const bf16_t*)(p.ws + WS_Q); const bf16_t* Kg = (const bf16_t*)(p.ws + WS_K); const bf16_t* VT = (const bf16_t*)(p.ws + WS_V);
    bf16_t* O = (bf16_t*)(p.ws + WS_OATT);
    bf16_t* L = (bf16_t*)ldsf;
    const int tid = otid(), lane = tid & 63, wv = tid >> 6, hh = lane >> 5, r32 = lane & 31;
    const float CS = 0.125f * 1.4426950408889634f;
    const float NEG = -1e30f;
    const int skey = tid >> 3, sch = (tid & 7) * 8;
    const float* qg = p.in[8];
    float kgmax; { const float v = fabsf(p.in[9][lane]); kgmax = wave_max(v); }
    int* qhead = (int*)(p.ws + WS_CTL) + CT_Q; int* bcast = (int*)(L + 4 * SLOT); int* sflag = bcast + 4;
    for (int tr_ = 0; tr_ < 8; ++tr_) {
        const int grp = (blockIdx.x + tr_) & 7;
        for (;;) {
            __syncthreads();
            if (tid == 0) *bcast = atomicAdd(qhead + grp, 1);
            __syncthreads();
            const int kq = *bcast;
            if (kq >= (grp >= 6 ? 96 : 64)) break;
            int bh, qb, part;
            if (grp < 6) { bh = grp + 8 * (kq & 1); qb = 31 - (kq >> 1); part = 0; }
            else if (kq < 32) { bh = grp + 8 * (kq & 1); qb = 31 - (kq >> 1); part = 1; }
            else { const int k2 = kq - 32, j = k2 >> 2, r = k2 & 3; bh = grp + 8 * (r & 1); if (r < 2) { qb = 31 - j; part = 2; } else { qb = 15 - j; part = 0; } }
            const int b = bh >> 3, h = bh & 7;
            const bf16_t* Kbase = Kg + (size_t)b * SEQ * AW + h * 64; const bf16_t* Vbase = VT + (size_t)bh * 64 * SEQ;
            {
            const int q0 = qb * 256 + wv * 32, q = q0 + r32, ntile = 4 * (qb + 1);
            const int kt_hi = (part == 2) ? ntile - 65 : ntile - 1, kt_lo = (part == 1) ? ntile - 64 : 0;
            const size_t qrow = (size_t)b * SEQ + q;
            bf16x8_t bq[5]; float qk_bound;
#pragma unroll
            for (int s2 = 0; s2 < 4; ++s2) bq[s2] = *(const bf16x8_t*)(Q + qrow * AW + h * 64 + 16 * s2 + 8 * hh);
            {
                float ss = 0.f;
#pragma unroll
                for (int s2 = 0; s2 < 4; ++s2)
#pragma unroll
                    for (int j = 0; j < 8; ++j) { const float v = bf2f((bf16_t)bq[s2][j]); ss += v * v; }
                ss = xhalf_sum(ss);
                const float rstd = rsqrtf(ss * (1.f / 64.f) + NORM_EPS);
                float qq = 0.f;
#pragma unroll
                for (int s2 = 0; s2 < 4; ++s2) { const float4 g0 = *(const float4*)(qg + 16 * s2 + 8 * hh), g1 = *(const float4*)(qg + 16 * s2 + 8 * hh + 4); const float gv[8] = {g0.x, g0.y, g0.z, g0.w, g1.x, g1.y, g1.z, g1.w};
                    u32x4_t w;
#pragma unroll
                    for (int j2 = 0; j2 < 4; ++j2) { const float e0 = bf2f((bf16_t)bq[s2][2 * j2]) * rstd * gv[2 * j2], e1 = bf2f((bf16_t)bq[s2][2 * j2 + 1]) * rstd * gv[2 * j2 + 1]; qq += e0 * e0 + e1 * e1; w[j2] = pk_bf16(e0, e1); }
                    bq[s2] = __builtin_bit_cast(bf16x8_t, w); }
                qk_bound = sqrtf(xhalf_sum(qq)) * kgmax * 1.03f;
            }
#pragma unroll
            for (int j = 0; j < 8; ++j) bq[4][j] = 0;
            if (hh == 0) { bq[4][0] = bf16_of_int(256 >> h); bq[4][1] = (short)(__float_as_uint(4.f / (float)(1 << h)) >> 16); }
            f32x16_t o0, o1;
#pragma unroll
            for (int i = 0; i < 16; ++i) { o0[i] = 0.f; o1[i] = 0.f; }
            float m_run = NEG, l_run = 0.f;
            __syncthreads();
            const float slope_l2 = 1.4426950408889634f / (float)(2 << h);
            { const int kt0 = kt_hi; const uint4 kr = *(const uint4*)(Kbase + (size_t)(kt0 * 64 + skey) * AW + sch), vr = *(const uint4*)(Vbase + (size_t)skey * SEQ + kt0 * 64 + sch);
              *(uint4*)(L + (kt0 & 1) * SLOT + skey * LP + sch) = kr; *(uint4*)(L + (2 + (kt0 & 1)) * SLOT + skey * LP + sch) = vr; }
            unsigned long long mw = MASK[qrow * 128 + kt_hi];
            if (tid < 16) sflag[tid] = 0;
            __syncthreads();
#pragma unroll 1
            for (int kt = kt_hi; kt >= kt_lo; --kt) {
                const int buf = kt & 1; const bool more = kt > kt_lo;
                if (kt < kt_hi) { int alld = 1;
#pragma unroll
                    for (int w2 = 0; w2 < 8; ++w2) alld &= sflag[((kt + 1) & 1) * 8 + w2];
                    if (alld) break; }
                uint4 kr = make_uint4(0, 0, 0, 0), vr = make_uint4(0, 0, 0, 0); unsigned long long mwn = 0ull;
                if (more) { kr = *(const uint4*)(Kbase + (size_t)((kt - 1) * 64 + skey) * AW + sch); vr = *(const uint4*)(Vbase + (size_t)skey * SEQ + (kt - 1) * 64 + sch); mwn = MASK[qrow * 128 + kt - 1]; }
                if (kt * 64 <= q0 + 31) {
                    const bf16_t* Kl = L + buf * SLOT; const bf16_t* Vl = L + (2 + buf) * SLOT;
                    f32x16_t p0, p1;
#pragma unroll
                    for (int i = 0; i < 16; ++i) { p0[i] = 0.f; p1[i] = 0.f; }
#pragma unroll
                    for (int s2 = 0; s2 < 4; ++s2) {
                        const bf16x8_t a0 = *(const bf16x8_t*)(Kl + r32 * LP + 16 * s2 + 8 * hh), a1 = *(const bf16x8_t*)(Kl + (32 + r32) * LP + 16 * s2 + 8 * hh);
                        p0 = MFMA32(a0, bq[s2], p0); p1 = MFMA32(a1, bq[s2], p1);
                    }
                    { bf16x8_t g0, g1;
#pragma unroll
                      for (int j = 0; j < 8; ++j) { g0[j] = 0; g1[j] = 0; }
                      if (hh == 0) { g0[0] = bf16_of_int(kt); g0[1] = bf16_of_int(r32); g1[0] = g0[0]; g1[1] = bf16_of_int(32 + r32); }
                      p0 = MFMA32(g0, bq[4], p0); p1 = MFMA32(g1, bq[4], p1); }
                    const unsigned wl = (unsigned)mw >> (4 * hh), wh = (unsigned)(mw >> 32) >> (4 * hh);
                    float mx = NEG;
#pragma unroll
                    for (int i = 0; i < 16; ++i) { const int bp = (i & 3) + 8 * (i >> 2);
                        const int m0 = __builtin_amdgcn_sbfe((int)wl, bp, 1), m1 = __builtin_amdgcn_sbfe((int)wh, bp, 1);
                        const float a_ = __uint_as_float((__float_as_uint(p0[i]) & (unsigned)m0) | (__float_as_uint(NEG) & ~(unsigned)m0));
                        const float b_ = __uint_as_float((__float_as_uint(p1[i]) & (unsigned)m1) | (__float_as_uint(NEG) & ~(unsigned)m1));
                        p0[i] = a_; p1[i] = b_;
                        mx = __builtin_fmaxf(mx, __builtin_fmaxf(a_, b_)); }
                    mx = xhalf_max(mx);
                    const float m_new = fmaxf(m_run, mx);
                    const float alpha = __builtin_amdgcn_exp2f((m_run - m_new) * CS);
                    m_run = m_new;
                    const float mc = fmaxf(m_new, -1e20f) * CS;
                    float rs = 0.f;
#pragma unroll
                    for (int i = 0; i < 16; ++i) { p0[i] = __builtin_amdgcn_exp2f(p0[i] * CS - mc); p1[i] = __builtin_amdgcn_exp2f(p1[i] * CS - mc); rs += p0[i] + p1[i]; }
                    l_run = l_run * alpha + rs;
#pragma unroll
                    for (int i = 0; i < 16; ++i) { o0[i] *= alpha; o1[i] *= alpha; }
                    bf16x8_t pb[4];
                    pb[0] = pack_step16(p0, 0); pb[1] = pack_step16(p0, 1); pb[2] = pack_step16(p1, 0); pb[3] = pack_step16(p1, 1);
#pragma unroll
                    for (int ks = 0; ks < 4; ++ks) {
                        const int kofs = 32 * (ks >> 1) + 16 * (ks & 1) + 4 * hh;
                        typedef short s16x4_t __attribute__((ext_vector_type(4)));
                        const s16x4_t v00 = *(const s16x4_t*)(Vl + r32 * LP + kofs), v01 = *(const s16x4_t*)(Vl + r32 * LP + kofs + 8);
                        const s16x4_t v10 = *(const s16x4_t*)(Vl + (32 + r32) * LP + kofs), v11 = *(const s16x4_t*)(Vl + (32 + r32) * LP + kofs + 8);
                        bf16x8_t av0, av1;
#pragma unroll
                        for (int j = 0; j < 4; ++j) { av0[j] = v00[j]; av0[4 + j] = v01[j]; av1[j] = v10[j]; av1[4 + j] = v11[j]; }
                        o0 = MFMA32(av0, pb[ks], o0); o1 = MFMA32(av1, pb[ks], o1);
                    }
                }
                if (more) { *(uint4*)(L + (buf ^ 1) * SLOT + skey * LP + sch) = kr; *(uint4*)(L + (2 + (buf ^ 1)) * SLOT + skey * LP + sch) = vr; }
                mw = mwn;
                {
                    const bool row_done = (qk_bound * 1.4426950408889634f + slope_l2 * (float)(64 * kt - 1)) < m_run * CS - 56.f;
                    const int wdone = __all(row_done) ? 1 : 0;
                    if (lane == 0) sflag[(kt & 1) * 8 + wv] = wdone;
                }
                __syncthreads();
            }
            const float l_tot = xhalf_sum(l_run);
            const float inv = l_tot > 0.f ? 1.f / l_tot : 0.f;
            bf16_t* orow = O + qrow * AW + h * 64 + 4 * hh;
            if (part) {
                const size_t prow = (size_t)((b * 2 + (h - 6)) * 4096 + (q - 4096));
                if (hh == 0) ((float2*)(p.ws + WS_AML))[(size_t)(part - 1) * 16384 + prow] = make_float2(m_run, l_tot);
                if (part == 2) orow = (bf16_t*)(p.ws + WS_OFAR) + prow * 64 + 4 * hh;
            }
#pragma unroll
            for (int g = 0; g < 4; ++g) {
                uint2 w0, w1;
                w0.x = (unsigned)f2bf(o0[4 * g] * inv) | ((unsigned)f2bf(o0[4 * g + 1] * inv) << 16); w0.y = (unsigned)f2bf(o0[4 * g + 2] * inv) | ((unsigned)f2bf(o0[4 * g + 3] * inv) << 16);
                w1.x = (unsigned)f2bf(o1[4 * g] * inv) | ((unsigned)f2bf(o1[4 * g + 1] * inv) << 16); w1.y = (unsigned)f2bf(o1[4 * g + 2] * inv) | ((unsigned)f2bf(o1[4 * g + 3] * inv) << 16);
                *(uint2*)(orow + 8 * g) = w0; *(uint2*)(orow + 32 + 8 * g) = w1;
            }
            }
        }
    }
}

__device__ void ph_attn_merge(const P& p) {
    bf16_t* O = (bf16_t*)(p.ws + WS_OATT); const bf16_t* OF = (const bf16_t*)(p.ws + WS_OFAR); const float2* ML = (const float2*)(p.ws + WS_AML);
    const float CS = 0.125f * 1.4426950408889634f;
    const int tid = otid();
    for (int i = blockIdx.x * NTHR + tid; i < 16384 * 8; i += gridDim.x * NTHR) {
        const int prow = i >> 3, c8 = (i & 7) * 8, bhx = prow >> 12, q = 4096 + (prow & 4095), b = bhx >> 1, h = 6 + (bhx & 1);
        const float2 n_ = ML[prow], f_ = ML[16384 + prow];
        const float mm = fmaxf(n_.x, f_.x);
        const float wn = n_.y * __builtin_amdgcn_exp2f((n_.x - mm) * CS), wf = f_.y * __builtin_amdgcn_exp2f((f_.x - mm) * CS);
        const float inv = (wn + wf) > 0.f ? 1.f / (wn + wf) : 0.f, a_ = wn * inv, b_ = wf * inv;
        bf16_t* op = O + ((size_t)b * SEQ + q) * AW + h * 64 + c8;
        const uint4 on = *(const uint4*)op, of = *(const uint4*)(OF + (size_t)prow * 64 + c8);
        const unsigned wn_[4] = {on.x, on.y, on.z, on.w}, wf_[4] = {of.x, of.y, of.z, of.w}; unsigned o[4];
#pragma unroll
        for (int e = 0; e < 4; ++e) o[e] = pk2(a_ * __uint_as_float(wn_[e] << 16) + b_ * __uint_as_float(wf_[e] << 16), a_ * __uint_as_float(wn_[e] & 0xffff0000u) + b_ * __uint_as_float(wf_[e] & 0xffff0000u));
        *(uint4*)op = make_uint4(o[0], o[1], o[2], o[3]);
    }
}
constexpr int AP = 328, KP = 520, OBP = 72, ODP = 68;
__device__ __forceinline__ f32x4_t mm16(const bf16_t* X, int xrs, const bf16_t* Y, int ycs, int nks, f32x4_t acc, int lane) {
    const int r = lane & 15, q = lane >> 4;
    for (int s2 = 0; s2 < nks; ++s2) {
        const bf16x8_t a = *(const bf16x8_t*)(X + r * xrs + 32 * s2 + 8 * q), b = *(const bf16x8_t*)(Y + r * ycs + 32 * s2 + 8 * q);
        acc = __builtin_amdgcn_mfma_f32_16x16x32_bf16(a, b, acc, 0, 0, 0);
    }
    return acc;
}
__device__ void ph_rwkv_prep(const P& p, float* ldsf, int blk_first, int blk_end, int blk_step) {
    const bf16_t* PS = (const bf16_t*)(p.ws + WS_PS);
    const float* mu = p.in[10]; const float* w0 = p.in[11]; const float* a0 = p.in[13]; const float* k_k = p.in[16]; const float* k_a = p.in[17];
    const bf16_t* W2T = (const bf16_t*)(p.ws + WS_LW2T); const bf16_t* A2T = (const bf16_t*)(p.ws + WS_LA2T); const bf16_t* G2T = (const bf16_t*)(p.ws + WS_LG2T);
    bf16_t* R = (bf16_t*)(p.ws + WS_R); bf16_t* K2 = (bf16_t*)(p.ws + WS_K2); bf16_t* VV = (bf16_t*)(p.ws + WS_VV); bf16_t* KK = (bf16_t*)(p.ws + WS_KK); bf16_t* BB = (bf16_t*)(p.ws + WS_BB);
    bf16_t* G = (bf16_t*)(p.ws + WS_G); float* DD = (float*)(p.ws + WS_DD);
    const int tid = otid(), lane = tid & 63, wv = tid >> 6, l15 = lane & 15, q4 = lane >> 4;
    bf16_t* Amix = (bf16_t*)ldsf; bf16_t* Kbuf = Amix + 32 * AP;
    bf16_t* KKo = Kbuf + 32 * KP + wv * (3 * 16 * OBP + 2 * 16 * ODP); bf16_t* BBo = KKo + 16 * OBP; bf16_t* Go = BBo + 16 * OBP; float* DDo = (float*)(Go + 16 * OBP);
    for (int blk = blk_first; blk < blk_end; blk += blk_step) {
        const int m0 = blk * 32;
        __syncthreads();
        if (tid < 456) {
            const int cc = tid % 228, th = tid / 228, c8 = cc * 8;
            const float4 mu0 = *(const float4*)(mu + c8), mu1 = *(const float4*)(mu + c8 + 4); const float muv[8] = {mu0.x, mu0.y, mu0.z, mu0.w, mu1.x, mu1.y, mu1.z, mu1.w};
            const bf16_t* src = PS + (size_t)(m0 + 16 * th) * SHW + c8;
            uint4 pv = make_uint4(0, 0, 0, 0); if ((m0 + 16 * th) % SEQ) pv = *(const uint4*)(src - SHW);
#pragma unroll 1
            for (int bt = 0; bt < 2; ++bt) {
                uint4 cu[8];
#pragma unroll
                for (int i = 0; i < 8; ++i) cu[i] = *(const uint4*)(src + (size_t)(8 * bt + i) * SHW);
#pragma unroll
                for (int i = 0; i < 8; ++i) {
                    const int tk = 16 * th + 8 * bt + i;
                    const unsigned cw[4] = {cu[i].x, cu[i].y, cu[i].z, cu[i].w}, pw[4] = {pv.x, pv.y, pv.z, pv.w};
                    float mx[8];
#pragma unroll
                    for (int e = 0; e < 8; ++e) { const float c_ = (e & 1) ? __uint_as_float(cw[e >> 1] & 0xffff0000u) : __uint_as_float(cw[e >> 1] << 16), p_ = (e & 1) ? __uint_as_float(pw[e >> 1] & 0xffff0000u) : __uint_as_float(pw[e >> 1] << 16);
                        mx[e] = c_ + (p_ - c_) * muv[e]; }
                    pv = cu[i];
                    if (cc >= 192) { const int col = c8 - 1536;
#pragma unroll
                        for (int e = 0; e < 8; ++e) mx[e] = (col < 64) ? (1.f - 2.f * __builtin_amdgcn_rcpf(__expf(2.f * mx[e]) + 1.f)) : ((col < 128) ? mx[e] : sigmoidf_(mx[e])); }
                    const uint4 o = make_uint4(pk2(mx[0], mx[1]), pk2(mx[2], mx[3]), pk2(mx[4], mx[5]), pk2(mx[6], mx[7]));
                    if (cc < 64) *(uint4*)(R + (size_t)(m0 + tk) * RW + c8) = o;
                    else if (cc < 128) *(uint4*)(Kbuf + tk * KP + (c8 - 512)) = o;
                    else if (cc < 192) *(uint4*)(VV + (size_t)(m0 + tk) * RW + (c8 - 1024)) = o;
                    else *(uint4*)(Amix + tk * AP + (c8 - 1536)) = o;
                }
            }
        }
        if (tid < 128) *(uint4*)(Amix + (tid >> 2) * AP + 288 + (tid & 3) * 8) = make_uint4(0, 0, 0, 0);
        __syncthreads();
        const int h = wv;
        float rn[2];
#pragma unroll
        for (int rt = 0; rt < 2; ++rt) { const int tk = 16 * rt + l15; float ss = 0.f;
#pragma unroll
            for (int ct = 0; ct < 4; ++ct) { const int c0 = 64 * h + 16 * ct + 4 * q4; const float4 kkc = *(const float4*)(k_k + c0); const uint2 kw = *(const uint2*)(Kbuf + tk * KP + c0);
                const float e0 = __uint_as_float(kw.x << 16) * kkc.x, e1 = __uint_as_float(kw.x & 0xffff0000u) * kkc.y, e2 = __uint_as_float(kw.y << 16) * kkc.z, e3 = __uint_as_float(kw.y & 0xffff0000u) * kkc.w;
                ss += (e0 * e0 + e1 * e1) + (e2 * e2 + e3 * e3); }
            ss += __shfl_xor(ss, 16); ss += __shfl_xor(ss, 32);
            rn[rt] = __builtin_amdgcn_rcpf(fmaxf(sqrtf(ss), 1e-12f)); }
#pragma unroll 1
        for (int rt = 0; rt < 2; ++rt) {
            const int tk = 16 * rt + l15; const bf16_t* xr = Amix + tk * AP + 8 * q4; const float rnv = rt ? rn[1] : rn[0];
#pragma unroll 1
            for (int ct = 0; ct < 4; ++ct) {
                const int cb = 64 * h + 16 * ct, c0 = cb + 4 * q4;
                const bf16_t* yw = W2T + (size_t)(cb + l15) * 64 + 8 * q4; const bf16_t* ya = A2T + (size_t)(cb + l15) * 64 + 8 * q4; const bf16_t* yg = G2T + (size_t)(cb + l15) * 192 + 8 * q4;
                bf16x8_t fw[2], fa[2], fg[6];
#pragma unroll
                for (int s2 = 0; s2 < 2; ++s2) { fw[s2] = *(const bf16x8_t*)(yw + 32 * s2); fa[s2] = *(const bf16x8_t*)(ya + 32 * s2); }
#pragma unroll
                for (int s2 = 0; s2 < 6; ++s2) fg[s2] = *(const bf16x8_t*)(yg + 32 * s2);
                const float4 cw0 = *(const float4*)(w0 + c0), ca0 = *(const float4*)(a0 + c0), cka = *(const float4*)(k_a + c0), ckk = *(const float4*)(k_k + c0);
                const float w0v[4] = {cw0.x, cw0.y, cw0.z, cw0.w}, a0v[4] = {ca0.x, ca0.y, ca0.z, ca0.w}, kav[4] = {cka.x, cka.y, cka.z, cka.w}, kkc[4] = {ckk.x, ckk.y, ckk.z, ckk.w};
                f32x4_t cw = {0.f, 0.f, 0.f, 0.f}, ca = cw, cg = cw;
#pragma unroll
                for (int s2 = 0; s2 < 2; ++s2) { cw = __builtin_amdgcn_mfma_f32_16x16x32_bf16(fw[s2], *(const bf16x8_t*)(xr + 32 * s2), cw, 0, 0, 0); ca = __builtin_amdgcn_mfma_f32_16x16x32_bf16(fa[s2], *(const bf16x8_t*)(xr + 64 + 32 * s2), ca, 0, 0, 0); }
#pragma unroll
                for (int s2 = 0; s2 < 6; ++s2) cg = __builtin_amdgcn_mfma_f32_16x16x32_bf16(fg[s2], *(const bf16x8_t*)(xr + 128 + 32 * s2), cg, 0, 0, 0);
                bf16_t* kp = Kbuf + tk * KP + c0;
                const uint2 kw2 = *(const uint2*)kp;
                const float kf[4] = {__uint_as_float(kw2.x << 16), __uint_as_float(kw2.x & 0xffff0000u), __uint_as_float(kw2.y << 16), __uint_as_float(kw2.y & 0xffff0000u)};
                float k2v[4], kkv[4], bbv[4], ddv[4];
#pragma unroll
                for (int e = 0; e < 4; ++e) {
                    const float xw = -(w0v[e] + cw[e]);
                    const float sp = fmaxf(xw, 0.f) + __logf(1.f + __expf(-fabsf(xw)));
                    const float w = -sp - 0.5f;
                    const float a = sigmoidf_(a0v[e] + ca[e]);
                    kkv[e] = kf[e] * kkc[e] * rnv; bbv[e] = kkv[e] * a; k2v[e] = kf[e] * (1.f + (a - 1.f) * kav[e]); ddv[e] = -__expf(w); }
                *(uint2*)kp = make_uint2(pk2(k2v[0], k2v[1]), pk2(k2v[2], k2v[3]));
                *(uint2*)(KKo + l15 * OBP + 16 * ct + 4 * q4) = make_uint2(pk2(kkv[0], kkv[1]), pk2(kkv[2], kkv[3]));
                *(uint2*)(BBo + l15 * OBP + 16 * ct + 4 * q4) = make_uint2(pk2(bbv[0], bbv[1]), pk2(bbv[2], bbv[3]));
                *(uint2*)(Go + l15 * OBP + 16 * ct + 4 * q4) = make_uint2(pk2(cg[0], cg[1]), pk2(cg[2], cg[3]));
                *(float4*)(DDo + l15 * ODP + 16 * ct + 4 * q4) = make_float4(ddv[0], ddv[1], ddv[2], ddv[3]);
            }
            __builtin_amdgcn_fence(__ATOMIC_ACQ_REL, "wavefront"); __builtin_amdgcn_wave_barrier();
            {
                const int rb = lane >> 3, cb8 = (lane & 7) * 8;
#pragma unroll
                for (int i = 0; i < 2; ++i) { const int row = rb + 8 * i; const size_t o = (size_t)(m0 + 16 * rt + row) * RW + 64 * h + cb8;
                    *(uint4*)(K2 + o) = *(const uint4*)(Kbuf + (16 * rt + row) * KP + 64 * h + cb8);
                    *(uint4*)(KK + o) = *(const uint4*)(KKo + row * OBP + cb8);
                    *(uint4*)(BB + o) = *(const uint4*)(BBo + row * OBP + cb8);
                    *(uint4*)(G + o) = *(const uint4*)(Go + row * OBP + cb8); }
                const int rd = lane >> 4, cd4 = (lane & 15) * 4;
#pragma unroll
                for (int i = 0; i < 4; ++i) { const int row = rd + 4 * i;
                    *(float4*)(DD + (size_t)(m0 + 16 * rt + row) * RW + 64 * h + cd4) = *(const float4*)(DDo + row * ODP + cd4); }
            }
            __builtin_amdgcn_fence(__ATOMIC_ACQ_REL, "wavefront"); __builtin_amdgcn_wave_barrier();
        }
    }
}

template <bool XC, bool YC>
__device__ __forceinline__ f32x4_t mm_tile(const bf16_t* X, int xrs, int xcs, const bf16_t* Y, int yrs, int ycs, int tr, int tc, f32x4_t acc, int lane) {
    const int r = lane & 15, q = lane >> 4;
#pragma unroll
    for (int s2 = 0; s2 < 2; ++s2) {
        bf16x8_t a, b;
        const bf16_t* xp = X + (16 * tr + r) * xrs + (32 * s2 + 8 * q) * xcs;
        if (XC) a = *(const bf16x8_t*)xp; else {
#pragma unroll
            for (int j = 0; j < 8; ++j) a[j] = (short)xp[j * xcs]; }
        const bf16_t* yp = Y + (32 * s2 + 8 * q) * yrs + (16 * tc + r) * ycs;
        if (YC) b = *(const bf16x8_t*)yp; else {
#pragma unroll
            for (int j = 0; j < 8; ++j) b[j] = (short)yp[j * yrs]; }
        acc = __builtin_amdgcn_mfma_f32_16x16x32_bf16(a, b, acc, 0, 0, 0);
    }
    return acc;
}
__device__ __forceinline__ void st_tile(const f32x4_t& acc, bf16_t* D, int drs, int dcs, int tr, int tc, int lane) {
    const int row0 = 16 * tr + 4 * (lane >> 4), col = 16 * tc + (lane & 15);
#pragma unroll
    for (int e = 0; e < 4; ++e) D[(row0 + e) * drs + col * dcs] = f2bf(acc[e]);
}
__device__ __forceinline__ f32x4_t ld_tile(const bf16_t* D, int drs, int dcs, int tr, int tc, int lane) {
    const int row0 = 16 * tr + 4 * (lane >> 4), col = 16 * tc + (lane & 15); f32x4_t v;
#pragma unroll
    for (int e = 0; e < 4; ++e) v[e] = bf2f(D[(row0 + e) * drs + col * dcs]);
    return v;
}
template <bool STRICT> __device__ __forceinline__ void triu_tile(f32x4_t& acc, int tr, int tc, int lane) {
    const int row0 = 16 * tr + 4 * (lane >> 4), col = 16 * tc + (lane & 15);
#pragma unroll
    for (int e = 0; e < 4; ++e) { const bool keep = STRICT ? (row0 + e < col) : (row0 + e <= col); acc[e] = keep ? acc[e] : 0.f; }
}

__device__ void ph_rwkv_r1(const P& p, float* ldsf, int ch_first, int ch_end, int ch_step) {
    const bf16_t* R = (const bf16_t*)(p.ws + WS_R); const bf16_t* K2 = (const bf16_t*)(p.ws + WS_K2); const bf16_t* VV = (const bf16_t*)(p.ws + WS_VV);
    const bf16_t* KK = (const bf16_t*)(p.ws + WS_KK); const bf16_t* BB = (const bf16_t*)(p.ws + WS_BB); const float* DD = (const float*)(p.ws + WS_DD);
    bf16_t* L = (bf16_t*)ldsf;
    bf16_t* At = L + 0 * SLOT; bf16_t* AtT = L + 1 * SLOT; bf16_t* Bt = L + 2 * SLOT; bf16_t* Kt = L + 3 * SLOT; bf16_t* Rt = L + 4 * SLOT; bf16_t* BhT = L + 5 * SLOT; bf16_t* Kh = L + 6 * SLOT;
    bf16_t* S7 = L + 7 * SLOT; bf16_t* S8 = L + 8 * SLOT; bf16_t* S9 = L + 9 * SLOT; bf16_t* Mka = L + 10 * SLOT; bf16_t* NbrT = L + 11 * SLOT; bf16_t* Nkr = L + 12 * SLOT;
    float* cs = (float*)(L + 13 * SLOT);
    float* segs = cs + 64 * 64;
    float* gLs = segs + 8 * 64;
    const int tid = otid(), lane = tid & 63, wv = tid >> 6;
    const int t0 = 2 * wv, t1 = 2 * wv + 1;
    for (int ch = ch_first; ch < ch_end; ch += ch_step) {
        const int bh = ch >> 7, c = ch & 127, b = bh >> 3, h = bh & 7;
        const size_t gbase = ((size_t)b * SEQ + (size_t)c * 64) * RW + h * 64;
        bf16_t* G1T = (bf16_t*)(p.ws + WS_KK) + gbase; bf16_t* PT = (bf16_t*)(p.ws + WS_BB) + gbase; bf16_t* G2T = (bf16_t*)(p.ws + WS_DD) + 2 * gbase; bf16_t* QT = G2T + 64;
        __syncthreads();
        const int st = tid >> 3, sj = (tid & 7) * 8;
        const uint4 vraw = *(const uint4*)(VV + gbase + (size_t)st * RW + sj);
        const uint4 rr = *(const uint4*)(R + gbase + (size_t)st * RW + sj), kr = *(const uint4*)(K2 + gbase + (size_t)st * RW + sj);
        const uint4 kkr = *(const uint4*)(KK + gbase + (size_t)st * RW + sj), br = *(const uint4*)(BB + gbase + (size_t)st * RW + sj);
        { const float4 l0 = *(const float4*)(DD + gbase + (size_t)st * RW + sj), l1 = *(const float4*)(DD + gbase + (size_t)st * RW + sj + 4);
          float* d = cs + st * 64 + sj; *(float4*)d = l0; *(float4*)(d + 4) = l1; }
        __syncthreads();
        { const int j = tid & 63, sg = tid >> 6; float run = 0.f;
#pragma unroll
          for (int i = 0; i < 8; ++i) { run += cs[(sg * 8 + i) * 64 + j]; }
          segs[sg * 64 + j] = run; }
        __syncthreads();
        { const int j = tid & 63, sg = tid >> 6; float run = 0.f;
          for (int q = 0; q < sg; ++q) run += segs[q * 64 + j];
#pragma unroll
          for (int i = 0; i < 8; ++i) { run += cs[(sg * 8 + i) * 64 + j]; cs[(sg * 8 + i) * 64 + j] = run; }
          if (sg == 7) gLs[j] = __expf(run); }
        __syncthreads();
        {
            const unsigned rw_[4] = {rr.x, rr.y, rr.z, rr.w}, kw_[4] = {kr.x, kr.y, kr.z, kr.w}, kkw_[4] = {kkr.x, kkr.y, kkr.z, kkr.w}, bw_[4] = {br.x, br.y, br.z, br.w};
            unsigned oa[4], ob[4], ok[4], orr[4], okh[4];
#pragma unroll
            for (int e2 = 0; e2 < 4; ++e2) {
                float va[2], vb[2], vk[2], vr2[2], vbh[2], vkh[2];
#pragma unroll
                for (int hf = 0; hf < 2; ++hf) {
                    const int j = sj + 2 * e2 + hf;
                    const float lgI = cs[st * 64 + j], lgE = st ? cs[(st - 1) * 64 + j] : 0.f, gl = cs[63 * 64 + j];
                    const float rv = hf ? __uint_as_float(rw_[e2] & 0xffff0000u) : __uint_as_float(rw_[e2] << 16);
                    const float kv = hf ? __uint_as_float(kw_[e2] & 0xffff0000u) : __uint_as_float(kw_[e2] << 16);
                    const float kkv = hf ? __uint_as_float(kkw_[e2] & 0xffff0000u) : __uint_as_float(kkw_[e2] << 16);
                    const float bv = hf ? __uint_as_float(bw_[e2] & 0xffff0000u) : __uint_as_float(bw_[e2] << 16);
                    const float einv = __expf(-lgI), eh = __expf(gl - lgI);
                    va[hf] = -kkv * __expf(lgE); vb[hf] = bv * einv; vk[hf] = kv * einv; vr2[hf] = rv * __expf(lgI); vbh[hf] = bv * eh; vkh[hf] = kv * eh;
                    AtT[j * LP + st] = f2bf(va[hf]); BhT[j * LP + st] = f2bf(vbh[hf]);
                }
                oa[e2] = pk2(va[0], va[1]); ob[e2] = pk2(vb[0], vb[1]); ok[e2] = pk2(vk[0], vk[1]); orr[e2] = pk2(vr2[0], vr2[1]); okh[e2] = pk2(vkh[0], vkh[1]);
            }
            *(uint4*)(At + st * LP + sj) = make_uint4(oa[0], oa[1], oa[2], oa[3]); *(uint4*)(Bt + st * LP + sj) = make_uint4(ob[0], ob[1], ob[2], ob[3]);
            *(uint4*)(Kt + st * LP + sj) = make_uint4(ok[0], ok[1], ok[2], ok[3]); *(uint4*)(Rt + st * LP + sj) = make_uint4(orr[0], orr[1], orr[2], orr[3]);
            *(uint4*)(Kh + st * LP + sj) = make_uint4(okh[0], okh[1], okh[2], okh[3]);
        }
        __syncthreads();
#define R1_FOR_TILES(idx, tr, tc) _Pragma("unroll") for (int _q = 0; _q < 2; ++_q) { const int idx = _q ? t1 : t0; const int tr = idx >> 2, tc = idx & 3;
#define R1_END }
#define MMF(X, Y, acc) mm_tile<true, true>((X), LP, 1, (Y), 1, LP, tr, tc, (acc), lane)
        const f32x4_t zero4 = {0.f, 0.f, 0.f, 0.f};
        R1_FOR_TILES(idx, tr, tc)
            f32x4_t mab = MMF(Bt, At, zero4); triu_tile<true>(mab, tr, tc, lane); st_tile(mab, S7, LP, 1, tr, tc, lane); st_tile(mab, S8, 1, LP, tr, tc, lane);
            { f32x4_t tt = mab; const int row0 = 16 * tr + 4 * (lane >> 4), col = 16 * tc + (lane & 15);
#pragma unroll
              for (int e = 0; e < 4; ++e) tt[e] += (row0 + e == col) ? 1.f : 0.f;
              st_tile(tt, S9, LP, 1, tr, tc, lane); }
            f32x4_t mka = MMF(Kt, At, zero4); triu_tile<true>(mka, tr, tc, lane); st_tile(mka, Mka, LP, 1, tr, tc, lane);
            f32x4_t nbr = MMF(Bt, Rt, zero4); triu_tile<false>(nbr, tr, tc, lane); st_tile(nbr, NbrT, 1, LP, tr, tc, lane);
            f32x4_t nkr = MMF(Kt, Rt, zero4); triu_tile<false>(nkr, tr, tc, lane); st_tile(nkr, Nkr, LP, 1, tr, tc, lane);
        R1_END
        __syncthreads();
        bf16_t* VmT = At;
        { const unsigned vw_[4] = {vraw.x, vraw.y, vraw.z, vraw.w};
#pragma unroll
          for (int e = 0; e < 8; ++e) VmT[(sj + e) * LP + st] = (bf16_t)((e & 1) ? (vw_[e >> 1] >> 16) : (vw_[e >> 1] & 0xffffu)); }
        bf16_t* Pc = S7; bf16_t* PcT = S8; bf16_t* Pn = Bt; bf16_t* PnT = Kt; bf16_t* Tc = S9; bf16_t* Tn = (bf16_t*)cs; bf16_t* TT = nullptr;
#pragma unroll 1
        for (int k = 1; k <= 6; ++k) {
            R1_FOR_TILES(idx, tr, tc)
                if (k <= 5) { f32x4_t pp = MMF(Pc, PcT, zero4); st_tile(pp, Pn, LP, 1, tr, tc, lane); st_tile(pp, PnT, 1, LP, tr, tc, lane); }
                if (k >= 2) { f32x4_t tn = ld_tile(Tc, LP, 1, tr, tc, lane); tn = MMF(Tc, PcT, tn); st_tile(tn, Tn, LP, 1, tr, tc, lane);
                    if (k == 6) st_tile(tn, Pn, 1, LP, tr, tc, lane); }
            R1_END
            __syncthreads();
            if (k == 6) TT = Pn;
            if (k <= 5) { bf16_t* x_ = Pc; Pc = Pn; Pn = x_; x_ = PcT; PcT = PnT; PnT = x_; }
            if (k >= 2) { bf16_t* x_ = Tc; Tc = Tn; Tn = x_; }
        }
        bf16_t* W1 = Pc; bf16_t* W2 = PcT; bf16_t* QkT = PnT;
        bf16_t* Og1 = Tn; bf16_t* Og2 = Tc; bf16_t* Opt = TT; bf16_t* Oqt = W1;
        R1_FOR_TILES(idx, tr, tc)
            f32x4_t w1 = MMF(AtT, TT, zero4); st_tile(w1, W1, LP, 1, tr, tc, lane);
            f32x4_t w2 = MMF(Mka, TT, zero4); st_tile(w2, W2, LP, 1, tr, tc, lane);
        R1_END
        __syncthreads();
        R1_FOR_TILES(idx, tr, tc)
            f32x4_t g1 = ld_tile(Rt, 1, LP, tr, tc, lane); g1 = MMF(W1, NbrT, g1); st_tile(g1, Og1, 1, LP, tr, tc, lane);
            f32x4_t g2 = ld_tile(Nkr, LP, 1, tr, tc, lane); g2 = MMF(W2, NbrT, g2); st_tile(g2, Og2, 1, LP, tr, tc, lane);
            f32x4_t pm = MMF(W1, BhT, zero4);
            { const int row0 = 16 * tr + 4 * (lane >> 4), col = 16 * tc + (lane & 15);
#pragma unroll
              for (int e = 0; e < 4; ++e) pm[e] += (row0 + e == col) ? gLs[col] : 0.f; }
            { const int row0 = 16 * tr + 4 * (lane >> 4), col = 16 * tc + (lane & 15);
#pragma unroll
              for (int e = 0; e < 4; ++e) { const int j = row0 + e; const int frag = (col >> 5) * 4 + 2 * (j >> 5) + ((j & 31) >> 4);
                Opt[(frag * 64 + (col & 31) + 32 * ((j >> 2) & 1)) * 8 + 4 * ((j >> 3) & 1) + (j & 3)] = f2bf(pm[e]); } }
            f32x4_t qk = ld_tile(Kh, LP, 1, tr, tc, lane); qk = MMF(W2, BhT, qk); st_tile(qk, QkT, 1, LP, tr, tc, lane);
        R1_END
        __syncthreads();
        {
            const int row = tid >> 3, ch8 = (tid & 7) * 8;
            *(uint4*)(G1T + (size_t)row * RW + ch8) = *(const uint4*)(Og1 + row * LP + ch8);
            *(uint4*)(G2T + (size_t)row * (2 * RW) + ch8) = *(const uint4*)(Og2 + row * LP + ch8);
            *(uint4*)(PT + (size_t)row * RW + ch8) = *(const uint4*)(Opt + row * 64 + ch8);
        }
        R1_FOR_TILES(idx, tr, tc)
            f32x4_t qt = MMF(QkT, VmT, zero4);
            { const int row0 = 16 * tr + 4 * (lane >> 4), col = 16 * tc + (lane & 15);
#pragma unroll
              for (int e = 0; e < 4; ++e) { const int jp = row0 + e; const int ci = ((jp >> 5) * 2 + (col >> 5)) * 64 + (col & 31) + 32 * ((jp >> 2) & 1);
                Oqt[ci * 16 + (jp & 3) + 4 * ((jp & 31) >> 3)] = f2bf(qt[e]); } }
        R1_END
        __syncthreads();
        { const int ci = tid >> 1, hf = tid & 1;
          *(uint4*)(QT + (size_t)(ci >> 2) * (2 * RW) + (ci & 3) * 16 + hf * 8) = *(const uint4*)(Oqt + ci * 16 + hf * 8); }
#undef MMF
    }
}
__device__ void ph_rwkv_prep_r1(const P& p, float* ldsf) {
    for (int b64 = blockIdx.x; b64 < NT / 64; b64 += gridDim.x) {
        ph_rwkv_prep(p, ldsf, 2 * b64, 2 * b64 + 2, 1);
        __syncthreads();
        const int b = b64 >> 7, c = b64 & 127, ch0 = (b * 8) * 128 + c;
        ph_rwkv_r1(p, ldsf, ch0, ch0 + 8 * 128, 128);
    }
}
__device__ void ph_rwkv_r2(const P& p, int bh_first, int bh_end, int bh_step) {
    bf16_t* SX = (bf16_t*)(p.ws + WS_SX);
    const int tid = otid(), lane = tid & 63, wv = tid >> 6, hh = lane >> 5, r32 = lane & 31;
    typedef short s16x4_t __attribute__((ext_vector_type(4)));
    for (int bh = bh_first; bh < bh_end; bh += bh_step) {
        if (wv >= 2) continue;
        const int cb = wv;
        f32x16_t x0, x1;
#pragma unroll
        for (int i = 0; i < 16; ++i) { x0[i] = 0.f; x1[i] = 0.f; }
        bf16x8_t pa[3][2][4]; uint4 qa[3][2][2];
#define R2_LOAD(S_, c_) do { const size_t gb_ = ((size_t)(bh >> 3) * SEQ + (size_t)(c_) * 64) * RW + (bh & 7) * 64; \
            const bf16_t* PT = (const bf16_t*)(p.ws + WS_BB) + gb_; const bf16_t* QT = (const bf16_t*)(p.ws + WS_DD) + 2 * gb_ + 64; \
            _Pragma("unroll") for (int rb = 0; rb < 2; ++rb) { \
                _Pragma("unroll") for (int ks = 0; ks < 4; ++ks) { const int o_ = ((rb * 4 + ks) * 64 + lane) * 8;        \
                    pa[S_][rb][ks] = *(const bf16x8_t*)(PT + (size_t)(o_ >> 6) * RW + (o_ & 63)); } \
                const int ci_ = (rb * 2 + cb) * 64 + lane; const uint4* qp = (const uint4*)(QT + (size_t)(ci_ >> 2) * (2 * RW) + (ci_ & 3) * 16); qa[S_][rb][0] = qp[0]; qa[S_][rb][1] = qp[1]; } } while (0)
#define R2_STEP(S_, c_) do { const int cc_ = (c_); const size_t ob_ = ((size_t)bh * 128 + cc_) * 4096; \
              \
            const bf16x8_t xb0 = pack_step16(x0, 0), xb1 = pack_step16(x0, 1), xb2 = pack_step16(x1, 0), xb3 = pack_step16(x1, 1); \
            { bf16x8_t* sp = (bf16x8_t*)(SX + ob_) + (cb * 4) * 64 + lane;        \
              sp[0] = xb0; sp[64] = xb1; sp[128] = xb2; sp[192] = xb3; } \
            f32x16_t n0, n1; \
            { const unsigned qw0[8] = {qa[S_][0][0].x, qa[S_][0][0].y, qa[S_][0][0].z, qa[S_][0][0].w, qa[S_][0][1].x, qa[S_][0][1].y, qa[S_][0][1].z, qa[S_][0][1].w}; \
              const unsigned qw1[8] = {qa[S_][1][0].x, qa[S_][1][0].y, qa[S_][1][0].z, qa[S_][1][0].w, qa[S_][1][1].x, qa[S_][1][1].y, qa[S_][1][1].z, qa[S_][1][1].w}; \
              _Pragma("unroll") for (int i = 0; i < 8; ++i) { n0[2 * i] = __uint_as_float(qw0[i] << 16); n0[2 * i + 1] = __uint_as_float(qw0[i] & 0xffff0000u); n1[2 * i] = __uint_as_float(qw1[i] << 16); n1[2 * i + 1] = __uint_as_float(qw1[i] & 0xffff0000u); } } \
            n0 = MFMA32(pa[S_][0][0], xb0, n0); n0 = MFMA32(pa[S_][0][1], xb1, n0); n0 = MFMA32(pa[S_][0][2], xb2, n0); n0 = MFMA32(pa[S_][0][3], xb3, n0); \
            n1 = MFMA32(pa[S_][1][0], xb0, n1); n1 = MFMA32(pa[S_][1][1], xb1, n1); n1 = MFMA32(pa[S_][1][2], xb2, n1); n1 = MFMA32(pa[S_][1][3], xb3, n1); \
            x0 = n0; x1 = n1; \
            if (cc_ + 3 < SEQ / 64) R2_LOAD(S_, cc_ + 3); } while (0)
        R2_LOAD(0, 0); R2_LOAD(1, 1); R2_LOAD(2, 2);
#pragma unroll 1
        for (int c = 0; c + 2 < SEQ / 64; c += 3) { R2_STEP(0, c); R2_STEP(1, c + 1); R2_STEP(2, c + 2); }
        R2_STEP(0, SEQ / 64 - 2); R2_STEP(1, SEQ / 64 - 1);
#undef R2_STEP
#undef R2_LOAD
    }
}
__device__ void ph_rwkv_r3(const P& p, float* ldsf) {
    const bf16_t* VV = (const bf16_t*)(p.ws + WS_VV); const bf16_t* SX = (const bf16_t*)(p.ws + WS_SX);
    const bf16_t* Rg = (const bf16_t*)(p.ws + WS_R); const bf16_t* K2 = (const bf16_t*)(p.ws + WS_K2); const bf16_t* Gg = (const bf16_t*)(p.ws + WS_G); bf16_t* ORW = (bf16_t*)(p.ws + WS_ORW);
    const float* r_k = p.in[18]; const float* ln_w = p.in[19]; const float* ln_b = p.in[20];
    bf16_t* Vm = (bf16_t*)ldsf; float* Yl = (float*)(Vm + SLOT);
    const int tid = otid(), lane = tid & 63, wv = tid >> 6; const int t0 = 2 * wv, t1 = 2 * wv + 1;
    const int st = tid >> 3, sj = (tid & 7) * 8;
    for (int ch = blockIdx.x; ch < NB * 8 * (SEQ / 64); ch += gridDim.x) {
        const int bh = ch >> 7, c = ch & 127, b = bh >> 3, h = bh & 7;
        const size_t gbase = ((size_t)b * SEQ + (size_t)c * 64) * RW + h * 64, ob_ = (size_t)ch * 4096;
        const bf16_t* G1T = (const bf16_t*)(p.ws + WS_KK) + gbase; const bf16_t* G2T = (const bf16_t*)(p.ws + WS_DD) + 2 * gbase;
        __syncthreads();
        const uint4 vraw = *(const uint4*)(VV + gbase + (size_t)st * RW + sj);
        *(uint4*)(Vm + st * LP + sj) = vraw;
        __syncthreads();
        R1_FOR_TILES(idx, tr, tc)
            const f32x4_t zero4 = {0.f, 0.f, 0.f, 0.f};
            f32x4_t y = zero4;
            {
                const int i_ = 16 * tr + (lane & 15), q_ = lane >> 4; typedef short s16x4_t __attribute__((ext_vector_type(4)));
#pragma unroll
                for (int s2 = 0; s2 < 2; ++s2) { const int j0 = 32 * s2 + 8 * q_;
                    const int frag = (i_ >> 5) * 4 + 2 * (j0 >> 5) + ((j0 & 31) >> 4); const bf16_t* fp = SX + ob_ + ((size_t)frag * 64 + (i_ & 31)) * 8 + 4 * ((j0 >> 3) & 1);
                    const s16x4_t lo = *(const s16x4_t*)fp, hi = *(const s16x4_t*)(fp + 32 * 8);
                    bf16x8_t a; a[0] = lo[0]; a[1] = lo[1]; a[2] = lo[2]; a[3] = lo[3]; a[4] = hi[0]; a[5] = hi[1]; a[6] = hi[2]; a[7] = hi[3];
                    const bf16x8_t b = *(const bf16x8_t*)(G1T + (size_t)(16 * tc + (lane & 15)) * RW + 32 * s2 + 8 * q_);
                    y = __builtin_amdgcn_mfma_f32_16x16x32_bf16(a, b, y, 0, 0, 0); }
            }
            y = mm_tile<false, true>(Vm, 1, LP, G2T, 1, 2 * RW, tr, tc, y, lane);
            const int i0 = 16 * tr + 4 * (lane >> 4), t = 16 * tc + (lane & 15);
#pragma unroll
            for (int e = 0; e < 4; ++e) Yl[t * 65 + i0 + e] = y[e];
        R1_END
        __syncthreads();
        {
            float y[8], s1 = 0.f;
#pragma unroll
            for (int e = 0; e < 8; ++e) { y[e] = Yl[st * 65 + sj + e]; s1 += y[e]; }
            s1 += __shfl_xor(s1, 1); s1 += __shfl_xor(s1, 2); s1 += __shfl_xor(s1, 4);
            const float mean = s1 * (1.f / 64.f); float s2 = 0.f;
#pragma unroll
            for (int e = 0; e < 8; ++e) { y[e] -= mean; s2 += y[e] * y[e]; }
            s2 += __shfl_xor(s2, 1); s2 += __shfl_xor(s2, 2); s2 += __shfl_xor(s2, 4);
            const float rstd = rsqrtf(s2 * (1.f / 64.f) + GN_EPS);
            const size_t o = gbase + (size_t)st * RW + sj;
            const uint4 rr = *(const uint4*)(Rg + o), kr = *(const uint4*)(K2 + o), gr = *(const uint4*)(Gg + o);
            const unsigned rw_[4] = {rr.x, rr.y, rr.z, rr.w}, kw_[4] = {kr.x, kr.y, kr.z, kr.w}, gw_[4] = {gr.x, gr.y, gr.z, gr.w}, vw_[4] = {vraw.x, vraw.y, vraw.z, vraw.w};
            float rk = 0.f;
#pragma unroll
            for (int e = 0; e < 8; ++e) { const float r_ = (e & 1) ? __uint_as_float(rw_[e >> 1] & 0xffff0000u) : __uint_as_float(rw_[e >> 1] << 16), k_ = (e & 1) ? __uint_as_float(kw_[e >> 1] & 0xffff0000u) : __uint_as_float(kw_[e >> 1] << 16);
                rk += r_ * k_ * r_k[h * 64 + sj + e]; }
            rk += __shfl_xor(rk, 1); rk += __shfl_xor(rk, 2); rk += __shfl_xor(rk, 4);
            float ov[8];
#pragma unroll
            for (int e = 0; e < 8; ++e) { const float v_ = (e & 1) ? __uint_as_float(vw_[e >> 1] & 0xffff0000u) : __uint_as_float(vw_[e >> 1] << 16), g_ = (e & 1) ? __uint_as_float(gw_[e >> 1] & 0xffff0000u) : __uint_as_float(gw_[e >> 1] << 16);
                ov[e] = (y[e] * rstd * ln_w[h * 64 + sj + e] + ln_b[h * 64 + sj + e] + rk * v_) * g_; }
            *(uint4*)(ORW + o) = make_uint4(pk2(ov[0], ov[1]), pk2(ov[2], ov[3]), pk2(ov[4], ov[5]), pk2(ov[6], ov[7]));
        }
    }
}
#undef R1_FOR_TILES
#undef R1_END

__device__ void ph_moe_lists(const P& p, float* ldsf) {
    int* ctl = (int*)(p.ws + WS_CTL); const int* cntB = ctl + CT_CNTB;
    int* ltok = (int*)(p.ws + WS_LTOK); float* lw = (float*)(p.ws + WS_LW);
    int* part = (int*)ldsf;
    int* tot = part + 1024; int* pre = tot + 64; int* offL = pre + 64; int* tp = offL + 64;
    const int tid = otid(), lane = tid & 63, wv = tid >> 6, G = gridDim.x;
    { int t_ = 0, p_ = 0;
      for (int b2 = wv; b2 < G; b2 += 8) { const int v = cntB[b2 * 64 + lane]; t_ += v; p_ += (b2 < (int)blockIdx.x) ? v : 0; }
      part[wv * 64 + lane] = t_; part[512 + wv * 64 + lane] = p_; }
    __syncthreads();
    if (tid < 64) { int t_ = 0, p_ = 0;
#pragma unroll
        for (int w2 = 0; w2 < 8; ++w2) { t_ += part[w2 * 64 + tid]; p_ += part[512 + w2 * 64 + tid]; }
        tot[tid] = t_; pre[tid] = p_;
        const int nt_ = (t_ + 255) >> 8; int incl = nt_;
#pragma unroll
        for (int o = 1; o < 64; o <<= 1) { const int oth = __shfl_up(incl, o); if (lane >= o) incl += oth; }
        tp[tid] = incl - nt_; offL[tid] = (incl - nt_) * 256; if (tid == 63) tp[64] = incl; }
    __syncthreads();
    const int TPB = NT / G;
    for (int i = tid; i < TPB; i += NTHR) { const int m = blockIdx.x * TPB + i; const int4 r = ((const int4*)(p.ws + WS_ROUTE))[m];
        const int l0 = r.x & 255, l1 = 32 + ((r.x >> 8) & 255), rk0 = r.y & 0xffff, rk1 = (r.y >> 16) & 0xffff;
        const int p0 = offL[l0] + pre[l0] + rk0, p1 = offL[l1] + pre[l1] + rk1;
        ltok[p0] = m; lw[p0] = __int_as_float(r.z); ltok[p1] = m; lw[p1] = __int_as_float(r.w); }
    for (int li = blockIdx.x; li < 64; li += G) {
        const int cnt = tot[li], off = offL[li], e = li & 31, nt_ = (cnt + 255) >> 8;
        int4* t1 = (int4*)(ctl + CT_TAB1) + tp[li] * 4;
        int4* t2 = (li < 32) ? (int4*)(ctl + CT_TAB2A) + tp[li] * 4 : (int4*)(ctl + CT_TAB2B) + (tp[li] - tp[32]) * 4;
        for (int i = tid; i < nt_ * 4; i += NTHR) { const int mt = i >> 2, nt = i & 3; const int4 ent = make_int4(off + mt * 256, e * 1024 + nt * 256, cnt - mt * 256, nt); t1[i] = ent; t2[i] = ent; }
        for (int r = cnt + tid; r < nt_ * 256; r += NTHR) ltok[off + r] = 0;
    }
    if (blockIdx.x == 0 && tid == 0) { ctl[CT_NU] = tp[64] * 4; ctl[CT_NU + 1] = tp[32] * 4; ctl[CT_NU + 2] = (tp[64] - tp[32]) * 4; }
}

template <int PH>
__device__ __forceinline__ void run_phase(const P& p, unsigned char* lds_raw) {
    float* lds = (float*)lds_raw; PG8_LAS unsigned char* ldsg = (PG8_LAS unsigned char*)lds_raw;
    const int G = gridDim.x, c = blockIdx.x;
    if constexpr (PH == 0) { ph_mod(p, lds); __syncthreads(); ph_convert_mixer_weights(p, lds); __syncthreads(); ph_convert_lora_weights(p, lds); }
    if constexpr (PH == 1) ph_norm(p, p.in[0], p.in[4], 0, (bf16_t*)(p.ws + WS_XN));
    if constexpr (PH == 2) { pg8::Gemm g{(const bf16_t*)(p.ws + WS_XN), (const bf16_t*)(p.ws + WS_WIN), DM, nullptr}; pg8::StaticOrder S; S.init(NT, 5120, G, c);
        pg8::EpiInproj E{p.ws, (bf16_t*)p.out}; pg8::gemm_phase(ldsg, g, S, E); }
    if constexpr (PH == 3) {
        { pg8::Gemm g{(const bf16_t*)(p.ws + WS_KVN), (const bf16_t*)(p.ws + WS_WKV), KVL, nullptr}; pg8::StaticOrder S; S.init(NT, 2 * AW, G, c);
          pg8::EpiKV E{p.ws}; pg8::gemm_phase(ldsg, g, S, E);
          pg8::Unit u;
          for (int i = 0; S.next(i, u); ++i) if (u.pn < 2) { __syncthreads(); knorm_tile(p, u.pm, u.pn); } }
        ph_rwkv_prep_r1(p, lds);
        ph_dsa_select(p, lds);
    }
    if constexpr (PH == 4) { ph_rwkv_r2(p, c, NB * 8, G); ph_dsa_attn(p, lds); }
    if constexpr (PH == 5) { ph_attn_merge(p); ph_rwkv_r3(p, lds); }
    if constexpr (PH == 6) { pg8::Gemm g{(const bf16_t*)(p.ws + WS_OATT), (const bf16_t*)(p.ws + WS_WBA), AW, nullptr}; pg8::BranchOrder S; S.S0.init(NT, DM, G, c);
        pg8::EpiMerge E{(bf16_t*)(p.ws + WS_MERGED), (const bf16_t*)p.out}; pg8::gemm_phase(ldsg, g, S, E);
        ph_convert_expert_weights(p, lds); }
    if constexpr (PH == 7) { pg8::Gemm g{(const bf16_t*)(p.ws + WS_MERGED), (const bf16_t*)(p.ws + WS_WOUT), DM, nullptr}; pg8::StaticOrder S; S.init(NT, DM, G, c);
        pg8::EpiOut E{p.in[0], (const float*)(p.ws + WS_MOD), p.out}; pg8::gemm_phase(ldsg, g, S, E); }
    if constexpr (PH == 8) ph_norm_route(p, lds);
    if constexpr (PH == 9) ph_moe_lists(p, lds);
    if constexpr (PH == 10) { const int* ctl = (const int*)(p.ws + WS_CTL);
        pg8::Gemm g{(const bf16_t*)(p.ws + WS_XN2), (const bf16_t*)(p.ws + WS_WGU), DM, (const int*)(p.ws + WS_LTOK)}; pg8::TableOrder S{(const int4*)(ctl + CT_TAB1), ctl[CT_NU], G, c};
        pg8::EpiMoe1 E{(bf16_t*)(p.ws + WS_HID), (const float*)(p.ws + WS_LW)}; pg8::gemm_phase(ldsg, g, S, E); }
    if constexpr (PH == 11 || PH == 12) { const int* ctl = (const int*)(p.ws + WS_CTL);
        pg8::Gemm g{(const bf16_t*)(p.ws + WS_HID), (const bf16_t*)(p.ws + WS_WDN), DE, nullptr};
        pg8::TableOrder S{(const int4*)(ctl + (PH == 11 ? CT_TAB2A : CT_TAB2B)), ctl[CT_NU + (PH == 11 ? 1 : 2)], G, c};
        pg8::EpiMoe2 E{(const int*)(p.ws + WS_LTOK), (const float*)(p.ws + WS_MOD), p.out}; pg8::gemm_phase(ldsg, g, S, E); }
}
constexpr int LDS_BYTES = 147456;
constexpr int ORDER[] = {0, 1, 2, 3, 4, 5, 6, 7, 8, 9, 10, 11, 12};
constexpr int NPHASE = sizeof(ORDER) / sizeof(int);
constexpr int CT_BAR = 65536;
constexpr int LDS_ST = LDS_BYTES - 64;
template <int I> __device__ __forceinline__ void run_all(const P& p, unsigned char* lds, const XcdBarrier& bar) {
    run_phase<ORDER[I]>(p, lds);
    if constexpr (I + 1 < NPHASE) { xcd_barrier(bar); run_all<I + 1>(p, lds, bar); }
}
__global__ void __launch_bounds__(NTHR, 2) k_mega(P p) {
    extern __shared__ __attribute__((aligned(16))) unsigned char lds[];
    volatile LAS3 unsigned* st = (volatile LAS3 unsigned*)((LAS3 unsigned char*)lds + LDS_ST);
    if (otid() < 16) st[otid()] = 0u;
    __syncthreads();
    const XcdBarrier bar = xcd_barrier_post((unsigned*)(p.ws + WS_CTL) + CT_BAR, st);
    run_all<0>(p, lds, bar);
}
}

extern "C" void kernel_launch(void* const* d_in, const int* in_sizes, int n_in, void* d_out, int out_size, void* d_ws, size_t ws_size, hipStream_t stream) {
    if (n_in != 31 || out_size != NT * DM || ws_size < WS_END) { fprintf(stderr, "kernel_launch: unexpected shapes (n_in %d out %d ws %zu need %zu)\n", n_in, out_size, ws_size, (size_t)WS_END); return; }
    P p{};
    for (int i = 0; i < 31; ++i) p.in[i] = (const float*)d_in[i];
    p.out = (float*)d_out; p.ws = (unsigned char*)d_ws;
    (void)hipMemsetAsync((char*)d_ws + WS_CTL, 0, 1 * MiB, stream);
    static int grid_blocks = 0;
    if (!grid_blocks) {
        int dev = 0, cus = 0, per_cu = 0;
        (void)hipGetDevice(&dev);
        (void)hipDeviceGetAttribute(&cus, hipDeviceAttributeMultiprocessorCount, dev);
        (void)hipFuncSetAttribute((const void*)k_mega, hipFuncAttributeMaxDynamicSharedMemorySize, LDS_BYTES);
        (void)hipOccupancyMaxActiveBlocksPerMultiprocessor(&per_cu, (const void*)k_mega, NTHR, LDS_BYTES);
        if (per_cu < 1) per_cu = 1;
        if (per_cu > 1) per_cu = 1;
        grid_blocks = cus * per_cu;
        fprintf(stderr, "kernel_launch: cus %d per_cu %d grid %d\n", cus, per_cu, grid_blocks);
    }
    hipLaunchKernelGGL(k_mega, dim3(grid_blocks), dim3(NTHR), LDS_BYTES, stream, p);
}
```

```cpp
#include <hip/hip_runtime.h>
#include <cstdio>
#include <cstdint>

namespace {
constexpr int NB = 2, SEQ = 8192, DM = 1024, NT = NB * SEQ;
constexpr int AW = 512, KVL = 256, NIH = 8, IDD = 32, SHW = 1824, INW = 4936;
constexpr int C_KV = 512, C_QI = 768, C_PS = 1064, C_GA = 2888, C_GR = 3912;
constexpr int IDXW = 296;
constexpr int RW = 512, NE = 32, DE = 512;
constexpr int TOPK = 256;
constexpr float NORM_EPS = 1e-6f, GN_EPS = 64e-5f;
constexpr int NTHR = 512;

typedef unsigned short bf16_t;
__device__ __forceinline__ float bf2f(bf16_t v) { return __uint_as_float(((unsigned)v) << 16); }
__device__ __forceinline__ bf16_t f2bf(float f) { unsigned u = __float_as_uint(f); return (bf16_t)((u + 0x7fffu + ((u >> 16) & 1u)) >> 16); }

constexpr size_t MiB = 1u << 20;
constexpr size_t WS_CTL = 0;
constexpr size_t WS_MOD = 1 * MiB;
constexpr size_t WS_RSS = 82 * MiB + 512 * 1024;
constexpr size_t WS_LW2T = 512 * 1024, WS_LA2T = 576 * 1024, WS_LG2T = 640 * 1024;
constexpr size_t WS_WIN = 2 * MiB;
constexpr size_t WS_WKV = 12 * MiB;
constexpr size_t WS_WBA = 13 * MiB;
constexpr size_t WS_WBR = 14 * MiB;
constexpr size_t WS_WOUT = 15 * MiB;
constexpr size_t WS_XN = 17 * MiB;
constexpr size_t WS_K = 17 * MiB;
constexpr size_t WS_V = 33 * MiB;
constexpr size_t WS_Q = 49 * MiB;
constexpr size_t WS_KVN = 65 * MiB;
constexpr size_t WS_QI = 73 * MiB;
constexpr size_t WS_KI = 81 * MiB;
constexpr size_t WS_WI = 82 * MiB;
constexpr size_t WS_PS = 83 * MiB;
constexpr size_t WS_SX = 83 * MiB;
constexpr size_t WS_OATT = 99 * MiB;
constexpr size_t WS_ORW = 115 * MiB;
constexpr size_t WS_MASK = 140 * MiB;
constexpr size_t WS_R = 156 * MiB, WS_K2 = 172 * MiB, WS_VV = 188 * MiB;
constexpr size_t WS_KK = 204 * MiB;
constexpr size_t WS_BB = 220 * MiB;
constexpr size_t WS_DD = 236 * MiB;
constexpr size_t WS_G = 268 * MiB;
constexpr size_t WS_MERGED = 131 * MiB;
constexpr size_t WS_XN2 = 163 * MiB;
constexpr size_t WS_WGU = 195 * MiB;
constexpr size_t WS_WDN = 259 * MiB;
constexpr size_t WS_HID = 17 * MiB;
constexpr size_t WS_ROUTE = 65 * MiB;
constexpr size_t WS_LTOK = 66 * MiB;
constexpr size_t WS_LW = 67 * MiB;
constexpr size_t WS_OFAR = 65 * MiB;
constexpr size_t WS_AML = 67 * MiB;
constexpr size_t WS_END = 291 * MiB;
constexpr int HID_ROWS = 49152;
constexpr int CT_CNT = 0, CT_OFF = 64, CT_CUR = 128, CT_NU = 192, CT_Q = 256;
constexpr int CT_CNTB = 16384;
constexpr int CT_TAB1 = 1024, CT_TAB2A = 1024 + 4 * 1024, CT_TAB2B = 1024 + 8 * 1024;

struct P {
    const float* in[31];
    float* out;
    unsigned char* ws;
};

__device__ __forceinline__ int otid() { int t = threadIdx.x; asm volatile("" : "+v"(t)); return t; }
__device__ __forceinline__ float dpp_row_shr(float v, int n) {
    int iv = __builtin_bit_cast(int, v), r;
    switch (n) { case 1: r = __builtin_amdgcn_update_dpp(0, iv, 0x111, 0xf, 0xf, true); break; case 2: r = __builtin_amdgcn_update_dpp(0, iv, 0x112, 0xf, 0xf, true); break;
                 case 4: r = __builtin_amdgcn_update_dpp(0, iv, 0x114, 0xf, 0xf, true); break; default: r = __builtin_amdgcn_update_dpp(0, iv, 0x118, 0xf, 0xf, true); break; }
    return __builtin_bit_cast(float, r);
}
__device__ __forceinline__ float wave_sum(float v) {
    v += dpp_row_shr(v, 1); v += dpp_row_shr(v, 2); v += dpp_row_shr(v, 4); v += dpp_row_shr(v, 8);
    v += __builtin_bit_cast(float, __builtin_amdgcn_update_dpp(0, __builtin_bit_cast(int, v), 0x142, 0xa, 0xf, false));
    v += __builtin_bit_cast(float, __builtin_amdgcn_update_dpp(0, __builtin_bit_cast(int, v), 0x143, 0xc, 0xf, false));
    return __builtin_bit_cast(float, __builtin_amdgcn_readlane(__builtin_bit_cast(int, v), 63));
}
__device__ __forceinline__ float wave_max(float v) {
#pragma unroll
    for (int o = 32; o > 0; o >>= 1) v = fmaxf(v, __shfl_xor(v, o));
    return v;
}
typedef short bf16x8_t __attribute__((ext_vector_type(8)));
typedef float f32x4_t __attribute__((ext_vector_type(4)));
constexpr int LP = 72;
constexpr int SLOT = 64 * LP;
typedef __bf16 bf2_t __attribute__((ext_vector_type(2)));
typedef float f2_t __attribute__((ext_vector_type(2)));
__device__ __forceinline__ unsigned pk_bf16(float lo, float hi) { const f2_t v = {lo, hi}; return __builtin_bit_cast(unsigned, __builtin_convertvector(v, bf2_t)); }
__device__ __forceinline__ float sigmoidf_(float x) { return __builtin_amdgcn_rcpf(1.f + __expf(-x)); }

#define XB_TMO      128
#define XB_XCNT(j)  (256  + 64 * (j))
#define XB_XSUB(j)  (1280 + 64 * (j))
#define XB_XGEN(j)  (2304 + 64 * (j))
#define XB_TOP      3328
#define XB_TOPGEN   3392
#define XCD_BAR_WORDS 3456
#define XB_SPIN_CAP (1u << 22)
#define LAS3 __attribute__((address_space(3)))
__device__ __forceinline__ unsigned xb_ld(unsigned* p)              { return __hip_atomic_load(p, __ATOMIC_RELAXED, __HIP_MEMORY_SCOPE_AGENT); }
__device__ __forceinline__ unsigned xb_add(unsigned* p, unsigned v) { return __hip_atomic_fetch_add(p, v, __ATOMIC_RELAXED, __HIP_MEMORY_SCOPE_AGENT); }
__device__ __forceinline__ unsigned xb_xcc_id() { return (unsigned)__builtin_amdgcn_s_getreg((3 << 11) | 20) & 0xFu; }
#define XB_SPIN(cond, bar) do { unsigned _sp = 0; while (cond) { __builtin_amdgcn_s_sleep(1); \
    if ((++_sp & 255u) == 0u) { if (xb_ld(&(bar)[XB_TMO])) break; if (_sp > XB_SPIN_CAP) { atomicAdd(&(bar)[XB_TMO], 1u); break; } } } } while (0)
struct XcdBarrier { unsigned* bar; unsigned x; volatile LAS3 unsigned* st; };
__device__ __forceinline__ XcdBarrier xcd_barrier_post(unsigned* bar, volatile LAS3 unsigned* st) {
    XcdBarrier b; b.bar = bar; b.x = xb_xcc_id(); b.st = st;
    if (otid() == 0) (void)xb_add(&bar[XB_XCNT(b.x)], 1u);
    return b;
}
__device__ __forceinline__ void xcd_barrier_complete(unsigned* bar, unsigned x, unsigned& nloc, unsigned& nx) {
    const unsigned G = gridDim.x * gridDim.y * gridDim.z;
    unsigned sum, cnt, mine, sp = 0u;
    for (;;) {
        sum = 0u; cnt = 0u; mine = 0u;
#pragma unroll
        for (unsigned j = 0; j < 16; ++j) { const unsigned c = xb_ld(&bar[XB_XCNT(j)]); sum += c; cnt += (c > 0u) ? 1u : 0u; mine = (j == x) ? c : mine; }
        if (sum == G) break;
        __builtin_amdgcn_s_sleep(1);
        if ((++sp & 255u) == 0u) { if (xb_ld(&bar[XB_TMO])) break; if (sp > XB_SPIN_CAP) { atomicAdd(&bar[XB_TMO], 1u); break; } }
    }
    nloc = mine > 0u ? mine : 1u; nx = cnt > 0u ? cnt : 1u;
}
__device__ __forceinline__ void xcd_barrier(const XcdBarrier& b) {
    asm volatile("s_waitcnt vmcnt(0)" ::: "memory");
    __syncthreads();
    if (otid() == 0) {
        unsigned* bar = b.bar;
        __builtin_amdgcn_s_waitcnt(0);
        unsigned nloc = b.st[0], nx = b.st[1];
        if (nloc == 0u) { xcd_barrier_complete(bar, b.x, nloc, nx); b.st[0] = nloc; b.st[1] = nx; }
        const unsigned old = xb_add(&bar[XB_XSUB(b.x)], 1u);
        const unsigned gen = old / nloc;
        if (old + 1u == (gen + 1u) * nloc) {
            __builtin_amdgcn_fence(__ATOMIC_RELEASE, "agent");
            asm volatile("s_waitcnt vmcnt(0)" ::: "memory");
            const unsigned og = xb_add(&bar[XB_TOP], 1u);
            const unsigned tg = og / nx;
            if (og + 1u == (tg + 1u) * nx) xb_add(&bar[XB_TOPGEN], 1u);
            else XB_SPIN(xb_ld(&bar[XB_TOPGEN]) == tg, bar);
            __builtin_amdgcn_fence(__ATOMIC_ACQUIRE, "agent");
            xb_add(&bar[XB_XGEN(b.x)], 1u);
            asm volatile("s_waitcnt vmcnt(0)" ::: "memory");
        } else {
            XB_SPIN(xb_ld(&bar[XB_XGEN(b.x)]) == gen, bar);
            __builtin_amdgcn_fence(__ATOMIC_ACQUIRE, "agent");
            asm volatile("s_waitcnt vmcnt(0)" ::: "memory");
        }
    }
    __syncthreads();
}

__device__ void ph_mod(const P& p, float* lds) {
    const float* c = p.in[1]; const float* W = p.in[2]; const float* bia = p.in[3];
    float* mod = (float*)(p.ws + WS_MOD);
    const int tid = otid(), lane = tid & 63, wv = tid >> 6;
    float* sil = lds; float* part = lds + NB * DM;
    for (int i = tid; i < NB * DM; i += NTHR) { const float v = c[i]; sil[i] = v / (1.f + __expf(-v)); }
    __syncthreads();
    const int cc = lane % 24, kk = lane / 24;
    for (int j0 = blockIdx.x * 24; j0 < 6 * DM; j0 += gridDim.x * 24) {
        float a0 = 0.f, a1 = 0.f;
        if (lane < 48) {
#pragma unroll 32
            for (int i = 0; i < 64; ++i) { const int k = 128 * wv + 2 * i + kk; const float w = W[(size_t)k * (6 * DM) + j0 + cc]; a0 += sil[k] * w; a1 += sil[DM + k] * w; }
        }
        a0 += __shfl(a0, (lane + 24) & 63); a1 += __shfl(a1, (lane + 24) & 63);
        if (lane < 24) { part[(wv * 2 + 0) * 24 + cc] = a0; part[(wv * 2 + 1) * 24 + cc] = a1; }
        __syncthreads();
        if (tid < 48) { const int bb = tid / 24, c2 = tid % 24; float sum = 0.f;
#pragma unroll
            for (int w2 = 0; w2 < 8; ++w2) sum += part[(w2 * 2 + bb) * 24 + c2];
            mod[bb * 6 * DM + j0 + c2] = sum + bia[j0 + c2]; }
        __syncthreads();
    }
}

__device__ void ph_norm(const P& p, const float* src, const float* g, int which, bf16_t* dst) {
    const float* mod = (const float*)(p.ws + WS_MOD);
    const int lane = otid() & 63, wv = otid() >> 6;
    const int gw = blockIdx.x * (NTHR / 64) + wv, nw = gridDim.x * (NTHR / 64);
    for (int m = gw; m < NT; m += nw) {
        const int b = m / SEQ;
        const float* sh = mod + b * 6 * DM + (which ? 3 * DM : 0);
        const float* sc = sh + DM;
        const float4* xr = (const float4*)(src + (size_t)m * DM);
        float4 v[4]; float ss = 0.f;
#pragma unroll
        for (int j = 0; j < 4; ++j) { v[j] = xr[lane + 64 * j]; ss += v[j].x * v[j].x + v[j].y * v[j].y + v[j].z * v[j].z + v[j].w * v[j].w; }
        ss = wave_sum(ss);
        const float rstd = rsqrtf(ss * (1.f / DM) + NORM_EPS);
        float o[16];
#pragma unroll
        for (int j = 0; j < 4; ++j) {
            int c0 = 4 * (lane + 64 * j); asm volatile("" : "+v"(c0));
            const float4 gg = *(const float4*)(g + c0), s1 = *(const float4*)(sc + c0), s0 = *(const float4*)(sh + c0);
            o[4 * j + 0] = v[j].x * rstd * gg.x * (1.f + s1.x) + s0.x; o[4 * j + 1] = v[j].y * rstd * gg.y * (1.f + s1.y) + s0.y;
            o[4 * j + 2] = v[j].z * rstd * gg.z * (1.f + s1.z) + s0.z; o[4 * j + 3] = v[j].w * rstd * gg.w * (1.f + s1.w) + s0.w;
            uint2 pk; pk.x = (unsigned)f2bf(o[4 * j]) | ((unsigned)f2bf(o[4 * j + 1]) << 16); pk.y = (unsigned)f2bf(o[4 * j + 2]) | ((unsigned)f2bf(o[4 * j + 3]) << 16);
            *(uint2*)(dst + (size_t)m * DM + c0) = pk;
        }
    }
}

__device__ void ph_norm_route(const P& p, float* lds) {
    const float* mod = (const float*)(p.ws + WS_MOD); const float* src = p.out; const float* g = p.in[24]; bf16_t* dst = (bf16_t*)(p.ws + WS_XN2);
    const float* wgr = p.in[25]; const float* wer = p.in[26]; const float* eb = p.in[27];
    const int tid = otid(), lane = tid & 63, wv = tid >> 6;
    float* sx = lds + wv * 4096;
    int* cntL = (int*)(lds + 8 * 4096);
    if (tid < 64) cntL[tid] = 0;
    __syncthreads();
    const int TPB = NT / gridDim.x;
    for (int m0 = blockIdx.x * TPB + wv * 4; m0 < (blockIdx.x + 1) * TPB; m0 += 8 * 4) {
        const int b = m0 / SEQ;
        const float* sh = mod + b * 6 * DM + 3 * DM; const float* sc = sh + DM;
#pragma unroll 1
        for (int tk = 0; tk < 4; ++tk) {
            const int m = m0 + tk;
            const float4* xr = (const float4*)(src + (size_t)m * DM);
            float4 v[4]; float ss = 0.f;
#pragma unroll
            for (int j = 0; j < 4; ++j) { v[j] = xr[lane + 64 * j]; ss += v[j].x * v[j].x + v[j].y * v[j].y + v[j].z * v[j].z + v[j].w * v[j].w; }
            ss = wave_sum(ss);
            const float rstd = rsqrtf(ss * (1.f / DM) + NORM_EPS);
#pragma unroll
            for (int j = 0; j < 4; ++j) {
                const int c0 = 4 * (lane + 64 * j);
                const float4 gg = *(const float4*)(g + c0), s1 = *(const float4*)(sc + c0), s0 = *(const float4*)(sh + c0);
                const float o0 = v[j].x * rstd * gg.x * (1.f + s1.x) + s0.x, o1 = v[j].y * rstd * gg.y * (1.f + s1.y) + s0.y;
                const float o2 = v[j].z * rstd * gg.z * (1.f + s1.z) + s0.z, o3 = v[j].w * rstd * gg.w * (1.f + s1.w) + s0.w;
                uint2 pk; pk.x = (unsigned)f2bf(o0) | ((unsigned)f2bf(o1) << 16); pk.y = (unsigned)f2bf(o2) | ((unsigned)f2bf(o3) << 16);
                *(uint2*)(dst + (size_t)m * DM + c0) = pk;
                sx[(c0 + 0) * 4 + tk] = o0; sx[(c0 + 1) * 4 + tk] = o1; sx[(c0 + 2) * 4 + tk] = o2; sx[(c0 + 3) * 4 + tk] = o3;
            }
        }
        __builtin_amdgcn_wave_barrier(); asm volatile("s_waitcnt lgkmcnt(0)" ::: "memory");
        float ae[4], ag[4];
        {
            float pe[4][4];
#pragma unroll
            for (int t_ = 0; t_ < 4; ++t_)
#pragma unroll
                for (int q = 0; q < 4; ++q) pe[t_][q] = 0.f;
            const int eq = lane & 7, kb = (lane >> 3) * 128;
#pragma unroll 16
            for (int i = 0; i < 128; ++i) { const float4 w = *(const float4*)(wer + (size_t)(kb + i) * 32 + 4 * eq); const float4 xv = *(const float4*)(sx + (kb + i) * 4);
                pe[0][0] += xv.x * w.x; pe[0][1] += xv.x * w.y; pe[0][2] += xv.x * w.z; pe[0][3] += xv.x * w.w;
                pe[1][0] += xv.y * w.x; pe[1][1] += xv.y * w.y; pe[1][2] += xv.y * w.z; pe[1][3] += xv.y * w.w;
                pe[2][0] += xv.z * w.x; pe[2][1] += xv.z * w.y; pe[2][2] += xv.z * w.z; pe[2][3] += xv.z * w.w;
                pe[3][0] += xv.w * w.x; pe[3][1] += xv.w * w.y; pe[3][2] += xv.w * w.z; pe[3][3] += xv.w * w.w; }
#pragma unroll
            for (int t_ = 0; t_ < 4; ++t_)
#pragma unroll
                for (int q = 0; q < 4; ++q) { float v = pe[t_][q]; v += __shfl_xor(v, 8); v += __shfl_xor(v, 16); v += __shfl_xor(v, 32); pe[t_][q] = v; }
#pragma unroll
            for (int t_ = 0; t_ < 4; ++t_) { const int srcl = (lane & 31) >> 2; const float v0 = __shfl(pe[t_][0], srcl), v1 = __shfl(pe[t_][1], srcl), v2 = __shfl(pe[t_][2], srcl), v3 = __shfl(pe[t_][3], srcl);
                const int cq = lane & 3; ae[t_] = cq == 0 ? v0 : (cq == 1 ? v1 : (cq == 2 ? v2 : v3)); }
            float pg_[4][4];
#pragma unroll
            for (int t_ = 0; t_ < 4; ++t_)
#pragma unroll
                for (int q = 0; q < 4; ++q) pg_[t_][q] = 0.f;
            const int kg = lane * 16;
#pragma unroll
            for (int i = 0; i < 16; ++i) { const float4 w = *(const float4*)(wgr + (size_t)(kg + i) * 4); const float4 xv = *(const float4*)(sx + (kg + i) * 4);
                pg_[0][0] += xv.x * w.x; pg_[0][1] += xv.x * w.y; pg_[0][2] += xv.x * w.z; pg_[0][3] += xv.x * w.w;
                pg_[1][0] += xv.y * w.x; pg_[1][1] += xv.y * w.y; pg_[1][2] += xv.y * w.z; pg_[1][3] += xv.y * w.w;
                pg_[2][0] += xv.z * w.x; pg_[2][1] += xv.z * w.y; pg_[2][2] += xv.z * w.z; pg_[2][3] += xv.z * w.w;
                pg_[3][0] += xv.w * w.x; pg_[3][1] += xv.w * w.y; pg_[3][2] += xv.w * w.z; pg_[3][3] += xv.w * w.w; }
#pragma unroll
            for (int t_ = 0; t_ < 4; ++t_) {
#pragma unroll
                for (int q = 0; q < 4; ++q) pg_[t_][q] = wave_sum(pg_[t_][q]);
                const int cq = lane & 3; ag[t_] = cq == 0 ? pg_[t_][0] : (cq == 1 ? pg_[t_][1] : (cq == 2 ? pg_[t_][2] : pg_[t_][3])); }
        }
#pragma unroll
        for (int tk = 0; tk < 4; ++tk) {
            float lg[4];
#pragma unroll
            for (int q = 0; q < 4; ++q) lg[q] = __shfl(ag[tk], q);
            int gs = 0; float mx = lg[0];
#pragma unroll
            for (int q = 1; q < 4; ++q) if (lg[q] > mx) { mx = lg[q]; gs = q; }
            float den = 0.f;
#pragma unroll
            for (int q = 0; q < 4; ++q) den += __expf(lg[q] - mx);
            const float pg = 1.f / den;
            float ev[8];
#pragma unroll
            for (int q = 0; q < 8; ++q) ev[q] = __shfl(ae[tk], gs * 8 + q) + eb[gs * 8 + q];
            int i0 = 0; float v0 = ev[0];
#pragma unroll
            for (int q = 1; q < 8; ++q) if (ev[q] > v0) { v0 = ev[q]; i0 = q; }
            int i1 = -1; float v1 = -INFINITY;
#pragma unroll
            for (int q = 0; q < 8; ++q) if (q != i0 && ev[q] > v1) { v1 = ev[q]; i1 = q; }
            if (lane == 0) {
                const float e1 = __expf(v1 - v0), w0 = pg / (1.f + e1), w1 = pg * e1 / (1.f + e1);
                const int x0 = gs * 8 + i0, x1 = gs * 8 + i1;
                const int rk0 = atomicAdd(&cntL[x0], 1), rk1 = atomicAdd(&cntL[32 + x1], 1);
                int4* route = (int4*)(p.ws + WS_ROUTE) + (size_t)(m0 + tk);
                *route = make_int4(x0 | (x1 << 8), rk0 | (rk1 << 16), __float_as_int(w0), __float_as_int(w1));
            }
        }
        __builtin_amdgcn_wave_barrier();
    }
    __syncthreads();
    if (tid < 64) ((int*)(p.ws + WS_CTL) + CT_CNTB)[blockIdx.x * 64 + tid] = cntL[tid];
}

namespace pg8 {
#define PG8_LAS __attribute__((address_space(3)))
typedef short bf16x8 __attribute__((ext_vector_type(8)));
typedef float f32x4 __attribute__((ext_vector_type(4)));
typedef unsigned u32x4 __attribute__((ext_vector_type(4)));
constexpr int BM = 256, BK = 64, HALF = 128, HTB = HALF * BK * 2, STAGE_BYTES = 8 * HTB, NXCD = 8, WGM = 8;
__host__ __device__ __forceinline__ int lds_byte(int r, int c) { const int st = (r >> 4) * 2 + (c >> 5), rr = r & 15, cc = c & 31, ob = rr * 64 + cc * 2; return st * 1024 + (ob ^ (((ob >> 9) & 1) << 5)); }
__host__ __device__ __forceinline__ void stage_rc(int b, int& R, int& C) { const int st = b / 1024, sb = b % 1024, swz = sb ^ (((sb >> 9) & 1) << 5); R = (st >> 1) * 16 + swz / 64; C = (st & 1) * 32 + (swz % 64) / 2; }
__host__ __device__ __forceinline__ int perm32(int rho) { const int n = rho >> 4, i = rho & 15; return 8 * (i >> 2) + 4 * n + (i & 3); }

struct Unit { int arow, brow, pm, pn, aux; };
struct Gemm { const bf16_t* A; const bf16_t* Bt; int K; const int* gather; };

struct StaticOrder {
    int nM, nN, nwg, G, c;
    __device__ void init(int M, int N, int G_, int c_) { nM = M / BM; nN = N / BM; nwg = nM * nN; G = G_; c = c_; }
    __device__ bool next(int i, Unit& u) const {
        const long L = (long)i * G + c; if (L >= nwg) return false;
        int wgid = (int)L; { const int q = nwg / NXCD, r = nwg % NXCD, xcd = wgid % NXCD, off = wgid / NXCD; wgid = (xcd < r ? xcd * (q + 1) : r * (q + 1) + (xcd - r) * q) + off; }
        const int nig = WGM * nN, gid = wgid / nig, fm = gid * WGM, gsz = (nM - fm) < WGM ? (nM - fm) : WGM;
        u.pm = fm + ((wgid % nig) % gsz); u.pn = (wgid % nig) / gsz; u.arow = u.pm * BM; u.brow = u.pn * BM; u.aux = 0; return true;
    }
};
struct BranchOrder {
    StaticOrder S0;
    __device__ bool next(int i, Unit& u) const {
        if (!S0.next(i >> 1, u)) return false;
        const int which = i & 1; u.arow += which * NT; u.brow += which * DM; u.aux = which; return true;
    }
};
struct TableOrder {
    const int4* tab; int n, G, c;
    __device__ bool next(int i, Unit& u) const {
        const int L = i * G + c; if (L >= n) return false;
        const int4 e = tab[L]; u.arow = __builtin_amdgcn_readfirstlane(e.x); u.brow = __builtin_amdgcn_readfirstlane(e.y); u.aux = __builtin_amdgcn_readfirstlane(e.z); u.pn = __builtin_amdgcn_readfirstlane(e.w); u.pm = 0; return true;
    }
};
__device__ __forceinline__ unsigned cvt_pk_bf16(float lo, float hi) { return pk_bf16(lo, hi); }

template <class Epi, class Sched>
__device__ __forceinline__ void gemm_phase(PG8_LAS unsigned char* lds, const Gemm g, const Sched& S, const Epi& E) {
    const int tid = otid(), wid = __builtin_amdgcn_readfirstlane(tid >> 6), lane = tid & 63, wr = wid >> 2, wc = wid & 3, fr = lane & 15, fq = lane >> 4;
    const int K = g.K, nt = K / BK;
    int RA0; unsigned cofA0, voffB0;
    { int R, C; stage_rc(tid * 16, R, C); const int Rb = Epi::PERM ? ((R & ~31) + perm32(R & 31)) : R; RA0 = R; cofA0 = (unsigned)C * 2u; voffB0 = (unsigned)(Rb * K + C) * 2u; }
    const size_t rstep64 = (size_t)64 * K * 2;
    const size_t kstep = (size_t)(BK * 2);
    const size_t hstep = (size_t)HALF * K * 2;
    const unsigned ldsw = (unsigned)wid * 1024u;
    const int aoff = lds_byte(wr * 64 + fr, fq * 8), boff = lds_byte(wc * 32 + fr, fq * 8);
#define PG8_SA(b, h) (((b) * 2 + (h)) * HTB)
#define PG8_SB(b, h) ((4 + (b) * 2 + (h)) * HTB)
#define PG8_STAGE_B(bufoff, gbase) do { _Pragma("unroll") for (int _i = 0; _i < 2; ++_i) \
        __builtin_amdgcn_global_load_lds((const unsigned*)((const char*)(gbase) + _i * rstep64 + voffB0), (PG8_LAS unsigned*)(lds + (bufoff) + ldsw + _i * 8192), 16, 0, 0); } while (0)
#define PG8_STAGE_A(bufoff, o2, kb) do { _Pragma("unroll") for (int _i = 0; _i < 2; ++_i) \
        __builtin_amdgcn_global_load_lds((const unsigned*)((const char*)g.A + (size_t)(o2)[_i] + (size_t)(kb)), (PG8_LAS unsigned*)(lds + (bufoff) + ldsw + _i * 8192), 16, 0, 0); } while (0)
#define PG8_LDA(dst, b, h) do { _Pragma("unroll") for (int m = 0; m < 4; ++m) _Pragma("unroll") for (int k = 0; k < 2; ++k) dst[m][k] = *(const PG8_LAS bf16x8*)(lds + PG8_SA(b, h) + aoff + m * 2048 + k * 1024); } while (0)
#define PG8_LDB(dst, b, h) do { _Pragma("unroll") for (int n = 0; n < 2; ++n) _Pragma("unroll") for (int k = 0; k < 2; ++k) dst[n][k] = *(const PG8_LAS bf16x8*)(lds + PG8_SB(b, h) + boff + n * 2048 + k * 1024); } while (0)
#define PG8_MMA(ai, bj, At, Bt) do { __builtin_amdgcn_s_setprio(1); _Pragma("unroll") for (int m = 0; m < 4; ++m) _Pragma("unroll") for (int n = 0; n < 2; ++n) _Pragma("unroll") for (int k = 0; k < 2; ++k) \
        acc[ai][bj][m][n] = __builtin_amdgcn_mfma_f32_16x16x32_bf16(Bt[n][k], At[m][k], acc[ai][bj][m][n], 0, 0, 0); __builtin_amdgcn_s_setprio(0); } while (0)
#define PG8_WAIT_V(n) asm volatile("s_waitcnt vmcnt(" #n ")" ::: "memory")
#define PG8_WAIT_L(n) asm volatile("s_waitcnt lgkmcnt(" #n ")" ::: "memory")
#define PG8_BAR __builtin_amdgcn_s_barrier()
#define PG8_SCHED __builtin_amdgcn_sched_barrier(0)
#define PG8_AOFFS(u, dst) do { _Pragma("unroll") for (int _h = 0; _h < 2; ++_h) _Pragma("unroll") for (int _i = 0; _i < 2; ++_i) { \
        const int _tr = (u).arow + _h * HALF + RA0 + 64 * _i; const unsigned _row = g.gather ? (unsigned)g.gather[_tr] : (unsigned)_tr; dst[_h][_i] = _row * (unsigned)(K * 2) + cofA0; } } while (0)
    Unit cur, nxt; int ui = 0;
    if (!S.next(0, cur)) return;
    f32x4 acc[2][2][4][2];
#pragma unroll
    for (int a = 0; a < 2; ++a)
#pragma unroll
        for (int b = 0; b < 2; ++b)
#pragma unroll
            for (int m = 0; m < 4; ++m)
#pragma unroll
                for (int n = 0; n < 2; ++n) acc[a][b][m][n] = (f32x4){0.f, 0.f, 0.f, 0.f};
    bf16x8 At[4][2], B0[2][2], B1[2][2];
    unsigned cof[2][2];
    PG8_AOFFS(cur, cof);
    const char* cB = (const char*)g.Bt + (size_t)cur.brow * K * 2;
    PG8_STAGE_B(PG8_SB(0, 0), cB); PG8_STAGE_B(PG8_SB(0, 1), cB + hstep); PG8_STAGE_A(PG8_SA(0, 0), cof[0], 0); PG8_STAGE_A(PG8_SA(0, 1), cof[1], 0);
    if (wr == 1) PG8_BAR;
    PG8_WAIT_V(2); PG8_BAR;
    PG8_STAGE_B(PG8_SB(1, 0), cB + kstep); PG8_STAGE_A(PG8_SA(1, 0), cof[0], kstep); PG8_STAGE_B(PG8_SB(1, 1), cB + hstep + kstep);
    PG8_WAIT_V(6); PG8_BAR;
    for (;;) {
        const bool has_next = S.next(ui + 1, nxt);
        if (!has_next) nxt = cur;
        const char* nB = (const char*)g.Bt + (size_t)nxt.brow * K * 2;
        for (int t = 0; t < nt; t += 2) {
            const bool last = (t == nt - 2);
            const size_t k1 = (size_t)(t + 1) * kstep;
            const size_t k2 = last ? 0 : (size_t)(t + 2) * kstep, k3 = k2 + kstep;
            const char* b2 = last ? nB : cB + (size_t)(t + 2) * kstep; const char* b3 = b2 + kstep;
            PG8_LDB(B0, 0, 0); PG8_LDB(B1, 0, 1); PG8_SCHED; PG8_LDA(At, 0, 0); PG8_STAGE_A(PG8_SA(1, 1), cof[1], k1);
            if (last) { PG8_AOFFS(nxt, cof); }
            PG8_WAIT_V(8); PG8_WAIT_L(0); PG8_BAR; PG8_MMA(0, 0, At, B0); PG8_MMA(0, 1, At, B1); PG8_BAR; PG8_SCHED;
            PG8_LDA(At, 0, 1); PG8_STAGE_B(PG8_SB(0, 0), b2); PG8_STAGE_B(PG8_SB(0, 1), b2 + hstep); PG8_STAGE_A(PG8_SA(0, 0), cof[0], k2);
            PG8_WAIT_V(8); PG8_WAIT_L(0); PG8_BAR; PG8_MMA(1, 0, At, B0); PG8_MMA(1, 1, At, B1); PG8_BAR; PG8_SCHED;
            PG8_LDB(B0, 1, 0); PG8_LDB(B1, 1, 1); PG8_SCHED; PG8_LDA(At, 1, 0); PG8_STAGE_A(PG8_SA(0, 1), cof[1], k2);
            PG8_WAIT_V(8); PG8_WAIT_L(0); PG8_BAR; PG8_MMA(0, 0, At, B0); PG8_MMA(0, 1, At, B1); PG8_BAR; PG8_SCHED;
            PG8_LDA(At, 1, 1); PG8_STAGE_B(PG8_SB(1, 0), b3); PG8_STAGE_B(PG8_SB(1, 1), b3 + hstep); PG8_STAGE_A(PG8_SA(1, 0), cof[0], k3);
            PG8_WAIT_V(8); PG8_WAIT_L(0); PG8_BAR; PG8_MMA(1, 0, At, B0); PG8_MMA(1, 1, At, B1); PG8_BAR; PG8_SCHED;
        }
        if (wr == 0) PG8_BAR;
        { const int l2 = otid() & 63; E(acc, cur, wr, wc, l2 & 15, l2 >> 4); }
        if (!has_next) break;
#pragma unroll
        for (int a = 0; a < 2; ++a)
#pragma unroll
            for (int b = 0; b < 2; ++b)
#pragma unroll
                for (int m = 0; m < 4; ++m)
#pragma unroll
                    for (int n = 0; n < 2; ++n) acc[a][b][m][n] = (f32x4){0.f, 0.f, 0.f, 0.f};
        cur = nxt; cB = nB; ++ui;
        if (wr == 1) PG8_BAR;
    }
    PG8_WAIT_V(0);
    PG8_BAR;
#undef PG8_SA
#undef PG8_SB
#undef PG8_STAGE_A
#undef PG8_STAGE_B
#undef PG8_LDA
#undef PG8_LDB
#undef PG8_MMA
#undef PG8_WAIT_V
#undef PG8_WAIT_L
#undef PG8_BAR
#undef PG8_SCHED
#undef PG8_AOFFS
}

#define PG8_FENCE asm volatile("" ::: "memory")
#define PG8_FOR_TILE(ai, m, bj) _Pragma("unroll") for (int ai = 0; ai < 2; ++ai) _Pragma("unroll") for (int m = 0; m < 4; ++m) _Pragma("unroll") for (int bj = 0; bj < 2; ++bj)
__device__ __forceinline__ u32x4 pack8(const f32x4& v0, const f32x4& v1) { u32x4 w; w.x = cvt_pk_bf16(v0[0], v0[1]); w.y = cvt_pk_bf16(v0[2], v0[3]); w.z = cvt_pk_bf16(v1[0], v1[1]); w.w = cvt_pk_bf16(v1[2], v1[3]); return w; }
__device__ __forceinline__ float sigm(float x) { return __builtin_amdgcn_rcpf(1.f + __expf(-x)); }
struct EpiInproj {
    static constexpr bool PERM = true;
    unsigned char* ws; bf16_t* gates;
    __device__ __forceinline__ void operator()(const f32x4 (&acc)[2][2][4][2], const Unit& u, int wr, int wc, int fr, int fq) const {
        PG8_FOR_TILE(ai, m, bj) { PG8_FENCE;
            int row = u.pm * BM + ai * HALF + wr * 64 + m * 16 + fr; asm volatile("" : "+v"(row)); const int col = u.pn * BM + bj * HALF + wc * 32 + 8 * fq;
            const f32x4 v0 = acc[ai][bj][m][0], v1 = acc[ai][bj][m][1];
            if (col < C_KV) *(u32x4*)((bf16_t*)(ws + WS_Q) + (size_t)row * AW + col) = pack8(v0, v1);
            else if (col < C_QI) {
                *(u32x4*)((bf16_t*)(ws + WS_KVN) + (size_t)row * KVL + (col - C_KV)) = pack8(v0, v1);
                float ss = (v0[0] * v0[0] + v0[1] * v0[1]) + (v0[2] * v0[2] + v0[3] * v0[3]) + (v1[0] * v1[0] + v1[1] * v1[1]) + (v1[2] * v1[2] + v1[3] * v1[3]);
                ss += __shfl_xor(ss, 16); ss += __shfl_xor(ss, 32);
                if (fq == 0) ((float*)(ws + WS_RSS))[(size_t)row * 8 + bj * 4 + wc] = ss;
            }
            else if (col < C_PS) {
                if (col < 1056) {
                    typedef _Float16 h8 __attribute__((ext_vector_type(8)));
                    h8 hv; hv[0] = (_Float16)v0[0]; hv[1] = (_Float16)v0[1]; hv[2] = (_Float16)v0[2]; hv[3] = (_Float16)v0[3]; hv[4] = (_Float16)v1[0]; hv[5] = (_Float16)v1[1]; hv[6] = (_Float16)v1[2]; hv[7] = (_Float16)v1[3];
                    _Float16* d = (col < 1024) ? (_Float16*)(ws + WS_QI) + (size_t)row * 256 + (col - C_QI) : (_Float16*)(ws + WS_KI) + (size_t)row * 32 + (col - 1024);
                    *(h8*)d = hv;
                } else { const float sc_ = 0.17677669529663687f * 0.35355339059327373f; float* d = (float*)(ws + WS_WI) + (size_t)row * 8; *(f32x4*)d = v0 * sc_; *(f32x4*)(d + 4) = v1 * sc_; }
            }
            else if (col < C_GA) *(u32x4*)((bf16_t*)(ws + WS_PS) + (size_t)row * SHW + (col - C_PS)) = pack8(v0, v1);
            else if (col < INW) {
                f32x4 s0, s1;
#pragma unroll
                for (int e = 0; e < 4; ++e) { s0[e] = sigm(v0[e]); s1[e] = sigm(v1[e]); }
                bf16_t* d = (col < C_GR) ? gates + (size_t)row * DM + (col - C_GA) : gates + (size_t)NT * DM + (size_t)row * DM + (col - C_GR);
                *(u32x4*)d = pack8(s0, s1);
            }
        }
    }
};
struct EpiKV {
    static constexpr bool PERM = true;
    unsigned char* ws;
    __device__ __forceinline__ void operator()(const f32x4 (&acc)[2][2][4][2], const Unit& u, int wr, int wc, int fr, int fq) const {
        PG8_FOR_TILE(ai, m, bj) { PG8_FENCE;
            int row = u.pm * BM + ai * HALF + wr * 64 + m * 16 + fr; asm volatile("" : "+v"(row)); const int col = u.pn * BM + bj * HALF + wc * 32 + 8 * fq;
            const f32x4 ra = *(const f32x4*)((const float*)(ws + WS_RSS) + (size_t)row * 8), rb = *(const f32x4*)((const float*)(ws + WS_RSS) + (size_t)row * 8 + 4);
            const float rstd = rsqrtf((((ra[0] + ra[1]) + (ra[2] + ra[3])) + ((rb[0] + rb[1]) + (rb[2] + rb[3]))) * (1.f / KVL) + NORM_EPS);
            if (col < AW) *(u32x4*)((bf16_t*)(ws + WS_K) + (size_t)row * AW + col) = pack8(acc[ai][bj][m][0] * rstd, acc[ai][bj][m][1] * rstd);
            else {
                bf16_t* d = (bf16_t*)(ws + WS_V) + ((size_t)(row / SEQ) * 512 + (col - AW)) * SEQ + (row % SEQ);
#pragma unroll
                for (int e = 0; e < 4; ++e) { d[(size_t)e * SEQ] = f2bf(acc[ai][bj][m][0][e] * rstd); d[(size_t)(4 + e) * SEQ] = f2bf(acc[ai][bj][m][1][e] * rstd); }
            }
        }
    }
};
struct EpiMerge {
    static constexpr bool PERM = true;
    bf16_t* merged; const bf16_t* gates;
    __device__ __forceinline__ void operator()(const f32x4 (&acc)[2][2][4][2], const Unit& u, int wr, int wc, int fr, int fq) const {
        const bf16_t* gate = gates + (size_t)u.aux * NT * DM;
        PG8_FOR_TILE(ai, m, bj) { PG8_FENCE;
            int row = u.pm * BM + ai * HALF + wr * 64 + m * 16 + fr; asm volatile("" : "+v"(row)); const int col = u.pn * BM + bj * HALF + wc * 32 + 8 * fq;
            const u32x4 gw = *(const u32x4*)(gate + (size_t)row * DM + col);
            f32x4 v0 = acc[ai][bj][m][0], v1 = acc[ai][bj][m][1];
            v0[0] *= __uint_as_float(gw.x << 16); v0[1] *= __uint_as_float(gw.x & 0xffff0000u); v0[2] *= __uint_as_float(gw.y << 16); v0[3] *= __uint_as_float(gw.y & 0xffff0000u);
            v1[0] *= __uint_as_float(gw.z << 16); v1[1] *= __uint_as_float(gw.z & 0xffff0000u); v1[2] *= __uint_as_float(gw.w << 16); v1[3] *= __uint_as_float(gw.w & 0xffff0000u);
            u32x4* d = (u32x4*)(merged + (size_t)row * DM + col);
            if (u.aux) { const u32x4 pw = *d;
                v0[0] += __uint_as_float(pw.x << 16); v0[1] += __uint_as_float(pw.x & 0xffff0000u); v0[2] += __uint_as_float(pw.y << 16); v0[3] += __uint_as_float(pw.y & 0xffff0000u);
                v1[0] += __uint_as_float(pw.z << 16); v1[1] += __uint_as_float(pw.z & 0xffff0000u); v1[2] += __uint_as_float(pw.w << 16); v1[3] += __uint_as_float(pw.w & 0xffff0000u); }
            *d = pack8(v0, v1);
        }
    }
};
struct EpiOut {
    static constexpr bool PERM = false;
    const float* x; const float* mod; float* out;
    __device__ __forceinline__ void operator()(const f32x4 (&acc)[2][2][4][2], const Unit& u, int wr, int wc, int fr, int fq) const {
        PG8_FOR_TILE(ai, m, bj) { PG8_FENCE;
            int row = u.pm * BM + ai * HALF + wr * 64 + m * 16 + fr; asm volatile("" : "+v"(row)); const float* gt = mod + (row / SEQ) * 6 * DM + 2 * DM;
#pragma unroll
            for (int n = 0; n < 2; ++n) { const int col = u.pn * BM + bj * HALF + wc * 32 + 16 * n + 4 * fq;
                const f32x4 xv = *(const f32x4*)(x + (size_t)row * DM + col), gv = *(const f32x4*)(gt + col);
                *(f32x4*)(out + (size_t)row * DM + col) = xv + gv * acc[ai][bj][m][n]; }
        }
    }
};
struct EpiMoe1 {
    static constexpr bool PERM = true;
    bf16_t* hid; const float* lw;
    __device__ __forceinline__ void operator()(const f32x4 (&acc)[2][2][4][2], const Unit& u, int wr, int wc, int fr, int fq) const {
#pragma unroll
        for (int ai = 0; ai < 2; ++ai)
#pragma unroll
            for (int m = 0; m < 4; ++m) {
                const int tr = ai * HALF + wr * 64 + m * 16 + fr; PG8_FENCE;
                if (tr < u.aux) {
                    const float w = lw[u.arow + tr]; f32x4 h0, h1;
#pragma unroll
                    for (int e = 0; e < 4; ++e) { const float g0 = acc[ai][0][m][0][e], g1 = acc[ai][0][m][1][e];
                        h0[e] = w * (g0 * __builtin_amdgcn_rcpf(1.f + __expf(-g0))) * acc[ai][1][m][0][e]; h1[e] = w * (g1 * __builtin_amdgcn_rcpf(1.f + __expf(-g1))) * acc[ai][1][m][1][e]; }
                    *(u32x4*)(hid + (size_t)(u.arow + tr) * DE + u.pn * HALF + wc * 32 + 8 * fq) = pack8(h0, h1);
                }
            }
    }
};
struct EpiMoe2 {
    static constexpr bool PERM = false;
    const int* ltok; const float* mod; float* out;
    __device__ __forceinline__ void operator()(const f32x4 (&acc)[2][2][4][2], const Unit& u, int wr, int wc, int fr, int fq) const {
#pragma unroll
        for (int ai = 0; ai < 2; ++ai)
#pragma unroll
            for (int m = 0; m < 4; ++m) {
                const int tr = ai * HALF + wr * 64 + m * 16 + fr; PG8_FENCE;
                if (tr < u.aux) {
                    const int tok = ltok[u.arow + tr]; const float* gt = mod + (tok / SEQ) * 6 * DM + 5 * DM; float* orow = out + (size_t)tok * DM;
#pragma unroll
                    for (int bj = 0; bj < 2; ++bj)
#pragma unroll
                        for (int n = 0; n < 2; ++n) { const int col = u.pn * BM + bj * HALF + wc * 32 + 16 * n + 4 * fq;
                            const f32x4 gv = *(const f32x4*)(gt + col); f32x4* d = (f32x4*)(orow + col); *d = *d + gv * acc[ai][bj][m][n]; }
                }
            }
    }
};
}

__device__ __forceinline__ unsigned pk2(float lo, float hi) { return (unsigned)f2bf(lo) | ((unsigned)f2bf(hi) << 16); }
__device__ __forceinline__ void transpose_item(const float* W, int K, int N, bf16_t* WT, size_t drow0, int k0, int n0, float* scr, int lane, int Ksrc = 1 << 30, const float* kscale = nullptr) {
#pragma unroll 8
    for (int i = 0; i < 32; ++i) { const int kk = 2 * i + (lane >> 5), n = n0 + (lane & 31); float v_ = (n < N && k0 + kk < Ksrc) ? W[(size_t)(k0 + kk) * N + n] : 0.f; if (kscale) v_ *= kscale[k0 + kk]; scr[kk * 33 + (lane & 31)] = v_; }
    asm volatile("s_waitcnt lgkmcnt(0)" ::: "memory");
    const int c = lane & 7;
#pragma unroll
    for (int j = 0; j < 4; ++j) { const int n = (lane >> 3) + 8 * j; const float* s_ = scr + (8 * c) * 33 + n;
        uint4 o; o.x = pk2(s_[0 * 33], s_[1 * 33]); o.y = pk2(s_[2 * 33], s_[3 * 33]); o.z = pk2(s_[4 * 33], s_[5 * 33]); o.w = pk2(s_[6 * 33], s_[7 * 33]);
        *(uint4*)(WT + (drow0 + n) * K + k0 + 8 * c) = o; }
    asm volatile("s_waitcnt lgkmcnt(0)" ::: "memory");
}
__device__ __forceinline__ void transpose_item64(const float* W, int K, int N, bf16_t* WT, size_t drow0, int k0, int n0, float* scr, int lane, const float* kscale = nullptr) {
    const int r_ = lane >> 4, c4 = (lane & 15) * 4, n = n0 + c4;
    float4 v[16];
#pragma unroll
    for (int i = 0; i < 16; ++i) { v[i] = make_float4(0.f, 0.f, 0.f, 0.f); if (n < N) v[i] = *(const float4*)(W + (size_t)(k0 + r_ + 4 * i) * N + n); }
#pragma unroll
    for (int i = 0; i < 16; ++i) { const int kk = r_ + 4 * i; float4 x = v[i]; if (kscale) { const float s_ = kscale[k0 + kk]; x.x *= s_; x.y *= s_; x.z *= s_; x.w *= s_; }
        float* d_ = scr + kk * 65 + c4; d_[0] = x.x; d_[1] = x.y; d_[2] = x.z; d_[3] = x.w; }
    asm volatile("s_waitcnt lgkmcnt(0)" ::: "memory");
    const int c = lane & 7;
#pragma unroll
    for (int j = 0; j < 8; ++j) { const int nn = (lane >> 3) + 8 * j; const float* s_ = scr + (8 * c) * 65 + nn;
        uint4 o; o.x = pk2(s_[0 * 65], s_[1 * 65]); o.y = pk2(s_[2 * 65], s_[3 * 65]); o.z = pk2(s_[4 * 65], s_[5 * 65]); o.w = pk2(s_[6 * 65], s_[7 * 65]);
        *(uint4*)(WT + (drow0 + nn) * K + k0 + 8 * c) = o; }
    asm volatile("s_waitcnt lgkmcnt(0)" ::: "memory");
}
__device__ void ph_convert_mixer_weights(const P& p, float* lds) {
    const int lane = otid() & 63, wv = otid() >> 6;
    float* scr = lds + wv * (64 * 65);
    const int gw = blockIdx.x * (NTHR / 64) + wv, nw = gridDim.x * (NTHR / 64);
    struct M { const float* W; int K, N, Npad; size_t dst; const float* ks; };
    const M ms[5] = { {p.in[5], DM, INW, 5120, WS_WIN, nullptr}, {p.in[7], KVL, 2 * AW, 2 * AW, WS_WKV, p.in[6]}, {p.in[21], AW, DM, DM, WS_WBA, nullptr}, {p.in[22], RW, DM, DM, WS_WBR, nullptr}, {p.in[23], DM, DM, DM, WS_WOUT, nullptr} };
    int base = 0;
#pragma unroll
    for (int q = 0; q < 5; ++q) {
        const int nkb = ms[q].K / 64, nnb = ms[q].Npad / 64, nitems = nkb * nnb;
        for (int it = gw; it < base + nitems; it += nw) { if (it < base) continue; const int r = it - base; const int kb = r / nnb, nb = r % nnb;
            transpose_item64(ms[q].W, ms[q].K, ms[q].N, (bf16_t*)(p.ws + ms[q].dst), (size_t)nb * 64, kb * 64, nb * 64, scr, lane, ms[q].ks); }
        base += nitems;
    }
}
__device__ void ph_convert_lora_weights(const P& p, float* lds) {
    const int lane = otid() & 63, wv = otid() >> 6;
    float* scr = lds + wv * (64 * 33);
    const int gw = blockIdx.x * (NTHR / 64) + wv, nw = gridDim.x * (NTHR / 64);
    for (int it = gw; it < 16 + 16 + 48; it += nw) {
        if (it < 16) transpose_item(p.in[12], 64, RW, (bf16_t*)(p.ws + WS_LW2T), (size_t)it * 32, 0, it * 32, scr, lane);
        else if (it < 32) transpose_item(p.in[14], 64, RW, (bf16_t*)(p.ws + WS_LA2T), (size_t)(it - 16) * 32, 0, (it - 16) * 32, scr, lane);
        else { const int r = it - 32, kb = r >> 4, nb = r & 15; transpose_item(p.in[15], 192, RW, (bf16_t*)(p.ws + WS_LG2T), (size_t)nb * 32, kb * 64, nb * 32, scr, lane, 160); }
    }
}
__device__ void ph_convert_expert_weights(const P& p, float* lds) {
    const int lane = otid() & 63, wv = otid() >> 6;
    float* scr = lds + wv * (64 * 65);
    const int gw = blockIdx.x * (NTHR / 64) + wv, nw = gridDim.x * (NTHR / 64);
    for (int it = gw; it < NE * 2 * 128; it += nw) { const int e = it >> 8, which = (it >> 7) & 1, r = it & 127, kb = r >> 3, nb = r & 7, n0 = nb * 64;
        transpose_item64(p.in[28 + which] + (size_t)e * DM * DE, DM, DE, (bf16_t*)(p.ws + WS_WGU), (size_t)e * 1024 + (n0 >> 7) * 256 + which * 128 + (n0 & 127), kb * 64, n0, scr, lane); }
    for (int it = gw; it < NE * 128; it += nw) { const int e = it >> 7, r = it & 127, kb = r >> 4, nb = r & 15;
        transpose_item64(p.in[30] + (size_t)e * DE * DM, DE, DM, (bf16_t*)(p.ws + WS_WDN), (size_t)e * 1024 + nb * 64, kb * 64, nb * 64, scr, lane); }
}

__device__ void ph_headnorm(bf16_t* X, const float* g) {
    const int lane = otid() & 63, wv = otid() >> 6;
    const int gw = blockIdx.x * (NTHR / 64) + wv, nw = gridDim.x * (NTHR / 64);
    for (int m = gw; m < NT; m += nw) {
        uint4 raw = *(const uint4*)(X + (size_t)m * AW + lane * 8);
        float v[8] = {bf2f(raw.x & 0xffff), bf2f(raw.x >> 16), bf2f(raw.y & 0xffff), bf2f(raw.y >> 16), bf2f(raw.z & 0xffff), bf2f(raw.z >> 16), bf2f(raw.w & 0xffff), bf2f(raw.w >> 16)};
        float ss = 0.f;
#pragma unroll
        for (int i = 0; i < 8; ++i) ss += v[i] * v[i];
        ss += __shfl_xor(ss, 1); ss += __shfl_xor(ss, 2); ss += __shfl_xor(ss, 4);
        const float rstd = rsqrtf(ss * (1.f / 64.f) + NORM_EPS);
        const int d0 = (lane & 7) * 8;
        unsigned o[4];
#pragma unroll
        for (int i = 0; i < 4; ++i) o[i] = (unsigned)f2bf(v[2 * i] * rstd * g[d0 + 2 * i]) | ((unsigned)f2bf(v[2 * i + 1] * rstd * g[d0 + 2 * i + 1]) << 16);
        *(uint4*)(X + (size_t)m * AW + lane * 8) = make_uint4(o[0], o[1], o[2], o[3]);
    }
}
__device__ void ph_kvnorm(bf16_t* X, const float* g) {
    const int lane = otid() & 63, wv = otid() >> 6;
    const int gw = blockIdx.x * (NTHR / 64) + wv, nw = gridDim.x * (NTHR / 64);
    for (int m = gw; m < NT; m += nw) {
        uint2 raw = *(const uint2*)(X + (size_t)m * KVL + lane * 4);
        float v[4] = {bf2f(raw.x & 0xffff), bf2f(raw.x >> 16), bf2f(raw.y & 0xffff), bf2f(raw.y >> 16)};
        float ss = wave_sum(v[0] * v[0] + v[1] * v[1] + v[2] * v[2] + v[3] * v[3]);
        const float rstd = rsqrtf(ss * (1.f / 256.f) + NORM_EPS);
        uint2 o; o.x = (unsigned)f2bf(v[0] * rstd * g[lane * 4]) | ((unsigned)f2bf(v[1] * rstd * g[lane * 4 + 1]) << 16);
        o.y = (unsigned)f2bf(v[2] * rstd * g[lane * 4 + 2]) | ((unsigned)f2bf(v[3] * rstd * g[lane * 4 + 3]) << 16);
        *(uint2*)(X + (size_t)m * KVL + lane * 4) = o;
    }
}

typedef _Float16 half8_t __attribute__((ext_vector_type(8)));
typedef float f32x16_t __attribute__((ext_vector_type(16)));
__device__ __forceinline__ unsigned f2key(float f) { unsigned u = __float_as_uint(f); return (u & 0x80000000u) ? ~u : (u | 0x80000000u); }
template <bool PASS1, bool FULL>
__device__ __forceinline__ void d1_unit(const half8_t& a0, const half8_t& a1, const half8_t& b0, const half8_t& b1, const float (&w)[4][4], int rg, int hh, int r32, int tile, int t0,
                                        unsigned* hist, unsigned* maskl, int* misc, uint2* cand, int tbA, int tbB) {
    constexpr int CCAP = 1024;
    f32x16_t c;
#pragma unroll
    for (int i = 0; i < 16; ++i) c[i] = 0.f;
    c = __builtin_amdgcn_mfma_f32_32x32x16_f16(a0, b0, c, 0, 0, 0);
    c = __builtin_amdgcn_mfma_f32_32x32x16_f16(a1, b1, c, 0, 0, 0);
    float x[4];
#pragma unroll
    for (int tl = 0; tl < 4; ++tl) { x[tl] = 0.f;
#pragma unroll
        for (int e = 0; e < 4; ++e) x[tl] = __builtin_fmaf(w[tl][e], __int_as_float(max(__float_as_int(c[4 * tl + e]), 0)), x[tl]); }
    const auto s01 = __builtin_amdgcn_permlane32_swap(__float_as_uint(x[0]), __float_as_uint(x[1]), false, false);
    const auto s23 = __builtin_amdgcn_permlane32_swap(__float_as_uint(x[2]), __float_as_uint(x[3]), false, false);
    const unsigned k01 = f2key(__uint_as_float(s01[0]) + __uint_as_float(s01[1]));
    const unsigned k23 = f2key(__uint_as_float(s23[0]) + __uint_as_float(s23[1]));
    const int rowA = 4 * rg + hh, rowB = rowA + 2, key = tile * 32 + r32;
    const bool okA = FULL || key <= t0 + rowA, okB = FULL || key <= t0 + rowB;
    if (!PASS1) {
        atomicAdd(&hist[okA ? rowA * 2048 + (int)(k01 >> 21) : 8 * 2048 + 16384 + 2048 + 7], 1u << (16 * ((k01 >> 20) & 1u)));
        atomicAdd(&hist[okB ? rowB * 2048 + (int)(k23 >> 21) : 8 * 2048 + 16384 + 2048 + 7], 1u << (16 * ((k23 >> 20) & 1u)));
    } else {
        const int binA = (int)(k01 >> 20), binB = (int)(k23 >> 20);
        const unsigned long long mA = __ballot(okA && binA > tbA), mB = __ballot(okB && binB > tbB);
        if (r32 == 0) { maskl[rowA * 256 + tile] = hh ? (unsigned)(mA >> 32) : (unsigned)mA; maskl[rowB * 256 + tile] = hh ? (unsigned)(mB >> 32) : (unsigned)mB; }
        if (okA && binA == tbA) { const int pos = atomicAdd(&misc[rowA * 8 + 2], 1); if (pos < CCAP) cand[rowA * CCAP + pos] = make_uint2(k01, (unsigned)key); }
        if (okB && binB == tbB) { const int pos = atomicAdd(&misc[rowB * 8 + 2], 1); if (pos < CCAP) cand[rowB * CCAP + pos] = make_uint2(k23, (unsigned)key); }
    }
}
__device__ void ph_dsa_select(const P& p, float* ldsf) {
    const _Float16* QI = (const _Float16*)(p.ws + WS_QI); const _Float16* KI = (const _Float16*)(p.ws + WS_KI); const float* WI = (const float*)(p.ws + WS_WI);
    unsigned* MASK32 = (unsigned*)(p.ws + WS_MASK);
    unsigned* hist = (unsigned*)ldsf;
    uint2* cand = (uint2*)(hist + 8 * 2048);
    unsigned* maskl = (unsigned*)(cand + 8 * 1024);
    unsigned* h2 = hist;
    int* misc = (int*)(maskl + 8 * 256);
    constexpr int CCAP = 1024;
    const int tid = otid(), lane = tid & 63, wv = tid >> 6, hh = lane >> 5, r32 = lane & 31;
    int* qhead = (int*)(p.ws + WS_CTL) + CT_Q + 16; int* qslot = misc + 64;
    __syncthreads();
    if (tid == 0) qslot[0] = atomicAdd(qhead, 1);
#pragma unroll 1
    for (int it = 0;; ++it) {
        __syncthreads();
        const int kq = __builtin_amdgcn_readfirstlane(qslot[it & 1]);
        if (kq >= NT / 8) break;
        const int item = (kq & 1) * (SEQ / 8) + (SEQ / 8 - 1 - (kq >> 1));
        const int tq0 = item * 8, b = tq0 / SEQ, t0 = tq0 % SEQ;
        const int nwords = ((t0 >> 8) + 1) * 8;
        int nxt = 0;
        if (t0 + 7 < TOPK) {
            if (tid == 0) nxt = atomicAdd(qhead, 1);
            for (int e = tid; e < 8 * nwords; e += NTHR) { const int row = e / nwords, w = e % nwords; const int tr_ = t0 + row; const int lo = 32 * w;
                const unsigned bits = (tr_ >= lo + 31) ? 0xffffffffu : ((tr_ < lo) ? 0u : ((2u << (tr_ - lo)) - 1u));
                MASK32[(size_t)(tq0 + row) * 256 + w] = bits; }
            if (tid == 0) qslot[(it & 1) ^ 1] = nxt;
            continue;
        }
        for (int e = tid; e < 8 * 2048; e += NTHR) hist[e] = 0u;
        for (int e = tid; e < 8 * 256; e += NTHR) maskl[e] = 0u;
        if (tid < 64) misc[tid] = 0;
        half8_t a0[2], a1[2]; float w[2][4][4];
#pragma unroll
        for (int rg = 0; rg < 2; ++rg) { const int tl_a = r32 >> 3, h_a = r32 & 7; const _Float16* qp = QI + (size_t)(tq0 + 4 * rg + tl_a) * 256 + h_a * 32 + 8 * hh;
            a0[rg] = *(const half8_t*)qp; a1[rg] = *(const half8_t*)(qp + 16);
#pragma unroll
            for (int tl = 0; tl < 4; ++tl) { const float4 wv4 = *(const float4*)(WI + (size_t)(tq0 + 4 * rg + tl) * 8 + 4 * hh); w[rg][tl][0] = wv4.x; w[rg][tl][1] = wv4.y; w[rg][tl][2] = wv4.z; w[rg][tl][3] = wv4.w; } }
        const int ntile = (t0 + 7) / 32 + 1;
        __syncthreads();
        int thr_bin[8];
#pragma unroll 1
        for (int pass = 0; pass < 2; ++pass) {
            if (pass == 1) {
#pragma unroll
                for (int r = 0; r < 8; ++r) thr_bin[r] = misc[r * 8];
            }
            half8_t kb0[4], kb1[4], nk0[4], nk1[4];
#pragma unroll
            for (int q = 0; q < 4; ++q) { const int tl_ = min(4 * wv + q, ntile - 1); const _Float16* kp = KI + (size_t)(b * SEQ + tl_ * 32 + r32) * 32 + 8 * hh; nk0[q] = *(const half8_t*)kp; nk1[q] = *(const half8_t*)(kp + 16); }
            for (int tbase = 4 * wv; tbase < ntile; tbase += 32) {
#pragma unroll
                for (int q = 0; q < 4; ++q) { kb0[q] = nk0[q]; kb1[q] = nk1[q]; }
                if (tbase + 32 < ntile) {
#pragma unroll
                    for (int q = 0; q < 4; ++q) { const int tl_ = min(tbase + 32 + q, ntile - 1); const _Float16* kp = KI + (size_t)(b * SEQ + tl_ * 32 + r32) * 32 + 8 * hh; nk0[q] = *(const half8_t*)kp; nk1[q] = *(const half8_t*)(kp + 16); }
                }
#pragma unroll
                for (int q = 0; q < 4; ++q) {
                const int tile = tbase + q;
                if (tile < ntile) {
                const half8_t b0 = kb0[q], b1 = kb1[q];
                const bool full = tile * 32 + 31 <= t0;
#pragma unroll
                for (int rg = 0; rg < 2; ++rg) {
                    const int tbA = hh ? thr_bin[4 * rg + 1] : thr_bin[4 * rg], tbB = hh ? thr_bin[4 * rg + 3] : thr_bin[4 * rg + 2];
                    if (pass == 0) { if (full) d1_unit<false, true>(a0[rg], a1[rg], b0, b1, w[rg], rg, hh, r32, tile, t0, hist, maskl, misc, cand, 0, 0);
                                     else d1_unit<false, false>(a0[rg], a1[rg], b0, b1, w[rg], rg, hh, r32, tile, t0, hist, maskl, misc, cand, 0, 0); }
                    else { if (full) d1_unit<true, true>(a0[rg], a1[rg], b0, b1, w[rg], rg, hh, r32, tile, t0, hist, maskl, misc, cand, tbA, tbB);
                           else d1_unit<true, false>(a0[rg], a1[rg], b0, b1, w[rg], rg, hh, r32, tile, t0, hist, maskl, misc, cand, tbA, tbB); }
                }
                }
                }
            }
            __syncthreads();
            if (pass == 0) {
                const unsigned* hrw = hist + wv * 2048; unsigned tot = 0;
                { const uint4* h4 = (const uint4*)(hrw + 32 * lane);
#pragma unroll
                  for (int i = 0; i < 8; ++i) { const uint4 v = h4[i]; tot += (v.x & 0xffffu) + (v.x >> 16) + (v.y & 0xffffu) + (v.y >> 16) + (v.z & 0xffffu) + (v.z >> 16) + (v.w & 0xffffu) + (v.w >> 16); } }
                unsigned suf = tot;
#pragma unroll
                for (int o = 1; o < 64; o <<= 1) { const unsigned oth = __shfl_down(suf, o); if (lane + o < 64) suf += oth; }
                const unsigned above = suf - tot;
                const unsigned long long hit = __ballot((int)above < TOPK && TOPK <= (int)(above + tot));
                const int lsel = __ffsll((long long)hit) - 1; const unsigned above_g = __shfl(above, lsel);
                const unsigned wd = hrw[32 * lsel + (lane >> 1)]; const unsigned cnt = (lane & 1) ? (wd >> 16) : (wd & 0xffffu);
                unsigned s2 = cnt;
#pragma unroll
                for (int o = 1; o < 64; o <<= 1) { const unsigned oth = __shfl_down(s2, o); if (lane + o < 64) s2 += oth; }
                const unsigned ab2 = above_g + s2 - cnt;
                if ((int)ab2 < TOPK && TOPK <= (int)(ab2 + cnt)) { misc[wv * 8] = 64 * lsel + lane; misc[wv * 8 + 1] = TOPK - (int)ab2; }
                __syncthreads();
            }
        }
        if (tid == 0) nxt = atomicAdd(qhead, 1);
        {
            const int row = wv, need0 = misc[row * 8 + 1]; const int cn = min(misc[row * 8 + 2], CCAP);
            const uint2* cr = cand + row * CCAP; unsigned* hrow = h2 + row * 256;
            unsigned prefix = 0; int remaining = need0, cnt_eq = cn;
#pragma unroll 1
            for (int pass = 0; pass < 3; ++pass) {
                const int shift = (pass == 0) ? 12 : ((pass == 1) ? 4 : 0), nb = (pass == 2) ? 4 : 8;
                for (int i = lane; i < 256; i += 64) hrow[i] = 0u;
                __builtin_amdgcn_wave_barrier(); asm volatile("s_waitcnt lgkmcnt(0)" ::: "memory");
                for (int i = lane; i < cn; i += 64) { const unsigned k = cr[i].x & 0xfffffu; if (pass == 0 || (k >> (shift + nb)) == (prefix >> (shift + nb))) atomicAdd(&hrow[(k >> shift) & ((1u << nb) - 1u)], 1u); }
                __builtin_amdgcn_wave_barrier(); asm volatile("s_waitcnt lgkmcnt(0)" ::: "memory");
                const unsigned h0 = hrow[4 * lane], h1 = hrow[4 * lane + 1], h2_ = hrow[4 * lane + 2], h3 = hrow[4 * lane + 3];
                unsigned suf = h0 + h1 + h2_ + h3;
#pragma unroll
                for (int o = 1; o < 64; o <<= 1) { const unsigned oth = __shfl_down(suf, o); if (lane + o < 64) suf += oth; }
                const unsigned above3 = suf - (h0 + h1 + h2_ + h3);
                const unsigned ab[4] = {above3 + h3 + h2_ + h1, above3 + h3 + h2_, above3 + h3, above3}; const unsigned hv[4] = {h0, h1, h2_, h3};
                int selbin = -1, newrem = 0, neweq = 0;
#pragma unroll
                for (int q = 0; q < 4; ++q) if ((int)ab[q] < remaining && remaining <= (int)(ab[q] + hv[q])) { selbin = 4 * lane + q; newrem = remaining - (int)ab[q]; neweq = (int)hv[q]; }
                const unsigned long long has = __ballot(selbin >= 0); const int src = __ffsll((long long)has) - 1;
                selbin = __shfl(selbin, src); newrem = __shfl(newrem, src); neweq = __shfl(neweq, src);
                prefix |= ((unsigned)selbin) << shift; remaining = newrem; cnt_eq = neweq;
            }
            for (int i0 = 0; i0 < cn; i0 += 64) { const int i = i0 + lane; bool sel = false;
                if (i < cn) { const uint2 ce = cr[i]; const unsigned k = ce.x & 0xfffffu;
                    if (k > prefix) sel = true;
                    else if (k == prefix) { if (cnt_eq == remaining) sel = true; else { int rank = 0; for (int j = 0; j < cn; ++j) { const uint2 cj = cr[j]; rank += ((cj.x & 0xfffffu) == prefix && cj.y < ce.y) ? 1 : 0; } sel = rank < remaining; } }
                    if (sel) atomicOr(&maskl[row * 256 + (ce.y >> 5)], 1u << (ce.y & 31)); } }
        }
        __syncthreads();
        for (int e = tid; e < 8 * nwords; e += NTHR) { const int row = e / nwords, w2 = e % nwords; MASK32[(size_t)(tq0 + row) * 256 + w2] = maskl[row * 256 + w2]; }
        if (tid == 0) qslot[(it & 1) ^ 1] = nxt;
    }
}

__device__ void knorm_tile(const P& p, int pm, int pn) {
    bf16_t* Kg = (bf16_t*)(p.ws + WS_K); const float* kg = p.in[9];
    const int tid = otid();
    for (int pr = tid; pr < 1024; pr += NTHR) {
        const int row = pm * 256 + (pr >> 2), head = pn * 4 + (pr & 3);
        uint4* ptr = (uint4*)(Kg + (size_t)row * AW + head * 64);
        uint4 v[8]; float ss = 0.f;
#pragma unroll
        for (int c = 0; c < 8; ++c) { v[c] = ptr[c]; const unsigned w[4] = {v[c].x, v[c].y, v[c].z, v[c].w};
#pragma unroll
            for (int e = 0; e < 4; ++e) { const float a = __uint_as_float(w[e] << 16), b2 = __uint_as_float(w[e] & 0xffff0000u); ss += a * a + b2 * b2; } }
        const float rstd = rsqrtf(ss * (1.f / 64.f) + NORM_EPS);
#pragma unroll
        for (int c = 0; c < 8; ++c) { const unsigned w[4] = {v[c].x, v[c].y, v[c].z, v[c].w}; unsigned o[4];
            const float4 g0 = *(const float4*)(kg + 8 * c), g1 = *(const float4*)(kg + 8 * c + 4); const float gv[8] = {g0.x, g0.y, g0.z, g0.w, g1.x, g1.y, g1.z, g1.w};
#pragma unroll
            for (int e = 0; e < 4; ++e) o[e] = pk2(__uint_as_float(w[e] << 16) * rstd * gv[2 * e], __uint_as_float(w[e] & 0xffff0000u) * rstd * gv[2 * e + 1]);
            ptr[c] = make_uint4(o[0], o[1], o[2], o[3]); }
    }
}
constexpr int D2_NQ = 104;
__device__ const int D2_QN[8] = {40, 40, 40, 40, 104, 104, 104, 104};
__device__ const unsigned short D2_Q[8][D2_NQ] = {{999, 967, 935, 903, 871, 839, 807, 775, 1511, 231, 1479, 199, 485, 453, 421, 389, 357, 325, 293, 261, 229, 197, 165, 1447, 167, 133, 1415, 135, 101, 1383, 103, 69, 1351, 71, 37, 1319, 39, 5, 1287, 7, 0, 0, 0, 0, 0, 0, 0, 0, 0, 0, 0, 0, 0, 0, 0, 0, 0, 0, 0, 0, 0, 0, 0, 0, 0, 0, 0, 0, 0, 0, 0, 0, 0, 0, 0, 0, 0, 0, 0, 0, 0, 0, 0, 0, 0, 0, 0, 0, 0, 0, 0, 0, 0, 0, 0, 0, 0, 0, 0, 0, 0, 0, 0, 0},
    {1015, 1527, 983, 951, 919, 887, 855, 823, 791, 247, 1495, 215, 1463, 183, 501, 469, 437, 405, 373, 341, 309, 277, 245, 213, 181, 149, 1431, 151, 117, 1399, 119, 85, 1367, 87, 53, 1335, 55, 21, 1303, 23, 0, 0, 0, 0, 0, 0, 0, 0, 0, 0, 0, 0, 0, 0, 0, 0, 0, 0, 0, 0, 0, 0, 0, 0, 0, 0, 0, 0, 0, 0, 0, 0, 0, 0, 0, 0, 0, 0, 0, 0, 0, 0, 0, 0, 0, 0, 0, 0, 0, 0, 0, 0, 0, 0, 0, 0, 0, 0, 0, 0, 0, 0, 0, 0},
    {1007, 975, 943, 911, 879, 847, 815, 783, 1519, 239, 1487, 207, 493, 461, 429, 397, 365, 333, 301, 269, 237, 205, 173, 1455, 175, 141, 1423, 143, 109, 1391, 111, 77, 1359, 79, 45, 1327, 47, 13, 1295, 15, 0, 0, 0, 0, 0, 0, 0, 0, 0, 0, 0, 0, 0, 0, 0, 0, 0, 0, 0, 0, 0, 0, 0, 0, 0, 0, 0, 0, 0, 0, 0, 0, 0, 0, 0, 0, 0, 0, 0, 0, 0, 0, 0, 0, 0, 0, 0, 0, 0, 0, 0, 0, 0, 0, 0, 0, 0, 0, 0, 0, 0, 0, 0, 0},
    {1023, 1535, 991, 959, 927, 895, 863, 831, 799, 255, 1503, 223, 1471, 191, 509, 477, 445, 413, 381, 349, 317, 285, 253, 221, 189, 157, 1439, 159, 125, 1407, 127, 93, 1375, 95, 61, 1343, 63, 29, 1311, 31, 0, 0, 0, 0, 0, 0, 0, 0, 0, 0, 0, 0, 0, 0, 0, 0, 0, 0, 0, 0, 0, 0, 0, 0, 0, 0, 0, 0, 0, 0, 0, 0, 0, 0, 0, 0, 0, 0, 0, 0, 0, 0, 0, 0, 0, 0, 0, 0, 0, 0, 0, 0, 0, 0, 0, 0, 0, 0, 0, 0, 0, 0, 0, 0},
    {998, 966, 934, 902, 870, 838, 806, 774, 1510, 230, 1478, 198, 1446, 166, 1414, 134, 1382, 102, 484, 452, 420, 388, 356, 324, 292, 260, 228, 196, 164, 132, 100, 68, 1350, 70, 483, 451, 419, 387, 355, 323, 291, 259, 227, 195, 163, 131, 99, 67, 35, 36, 1318, 38, 482, 450, 418, 386, 354, 322, 290, 258, 226, 194, 162, 130, 98, 66, 34, 2, 3, 4, 1286, 6, 481, 449, 417, 385, 353, 321, 289, 257, 225, 193, 161, 129, 97, 65, 33, 1, 480, 448, 416, 384, 352, 320, 288, 256, 224, 192, 160, 128, 96, 64, 32, 0},
    {1014, 1526, 982, 950, 918, 886, 854, 822, 790, 246, 1494, 214, 1462, 182, 1430, 150, 1398, 118, 1366, 86, 500, 468, 436, 404, 372, 340, 308, 276, 244, 212, 180, 148, 116, 84, 52, 1334, 54, 499, 467, 435, 403, 371, 339, 307, 275, 243, 211, 179, 147, 115, 83, 51, 19, 20, 1302, 22, 498, 466, 434, 402, 370, 338, 306, 274, 242, 210, 178, 146, 114, 82, 50, 18, 497, 465, 433, 401, 369, 337, 305, 273, 241, 209, 177, 145, 113, 81, 49, 17, 496, 464, 432, 400, 368, 336, 304, 272, 240, 208, 176, 144, 112, 80, 48, 16},
    {1006, 974, 942, 910, 878, 846, 814, 782, 1518, 238, 1486, 206, 1454, 174, 1422, 142, 1390, 110, 492, 460, 428, 396, 364, 332, 300, 268, 236, 204, 172, 140, 108, 76, 1358, 78, 491, 459, 427, 395, 363, 331, 299, 267, 235, 203, 171, 139, 107, 75, 43, 44, 1326, 46, 490, 458, 426, 394, 362, 330, 298, 266, 234, 202, 170, 138, 106, 74, 42, 10, 11, 12, 1294, 14, 489, 457, 425, 393, 361, 329, 297, 265, 233, 201, 169, 137, 105, 73, 41, 9, 488, 456, 424, 392, 360, 328, 296, 264, 232, 200, 168, 136, 104, 72, 40, 8},
    {1022, 1534, 990, 958, 926, 894, 862, 830, 798, 254, 1502, 222, 1470, 190, 1438, 158, 1406, 126, 1374, 94, 508, 476, 444, 412, 380, 348, 316, 284, 252, 220, 188, 156, 124, 92, 60, 1342, 62, 507, 475, 443, 411, 379, 347, 315, 283, 251, 219, 187, 155, 123, 91, 59, 27, 28, 1310, 30, 506, 474, 442, 410, 378, 346, 314, 282, 250, 218, 186, 154, 122, 90, 58, 26, 505, 473, 441, 409, 377, 345, 313, 281, 249, 217, 185, 153, 121, 89, 57, 25, 504, 472, 440, 408, 376, 344, 312, 280, 248, 216, 184, 152, 120, 88, 56, 24}};
typedef unsigned u32x4_t __attribute__((ext_vector_type(4)));
__device__ __forceinline__ bf16x8_t pack_step16(const f32x16_t& x, int s2) {
    u32x4_t pk;
    if (s2 == 0) { pk[0] = pk_bf16(x[0], x[1]); pk[1] = pk_bf16(x[2], x[3]); pk[2] = pk_bf16(x[4], x[5]); pk[3] = pk_bf16(x[6], x[7]); }
    else { pk[0] = pk_bf16(x[8], x[9]); pk[1] = pk_bf16(x[10], x[11]); pk[2] = pk_bf16(x[12], x[13]); pk[3] = pk_bf16(x[14], x[15]); }
    return __builtin_bit_cast(bf16x8_t, pk);
}
__device__ __forceinline__ float xhalf_max(float x) { const auto t = __builtin_amdgcn_permlane32_swap(__float_as_uint(x), __float_as_uint(x), false, false); return fmaxf(__uint_as_float(t[0]), __uint_as_float(t[1])); }
__device__ __forceinline__ float xhalf_sum(float x) { const auto t = __builtin_amdgcn_permlane32_swap(__float_as_uint(x), __float_as_uint(x), false, false); return __uint_as_float(t[0]) + __uint_as_float(t[1]); }
__device__ __forceinline__ short bf16_of_int(int v) { return (short)(__float_as_uint((float)v) >> 16); }
#define MFMA32(a, b, c) __builtin_amdgcn_mfma_f32_32x32x16_bf16((a), (b), (c), 0, 0, 0)
__device__ void ph_dsa_attn(const P& p, float* ldsf) {
    const unsigned long long* MASK = (const unsigned long long*)(p.ws + WS_MASK);
    const bf16_t* Q = (const bf16_t*)(p.ws + WS_Q); const bf16_t* Kg = (const bf16_t*)(p.ws + WS_K); const bf16_t* VT = (const bf16_t*)(p.ws + WS_V);
    bf16_t* O = (bf16_t*)(p.ws + WS_OATT);
    bf16_t* L = (bf16_t*)ldsf;
    const int tid = otid(), lane = tid & 63, wv = tid >> 6, hh = lane >> 5, r32 = lane & 31;
    const float CS = 0.125f * 1.4426950408889634f;
    const float NEG = -1e30f;
    const int skey = tid >> 3, sch = (tid & 7) * 8;
    const float* qg = p.in[8];
    float kgmax; { const float v = fabsf(p.in[9][lane]); kgmax = wave_max(v); }
    int* qhead = (int*)(p.ws + WS_CTL) + CT_Q; int* bcast = (int*)(L + 4 * SLOT); int* sflag = bcast + 4;
    for (int tr_ = 0; tr_ < 8; ++tr_) {
        const int grp = (blockIdx.x + tr_) & 7;
        for (;;) {
            __syncthreads();
            if (tid == 0) *bcast = atomicAdd(qhead + grp, 1);
            __syncthreads();
            const int kq = *bcast;
            if (kq >= D2_QN[grp]) break;
            const int e_ = D2_Q[grp][kq], bh = e_ & 15, qb = (e_ >> 4) & 31, part = e_ >> 9;
            const int b = bh >> 3, h = bh & 7;
            const bf16_t* Kbase = Kg + (size_t)b * SEQ * AW + h * 64; const bf16_t* Vbase = VT + (size_t)bh * 64 * SEQ;
            {
            const int q0 = qb * 256 + wv * 32, q = q0 + r32, ntile = 4 * (qb + 1);
            const int kt_hi = (part == 2) ? ntile - 65 : ntile - 1, kt_lo = (part == 1) ? ntile - 64 : 0;
            const size_t qrow = (size_t)b * SEQ + q;
            bf16x8_t bq[5]; float qk_bound;
#pragma unroll
            for (int s2 = 0; s2 < 4; ++s2) bq[s2] = *(const bf16x8_t*)(Q + qrow * AW + h * 64 + 16 * s2 + 8 * hh);
            {
                float ss = 0.f;
#pragma unroll
                for (int s2 = 0; s2 < 4; ++s2)
#pragma unroll
                    for (int j = 0; j < 8; ++j) { const float v = bf2f((bf16_t)bq[s2][j]); ss += v * v; }
                ss = xhalf_sum(ss);
                const float rstd = rsqrtf(ss * (1.f / 64.f) + NORM_EPS);
                float qq = 0.f;
#pragma unroll
                for (int s2 = 0; s2 < 4; ++s2) { const float4 g0 = *(const float4*)(qg + 16 * s2 + 8 * hh), g1 = *(const float4*)(qg + 16 * s2 + 8 * hh + 4); const float gv[8] = {g0.x, g0.y, g0.z, g0.w, g1.x, g1.y, g1.z, g1.w};
                    u32x4_t w;
#pragma unroll
                    for (int j2 = 0; j2 < 4; ++j2) { const float e0 = bf2f((bf16_t)bq[s2][2 * j2]) * rstd * gv[2 * j2], e1 = bf2f((bf16_t)bq[s2][2 * j2 + 1]) * rstd * gv[2 * j2 + 1]; qq += e0 * e0 + e1 * e1; w[j2] = pk_bf16(e0, e1); }
                    bq[s2] = __builtin_bit_cast(bf16x8_t, w); }
                qk_bound = sqrtf(xhalf_sum(qq)) * kgmax * 1.03f;
            }
#pragma unroll
            for (int j = 0; j < 8; ++j) bq[4][j] = 0;
            if (hh == 0) { bq[4][0] = bf16_of_int(256 >> h); bq[4][1] = (short)(__float_as_uint(4.f / (float)(1 << h)) >> 16); }
            f32x16_t o0, o1;
#pragma unroll
            for (int i = 0; i < 16; ++i) { o0[i] = 0.f; o1[i] = 0.f; }
            float m_run = NEG, l_run = 0.f;
            __syncthreads();
            const float slope_l2 = 1.4426950408889634f / (float)(2 << h);
            { const int kt0 = kt_hi; const uint4 kr = *(const uint4*)(Kbase + (size_t)(kt0 * 64 + skey) * AW + sch), vr = *(const uint4*)(Vbase + (size_t)skey * SEQ + kt0 * 64 + sch);
              *(uint4*)(L + (kt0 & 1) * SLOT + skey * LP + sch) = kr; *(uint4*)(L + (2 + (kt0 & 1)) * SLOT + skey * LP + sch) = vr; }
            unsigned long long mw = MASK[qrow * 128 + kt_hi];
            if (tid < 16) sflag[tid] = 0;
            __syncthreads();
#pragma unroll 1
            for (int kt = kt_hi; kt >= kt_lo; --kt) {
                const int buf = kt & 1; const bool more = kt > kt_lo;
                if (kt < kt_hi) { int alld = 1;
#pragma unroll
                    for (int w2 = 0; w2 < 8; ++w2) alld &= sflag[((kt + 1) & 1) * 8 + w2];
                    if (alld) break; }
                uint4 kr = make_uint4(0, 0, 0, 0), vr = make_uint4(0, 0, 0, 0); unsigned long long mwn = 0ull;
                if (more) { kr = *(const uint4*)(Kbase + (size_t)((kt - 1) * 64 + skey) * AW + sch); vr = *(const uint4*)(Vbase + (size_t)skey * SEQ + (kt - 1) * 64 + sch); mwn = MASK[qrow * 128 + kt - 1]; }
                if (kt * 64 <= q0 + 31) {
                    const bf16_t* Kl = L + buf * SLOT; const bf16_t* Vl = L + (2 + buf) * SLOT;
                    f32x16_t p0, p1;
#pragma unroll
                    for (int i = 0; i < 16; ++i) { p0[i] = 0.f; p1[i] = 0.f; }
#pragma unroll
                    for (int s2 = 0; s2 < 4; ++s2) {
                        const bf16x8_t a0 = *(const bf16x8_t*)(Kl + r32 * LP + 16 * s2 + 8 * hh), a1 = *(const bf16x8_t*)(Kl + (32 + r32) * LP + 16 * s2 + 8 * hh);
                        p0 = MFMA32(a0, bq[s2], p0); p1 = MFMA32(a1, bq[s2], p1);
                    }
                    { bf16x8_t g0, g1;
#pragma unroll
                      for (int j = 0; j < 8; ++j) { g0[j] = 0; g1[j] = 0; }
                      if (hh == 0) { g0[0] = bf16_of_int(kt); g0[1] = bf16_of_int(r32); g1[0] = g0[0]; g1[1] = bf16_of_int(32 + r32); }
                      p0 = MFMA32(g0, bq[4], p0); p1 = MFMA32(g1, bq[4], p1); }
                    const unsigned wl = (unsigned)mw >> (4 * hh), wh = (unsigned)(mw >> 32) >> (4 * hh);
                    float mx = NEG;
#pragma unroll
                    for (int i = 0; i < 16; ++i) { const int bp = (i & 3) + 8 * (i >> 2);
                        const int m0 = __builtin_amdgcn_sbfe((int)wl, bp, 1), m1 = __builtin_amdgcn_sbfe((int)wh, bp, 1);
                        const float a_ = __uint_as_float((__float_as_uint(p0[i]) & (unsigned)m0) | (__float_as_uint(NEG) & ~(unsigned)m0));
                        const float b_ = __uint_as_float((__float_as_uint(p1[i]) & (unsigned)m1) | (__float_as_uint(NEG) & ~(unsigned)m1));
                        p0[i] = a_; p1[i] = b_;
                        mx = __builtin_fmaxf(mx, __builtin_fmaxf(a_, b_)); }
                    mx = xhalf_max(mx);
                    const float m_new = fmaxf(m_run, mx);
                    const float alpha = __builtin_amdgcn_exp2f((m_run - m_new) * CS);
                    m_run = m_new;
                    const float mc = fmaxf(m_new, -1e20f) * CS;
                    float rs = 0.f;
#pragma unroll
                    for (int i = 0; i < 16; ++i) { p0[i] = __builtin_amdgcn_exp2f(p0[i] * CS - mc); p1[i] = __builtin_amdgcn_exp2f(p1[i] * CS - mc); rs += p0[i] + p1[i]; }
                    l_run = l_run * alpha + rs;
#pragma unroll
                    for (int i = 0; i < 16; ++i) { o0[i] *= alpha; o1[i] *= alpha; }
                    bf16x8_t pb[4];
                    pb[0] = pack_step16(p0, 0); pb[1] = pack_step16(p0, 1); pb[2] = pack_step16(p1, 0); pb[3] = pack_step16(p1, 1);
#pragma unroll
                    for (int ks = 0; ks < 4; ++ks) {
                        const int kofs = 32 * (ks >> 1) + 16 * (ks & 1) + 4 * hh;
                        typedef short s16x4_t __attribute__((ext_vector_type(4)));
                        const s16x4_t v00 = *(const s16x4_t*)(Vl + r32 * LP + kofs), v01 = *(const s16x4_t*)(Vl + r32 * LP + kofs + 8);
                        const s16x4_t v10 = *(const s16x4_t*)(Vl + (32 + r32) * LP + kofs), v11 = *(const s16x4_t*)(Vl + (32 + r32) * LP + kofs + 8);
                        bf16x8_t av0, av1;
#pragma unroll
                        for (int j = 0; j < 4; ++j) { av0[j] = v00[j]; av0[4 + j] = v01[j]; av1[j] = v10[j]; av1[4 + j] = v11[j]; }
                        o0 = MFMA32(av0, pb[ks], o0); o1 = MFMA32(av1, pb[ks], o1);
                    }
                }
                if (more) { *(uint4*)(L + (buf ^ 1) * SLOT + skey * LP + sch) = kr; *(uint4*)(L + (2 + (buf ^ 1)) * SLOT + skey * LP + sch) = vr; }
                mw = mwn;
                {
                    const bool row_done = (qk_bound * 1.4426950408889634f + slope_l2 * (float)(64 * kt - 1)) < m_run * CS - 56.f;
                    const int wdone = __all(row_done) ? 1 : 0;
                    if (lane == 0) sflag[(kt & 1) * 8 + wv] = wdone;
                }
                __syncthreads();
            }
            const float l_tot = xhalf_sum(l_run);
            const float inv = l_tot > 0.f ? 1.f / l_tot : 0.f;
            bf16_t* orow = O + qrow * AW + h * 64 + 4 * hh;
            if (part) {
                const size_t prow = (size_t)((b * 2 + (h - 6)) * 4096 + (q - 4096));
                if (hh == 0) ((float2*)(p.ws + WS_AML))[(size_t)(part - 1) * 16384 + prow] = make_float2(m_run, l_tot);
                if (part == 2) orow = (bf16_t*)(p.ws + WS_OFAR) + prow * 64 + 4 * hh;
            }
#pragma unroll
            for (int g = 0; g < 4; ++g) {
                uint2 w0, w1;
                w0.x = (unsigned)f2bf(o0[4 * g] * inv) | ((unsigned)f2bf(o0[4 * g + 1] * inv) << 16); w0.y = (unsigned)f2bf(o0[4 * g + 2] * inv) | ((unsigned)f2bf(o0[4 * g + 3] * inv) << 16);
                w1.x = (unsigned)f2bf(o1[4 * g] * inv) | ((unsigned)f2bf(o1[4 * g + 1] * inv) << 16); w1.y = (unsigned)f2bf(o1[4 * g + 2] * inv) | ((unsigned)f2bf(o1[4 * g + 3] * inv) << 16);
                *(uint2*)(orow + 8 * g) = w0; *(uint2*)(orow + 32 + 8 * g) = w1;
            }
            }
        }
    }
}

__device__ void ph_attn_merge(const P& p) {
    bf16_t* O = (bf16_t*)(p.ws + WS_OATT); const bf16_t* OF = (const bf16_t*)(p.ws + WS_OFAR); const float2* ML = (const float2*)(p.ws + WS_AML);
    const float CS = 0.125f * 1.4426950408889634f;
    const int tid = otid();
    for (int i = blockIdx.x * NTHR + tid; i < 16384 * 8; i += gridDim.x * NTHR) {
        const int prow = i >> 3, c8 = (i & 7) * 8, bhx = prow >> 12, q = 4096 + (prow & 4095), b = bhx >> 1, h = 6 + (bhx & 1);
        const float2 n_ = ML[prow], f_ = ML[16384 + prow];
        const float mm = fmaxf(n_.x, f_.x);
        const float wn = n_.y * __builtin_amdgcn_exp2f((n_.x - mm) * CS), wf = f_.y * __builtin_amdgcn_exp2f((f_.x - mm) * CS);
        const float inv = (wn + wf) > 0.f ? 1.f / (wn + wf) : 0.f, a_ = wn * inv, b_ = wf * inv;
        bf16_t* op = O + ((size_t)b * SEQ + q) * AW + h * 64 + c8;
        const uint4 on = *(const uint4*)op, of = *(const uint4*)(OF + (size_t)prow * 64 + c8);
        const unsigned wn_[4] = {on.x, on.y, on.z, on.w}, wf_[4] = {of.x, of.y, of.z, of.w}; unsigned o[4];
#pragma unroll
        for (int e = 0; e < 4; ++e) o[e] = pk2(a_ * __uint_as_float(wn_[e] << 16) + b_ * __uint_as_float(wf_[e] << 16), a_ * __uint_as_float(wn_[e] & 0xffff0000u) + b_ * __uint_as_float(wf_[e] & 0xffff0000u));
        *(uint4*)op = make_uint4(o[0], o[1], o[2], o[3]);
    }
}
constexpr int AP = 328, KP = 520, OBP = 72, ODP = 68;
__device__ __forceinline__ f32x4_t mm16(const bf16_t* X, int xrs, const bf16_t* Y, int ycs, int nks, f32x4_t acc, int lane) {
    const int r = lane & 15, q = lane >> 4;
    for (int s2 = 0; s2 < nks; ++s2) {
        const bf16x8_t a = *(const bf16x8_t*)(X + r * xrs + 32 * s2 + 8 * q), b = *(const bf16x8_t*)(Y + r * ycs + 32 * s2 + 8 * q);
        acc = __builtin_amdgcn_mfma_f32_16x16x32_bf16(a, b, acc, 0, 0, 0);
    }
    return acc;
}
__device__ void ph_rwkv_prep(const P& p, float* ldsf, int blk_first, int blk_end, int blk_step) {
    const bf16_t* PS = (const bf16_t*)(p.ws + WS_PS);
    const float* mu = p.in[10]; const float* w0 = p.in[11]; const float* a0 = p.in[13]; const float* k_k = p.in[16]; const float* k_a = p.in[17];
    const bf16_t* W2T = (const bf16_t*)(p.ws + WS_LW2T); const bf16_t* A2T = (const bf16_t*)(p.ws + WS_LA2T); const bf16_t* G2T = (const bf16_t*)(p.ws + WS_LG2T);
    bf16_t* R = (bf16_t*)(p.ws + WS_R); bf16_t* K2 = (bf16_t*)(p.ws + WS_K2); bf16_t* VV = (bf16_t*)(p.ws + WS_VV); bf16_t* KK = (bf16_t*)(p.ws + WS_KK); bf16_t* BB = (bf16_t*)(p.ws + WS_BB);
    bf16_t* G = (bf16_t*)(p.ws + WS_G); float* DD = (float*)(p.ws + WS_DD);
    const int tid = otid(), lane = tid & 63, wv = tid >> 6, l15 = lane & 15, q4 = lane >> 4;
    bf16_t* Amix = (bf16_t*)ldsf; bf16_t* Kbuf = Amix + 32 * AP;
    bf16_t* KKo = Kbuf + 32 * KP + wv * (3 * 16 * OBP + 2 * 16 * ODP); bf16_t* BBo = KKo + 16 * OBP; bf16_t* Go = BBo + 16 * OBP; float* DDo = (float*)(Go + 16 * OBP);
    for (int blk = blk_first; blk < blk_end; blk += blk_step) {
        const int m0 = blk * 32;
        __syncthreads();
        if (tid < 456) {
            const int cc = tid % 228, th = tid / 228, c8 = cc * 8;
            const float4 mu0 = *(const float4*)(mu + c8), mu1 = *(const float4*)(mu + c8 + 4); const float muv[8] = {mu0.x, mu0.y, mu0.z, mu0.w, mu1.x, mu1.y, mu1.z, mu1.w};
            const bf16_t* src = PS + (size_t)(m0 + 16 * th) * SHW + c8;
            uint4 pv = make_uint4(0, 0, 0, 0); if ((m0 + 16 * th) % SEQ) pv = *(const uint4*)(src - SHW);
#pragma unroll 1
            for (int bt = 0; bt < 2; ++bt) {
                uint4 cu[8];
#pragma unroll
                for (int i = 0; i < 8; ++i) cu[i] = *(const uint4*)(src + (size_t)(8 * bt + i) * SHW);
#pragma unroll
                for (int i = 0; i < 8; ++i) {
                    const int tk = 16 * th + 8 * bt + i;
                    const unsigned cw[4] = {cu[i].x, cu[i].y, cu[i].z, cu[i].w}, pw[4] = {pv.x, pv.y, pv.z, pv.w};
                    float mx[8];
#pragma unroll
                    for (int e = 0; e < 8; ++e) { const float c_ = (e & 1) ? __uint_as_float(cw[e >> 1] & 0xffff0000u) : __uint_as_float(cw[e >> 1] << 16), p_ = (e & 1) ? __uint_as_float(pw[e >> 1] & 0xffff0000u) : __uint_as_float(pw[e >> 1] << 16);
                        mx[e] = c_ + (p_ - c_) * muv[e]; }
                    pv = cu[i];
                    if (cc >= 192) { const int col = c8 - 1536;
#pragma unroll
                        for (int e = 0; e < 8; ++e) mx[e] = (col < 64) ? (1.f - 2.f * __builtin_amdgcn_rcpf(__expf(2.f * mx[e]) + 1.f)) : ((col < 128) ? mx[e] : sigmoidf_(mx[e])); }
                    const uint4 o = make_uint4(pk2(mx[0], mx[1]), pk2(mx[2], mx[3]), pk2(mx[4], mx[5]), pk2(mx[6], mx[7]));
                    if (cc < 64) *(uint4*)(R + (size_t)(m0 + tk) * RW + c8) = o;
                    else if (cc < 128) *(uint4*)(Kbuf + tk * KP + (c8 - 512)) = o;
                    else if (cc < 192) *(uint4*)(VV + (size_t)(m0 + tk) * RW + (c8 - 1024)) = o;
                    else *(uint4*)(Amix + tk * AP + (c8 - 1536)) = o;
                }
            }
        }
        if (tid < 128) *(uint4*)(Amix + (tid >> 2) * AP + 288 + (tid & 3) * 8) = make_uint4(0, 0, 0, 0);
        __syncthreads();
        const int h = wv;
        float rn[2];
#pragma unroll
        for (int rt = 0; rt < 2; ++rt) { const int tk = 16 * rt + l15; float ss = 0.f;
#pragma unroll
            for (int ct = 0; ct < 4; ++ct) { const int c0 = 64 * h + 16 * ct + 4 * q4; const float4 kkc = *(const float4*)(k_k + c0); const uint2 kw = *(const uint2*)(Kbuf + tk * KP + c0);
                const float e0 = __uint_as_float(kw.x << 16) * kkc.x, e1 = __uint_as_float(kw.x & 0xffff0000u) * kkc.y, e2 = __uint_as_float(kw.y << 16) * kkc.z, e3 = __uint_as_float(kw.y & 0xffff0000u) * kkc.w;
                ss += (e0 * e0 + e1 * e1) + (e2 * e2 + e3 * e3); }
            ss += __shfl_xor(ss, 16); ss += __shfl_xor(ss, 32);
            rn[rt] = __builtin_amdgcn_rcpf(fmaxf(sqrtf(ss), 1e-12f)); }
#pragma unroll 1
        for (int rt = 0; rt < 2; ++rt) {
            const int tk = 16 * rt + l15; const bf16_t* xr = Amix + tk * AP + 8 * q4; const float rnv = rt ? rn[1] : rn[0];
#pragma unroll 1
            for (int ct = 0; ct < 4; ++ct) {
                const int cb = 64 * h + 16 * ct, c0 = cb + 4 * q4;
                const bf16_t* yw = W2T + (size_t)(cb + l15) * 64 + 8 * q4; const bf16_t* ya = A2T + (size_t)(cb + l15) * 64 + 8 * q4; const bf16_t* yg = G2T + (size_t)(cb + l15) * 192 + 8 * q4;
                bf16x8_t fw[2], fa[2], fg[6];
#pragma unroll
                for (int s2 = 0; s2 < 2; ++s2) { fw[s2] = *(const bf16x8_t*)(yw + 32 * s2); fa[s2] = *(const bf16x8_t*)(ya + 32 * s2); }
#pragma unroll
                for (int s2 = 0; s2 < 6; ++s2) fg[s2] = *(const bf16x8_t*)(yg + 32 * s2);
                const float4 cw0 = *(const float4*)(w0 + c0), ca0 = *(const float4*)(a0 + c0), cka = *(const float4*)(k_a + c0), ckk = *(const float4*)(k_k + c0);
                const float w0v[4] = {cw0.x, cw0.y, cw0.z, cw0.w}, a0v[4] = {ca0.x, ca0.y, ca0.z, ca0.w}, kav[4] = {cka.x, cka.y, cka.z, cka.w}, kkc[4] = {ckk.x, ckk.y, ckk.z, ckk.w};
                f32x4_t cw = {0.f, 0.f, 0.f, 0.f}, ca = cw, cg = cw;
#pragma unroll
                for (int s2 = 0; s2 < 2; ++s2) { cw = __builtin_amdgcn_mfma_f32_16x16x32_bf16(fw[s2], *(const bf16x8_t*)(xr + 32 * s2), cw, 0, 0, 0); ca = __builtin_amdgcn_mfma_f32_16x16x32_bf16(fa[s2], *(const bf16x8_t*)(xr + 64 + 32 * s2), ca, 0, 0, 0); }
#pragma unroll
                for (int s2 = 0; s2 < 6; ++s2) cg = __builtin_amdgcn_mfma_f32_16x16x32_bf16(fg[s2], *(const bf16x8_t*)(xr + 128 + 32 * s2), cg, 0, 0, 0);
                bf16_t* kp = Kbuf + tk * KP + c0;
                const uint2 kw2 = *(const uint2*)kp;
                const float kf[4] = {__uint_as_float(kw2.x << 16), __uint_as_float(kw2.x & 0xffff0000u), __uint_as_float(kw2.y << 16), __uint_as_float(kw2.y & 0xffff0000u)};
                float k2v[4], kkv[4], bbv[4], ddv[4];
#pragma unroll
                for (int e = 0; e < 4; ++e) {
                    const float xw = -(w0v[e] + cw[e]);
                    const float sp = fmaxf(xw, 0.f) + __logf(1.f + __expf(-fabsf(xw)));
                    const float w = -sp - 0.5f;
                    const float a = sigmoidf_(a0v[e] + ca[e]);
                    kkv[e] = kf[e] * kkc[e] * rnv; bbv[e] = kkv[e] * a; k2v[e] = kf[e] * (1.f + (a - 1.f) * kav[e]); ddv[e] = -__expf(w); }
                *(uint2*)kp = make_uint2(pk2(k2v[0], k2v[1]), pk2(k2v[2], k2v[3]));
                *(uint2*)(KKo + l15 * OBP + 16 * ct + 4 * q4) = make_uint2(pk2(kkv[0], kkv[1]), pk2(kkv[2], kkv[3]));
                *(uint2*)(BBo + l15 * OBP + 16 * ct + 4 * q4) = make_uint2(pk2(bbv[0], bbv[1]), pk2(bbv[2], bbv[3]));
                *(uint2*)(Go + l15 * OBP + 16 * ct + 4 * q4) = make_uint2(pk2(cg[0], cg[1]), pk2(cg[2], cg[3]));
                *(float4*)(DDo + l15 * ODP + 16 * ct + 4 * q4) = make_float4(ddv[0], ddv[1], ddv[2], ddv[3]);
            }
            __builtin_amdgcn_fence(__ATOMIC_ACQ_REL, "wavefront"); __builtin_amdgcn_wave_barrier();
            {
                const int rb = lane >> 3, cb8 = (lane & 7) * 8;
#pragma unroll
                for (int i = 0; i < 2; ++i) { const int row = rb + 8 * i; const size_t o = (size_t)(m0 + 16 * rt + row) * RW + 64 * h + cb8;
                    *(uint4*)(K2 + o) = *(const uint4*)(Kbuf + (16 * rt + row) * KP + 64 * h + cb8);
                    *(uint4*)(KK + o) = *(const uint4*)(KKo + row * OBP + cb8);
                    *(uint4*)(BB + o) = *(const uint4*)(BBo + row * OBP + cb8);
                    *(uint4*)(G + o) = *(const uint4*)(Go + row * OBP + cb8); }
                const int rd = lane >> 4, cd4 = (lane & 15) * 4;
#pragma unroll
                for (int i = 0; i < 4; ++i) { const int row = rd + 4 * i;
                    *(float4*)(DD + (size_t)(m0 + 16 * rt + row) * RW + 64 * h + cd4) = *(const float4*)(DDo + row * ODP + cd4); }
            }
            __builtin_amdgcn_fence(__ATOMIC_ACQ_REL, "wavefront"); __builtin_amdgcn_wave_barrier();
        }
    }
}

template <bool XC, bool YC>
__device__ __forceinline__ f32x4_t mm_tile(const bf16_t* X, int xrs, int xcs, const bf16_t* Y, int yrs, int ycs, int tr, int tc, f32x4_t acc, int lane) {
    const int r = lane & 15, q = lane >> 4;
#pragma unroll
    for (int s2 = 0; s2 < 2; ++s2) {
        bf16x8_t a, b;
        const bf16_t* xp = X + (16 * tr + r) * xrs + (32 * s2 + 8 * q) * xcs;
        if (XC) a = *(const bf16x8_t*)xp; else {
#pragma unroll
            for (int j = 0; j < 8; ++j) a[j] = (short)xp[j * xcs]; }
        const bf16_t* yp = Y + (32 * s2 + 8 * q) * yrs + (16 * tc + r) * ycs;
        if (YC) b = *(const bf16x8_t*)yp; else {
#pragma unroll
            for (int j = 0; j < 8; ++j) b[j] = (short)yp[j * yrs]; }
        acc = __builtin_amdgcn_mfma_f32_16x16x32_bf16(a, b, acc, 0, 0, 0);
    }
    return acc;
}
__device__ __forceinline__ void st_tile(const f32x4_t& acc, bf16_t* D, int drs, int dcs, int tr, int tc, int lane) {
    const int row0 = 16 * tr + 4 * (lane >> 4), col = 16 * tc + (lane & 15);
#pragma unroll
    for (int e = 0; e < 4; ++e) D[(row0 + e) * drs + col * dcs] = f2bf(acc[e]);
}
__device__ __forceinline__ f32x4_t ld_tile(const bf16_t* D, int drs, int dcs, int tr, int tc, int lane) {
    const int row0 = 16 * tr + 4 * (lane >> 4), col = 16 * tc + (lane & 15); f32x4_t v;
#pragma unroll
    for (int e = 0; e < 4; ++e) v[e] = bf2f(D[(row0 + e) * drs + col * dcs]);
    return v;
}
template <bool STRICT> __device__ __forceinline__ void triu_tile(f32x4_t& acc, int tr, int tc, int lane) {
    const int row0 = 16 * tr + 4 * (lane >> 4), col = 16 * tc + (lane & 15);
#pragma unroll
    for (int e = 0; e < 4; ++e) { const bool keep = STRICT ? (row0 + e < col) : (row0 + e <= col); acc[e] = keep ? acc[e] : 0.f; }
}

__device__ void ph_rwkv_r1(const P& p, float* ldsf, int ch_first, int ch_end, int ch_step) {
    const bf16_t* R = (const bf16_t*)(p.ws + WS_R); const bf16_t* K2 = (const bf16_t*)(p.ws + WS_K2); const bf16_t* VV = (const bf16_t*)(p.ws + WS_VV);
    const bf16_t* KK = (const bf16_t*)(p.ws + WS_KK); const bf16_t* BB = (const bf16_t*)(p.ws + WS_BB); const float* DD = (const float*)(p.ws + WS_DD);
    bf16_t* L = (bf16_t*)ldsf;
    bf16_t* At = L + 0 * SLOT; bf16_t* AtT = L + 1 * SLOT; bf16_t* Bt = L + 2 * SLOT; bf16_t* Kt = L + 3 * SLOT; bf16_t* Rt = L + 4 * SLOT; bf16_t* BhT = L + 5 * SLOT; bf16_t* Kh = L + 6 * SLOT;
    bf16_t* S7 = L + 7 * SLOT; bf16_t* S8 = L + 8 * SLOT; bf16_t* S9 = L + 9 * SLOT; bf16_t* Mka = L + 10 * SLOT; bf16_t* NbrT = L + 11 * SLOT; bf16_t* Nkr = L + 12 * SLOT;
    float* cs = (float*)(L + 13 * SLOT);
    float* segs = cs + 64 * 64;
    float* gLs = segs + 8 * 64;
    const int tid = otid(), lane = tid & 63, wv = tid >> 6;
    const int t0 = 2 * wv, t1 = 2 * wv + 1;
    for (int ch = ch_first; ch < ch_end; ch += ch_step) {
        const int bh = ch >> 7, c = ch & 127, b = bh >> 3, h = bh & 7;
        const size_t gbase = ((size_t)b * SEQ + (size_t)c * 64) * RW + h * 64;
        bf16_t* G1T = (bf16_t*)(p.ws + WS_KK) + gbase; bf16_t* PT = (bf16_t*)(p.ws + WS_BB) + gbase; bf16_t* G2T = (bf16_t*)(p.ws + WS_DD) + 2 * gbase; bf16_t* QT = G2T + 64;
        __syncthreads();
        const int st = tid >> 3, sj = (tid & 7) * 8;
        const uint4 vraw = *(const uint4*)(VV + gbase + (size_t)st * RW + sj);
        const uint4 rr = *(const uint4*)(R + gbase + (size_t)st * RW + sj), kr = *(const uint4*)(K2 + gbase + (size_t)st * RW + sj);
        const uint4 kkr = *(const uint4*)(KK + gbase + (size_t)st * RW + sj), br = *(const uint4*)(BB + gbase + (size_t)st * RW + sj);
        { const float4 l0 = *(const float4*)(DD + gbase + (size_t)st * RW + sj), l1 = *(const float4*)(DD + gbase + (size_t)st * RW + sj + 4);
          float* d = cs + st * 64 + sj; *(float4*)d = l0; *(float4*)(d + 4) = l1; }
        __syncthreads();
        { const int j = tid & 63, sg = tid >> 6; float run = 0.f;
#pragma unroll
          for (int i = 0; i < 8; ++i) { run += cs[(sg * 8 + i) * 64 + j]; }
          segs[sg * 64 + j] = run; }
        __syncthreads();
        { const int j = tid & 63, sg = tid >> 6; float run = 0.f;
          for (int q = 0; q < sg; ++q) run += segs[q * 64 + j];
#pragma unroll
          for (int i = 0; i < 8; ++i) { run += cs[(sg * 8 + i) * 64 + j]; cs[(sg * 8 + i) * 64 + j] = run; }
          if (sg == 7) gLs[j] = __expf(run); }
        __syncthreads();
        {
            const unsigned rw_[4] = {rr.x, rr.y, rr.z, rr.w}, kw_[4] = {kr.x, kr.y, kr.z, kr.w}, kkw_[4] = {kkr.x, kkr.y, kkr.z, kkr.w}, bw_[4] = {br.x, br.y, br.z, br.w};
            unsigned oa[4], ob[4], ok[4], orr[4], okh[4];
#pragma unroll
            for (int e2 = 0; e2 < 4; ++e2) {
                float va[2], vb[2], vk[2], vr2[2], vbh[2], vkh[2];
#pragma unroll
                for (int hf = 0; hf < 2; ++hf) {
                    const int j = sj + 2 * e2 + hf;
                    const float lgI = cs[st * 64 + j], lgE = st ? cs[(st - 1) * 64 + j] : 0.f, gl = cs[63 * 64 + j];
                    const float rv = hf ? __uint_as_float(rw_[e2] & 0xffff0000u) : __uint_as_float(rw_[e2] << 16);
                    const float kv = hf ? __uint_as_float(kw_[e2] & 0xffff0000u) : __uint_as_float(kw_[e2] << 16);
                    const float kkv = hf ? __uint_as_float(kkw_[e2] & 0xffff0000u) : __uint_as_float(kkw_[e2] << 16);
                    const float bv = hf ? __uint_as_float(bw_[e2] & 0xffff0000u) : __uint_as_float(bw_[e2] << 16);
                    const float einv = __expf(-lgI), eh = __expf(gl - lgI);
                    va[hf] = -kkv * __expf(lgE); vb[hf] = bv * einv; vk[hf] = kv * einv; vr2[hf] = rv * __expf(lgI); vbh[hf] = bv * eh; vkh[hf] = kv * eh;
                    AtT[j * LP + st] = f2bf(va[hf]); BhT[j * LP + st] = f2bf(vbh[hf]);
                }
                oa[e2] = pk2(va[0], va[1]); ob[e2] = pk2(vb[0], vb[1]); ok[e2] = pk2(vk[0], vk[1]); orr[e2] = pk2(vr2[0], vr2[1]); okh[e2] = pk2(vkh[0], vkh[1]);
            }
            *(uint4*)(At + st * LP + sj) = make_uint4(oa[0], oa[1], oa[2], oa[3]); *(uint4*)(Bt + st * LP + sj) = make_uint4(ob[0], ob[1], ob[2], ob[3]);
            *(uint4*)(Kt + st * LP + sj) = make_uint4(ok[0], ok[1], ok[2], ok[3]); *(uint4*)(Rt + st * LP + sj) = make_uint4(orr[0], orr[1], orr[2], orr[3]);
            *(uint4*)(Kh + st * LP + sj) = make_uint4(okh[0], okh[1], okh[2], okh[3]);
        }
        __syncthreads();
#define R1_FOR_TILES(idx, tr, tc) _Pragma("unroll") for (int _q = 0; _q < 2; ++_q) { const int idx = _q ? t1 : t0; const int tr = idx >> 2, tc = idx & 3;
#define R1_END }
#define MMF(X, Y, acc) mm_tile<true, true>((X), LP, 1, (Y), 1, LP, tr, tc, (acc), lane)
        const f32x4_t zero4 = {0.f, 0.f, 0.f, 0.f};
        R1_FOR_TILES(idx, tr, tc)
            f32x4_t mab = MMF(Bt, At, zero4); triu_tile<true>(mab, tr, tc, lane); st_tile(mab, S7, LP, 1, tr, tc, lane); st_tile(mab, S8, 1, LP, tr, tc, lane);
            { f32x4_t tt = mab; const int row0 = 16 * tr + 4 * (lane >> 4), col = 16 * tc + (lane & 15);
#pragma unroll
              for (int e = 0; e < 4; ++e) tt[e] += (row0 + e == col) ? 1.f : 0.f;
              st_tile(tt, S9, LP, 1, tr, tc, lane); }
            f32x4_t mka = MMF(Kt, At, zero4); triu_tile<true>(mka, tr, tc, lane); st_tile(mka, Mka, LP, 1, tr, tc, lane);
            f32x4_t nbr = MMF(Bt, Rt, zero4); triu_tile<false>(nbr, tr, tc, lane); st_tile(nbr, NbrT, 1, LP, tr, tc, lane);
            f32x4_t nkr = MMF(Kt, Rt, zero4); triu_tile<false>(nkr, tr, tc, lane); st_tile(nkr, Nkr, LP, 1, tr, tc, lane);
        R1_END
        __syncthreads();
        bf16_t* VmT = At;
        { const unsigned vw_[4] = {vraw.x, vraw.y, vraw.z, vraw.w};
#pragma unroll
          for (int e = 0; e < 8; ++e) VmT[(sj + e) * LP + st] = (bf16_t)((e & 1) ? (vw_[e >> 1] >> 16) : (vw_[e >> 1] & 0xffffu)); }
        bf16_t* Pc = S7; bf16_t* PcT = S8; bf16_t* Pn = Bt; bf16_t* PnT = Kt; bf16_t* Tc = S9; bf16_t* Tn = (bf16_t*)cs; bf16_t* TT = nullptr;
#pragma unroll 1
        for (int k = 1; k <= 6; ++k) {
            R1_FOR_TILES(idx, tr, tc)
                if (k <= 5) { f32x4_t pp = MMF(Pc, PcT, zero4); st_tile(pp, Pn, LP, 1, tr, tc, lane); st_tile(pp, PnT, 1, LP, tr, tc, lane); }
                if (k >= 2) { f32x4_t tn = ld_tile(Tc, LP, 1, tr, tc, lane); tn = MMF(Tc, PcT, tn); st_tile(tn, Tn, LP, 1, tr, tc, lane);
                    if (k == 6) st_tile(tn, Pn, 1, LP, tr, tc, lane); }
            R1_END
            __syncthreads();
            if (k == 6) TT = Pn;
            if (k <= 5) { bf16_t* x_ = Pc; Pc = Pn; Pn = x_; x_ = PcT; PcT = PnT; PnT = x_; }
            if (k >= 2) { bf16_t* x_ = Tc; Tc = Tn; Tn = x_; }
        }
        bf16_t* W1 = Pc; bf16_t* W2 = PcT; bf16_t* QkT = PnT;
        bf16_t* Og1 = Tn; bf16_t* Og2 = Tc; bf16_t* Opt = TT; bf16_t* Oqt = W1;
        R1_FOR_TILES(idx, tr, tc)
            f32x4_t w1 = MMF(AtT, TT, zero4); st_tile(w1, W1, LP, 1, tr, tc, lane);
            f32x4_t w2 = MMF(Mka, TT, zero4); st_tile(w2, W2, LP, 1, tr, tc, lane);
        R1_END
        __syncthreads();
        R1_FOR_TILES(idx, tr, tc)
            f32x4_t g1 = ld_tile(Rt, 1, LP, tr, tc, lane); g1 = MMF(W1, NbrT, g1); st_tile(g1, Og1, 1, LP, tr, tc, lane);
            f32x4_t g2 = ld_tile(Nkr, LP, 1, tr, tc, lane); g2 = MMF(W2, NbrT, g2); st_tile(g2, Og2, 1, LP, tr, tc, lane);
            f32x4_t pm = MMF(W1, BhT, zero4);
            { const int row0 = 16 * tr + 4 * (lane >> 4), col = 16 * tc + (lane & 15);
#pragma unroll
              for (int e = 0; e < 4; ++e) pm[e] += (row0 + e == col) ? gLs[col] : 0.f; }
            { const int row0 = 16 * tr + 4 * (lane >> 4), col = 16 * tc + (lane & 15);
#pragma unroll
              for (int e = 0; e < 4; ++e) { const int j = row0 + e; const int frag = (col >> 5) * 4 + 2 * (j >> 5) + ((j & 31) >> 4);
                Opt[(frag * 64 + (col & 31) + 32 * ((j >> 2) & 1)) * 8 + 4 * ((j >> 3) & 1) + (j & 3)] = f2bf(pm[e]); } }
            f32x4_t qk = ld_tile(Kh, LP, 1, tr, tc, lane); qk = MMF(W2, BhT, qk); st_tile(qk, QkT, 1, LP, tr, tc, lane);
        R1_END
        __syncthreads();
        {
            const int row = tid >> 3, ch8 = (tid & 7) * 8;
            *(uint4*)(G1T + (size_t)row * RW + ch8) = *(const uint4*)(Og1 + row * LP + ch8);
            *(uint4*)(G2T + (size_t)row * (2 * RW) + ch8) = *(const uint4*)(Og2 + row * LP + ch8);
            *(uint4*)(PT + (size_t)row * RW + ch8) = *(const uint4*)(Opt + row * 64 + ch8);
        }
        R1_FOR_TILES(idx, tr, tc)
            f32x4_t qt = MMF(QkT, VmT, zero4);
            { const int row0 = 16 * tr + 4 * (lane >> 4), col = 16 * tc + (lane & 15);
#pragma unroll
              for (int e = 0; e < 4; ++e) { const int jp = row0 + e; const int ci = ((jp >> 5) * 2 + (col >> 5)) * 64 + (col & 31) + 32 * ((jp >> 2) & 1);
                Oqt[ci * 16 + (jp & 3) + 4 * ((jp & 31) >> 3)] = f2bf(qt[e]); } }
        R1_END
        __syncthreads();
        { const int ci = tid >> 1, hf = tid & 1;
          *(uint4*)(QT + (size_t)(ci >> 2) * (2 * RW) + (ci & 3) * 16 + hf * 8) = *(const uint4*)(Oqt + ci * 16 + hf * 8); }
#undef MMF
    }
}
__device__ void ph_rwkv_prep_r1(const P& p, float* ldsf) {
    for (int b64 = blockIdx.x; b64 < NT / 64; b64 += gridDim.x) {
        ph_rwkv_prep(p, ldsf, 2 * b64, 2 * b64 + 2, 1);
        __syncthreads();
        const int b = b64 >> 7, c = b64 & 127, ch0 = (b * 8) * 128 + c;
        ph_rwkv_r1(p, ldsf, ch0, ch0 + 8 * 128, 128);
    }
}
__device__ void ph_rwkv_r2(const P& p, int bh_first, int bh_end, int bh_step) {
    bf16_t* SX = (bf16_t*)(p.ws + WS_SX);
    const int tid = otid(), lane = tid & 63, wv = tid >> 6, hh = lane >> 5, r32 = lane & 31;
    typedef short s16x4_t __attribute__((ext_vector_type(4)));
    for (int bh = bh_first; bh < bh_end; bh += bh_step) {
        if (wv >= 2) continue;
        const int cb = wv;
        f32x16_t x0, x1;
#pragma unroll
        for (int i = 0; i < 16; ++i) { x0[i] = 0.f; x1[i] = 0.f; }
        bf16x8_t pa[3][2][4]; uint4 qa[3][2][2];
#define R2_LOAD(S_, c_) do { const size_t gb_ = ((size_t)(bh >> 3) * SEQ + (size_t)(c_) * 64) * RW + (bh & 7) * 64; \
            const bf16_t* PT = (const bf16_t*)(p.ws + WS_BB) + gb_; const bf16_t* QT = (const bf16_t*)(p.ws + WS_DD) + 2 * gb_ + 64; \
            _Pragma("unroll") for (int rb = 0; rb < 2; ++rb) { \
                _Pragma("unroll") for (int ks = 0; ks < 4; ++ks) { const int o_ = ((rb * 4 + ks) * 64 + lane) * 8;        \
                    pa[S_][rb][ks] = *(const bf16x8_t*)(PT + (size_t)(o_ >> 6) * RW + (o_ & 63)); } \
                const int ci_ = (rb * 2 + cb) * 64 + lane; const uint4* qp = (const uint4*)(QT + (size_t)(ci_ >> 2) * (2 * RW) + (ci_ & 3) * 16); qa[S_][rb][0] = qp[0]; qa[S_][rb][1] = qp[1]; } } while (0)
#define R2_STEP(S_, c_) do { const int cc_ = (c_); const size_t ob_ = ((size_t)bh * 128 + cc_) * 4096; \
              \
            const bf16x8_t xb0 = pack_step16(x0, 0), xb1 = pack_step16(x0, 1), xb2 = pack_step16(x1, 0), xb3 = pack_step16(x1, 1); \
            { bf16x8_t* sp = (bf16x8_t*)(SX + ob_) + (cb * 4) * 64 + lane;        \
              sp[0] = xb0; sp[64] = xb1; sp[128] = xb2; sp[192] = xb3; } \
            f32x16_t n0, n1; \
            { const unsigned qw0[8] = {qa[S_][0][0].x, qa[S_][0][0].y, qa[S_][0][0].z, qa[S_][0][0].w, qa[S_][0][1].x, qa[S_][0][1].y, qa[S_][0][1].z, qa[S_][0][1].w}; \
              const unsigned qw1[8] = {qa[S_][1][0].x, qa[S_][1][0].y, qa[S_][1][0].z, qa[S_][1][0].w, qa[S_][1][1].x, qa[S_][1][1].y, qa[S_][1][1].z, qa[S_][1][1].w}; \
              _Pragma("unroll") for (int i = 0; i < 8; ++i) { n0[2 * i] = __uint_as_float(qw0[i] << 16); n0[2 * i + 1] = __uint_as_float(qw0[i] & 0xffff0000u); n1[2 * i] = __uint_as_float(qw1[i] << 16); n1[2 * i + 1] = __uint_as_float(qw1[i] & 0xffff0000u); } } \
            n0 = MFMA32(pa[S_][0][0], xb0, n0); n0 = MFMA32(pa[S_][0][1], xb1, n0); n0 = MFMA32(pa[S_][0][2], xb2, n0); n0 = MFMA32(pa[S_][0][3], xb3, n0); \
            n1 = MFMA32(pa[S_][1][0], xb0, n1); n1 = MFMA32(pa[S_][1][1], xb1, n1); n1 = MFMA32(pa[S_][1][2], xb2, n1); n1 = MFMA32(pa[S_][1][3], xb3, n1); \
            x0 = n0; x1 = n1; \
            if (cc_ + 3 < SEQ / 64) R2_LOAD(S_, cc_ + 3); } while (0)
        R2_LOAD(0, 0); R2_LOAD(1, 1); R2_LOAD(2, 2);
#pragma unroll 1
        for (int c = 0; c + 2 < SEQ / 64; c += 3) { R2_STEP(0, c); R2_STEP(1, c + 1); R2_STEP(2, c + 2); }
        R2_STEP(0, SEQ / 64 - 2); R2_STEP(1, SEQ / 64 - 1);
#undef R2_STEP
#undef R2_LOAD
    }
}
__device__ void ph_rwkv_r3(const P& p, float* ldsf) {
    const bf16_t* VV = (const bf16_t*)(p.ws + WS_VV); const bf16_t* SX = (const bf16_t*)(p.ws + WS_SX);
    const bf16_t* Rg = (const bf16_t*)(p.ws + WS_R); const bf16_t* K2 = (const bf16_t*)(p.ws + WS_K2); const bf16_t* Gg = (const bf16_t*)(p.ws + WS_G); bf16_t* ORW = (bf16_t*)(p.ws + WS_ORW);
    const float* r_k = p.in[18]; const float* ln_w = p.in[19]; const float* ln_b = p.in[20];
    bf16_t* Vm = (bf16_t*)ldsf; float* Yl = (float*)(Vm + SLOT);
    const int tid = otid(), lane = tid & 63, wv = tid >> 6; const int t0 = 2 * wv, t1 = 2 * wv + 1;
    const int st = tid >> 3, sj = (tid & 7) * 8;
    for (int ch = blockIdx.x; ch < NB * 8 * (SEQ / 64); ch += gridDim.x) {
        const int bh = ch >> 7, c = ch & 127, b = bh >> 3, h = bh & 7;
        const size_t gbase = ((size_t)b * SEQ + (size_t)c * 64) * RW + h * 64, ob_ = (size_t)ch * 4096;
        const bf16_t* G1T = (const bf16_t*)(p.ws + WS_KK) + gbase; const bf16_t* G2T = (const bf16_t*)(p.ws + WS_DD) + 2 * gbase;
        __syncthreads();
        const uint4 vraw = *(const uint4*)(VV + gbase + (size_t)st * RW + sj);
        *(uint4*)(Vm + st * LP + sj) = vraw;
        __syncthreads();
        R1_FOR_TILES(idx, tr, tc)
            const f32x4_t zero4 = {0.f, 0.f, 0.f, 0.f};
            f32x4_t y = zero4;
            {
                const int i_ = 16 * tr + (lane & 15), q_ = lane >> 4; typedef short s16x4_t __attribute__((ext_vector_type(4)));
#pragma unroll
                for (int s2 = 0; s2 < 2; ++s2) { const int j0 = 32 * s2 + 8 * q_;
                    const int frag = (i_ >> 5) * 4 + 2 * (j0 >> 5) + ((j0 & 31) >> 4); const bf16_t* fp = SX + ob_ + ((size_t)frag * 64 + (i_ & 31)) * 8 + 4 * ((j0 >> 3) & 1);
                    const s16x4_t lo = *(const s16x4_t*)fp, hi = *(const s16x4_t*)(fp + 32 * 8);
                    bf16x8_t a; a[0] = lo[0]; a[1] = lo[1]; a[2] = lo[2]; a[3] = lo[3]; a[4] = hi[0]; a[5] = hi[1]; a[6] = hi[2]; a[7] = hi[3];
                    const bf16x8_t b = *(const bf16x8_t*)(G1T + (size_t)(16 * tc + (lane & 15)) * RW + 32 * s2 + 8 * q_);
                    y = __builtin_amdgcn_mfma_f32_16x16x32_bf16(a, b, y, 0, 0, 0); }
            }
            y = mm_tile<false, true>(Vm, 1, LP, G2T, 1, 2 * RW, tr, tc, y, lane);
            const int i0 = 16 * tr + 4 * (lane >> 4), t = 16 * tc + (lane & 15);
#pragma unroll
            for (int e = 0; e < 4; ++e) Yl[t * 65 + i0 + e] = y[e];
        R1_END
        __syncthreads();
        {
            float y[8], s1 = 0.f;
#pragma unroll
            for (int e = 0; e < 8; ++e) { y[e] = Yl[st * 65 + sj + e]; s1 += y[e]; }
            s1 += __shfl_xor(s1, 1); s1 += __shfl_xor(s1, 2); s1 += __shfl_xor(s1, 4);
            const float mean = s1 * (1.f / 64.f); float s2 = 0.f;
#pragma unroll
            for (int e = 0; e < 8; ++e) { y[e] -= mean; s2 += y[e] * y[e]; }
            s2 += __shfl_xor(s2, 1); s2 += __shfl_xor(s2, 2); s2 += __shfl_xor(s2, 4);
            const float rstd = rsqrtf(s2 * (1.f / 64.f) + GN_EPS);
            const size_t o = gbase + (size_t)st * RW + sj;
            const uint4 rr = *(const uint4*)(Rg + o), kr = *(const uint4*)(K2 + o), gr = *(const uint4*)(Gg + o);
            const unsigned rw_[4] = {rr.x, rr.y, rr.z, rr.w}, kw_[4] = {kr.x, kr.y, kr.z, kr.w}, gw_[4] = {gr.x, gr.y, gr.z, gr.w}, vw_[4] = {vraw.x, vraw.y, vraw.z, vraw.w};
            float rk = 0.f;
#pragma unroll
            for (int e = 0; e < 8; ++e) { const float r_ = (e & 1) ? __uint_as_float(rw_[e >> 1] & 0xffff0000u) : __uint_as_float(rw_[e >> 1] << 16), k_ = (e & 1) ? __uint_as_float(kw_[e >> 1] & 0xffff0000u) : __uint_as_float(kw_[e >> 1] << 16);
                rk += r_ * k_ * r_k[h * 64 + sj + e]; }
            rk += __shfl_xor(rk, 1); rk += __shfl_xor(rk, 2); rk += __shfl_xor(rk, 4);
            float ov[8];
#pragma unroll
            for (int e = 0; e < 8; ++e) { const float v_ = (e & 1) ? __uint_as_float(vw_[e >> 1] & 0xffff0000u) : __uint_as_float(vw_[e >> 1] << 16), g_ = (e & 1) ? __uint_as_float(gw_[e >> 1] & 0xffff0000u) : __uint_as_float(gw_[e >> 1] << 16);
                ov[e] = (y[e] * rstd * ln_w[h * 64 + sj + e] + ln_b[h * 64 + sj + e] + rk * v_) * g_; }
            *(uint4*)(ORW + o) = make_uint4(pk2(ov[0], ov[1]), pk2(ov[2], ov[3]), pk2(ov[4], ov[5]), pk2(ov[6], ov[7]));
        }
    }
}
#undef R1_FOR_TILES
#undef R1_END

__device__ void ph_moe_lists(const P& p, float* ldsf) {
    int* ctl = (int*)(p.ws + WS_CTL); const int* cntB = ctl + CT_CNTB;
    int* ltok = (int*)(p.ws + WS_LTOK); float* lw = (float*)(p.ws + WS_LW);
    int* part = (int*)ldsf;
    int* tot = part + 1024; int* pre = tot + 64; int* offL = pre + 64; int* tp = offL + 64;
    const int tid = otid(), lane = tid & 63, wv = tid >> 6, G = gridDim.x;
    { int t_ = 0, p_ = 0;
      for (int b2 = wv; b2 < G; b2 += 8) { const int v = cntB[b2 * 64 + lane]; t_ += v; p_ += (b2 < (int)blockIdx.x) ? v : 0; }
      part[wv * 64 + lane] = t_; part[512 + wv * 64 + lane] = p_; }
    __syncthreads();
    if (tid < 64) { int t_ = 0, p_ = 0;
#pragma unroll
        for (int w2 = 0; w2 < 8; ++w2) { t_ += part[w2 * 64 + tid]; p_ += part[512 + w2 * 64 + tid]; }
        tot[tid] = t_; pre[tid] = p_;
        const int nt_ = (t_ + 255) >> 8; int incl = nt_;
#pragma unroll
        for (int o = 1; o < 64; o <<= 1) { const int oth = __shfl_up(incl, o); if (lane >= o) incl += oth; }
        tp[tid] = incl - nt_; offL[tid] = (incl - nt_) * 256; if (tid == 63) tp[64] = incl; }
    __syncthreads();
    const int TPB = NT / G;
    for (int i = tid; i < TPB; i += NTHR) { const int m = blockIdx.x * TPB + i; const int4 r = ((const int4*)(p.ws + WS_ROUTE))[m];
        const int l0 = r.x & 255, l1 = 32 + ((r.x >> 8) & 255), rk0 = r.y & 0xffff, rk1 = (r.y >> 16) & 0xffff;
        const int p0 = offL[l0] + pre[l0] + rk0, p1 = offL[l1] + pre[l1] + rk1;
        ltok[p0] = m; lw[p0] = __int_as_float(r.z); ltok[p1] = m; lw[p1] = __int_as_float(r.w); }
    for (int li = blockIdx.x; li < 64; li += G) {
        const int cnt = tot[li], off = offL[li], e = li & 31, nt_ = (cnt + 255) >> 8;
        int4* t1 = (int4*)(ctl + CT_TAB1) + tp[li] * 4;
        int4* t2 = (li < 32) ? (int4*)(ctl + CT_TAB2A) + tp[li] * 4 : (int4*)(ctl + CT_TAB2B) + (tp[li] - tp[32]) * 4;
        for (int i = tid; i < nt_ * 4; i += NTHR) { const int mt = i >> 2, nt = i & 3; const int4 ent = make_int4(off + mt * 256, e * 1024 + nt * 256, cnt - mt * 256, nt); t1[i] = ent; t2[i] = ent; }
        for (int r = cnt + tid; r < nt_ * 256; r += NTHR) ltok[off + r] = 0;
    }
    if (blockIdx.x == 0 && tid == 0) { ctl[CT_NU] = tp[64] * 4; ctl[CT_NU + 1] = tp[32] * 4; ctl[CT_NU + 2] = (tp[64] - tp[32]) * 4; }
}

template <int PH>
__device__ __forceinline__ void run_phase(const P& p, unsigned char* lds_raw) {
    float* lds = (float*)lds_raw; PG8_LAS unsigned char* ldsg = (PG8_LAS unsigned char*)lds_raw;
    const int G = gridDim.x, c = blockIdx.x;
    if constexpr (PH == 0) { ph_mod(p, lds); __syncthreads(); ph_convert_mixer_weights(p, lds); __syncthreads(); ph_convert_lora_weights(p, lds); }
    if constexpr (PH == 1) ph_norm(p, p.in[0], p.in[4], 0, (bf16_t*)(p.ws + WS_XN));
    if constexpr (PH == 2) { pg8::Gemm g{(const bf16_t*)(p.ws + WS_XN), (const bf16_t*)(p.ws + WS_WIN), DM, nullptr}; pg8::StaticOrder S; S.init(NT, 5120, G, c);
        pg8::EpiInproj E{p.ws, (bf16_t*)p.out}; pg8::gemm_phase(ldsg, g, S, E); }
    if constexpr (PH == 3) {
        { pg8::Gemm g{(const bf16_t*)(p.ws + WS_KVN), (const bf16_t*)(p.ws + WS_WKV), KVL, nullptr}; pg8::StaticOrder S; S.init(NT, 2 * AW, G, c);
          pg8::EpiKV E{p.ws}; pg8::gemm_phase(ldsg, g, S, E);
          pg8::Unit u;
          for (int i = 0; S.next(i, u); ++i) if (u.pn < 2) { __syncthreads(); knorm_tile(p, u.pm, u.pn); } }
        ph_rwkv_prep_r1(p, lds);
        ph_dsa_select(p, lds);
    }
    if constexpr (PH == 4) { ph_rwkv_r2(p, c, NB * 8, G); ph_dsa_attn(p, lds); }
    if constexpr (PH == 5) { ph_attn_merge(p); ph_rwkv_r3(p, lds); }
    if constexpr (PH == 6) { pg8::Gemm g{(const bf16_t*)(p.ws + WS_OATT), (const bf16_t*)(p.ws + WS_WBA), AW, nullptr}; pg8::BranchOrder S; S.S0.init(NT, DM, G, c);
        pg8::EpiMerge E{(bf16_t*)(p.ws + WS_MERGED), (const bf16_t*)p.out}; pg8::gemm_phase(ldsg, g, S, E);
        ph_convert_expert_weights(p, lds); }
    if constexpr (PH == 7) { pg8::Gemm g{(const bf16_t*)(p.ws + WS_MERGED), (const bf16_t*)(p.ws + WS_WOUT), DM, nullptr}; pg8::StaticOrder S; S.init(NT, DM, G, c);
        pg8::EpiOut E{p.in[0], (const float*)(p.ws + WS_MOD), p.out}; pg8::gemm_phase(ldsg, g, S, E); }
    if constexpr (PH == 8) ph_norm_route(p, lds);
    if constexpr (PH == 9) ph_moe_lists(p, lds);
    if constexpr (PH == 10) { const int* ctl = (const int*)(p.ws + WS_CTL);
        pg8::Gemm g{(const bf16_t*)(p.ws + WS_XN2), (const bf16_t*)(p.ws + WS_WGU), DM, (const int*)(p.ws + WS_LTOK)}; pg8::TableOrder S{(const int4*)(ctl + CT_TAB1), ctl[CT_NU], G, c};
        pg8::EpiMoe1 E{(bf16_t*)(p.ws + WS_HID), (const float*)(p.ws + WS_LW)}; pg8::gemm_phase(ldsg, g, S, E); }
    if constexpr (PH == 11 || PH == 12) { const int* ctl = (const int*)(p.ws + WS_CTL);
        pg8::Gemm g{(const bf16_t*)(p.ws + WS_HID), (const bf16_t*)(p.ws + WS_WDN), DE, nullptr};
        pg8::TableOrder S{(const int4*)(ctl + (PH == 11 ? CT_TAB2A : CT_TAB2B)), ctl[CT_NU + (PH == 11 ? 1 : 2)], G, c};
        pg8::EpiMoe2 E{(const int*)(p.ws + WS_LTOK), (const float*)(p.ws + WS_MOD), p.out}; pg8::gemm_phase(ldsg, g, S, E); }
}
constexpr int LDS_BYTES = 147456;
constexpr int ORDER[] = {0, 1, 2, 3, 4, 5, 6, 7, 8, 9, 10, 11, 12};
constexpr int NPHASE = sizeof(ORDER) / sizeof(int);
constexpr int CT_BAR = 65536;
constexpr int LDS_ST = LDS_BYTES - 64;
template <int I> __device__ __forceinline__ void run_all(const P& p, unsigned char* lds, const XcdBarrier& bar) {
    run_phase<ORDER[I]>(p, lds);
    if constexpr (I + 1 < NPHASE) { xcd_barrier(bar); run_all<I + 1>(p, lds, bar); }
}
__global__ void __launch_bounds__(NTHR, 2) k_mega(P p) {
    extern __shared__ __attribute__((aligned(16))) unsigned char lds[];
    volatile LAS3 unsigned* st = (volatile LAS3 unsigned*)((LAS3 unsigned char*)lds + LDS_ST);
    if (otid() < 16) st[otid()] = 0u;
    __syncthreads();
    const XcdBarrier bar = xcd_barrier_post((unsigned*)(p.ws + WS_CTL) + CT_BAR, st);
    run_all<0>(p, lds, bar);
}
}

extern "C" void kernel_launch(void* const* d_in, const int* in_sizes, int n_in, void* d_out, int out_size, void* d_ws, size_t ws_size, hipStream_t stream) {
    if (n_in != 31 || out_size != NT * DM || ws_size < WS_END) { fprintf(stderr, "kernel_launch: unexpected shapes (n_in %d out %d ws %zu need %zu)\n", n_in, out_size, ws_size, (size_t)WS_END); return; }
    P p{};
    for (int i = 0; i < 31; ++i) p.in[i] = (const float*)d_in[i];
    p.out = (float*)d_out; p.ws = (unsigned char*)d_ws;
    (void)hipMemsetAsync((char*)d_ws + WS_CTL, 0, 1 * MiB, stream);
    static int grid_blocks = 0;
    if (!grid_blocks) {
        int dev = 0, cus = 0, per_cu = 0;
        (void)hipGetDevice(&dev);
        (void)hipDeviceGetAttribute(&cus, hipDeviceAttributeMultiprocessorCount, dev);
        (void)hipFuncSetAttribute((const void*)k_mega, hipFuncAttributeMaxDynamicSharedMemorySize, LDS_BYTES);
        (void)hipOccupancyMaxActiveBlocksPerMultiprocessor(&per_cu, (const void*)k_mega, NTHR, LDS_BYTES);
        if (per_cu < 1) per_cu = 1;
        if (per_cu > 1) per_cu = 1;
        grid_blocks = cus * per_cu;
        fprintf(stderr, "kernel_launch: cus %d per_cu %d grid %d\n", cus, per_cu, grid_blocks);
    }
    hipLaunchKernelGGL(k_mega, dim3(grid_blocks), dim3(NTHR), LDS_BYTES, stream, p);
}
```

```cpp
#include <hip/hip_runtime.h>
#include <cstdio>
#include <cstdint>

namespace {
constexpr int NB = 2, SEQ = 8192, DM = 1024, NT = NB * SEQ;
constexpr int AW = 512, KVL = 256, NIH = 8, IDD = 32, SHW = 1824, INW = 4936;
constexpr int C_KV = 512, C_QI = 768, C_PS = 1064, C_GA = 2888, C_GR = 3912;
constexpr int IDXW = 296;
constexpr int RW = 512, NE = 32, DE = 512;
constexpr int TOPK = 256;
constexpr float NORM_EPS = 1e-6f, GN_EPS = 64e-5f;
constexpr int NTHR = 512;

typedef unsigned short bf16_t;
__device__ __forceinline__ float bf2f(bf16_t v) { return __uint_as_float(((unsigned)v) << 16); }
typedef __bf16 bf2v0_t __attribute__((ext_vector_type(2)));
typedef float f2v0_t __attribute__((ext_vector_type(2)));
__device__ __forceinline__ unsigned pk_bf16x2(float lo, float hi) { const f2v0_t v = {lo, hi}; return __builtin_bit_cast(unsigned, __builtin_convertvector(v, bf2v0_t)); }
__device__ __forceinline__ bf16_t f2bf(float f) { return (bf16_t)(pk_bf16x2(f, 0.f) & 0xffffu); }

constexpr size_t MiB = 1u << 20;
constexpr size_t WS_CTL = 0;
constexpr size_t WS_MOD = 1 * MiB;
constexpr size_t WS_RSS = 82 * MiB + 512 * 1024;
constexpr size_t WS_LW2T = 512 * 1024, WS_LA2T = 576 * 1024, WS_LG2T = 640 * 1024;
constexpr size_t WS_WIN = 2 * MiB;
constexpr size_t WS_WKV = 12 * MiB;
constexpr size_t WS_WBA = 13 * MiB;
constexpr size_t WS_WBR = 14 * MiB;
constexpr size_t WS_WOUT = 15 * MiB;
constexpr size_t WS_XN = 17 * MiB;
constexpr size_t WS_K = 17 * MiB;
constexpr size_t WS_V = 33 * MiB;
constexpr size_t WS_Q = 49 * MiB;
constexpr size_t WS_KVN = 65 * MiB;
constexpr size_t WS_QI = 73 * MiB;
constexpr size_t WS_KI = 81 * MiB;
constexpr size_t WS_WI = 82 * MiB;
constexpr size_t WS_PS = 83 * MiB;
constexpr size_t WS_SX = 83 * MiB;
constexpr size_t WS_OATT = 99 * MiB;
constexpr size_t WS_ORW = 115 * MiB;
constexpr size_t WS_MASK = 140 * MiB;
constexpr size_t WS_R = 156 * MiB, WS_K2 = 172 * MiB, WS_VV = 188 * MiB;
constexpr size_t WS_KK = 204 * MiB;
constexpr size_t WS_BB = 220 * MiB;
constexpr size_t WS_DD = 236 * MiB;
constexpr size_t WS_G = 268 * MiB;
constexpr size_t WS_MERGED = 131 * MiB;
constexpr size_t WS_XN2 = 163 * MiB;
constexpr size_t WS_WGU = 195 * MiB;
constexpr size_t WS_WDN = 259 * MiB;
constexpr size_t WS_HID = 17 * MiB;
constexpr size_t WS_ROUTE = 65 * MiB;
constexpr size_t WS_LTOK = 66 * MiB;
constexpr size_t WS_LW = 67 * MiB;
constexpr size_t WS_OFAR = 65 * MiB;
constexpr size_t WS_AML = 67 * MiB;
constexpr size_t WS_WR = 1 * MiB + 64 * 1024;
constexpr size_t WS_END = 291 * MiB;
constexpr int HID_ROWS = 49152;
constexpr int CT_CNT = 0, CT_OFF = 64, CT_CUR = 128, CT_NU = 192, CT_Q = 256;
constexpr int CT_CNTB = 16384;
constexpr int CT_TAB1 = 1024, CT_TAB2A = 1024 + 4 * 1024, CT_TAB2B = 1024 + 8 * 1024;

struct P {
    const float* in[31];
    float* out;
    unsigned char* ws;
};

__device__ __forceinline__ int otid() { int t = threadIdx.x; asm volatile("" : "+v"(t)); return t; }
__device__ __forceinline__ float dpp_row_shr(float v, int n) {
    int iv = __builtin_bit_cast(int, v), r;
    switch (n) { case 1: r = __builtin_amdgcn_update_dpp(0, iv, 0x111, 0xf, 0xf, true); break; case 2: r = __builtin_amdgcn_update_dpp(0, iv, 0x112, 0xf, 0xf, true); break;
                 case 4: r = __builtin_amdgcn_update_dpp(0, iv, 0x114, 0xf, 0xf, true); break; default: r = __builtin_amdgcn_update_dpp(0, iv, 0x118, 0xf, 0xf, true); break; }
    return __builtin_bit_cast(float, r);
}
__device__ __forceinline__ unsigned wave_scan_u32(unsigned v) {
    v += (unsigned)__builtin_amdgcn_update_dpp(0, (int)v, 0x111, 0xf, 0xf, true); v += (unsigned)__builtin_amdgcn_update_dpp(0, (int)v, 0x112, 0xf, 0xf, true);
    v += (unsigned)__builtin_amdgcn_update_dpp(0, (int)v, 0x114, 0xf, 0xf, true); v += (unsigned)__builtin_amdgcn_update_dpp(0, (int)v, 0x118, 0xf, 0xf, true);
    v += (unsigned)__builtin_amdgcn_update_dpp(0, (int)v, 0x142, 0xa, 0xf, false);
    v += (unsigned)__builtin_amdgcn_update_dpp(0, (int)v, 0x143, 0xc, 0xf, false);
    return v;
}
__device__ __forceinline__ unsigned wave_suffix_u32(unsigned x) { const unsigned inc = wave_scan_u32(x); return (unsigned)__builtin_amdgcn_readlane((int)inc, 63) - inc + x; }
__device__ __forceinline__ float sum8_dpp(float v) {
    v += __builtin_bit_cast(float, __builtin_amdgcn_update_dpp(0, __builtin_bit_cast(int, v), 0xB1, 0xf, 0xf, false));
    v += __builtin_bit_cast(float, __builtin_amdgcn_update_dpp(0, __builtin_bit_cast(int, v), 0x4E, 0xf, 0xf, false));
    const int i = __builtin_bit_cast(int, v);
    const float a = __builtin_bit_cast(float, __builtin_amdgcn_update_dpp(0, i, 0x104, 0xf, 0x5, false));
    const float b = __builtin_bit_cast(float, __builtin_amdgcn_update_dpp(0, i, 0x114, 0xf, 0xa, false));
    return v + a + b;
}
__device__ __forceinline__ float wave_sum(float v) {
    v += dpp_row_shr(v, 1); v += dpp_row_shr(v, 2); v += dpp_row_shr(v, 4); v += dpp_row_shr(v, 8);
    v += __builtin_bit_cast(float, __builtin_amdgcn_update_dpp(0, __builtin_bit_cast(int, v), 0x142, 0xa, 0xf, false));
    v += __builtin_bit_cast(float, __builtin_amdgcn_update_dpp(0, __builtin_bit_cast(int, v), 0x143, 0xc, 0xf, false));
    return __builtin_bit_cast(float, __builtin_amdgcn_readlane(__builtin_bit_cast(int, v), 63));
}
__device__ __forceinline__ float wave_max(float v) {
#pragma unroll
    for (int o = 32; o > 0; o >>= 1) v = fmaxf(v, __shfl_xor(v, o));
    return v;
}
typedef short bf16x8_t __attribute__((ext_vector_type(8)));
typedef float f32x4_t __attribute__((ext_vector_type(4)));
constexpr int LP = 72;
constexpr int SLOT = 64 * LP;
typedef __bf16 bf2_t __attribute__((ext_vector_type(2)));
typedef float f2_t __attribute__((ext_vector_type(2)));
__device__ __forceinline__ unsigned pk_bf16(float lo, float hi) { const f2_t v = {lo, hi}; return __builtin_bit_cast(unsigned, __builtin_convertvector(v, bf2_t)); }
__device__ __forceinline__ float sigmoidf_(float x) { return __builtin_amdgcn_rcpf(1.f + __expf(-x)); }

#define XB_TMO      128
#define XB_XCNT(j)  (256  + 64 * (j))
#define XB_XSUB(j)  (1280 + 64 * (j))
#define XB_XGEN(j)  (2304 + 64 * (j))
#define XB_TOP      3328
#define XB_TOPGEN   3392
#define XCD_BAR_WORDS 3456
#define XB_SPIN_CAP (1u << 22)
#define LAS3 __attribute__((address_space(3)))
__device__ __forceinline__ unsigned xb_ld(unsigned* p)              { return __hip_atomic_load(p, __ATOMIC_RELAXED, __HIP_MEMORY_SCOPE_AGENT); }
__device__ __forceinline__ unsigned xb_add(unsigned* p, unsigned v) { return __hip_atomic_fetch_add(p, v, __ATOMIC_RELAXED, __HIP_MEMORY_SCOPE_AGENT); }
__device__ __forceinline__ unsigned xb_xcc_id() { return (unsigned)__builtin_amdgcn_s_getreg((3 << 11) | 20) & 0xFu; }
#define XB_SPIN(cond, bar) do { unsigned _sp = 0; while (cond) { __builtin_amdgcn_s_sleep(1); \
    if ((++_sp & 255u) == 0u) { if (xb_ld(&(bar)[XB_TMO])) break; if (_sp > XB_SPIN_CAP) { atomicAdd(&(bar)[XB_TMO], 1u); break; } } } } while (0)
struct XcdBarrier { unsigned* bar; unsigned x; volatile LAS3 unsigned* st; };
__device__ __forceinline__ XcdBarrier xcd_barrier_post(unsigned* bar, volatile LAS3 unsigned* st) {
    XcdBarrier b; b.bar = bar; b.x = xb_xcc_id(); b.st = st;
    if (otid() == 0) (void)xb_add(&bar[XB_XCNT(b.x)], 1u);
    return b;
}
__device__ __forceinline__ void xcd_barrier_complete(unsigned* bar, unsigned x, unsigned& nloc, unsigned& nx) {
    const unsigned G = gridDim.x * gridDim.y * gridDim.z;
    unsigned sum, cnt, mine, sp = 0u;
    for (;;) {
        sum = 0u; cnt = 0u; mine = 0u;
#pragma unroll
        for (unsigned j = 0; j < 16; ++j) { const unsigned c = xb_ld(&bar[XB_XCNT(j)]); sum += c; cnt += (c > 0u) ? 1u : 0u; mine = (j == x) ? c : mine; }
        if (sum == G) break;
        __builtin_amdgcn_s_sleep(1);
        if ((++sp & 255u) == 0u) { if (xb_ld(&bar[XB_TMO])) break; if (sp > XB_SPIN_CAP) { atomicAdd(&bar[XB_TMO], 1u); break; } }
    }
    nloc = mine > 0u ? mine : 1u; nx = cnt > 0u ? cnt : 1u;
}
__device__ __forceinline__ void xcd_barrier(const XcdBarrier& b) {
    asm volatile("s_waitcnt vmcnt(0)" ::: "memory");
    __syncthreads();
    if (otid() == 0) {
        unsigned* bar = b.bar;
        __builtin_amdgcn_s_waitcnt(0);
        unsigned nloc = b.st[0], nx = b.st[1];
        if (nloc == 0u) { xcd_barrier_complete(bar, b.x, nloc, nx); b.st[0] = nloc; b.st[1] = nx; }
        const unsigned old = xb_add(&bar[XB_XSUB(b.x)], 1u);
        const unsigned gen = old / nloc;
        if (old + 1u == (gen + 1u) * nloc) {
            __builtin_amdgcn_fence(__ATOMIC_RELEASE, "agent");
            asm volatile("s_waitcnt vmcnt(0)" ::: "memory");
            const unsigned og = xb_add(&bar[XB_TOP], 1u);
            const unsigned tg = og / nx;
            if (og + 1u == (tg + 1u) * nx) xb_add(&bar[XB_TOPGEN], 1u);
            else XB_SPIN(xb_ld(&bar[XB_TOPGEN]) == tg, bar);
            __builtin_amdgcn_fence(__ATOMIC_ACQUIRE, "agent");
            xb_add(&bar[XB_XGEN(b.x)], 1u);
            asm volatile("s_waitcnt vmcnt(0)" ::: "memory");
        } else {
            XB_SPIN(xb_ld(&bar[XB_XGEN(b.x)]) == gen, bar);
            __builtin_amdgcn_fence(__ATOMIC_ACQUIRE, "agent");
            asm volatile("s_waitcnt vmcnt(0)" ::: "memory");
        }
    }
    __syncthreads();
}

__device__ void ph_mod(const P& p, float* lds) {
    const float* c = p.in[1]; const float* W = p.in[2]; const float* bia = p.in[3];
    float* mod = (float*)(p.ws + WS_MOD);
    const int tid = otid(), lane = tid & 63, wv = tid >> 6;
    float* sil = lds; float* part = lds + NB * DM;
    for (int i = tid; i < NB * DM; i += NTHR) { const float v = c[i]; sil[i] = v / (1.f + __expf(-v)); }
    __syncthreads();
    const int cc = lane % 24, kk = lane / 24;
    for (int j0 = blockIdx.x * 24; j0 < 6 * DM; j0 += gridDim.x * 24) {
        float a0 = 0.f, a1 = 0.f;
        if (lane < 48) {
#pragma unroll 32
            for (int i = 0; i < 64; ++i) { const int k = 128 * wv + 2 * i + kk; const float w = W[(size_t)k * (6 * DM) + j0 + cc]; a0 += sil[k] * w; a1 += sil[DM + k] * w; }
        }
        a0 += __shfl(a0, (lane + 24) & 63); a1 += __shfl(a1, (lane + 24) & 63);
        if (lane < 24) { part[(wv * 2 + 0) * 24 + cc] = a0; part[(wv * 2 + 1) * 24 + cc] = a1; }
        __syncthreads();
        if (tid < 48) { const int bb = tid / 24, c2 = tid % 24; float sum = 0.f;
#pragma unroll
            for (int w2 = 0; w2 < 8; ++w2) sum += part[(w2 * 2 + bb) * 24 + c2];
            mod[bb * 6 * DM + j0 + c2] = sum + bia[j0 + c2]; }
        __syncthreads();
    }
}

__device__ void ph_norm(const P& p, const float* src, const float* g, int which, bf16_t* dst) {
    const float* mod = (const float*)(p.ws + WS_MOD);
    const int lane = otid() & 63, wv = otid() >> 6;
    const int gw = blockIdx.x * (NTHR / 64) + wv, nw = gridDim.x * (NTHR / 64);
    for (int m = gw; m < NT; m += nw) {
        const int b = m / SEQ;
        const float* sh = mod + b * 6 * DM + (which ? 3 * DM : 0);
        const float* sc = sh + DM;
        const float4* xr = (const float4*)(src + (size_t)m * DM);
        float4 v[4]; float ss = 0.f;
#pragma unroll
        for (int j = 0; j < 4; ++j) { v[j] = xr[lane + 64 * j]; ss += v[j].x * v[j].x + v[j].y * v[j].y + v[j].z * v[j].z + v[j].w * v[j].w; }
        ss = wave_sum(ss);
        const float rstd = rsqrtf(ss * (1.f / DM) + NORM_EPS);
        float o[16];
#pragma unroll
        for (int j = 0; j < 4; ++j) {
            int c0 = 4 * (lane + 64 * j); asm volatile("" : "+v"(c0));
            const float4 gg = *(const float4*)(g + c0), s1 = *(const float4*)(sc + c0), s0 = *(const float4*)(sh + c0);
            o[4 * j + 0] = v[j].x * rstd * gg.x * (1.f + s1.x) + s0.x; o[4 * j + 1] = v[j].y * rstd * gg.y * (1.f + s1.y) + s0.y;
            o[4 * j + 2] = v[j].z * rstd * gg.z * (1.f + s1.z) + s0.z; o[4 * j + 3] = v[j].w * rstd * gg.w * (1.f + s1.w) + s0.w;
            uint2 pk; pk.x = pk_bf16x2(o[4 * j], o[4 * j + 1]); pk.y = pk_bf16x2(o[4 * j + 2], o[4 * j + 3]);
            *(uint2*)(dst + (size_t)m * DM + c0) = pk;
        }
    }
}

__device__ void ph_convert_router_weights(const P& p) {
    const float* wgr = p.in[25]; const float* wer = p.in[26]; bf16_t* Wr = (bf16_t*)(p.ws + WS_WR);
    for (int i = blockIdx.x * NTHR + otid(); i < 48 * DM; i += gridDim.x * NTHR) {
        const int n = i / DM, k = i % DM;
        const float v = n < 32 ? wer[(size_t)k * 32 + n] : (n < 36 ? wgr[(size_t)k * 4 + (n - 32)] : 0.f);
        const bf16_t hi = f2bf(v); Wr[i] = hi; Wr[48 * DM + i] = f2bf(v - bf2f(hi));
    }
}
__device__ void ph_norm_route(const P& p, float* lds) {
    const float* mod = (const float*)(p.ws + WS_MOD); const float* src = p.out; const float* g = p.in[24]; bf16_t* dst = (bf16_t*)(p.ws + WS_XN2);
    const float* eb = p.in[27]; const bf16_t* Wr = (const bf16_t*)(p.ws + WS_WR);
    const int tid = otid(), lane = tid & 63, wv = tid >> 6;
    constexpr int APT = 1032;
    bf16_t* At = (bf16_t*)lds;
    float* red = (float*)(At + 64 * APT);
    int* cntL = (int*)(red + 12 * 256);
    if (tid < 64) cntL[tid] = 0;
    const int TPB = NT / gridDim.x;
    for (int mb = blockIdx.x * TPB; mb < (blockIdx.x + 1) * TPB; mb += 64) {
        __syncthreads();
        {
            const int b = mb / SEQ;
            const float* sh = mod + b * 6 * DM + 3 * DM; const float* sc = sh + DM;
            float scl[16], sft[16];
#pragma unroll
            for (int j = 0; j < 4; ++j) { const int c0 = 4 * (lane + 64 * j); const float4 gg = *(const float4*)(g + c0), s1 = *(const float4*)(sc + c0), s0 = *(const float4*)(sh + c0);
                scl[4 * j] = gg.x * (1.f + s1.x); scl[4 * j + 1] = gg.y * (1.f + s1.y); scl[4 * j + 2] = gg.z * (1.f + s1.z); scl[4 * j + 3] = gg.w * (1.f + s1.w);
                sft[4 * j] = s0.x; sft[4 * j + 1] = s0.y; sft[4 * j + 2] = s0.z; sft[4 * j + 3] = s0.w; }
#pragma unroll 1
            for (int i = 0; i < 8; i += 2) {
                const int tl = 8 * wv + i;
                float4 v[2][4];
#pragma unroll
                for (int u = 0; u < 2; ++u)
#pragma unroll
                    for (int j = 0; j < 4; ++j) v[u][j] = ((const float4*)(src + (size_t)(mb + tl + u) * DM))[lane + 64 * j];
#pragma unroll
                for (int u = 0; u < 2; ++u) {
                    float ss = 0.f;
#pragma unroll
                    for (int j = 0; j < 4; ++j) ss += v[u][j].x * v[u][j].x + v[u][j].y * v[u][j].y + v[u][j].z * v[u][j].z + v[u][j].w * v[u][j].w;
                    ss = wave_sum(ss);
                    const float rstd = rsqrtf(ss * (1.f / DM) + NORM_EPS);
#pragma unroll
                    for (int j = 0; j < 4; ++j) {
                        const int c0 = 4 * (lane + 64 * j);
                        const float o0 = v[u][j].x * rstd * scl[4 * j] + sft[4 * j], o1 = v[u][j].y * rstd * scl[4 * j + 1] + sft[4 * j + 1];
                        const float o2 = v[u][j].z * rstd * scl[4 * j + 2] + sft[4 * j + 2], o3 = v[u][j].w * rstd * scl[4 * j + 3] + sft[4 * j + 3];
                        const uint2 pk = make_uint2(pk_bf16x2(o0, o1), pk_bf16x2(o2, o3));
                        *(uint2*)(dst + (size_t)(mb + tl + u) * DM + c0) = pk;
                        *(uint2*)(At + (tl + u) * APT + c0) = pk;
                    }
                }
            }
        }
        __syncthreads();
        {
            const int mt = wv & 3, kh = wv >> 2, l15 = lane & 15, q4 = lane >> 4;
            f32x4_t acc[3];
#pragma unroll
            for (int nt = 0; nt < 3; ++nt) acc[nt] = (f32x4_t){0.f, 0.f, 0.f, 0.f};
            const bf16_t* ap = At + (16 * mt + l15) * APT + 512 * kh + 8 * q4;
            const bf16_t* bp = Wr + (size_t)l15 * DM + 512 * kh + 8 * q4;
#pragma unroll 4
            for (int ks = 0; ks < 16; ++ks) {
                const bf16x8_t a = *(const bf16x8_t*)(ap + 32 * ks);
#pragma unroll
                for (int nt = 0; nt < 3; ++nt) {
                    const bf16x8_t bh_ = *(const bf16x8_t*)(bp + (size_t)(16 * nt) * DM + 32 * ks), bl_ = *(const bf16x8_t*)(bp + (size_t)(48 + 16 * nt) * DM + 32 * ks);
                    acc[nt] = __builtin_amdgcn_mfma_f32_16x16x32_bf16(a, bh_, acc[nt], 0, 0, 0);
                    acc[nt] = __builtin_amdgcn_mfma_f32_16x16x32_bf16(a, bl_, acc[nt], 0, 0, 0);
                }
            }
            if (kh == 1) {
#pragma unroll
                for (int nt = 0; nt < 3; ++nt) *(f32x4_t*)(red + (mt * 3 + nt) * 256 + lane * 4) = acc[nt];
            }
            __syncthreads();
            if (kh == 0) {
#pragma unroll
                for (int nt = 0; nt < 3; ++nt) { f32x4_t* r_ = (f32x4_t*)(red + (mt * 3 + nt) * 256 + lane * 4); *r_ = *r_ + acc[nt]; }
            }
            __syncthreads();
        }
        if (tid < 64) {
            const int mt = tid >> 4, tr_ = tid & 15; const float* rb = red + mt * 768 + 64 * (tr_ >> 2) + (tr_ & 3);
            float lg[4];
#pragma unroll
            for (int q = 0; q < 4; ++q) lg[q] = rb[2 * 256 + q * 4];
            int gs = 0; float mx = lg[0];
#pragma unroll
            for (int q = 1; q < 4; ++q) if (lg[q] > mx) { mx = lg[q]; gs = q; }
            float den = 0.f;
#pragma unroll
            for (int q = 0; q < 4; ++q) den += __expf(lg[q] - mx);
            const float pg = 1.f / den;
            float ev[8];
#pragma unroll
            for (int q = 0; q < 8; ++q) { const int n = gs * 8 + q; ev[q] = rb[(n >> 4) * 256 + (n & 15) * 4] + eb[n]; }
            int i0 = 0; float v0 = ev[0];
#pragma unroll
            for (int q = 1; q < 8; ++q) if (ev[q] > v0) { v0 = ev[q]; i0 = q; }
            int i1 = -1; float v1 = -INFINITY;
#pragma unroll
            for (int q = 0; q < 8; ++q) if (q != i0 && ev[q] > v1) { v1 = ev[q]; i1 = q; }
            const float e1 = __expf(v1 - v0), w0 = pg / (1.f + e1), w1 = pg * e1 / (1.f + e1);
            const int x0 = gs * 8 + i0, x1 = gs * 8 + i1;
            const int rk0 = atomicAdd(&cntL[x0], 1), rk1 = atomicAdd(&cntL[32 + x1], 1);
            int4* route = (int4*)(p.ws + WS_ROUTE) + (size_t)(mb + tid);
            *route = make_int4(x0 | (x1 << 8), rk0 | (rk1 << 16), __float_as_int(w0), __float_as_int(w1));
        }
    }
    __syncthreads();
    if (tid < 64) ((int*)(p.ws + WS_CTL) + CT_CNTB)[blockIdx.x * 64 + tid] = cntL[tid];
}

namespace pg8 {
#define PG8_LAS __attribute__((address_space(3)))
typedef short bf16x8 __attribute__((ext_vector_type(8)));
typedef float f32x4 __attribute__((ext_vector_type(4)));
typedef unsigned u32x4 __attribute__((ext_vector_type(4)));
constexpr int BM = 256, BK = 64, HALF = 128, HTB = HALF * BK * 2, STAGE_BYTES = 8 * HTB, NXCD = 8, WGM = 4;
__host__ __device__ __forceinline__ int lds_byte(int r, int c) { const int st = (r >> 4) * 2 + (c >> 5), rr = r & 15, cc = c & 31, ob = rr * 64 + cc * 2; return st * 1024 + (ob ^ (((ob >> 9) & 1) << 5)); }
__host__ __device__ __forceinline__ void stage_rc(int b, int& R, int& C) { const int st = b / 1024, sb = b % 1024, swz = sb ^ (((sb >> 9) & 1) << 5); R = (st >> 1) * 16 + swz / 64; C = (st & 1) * 32 + (swz % 64) / 2; }
__host__ __device__ __forceinline__ int perm32(int rho) { const int n = rho >> 4, i = rho & 15; return 8 * (i >> 2) + 4 * n + (i & 3); }

struct Unit { int arow, brow, pm, pn, aux; };
struct Gemm { const bf16_t* A; const bf16_t* Bt; int K; const int* gather; };

struct StaticOrder {
    int nM, nN, nwg, G, c;
    __device__ void init(int M, int N, int G_, int c_) { nM = M / BM; nN = N / BM; nwg = nM * nN; G = G_; c = c_; }
    __device__ bool next(int i, Unit& u) const {
        const long L = (long)i * G + c; if (L >= nwg) return false;
        int wgid = (int)L; { const int q = nwg / NXCD, r = nwg % NXCD, xcd = wgid % NXCD, off = wgid / NXCD; wgid = (xcd < r ? xcd * (q + 1) : r * (q + 1) + (xcd - r) * q) + off; }
        const int nig = WGM * nN, gid = wgid / nig, fm = gid * WGM, gsz = (nM - fm) < WGM ? (nM - fm) : WGM;
        u.pm = fm + ((wgid % nig) % gsz); u.pn = (wgid % nig) / gsz; u.arow = u.pm * BM; u.brow = u.pn * BM; u.aux = 0; return true;
    }
};
struct BranchOrder {
    StaticOrder S0;
    __device__ bool next(int i, Unit& u) const {
        if (!S0.next(i >> 1, u)) return false;
        const int which = i & 1; u.arow += which * NT; u.brow += which * DM; u.aux = which; return true;
    }
};
struct TableOrder {
    const int4* tab; int n, G, c;
    __device__ bool next(int i, Unit& u) const {
        const int L = i * G + c; if (L >= n) return false;
        const int4 e = tab[L]; u.arow = __builtin_amdgcn_readfirstlane(e.x); u.brow = __builtin_amdgcn_readfirstlane(e.y); u.aux = __builtin_amdgcn_readfirstlane(e.z); u.pn = __builtin_amdgcn_readfirstlane(e.w); u.pm = 0; return true;
    }
};
__device__ __forceinline__ unsigned cvt_pk_bf16(float lo, float hi) { return pk_bf16(lo, hi); }

template <class Epi, class Sched>
__device__ __forceinline__ void gemm_phase(PG8_LAS unsigned char* lds, const Gemm g, const Sched& S, const Epi& E) {
    const int tid = otid(), wid = __builtin_amdgcn_readfirstlane(tid >> 6), lane = tid & 63, wr = wid >> 2, wc = wid & 3, fr = lane & 15, fq = lane >> 4;
    const int K = g.K, nt = K / BK;
    int RA0; unsigned cofA0, voffB0;
    { int R, C; stage_rc(tid * 16, R, C); const int Rb = Epi::PERM ? ((R & ~31) + perm32(R & 31)) : R; RA0 = R; cofA0 = (unsigned)C * 2u; voffB0 = (unsigned)(Rb * K + C) * 2u; }
    const size_t rstep64 = (size_t)64 * K * 2;
    const size_t kstep = (size_t)(BK * 2);
    const size_t hstep = (size_t)HALF * K * 2;
    const unsigned ldsw = (unsigned)wid * 1024u;
    const int aoff = lds_byte(wr * 64 + fr, fq * 8), boff = lds_byte(wc * 32 + fr, fq * 8);
#define PG8_SA(b, h) (((b) * 2 + (h)) * HTB)
#define PG8_SB(b, h) ((4 + (b) * 2 + (h)) * HTB)
#define PG8_STAGE_B(bufoff, gbase) do { _Pragma("unroll") for (int _i = 0; _i < 2; ++_i) \
        __builtin_amdgcn_global_load_lds((const unsigned*)((const char*)(gbase) + _i * rstep64 + voffB0), (PG8_LAS unsigned*)(lds + (bufoff) + ldsw + _i * 8192), 16, 0, 0); } while (0)
#define PG8_STAGE_A(bufoff, o2, kb) do { _Pragma("unroll") for (int _i = 0; _i < 2; ++_i) \
        __builtin_amdgcn_global_load_lds((const unsigned*)((const char*)g.A + (size_t)(o2)[_i] + (size_t)(kb)), (PG8_LAS unsigned*)(lds + (bufoff) + ldsw + _i * 8192), 16, 0, 0); } while (0)
#define PG8_LDA(dst, b, h) do { _Pragma("unroll") for (int m = 0; m < 4; ++m) _Pragma("unroll") for (int k = 0; k < 2; ++k) dst[m][k] = *(const PG8_LAS bf16x8*)(lds + PG8_SA(b, h) + aoff + m * 2048 + k * 1024); } while (0)
#define PG8_LDB(dst, b, h) do { _Pragma("unroll") for (int n = 0; n < 2; ++n) _Pragma("unroll") for (int k = 0; k < 2; ++k) dst[n][k] = *(const PG8_LAS bf16x8*)(lds + PG8_SB(b, h) + boff + n * 2048 + k * 1024); } while (0)
#define PG8_MMA(ai, bj, At, Bt) do { __builtin_amdgcn_s_setprio(1); _Pragma("unroll") for (int m = 0; m < 4; ++m) _Pragma("unroll") for (int n = 0; n < 2; ++n) _Pragma("unroll") for (int k = 0; k < 2; ++k) \
        acc[ai][bj][m][n] = __builtin_amdgcn_mfma_f32_16x16x32_bf16(Bt[n][k], At[m][k], acc[ai][bj][m][n], 0, 0, 0); __builtin_amdgcn_s_setprio(0); } while (0)
#define PG8_WAIT_V(n) asm volatile("s_waitcnt vmcnt(" #n ")" ::: "memory")
#define PG8_WAIT_L(n) asm volatile("s_waitcnt lgkmcnt(" #n ")" ::: "memory")
#define PG8_BAR __builtin_amdgcn_s_barrier()
#define PG8_SCHED __builtin_amdgcn_sched_barrier(0)
#define PG8_AOFFS(u, dst) do { _Pragma("unroll") for (int _h = 0; _h < 2; ++_h) _Pragma("unroll") for (int _i = 0; _i < 2; ++_i) { \
        const int _tr = (u).arow + _h * HALF + RA0 + 64 * _i; const unsigned _row = g.gather ? (unsigned)g.gather[_tr] : (unsigned)_tr; dst[_h][_i] = _row * (unsigned)(K * 2) + cofA0; } } while (0)
    Unit cur, nxt; int ui = 0;
    if (!S.next(0, cur)) return;
    f32x4 acc[2][2][4][2];
#pragma unroll
    for (int a = 0; a < 2; ++a)
#pragma unroll
        for (int b = 0; b < 2; ++b)
#pragma unroll
            for (int m = 0; m < 4; ++m)
#pragma unroll
                for (int n = 0; n < 2; ++n) acc[a][b][m][n] = (f32x4){0.f, 0.f, 0.f, 0.f};
    bf16x8 At[4][2], B0[2][2], B1[2][2];
    unsigned cof[2][2];
    PG8_AOFFS(cur, cof);
    const char* cB = (const char*)g.Bt + (size_t)cur.brow * K * 2;
    PG8_STAGE_B(PG8_SB(0, 0), cB); PG8_STAGE_B(PG8_SB(0, 1), cB + hstep); PG8_STAGE_A(PG8_SA(0, 0), cof[0], 0); PG8_STAGE_A(PG8_SA(0, 1), cof[1], 0);
    if (wr == 1) PG8_BAR;
    PG8_WAIT_V(2); PG8_BAR;
    PG8_STAGE_B(PG8_SB(1, 0), cB + kstep); PG8_STAGE_A(PG8_SA(1, 0), cof[0], kstep); PG8_STAGE_B(PG8_SB(1, 1), cB + hstep + kstep);
    PG8_WAIT_V(6); PG8_BAR;
    for (;;) {
        const bool has_next = S.next(ui + 1, nxt);
        if (!has_next) nxt = cur;
        const char* nB = (const char*)g.Bt + (size_t)nxt.brow * K * 2;
        for (int t = 0; t < nt; t += 2) {
            const bool last = (t == nt - 2);
            const size_t k1 = (size_t)(t + 1) * kstep;
            const size_t k2 = last ? 0 : (size_t)(t + 2) * kstep, k3 = k2 + kstep;
            const char* b2 = last ? nB : cB + (size_t)(t + 2) * kstep; const char* b3 = b2 + kstep;
            PG8_LDB(B0, 0, 0); PG8_LDB(B1, 0, 1); PG8_SCHED; PG8_LDA(At, 0, 0); PG8_STAGE_A(PG8_SA(1, 1), cof[1], k1);
            if (last) { PG8_AOFFS(nxt, cof); }
            PG8_WAIT_V(8); PG8_WAIT_L(0); PG8_BAR; PG8_MMA(0, 0, At, B0); PG8_MMA(0, 1, At, B1); PG8_BAR; PG8_SCHED;
            PG8_LDA(At, 0, 1); PG8_STAGE_B(PG8_SB(0, 0), b2); PG8_STAGE_B(PG8_SB(0, 1), b2 + hstep); PG8_STAGE_A(PG8_SA(0, 0), cof[0], k2);
            PG8_WAIT_V(8); PG8_WAIT_L(0); PG8_BAR; PG8_MMA(1, 0, At, B0); PG8_MMA(1, 1, At, B1); PG8_BAR; PG8_SCHED;
            PG8_LDB(B0, 1, 0); PG8_LDB(B1, 1, 1); PG8_SCHED; PG8_LDA(At, 1, 0); PG8_STAGE_A(PG8_SA(0, 1), cof[1], k2);
            PG8_WAIT_V(8); PG8_WAIT_L(0); PG8_BAR; PG8_MMA(0, 0, At, B0); PG8_MMA(0, 1, At, B1); PG8_BAR; PG8_SCHED;
            PG8_LDA(At, 1, 1); PG8_STAGE_B(PG8_SB(1, 0), b3); PG8_STAGE_B(PG8_SB(1, 1), b3 + hstep); PG8_STAGE_A(PG8_SA(1, 0), cof[0], k3);
            PG8_WAIT_V(8); PG8_WAIT_L(0); PG8_BAR; PG8_MMA(1, 0, At, B0); PG8_MMA(1, 1, At, B1); PG8_BAR; PG8_SCHED;
        }
        if (wr == 0) PG8_BAR;
        { const int l2 = otid() & 63; E(acc, cur, wr, wc, l2 & 15, l2 >> 4); }
        if (!has_next) break;
#pragma unroll
        for (int a = 0; a < 2; ++a)
#pragma unroll
            for (int b = 0; b < 2; ++b)
#pragma unroll
                for (int m = 0; m < 4; ++m)
#pragma unroll
                    for (int n = 0; n < 2; ++n) acc[a][b][m][n] = (f32x4){0.f, 0.f, 0.f, 0.f};
        cur = nxt; cB = nB; ++ui;
        if (wr == 1) PG8_BAR;
    }
    PG8_WAIT_V(0);
    PG8_BAR;
#undef PG8_SA
#undef PG8_SB
#undef PG8_STAGE_A
#undef PG8_STAGE_B
#undef PG8_LDA
#undef PG8_LDB
#undef PG8_MMA
#undef PG8_WAIT_V
#undef PG8_WAIT_L
#undef PG8_BAR
#undef PG8_SCHED
#undef PG8_AOFFS
}

#define PG8_FENCE asm volatile("" ::: "memory")
#define PG8_FOR_TILE(ai, m, bj) _Pragma("unroll") for (int ai = 0; ai < 2; ++ai) _Pragma("unroll") for (int m = 0; m < 4; ++m) _Pragma("unroll") for (int bj = 0; bj < 2; ++bj)
__device__ __forceinline__ u32x4 pack8(const f32x4& v0, const f32x4& v1) { u32x4 w; w.x = cvt_pk_bf16(v0[0], v0[1]); w.y = cvt_pk_bf16(v0[2], v0[3]); w.z = cvt_pk_bf16(v1[0], v1[1]); w.w = cvt_pk_bf16(v1[2], v1[3]); return w; }
__device__ __forceinline__ float sigm(float x) { return __builtin_amdgcn_rcpf(1.f + __expf(-x)); }
struct EpiInproj {
    static constexpr bool PERM = true;
    unsigned char* ws; bf16_t* gates;
    __device__ __forceinline__ void operator()(const f32x4 (&acc)[2][2][4][2], const Unit& u, int wr, int wc, int fr, int fq) const {
        PG8_FOR_TILE(ai, m, bj) { PG8_FENCE;
            int row = u.pm * BM + ai * HALF + wr * 64 + m * 16 + fr; asm volatile("" : "+v"(row)); const int col = u.pn * BM + bj * HALF + wc * 32 + 8 * fq;
            const f32x4 v0 = acc[ai][bj][m][0], v1 = acc[ai][bj][m][1];
            if (col < C_KV) *(u32x4*)((bf16_t*)(ws + WS_Q) + (size_t)row * AW + col) = pack8(v0, v1);
            else if (col < C_QI) {
                *(u32x4*)((bf16_t*)(ws + WS_KVN) + (size_t)row * KVL + (col - C_KV)) = pack8(v0, v1);
                float ss = (v0[0] * v0[0] + v0[1] * v0[1]) + (v0[2] * v0[2] + v0[3] * v0[3]) + (v1[0] * v1[0] + v1[1] * v1[1]) + (v1[2] * v1[2] + v1[3] * v1[3]);
                ss += __shfl_xor(ss, 16); ss += __shfl_xor(ss, 32);
                if (fq == 0) ((float*)(ws + WS_RSS))[(size_t)row * 8 + bj * 4 + wc] = ss;
            }
            else if (col < C_PS) {
                if (col < 1056) {
                    typedef _Float16 h8 __attribute__((ext_vector_type(8)));
                    h8 hv; hv[0] = (_Float16)v0[0]; hv[1] = (_Float16)v0[1]; hv[2] = (_Float16)v0[2]; hv[3] = (_Float16)v0[3]; hv[4] = (_Float16)v1[0]; hv[5] = (_Float16)v1[1]; hv[6] = (_Float16)v1[2]; hv[7] = (_Float16)v1[3];
                    _Float16* d = (col < 1024) ? (_Float16*)(ws + WS_QI) + (size_t)row * 256 + (col - C_QI) : (_Float16*)(ws + WS_KI) + (size_t)row * 32 + (col - 1024);
                    *(h8*)d = hv;
                } else { const float sc_ = 0.17677669529663687f * 0.35355339059327373f; float* d = (float*)(ws + WS_WI) + (size_t)row * 8; *(f32x4*)d = v0 * sc_; *(f32x4*)(d + 4) = v1 * sc_; }
            }
            else if (col < C_GA) *(u32x4*)((bf16_t*)(ws + WS_PS) + (size_t)row * SHW + (col - C_PS)) = pack8(v0, v1);
            else if (col < INW) {
                f32x4 s0, s1;
#pragma unroll
                for (int e = 0; e < 4; ++e) { s0[e] = sigm(v0[e]); s1[e] = sigm(v1[e]); }
                bf16_t* d = (col < C_GR) ? gates + (size_t)row * DM + (col - C_GA) : gates + (size_t)NT * DM + (size_t)row * DM + (col - C_GR);
                *(u32x4*)d = pack8(s0, s1);
            }
        }
    }
};
struct EpiKV {
    static constexpr bool PERM = true;
    unsigned char* ws;
    __device__ __forceinline__ void operator()(const f32x4 (&acc)[2][2][4][2], const Unit& u, int wr, int wc, int fr, int fq) const {
        PG8_FOR_TILE(ai, m, bj) { PG8_FENCE;
            int row = u.pm * BM + ai * HALF + wr * 64 + m * 16 + fr; asm volatile("" : "+v"(row)); const int col = u.pn * BM + bj * HALF + wc * 32 + 8 * fq;
            const f32x4 ra = *(const f32x4*)((const float*)(ws + WS_RSS) + (size_t)row * 8), rb = *(const f32x4*)((const float*)(ws + WS_RSS) + (size_t)row * 8 + 4);
            const float rstd = rsqrtf((((ra[0] + ra[1]) + (ra[2] + ra[3])) + ((rb[0] + rb[1]) + (rb[2] + rb[3]))) * (1.f / KVL) + NORM_EPS);
            if (col < AW) *(u32x4*)((bf16_t*)(ws + WS_K) + (size_t)row * AW + col) = pack8(acc[ai][bj][m][0] * rstd, acc[ai][bj][m][1] * rstd);
            else {
                bf16_t* d = (bf16_t*)(ws + WS_V) + ((size_t)(row / SEQ) * 512 + (col - AW)) * SEQ + (row % SEQ);
#pragma unroll
                for (int e = 0; e < 4; ++e) { d[(size_t)e * SEQ] = f2bf(acc[ai][bj][m][0][e] * rstd); d[(size_t)(4 + e) * SEQ] = f2bf(acc[ai][bj][m][1][e] * rstd); }
            }
        }
    }
};
struct EpiMerge {
    static constexpr bool PERM = true;
    bf16_t* merged; const bf16_t* gates;
    __device__ __forceinline__ void operator()(const f32x4 (&acc)[2][2][4][2], const Unit& u, int wr, int wc, int fr, int fq) const {
        const bf16_t* gate = gates + (size_t)u.aux * NT * DM;
        PG8_FOR_TILE(ai, m, bj) { PG8_FENCE;
            int row = u.pm * BM + ai * HALF + wr * 64 + m * 16 + fr; asm volatile("" : "+v"(row)); const int col = u.pn * BM + bj * HALF + wc * 32 + 8 * fq;
            const u32x4 gw = *(const u32x4*)(gate + (size_t)row * DM + col);
            f32x4 v0 = acc[ai][bj][m][0], v1 = acc[ai][bj][m][1];
            v0[0] *= __uint_as_float(gw.x << 16); v0[1] *= __uint_as_float(gw.x & 0xffff0000u); v0[2] *= __uint_as_float(gw.y << 16); v0[3] *= __uint_as_float(gw.y & 0xffff0000u);
            v1[0] *= __uint_as_float(gw.z << 16); v1[1] *= __uint_as_float(gw.z & 0xffff0000u); v1[2] *= __uint_as_float(gw.w << 16); v1[3] *= __uint_as_float(gw.w & 0xffff0000u);
            u32x4* d = (u32x4*)(merged + (size_t)row * DM + col);
            if (u.aux) { const u32x4 pw = *d;
                v0[0] += __uint_as_float(pw.x << 16); v0[1] += __uint_as_float(pw.x & 0xffff0000u); v0[2] += __uint_as_float(pw.y << 16); v0[3] += __uint_as_float(pw.y & 0xffff0000u);
                v1[0] += __uint_as_float(pw.z << 16); v1[1] += __uint_as_float(pw.z & 0xffff0000u); v1[2] += __uint_as_float(pw.w << 16); v1[3] += __uint_as_float(pw.w & 0xffff0000u); }
            *d = pack8(v0, v1);
        }
    }
};
struct EpiOut {
    static constexpr bool PERM = false;
    const float* x; const float* mod; float* out;
    __device__ __forceinline__ void operator()(const f32x4 (&acc)[2][2][4][2], const Unit& u, int wr, int wc, int fr, int fq) const {
        PG8_FOR_TILE(ai, m, bj) { PG8_FENCE;
            int row = u.pm * BM + ai * HALF + wr * 64 + m * 16 + fr; asm volatile("" : "+v"(row)); const float* gt = mod + (row / SEQ) * 6 * DM + 2 * DM;
#pragma unroll
            for (int n = 0; n < 2; ++n) { const int col = u.pn * BM + bj * HALF + wc * 32 + 16 * n + 4 * fq;
                const f32x4 xv = *(const f32x4*)(x + (size_t)row * DM + col), gv = *(const f32x4*)(gt + col);
                *(f32x4*)(out + (size_t)row * DM + col) = xv + gv * acc[ai][bj][m][n]; }
        }
    }
};
struct EpiMoe1 {
    static constexpr bool PERM = true;
    bf16_t* hid; const float* lw;
    __device__ __forceinline__ void operator()(const f32x4 (&acc)[2][2][4][2], const Unit& u, int wr, int wc, int fr, int fq) const {
#pragma unroll
        for (int ai = 0; ai < 2; ++ai)
#pragma unroll
            for (int m = 0; m < 4; ++m) {
                const int tr = ai * HALF + wr * 64 + m * 16 + fr; PG8_FENCE;
                if (tr < u.aux) {
                    const float w = lw[u.arow + tr]; f32x4 h0, h1;
#pragma unroll
                    for (int e = 0; e < 4; ++e) { const float g0 = acc[ai][0][m][0][e], g1 = acc[ai][0][m][1][e];
                        h0[e] = w * (g0 * __builtin_amdgcn_rcpf(1.f + __expf(-g0))) * acc[ai][1][m][0][e]; h1[e] = w * (g1 * __builtin_amdgcn_rcpf(1.f + __expf(-g1))) * acc[ai][1][m][1][e]; }
                    *(u32x4*)(hid + (size_t)(u.arow + tr) * DE + u.pn * HALF + wc * 32 + 8 * fq) = pack8(h0, h1);
                }
            }
    }
};
struct EpiMoe2 {
    static constexpr bool PERM = false;
    const int* ltok; const float* mod; float* out;
    __device__ __forceinline__ void operator()(const f32x4 (&acc)[2][2][4][2], const Unit& u, int wr, int wc, int fr, int fq) const {
#pragma unroll
        for (int ai = 0; ai < 2; ++ai)
#pragma unroll
            for (int m = 0; m < 4; ++m) {
                const int tr = ai * HALF + wr * 64 + m * 16 + fr; PG8_FENCE;
                if (tr < u.aux) {
                    const int tok = ltok[u.arow + tr]; const float* gt = mod + (tok / SEQ) * 6 * DM + 5 * DM; float* orow = out + (size_t)tok * DM;
#pragma unroll
                    for (int bj = 0; bj < 2; ++bj)
#pragma unroll
                        for (int n = 0; n < 2; ++n) { const int col = u.pn * BM + bj * HALF + wc * 32 + 16 * n + 4 * fq;
                            const f32x4 gv = *(const f32x4*)(gt + col); f32x4* d = (f32x4*)(orow + col); *d = *d + gv * acc[ai][bj][m][n]; }
                }
            }
    }
};
}

__device__ __forceinline__ unsigned pk2(float lo, float hi) { return pk_bf16(lo, hi); }
__device__ __forceinline__ void transpose_item(const float* W, int K, int N, bf16_t* WT, size_t drow0, int k0, int n0, float* scr, int lane, int Ksrc = 1 << 30, const float* kscale = nullptr) {
#pragma unroll 8
    for (int i = 0; i < 32; ++i) { const int kk = 2 * i + (lane >> 5), n = n0 + (lane & 31); float v_ = (n < N && k0 + kk < Ksrc) ? W[(size_t)(k0 + kk) * N + n] : 0.f; if (kscale) v_ *= kscale[k0 + kk]; scr[kk * 33 + (lane & 31)] = v_; }
    asm volatile("s_waitcnt lgkmcnt(0)" ::: "memory");
    const int c = lane & 7;
#pragma unroll
    for (int j = 0; j < 4; ++j) { const int n = (lane >> 3) + 8 * j; const float* s_ = scr + (8 * c) * 33 + n;
        uint4 o; o.x = pk2(s_[0 * 33], s_[1 * 33]); o.y = pk2(s_[2 * 33], s_[3 * 33]); o.z = pk2(s_[4 * 33], s_[5 * 33]); o.w = pk2(s_[6 * 33], s_[7 * 33]);
        *(uint4*)(WT + (drow0 + n) * K + k0 + 8 * c) = o; }
    asm volatile("s_waitcnt lgkmcnt(0)" ::: "memory");
}
__device__ __forceinline__ void transpose_item64(const float* W, int K, int N, bf16_t* WT, size_t drow0, int k0, int n0, float* scr, int lane, const float* kscale = nullptr) {
    const int r_ = lane >> 4, c4 = (lane & 15) * 4, n = n0 + c4;
    float4 v[16];
#pragma unroll
    for (int i = 0; i < 16; ++i) { v[i] = make_float4(0.f, 0.f, 0.f, 0.f); if (n < N) v[i] = *(const float4*)(W + (size_t)(k0 + r_ + 4 * i) * N + n); }
#pragma unroll
    for (int i = 0; i < 16; ++i) { const int kk = r_ + 4 * i; float4 x = v[i]; if (kscale) { const float s_ = kscale[k0 + kk]; x.x *= s_; x.y *= s_; x.z *= s_; x.w *= s_; }
        float* d_ = scr + kk * 65 + c4; d_[0] = x.x; d_[1] = x.y; d_[2] = x.z; d_[3] = x.w; }
    asm volatile("s_waitcnt lgkmcnt(0)" ::: "memory");
    const int c = lane & 7;
#pragma unroll
    for (int j = 0; j < 8; ++j) { const int nn = (lane >> 3) + 8 * j; const float* s_ = scr + (8 * c) * 65 + nn;
        uint4 o; o.x = pk2(s_[0 * 65], s_[1 * 65]); o.y = pk2(s_[2 * 65], s_[3 * 65]); o.z = pk2(s_[4 * 65], s_[5 * 65]); o.w = pk2(s_[6 * 65], s_[7 * 65]);
        *(uint4*)(WT + (drow0 + nn) * K + k0 + 8 * c) = o; }
    asm volatile("s_waitcnt lgkmcnt(0)" ::: "memory");
}
__device__ void ph_convert_mixer_weights(const P& p, float* lds) {
    const int lane = otid() & 63, wv = otid() >> 6;
    float* scr = lds + wv * (64 * 65);
    const int gw = blockIdx.x * (NTHR / 64) + wv, nw = gridDim.x * (NTHR / 64);
    struct M { const float* W; int K, N, Npad; size_t dst; const float* ks; };
    const M ms[5] = { {p.in[5], DM, INW, 5120, WS_WIN, nullptr}, {p.in[7], KVL, 2 * AW, 2 * AW, WS_WKV, p.in[6]}, {p.in[21], AW, DM, DM, WS_WBA, nullptr}, {p.in[22], RW, DM, DM, WS_WBR, nullptr}, {p.in[23], DM, DM, DM, WS_WOUT, nullptr} };
    int base = 0;
#pragma unroll
    for (int q = 0; q < 5; ++q) {
        const int nkb = ms[q].K / 64, nnb = ms[q].Npad / 64, nitems = nkb * nnb;
        for (int it = gw; it < base + nitems; it += nw) { if (it < base) continue; const int r = it - base; const int kb = r / nnb, nb = r % nnb;
            transpose_item64(ms[q].W, ms[q].K, ms[q].N, (bf16_t*)(p.ws + ms[q].dst), (size_t)nb * 64, kb * 64, nb * 64, scr, lane, ms[q].ks); }
        base += nitems;
    }
}
__device__ void ph_convert_lora_weights(const P& p, float* lds) {
    const int lane = otid() & 63, wv = otid() >> 6;
    float* scr = lds + wv * (64 * 33);
    const int gw = blockIdx.x * (NTHR / 64) + wv, nw = gridDim.x * (NTHR / 64);
    for (int it = gw; it < 16 + 16 + 48; it += nw) {
        if (it < 16) transpose_item(p.in[12], 64, RW, (bf16_t*)(p.ws + WS_LW2T), (size_t)it * 32, 0, it * 32, scr, lane);
        else if (it < 32) transpose_item(p.in[14], 64, RW, (bf16_t*)(p.ws + WS_LA2T), (size_t)(it - 16) * 32, 0, (it - 16) * 32, scr, lane);
        else { const int r = it - 32, kb = r >> 4, nb = r & 15; transpose_item(p.in[15], 192, RW, (bf16_t*)(p.ws + WS_LG2T), (size_t)nb * 32, kb * 64, nb * 32, scr, lane, 160); }
    }
}
__device__ void ph_convert_expert_weights(const P& p, float* lds) {
    const int lane = otid() & 63, wv = otid() >> 6;
    float* scr = lds + wv * (64 * 65);
    const int gw = blockIdx.x * (NTHR / 64) + wv, nw = gridDim.x * (NTHR / 64);
    for (int it = gw; it < NE * 2 * 128; it += nw) { const int e = it >> 8, which = (it >> 7) & 1, r = it & 127, kb = r >> 3, nb = r & 7, n0 = nb * 64;
        transpose_item64(p.in[28 + which] + (size_t)e * DM * DE, DM, DE, (bf16_t*)(p.ws + WS_WGU), (size_t)e * 1024 + (n0 >> 7) * 256 + which * 128 + (n0 & 127), kb * 64, n0, scr, lane); }
    for (int it = gw; it < NE * 128; it += nw) { const int e = it >> 7, r = it & 127, kb = r >> 4, nb = r & 15;
        transpose_item64(p.in[30] + (size_t)e * DE * DM, DE, DM, (bf16_t*)(p.ws + WS_WDN), (size_t)e * 1024 + nb * 64, kb * 64, nb * 64, scr, lane); }
}

__device__ void ph_headnorm(bf16_t* X, const float* g) {
    const int lane = otid() & 63, wv = otid() >> 6;
    const int gw = blockIdx.x * (NTHR / 64) + wv, nw = gridDim.x * (NTHR / 64);
    for (int m = gw; m < NT; m += nw) {
        uint4 raw = *(const uint4*)(X + (size_t)m * AW + lane * 8);
        float v[8] = {bf2f(raw.x & 0xffff), bf2f(raw.x >> 16), bf2f(raw.y & 0xffff), bf2f(raw.y >> 16), bf2f(raw.z & 0xffff), bf2f(raw.z >> 16), bf2f(raw.w & 0xffff), bf2f(raw.w >> 16)};
        float ss = 0.f;
#pragma unroll
        for (int i = 0; i < 8; ++i) ss += v[i] * v[i];
        ss += __shfl_xor(ss, 1); ss += __shfl_xor(ss, 2); ss += __shfl_xor(ss, 4);
        const float rstd = rsqrtf(ss * (1.f / 64.f) + NORM_EPS);
        const int d0 = (lane & 7) * 8;
        unsigned o[4];
#pragma unroll
        for (int i = 0; i < 4; ++i) o[i] = (unsigned)f2bf(v[2 * i] * rstd * g[d0 + 2 * i]) | ((unsigned)f2bf(v[2 * i + 1] * rstd * g[d0 + 2 * i + 1]) << 16);
        *(uint4*)(X + (size_t)m * AW + lane * 8) = make_uint4(o[0], o[1], o[2], o[3]);
    }
}
__device__ void ph_kvnorm(bf16_t* X, const float* g) {
    const int lane = otid() & 63, wv = otid() >> 6;
    const int gw = blockIdx.x * (NTHR / 64) + wv, nw = gridDim.x * (NTHR / 64);
    for (int m = gw; m < NT; m += nw) {
        uint2 raw = *(const uint2*)(X + (size_t)m * KVL + lane * 4);
        float v[4] = {bf2f(raw.x & 0xffff), bf2f(raw.x >> 16), bf2f(raw.y & 0xffff), bf2f(raw.y >> 16)};
        float ss = wave_sum(v[0] * v[0] + v[1] * v[1] + v[2] * v[2] + v[3] * v[3]);
        const float rstd = rsqrtf(ss * (1.f / 256.f) + NORM_EPS);
        uint2 o; o.x = (unsigned)f2bf(v[0] * rstd * g[lane * 4]) | ((unsigned)f2bf(v[1] * rstd * g[lane * 4 + 1]) << 16);
        o.y = (unsigned)f2bf(v[2] * rstd * g[lane * 4 + 2]) | ((unsigned)f2bf(v[3] * rstd * g[lane * 4 + 3]) << 16);
        *(uint2*)(X + (size_t)m * KVL + lane * 4) = o;
    }
}

typedef _Float16 half8_t __attribute__((ext_vector_type(8)));
typedef float f32x16_t __attribute__((ext_vector_type(16)));
__device__ __forceinline__ unsigned f2key(float f) { const unsigned u = __float_as_uint(f); return u ^ ((unsigned)((int)u >> 31) | 0x80000000u); }
template <bool PASS1, bool FULL>
__device__ __forceinline__ void d1_unit(const half8_t& a0, const half8_t& a1, const half8_t& b0, const half8_t& b1, const float (&w)[4][4], int rg, int hh, int r32, int tile, int t0,
                                        unsigned* hist, unsigned* maskl, int* misc, uint2* cand, int tbA, int tbB) {
    constexpr int CCAP = 1024;
    f32x16_t c;
#pragma unroll
    for (int i = 0; i < 16; ++i) c[i] = 0.f;
    c = __builtin_amdgcn_mfma_f32_32x32x16_f16(a0, b0, c, 0, 0, 0);
    c = __builtin_amdgcn_mfma_f32_32x32x16_f16(a1, b1, c, 0, 0, 0);
    float x[4];
#pragma unroll
    for (int tl = 0; tl < 4; ++tl) { x[tl] = 0.f;
#pragma unroll
        for (int e = 0; e < 4; ++e) x[tl] = __builtin_fmaf(w[tl][e], __int_as_float(max(__float_as_int(c[4 * tl + e]), 0)), x[tl]); }
    const unsigned k01 = f2key(x[0] + x[1]);
    const unsigned k23 = f2key(x[2] + x[3]);
    const int rowA = 4 * rg + 2 * hh, rowB = rowA + 1, key = tile * 32 + r32;
    const bool okA = FULL || key <= t0 + rowA, okB = FULL || key <= t0 + rowB;
    if (!PASS1) {
        atomicAdd(&hist[okA ? rowA * 2048 + (int)(k01 >> 21) : 8 * 2048 + 16384 + 2048 + 7], 1u << (16 * ((k01 >> 20) & 1u)));
        atomicAdd(&hist[okB ? rowB * 2048 + (int)(k23 >> 21) : 8 * 2048 + 16384 + 2048 + 7], 1u << (16 * ((k23 >> 20) & 1u)));
    } else {
        const int binA = (int)(k01 >> 20), binB = (int)(k23 >> 20);
        const unsigned long long mA = __ballot(okA && binA > tbA), mB = __ballot(okB && binB > tbB);
        if (r32 == 0) { maskl[rowA * 256 + tile] = hh ? (unsigned)(mA >> 32) : (unsigned)mA; maskl[rowB * 256 + tile] = hh ? (unsigned)(mB >> 32) : (unsigned)mB; }
        if (okA && binA == tbA) { const int pos = atomicAdd(&misc[rowA * 8 + 2], 1); if (pos < CCAP) cand[rowA * CCAP + pos] = make_uint2(k01, (unsigned)key); }
        if (okB && binB == tbB) { const int pos = atomicAdd(&misc[rowB * 8 + 2], 1); if (pos < CCAP) cand[rowB * CCAP + pos] = make_uint2(k23, (unsigned)key); }
    }
}
__device__ void ph_dsa_select(const P& p, float* ldsf) {
    const _Float16* QI = (const _Float16*)(p.ws + WS_QI); const _Float16* KI = (const _Float16*)(p.ws + WS_KI); const float* WI = (const float*)(p.ws + WS_WI);
    unsigned* MASK32 = (unsigned*)(p.ws + WS_MASK);
    unsigned* hist = (unsigned*)ldsf;
    uint2* cand = (uint2*)(hist + 8 * 2048);
    unsigned* maskl = (unsigned*)(cand + 8 * 1024);
    unsigned* h2 = hist;
    int* misc = (int*)(maskl + 8 * 256);
    constexpr int CCAP = 1024;
    const int tid = otid(), lane = tid & 63, wv = tid >> 6, hh = lane >> 5, r32 = lane & 31;
    int* qhead = (int*)(p.ws + WS_CTL) + CT_Q + 16; int* qslot = misc + 64;
    __syncthreads();
    for (int e = tid; e < 8 * 2048 / 4; e += NTHR) ((uint4*)hist)[e] = make_uint4(0u, 0u, 0u, 0u);
    ((uint4*)maskl)[tid] = make_uint4(0u, 0u, 0u, 0u);
    if (tid < 64) misc[tid] = 0;
    if (tid == 0) qslot[0] = atomicAdd(qhead, 1);
#pragma unroll 1
    for (int it = 0;; ++it) {
        __syncthreads();
        const int kq = __builtin_amdgcn_readfirstlane(qslot[it & 1]);
        if (kq >= NT / 8) break;
        const int item = (kq & 1) * (SEQ / 8) + (SEQ / 8 - 1 - (kq >> 1));
        const int tq0 = item * 8, b = tq0 / SEQ, t0 = tq0 % SEQ;
        const int nwords = ((t0 >> 8) + 1) * 8;
        int nxt = 0;
        if (t0 + 7 < TOPK) {
            if (tid == 0) nxt = atomicAdd(qhead, 1);
            for (int e = tid; e < 8 * nwords; e += NTHR) { const int row = e / nwords, w = e % nwords; const int tr_ = t0 + row; const int lo = 32 * w;
                const unsigned bits = (tr_ >= lo + 31) ? 0xffffffffu : ((tr_ < lo) ? 0u : ((2u << (tr_ - lo)) - 1u));
                MASK32[(size_t)(tq0 + row) * 256 + w] = bits; }
            if (tid == 0) qslot[(it & 1) ^ 1] = nxt;
            continue;
        }
        half8_t a0[2], a1[2]; float w[2][4][4];
#pragma unroll
        for (int rg = 0; rg < 2; ++rg) { const int tl_a = ((r32 >> 4) & 1) + 2 * ((r32 >> 2) & 1), h_a = (r32 & 3) + 4 * ((r32 >> 3) & 1);
            const _Float16* qp = QI + (size_t)(tq0 + 4 * rg + tl_a) * 256 + h_a * 32 + 8 * hh;
            a0[rg] = *(const half8_t*)qp; a1[rg] = *(const half8_t*)(qp + 16);
#pragma unroll
            for (int tl = 0; tl < 4; ++tl) { const float4 wv4 = *(const float4*)(WI + (size_t)(tq0 + 4 * rg + 2 * hh + (tl >> 1)) * 8 + 4 * (tl & 1));   w[rg][tl][0] = wv4.x; w[rg][tl][1] = wv4.y; w[rg][tl][2] = wv4.z; w[rg][tl][3] = wv4.w; } }
        const int ntile = (t0 + 7) / 32 + 1;
        half8_t nk0[4], nk1[4];
#define D1_LOAD0 do { _Pragma("unroll") for (int q = 0; q < 4; ++q) { const int tl_ = min(4 * wv + q, ntile - 1); const _Float16* kp = KI + (size_t)(b * SEQ + tl_ * 32 + r32) * 32 + 8 * hh; nk0[q] = *(const half8_t*)kp; nk1[q] = *(const half8_t*)(kp + 16); } } while (0)
        D1_LOAD0;
        int thr_bin[8];
#pragma unroll 1
        for (int pass = 0; pass < 2; ++pass) {
            if (pass == 1) {
#pragma unroll
                for (int r = 0; r < 8; ++r) thr_bin[r] = __builtin_amdgcn_readfirstlane(misc[r * 8]);
            }
            half8_t kb0[4], kb1[4];
            for (int tbase = 4 * wv; tbase < ntile; tbase += 32) {
#pragma unroll
                for (int q = 0; q < 4; ++q) { kb0[q] = nk0[q]; kb1[q] = nk1[q]; }
                if (tbase + 32 < ntile) {
#pragma unroll
                    for (int q = 0; q < 4; ++q) { const int tl_ = min(tbase + 32 + q, ntile - 1); const _Float16* kp = KI + (size_t)(b * SEQ + tl_ * 32 + r32) * 32 + 8 * hh; nk0[q] = *(const half8_t*)kp; nk1[q] = *(const half8_t*)(kp + 16); }
                }
#pragma unroll
                for (int q = 0; q < 4; ++q) {
                const int tile = tbase + q;
                if (tile < ntile) {
                const half8_t b0 = kb0[q], b1 = kb1[q];
                const bool full = tile * 32 + 31 <= t0;
#pragma unroll
                for (int rg = 0; rg < 2; ++rg) {
                    const int tbA = hh ? thr_bin[4 * rg + 2] : thr_bin[4 * rg], tbB = hh ? thr_bin[4 * rg + 3] : thr_bin[4 * rg + 1];
                    if (pass == 0) { if (full) d1_unit<false, true>(a0[rg], a1[rg], b0, b1, w[rg], rg, hh, r32, tile, t0, hist, maskl, misc, cand, 0, 0);
                                     else d1_unit<false, false>(a0[rg], a1[rg], b0, b1, w[rg], rg, hh, r32, tile, t0, hist, maskl, misc, cand, 0, 0); }
                    else { if (full) d1_unit<true, true>(a0[rg], a1[rg], b0, b1, w[rg], rg, hh, r32, tile, t0, hist, maskl, misc, cand, tbA, tbB);
                           else d1_unit<true, false>(a0[rg], a1[rg], b0, b1, w[rg], rg, hh, r32, tile, t0, hist, maskl, misc, cand, tbA, tbB); }
                }
                }
                }
            }
            __syncthreads();
            if (pass == 0) D1_LOAD0;
            if (pass == 0) {
                const unsigned* hrw = hist + wv * 2048; unsigned tot = 0;
                { const uint4* h4 = (const uint4*)(hrw + 32 * lane);
#pragma unroll
                  for (int i = 0; i < 8; ++i) { const uint4 v = h4[i]; tot += (v.x & 0xffffu) + (v.x >> 16) + (v.y & 0xffffu) + (v.y >> 16) + (v.z & 0xffffu) + (v.z >> 16) + (v.w & 0xffffu) + (v.w >> 16); } }
                const unsigned suf = wave_suffix_u32(tot);
                const unsigned above = suf - tot;
                const unsigned long long hit = __ballot((int)above < TOPK && TOPK <= (int)(above + tot));
                const int lsel = __builtin_amdgcn_readfirstlane(__ffsll((long long)hit) - 1); const unsigned above_g = (unsigned)__builtin_amdgcn_readlane((int)above, lsel);
                const unsigned wd = hrw[32 * lsel + (lane >> 1)]; const unsigned cnt = (lane & 1) ? (wd >> 16) : (wd & 0xffffu);
                const unsigned s2 = wave_suffix_u32(cnt);
                const unsigned ab2 = above_g + s2 - cnt;
                if ((int)ab2 < TOPK && TOPK <= (int)(ab2 + cnt)) { misc[wv * 8] = 64 * lsel + lane; misc[wv * 8 + 1] = TOPK - (int)ab2; }
                __syncthreads();
            }
        }
        if (tid == 0) nxt = atomicAdd(qhead, 1);
        {
            const int row = wv, need0 = misc[row * 8 + 1]; const int cn = min(misc[row * 8 + 2], CCAP);
            const uint2* cr = cand + row * CCAP; unsigned* hrow = h2 + row * 256;
            unsigned prefix = 0; int remaining = need0, cnt_eq = cn;
#pragma unroll 1
            for (int pass = 0; pass < 3; ++pass) {
                const int shift = (pass == 0) ? 12 : ((pass == 1) ? 4 : 0), nb = (pass == 2) ? 4 : 8;
                ((uint4*)hrow)[lane] = make_uint4(0u, 0u, 0u, 0u);
                __builtin_amdgcn_wave_barrier(); asm volatile("s_waitcnt lgkmcnt(0)" ::: "memory");
                for (int i = lane; i < cn; i += 64) { const unsigned k = cr[i].x & 0xfffffu; if (pass == 0 || (k >> (shift + nb)) == (prefix >> (shift + nb))) atomicAdd(&hrow[(k >> shift) & ((1u << nb) - 1u)], 1u); }
                __builtin_amdgcn_wave_barrier(); asm volatile("s_waitcnt lgkmcnt(0)" ::: "memory");
                const uint4 hq = ((const uint4*)hrow)[lane]; const unsigned h0 = hq.x, h1 = hq.y, h2_ = hq.z, h3 = hq.w;
                const unsigned suf = wave_suffix_u32(h0 + h1 + h2_ + h3);
                const unsigned above3 = suf - (h0 + h1 + h2_ + h3);
                const unsigned ab[4] = {above3 + h3 + h2_ + h1, above3 + h3 + h2_, above3 + h3, above3}; const unsigned hv[4] = {h0, h1, h2_, h3};
                int selbin = -1, newrem = 0, neweq = 0;
#pragma unroll
                for (int q = 0; q < 4; ++q) if ((int)ab[q] < remaining && remaining <= (int)(ab[q] + hv[q])) { selbin = 4 * lane + q; newrem = remaining - (int)ab[q]; neweq = (int)hv[q]; }
                const unsigned long long has = __ballot(selbin >= 0); const int src = __ffsll((long long)has) - 1;
                { const int srcu = __builtin_amdgcn_readfirstlane(src); selbin = __builtin_amdgcn_readlane(selbin, srcu); newrem = __builtin_amdgcn_readlane(newrem, srcu); neweq = __builtin_amdgcn_readlane(neweq, srcu); }
                prefix |= ((unsigned)selbin) << shift; remaining = newrem; cnt_eq = neweq;
                if (cnt_eq == remaining) break;
            }
            for (int i0 = 0; i0 < cn; i0 += 64) { const int i = i0 + lane; bool sel = false;
                if (i < cn) { const uint2 ce = cr[i]; const unsigned k = ce.x & 0xfffffu;
                    if (k > prefix) sel = true;
                    else if (k == prefix) { if (cnt_eq == remaining) sel = true; else { int rank = 0; for (int j = 0; j < cn; ++j) { const uint2 cj = cr[j]; rank += ((cj.x & 0xfffffu) == prefix && cj.y < ce.y) ? 1 : 0; } sel = rank < remaining; } }
                    if (sel) atomicOr(&maskl[row * 256 + (ce.y >> 5)], 1u << (ce.y & 31)); } }
            __builtin_amdgcn_wave_barrier(); asm volatile("s_waitcnt lgkmcnt(0)" ::: "memory");
            { const int l2 = otid() & 63;
              if (4 * l2 < nwords) *(uint4*)(MASK32 + (size_t)(tq0 + row) * 256 + 4 * l2) = *(const uint4*)(maskl + row * 256 + 4 * l2); }
            { const uint4 z4 = make_uint4(0u, 0u, 0u, 0u);
              if (row > 0) {
#pragma unroll
                  for (int i = 0; i < 8; ++i) ((uint4*)(hist + row * 2048))[lane + 64 * i] = z4; }
              ((uint4*)(h2 + row * 256))[lane] = z4; ((uint4*)(maskl + row * 256))[lane] = z4;
              if (lane < 8) misc[row * 8 + lane] = 0; }
        }
        if (tid == 0) qslot[(it & 1) ^ 1] = nxt;
    }
}

#undef D1_LOAD0
__device__ void knorm_tile(const P& p, int pm, int pn) {
    bf16_t* Kg = (bf16_t*)(p.ws + WS_K); const float* kg = p.in[9];
    const int tid = otid();
    for (int pr = tid; pr < 1024; pr += NTHR) {
        const int row = pm * 256 + (pr >> 2), head = pn * 4 + (pr & 3);
        uint4* ptr = (uint4*)(Kg + (size_t)row * AW + head * 64);
        uint4 v[8]; float ss = 0.f;
#pragma unroll
        for (int c = 0; c < 8; ++c) { v[c] = ptr[c]; const unsigned w[4] = {v[c].x, v[c].y, v[c].z, v[c].w};
#pragma unroll
            for (int e = 0; e < 4; ++e) { const float a = __uint_as_float(w[e] << 16), b2 = __uint_as_float(w[e] & 0xffff0000u); ss += a * a + b2 * b2; } }
        const float rstd = rsqrtf(ss * (1.f / 64.f) + NORM_EPS);
#pragma unroll
        for (int c = 0; c < 8; ++c) { const unsigned w[4] = {v[c].x, v[c].y, v[c].z, v[c].w}; unsigned o[4];
            const float4 g0 = *(const float4*)(kg + 8 * c), g1 = *(const float4*)(kg + 8 * c + 4); const float gv[8] = {g0.x, g0.y, g0.z, g0.w, g1.x, g1.y, g1.z, g1.w};
#pragma unroll
            for (int e = 0; e < 4; ++e) o[e] = pk2(__uint_as_float(w[e] << 16) * rstd * gv[2 * e], __uint_as_float(w[e] & 0xffff0000u) * rstd * gv[2 * e + 1]);
            ptr[c] = make_uint4(o[0], o[1], o[2], o[3]); }
    }
}
constexpr int D2_NQ = 104;
__device__ const int D2_QN[8] = {40, 40, 40, 40, 104, 104, 104, 104};
__device__ const unsigned short D2_Q[8][D2_NQ] = {{999, 967, 935, 903, 871, 839, 807, 775, 1511, 231, 1479, 199, 485, 453, 421, 389, 357, 325, 293, 261, 229, 197, 165, 1447, 167, 133, 1415, 135, 101, 1383, 103, 69, 1351, 71, 37, 1319, 39, 5, 1287, 7, 0, 0, 0, 0, 0, 0, 0, 0, 0, 0, 0, 0, 0, 0, 0, 0, 0, 0, 0, 0, 0, 0, 0, 0, 0, 0, 0, 0, 0, 0, 0, 0, 0, 0, 0, 0, 0, 0, 0, 0, 0, 0, 0, 0, 0, 0, 0, 0, 0, 0, 0, 0, 0, 0, 0, 0, 0, 0, 0, 0, 0, 0, 0, 0},
    {1015, 1527, 983, 951, 919, 887, 855, 823, 791, 247, 1495, 215, 1463, 183, 501, 469, 437, 405, 373, 341, 309, 277, 245, 213, 181, 149, 1431, 151, 117, 1399, 119, 85, 1367, 87, 53, 1335, 55, 21, 1303, 23, 0, 0, 0, 0, 0, 0, 0, 0, 0, 0, 0, 0, 0, 0, 0, 0, 0, 0, 0, 0, 0, 0, 0, 0, 0, 0, 0, 0, 0, 0, 0, 0, 0, 0, 0, 0, 0, 0, 0, 0, 0, 0, 0, 0, 0, 0, 0, 0, 0, 0, 0, 0, 0, 0, 0, 0, 0, 0, 0, 0, 0, 0, 0, 0},
    {1007, 975, 943, 911, 879, 847, 815, 783, 1519, 239, 1487, 207, 493, 461, 429, 397, 365, 333, 301, 269, 237, 205, 173, 1455, 175, 141, 1423, 143, 109, 1391, 111, 77, 1359, 79, 45, 1327, 47, 13, 1295, 15, 0, 0, 0, 0, 0, 0, 0, 0, 0, 0, 0, 0, 0, 0, 0, 0, 0, 0, 0, 0, 0, 0, 0, 0, 0, 0, 0, 0, 0, 0, 0, 0, 0, 0, 0, 0, 0, 0, 0, 0, 0, 0, 0, 0, 0, 0, 0, 0, 0, 0, 0, 0, 0, 0, 0, 0, 0, 0, 0, 0, 0, 0, 0, 0},
    {1023, 1535, 991, 959, 927, 895, 863, 831, 799, 255, 1503, 223, 1471, 191, 509, 477, 445, 413, 381, 349, 317, 285, 253, 221, 189, 157, 1439, 159, 125, 1407, 127, 93, 1375, 95, 61, 1343, 63, 29, 1311, 31, 0, 0, 0, 0, 0, 0, 0, 0, 0, 0, 0, 0, 0, 0, 0, 0, 0, 0, 0, 0, 0, 0, 0, 0, 0, 0, 0, 0, 0, 0, 0, 0, 0, 0, 0, 0, 0, 0, 0, 0, 0, 0, 0, 0, 0, 0, 0, 0, 0, 0, 0, 0, 0, 0, 0, 0, 0, 0, 0, 0, 0, 0, 0, 0},
    {998, 966, 934, 902, 870, 838, 806, 774, 1510, 230, 1478, 198, 1446, 166, 1414, 134, 1382, 102, 484, 452, 420, 388, 356, 324, 292, 260, 228, 196, 164, 132, 100, 68, 1350, 70, 483, 451, 419, 387, 355, 323, 291, 259, 227, 195, 163, 131, 99, 67, 35, 36, 1318, 38, 482, 450, 418, 386, 354, 322, 290, 258, 226, 194, 162, 130, 98, 66, 34, 2, 3, 4, 1286, 6, 481, 449, 417, 385, 353, 321, 289, 257, 225, 193, 161, 129, 97, 65, 33, 1, 480, 448, 416, 384, 352, 320, 288, 256, 224, 192, 160, 128, 96, 64, 32, 0},
    {1014, 1526, 982, 950, 918, 886, 854, 822, 790, 246, 1494, 214, 1462, 182, 1430, 150, 1398, 118, 1366, 86, 500, 468, 436, 404, 372, 340, 308, 276, 244, 212, 180, 148, 116, 84, 52, 1334, 54, 499, 467, 435, 403, 371, 339, 307, 275, 243, 211, 179, 147, 115, 83, 51, 19, 20, 1302, 22, 498, 466, 434, 402, 370, 338, 306, 274, 242, 210, 178, 146, 114, 82, 50, 18, 497, 465, 433, 401, 369, 337, 305, 273, 241, 209, 177, 145, 113, 81, 49, 17, 496, 464, 432, 400, 368, 336, 304, 272, 240, 208, 176, 144, 112, 80, 48, 16},
    {1006, 974, 942, 910, 878, 846, 814, 782, 1518, 238, 1486, 206, 1454, 174, 1422, 142, 1390, 110, 492, 460, 428, 396, 364, 332, 300, 268, 236, 204, 172, 140, 108, 76, 1358, 78, 491, 459, 427, 395, 363, 331, 299, 267, 235, 203, 171, 139, 107, 75, 43, 44, 1326, 46, 490, 458, 426, 394, 362, 330, 298, 266, 234, 202, 170, 138, 106, 74, 42, 10, 11, 12, 1294, 14, 489, 457, 425, 393, 361, 329, 297, 265, 233, 201, 169, 137, 105, 73, 41, 9, 488, 456, 424, 392, 360, 328, 296, 264, 232, 200, 168, 136, 104, 72, 40, 8},
    {1022, 1534, 990, 958, 926, 894, 862, 830, 798, 254, 1502, 222, 1470, 190, 1438, 158, 1406, 126, 1374, 94, 508, 476, 444, 412, 380, 348, 316, 284, 252, 220, 188, 156, 124, 92, 60, 1342, 62, 507, 475, 443, 411, 379, 347, 315, 283, 251, 219, 187, 155, 123, 91, 59, 27, 28, 1310, 30, 506, 474, 442, 410, 378, 346, 314, 282, 250, 218, 186, 154, 122, 90, 58, 26, 505, 473, 441, 409, 377, 345, 313, 281, 249, 217, 185, 153, 121, 89, 57, 25, 504, 472, 440, 408, 376, 344, 312, 280, 248, 216, 184, 152, 120, 88, 56, 24}};
typedef unsigned u32x4_t __attribute__((ext_vector_type(4)));
__device__ __forceinline__ bf16x8_t pack_step16(const f32x16_t& x, int s2) {
    u32x4_t pk;
    if (s2 == 0) { pk[0] = pk_bf16(x[0], x[1]); pk[1] = pk_bf16(x[2], x[3]); pk[2] = pk_bf16(x[4], x[5]); pk[3] = pk_bf16(x[6], x[7]); }
    else { pk[0] = pk_bf16(x[8], x[9]); pk[1] = pk_bf16(x[10], x[11]); pk[2] = pk_bf16(x[12], x[13]); pk[3] = pk_bf16(x[14], x[15]); }
    return __builtin_bit_cast(bf16x8_t, pk);
}
__device__ __forceinline__ float xhalf_max(float x) { const auto t = __builtin_amdgcn_permlane32_swap(__float_as_uint(x), __float_as_uint(x), false, false); return fmaxf(__uint_as_float(t[0]), __uint_as_float(t[1])); }
__device__ __forceinline__ float xhalf_sum(float x) { const auto t = __builtin_amdgcn_permlane32_swap(__float_as_uint(x), __float_as_uint(x), false, false); return __uint_as_float(t[0]) + __uint_as_float(t[1]); }
__device__ __forceinline__ short bf16_of_int(int v) { return (short)(__float_as_uint((float)v) >> 16); }
#define MFMA32(a, b, c) __builtin_amdgcn_mfma_f32_32x32x16_bf16((a), (b), (c), 0, 0, 0)
__device__ void ph_dsa_attn(const P& p, float* ldsf) {
    const unsigned long long* MASK = (const unsigned long long*)(p.ws + WS_MASK);
    const bf16_t* Q = (const bf16_t*)(p.ws + WS_Q); const bf16_t* Kg = (const bf16_t*)(p.ws + WS_K); const bf16_t* VT = (const bf16_t*)(p.ws + WS_V);
    bf16_t* O = (bf16_t*)(p.ws + WS_OATT);
    bf16_t* L = (bf16_t*)ldsf;
    const int tid = otid(), lane = tid & 63, wv = tid >> 6, hh = lane >> 5, r32 = lane & 31;
    const float CS = 0.125f * 1.4426950408889634f;
    const float NEG = -1e30f;
    const int skey = tid >> 3, sch = (tid & 7) * 8;
    const float* qg = p.in[8];
    float kgmax; { const float v = fabsf(p.in[9][lane]); kgmax = wave_max(v); }
    int* qhead = (int*)(p.ws + WS_CTL) + CT_Q; int* bcast = (int*)(L + 4 * SLOT); int* sflag = bcast + 4;
    for (int tr_ = 0; tr_ < 8; ++tr_) {
        const int grp = (blockIdx.x + tr_) & 7;
        int nxt = -1;
        for (;;) {
            __syncthreads();
            if (tid == 0) *bcast = nxt >= 0 ? nxt : atomicAdd(qhead + grp, 1);
            __syncthreads();
            const int kq = *bcast;
            if (kq >= D2_QN[grp]) break;
            const int e_ = D2_Q[grp][kq], bh = e_ & 15, qb = (e_ >> 4) & 31, part = e_ >> 9;
            const int b = bh >> 3, h = bh & 7;
            const bf16_t* Kbase = Kg + (size_t)b * SEQ * AW + h * 64; const bf16_t* Vbase = VT + (size_t)bh * 64 * SEQ;
            {
            const int q0 = qb * 256 + wv * 32, q = q0 + r32, ntile = 4 * (qb + 1);
            const int kt_hi = (part == 2) ? ntile - 65 : ntile - 1, kt_lo = (part == 1) ? ntile - 64 : 0;
            const size_t qrow = (size_t)b * SEQ + q;
            bf16x8_t bq[5]; float qk_bound;
#pragma unroll
            for (int s2 = 0; s2 < 4; ++s2) bq[s2] = *(const bf16x8_t*)(Q + qrow * AW + h * 64 + 16 * s2 + 8 * hh);
            const uint4 kr0 = *(const uint4*)(Kbase + (size_t)(kt_hi * 64 + skey) * AW + sch), vr0 = *(const uint4*)(Vbase + (size_t)skey * SEQ + kt_hi * 64 + sch);
            unsigned long long mw = MASK[qrow * 128 + kt_hi];
            {
                float ss = 0.f;
#pragma unroll
                for (int s2 = 0; s2 < 4; ++s2)
#pragma unroll
                    for (int j = 0; j < 8; ++j) { const float v = bf2f((bf16_t)bq[s2][j]); ss += v * v; }
                ss = xhalf_sum(ss);
                const float rstd = rsqrtf(ss * (1.f / 64.f) + NORM_EPS);
                float qq = 0.f;
#pragma unroll
                for (int s2 = 0; s2 < 4; ++s2) { const float4 g0 = *(const float4*)(qg + 16 * s2 + 8 * hh), g1 = *(const float4*)(qg + 16 * s2 + 8 * hh + 4); const float gv[8] = {g0.x, g0.y, g0.z, g0.w, g1.x, g1.y, g1.z, g1.w};
                    u32x4_t w;
#pragma unroll
                    for (int j2 = 0; j2 < 4; ++j2) { const float e0 = bf2f((bf16_t)bq[s2][2 * j2]) * rstd * gv[2 * j2], e1 = bf2f((bf16_t)bq[s2][2 * j2 + 1]) * rstd * gv[2 * j2 + 1]; qq += e0 * e0 + e1 * e1; w[j2] = pk_bf16(e0, e1); }
                    bq[s2] = __builtin_bit_cast(bf16x8_t, w); }
                qk_bound = sqrtf(xhalf_sum(qq)) * kgmax * 1.03f;
            }
#pragma unroll
            for (int j = 0; j < 8; ++j) bq[4][j] = 0;
            if (hh == 0) { bq[4][0] = bf16_of_int(256 >> h); bq[4][1] = (short)(__float_as_uint(4.f / (float)(1 << h)) >> 16); }
            f32x16_t o0, o1;
#pragma unroll
            for (int i = 0; i < 16; ++i) { o0[i] = 0.f; o1[i] = 0.f; }
            float m_run = NEG, l_run = 0.f;
            const float slope_l2 = 1.4426950408889634f / (float)(2 << h);
            { const int kt0 = kt_hi; *(uint4*)(L + (kt0 & 1) * SLOT + skey * LP + sch) = kr0; *(uint4*)(L + (2 + (kt0 & 1)) * SLOT + skey * LP + sch) = vr0; }
            if (tid < 16) sflag[tid] = 0;
            __syncthreads();
#pragma unroll 1
            for (int kt = kt_hi; kt >= kt_lo; --kt) {
                const int buf = kt & 1; const bool more = kt > kt_lo;
                if (kt < kt_hi) { int alld = 1;
#pragma unroll
                    for (int w2 = 0; w2 < 8; ++w2) alld &= sflag[((kt + 1) & 1) * 8 + w2];
                    if (alld) break; }
                uint4 kr = make_uint4(0, 0, 0, 0), vr = make_uint4(0, 0, 0, 0); unsigned long long mwn = 0ull;
                if (more) { kr = *(const uint4*)(Kbase + (size_t)((kt - 1) * 64 + skey) * AW + sch); vr = *(const uint4*)(Vbase + (size_t)skey * SEQ + (kt - 1) * 64 + sch); mwn = MASK[qrow * 128 + kt - 1]; }
                if (kt * 64 <= q0 + 31) {
                    const bf16_t* Kl = L + buf * SLOT; const bf16_t* Vl = L + (2 + buf) * SLOT;
                    f32x16_t p0, p1;
#pragma unroll
                    for (int i = 0; i < 16; ++i) { p0[i] = 0.f; p1[i] = 0.f; }
                    {
                        bf16x8_t ka0 = *(const bf16x8_t*)(Kl + r32 * LP + 8 * hh), ka1 = *(const bf16x8_t*)(Kl + (32 + r32) * LP + 8 * hh);
#pragma unroll
                        for (int s2 = 0; s2 < 4; ++s2) {
                            bf16x8_t n0 = ka0, n1 = ka1;
                            if (s2 < 3) { n0 = *(const bf16x8_t*)(Kl + r32 * LP + 16 * (s2 + 1) + 8 * hh); n1 = *(const bf16x8_t*)(Kl + (32 + r32) * LP + 16 * (s2 + 1) + 8 * hh); }
                            p0 = MFMA32(ka0, bq[s2], p0); p1 = MFMA32(ka1, bq[s2], p1);
                            __builtin_amdgcn_sched_barrier(0);
                            ka0 = n0; ka1 = n1;
                        }
                    }
                    { bf16x8_t g0, g1;
#pragma unroll
                      for (int j = 0; j < 8; ++j) { g0[j] = 0; g1[j] = 0; }
                      if (hh == 0) { g0[0] = bf16_of_int(kt); g0[1] = bf16_of_int(r32); g1[0] = g0[0]; g1[1] = bf16_of_int(32 + r32); }
                      p0 = MFMA32(g0, bq[4], p0); p1 = MFMA32(g1, bq[4], p1); }
                    const unsigned wl = (unsigned)mw >> (4 * hh), wh = (unsigned)(mw >> 32) >> (4 * hh);
                    float mx = NEG;
#pragma unroll
                    for (int i = 0; i < 16; ++i) { const int bp = (i & 3) + 8 * (i >> 2);
                        const int m0 = __builtin_amdgcn_sbfe((int)wl, bp, 1), m1 = __builtin_amdgcn_sbfe((int)wh, bp, 1);
                        const float a_ = __uint_as_float((__float_as_uint(p0[i]) & (unsigned)m0) | (__float_as_uint(NEG) & ~(unsigned)m0));
                        const float b_ = __uint_as_float((__float_as_uint(p1[i]) & (unsigned)m1) | (__float_as_uint(NEG) & ~(unsigned)m1));
                        p0[i] = a_; p1[i] = b_;
                        mx = __builtin_fmaxf(mx, __builtin_fmaxf(a_, b_)); }
                    mx = xhalf_max(mx);
                    const float m_new = fmaxf(m_run, mx);
                    const float alpha = __builtin_amdgcn_exp2f((m_run - m_new) * CS);
                    m_run = m_new;
                    const float mc = fmaxf(m_new, -1e20f) * CS;
                    float rs = 0.f;
#pragma unroll
                    for (int i = 0; i < 16; ++i) { p0[i] = __builtin_amdgcn_exp2f(p0[i] * CS - mc); p1[i] = __builtin_amdgcn_exp2f(p1[i] * CS - mc); rs += p0[i] + p1[i]; }
                    l_run = l_run * alpha + rs;
                    if (__any(alpha != 1.f)) {
#pragma unroll
                        for (int i = 0; i < 16; ++i) { o0[i] *= alpha; o1[i] *= alpha; } }
                    bf16x8_t pb[4];
                    pb[0] = pack_step16(p0, 0); pb[1] = pack_step16(p0, 1); pb[2] = pack_step16(p1, 0); pb[3] = pack_step16(p1, 1);
#pragma unroll
                    for (int ks = 0; ks < 4; ++ks) {
                        const int kofs = 32 * (ks >> 1) + 16 * (ks & 1) + 4 * hh;
                        typedef short s16x4_t __attribute__((ext_vector_type(4)));
                        const s16x4_t v00 = *(const s16x4_t*)(Vl + r32 * LP + kofs), v01 = *(const s16x4_t*)(Vl + r32 * LP + kofs + 8);
                        const s16x4_t v10 = *(const s16x4_t*)(Vl + (32 + r32) * LP + kofs), v11 = *(const s16x4_t*)(Vl + (32 + r32) * LP + kofs + 8);
                        bf16x8_t av0, av1;
#pragma unroll
                        for (int j = 0; j < 4; ++j) { av0[j] = v00[j]; av0[4 + j] = v01[j]; av1[j] = v10[j]; av1[4 + j] = v11[j]; }
                        o0 = MFMA32(av0, pb[ks], o0); o1 = MFMA32(av1, pb[ks], o1);
                    }
                }
                if (more) { *(uint4*)(L + (buf ^ 1) * SLOT + skey * LP + sch) = kr; *(uint4*)(L + (2 + (buf ^ 1)) * SLOT + skey * LP + sch) = vr; }
                mw = mwn;
                {
                    const bool row_done = (qk_bound * 1.4426950408889634f + slope_l2 * (float)(64 * kt - 1)) < m_run * CS - 56.f;
                    const int wdone = __all(row_done) ? 1 : 0;
                    if (lane == 0) sflag[(kt & 1) * 8 + wv] = wdone;
                }
                __syncthreads();
            }
            if (tid == 0) nxt = atomicAdd(qhead + grp, 1);
            const float l_tot = xhalf_sum(l_run);
            const float inv = l_tot > 0.f ? 1.f / l_tot : 0.f;
            bf16_t* orow = O + qrow * AW + h * 64 + 4 * hh;
            if (part) {
                const size_t prow = (size_t)((b * 2 + (h - 6)) * 4096 + (q - 4096));
                if (hh == 0) ((float2*)(p.ws + WS_AML))[(size_t)(part - 1) * 16384 + prow] = make_float2(m_run, l_tot);
                if (part == 2) orow = (bf16_t*)(p.ws + WS_OFAR) + prow * 64 + 4 * hh;
            }
#pragma unroll
            for (int g = 0; g < 4; ++g) {
                uint2 w0, w1;
                w0.x = pk_bf16x2(o0[4 * g] * inv, o0[4 * g + 1] * inv); w0.y = pk_bf16x2(o0[4 * g + 2] * inv, o0[4 * g + 3] * inv);
                w1.x = pk_bf16x2(o1[4 * g] * inv, o1[4 * g + 1] * inv); w1.y = pk_bf16x2(o1[4 * g + 2] * inv, o1[4 * g + 3] * inv);
                *(uint2*)(orow + 8 * g) = w0; *(uint2*)(orow + 32 + 8 * g) = w1;
            }
            }
        }
    }
}

__device__ void ph_attn_merge(const P& p) {
    bf16_t* O = (bf16_t*)(p.ws + WS_OATT); const bf16_t* OF = (const bf16_t*)(p.ws + WS_OFAR); const float2* ML = (const float2*)(p.ws + WS_AML);
    const float CS = 0.125f * 1.4426950408889634f;
    const int tid = otid();
    for (int i = blockIdx.x * NTHR + tid; i < 16384 * 8; i += gridDim.x * NTHR) {
        const int prow = i >> 3, c8 = (i & 7) * 8, bhx = prow >> 12, q = 4096 + (prow & 4095), b = bhx >> 1, h = 6 + (bhx & 1);
        const float2 n_ = ML[prow], f_ = ML[16384 + prow];
        const float mm = fmaxf(n_.x, f_.x);
        const float wn = n_.y * __builtin_amdgcn_exp2f((n_.x - mm) * CS), wf = f_.y * __builtin_amdgcn_exp2f((f_.x - mm) * CS);
        const float inv = (wn + wf) > 0.f ? 1.f / (wn + wf) : 0.f, a_ = wn * inv, b_ = wf * inv;
        bf16_t* op = O + ((size_t)b * SEQ + q) * AW + h * 64 + c8;
        const uint4 on = *(const uint4*)op, of = *(const uint4*)(OF + (size_t)prow * 64 + c8);
        const unsigned wn_[4] = {on.x, on.y, on.z, on.w}, wf_[4] = {of.x, of.y, of.z, of.w}; unsigned o[4];
#pragma unroll
        for (int e = 0; e < 4; ++e) o[e] = pk2(a_ * __uint_as_float(wn_[e] << 16) + b_ * __uint_as_float(wf_[e] << 16), a_ * __uint_as_float(wn_[e] & 0xffff0000u) + b_ * __uint_as_float(wf_[e] & 0xffff0000u));
        *(uint4*)op = make_uint4(o[0], o[1], o[2], o[3]);
    }
}
constexpr int AP = 328, KP = 520, OBP = 72, ODP = 68;
__device__ __forceinline__ f32x4_t mm16(const bf16_t* X, int xrs, const bf16_t* Y, int ycs, int nks, f32x4_t acc, int lane) {
    const int r = lane & 15, q = lane >> 4;
    for (int s2 = 0; s2 < nks; ++s2) {
        const bf16x8_t a = *(const bf16x8_t*)(X + r * xrs + 32 * s2 + 8 * q), b = *(const bf16x8_t*)(Y + r * ycs + 32 * s2 + 8 * q);
        acc = __builtin_amdgcn_mfma_f32_16x16x32_bf16(a, b, acc, 0, 0, 0);
    }
    return acc;
}
__device__ void ph_rwkv_prep(const P& p, float* ldsf, int blk_first, int blk_end, int blk_step) {
    const bf16_t* PS = (const bf16_t*)(p.ws + WS_PS);
    const float* mu = p.in[10]; const float* w0 = p.in[11]; const float* a0 = p.in[13]; const float* k_k = p.in[16]; const float* k_a = p.in[17];
    const bf16_t* W2T = (const bf16_t*)(p.ws + WS_LW2T); const bf16_t* A2T = (const bf16_t*)(p.ws + WS_LA2T); const bf16_t* G2T = (const bf16_t*)(p.ws + WS_LG2T);
    bf16_t* R = (bf16_t*)(p.ws + WS_R); bf16_t* K2 = (bf16_t*)(p.ws + WS_K2); bf16_t* VV = (bf16_t*)(p.ws + WS_VV); bf16_t* KK = (bf16_t*)(p.ws + WS_KK); bf16_t* BB = (bf16_t*)(p.ws + WS_BB);
    bf16_t* G = (bf16_t*)(p.ws + WS_G); float* DD = (float*)(p.ws + WS_DD);
    const int tid = otid(), lane = tid & 63, wv = tid >> 6, l15 = lane & 15, q4 = lane >> 4;
    bf16_t* Amix = (bf16_t*)ldsf; bf16_t* Kbuf = Amix + 32 * AP;
    bf16_t* KKo = Kbuf + 32 * KP + wv * (3 * 16 * OBP + 2 * 16 * ODP); bf16_t* BBo = KKo + 16 * OBP; bf16_t* Go = BBo + 16 * OBP; float* DDo = (float*)(Go + 16 * OBP);
    for (int blk = blk_first; blk < blk_end; blk += blk_step) {
        const int m0 = blk * 32;
        __syncthreads();
        if (tid < 456) {
            const int cc = tid % 228, th = tid / 228, c8 = cc * 8;
            const float4 mu0 = *(const float4*)(mu + c8), mu1 = *(const float4*)(mu + c8 + 4); const float muv[8] = {mu0.x, mu0.y, mu0.z, mu0.w, mu1.x, mu1.y, mu1.z, mu1.w};
            const bf16_t* src = PS + (size_t)(m0 + 16 * th) * SHW + c8;
            uint4 pv = make_uint4(0, 0, 0, 0); if ((m0 + 16 * th) % SEQ) pv = *(const uint4*)(src - SHW);
#pragma unroll 1
            for (int bt = 0; bt < 2; ++bt) {
                uint4 cu[8];
#pragma unroll
                for (int i = 0; i < 8; ++i) cu[i] = *(const uint4*)(src + (size_t)(8 * bt + i) * SHW);
#pragma unroll
                for (int i = 0; i < 8; ++i) {
                    const int tk = 16 * th + 8 * bt + i;
                    const unsigned cw[4] = {cu[i].x, cu[i].y, cu[i].z, cu[i].w}, pw[4] = {pv.x, pv.y, pv.z, pv.w};
                    float mx[8];
#pragma unroll
                    for (int e = 0; e < 8; ++e) { const float c_ = (e & 1) ? __uint_as_float(cw[e >> 1] & 0xffff0000u) : __uint_as_float(cw[e >> 1] << 16), p_ = (e & 1) ? __uint_as_float(pw[e >> 1] & 0xffff0000u) : __uint_as_float(pw[e >> 1] << 16);
                        mx[e] = c_ + (p_ - c_) * muv[e]; }
                    pv = cu[i];
                    if (cc >= 192 && (cc < 200 || cc >= 208)) {
                        const bool th_ = cc < 200; const float A_ = th_ ? 1.f : 0.f, B_ = th_ ? -2.f : 1.f, C_ = th_ ? 2.f : -1.f;
#pragma unroll
                        for (int e = 0; e < 8; ++e) mx[e] = A_ + B_ * __builtin_amdgcn_rcpf(1.f + __expf(C_ * mx[e])); }
                    const uint4 o = make_uint4(pk2(mx[0], mx[1]), pk2(mx[2], mx[3]), pk2(mx[4], mx[5]), pk2(mx[6], mx[7]));
                    if (cc < 64) *(uint4*)(R + (size_t)(m0 + tk) * RW + c8) = o;
                    else if (cc < 128) *(uint4*)(Kbuf + tk * KP + (c8 - 512)) = o;
                    else if (cc < 192) *(uint4*)(VV + (size_t)(m0 + tk) * RW + (c8 - 1024)) = o;
                    else *(uint4*)(Amix + tk * AP + (c8 - 1536)) = o;
                }
            }
        }
        if (tid < 128) *(uint4*)(Amix + (tid >> 2) * AP + 288 + (tid & 3) * 8) = make_uint4(0, 0, 0, 0);
        __syncthreads();
        const int h = wv;
        float rn[2];
#pragma unroll
        for (int rt = 0; rt < 2; ++rt) { const int tk = 16 * rt + l15; float ss = 0.f;
#pragma unroll
            for (int ct = 0; ct < 4; ++ct) { const int c0 = 64 * h + 16 * ct + 4 * q4; const float4 kkc = *(const float4*)(k_k + c0); const uint2 kw = *(const uint2*)(Kbuf + tk * KP + c0);
                const float e0 = __uint_as_float(kw.x << 16) * kkc.x, e1 = __uint_as_float(kw.x & 0xffff0000u) * kkc.y, e2 = __uint_as_float(kw.y << 16) * kkc.z, e3 = __uint_as_float(kw.y & 0xffff0000u) * kkc.w;
                ss += (e0 * e0 + e1 * e1) + (e2 * e2 + e3 * e3); }
            ss += __shfl_xor(ss, 16); ss += __shfl_xor(ss, 32);
            rn[rt] = __builtin_amdgcn_rcpf(fmaxf(sqrtf(ss), 1e-12f)); }
#pragma unroll 1
        for (int rt = 0; rt < 2; ++rt) {
            const int tk = 16 * rt + l15; const bf16_t* xr = Amix + tk * AP + 8 * q4; const float rnv = rt ? rn[1] : rn[0];
            bf16x8_t fw[2], fa[2], fg[6]; float4 cw0n, ca0n, ckan, ckkn;
#define PREP_WLOAD(ct_) do { const int cb_ = 64 * h + 16 * (ct_), c0_ = cb_ + 4 * q4; \
                const bf16_t* yw = W2T + (size_t)(cb_ + l15) * 64 + 8 * q4; const bf16_t* ya = A2T + (size_t)(cb_ + l15) * 64 + 8 * q4; const bf16_t* yg = G2T + (size_t)(cb_ + l15) * 192 + 8 * q4; \
                _Pragma("unroll") for (int s2 = 0; s2 < 2; ++s2) { fw[s2] = *(const bf16x8_t*)(yw + 32 * s2); fa[s2] = *(const bf16x8_t*)(ya + 32 * s2); } \
                _Pragma("unroll") for (int s2 = 0; s2 < 6; ++s2) fg[s2] = *(const bf16x8_t*)(yg + 32 * s2); \
                cw0n = *(const float4*)(w0 + c0_); ca0n = *(const float4*)(a0 + c0_); ckan = *(const float4*)(k_a + c0_); ckkn = *(const float4*)(k_k + c0_); } while (0)
            PREP_WLOAD(0);
#pragma unroll 1
            for (int ct = 0; ct < 4; ++ct) {
                const int cb = 64 * h + 16 * ct, c0 = cb + 4 * q4;
                const float4 cw0 = cw0n, ca0 = ca0n, cka = ckan, ckk = ckkn;
                const float w0v[4] = {cw0.x, cw0.y, cw0.z, cw0.w}, a0v[4] = {ca0.x, ca0.y, ca0.z, ca0.w}, kav[4] = {cka.x, cka.y, cka.z, cka.w}, kkc[4] = {ckk.x, ckk.y, ckk.z, ckk.w};
                f32x4_t cw = {0.f, 0.f, 0.f, 0.f}, ca = cw, cg = cw;
#pragma unroll
                for (int s2 = 0; s2 < 2; ++s2) { cw = __builtin_amdgcn_mfma_f32_16x16x32_bf16(fw[s2], *(const bf16x8_t*)(xr + 32 * s2), cw, 0, 0, 0); ca = __builtin_amdgcn_mfma_f32_16x16x32_bf16(fa[s2], *(const bf16x8_t*)(xr + 64 + 32 * s2), ca, 0, 0, 0); }
#pragma unroll
                for (int s2 = 0; s2 < 6; ++s2) cg = __builtin_amdgcn_mfma_f32_16x16x32_bf16(fg[s2], *(const bf16x8_t*)(xr + 128 + 32 * s2), cg, 0, 0, 0);
                if (ct < 3) PREP_WLOAD(ct + 1);
                bf16_t* kp = Kbuf + tk * KP + c0;
                const uint2 kw2 = *(const uint2*)kp;
                const float kf[4] = {__uint_as_float(kw2.x << 16), __uint_as_float(kw2.x & 0xffff0000u), __uint_as_float(kw2.y << 16), __uint_as_float(kw2.y & 0xffff0000u)};
                float k2v[4], kkv[4], bbv[4], ddv[4];
#pragma unroll
                for (int e = 0; e < 4; ++e) {
                    const float a = sigmoidf_(a0v[e] + ca[e]);
                    kkv[e] = kf[e] * kkc[e] * rnv; bbv[e] = kkv[e] * a; k2v[e] = kf[e] * (1.f + (a - 1.f) * kav[e]); ddv[e] = -0.6065306597126334f * sigmoidf_(w0v[e] + cw[e]); }
                *(uint2*)kp = make_uint2(pk2(k2v[0], k2v[1]), pk2(k2v[2], k2v[3]));
                *(uint2*)(KKo + l15 * OBP + 16 * ct + 4 * q4) = make_uint2(pk2(kkv[0], kkv[1]), pk2(kkv[2], kkv[3]));
                *(uint2*)(BBo + l15 * OBP + 16 * ct + 4 * q4) = make_uint2(pk2(bbv[0], bbv[1]), pk2(bbv[2], bbv[3]));
                *(uint2*)(Go + l15 * OBP + 16 * ct + 4 * q4) = make_uint2(pk2(cg[0], cg[1]), pk2(cg[2], cg[3]));
                *(float4*)(DDo + l15 * ODP + 16 * ct + 4 * q4) = make_float4(ddv[0], ddv[1], ddv[2], ddv[3]);
            }
            __builtin_amdgcn_fence(__ATOMIC_ACQ_REL, "wavefront"); __builtin_amdgcn_wave_barrier();
            {
                const int rb = lane >> 3, cb8 = (lane & 7) * 8;
#pragma unroll
                for (int i = 0; i < 2; ++i) { const int row = rb + 8 * i; const size_t o = (size_t)(m0 + 16 * rt + row) * RW + 64 * h + cb8;
                    *(uint4*)(K2 + o) = *(const uint4*)(Kbuf + (16 * rt + row) * KP + 64 * h + cb8);
                    *(uint4*)(KK + o) = *(const uint4*)(KKo + row * OBP + cb8);
                    *(uint4*)(BB + o) = *(const uint4*)(BBo + row * OBP + cb8);
                    *(uint4*)(G + o) = *(const uint4*)(Go + row * OBP + cb8); }
                const int rd = lane >> 4, cd4 = (lane & 15) * 4;
#pragma unroll
                for (int i = 0; i < 4; ++i) { const int row = rd + 4 * i;
                    *(float4*)(DD + (size_t)(m0 + 16 * rt + row) * RW + 64 * h + cd4) = *(const float4*)(DDo + row * ODP + cd4); }
            }
            __builtin_amdgcn_fence(__ATOMIC_ACQ_REL, "wavefront"); __builtin_amdgcn_wave_barrier();
        }
    }
}

#undef PREP_WLOAD
template <bool XC, bool YC>
__device__ __forceinline__ f32x4_t mm_tile(const bf16_t* X, int xrs, int xcs, const bf16_t* Y, int yrs, int ycs, int tr, int tc, f32x4_t acc, int lane) {
    const int r = lane & 15, q = lane >> 4;
#pragma unroll
    for (int s2 = 0; s2 < 2; ++s2) {
        bf16x8_t a, b;
        const bf16_t* xp = X + (16 * tr + r) * xrs + (32 * s2 + 8 * q) * xcs;
        if (XC) a = *(const bf16x8_t*)xp; else {
#pragma unroll
            for (int j = 0; j < 8; ++j) a[j] = (short)xp[j * xcs]; }
        const bf16_t* yp = Y + (32 * s2 + 8 * q) * yrs + (16 * tc + r) * ycs;
        if (YC) b = *(const bf16x8_t*)yp; else {
#pragma unroll
            for (int j = 0; j < 8; ++j) b[j] = (short)yp[j * yrs]; }
        acc = __builtin_amdgcn_mfma_f32_16x16x32_bf16(a, b, acc, 0, 0, 0);
    }
    return acc;
}
__device__ __forceinline__ void st_tile(const f32x4_t& acc, bf16_t* D, int drs, int dcs, int tr, int tc, int lane) {
    const int row0 = 16 * tr + 4 * (lane >> 4), col = 16 * tc + (lane & 15);
    const unsigned w01 = pk_bf16(acc[0], acc[1]), w23 = pk_bf16(acc[2], acc[3]);
    D[(row0 + 0) * drs + col * dcs] = (bf16_t)(w01 & 0xffffu); D[(row0 + 1) * drs + col * dcs] = (bf16_t)(w01 >> 16);
    D[(row0 + 2) * drs + col * dcs] = (bf16_t)(w23 & 0xffffu); D[(row0 + 3) * drs + col * dcs] = (bf16_t)(w23 >> 16);
}
__device__ __forceinline__ f32x4_t ld_tile(const bf16_t* D, int drs, int dcs, int tr, int tc, int lane) {
    const int row0 = 16 * tr + 4 * (lane >> 4), col = 16 * tc + (lane & 15); f32x4_t v;
#pragma unroll
    for (int e = 0; e < 4; ++e) v[e] = bf2f(D[(row0 + e) * drs + col * dcs]);
    return v;
}
template <bool STRICT> __device__ __forceinline__ void triu_tile(f32x4_t& acc, int tr, int tc, int lane) {
    const int row0 = 16 * tr + 4 * (lane >> 4), col = 16 * tc + (lane & 15);
#pragma unroll
    for (int e = 0; e < 4; ++e) { const bool keep = STRICT ? (row0 + e < col) : (row0 + e <= col); acc[e] = keep ? acc[e] : 0.f; }
}

__device__ void ph_rwkv_r1(const P& p, float* ldsf, int ch_first, int ch_end, int ch_step) {
    const bf16_t* R = (const bf16_t*)(p.ws + WS_R); const bf16_t* K2 = (const bf16_t*)(p.ws + WS_K2); const bf16_t* VV = (const bf16_t*)(p.ws + WS_VV);
    const bf16_t* KK = (const bf16_t*)(p.ws + WS_KK); const bf16_t* BB = (const bf16_t*)(p.ws + WS_BB); const float* DD = (const float*)(p.ws + WS_DD);
    bf16_t* L = (bf16_t*)ldsf;
    bf16_t* At = L + 0 * SLOT; bf16_t* AtT = L + 1 * SLOT; bf16_t* Bt = L + 2 * SLOT; bf16_t* Kt = L + 3 * SLOT; bf16_t* Rt = L + 4 * SLOT; bf16_t* BhT = L + 5 * SLOT; bf16_t* Kh = L + 6 * SLOT;
    bf16_t* S7 = L + 7 * SLOT; bf16_t* S8 = L + 8 * SLOT; bf16_t* S9 = L + 9 * SLOT; bf16_t* Mka = L + 10 * SLOT; bf16_t* NbrT = L + 11 * SLOT; bf16_t* Nkr = L + 12 * SLOT;
    float* cs = (float*)(L + 13 * SLOT);
    float* segs = cs + 64 * 64;
    float* gLs = segs + 8 * 64;
    const int tid = otid(), lane = tid & 63, wv = tid >> 6;
    const int t0 = 2 * wv, t1 = 2 * wv + 1;
    for (int ch = ch_first; ch < ch_end; ch += ch_step) {
        const int bh = ch >> 7, c = ch & 127, b = bh >> 3, h = bh & 7;
        const size_t gbase = ((size_t)b * SEQ + (size_t)c * 64) * RW + h * 64;
        bf16_t* G1T = (bf16_t*)(p.ws + WS_KK) + gbase; bf16_t* PT = (bf16_t*)(p.ws + WS_BB) + gbase; bf16_t* G2T = (bf16_t*)(p.ws + WS_DD) + 2 * gbase; bf16_t* QT = G2T + 64;
        __syncthreads();
        const int st = tid >> 3, sj = (tid & 7) * 8;
        const uint4 rr = *(const uint4*)(R + gbase + (size_t)st * RW + sj), kr = *(const uint4*)(K2 + gbase + (size_t)st * RW + sj);
        const uint4 kkr = *(const uint4*)(KK + gbase + (size_t)st * RW + sj), br = *(const uint4*)(BB + gbase + (size_t)st * RW + sj);
        float lgIv[8], lgEv[8], glv[8];
        { const float4 l0 = *(const float4*)(DD + gbase + (size_t)st * RW + sj), l1 = *(const float4*)(DD + gbase + (size_t)st * RW + sj + 4);
          const float dv[8] = {l0.x, l0.y, l0.z, l0.w, l1.x, l1.y, l1.z, l1.w};
          float pre[8];
#pragma unroll
          for (int e = 0; e < 8; ++e) pre[e] = dv[e];
#pragma unroll
          for (int off = 8; off < 64; off <<= 1) {
#pragma unroll
              for (int e = 0; e < 8; ++e) { const float t_ = __shfl_up(pre[e], off); if (lane >= off) pre[e] += t_; } }
          if (lane >= 56) { float* d = segs + wv * 64 + sj; *(float4*)d = make_float4(pre[0], pre[1], pre[2], pre[3]); *(float4*)(d + 4) = make_float4(pre[4], pre[5], pre[6], pre[7]); }
          __syncthreads();
          float base[8];
#pragma unroll
          for (int e = 0; e < 8; ++e) { base[e] = 0.f; glv[e] = 0.f; }
#pragma unroll
          for (int q = 0; q < 8; ++q) { const float4 s0 = *(const float4*)(segs + q * 64 + sj), s1 = *(const float4*)(segs + q * 64 + sj + 4); const float sv[8] = {s0.x, s0.y, s0.z, s0.w, s1.x, s1.y, s1.z, s1.w};
#pragma unroll
              for (int e = 0; e < 8; ++e) { glv[e] += sv[e]; base[e] += (q < wv) ? sv[e] : 0.f; } }
#pragma unroll
          for (int e = 0; e < 8; ++e) { lgIv[e] = base[e] + pre[e]; lgEv[e] = lgIv[e] - dv[e]; }
          if (tid < 8) {
#pragma unroll
              for (int e = 0; e < 8; ++e) gLs[sj + e] = __expf(glv[e]); }
        }
        {
            const unsigned rw_[4] = {rr.x, rr.y, rr.z, rr.w}, kw_[4] = {kr.x, kr.y, kr.z, kr.w}, kkw_[4] = {kkr.x, kkr.y, kkr.z, kkr.w}, bw_[4] = {br.x, br.y, br.z, br.w};
            unsigned oa[4], ob[4], ok[4], orr[4], okh[4];
#pragma unroll
            for (int e2 = 0; e2 < 4; ++e2) {
                float va[2], vb[2], vk[2], vr2[2], vbh[2], vkh[2];
#pragma unroll
                for (int hf = 0; hf < 2; ++hf) {
                    const int j = sj + 2 * e2 + hf;
                    const float lgI = lgIv[2 * e2 + hf], lgE = lgEv[2 * e2 + hf], gl = glv[2 * e2 + hf];
                    const float rv = hf ? __uint_as_float(rw_[e2] & 0xffff0000u) : __uint_as_float(rw_[e2] << 16);
                    const float kv = hf ? __uint_as_float(kw_[e2] & 0xffff0000u) : __uint_as_float(kw_[e2] << 16);
                    const float kkv = hf ? __uint_as_float(kkw_[e2] & 0xffff0000u) : __uint_as_float(kkw_[e2] << 16);
                    const float bv = hf ? __uint_as_float(bw_[e2] & 0xffff0000u) : __uint_as_float(bw_[e2] << 16);
                    const float einv = __expf(-lgI), eh = __expf(gl - lgI);
                    va[hf] = -kkv * __expf(lgE); vb[hf] = bv * einv; vk[hf] = kv * einv; vr2[hf] = rv * __expf(lgI); vbh[hf] = bv * eh; vkh[hf] = kv * eh;
                    AtT[j * LP + st] = f2bf(va[hf]); BhT[j * LP + st] = f2bf(vbh[hf]);
                }
                oa[e2] = pk2(va[0], va[1]); ob[e2] = pk2(vb[0], vb[1]); ok[e2] = pk2(vk[0], vk[1]); orr[e2] = pk2(vr2[0], vr2[1]); okh[e2] = pk2(vkh[0], vkh[1]);
            }
            *(uint4*)(At + st * LP + sj) = make_uint4(oa[0], oa[1], oa[2], oa[3]); *(uint4*)(Bt + st * LP + sj) = make_uint4(ob[0], ob[1], ob[2], ob[3]);
            *(uint4*)(Kt + st * LP + sj) = make_uint4(ok[0], ok[1], ok[2], ok[3]); *(uint4*)(Rt + st * LP + sj) = make_uint4(orr[0], orr[1], orr[2], orr[3]);
            *(uint4*)(Kh + st * LP + sj) = make_uint4(okh[0], okh[1], okh[2], okh[3]);
        }
        const uint4 vraw = *(const uint4*)(VV + gbase + (size_t)st * RW + sj);
        __syncthreads();
#define R1_FOR_TILES(idx, tr, tc) _Pragma("unroll") for (int _q = 0; _q < 2; ++_q) { const int idx = _q ? t1 : t0; const int tr = idx >> 2, tc = idx & 3;
#define R1_END }
#define MMF(X, Y, acc) mm_tile<true, true>((X), LP, 1, (Y), 1, LP, tr, tc, (acc), lane)
        const f32x4_t zero4 = {0.f, 0.f, 0.f, 0.f};
        R1_FOR_TILES(idx, tr, tc)
            f32x4_t mab = MMF(Bt, At, zero4); triu_tile<true>(mab, tr, tc, lane); st_tile(mab, S7, LP, 1, tr, tc, lane); st_tile(mab, S8, 1, LP, tr, tc, lane);
            { f32x4_t tt = mab; const int row0 = 16 * tr + 4 * (lane >> 4), col = 16 * tc + (lane & 15);
#pragma unroll
              for (int e = 0; e < 4; ++e) tt[e] += (row0 + e == col) ? 1.f : 0.f;
              st_tile(tt, S9, LP, 1, tr, tc, lane); }
            f32x4_t mka = MMF(Kt, At, zero4); triu_tile<true>(mka, tr, tc, lane); st_tile(mka, Mka, LP, 1, tr, tc, lane);
            f32x4_t nbr = MMF(Bt, Rt, zero4); triu_tile<false>(nbr, tr, tc, lane); st_tile(nbr, NbrT, 1, LP, tr, tc, lane);
            f32x4_t nkr = MMF(Kt, Rt, zero4); triu_tile<false>(nkr, tr, tc, lane); st_tile(nkr, Nkr, LP, 1, tr, tc, lane);
        R1_END
        __syncthreads();
        bf16_t* VmT = At;
        { const unsigned vw_[4] = {vraw.x, vraw.y, vraw.z, vraw.w};
#pragma unroll
          for (int e = 0; e < 8; ++e) VmT[(sj + e) * LP + st] = (bf16_t)((e & 1) ? (vw_[e >> 1] >> 16) : (vw_[e >> 1] & 0xffffu)); }
        bf16_t* Pc = S7; bf16_t* PcT = S8; bf16_t* Pn = Bt; bf16_t* PnT = Kt; bf16_t* Tc = S9; bf16_t* Tn = (bf16_t*)cs; bf16_t* TT = nullptr;
#pragma unroll 1
        for (int k = 1; k <= 6; ++k) {
            R1_FOR_TILES(idx, tr, tc)
                if (k <= 5) { f32x4_t pp = MMF(Pc, PcT, zero4); st_tile(pp, Pn, LP, 1, tr, tc, lane); st_tile(pp, PnT, 1, LP, tr, tc, lane); }
                if (k >= 2) { f32x4_t tn = ld_tile(Tc, LP, 1, tr, tc, lane); tn = MMF(Tc, PcT, tn); st_tile(tn, Tn, LP, 1, tr, tc, lane);
                    if (k == 6) st_tile(tn, Pn, 1, LP, tr, tc, lane); }
            R1_END
            __syncthreads();
            if (k == 6) TT = Pn;
            if (k <= 5) { bf16_t* x_ = Pc; Pc = Pn; Pn = x_; x_ = PcT; PcT = PnT; PnT = x_; }
            if (k >= 2) { bf16_t* x_ = Tc; Tc = Tn; Tn = x_; }
        }
        bf16_t* W1 = Pc; bf16_t* W2 = PcT; bf16_t* QkT = PnT;
        bf16_t* Og1 = Tn; bf16_t* Og2 = Tc; bf16_t* Opt = TT; bf16_t* Oqt = W1;
        R1_FOR_TILES(idx, tr, tc)
            f32x4_t w1 = MMF(AtT, TT, zero4); st_tile(w1, W1, LP, 1, tr, tc, lane);
            f32x4_t w2 = MMF(Mka, TT, zero4); st_tile(w2, W2, LP, 1, tr, tc, lane);
        R1_END
        __syncthreads();
        R1_FOR_TILES(idx, tr, tc)
            f32x4_t g1 = ld_tile(Rt, 1, LP, tr, tc, lane); g1 = MMF(W1, NbrT, g1); st_tile(g1, Og1, 1, LP, tr, tc, lane);
            f32x4_t g2 = ld_tile(Nkr, LP, 1, tr, tc, lane); g2 = MMF(W2, NbrT, g2); st_tile(g2, Og2, 1, LP, tr, tc, lane);
            f32x4_t pm = MMF(W1, BhT, zero4);
            { const int row0 = 16 * tr + 4 * (lane >> 4), col = 16 * tc + (lane & 15);
#pragma unroll
              for (int e = 0; e < 4; ++e) pm[e] += (row0 + e == col) ? gLs[col] : 0.f; }
            { const int row0 = 16 * tr + 4 * (lane >> 4), col = 16 * tc + (lane & 15);
#pragma unroll
              for (int e = 0; e < 4; ++e) { const int j = row0 + e; const int frag = (col >> 5) * 4 + 2 * (j >> 5) + ((j & 31) >> 4);
                Opt[(frag * 64 + (col & 31) + 32 * ((j >> 2) & 1)) * 8 + 4 * ((j >> 3) & 1) + (j & 3)] = f2bf(pm[e]); } }
            f32x4_t qk = ld_tile(Kh, LP, 1, tr, tc, lane); qk = MMF(W2, BhT, qk); st_tile(qk, QkT, 1, LP, tr, tc, lane);
        R1_END
        __syncthreads();
        {
            const int row = tid >> 3, ch8 = (tid & 7) * 8;
            *(uint4*)(G1T + (size_t)row * RW + ch8) = *(const uint4*)(Og1 + row * LP + ch8);
            *(uint4*)(G2T + (size_t)row * (2 * RW) + ch8) = *(const uint4*)(Og2 + row * LP + ch8);
            *(uint4*)(PT + (size_t)row * RW + ch8) = *(const uint4*)(Opt + row * 64 + ch8);
        }
        R1_FOR_TILES(idx, tr, tc)
            f32x4_t qt = MMF(QkT, VmT, zero4);
            { const int row0 = 16 * tr + 4 * (lane >> 4), col = 16 * tc + (lane & 15);
#pragma unroll
              for (int e = 0; e < 4; ++e) { const int jp = row0 + e; const int ci = ((jp >> 5) * 2 + (col >> 5)) * 64 + (col & 31) + 32 * ((jp >> 2) & 1);
                Oqt[ci * 16 + (jp & 3) + 4 * ((jp & 31) >> 3)] = f2bf(qt[e]); } }
        R1_END
        __syncthreads();
        { const int ci = tid >> 1, hf = tid & 1;
          *(uint4*)(QT + (size_t)(ci >> 2) * (2 * RW) + (ci & 3) * 16 + hf * 8) = *(const uint4*)(Oqt + ci * 16 + hf * 8); }
#undef MMF
    }
}
__device__ void ph_rwkv_prep_r1(const P& p, float* ldsf) {
    for (int b64 = blockIdx.x; b64 < NT / 64; b64 += gridDim.x) {
        ph_rwkv_prep(p, ldsf, 2 * b64, 2 * b64 + 2, 1);
        __syncthreads();
        const int b = b64 >> 7, c = b64 & 127, ch0 = (b * 8) * 128 + c;
        ph_rwkv_r1(p, ldsf, ch0, ch0 + 8 * 128, 128);
    }
}
__device__ void ph_rwkv_r2(const P& p, int bh_first, int bh_end, int bh_step) {
    bf16_t* SX = (bf16_t*)(p.ws + WS_SX);
    const int tid = otid(), lane = tid & 63, wv = tid >> 6, hh = lane >> 5, r32 = lane & 31;
    typedef short s16x4_t __attribute__((ext_vector_type(4)));
    for (int bh = bh_first; bh < bh_end; bh += bh_step) {
        if (wv >= 2) continue;
        const int cb = wv;
        f32x16_t x0, x1;
#pragma unroll
        for (int i = 0; i < 16; ++i) { x0[i] = 0.f; x1[i] = 0.f; }
        bf16x8_t pa[3][2][4]; uint4 qa[3][2][2];
#define R2_LOAD(S_, c_) do { const size_t gb_ = ((size_t)(bh >> 3) * SEQ + (size_t)(c_) * 64) * RW + (bh & 7) * 64; \
            const bf16_t* PT = (const bf16_t*)(p.ws + WS_BB) + gb_; const bf16_t* QT = (const bf16_t*)(p.ws + WS_DD) + 2 * gb_ + 64; \
            _Pragma("unroll") for (int rb = 0; rb < 2; ++rb) { \
                _Pragma("unroll") for (int ks = 0; ks < 4; ++ks) { const int o_ = ((rb * 4 + ks) * 64 + lane) * 8;        \
                    pa[S_][rb][ks] = *(const bf16x8_t*)(PT + (size_t)(o_ >> 6) * RW + (o_ & 63)); } \
                const int ci_ = (rb * 2 + cb) * 64 + lane; const uint4* qp = (const uint4*)(QT + (size_t)(ci_ >> 2) * (2 * RW) + (ci_ & 3) * 16); qa[S_][rb][0] = qp[0]; qa[S_][rb][1] = qp[1]; } } while (0)
#define R2_STEP(S_, c_) do { const int cc_ = (c_); const size_t ob_ = ((size_t)bh * 128 + cc_) * 4096; \
              \
            const bf16x8_t xb0 = pack_step16(x0, 0), xb1 = pack_step16(x0, 1), xb2 = pack_step16(x1, 0), xb3 = pack_step16(x1, 1); \
            { bf16x8_t* sp = (bf16x8_t*)(SX + ob_) + (cb * 4) * 64 + lane;        \
              sp[0] = xb0; sp[64] = xb1; sp[128] = xb2; sp[192] = xb3; } \
            f32x16_t n0, n1; \
            { const unsigned qw0[8] = {qa[S_][0][0].x, qa[S_][0][0].y, qa[S_][0][0].z, qa[S_][0][0].w, qa[S_][0][1].x, qa[S_][0][1].y, qa[S_][0][1].z, qa[S_][0][1].w}; \
              const unsigned qw1[8] = {qa[S_][1][0].x, qa[S_][1][0].y, qa[S_][1][0].z, qa[S_][1][0].w, qa[S_][1][1].x, qa[S_][1][1].y, qa[S_][1][1].z, qa[S_][1][1].w}; \
              _Pragma("unroll") for (int i = 0; i < 8; ++i) { n0[2 * i] = __uint_as_float(qw0[i] << 16); n0[2 * i + 1] = __uint_as_float(qw0[i] & 0xffff0000u); n1[2 * i] = __uint_as_float(qw1[i] << 16); n1[2 * i + 1] = __uint_as_float(qw1[i] & 0xffff0000u); } } \
              \
            n0 = MFMA32(pa[S_][0][0], xb0, n0); n1 = MFMA32(pa[S_][1][0], xb0, n1); __builtin_amdgcn_sched_barrier(0); \
            n0 = MFMA32(pa[S_][0][1], xb1, n0); n1 = MFMA32(pa[S_][1][1], xb1, n1); __builtin_amdgcn_sched_barrier(0); \
            n0 = MFMA32(pa[S_][0][2], xb2, n0); n1 = MFMA32(pa[S_][1][2], xb2, n1); __builtin_amdgcn_sched_barrier(0); \
            n0 = MFMA32(pa[S_][0][3], xb3, n0); n1 = MFMA32(pa[S_][1][3], xb3, n1); __builtin_amdgcn_sched_barrier(0); \
            x0 = n0; x1 = n1; \
            if (cc_ + 3 < SEQ / 64) R2_LOAD(S_, cc_ + 3); } while (0)
        R2_LOAD(0, 0); R2_LOAD(1, 1); R2_LOAD(2, 2);
#pragma unroll 1
        for (int c = 0; c + 2 < SEQ / 64; c += 3) { R2_STEP(0, c); R2_STEP(1, c + 1); R2_STEP(2, c + 2); }
        R2_STEP(0, SEQ / 64 - 2); R2_STEP(1, SEQ / 64 - 1);
#undef R2_STEP
#undef R2_LOAD
    }
}
__device__ void ph_rwkv_r3(const P& p, float* ldsf) {
    const bf16_t* VV = (const bf16_t*)(p.ws + WS_VV); const bf16_t* SX = (const bf16_t*)(p.ws + WS_SX);
    const bf16_t* Rg = (const bf16_t*)(p.ws + WS_R); const bf16_t* K2 = (const bf16_t*)(p.ws + WS_K2); const bf16_t* Gg = (const bf16_t*)(p.ws + WS_G); bf16_t* ORW = (bf16_t*)(p.ws + WS_ORW);
    const float* r_k = p.in[18]; const float* ln_w = p.in[19]; const float* ln_b = p.in[20];
    bf16_t* Vm0 = (bf16_t*)ldsf;
    constexpr int R3BUF = SLOT + 2 * (64 * 65 + 64);
    const int tid = otid(), lane = tid & 63, wv = tid >> 6; const int t0 = 2 * wv, t1 = 2 * wv + 1;
    const int st = tid >> 3, sj = (tid & 7) * 8;
    __syncthreads();
    int par = 0;
    for (int ch = blockIdx.x; ch < NB * 8 * (SEQ / 64); ch += gridDim.x, par ^= 1) {
        bf16_t* Vm = Vm0 + par * R3BUF; float* Yl = (float*)(Vm + SLOT);
        const int bh = ch >> 7, c = ch & 127, b = bh >> 3, h = bh & 7;
        const size_t gbase = ((size_t)b * SEQ + (size_t)c * 64) * RW + h * 64, ob_ = (size_t)ch * 4096;
        const bf16_t* G1T = (const bf16_t*)(p.ws + WS_KK) + gbase; const bf16_t* G2T = (const bf16_t*)(p.ws + WS_DD) + 2 * gbase;
        typedef short s16x4_t __attribute__((ext_vector_type(4)));
        const size_t o = gbase + (size_t)st * RW + sj;
        const uint4 vraw = *(const uint4*)(VV + o);
        s16x4_t sxl[2][2], sxh[2][2]; bf16x8_t g1f[2][2], g2f[2][2];
#pragma unroll
        for (int _q = 0; _q < 2; ++_q) { const int idx = _q ? t1 : t0, tr = idx >> 2, tc = idx & 3, i_ = 16 * tr + (lane & 15), q_ = lane >> 4;
#pragma unroll
            for (int s2 = 0; s2 < 2; ++s2) { const int j0 = 32 * s2 + 8 * q_;
                const int frag = (i_ >> 5) * 4 + 2 * (j0 >> 5) + ((j0 & 31) >> 4); const bf16_t* fp = SX + ob_ + ((size_t)frag * 64 + (i_ & 31)) * 8 + 4 * ((j0 >> 3) & 1);
                sxl[_q][s2] = *(const s16x4_t*)fp; sxh[_q][s2] = *(const s16x4_t*)(fp + 32 * 8);
                g1f[_q][s2] = *(const bf16x8_t*)(G1T + (size_t)(16 * tc + (lane & 15)) * RW + 32 * s2 + 8 * q_);
                g2f[_q][s2] = *(const bf16x8_t*)(G2T + (size_t)(16 * tc + (lane & 15)) * (2 * RW) + 32 * s2 + 8 * q_); } }
        const uint4 rr = *(const uint4*)(Rg + o), kr = *(const uint4*)(K2 + o), gr = *(const uint4*)(Gg + o);
        *(uint4*)(Vm + st * LP + sj) = vraw;
        __syncthreads();
#pragma unroll
        for (int _q = 0; _q < 2; ++_q) { const int idx = _q ? t1 : t0, tr = idx >> 2, tc = idx & 3, q_ = lane >> 4;
            f32x4_t y = {0.f, 0.f, 0.f, 0.f};
#pragma unroll
            for (int s2 = 0; s2 < 2; ++s2) { bf16x8_t a; const s16x4_t lo = sxl[_q][s2], hi = sxh[_q][s2];
                a[0] = lo[0]; a[1] = lo[1]; a[2] = lo[2]; a[3] = lo[3]; a[4] = hi[0]; a[5] = hi[1]; a[6] = hi[2]; a[7] = hi[3];
                y = __builtin_amdgcn_mfma_f32_16x16x32_bf16(a, g1f[_q][s2], y, 0, 0, 0); }
#pragma unroll
            for (int s2 = 0; s2 < 2; ++s2) { bf16x8_t a; const bf16_t* xp = Vm + (16 * tr + (lane & 15)) + (32 * s2 + 8 * q_) * LP;
#pragma unroll
                for (int j = 0; j < 8; ++j) a[j] = (short)xp[j * LP];
                y = __builtin_amdgcn_mfma_f32_16x16x32_bf16(a, g2f[_q][s2], y, 0, 0, 0); }
            const int i0 = 16 * tr + 4 * (lane >> 4), t = 16 * tc + (lane & 15);
#pragma unroll
            for (int e = 0; e < 4; ++e) Yl[t * 65 + i0 + e] = y[e];
        }
        __syncthreads();
        {
            float y[8], s1 = 0.f;
#pragma unroll
            for (int e = 0; e < 8; ++e) { y[e] = Yl[st * 65 + sj + e]; s1 += y[e]; }
            s1 = sum8_dpp(s1);
            const float mean = s1 * (1.f / 64.f); float s2 = 0.f;
#pragma unroll
            for (int e = 0; e < 8; ++e) { y[e] -= mean; s2 += y[e] * y[e]; }
            s2 = sum8_dpp(s2);
            const float rstd = rsqrtf(s2 * (1.f / 64.f) + GN_EPS);
            const unsigned rw_[4] = {rr.x, rr.y, rr.z, rr.w}, kw_[4] = {kr.x, kr.y, kr.z, kr.w}, gw_[4] = {gr.x, gr.y, gr.z, gr.w}, vw_[4] = {vraw.x, vraw.y, vraw.z, vraw.w};
            float rk = 0.f;
#pragma unroll
            for (int e = 0; e < 8; ++e) { const float r_ = (e & 1) ? __uint_as_float(rw_[e >> 1] & 0xffff0000u) : __uint_as_float(rw_[e >> 1] << 16), k_ = (e & 1) ? __uint_as_float(kw_[e >> 1] & 0xffff0000u) : __uint_as_float(kw_[e >> 1] << 16);
                rk += r_ * k_ * r_k[h * 64 + sj + e]; }
            rk = sum8_dpp(rk);
            float ov[8];
#pragma unroll
            for (int e = 0; e < 8; ++e) { const float v_ = (e & 1) ? __uint_as_float(vw_[e >> 1] & 0xffff0000u) : __uint_as_float(vw_[e >> 1] << 16), g_ = (e & 1) ? __uint_as_float(gw_[e >> 1] & 0xffff0000u) : __uint_as_float(gw_[e >> 1] << 16);
                ov[e] = (y[e] * rstd * ln_w[h * 64 + sj + e] + ln_b[h * 64 + sj + e] + rk * v_) * g_; }
            *(uint4*)(ORW + o) = make_uint4(pk2(ov[0], ov[1]), pk2(ov[2], ov[3]), pk2(ov[4], ov[5]), pk2(ov[6], ov[7]));
        }
    }
}
#undef R1_FOR_TILES
#undef R1_END

__device__ __forceinline__ int unit_pos(int L, int n) {
    const int base = L & ~255, j = L & 255, left = n - base;
    const int R = left >= 256 ? 256 : (left & ~31);
    if (j >= R) return L;
    const int g = R >> 5, m = j >> 2, nt = j & 3;
    return base + (m / g) + 8 * (4 * (m % g) + nt);
}
__device__ void ph_moe_lists(const P& p, float* ldsf) {
    int* ctl = (int*)(p.ws + WS_CTL); const int* cntB = ctl + CT_CNTB;
    int* ltok = (int*)(p.ws + WS_LTOK); float* lw = (float*)(p.ws + WS_LW);
    int* part = (int*)ldsf;
    int* tot = part + 1024; int* pre = tot + 64; int* offL = pre + 64; int* tp = offL + 64;
    const int tid = otid(), lane = tid & 63, wv = tid >> 6, G = gridDim.x;
    { int t_ = 0, p_ = 0;
      for (int b2 = wv; b2 < G; b2 += 8) { const int v = cntB[b2 * 64 + lane]; t_ += v; p_ += (b2 < (int)blockIdx.x) ? v : 0; }
      part[wv * 64 + lane] = t_; part[512 + wv * 64 + lane] = p_; }
    __syncthreads();
    if (tid < 64) { int t_ = 0, p_ = 0;
#pragma unroll
        for (int w2 = 0; w2 < 8; ++w2) { t_ += part[w2 * 64 + tid]; p_ += part[512 + w2 * 64 + tid]; }
        tot[tid] = t_; pre[tid] = p_;
        const int nt_ = (t_ + 255) >> 8; int incl = nt_;
#pragma unroll
        for (int o = 1; o < 64; o <<= 1) { const int oth = __shfl_up(incl, o); if (lane >= o) incl += oth; }
        tp[tid] = incl - nt_; offL[tid] = (incl - nt_) * 256; if (tid == 63) tp[64] = incl; }
    __syncthreads();
    const int TPB = NT / G;
    for (int i = tid; i < TPB; i += NTHR) { const int m = blockIdx.x * TPB + i; const int4 r = ((const int4*)(p.ws + WS_ROUTE))[m];
        const int l0 = r.x & 255, l1 = 32 + ((r.x >> 8) & 255), rk0 = r.y & 0xffff, rk1 = (r.y >> 16) & 0xffff;
        const int p0 = offL[l0] + pre[l0] + rk0, p1 = offL[l1] + pre[l1] + rk1;
        ltok[p0] = m; lw[p0] = __int_as_float(r.z); ltok[p1] = m; lw[p1] = __int_as_float(r.w); }
    for (int li = blockIdx.x; li < 64; li += G) {
        const int cnt = tot[li], off = offL[li], e = li & 31, nt_ = (cnt + 255) >> 8;
        int4* t1 = (int4*)(ctl + CT_TAB1);
        int4* t2 = (li < 32) ? (int4*)(ctl + CT_TAB2A) : (int4*)(ctl + CT_TAB2B);
        const int b1 = tp[li] * 4, n1 = tp[64] * 4, b2 = (li < 32) ? tp[li] * 4 : (tp[li] - tp[32]) * 4, n2 = (li < 32) ? tp[32] * 4 : (tp[64] - tp[32]) * 4;
        for (int i = tid; i < nt_ * 4; i += NTHR) { const int mt = i >> 2, nt = i & 3; const int4 ent = make_int4(off + mt * 256, e * 1024 + nt * 256, cnt - mt * 256, nt);
            t1[unit_pos(b1 + i, n1)] = ent; t2[unit_pos(b2 + i, n2)] = ent; }
        for (int r = cnt + tid; r < nt_ * 256; r += NTHR) ltok[off + r] = 0;
    }
    if (blockIdx.x == 0 && tid == 0) { ctl[CT_NU] = tp[64] * 4; ctl[CT_NU + 1] = tp[32] * 4; ctl[CT_NU + 2] = (tp[64] - tp[32]) * 4; }
}

template <int PH>
__device__ __forceinline__ void run_phase(const P& p, unsigned char* lds_raw) {
    float* lds = (float*)lds_raw; PG8_LAS unsigned char* ldsg = (PG8_LAS unsigned char*)lds_raw;
    const int G = gridDim.x, c = blockIdx.x;
    if constexpr (PH == 0) { ph_mod(p, lds); __syncthreads(); ph_convert_mixer_weights(p, lds); __syncthreads(); ph_convert_lora_weights(p, lds); ph_convert_router_weights(p); }
    if constexpr (PH == 1) ph_norm(p, p.in[0], p.in[4], 0, (bf16_t*)(p.ws + WS_XN));
    if constexpr (PH == 2) { pg8::Gemm g{(const bf16_t*)(p.ws + WS_XN), (const bf16_t*)(p.ws + WS_WIN), DM, nullptr}; pg8::StaticOrder S; S.init(NT, 5120, G, c);
        pg8::EpiInproj E{p.ws, (bf16_t*)p.out}; pg8::gemm_phase(ldsg, g, S, E); }
    if constexpr (PH == 3) {
        { pg8::Gemm g{(const bf16_t*)(p.ws + WS_KVN), (const bf16_t*)(p.ws + WS_WKV), KVL, nullptr}; pg8::StaticOrder S; S.init(NT, 2 * AW, G, c);
          pg8::EpiKV E{p.ws}; pg8::gemm_phase(ldsg, g, S, E);
          pg8::Unit u;
          for (int i = 0; S.next(i, u); ++i) if (u.pn < 2) { __syncthreads(); knorm_tile(p, u.pm, u.pn); } }
        ph_rwkv_prep_r1(p, lds);
        ph_dsa_select(p, lds);
    }
    if constexpr (PH == 4) { ph_rwkv_r2(p, c, NB * 8, G); ph_dsa_attn(p, lds); }
    if constexpr (PH == 5) { ph_attn_merge(p); ph_rwkv_r3(p, lds); }
    if constexpr (PH == 6) { pg8::Gemm g{(const bf16_t*)(p.ws + WS_OATT), (const bf16_t*)(p.ws + WS_WBA), AW, nullptr}; pg8::BranchOrder S; S.S0.init(NT, DM, G, c);
        pg8::EpiMerge E{(bf16_t*)(p.ws + WS_MERGED), (const bf16_t*)p.out}; pg8::gemm_phase(ldsg, g, S, E);
        ph_convert_expert_weights(p, lds); }
    if constexpr (PH == 7) { pg8::Gemm g{(const bf16_t*)(p.ws + WS_MERGED), (const bf16_t*)(p.ws + WS_WOUT), DM, nullptr}; pg8::StaticOrder S; S.init(NT, DM, G, c);
        pg8::EpiOut E{p.in[0], (const float*)(p.ws + WS_MOD), p.out}; pg8::gemm_phase(ldsg, g, S, E); }
    if constexpr (PH == 8) ph_norm_route(p, lds);
    if constexpr (PH == 9) ph_moe_lists(p, lds);
    if constexpr (PH == 10) { const int* ctl = (const int*)(p.ws + WS_CTL);
        pg8::Gemm g{(const bf16_t*)(p.ws + WS_XN2), (const bf16_t*)(p.ws + WS_WGU), DM, (const int*)(p.ws + WS_LTOK)}; pg8::TableOrder S{(const int4*)(ctl + CT_TAB1), ctl[CT_NU], G, c};
        pg8::EpiMoe1 E{(bf16_t*)(p.ws + WS_HID), (const float*)(p.ws + WS_LW)}; pg8::gemm_phase(ldsg, g, S, E); }
    if constexpr (PH == 11 || PH == 12) { const int* ctl = (const int*)(p.ws + WS_CTL);
        pg8::Gemm g{(const bf16_t*)(p.ws + WS_HID), (const bf16_t*)(p.ws + WS_WDN), DE, nullptr};
        pg8::TableOrder S{(const int4*)(ctl + (PH == 11 ? CT_TAB2A : CT_TAB2B)), ctl[CT_NU + (PH == 11 ? 1 : 2)], G, c};
        pg8::EpiMoe2 E{(const int*)(p.ws + WS_LTOK), (const float*)(p.ws + WS_MOD), p.out}; pg8::gemm_phase(ldsg, g, S, E); }
}
constexpr int LDS_BYTES = 147456;
constexpr int ORDER[] = {0, 1, 2, 3, 4, 5, 6, 7, 8, 9, 10, 11, 12};
constexpr int NPHASE = sizeof(ORDER) / sizeof(int);
constexpr int CT_BAR = 65536;
constexpr int LDS_ST = LDS_BYTES - 64;
template <int I> __device__ __forceinline__ void run_all(const P& p, unsigned char* lds, const XcdBarrier& bar) {
    run_phase<ORDER[I]>(p, lds);
    if constexpr (I + 1 < NPHASE) { xcd_barrier(bar); run_all<I + 1>(p, lds, bar); }
}
__global__ void __launch_bounds__(NTHR, 2) k_mega(P p) {
    extern __shared__ __attribute__((aligned(16))) unsigned char lds[];
    volatile LAS3 unsigned* st = (volatile LAS3 unsigned*)((LAS3 unsigned char*)lds + LDS_ST);
    if (otid() < 16) st[otid()] = 0u;
    __syncthreads();
    const XcdBarrier bar = xcd_barrier_post((unsigned*)(p.ws + WS_CTL) + CT_BAR, st);
    run_all<0>(p, lds, bar);
}
}

extern "C" void kernel_launch(void* const* d_in, const int* in_sizes, int n_in, void* d_out, int out_size, void* d_ws, size_t ws_size, hipStream_t stream) {
    if (n_in != 31 || out_size != NT * DM || ws_size < WS_END) { fprintf(stderr, "kernel_launch: unexpected shapes (n_in %d out %d ws %zu need %zu)\n", n_in, out_size, ws_size, (size_t)WS_END); return; }
    P p{};
    for (int i = 0; i < 31; ++i) p.in[i] = (const float*)d_in[i];
    p.out = (float*)d_out; p.ws = (unsigned char*)d_ws;
    (void)hipMemsetAsync((char*)d_ws + WS_CTL, 0, 1 * MiB, stream);
    static int grid_blocks = 0;
    if (!grid_blocks) {
        int dev = 0, cus = 0, per_cu = 0;
        (void)hipGetDevice(&dev);
        (void)hipDeviceGetAttribute(&cus, hipDeviceAttributeMultiprocessorCount, dev);
        (void)hipFuncSetAttribute((const void*)k_mega, hipFuncAttributeMaxDynamicSharedMemorySize, LDS_BYTES);
        (void)hipOccupancyMaxActiveBlocksPerMultiprocessor(&per_cu, (const void*)k_mega, NTHR, LDS_BYTES);
        if (per_cu < 1) per_cu = 1;
        if (per_cu > 1) per_cu = 1;
        grid_blocks = cus * per_cu;
        fprintf(stderr, "kernel_launch: cus %d per_cu %d grid %d\n", cus, per_cu, grid_blocks);
    }
    hipLaunchKernelGGL(k_mega, dim3(grid_blocks), dim3(NTHR), LDS_BYTES, stream, p);
}
```
